# Optimizing an MI355X kernel written in HIP

```python
import math
import jax, jax.numpy as jnp
from jax import lax
import numpy as np


D_MODEL = 1024
BATCH = 8
SEQ = 4096
DEPTH = 1

RMS_EPS = 1e-6
MASK_VALUE = -1e30

NSA_HEADS = 8
NSA_KV_GROUPS = 2
NSA_HEAD_DIM = 64
NSA_CMP_BLOCK = 32
NSA_CMP_STRIDE = 16
NSA_CMP_HIDDEN = 128
NSA_SEL_BLOCK = 64
NSA_TOP_N = 16
NSA_WINDOW = 512
NSA_Q_BLOCK = 64
NSA_FORCE_BONUS = 1e3
NSA_Q_W = NSA_HEADS * NSA_HEAD_DIM
NSA_KV_W = NSA_KV_GROUPS * NSA_HEAD_DIM
NSA_GATE_W = NSA_HEADS * 3

SSM_HEADS = 16
SSM_HEAD_DIM = 64
SSM_INNER = SSM_HEADS * SSM_HEAD_DIM
SSM_GROUPS = 2
SSM_STATE = 128
SSM_CONV = 4
SSM_CHUNK = 256
SSM_CONV_DIM = SSM_INNER + 2 * SSM_GROUPS * SSM_STATE
SSM_DT_MIN = 0.001
SSM_DT_MAX = 0.1

MOE_GROUPS = 4
MOE_EXPERTS_PER_GROUP = 8
MOE_EXPERTS = MOE_GROUPS * MOE_EXPERTS_PER_GROUP
MOE_TOP_K = 2
MOE_HIDDEN = 256
MOE_ROW_BLOCK = 256

PLE_DIM = 256

IN_SIZES = (NSA_Q_W, NSA_KV_W, NSA_KV_W, NSA_KV_W, NSA_KV_W, NSA_KV_W, NSA_KV_W, NSA_GATE_W,
            SSM_INNER, SSM_CONV_DIM, SSM_HEADS, 2 * D_MODEL)
IN_W = sum(IN_SIZES)

kernel_name = 'nsa_ssd_hier_moe_hybrid_block'


def rmsnorm(x, gain):
    xf = x.astype(jnp.float32)
    y = xf * lax.rsqrt(jnp.mean(xf * xf, axis=-1, keepdims=True) + RMS_EPS)
    return (y * gain.astype(jnp.float32)).astype(x.dtype)


def _compress(k, pos, w1, w2):
    b, s, g, hd = k.shape
    r = NSA_CMP_BLOCK // NSA_CMP_STRIDE
    n_cmp = s // NSA_CMP_STRIDE - r + 1
    chunks = k.reshape(b, s // NSA_CMP_STRIDE, NSA_CMP_STRIDE, g, hd)
    blocks = jnp.concatenate([chunks[:, j:j + n_cmp] for j in range(r)], axis=2)
    blocks = blocks + pos[None, None, :, None, :]
    flat = blocks.transpose(0, 3, 1, 2, 4).reshape(b, g, n_cmp, NSA_CMP_BLOCK * hd)
    return jax.nn.silu(flat @ w1) @ w2


def nsa_mixer(q, kc, vc, ks, vs, kw, vw, gate_logits, q_gain, kc_gain, ks_gain, kw_gain,
              pos_k, w1_k, w2_k, pos_v, w1_v, w2_v):
    b, s = q.shape[:2]
    G, E, hd = NSA_KV_GROUPS, NSA_HEADS // NSA_KV_GROUPS, NSA_HEAD_DIM
    QB, SB, W = NSA_Q_BLOCK, NSA_SEL_BLOCK, NSA_WINDOW
    nqb, n_sel = s // QB, s // SB
    n_top = min(NSA_TOP_N, n_sel)
    scale = hd ** -0.5

    q = rmsnorm(q.reshape(b, s, G, E, hd), q_gain)
    to_g = lambda t: t.transpose(0, 2, 1, 3)
    k_cmp = rmsnorm(_compress(kc, pos_k, w1_k, w2_k), kc_gain)
    v_cmp = _compress(vc, pos_v, w1_v, w2_v)
    n_cmp = k_cmp.shape[2]
    k_sel = to_g(rmsnorm(ks, ks_gain)).reshape(b, G, n_sel, SB, hd)
    v_sel = to_g(vs).reshape(b, G, n_sel, SB, hd)
    pad = ((0, 0), (0, 0), (W, 0), (0, 0))
    k_win = jnp.pad(to_g(rmsnorm(kw, kw_gain)), pad)
    v_win = jnp.pad(to_g(vw), pad)

    cmp_start = jnp.arange(n_cmp) * NSA_CMP_STRIDE
    cmp_end = cmp_start + NSA_CMP_BLOCK - 1
    sel_idx = jnp.arange(n_sel)
    overlap = ((cmp_start[:, None] <= sel_idx[None, :] * SB + SB - 1)
               & (cmp_end[:, None] >= sel_idx[None, :] * SB)).astype(jnp.float32)
    bi = jnp.arange(b)[:, None, None, None]
    gi = jnp.arange(G)[None, :, None, None]

    q_blk = q.reshape(b, nqb, QB, G, E, hd).transpose(1, 0, 3, 4, 2, 5)
    g_blk = jax.nn.sigmoid(gate_logits.reshape(b, nqb, QB, G, E, 3)).transpose(1, 0, 3, 4, 2, 5)

    def block(args):
        qq, gg, i = args
        t = i * QB + jnp.arange(QB)
        s_c = jnp.einsum('bgeqd,bgcd->bgeqc', qq, k_cmp).astype(jnp.float32) * scale
        m_c = cmp_end[None, :] <= t[:, None]
        p_c = jax.nn.softmax(jnp.where(m_c, s_c, MASK_VALUE), axis=-1) * jnp.any(m_c, axis=-1)[:, None]
        o_c = jnp.einsum('bgeqc,bgcd->bgeqd', p_c.astype(v_cmp.dtype), v_cmp)
        imp = jnp.einsum('bgeqc,cj->bgqj', p_c, overlap)
        cur = t // SB
        j = sel_idx[None, :]
        forced = (j == 0) | (j == cur[:, None]) | (j == cur[:, None] - 1)
        valid = j * SB <= t[:, None]
        imp = jnp.where(valid, imp + NSA_FORCE_BONUS * forced, -jnp.inf)
        _, top = lax.top_k(imp, n_top)
        top_ok = jnp.take_along_axis(jnp.broadcast_to(valid, imp.shape), top, axis=-1)
        kg = k_sel[bi, gi, top]
        vg = v_sel[bi, gi, top]
        kpos = top[..., None] * SB + jnp.arange(SB)
        m_s = (kpos <= t[:, None, None]) & top_ok[..., None]
        s_s = jnp.einsum('bgeqd,bgqnkd->bgeqnk', qq, kg).astype(jnp.float32) * scale
        s_s = jnp.where(m_s[:, :, None], s_s, MASK_VALUE).reshape(b, G, E, QB, n_top * SB)
        p_s = jax.nn.softmax(s_s, axis=-1).reshape(b, G, E, QB, n_top, SB)
        o_s = jnp.einsum('bgeqnk,bgqnkd->bgeqd', p_s.astype(vg.dtype), vg)
        kw_b = lax.dynamic_slice_in_dim(k_win, i * QB, QB + W, axis=2)
        vw_b = lax.dynamic_slice_in_dim(v_win, i * QB, QB + W, axis=2)
        wpos = i * QB - W + jnp.arange(QB + W)
        dist = t[:, None] - wpos[None, :]
        m_w = (wpos[None, :] >= 0) & (dist >= 0) & (dist < W)
        s_w = jnp.einsum('bgeqd,bgkd->bgeqk', qq, kw_b).astype(jnp.float32) * scale
        p_w = jax.nn.softmax(jnp.where(m_w, s_w, MASK_VALUE), axis=-1)
        o_w = jnp.einsum('bgeqk,bgkd->bgeqd', p_w.astype(vw_b.dtype), vw_b)
        return gg[..., 0:1] * o_c + gg[..., 1:2] * o_s + gg[..., 2:3] * o_w

    out = lax.map(block, (q_blk, g_blk, jnp.arange(nqb)))
    return out.transpose(1, 0, 4, 2, 3, 5).reshape(b, s, NSA_HEADS * hd)


def ssd_mixer(z, xbc, dt_raw, conv_w, conv_b, dt_bias, a_log, d_skip, norm_gain):
    b, s, cdim = xbc.shape
    G, E, P, N = SSM_GROUPS, SSM_HEADS // SSM_GROUPS, SSM_HEAD_DIM, SSM_STATE
    f32 = jnp.float32
    Lc = math.gcd(SSM_CHUNK, s)
    nc = s // Lc
    conv = lax.conv_general_dilated(xbc, conv_w[:, None, :], window_strides=(1,),
                                    padding=[(SSM_CONV - 1, 0)],
                                    dimension_numbers=('NWC', 'WIO', 'NWC'),
                                    feature_group_count=cdim)
    xbc = jax.nn.silu(conv + conv_b)
    xs, bm, cm = jnp.split(xbc, [SSM_INNER, SSM_INNER + G * N], axis=-1)
    x = xs.reshape(b, s, G, E, P)
    dt = jax.nn.softplus(dt_raw.astype(f32) + dt_bias.astype(f32)).reshape(b, s, G, E)
    a = -jnp.exp(a_log.astype(f32)).reshape(G, E)
    xd = (x.astype(f32) * dt[..., None]).reshape(b, nc, Lc, G, E, P)
    bc = bm.astype(f32).reshape(b, nc, Lc, G, N)
    cc = cm.astype(f32).reshape(b, nc, Lc, G, N)
    a_cs = jnp.cumsum((dt * a).reshape(b, nc, Lc, G, E).transpose(0, 3, 4, 1, 2), axis=-1)
    causal = jnp.tril(jnp.ones((Lc, Lc), dtype=bool))
    seg = jnp.exp(jnp.where(causal, a_cs[..., :, None] - a_cs[..., None, :], -jnp.inf))
    cb = jnp.einsum('bclgn,bcsgn->bgcls', cc, bc)
    y_diag = jnp.einsum('bgecls,bcsgep->bclgep', cb[:, :, None] * seg, xd)
    to_cl = lambda t: t.transpose(0, 3, 4, 1, 2)
    decay_in = to_cl(jnp.exp(a_cs[..., -1:] - a_cs))
    states = jnp.einsum('bclgn,bclgep->bcgepn', bc, xd * decay_in[..., None])
    chunk_decay = jnp.exp(a_cs[..., -1])

    def step(h, inp):
        st, dec = inp
        return h * dec[..., None, None] + st, h

    _, prev = lax.scan(step, jnp.zeros((b, G, E, P, N), f32),
                       (jnp.moveaxis(states, 1, 0), jnp.moveaxis(chunk_decay, -1, 0)))
    prev = jnp.moveaxis(prev, 0, 1)
    y_off = jnp.einsum('bclgn,bcgepn->bclgep', cc, prev) * to_cl(jnp.exp(a_cs))[..., None]
    y = (y_diag + y_off).reshape(b, s, G, E, P) + x.astype(f32) * d_skip.astype(f32).reshape(G, E, 1)
    gw = SSM_INNER // G
    y = y.reshape(b, s, G, gw) * jax.nn.silu(z.astype(f32)).reshape(b, s, G, gw)
    y = rmsnorm(y, norm_gain.reshape(G, gw))
    return y.reshape(b, s, SSM_INNER).astype(z.dtype)


def hier_moe(h, w_group, b_group, w_expert, b_expert, w_gate, w_up, w_down):
    b, s, d = h.shape
    n = b * s
    hf = h.reshape(n, d)
    grp_p = jax.nn.softmax((hf @ w_group + b_group).astype(jnp.float32), axis=-1)
    grp_w, grp_i = lax.top_k(grp_p, 1)
    e_logits = (hf @ w_expert + b_expert).astype(jnp.float32).reshape(n, MOE_GROUPS, MOE_EXPERTS_PER_GROUP)
    e_logits = jnp.take_along_axis(e_logits, grp_i[:, :, None], axis=1)[:, 0]
    top_p, top_i = lax.top_k(jax.nn.softmax(e_logits, axis=-1), MOE_TOP_K)
    weights = grp_w * top_p / jnp.sum(top_p, axis=-1, keepdims=True)
    experts = grp_i * MOE_EXPERTS_PER_GROUP + top_i

    e_flat = experts.reshape(-1)
    w_flat = weights.reshape(-1)
    tok = jnp.repeat(jnp.arange(n, dtype=jnp.int32), MOE_TOP_K)
    order = jnp.argsort(e_flat)
    se, st, sw = e_flat[order], tok[order], w_flat[order]
    counts = jnp.zeros((MOE_EXPERTS,), jnp.int32).at[e_flat].add(1)
    starts = jnp.cumsum(counts) - counts
    padded = (counts + MOE_ROW_BLOCK - 1) // MOE_ROW_BLOCK * MOE_ROW_BLOCK
    pend = jnp.cumsum(padded)
    pstarts = pend - padded
    dest = pstarts[se] + jnp.arange(n * MOE_TOP_K, dtype=jnp.int32) - starts[se]
    n_blocks = -(-(n * MOE_TOP_K) // MOE_ROW_BLOCK) + MOE_EXPERTS
    slot_tok = jnp.full((n_blocks * MOE_ROW_BLOCK,), n, jnp.int32).at[dest].set(st)
    slot_w = jnp.zeros((n_blocks * MOE_ROW_BLOCK,), jnp.float32).at[dest].set(sw)
    block_e = jnp.clip(jnp.searchsorted(pend, jnp.arange(n_blocks) * MOE_ROW_BLOCK, side='right'),
                       0, MOE_EXPERTS - 1)
    x_pad = jnp.concatenate([hf, jnp.zeros((1, d), hf.dtype)], axis=0)
    x_slots = x_pad[slot_tok].reshape(n_blocks, MOE_ROW_BLOCK, d)

    def expert_rows(args):
        xb, e = args
        return (jax.nn.silu(xb @ w_gate[e]) * (xb @ w_up[e])) @ w_down[e]

    out = lax.map(expert_rows, (x_slots, block_e)).reshape(-1, d)
    out = out * slot_w[:, None].astype(out.dtype)
    y = jnp.zeros((n + 1, d), out.dtype).at[slot_tok].add(out)[:n]
    return y.reshape(b, s, d)


def setup_inputs(seed: int = 0) -> dict:
    key = jax.random.key(seed)
    ks = iter(jax.random.split(key, 48))
    L = DEPTH
    hd = NSA_HEAD_DIM

    def nrm(shape, scale):
        return jax.random.normal(next(ks), shape, jnp.float32) * scale

    def gain(n):
        return 1.0 + nrm((L, n), 0.05)

    x = nrm((BATCH, SEQ, D_MODEL), 1.0)
    p = nrm((DEPTH, BATCH, SEQ, PLE_DIM), 1.0)
    dt = jnp.exp(jax.random.uniform(next(ks), (L, SSM_HEADS), jnp.float32,
                                    minval=math.log(SSM_DT_MIN), maxval=math.log(SSM_DT_MAX)))
    dt_bias = dt + jnp.log(-jnp.expm1(-dt))
    a_log = jnp.log(jax.random.uniform(next(ks), (L, SSM_HEADS), jnp.float32, minval=1.0, maxval=16.0))
    cl = NSA_CMP_BLOCK * hd
    return {
        'x': x,
        'p': p,
        'mix_norm': gain(D_MODEL),
        'w_in': nrm((L, D_MODEL, IN_W), D_MODEL ** -0.5),
        'nsa_q_gain': gain(hd),
        'nsa_kc_gain': gain(hd),
        'nsa_ks_gain': gain(hd),
        'nsa_kw_gain': gain(hd),
        'cmp_pos_k': nrm((L, NSA_CMP_BLOCK, hd), 0.1),
        'cmp_w1_k': nrm((L, cl, NSA_CMP_HIDDEN), cl ** -0.5),
        'cmp_w2_k': nrm((L, NSA_CMP_HIDDEN, hd), NSA_CMP_HIDDEN ** -0.5),
        'cmp_pos_v': nrm((L, NSA_CMP_BLOCK, hd), 0.1),
        'cmp_w1_v': nrm((L, cl, NSA_CMP_HIDDEN), cl ** -0.5),
        'cmp_w2_v': nrm((L, NSA_CMP_HIDDEN, hd), NSA_CMP_HIDDEN ** -0.5),
        'ssm_conv_w': nrm((L, SSM_CONV, SSM_CONV_DIM), SSM_CONV ** -0.5),
        'ssm_conv_b': nrm((L, SSM_CONV_DIM), 0.02),
        'ssm_dt_bias': dt_bias,
        'ssm_a_log': a_log,
        'ssm_d': 1.0 + nrm((L, SSM_HEADS), 0.1),
        'ssm_norm': gain(SSM_INNER),
        'w_branch_a': nrm((L, NSA_Q_W, D_MODEL), NSA_Q_W ** -0.5),
        'w_branch_b': nrm((L, SSM_INNER, D_MODEL), SSM_INNER ** -0.5),
        'w_out': nrm((L, D_MODEL, D_MODEL), D_MODEL ** -0.5),
        'moe_norm': gain(D_MODEL),
        'moe_w_group': nrm((L, D_MODEL, MOE_GROUPS), D_MODEL ** -0.5),
        'moe_b_group': nrm((L, MOE_GROUPS), 0.01),
        'moe_w_expert': nrm((L, D_MODEL, MOE_EXPERTS), D_MODEL ** -0.5),
        'moe_b_expert': nrm((L, MOE_EXPERTS), 0.01),
        'moe_w_gate': nrm((L, MOE_EXPERTS, D_MODEL, MOE_HIDDEN), D_MODEL ** -0.5),
        'moe_w_up': nrm((L, MOE_EXPERTS, D_MODEL, MOE_HIDDEN), D_MODEL ** -0.5),
        'moe_w_down': nrm((L, MOE_EXPERTS, MOE_HIDDEN, D_MODEL), MOE_HIDDEN ** -0.5),
        'ple_norm': gain(D_MODEL),
        'ple_w_gate': nrm((L, D_MODEL, D_MODEL), D_MODEL ** -0.5),
        'ple_w_proj': nrm((L, PLE_DIM, D_MODEL), PLE_DIM ** -0.5),
    }


def reference(x, p, mix_norm, w_in, nsa_q_gain, nsa_kc_gain, nsa_ks_gain, nsa_kw_gain,
              cmp_pos_k, cmp_w1_k, cmp_w2_k, cmp_pos_v, cmp_w1_v, cmp_w2_v,
              ssm_conv_w, ssm_conv_b, ssm_dt_bias, ssm_a_log, ssm_d, ssm_norm,
              w_branch_a, w_branch_b, w_out,
              moe_norm, moe_w_group, moe_b_group, moe_w_expert, moe_b_expert,
              moe_w_gate, moe_w_up, moe_w_down,
              ple_norm, ple_w_gate, ple_w_proj):
    b, s, _ = x.shape
    offsets = np.cumsum(IN_SIZES)[:-1].tolist()
    for i in range(DEPTH):
        h = rmsnorm(x, mix_norm[i])
        proj = h @ w_in[i]
        (q, kc, vc, ks, vs, kw, vw, nsa_g, z, xbc, dt_raw, br_g) = jnp.split(proj, offsets, axis=-1)
        kv = lambda t: t.reshape(b, s, NSA_KV_GROUPS, NSA_HEAD_DIM)
        y_a = nsa_mixer(q.reshape(b, s, NSA_HEADS, NSA_HEAD_DIM), kv(kc), kv(vc), kv(ks), kv(vs),
                        kv(kw), kv(vw), nsa_g, nsa_q_gain[i], nsa_kc_gain[i], nsa_ks_gain[i],
                        nsa_kw_gain[i], cmp_pos_k[i], cmp_w1_k[i], cmp_w2_k[i],
                        cmp_pos_v[i], cmp_w1_v[i], cmp_w2_v[i])
        y_b = ssd_mixer(z, xbc, dt_raw, ssm_conv_w[i], ssm_conv_b[i], ssm_dt_bias[i],
                        ssm_a_log[i], ssm_d[i], ssm_norm[i])
        gate_a, gate_b = jnp.split(jax.nn.sigmoid(br_g), 2, axis=-1)
        merged = gate_a * (y_a @ w_branch_a[i]) + gate_b * (y_b @ w_branch_b[i])
        x = x + merged @ w_out[i]
        h = rmsnorm(x, moe_norm[i])
        x = x + hier_moe(h, moe_w_group[i], moe_b_group[i], moe_w_expert[i], moe_b_expert[i],
                         moe_w_gate[i], moe_w_up[i], moe_w_down[i])
        h = rmsnorm(x, ple_norm[i])
        x = x + jax.nn.sigmoid(h @ ple_w_gate[i]) * (p[i] @ ple_w_proj[i])
    return x
```

```cpp
#include <hip/hip_runtime.h>
#define HD __host__ __device__ inline
#ifndef CFG_DM
#define CFG_DM 1024
#endif
#ifndef CFG_BATCH
#define CFG_BATCH 8
#endif
#ifndef CFG_SEQ
#define CFG_SEQ 4096
#endif
#ifndef CFG_MH
#define CFG_MH 256
#endif
#ifndef CFG_PLE
#define CFG_PLE 256
#endif

namespace nv {
constexpr int DM = CFG_DM, NB = CFG_BATCH, S = CFG_SEQ, MH = CFG_MH, PLE = CFG_PLE;
constexpr int NTOK = NB * S;
constexpr int H = 8, G = 2, E = 4, HD_ = 64;
constexpr int QW = 512, KVW = 128, GW = 24;
constexpr int SH = 16, SP = 64, SI = 1024, SG = 2, SN = 128, SCD = 1536;
constexpr int INW = QW + 6 * KVW + GW + SI + SCD + SH + 2 * DM;
constexpr int O_Q = 0, O_KC = 512, O_VC = 640, O_KS = 768, O_VS = 896, O_KW = 1024, O_VW = 1152, O_NG = 1280, O_Z = 1304, O_XBC = 2328, O_DT = 3864, O_BG = 3880;
static_assert(O_BG + 2 * DM == INW, "in-proj width");
constexpr int NCMP = S / 16 - 1, NSEL = S / 64, NTOP = NSEL < 16 ? NSEL : 16;
constexpr int NEXP = 32;
constexpr float EPS = 1e-6f;

HD float sigmoidf_(float x) { return 1.0f / (1.0f + expf(-x)); }
HD float siluf_(float x) { return x / (1.0f + expf(-x)); }
HD float softplusf_(float x) { return x > 20.f ? x : log1pf(expf(x)); }

struct RmsRows { const float* in; const float* gain; float* out; long ncols;
  HD void operator()(long r) const { const float* x = in + r * ncols; float s = 0.f; for (long c = 0; c < ncols; ++c) s += x[c] * x[c];
    const float rs = 1.0f / sqrtf(s / (float)ncols + EPS); float* o = out + r * ncols; for (long c = 0; c < ncols; ++c) o[c] = x[c] * rs * gain[c]; } };

struct Gemm { const float* A; const float* B; float* C; long M, N, K, lda, ldb, ldc;
  HD long items() const { return ((M + 7) / 8) * ((N + 3) / 4); }
  HD void operator()(long it) const { const long nt = (N + 3) / 4; const long tm = it / nt, tn = it % nt; const long r0 = tm * 8, c0 = tn * 4;
    float acc[8][4];
#pragma unroll
    for (int i = 0; i < 8; ++i)
#pragma unroll
      for (int j = 0; j < 4; ++j) acc[i][j] = 0.f;
    const bool fullc = (c0 + 3 < N);
    for (long k = 0; k < K; ++k) { float b[4];
      if (fullc) {
#pragma unroll
        for (int j = 0; j < 4; ++j) b[j] = B[k * ldb + c0 + j]; }
      else {
#pragma unroll
        for (int j = 0; j < 4; ++j) b[j] = (c0 + j < N) ? B[k * ldb + c0 + j] : 0.f; }
#pragma unroll
      for (int i = 0; i < 8; ++i) { const long r = r0 + i < M ? r0 + i : M - 1; const float a = A[r * lda + k];
#pragma unroll
        for (int j = 0; j < 4; ++j) acc[i][j] += a * b[j]; } }
#pragma unroll
    for (int i = 0; i < 8; ++i) if (r0 + i < M) {
#pragma unroll
      for (int j = 0; j < 4; ++j) if (c0 + j < N) C[(r0 + i) * ldc + c0 + j] = acc[i][j]; } } };

struct NsaPrep { float* proj; const float* qg; const float* ksg; const float* kwg;
  HD long items() const { return (long)S * (H + G + G + 1); }
  HD void norm64(float* v, const float* gain) const { float s = 0.f; for (int d = 0; d < 64; ++d) s += v[d] * v[d]; const float rs = 1.0f / sqrtf(s / 64.f + EPS); for (int d = 0; d < 64; ++d) v[d] = v[d] * rs * gain[d]; }
  HD void operator()(long it) const { const long t = it / (H + G + G + 1); const int w = (int)(it % (H + G + G + 1)); float* row = proj + t * INW;
    if (w < H) norm64(row + O_Q + w * 64, qg);
    else if (w < H + G) norm64(row + O_KS + (w - H) * 64, ksg);
    else if (w < H + 2 * G) norm64(row + O_KW + (w - H - G) * 64, kwg);
    else { for (int j = 0; j < GW; ++j) row[O_NG + j] = sigmoidf_(row[O_NG + j]); } } };

struct CmpFlat { const float* proj; const float* pos; float* flat; long off;
  HD long items() const { return (long)G * NCMP * 2048; }
  HD void operator()(long it) const { const long e = it % 2048, gc = it / 2048; const long c = gc % NCMP, g = gc / NCMP; const long l = e / 64, d = e % 64;
    flat[it] = proj[(16 * c + l) * INW + off + g * 64 + d] + pos[l * 64 + d]; } };
struct SiluInplace { float* v; HD void operator()(long i) const { v[i] = siluf_(v[i]); } };
struct Norm64Rows { float* v; const float* gain;
  HD void operator()(long r) const { float* x = v + r * 64; float s = 0.f; for (int d = 0; d < 64; ++d) s += x[d] * x[d]; const float rs = 1.0f / sqrtf(s / 64.f + EPS); for (int d = 0; d < 64; ++d) x[d] = x[d] * rs * gain[d]; } };

struct CmpAttn { const float* proj; const float* kcmp; const float* vcmp; float* ya; float* ml;
  HD long items() const { return (long)H * S; }
  HD void operator()(long it) const { const long t = it % S; const int h = (int)(it / S), g = h / E; const float* q = proj + t * INW + O_Q + h * 64;
    float qr[64];
#pragma unroll
    for (int d = 0; d < 64; ++d) qr[d] = q[d];
    long nv = (t - 31 >= 0) ? (t - 31) / 16 + 1 : 0; if (nv > NCMP) nv = NCMP;
    float m = -3.0e38f;
    for (long c = 0; c < nv; ++c) { const float* k = kcmp + ((long)g * NCMP + c) * 64; float s = 0.f;
#pragma unroll
      for (int d = 0; d < 64; ++d) s += qr[d] * k[d];
      s *= 0.125f; m = s > m ? s : m; }
    float o[64];
#pragma unroll
    for (int d = 0; d < 64; ++d) o[d] = 0.f;
    float l = 0.f;
    for (long c = 0; c < nv; ++c) { const float* k = kcmp + ((long)g * NCMP + c) * 64; const float* v = vcmp + ((long)g * NCMP + c) * 64; float s = 0.f;
#pragma unroll
      for (int d = 0; d < 64; ++d) s += qr[d] * k[d];
      const float p = expf(s * 0.125f - m); l += p;
#pragma unroll
      for (int d = 0; d < 64; ++d) o[d] += p * v[d]; }
    const float g0 = proj[t * INW + O_NG + h * 3 + 0]; const float inv = nv > 0 ? g0 / l : 0.f;
#pragma unroll
    for (int d = 0; d < 64; ++d) ya[t * QW + h * 64 + d] = o[d] * inv;
    ml[it * 2] = m; ml[it * 2 + 1] = nv > 0 ? l : 0.f; } };

struct Importance { const float* proj; const float* kcmp; const float* ml; float* imp;
  HD long items() const { return (long)G * S * NSEL; }
  HD void operator()(long it) const { const int j = (int)(it % NSEL); const long gt = it / NSEL; const long t = gt % S; const int g = (int)(gt / S);
    long nv = (t - 31 >= 0) ? (t - 31) / 16 + 1 : 0; if (nv > NCMP) nv = NCMP;
    long c0 = 4 * j - 1; if (c0 < 0) c0 = 0; long c1 = 4 * j + 3; if (c1 > nv - 1) c1 = nv - 1;
    float acc = 0.f;
    for (int e = 0; e < E; ++e) { const int h = g * E + e; const float* q = proj + t * INW + O_Q + h * 64; const float m = ml[((long)h * S + t) * 2], l = ml[((long)h * S + t) * 2 + 1];
      if (l > 0.f) for (long c = c0; c <= c1; ++c) { const float* k = kcmp + ((long)g * NCMP + c) * 64; float s = 0.f; for (int d = 0; d < 64; ++d) s += q[d] * k[d]; acc += expf(s * 0.125f - m) / l; } }
    imp[(long)gt * 64 + j] = acc; } };

struct TopSel { const float* imp; unsigned long long* mask;
  HD long items() const { return (long)G * S; }
  HD void operator()(long gt) const { const long t = gt % S; const int cur = (int)(t / 64); unsigned long long m = 0ull;
    for (int r = 0; r < NTOP; ++r) { float best = -3.0e38f; int bj = -1;
      for (int j = 0; j <= cur && j < NSEL; ++j) { if ((m >> j) & 1ull) continue; float v = imp[gt * 64 + j]; if (j == 0 || j == cur || j == cur - 1) v += 1000.f; if (v > best) { best = v; bj = j; } }
      if (bj < 0) break; m |= 1ull << bj; }
    mask[gt] = m; } };

struct SelAttn { const float* proj; const unsigned long long* mask; float* ya;
  HD long items() const { return (long)H * S; }
  HD void operator()(long it) const { const long t = it % S; const int h = (int)(it / S), g = h / E; const float* q = proj + t * INW + O_Q + h * 64; const unsigned long long mk = mask[(long)g * S + t];
    float qr[64], o[64];
#pragma unroll
    for (int d = 0; d < 64; ++d) { qr[d] = q[d]; o[d] = 0.f; }
    float m = -3.0e38f, l = 0.f;
    for (int j = 0; j < NSEL; ++j) { if (!((mk >> j) & 1ull)) continue;
      for (long kp = 64L * j; kp < 64L * j + 64 && kp <= t; ++kp) { const float* k = proj + kp * INW + O_KS + g * 64; const float* v = proj + kp * INW + O_VS + g * 64; float s = 0.f;
#pragma unroll
        for (int d = 0; d < 64; ++d) s += qr[d] * k[d];
        s *= 0.125f;
        if (s > m) { const float f = expf(m - s); l *= f;
#pragma unroll
          for (int d = 0; d < 64; ++d) o[d] *= f;
          m = s; }
        const float p = expf(s - m); l += p;
#pragma unroll
        for (int d = 0; d < 64; ++d) o[d] += p * v[d]; } }
    const float g1 = proj[t * INW + O_NG + h * 3 + 1]; const float inv = g1 / l;
#pragma unroll
    for (int d = 0; d < 64; ++d) ya[t * QW + h * 64 + d] += o[d] * inv; } };

struct WinAttn { const float* proj; float* ya;
  HD long items() const { return (long)H * S; }
  HD void operator()(long it) const { const long t = it % S; const int h = (int)(it / S), g = h / E; const float* q = proj + t * INW + O_Q + h * 64;
    float qr[64], o[64];
#pragma unroll
    for (int d = 0; d < 64; ++d) { qr[d] = q[d]; o[d] = 0.f; }
    float m = -3.0e38f, l = 0.f; long k0 = t - 511; if (k0 < 0) k0 = 0;
    for (long kp = k0; kp <= t; ++kp) { const float* k = proj + kp * INW + O_KW + g * 64; const float* v = proj + kp * INW + O_VW + g * 64; float s = 0.f;
#pragma unroll
      for (int d = 0; d < 64; ++d) s += qr[d] * k[d];
      s *= 0.125f;
      if (s > m) { const float f = expf(m - s); l *= f;
#pragma unroll
        for (int d = 0; d < 64; ++d) o[d] *= f;
        m = s; }
      const float p = expf(s - m); l += p;
#pragma unroll
      for (int d = 0; d < 64; ++d) o[d] += p * v[d]; }
    const float g2 = proj[t * INW + O_NG + h * 3 + 2]; const float inv = g2 / l;
#pragma unroll
    for (int d = 0; d < 64; ++d) ya[t * QW + h * 64 + d] += o[d] * inv; } };

struct SsdConv { const float* proj; const float* cw; const float* cb; const float* dtb; float* xc; float* dts;
  HD long items() const { return (long)S * (SCD + SH); }
  HD void operator()(long it) const { const long t = it / (SCD + SH); const int c = (int)(it % (SCD + SH));
    if (c < SCD) { float a = cb[c]; for (int k = 0; k < 4; ++k) { const long tt = t - 3 + k; if (tt >= 0) a += cw[k * SCD + c] * proj[tt * INW + O_XBC + c]; } xc[t * SCD + c] = siluf_(a); }
    else { const int hh = c - SCD; dts[t * SH + hh] = softplusf_(proj[t * INW + O_DT + hh] + dtb[hh]); } } };
struct SsdScan { const float* xc; const float* dts; const float* alog; float* yp;
  HD long items() const { return (long)SH * SP * 4; }
  HD void operator()(long it) const { const int qt = (int)(it % 4); const int p = (int)((it / 4) % SP); const int hh = (int)(it / (4 * SP)); const int g = hh / 8;
    const float a = -expf(alog[hh]); float st[32];
#pragma unroll
    for (int n = 0; n < 32; ++n) st[n] = 0.f;
    for (long t = 0; t < S; ++t) { const float dt = dts[t * SH + hh]; const float dec = expf(dt * a); const float xd = xc[t * SCD + hh * 64 + p] * dt;
      const float* Bv = xc + t * SCD + SI + g * SN + qt * 32; const float* Cv = xc + t * SCD + SI + SG * SN + g * SN + qt * 32; float y = 0.f;
#pragma unroll
      for (int n = 0; n < 32; ++n) { st[n] = st[n] * dec + xd * Bv[n]; y += Cv[n] * st[n]; }
      yp[((long)qt * S + t) * SI + hh * 64 + p] = y; } } };
struct SsdOut { const float* yp; const float* xc; const float* proj; const float* dskip; const float* ngain; float* yb;
  HD long items() const { return (long)S * SG; }
  HD void operator()(long it) const { const long t = it / SG; const int g = (int)(it % SG); float s = 0.f;
    for (int c = g * 512; c < g * 512 + 512; ++c) { float y = yp[(0L * S + t) * SI + c] + yp[(1L * S + t) * SI + c] + yp[(2L * S + t) * SI + c] + yp[(3L * S + t) * SI + c];
      y += xc[t * SCD + c] * dskip[c / 64]; y *= siluf_(proj[t * INW + O_Z + c]); yb[t * SI + c] = y; s += y * y; }
    const float rs = 1.0f / sqrtf(s / 512.f + EPS);
    for (int c = g * 512; c < g * 512 + 512; ++c) yb[t * SI + c] = yb[t * SI + c] * rs * ngain[c]; } };

struct Merge { float* t1; const float* t2; const float* proj;
  HD long items() const { return (long)S * DM; }
  HD void operator()(long it) const { const long t = it / DM; const int c = (int)(it % DM); const float ga = sigmoidf_(proj[t * INW + O_BG + c]), gb = sigmoidf_(proj[t * INW + O_BG + DM + c]); t1[it] = ga * t1[it] + gb * t2[it]; } };
struct AddInto { float* dst; const float* a; const float* b; HD void operator()(long i) const { dst[i] = a[i] + b[i]; } };
struct CopyF { float* dst; const float* a; HD void operator()(long i) const { dst[i] = a[i]; } };

struct Router { const float* h2; const float* wg; const float* bg; const float* we; const float* be; int* ei; float* ew;
  HD void operator()(long tok) const { const float* x = h2 + tok * DM; float gl[4];
    for (int j = 0; j < 4; ++j) gl[j] = bg[j];
    for (long d = 0; d < DM; ++d) { const float xv = x[d];
#pragma unroll
      for (int j = 0; j < 4; ++j) gl[j] += xv * wg[d * 4 + j]; }
    int gi = 0; float gm = gl[0];
#pragma unroll
    for (int j = 1; j < 4; ++j) if (gl[j] > gm) { gm = gl[j]; gi = j; }
    float gs = 0.f;
#pragma unroll
    for (int j = 0; j < 4; ++j) gs += expf(gl[j] - gm);
    const float grp_w = 1.0f / gs;
    float el[8];
#pragma unroll
    for (int j = 0; j < 8; ++j) el[j] = be[gi * 8 + j];
    for (long d = 0; d < DM; ++d) { const float xv = x[d];
#pragma unroll
      for (int j = 0; j < 8; ++j) el[j] += xv * we[d * NEXP + gi * 8 + j]; }
    int i0 = 0; float m0 = el[0];
#pragma unroll
    for (int j = 1; j < 8; ++j) if (el[j] > m0) { m0 = el[j]; i0 = j; }
    int i1 = -1; float m1 = -3.0e38f;
#pragma unroll
    for (int j = 0; j < 8; ++j) if (j != i0 && el[j] > m1) { m1 = el[j]; i1 = j; }
    const float r = expf(m1 - m0); const float w0 = 1.0f / (1.0f + r), w1 = r / (1.0f + r);
    ei[tok * 2] = gi * 8 + i0; ei[tok * 2 + 1] = gi * 8 + i1; ew[tok * 2] = grp_w * w0; ew[tok * 2 + 1] = grp_w * w1; } };
struct MoeHidden { const float* h2; const float* wgate; const float* wup; const int* ei; float* act;
  HD long items() const { return (long)NTOK * 2 * MH; }
  HD void operator()(long it) const { const int j = (int)(it % MH); const long tk = it / MH; const long tok = tk / 2; const int e = ei[tk]; const float* x = h2 + tok * DM;
    const float* wg_ = wgate + (long)e * DM * MH + j; const float* wu_ = wup + (long)e * DM * MH + j; float a = 0.f, b = 0.f;
    for (long d = 0; d < DM; ++d) { const float xv = x[d]; a += xv * wg_[d * MH]; b += xv * wu_[d * MH]; }
    act[it] = siluf_(a) * b; } };
struct MoeDown { const float* act; const float* wdown; const int* ei; const float* ew; float* x;
  HD long items() const { return (long)NTOK * DM; }
  HD void operator()(long it) const { const int c = (int)(it % DM); const long tok = it / DM; float tot = 0.f;
    for (int k = 0; k < 2; ++k) { const int e = ei[tok * 2 + k]; const float* a = act + (tok * 2 + k) * MH; const float* w = wdown + (long)e * MH * DM + c; float s = 0.f;
      for (int j = 0; j < MH; ++j) s += a[j] * w[(long)j * DM];
      tot += ew[tok * 2 + k] * s; }
    x[it] += tot; } };
struct PleOut { float* x; const float* gt; const float* pp; HD void operator()(long i) const { x[i] = x[i] + sigmoidf_(gt[i]) * pp[i]; } };

struct Inputs { const float *x, *p, *mix_norm, *w_in, *q_gain, *kc_gain, *ks_gain, *kw_gain, *pos_k, *w1_k, *w2_k, *pos_v, *w1_v, *w2_v, *conv_w, *conv_b, *dt_bias, *a_log, *d_skip, *ssm_norm,
  *w_a, *w_b, *w_out, *moe_norm, *w_group, *b_group, *w_expert, *b_expert, *w_gate, *w_up, *w_down, *ple_norm, *ple_wg, *ple_wp; };

template <class L> void forward(const Inputs& I, float* out, float* ws, L& launch, float* dbg_ya = nullptr, float* dbg_yb = nullptr, float* dbg_x1 = nullptr, float* dbg_x2 = nullptr) {
  float* wp = ws;
  auto take = [&](long n) { float* r = wp; wp += (n + 63) / 64 * 64; return r; };
  float* Hb = take((long)S * DM); float* PROJ = take((long)S * INW);
  float* FLAT = take((long)G * NCMP * 2048); float* HID = take((long)G * NCMP * 128); float* KCMP = take((long)G * NCMP * 64); float* VCMP = take((long)G * NCMP * 64);
  float* ML = take((long)H * S * 2); float* IMP = take((long)G * S * 64); unsigned long long* MASK = (unsigned long long*)take((long)G * S * 2);
  float* YA = take((long)S * QW); float* XC = take((long)S * SCD); float* DTS = take((long)S * SH); float* YP = take(4L * S * SI); float* YB = take((long)S * SI);
  float* T1 = take((long)S * DM); float* T2 = take((long)S * DM); float* T3 = take((long)S * DM);
  for (int b = 0; b < NB; ++b) {
    const float* xb = I.x + (long)b * S * DM; float* x1b = out + (long)b * S * DM;
    { RmsRows f{xb, I.mix_norm, Hb, DM}; launch(f, (long)S); }
    { Gemm f{Hb, I.w_in, PROJ, S, INW, DM, DM, INW, INW}; launch(f, f.items()); }
    { NsaPrep f{PROJ, I.q_gain, I.ks_gain, I.kw_gain}; launch(f, f.items()); }
    { CmpFlat f{PROJ, I.pos_k, FLAT, O_KC}; launch(f, f.items()); }
    { Gemm f{FLAT, I.w1_k, HID, (long)G * NCMP, 128, 2048, 2048, 128, 128}; launch(f, f.items()); }
    { SiluInplace f{HID}; launch(f, (long)G * NCMP * 128); }
    { Gemm f{HID, I.w2_k, KCMP, (long)G * NCMP, 64, 128, 128, 64, 64}; launch(f, f.items()); }
    { Norm64Rows f{KCMP, I.kc_gain}; launch(f, (long)G * NCMP); }
    { CmpFlat f{PROJ, I.pos_v, FLAT, O_VC}; launch(f, f.items()); }
    { Gemm f{FLAT, I.w1_v, HID, (long)G * NCMP, 128, 2048, 2048, 128, 128}; launch(f, f.items()); }
    { SiluInplace f{HID}; launch(f, (long)G * NCMP * 128); }
    { Gemm f{HID, I.w2_v, VCMP, (long)G * NCMP, 64, 128, 128, 64, 64}; launch(f, f.items()); }
    { CmpAttn f{PROJ, KCMP, VCMP, YA, ML}; launch(f, f.items()); }
    { Importance f{PROJ, KCMP, ML, IMP}; launch(f, f.items()); }
    { TopSel f{IMP, MASK}; launch(f, f.items()); }
    { SelAttn f{PROJ, MASK, YA}; launch(f, f.items()); }
    { WinAttn f{PROJ, YA}; launch(f, f.items()); }
    { SsdConv f{PROJ, I.conv_w, I.conv_b, I.dt_bias, XC, DTS}; launch(f, f.items()); }
    { SsdScan f{XC, DTS, I.a_log, YP}; launch(f, f.items()); }
    { SsdOut f{YP, XC, PROJ, I.d_skip, I.ssm_norm, YB}; launch(f, f.items()); }
    if (dbg_ya) { CopyF f{dbg_ya + (long)b * S * QW, YA}; launch(f, (long)S * QW); }
    if (dbg_yb) { CopyF f{dbg_yb + (long)b * S * SI, YB}; launch(f, (long)S * SI); }
    { Gemm f{YA, I.w_a, T1, S, DM, QW, QW, DM, DM}; launch(f, f.items()); }
    { Gemm f{YB, I.w_b, T2, S, DM, SI, SI, DM, DM}; launch(f, f.items()); }
    { Merge f{T1, T2, PROJ}; launch(f, f.items()); }
    { Gemm f{T1, I.w_out, T3, S, DM, DM, DM, DM, DM}; launch(f, f.items()); }
    { AddInto f{x1b, xb, T3}; launch(f, (long)S * DM); }
  }
  if (dbg_x1) { CopyF f{dbg_x1, out}; launch(f, (long)NTOK * DM); }
  wp = ws;
  float* H2 = take((long)NTOK * DM); int* EI = (int*)take((long)NTOK * 2); float* EW = take((long)NTOK * 2); float* ACT = take((long)NTOK * 2 * MH);
  { RmsRows f{out, I.moe_norm, H2, DM}; launch(f, (long)NTOK); }
  { Router f{H2, I.w_group, I.b_group, I.w_expert, I.b_expert, EI, EW}; launch(f, (long)NTOK); }
  { MoeHidden f{H2, I.w_gate, I.w_up, EI, ACT}; launch(f, f.items()); }
  { MoeDown f{ACT, I.w_down, EI, EW, out}; launch(f, f.items()); }
  if (dbg_x2) { CopyF f{dbg_x2, out}; launch(f, (long)NTOK * DM); }
  wp = ws;
  float* H3 = take((long)NTOK * DM); float* GT = take((long)NTOK * DM); float* PP = take((long)NTOK * DM);
  { RmsRows f{out, I.ple_norm, H3, DM}; launch(f, (long)NTOK); }
  { Gemm f{H3, I.ple_wg, GT, NTOK, DM, DM, DM, DM, DM}; launch(f, f.items()); }
  { Gemm f{I.p, I.ple_wp, PP, NTOK, DM, PLE, PLE, DM, DM}; launch(f, f.items()); }
  { PleOut f{out, GT, PP}; launch(f, (long)NTOK * DM); }
}
}
template <class F> __global__ void __launch_bounds__(256) run_kernel(F f, long n) {
  for (long i = blockIdx.x * 256L + threadIdx.x; i < n; i += (long)gridDim.x * 256L) f(i);
}
struct GpuLaunch { hipStream_t st;
  template <class F> void operator()(const F& f, long n) { long blocks = (n + 255) / 256; if (blocks > 262144) blocks = 262144; if (blocks < 1) blocks = 1;
    hipLaunchKernelGGL(run_kernel<F>, dim3((unsigned)blocks), dim3(256), 0, st, f, n); } };
extern "C" void kernel_launch(void* const* d_in, const int* in_sizes, int n_in, void* d_out, int out_size, void* d_ws, size_t ws_size, hipStream_t stream) {
  nv::Inputs I; const float** ip = (const float**)&I; for (int i = 0; i < 34; ++i) ip[i] = (const float*)d_in[i];
  GpuLaunch L{stream};
  nv::forward(I, (float*)d_out, (float*)d_ws, L);
}
```

```cpp
#include <hip/hip_runtime.h>
#include <hip/hip_cooperative_groups.h>
#include <cstdio>
#include <cstring>
namespace cg = cooperative_groups;
#define HD __host__ __device__ inline
#ifndef CFG_DM
#define CFG_DM 1024
#endif
#ifndef CFG_BATCH
#define CFG_BATCH 8
#endif
#ifndef CFG_SEQ
#define CFG_SEQ 4096
#endif
#ifndef CFG_MH
#define CFG_MH 256
#endif
#ifndef CFG_PLE
#define CFG_PLE 256
#endif

namespace nv {
typedef unsigned short u16;
typedef unsigned long long u64;
constexpr int DM = CFG_DM, NB = CFG_BATCH, S = CFG_SEQ, MH = CFG_MH, PLE = CFG_PLE;
constexpr int NTOK = NB * S;
constexpr int H = 8, G = 2, E = 4;
constexpr int QW = 512, GW = 24, QKVW = 1280;
constexpr int SH = 16, SP = 64, SI = 1024, SG = 2, SN = 128, SCD = 1536;
constexpr int INW = QW + 6 * 128 + GW + SI + SCD + SH + 2 * DM;
constexpr int O_Q = 0, O_KC = 512, O_VC = 640, O_KS = 768, O_VS = 896, O_KW = 1024, O_VW = 1152, O_NG = 1280, O_Z = 1304, O_XBC = 2328, O_DT = 3864, O_BG = 3880;
static_assert(O_BG + 2 * DM == INW, "in-proj width");
constexpr int NCMP = S / 16 - 1, NCP = S / 16, NSEL = S / 64, NTOP = NSEL < 16 ? NSEL : 16;
constexpr int NEXP = 32;
constexpr float EPS = 1e-6f;

HD float sigmoidf_(float x) { return 1.0f / (1.0f + expf(-x)); }
HD float siluf_(float x) { return x / (1.0f + expf(-x)); }
HD float softplusf_(float x) { return x > 20.f ? x : log1pf(expf(x)); }
HD u16 f2bf(float f) { unsigned u = __builtin_bit_cast(unsigned, f); u += 0x7fffu + ((u >> 16) & 1u); return (u16)(u >> 16); }
HD float bf2f(u16 h) { return __builtin_bit_cast(float, (unsigned)h << 16); }

struct Bufs {
  u16* HB;
  u16* QKV;
  float* NG;
  u16* Z;
  u16* XBC;
  float* DT;
  u16* BG;
  u16* KCMP;
  u16* VCMP;
  u16* YA;
  u16* YB;
  u16* T1;
  u16* MERGED;
  u16* H2;
  u16* ACT;
  u16* PP;
  int* EI;
  float* EW;
  float* HID;
  float* KTMP;
  float* ML;
  float* IMP;
  u64* MASK;
};
struct Inputs { const float *x, *p, *mix_norm, *w_in, *q_gain, *kc_gain, *ks_gain, *kw_gain, *pos_k, *w1_k, *w2_k, *pos_v, *w1_v, *w2_v, *conv_w, *conv_b, *dt_bias, *a_log, *d_skip, *ssm_norm,
  *w_a, *w_b, *w_out, *moe_norm, *w_group, *b_group, *w_expert, *b_expert, *w_gate, *w_up, *w_down, *ple_norm, *ple_wg, *ple_wp; };

struct RmsRowsBf { const float* in; const float* gain; u16* out; long ncols;
  HD void operator()(long r) const { const float* x = in + r * ncols; float s = 0.f; for (long c = 0; c < ncols; ++c) s += x[c] * x[c];
    const float rs = 1.0f / sqrtf(s / (float)ncols + EPS); u16* o = out + r * ncols; for (long c = 0; c < ncols; ++c) o[c] = f2bf(x[c] * rs * gain[c]); } };

template <class AL, class EP> struct GemmT { AL a; const float* B; EP ep; long M, N, K, ldb;
  HD long items() const { return ((M + 7) / 8) * ((N + 3) / 4); }
  HD void operator()(long it) const { const long nt = (N + 3) / 4; const long tm = it / nt, tn = it % nt; const long r0 = tm * 8, c0 = tn * 4;
    float acc[8][4];
#pragma unroll
    for (int i = 0; i < 8; ++i)
#pragma unroll
      for (int j = 0; j < 4; ++j) acc[i][j] = 0.f;
    for (long k = 0; k < K; ++k) { float b[4];
#pragma unroll
      for (int j = 0; j < 4; ++j) b[j] = (c0 + j < N) ? B[k * ldb + c0 + j] : 0.f;
#pragma unroll
      for (int i = 0; i < 8; ++i) { const long r = r0 + i < M ? r0 + i : M - 1; const float av = a(r, k);
#pragma unroll
        for (int j = 0; j < 4; ++j) acc[i][j] += av * b[j]; } }
#pragma unroll
    for (int i = 0; i < 8; ++i) if (r0 + i < M) {
#pragma unroll
      for (int j = 0; j < 4; ++j) if (c0 + j < N) ep(r0 + i, c0 + j, acc[i][j]); } } };
struct ABf { const u16* p; long ld; HD float operator()(long r, long k) const { return bf2f(p[r * ld + k]); } };
struct AF32 { const float* p; long ld; HD float operator()(long r, long k) const { return p[r * ld + k]; } };
struct ACmp { const u16* qkv; const float* pos; long off;
  HD float operator()(long r, long k) const { const long c = r % NCMP, bg = r / NCMP, b = bg / G, g = bg % G; const long l = k / 64, d = k % 64;
    return bf2f(qkv[(b * S + 16 * c + l) * QKVW + off + g * 64 + d]) + pos[k]; } };

struct EpInProj { Bufs B; const float* dt_bias;
  HD void operator()(long r, long c, float v) const {
    if (c < O_NG) B.QKV[r * QKVW + c] = f2bf(v);
    else if (c < O_Z) B.NG[r * GW + (c - O_NG)] = sigmoidf_(v);
    else if (c < O_XBC) B.Z[r * SI + (c - O_Z)] = f2bf(v);
    else if (c < O_DT) B.XBC[r * SCD + (c - O_XBC)] = f2bf(v);
    else if (c < O_BG) B.DT[r * SH + (c - O_DT)] = softplusf_(v + dt_bias[c - O_DT]);
    else B.BG[r * (2 * DM) + (c - O_BG)] = f2bf(sigmoidf_(v)); } };
struct EpSiluF32 { float* o; long ld; HD void operator()(long r, long c, float v) const { o[r * ld + c] = siluf_(v); } };
struct EpF32 { float* o; long ld; HD void operator()(long r, long c, float v) const { o[r * ld + c] = v; } };
struct EpBf { u16* o; long ld; HD void operator()(long r, long c, float v) const { o[r * ld + c] = f2bf(v); } };
struct EpMerge { const u16* t1; const u16* bg; u16* o; HD void operator()(long r, long c, float v) const { const float ga = bf2f(bg[r * (2 * DM) + c]), gb = bf2f(bg[r * (2 * DM) + DM + c]); o[r * DM + c] = f2bf(ga * bf2f(t1[r * DM + c]) + gb * v); } };
struct EpResid { const float* x; float* o; HD void operator()(long r, long c, float v) const { o[r * DM + c] = x[r * DM + c] + v; } };
struct EpPle { float* x; const u16* pp; HD void operator()(long r, long c, float v) const { x[r * DM + c] = x[r * DM + c] + sigmoidf_(v) * bf2f(pp[r * DM + c]); } };

struct QkNorm { u16* qkv; const float* qg; const float* ksg; const float* kwg;
  HD long items() const { return (long)NTOK * 12; }
  HD void operator()(long it) const { const long tok = it / 12; const int w = (int)(it % 12); u16* v; const float* gain;
    if (w < 8) { v = qkv + tok * QKVW + O_Q + w * 64; gain = qg; } else if (w < 10) { v = qkv + tok * QKVW + O_KS + (w - 8) * 64; gain = ksg; } else { v = qkv + tok * QKVW + O_KW + (w - 10) * 64; gain = kwg; }
    float s = 0.f; for (int d = 0; d < 64; ++d) { const float x = bf2f(v[d]); s += x * x; } const float rs = 1.0f / sqrtf(s / 64.f + EPS);
    for (int d = 0; d < 64; ++d) v[d] = f2bf(bf2f(v[d]) * rs * gain[d]); } };
struct CmpFinish { const float* src; const float* gain; u16* dst; long donorm;
  HD long items() const { return (long)NB * G * NCP; }
  HD void operator()(long it) const { const long c = it % NCP, bg = it / NCP; u16* o = dst + it * 64;
    if (c >= NCMP) { for (int d = 0; d < 64; ++d) o[d] = 0; return; }
    const float* x = src + (bg * NCMP + c) * 64; float rs = 1.f;
    if (donorm) { float s = 0.f; for (int d = 0; d < 64; ++d) s += x[d] * x[d]; rs = 1.0f / sqrtf(s / 64.f + EPS); }
    for (int d = 0; d < 64; ++d) o[d] = f2bf(donorm ? x[d] * rs * gain[d] : x[d]); } };

struct CmpAttn { Bufs B;
  HD long items() const { return (long)NB * H * S; }
  HD void operator()(long it) const { const long t = it % S; const int h = (int)((it / S) % H), g = h / E; const long b = it / ((long)S * H); const long tok = b * S + t;
    const u16* q = B.QKV + tok * QKVW + O_Q + h * 64; const u16* kc = B.KCMP + (b * G + g) * (long)NCP * 64; const u16* vc = B.VCMP + (b * G + g) * (long)NCP * 64;
    float qr[64];
#pragma unroll
    for (int d = 0; d < 64; ++d) qr[d] = bf2f(q[d]);
    long nvis = (t - 31 >= 0) ? (t - 31) / 16 + 1 : 0; if (nvis > NCMP) nvis = NCMP;
    float m = -3.0e38f;
    for (long c = 0; c < nvis; ++c) { const u16* k = kc + c * 64; float s = 0.f;
#pragma unroll
      for (int d = 0; d < 64; ++d) s += qr[d] * bf2f(k[d]);
      s *= 0.125f; m = s > m ? s : m; }
    float o[64];
#pragma unroll
    for (int d = 0; d < 64; ++d) o[d] = 0.f;
    float l = 0.f;
    for (long c = 0; c < nvis; ++c) { const u16* k = kc + c * 64; const u16* v = vc + c * 64; float s = 0.f;
#pragma unroll
      for (int d = 0; d < 64; ++d) s += qr[d] * bf2f(k[d]);
      const float p = expf(s * 0.125f - m); l += p;
#pragma unroll
      for (int d = 0; d < 64; ++d) o[d] += p * bf2f(v[d]); }
    const float g0 = B.NG[tok * GW + h * 3 + 0]; const float inv = nvis > 0 ? g0 / l : 0.f;
#pragma unroll
    for (int d = 0; d < 64; ++d) B.YA[tok * QW + h * 64 + d] = f2bf(o[d] * inv);
    B.ML[it * 2] = m; B.ML[it * 2 + 1] = nvis > 0 ? l : 0.f; } };
struct Importance { Bufs B;
  HD long items() const { return (long)NB * G * S * NSEL; }
  HD void operator()(long it) const { const int j = (int)(it % NSEL); const long bgt = it / NSEL; const long t = bgt % S; const long bg = bgt / S; const long b = bg / G; const int g = (int)(bg % G); const long tok = b * S + t;
    long nvis = (t - 31 >= 0) ? (t - 31) / 16 + 1 : 0; if (nvis > NCMP) nvis = NCMP;
    long c0 = 4 * j - 1; if (c0 < 0) c0 = 0; long c1 = 4 * j + 3; if (c1 > nvis - 1) c1 = nvis - 1;
    const u16* kc = B.KCMP + bg * (long)NCP * 64; float acc = 0.f;
    for (int e = 0; e < E; ++e) { const int h = g * E + e; const u16* q = B.QKV + tok * QKVW + O_Q + h * 64; const long mi = ((b * H + h) * (long)S + t) * 2; const float m = B.ML[mi], l = B.ML[mi + 1];
      if (l > 0.f) for (long c = c0; c <= c1; ++c) { const u16* k = kc + c * 64; float s = 0.f; for (int d = 0; d < 64; ++d) s += bf2f(q[d]) * bf2f(k[d]); acc += expf(s * 0.125f - m) / l; } }
    B.IMP[bgt * 64 + j] = acc; } };
struct TopSel { Bufs B;
  HD long items() const { return (long)NB * G * S; }
  HD void operator()(long bgt) const { const long t = bgt % S; const int cur = (int)(t / 64); u64 m = 0ull;
    for (int r = 0; r < NTOP; ++r) { float best = -3.0e38f; int bj = -1;
      for (int j = 0; j <= cur && j < NSEL; ++j) { if ((m >> j) & 1ull) continue; float v = B.IMP[bgt * 64 + j]; if (j == 0 || j == cur || j == cur - 1) v += 1000.f; if (v > best) { best = v; bj = j; } }
      if (bj < 0) break; m |= 1ull << bj; }
    B.MASK[bgt] = m; } };
struct SelAttn { Bufs B;
  HD long items() const { return (long)NB * H * S; }
  HD void operator()(long it) const { const long t = it % S; const int h = (int)((it / S) % H), g = h / E; const long b = it / ((long)S * H); const long tok = b * S + t;
    const u16* q = B.QKV + tok * QKVW + O_Q + h * 64; const u64 mk = B.MASK[(b * G + g) * (long)S + t];
    float qr[64], o[64];
#pragma unroll
    for (int d = 0; d < 64; ++d) { qr[d] = bf2f(q[d]); o[d] = 0.f; }
    float m = -3.0e38f, l = 0.f;
    for (int j = 0; j < NSEL; ++j) { if (!((mk >> j) & 1ull)) continue;
      for (long kp = 64L * j; kp < 64L * j + 64 && kp <= t; ++kp) { const u16* k = B.QKV + (b * S + kp) * QKVW + O_KS + g * 64; const u16* v = B.QKV + (b * S + kp) * QKVW + O_VS + g * 64; float s = 0.f;
#pragma unroll
        for (int d = 0; d < 64; ++d) s += qr[d] * bf2f(k[d]);
        s *= 0.125f;
        if (s > m) { const float f = expf(m - s); l *= f;
#pragma unroll
          for (int d = 0; d < 64; ++d) o[d] *= f;
          m = s; }
        const float p = expf(s - m); l += p;
#pragma unroll
        for (int d = 0; d < 64; ++d) o[d] += p * bf2f(v[d]); } }
    const float g1 = B.NG[tok * GW + h * 3 + 1]; const float inv = g1 / l;
#pragma unroll
    for (int d = 0; d < 64; ++d) { u16* y = B.YA + tok * QW + h * 64 + d; *y = f2bf(bf2f(*y) + o[d] * inv); } } };
struct WinAttn { Bufs B;
  HD long items() const { return (long)NB * H * S; }
  HD void operator()(long it) const { const long t = it % S; const int h = (int)((it / S) % H), g = h / E; const long b = it / ((long)S * H); const long tok = b * S + t;
    const u16* q = B.QKV + tok * QKVW + O_Q + h * 64;
    float qr[64], o[64];
#pragma unroll
    for (int d = 0; d < 64; ++d) { qr[d] = bf2f(q[d]); o[d] = 0.f; }
    float m = -3.0e38f, l = 0.f; long k0 = t - 511; if (k0 < 0) k0 = 0;
    for (long kp = k0; kp <= t; ++kp) { const u16* k = B.QKV + (b * S + kp) * QKVW + O_KW + g * 64; const u16* v = B.QKV + (b * S + kp) * QKVW + O_VW + g * 64; float s = 0.f;
#pragma unroll
      for (int d = 0; d < 64; ++d) s += qr[d] * bf2f(k[d]);
      s *= 0.125f;
      if (s > m) { const float f = expf(m - s); l *= f;
#pragma unroll
        for (int d = 0; d < 64; ++d) o[d] *= f;
        m = s; }
      const float p = expf(s - m); l += p;
#pragma unroll
      for (int d = 0; d < 64; ++d) o[d] += p * bf2f(v[d]); }
    const float g2 = B.NG[tok * GW + h * 3 + 2]; const float inv = g2 / l;
#pragma unroll
    for (int d = 0; d < 64; ++d) { u16* y = B.YA + tok * QW + h * 64 + d; *y = f2bf(bf2f(*y) + o[d] * inv); } } };

struct SsdConv { u16* xbc; const float* cw; const float* cb;
  HD long items() const { return (long)NB * SCD; }
  HD void operator()(long it) const { const int c = (int)(it % SCD); const long b = it / SCD; u16* col = xbc + b * S * SCD + c; const float w0 = cw[c], w1 = cw[SCD + c], w2 = cw[2 * SCD + c], w3 = cw[3 * SCD + c], bias = cb[c];
    for (long t = S - 1; t >= 0; --t) { float a = bias + w3 * bf2f(col[t * SCD]); if (t >= 1) a += w2 * bf2f(col[(t - 1) * SCD]); if (t >= 2) a += w1 * bf2f(col[(t - 2) * SCD]); if (t >= 3) a += w0 * bf2f(col[(t - 3) * SCD]);
      col[t * SCD] = f2bf(siluf_(a)); } } };
struct SsdScan { Bufs B; const float* alog;
  HD long items() const { return (long)NB * SH * SP; }
  HD void operator()(long it) const { const int p = (int)(it % SP); const int hh = (int)((it / SP) % SH); const long b = it / (SP * SH); const int g = hh / 8;
    const float a = -expf(alog[hh]); float st[128];
#pragma unroll
    for (int n = 0; n < 128; ++n) st[n] = 0.f;
    for (long t = 0; t < S; ++t) { const long tok = b * S + t; const float dt = B.DT[tok * SH + hh]; const float dec = expf(dt * a); const float xd = bf2f(B.XBC[tok * SCD + hh * 64 + p]) * dt;
      const u16* Bv = B.XBC + tok * SCD + SI + g * SN; const u16* Cv = B.XBC + tok * SCD + SI + SG * SN + g * SN; float y = 0.f;
#pragma unroll
      for (int n = 0; n < 128; ++n) { st[n] = st[n] * dec + xd * bf2f(Bv[n]); y += bf2f(Cv[n]) * st[n]; }
      B.YB[tok * SI + hh * 64 + p] = f2bf(y); } } };
struct SsdOut { Bufs B; const float* dskip; const float* ngain;
  HD long items() const { return (long)NTOK * SG; }
  HD void operator()(long it) const { const long tok = it / SG; const int g = (int)(it % SG); float s = 0.f;
    for (int c = g * 512; c < g * 512 + 512; ++c) { float y = bf2f(B.YB[tok * SI + c]) + bf2f(B.XBC[tok * SCD + c]) * dskip[c / 64]; y *= siluf_(bf2f(B.Z[tok * SI + c])); s += y * y; }
    const float rs = 1.0f / sqrtf(s / 512.f + EPS);
    for (int c = g * 512; c < g * 512 + 512; ++c) { float y = bf2f(B.YB[tok * SI + c]) + bf2f(B.XBC[tok * SCD + c]) * dskip[c / 64]; y *= siluf_(bf2f(B.Z[tok * SI + c])); B.YB[tok * SI + c] = f2bf(y * rs * ngain[c]); } } };

struct Router { const u16* h2; const float* wg; const float* bg; const float* we; const float* be; int* ei; float* ew;
  HD void operator()(long tok) const { const u16* x = h2 + tok * DM; float gl[4];
#pragma unroll
    for (int j = 0; j < 4; ++j) gl[j] = bg[j];
    for (long d = 0; d < DM; ++d) { const float xv = bf2f(x[d]);
#pragma unroll
      for (int j = 0; j < 4; ++j) gl[j] += xv * wg[d * 4 + j]; }
    int gi = 0; float gm = gl[0];
#pragma unroll
    for (int j = 1; j < 4; ++j) if (gl[j] > gm) { gm = gl[j]; gi = j; }
    float gs = 0.f;
#pragma unroll
    for (int j = 0; j < 4; ++j) gs += expf(gl[j] - gm);
    const float grp_w = 1.0f / gs;
    float el[8];
#pragma unroll
    for (int j = 0; j < 8; ++j) el[j] = be[gi * 8 + j];
    for (long d = 0; d < DM; ++d) { const float xv = bf2f(x[d]);
#pragma unroll
      for (int j = 0; j < 8; ++j) el[j] += xv * we[d * NEXP + gi * 8 + j]; }
    int i0 = 0; float m0 = el[0];
#pragma unroll
    for (int j = 1; j < 8; ++j) if (el[j] > m0) { m0 = el[j]; i0 = j; }
    int i1 = -1; float m1 = -3.0e38f;
#pragma unroll
    for (int j = 0; j < 8; ++j) if (j != i0 && el[j] > m1) { m1 = el[j]; i1 = j; }
    const float r = expf(m1 - m0); const float w0 = 1.0f / (1.0f + r), w1 = r / (1.0f + r);
    ei[tok * 2] = gi * 8 + i0; ei[tok * 2 + 1] = gi * 8 + i1; ew[tok * 2] = grp_w * w0; ew[tok * 2 + 1] = grp_w * w1; } };
struct MoeHidden { const u16* h2; const float* wgate; const float* wup; const int* ei; u16* act;
  HD long items() const { return (long)NTOK * 2 * MH; }
  HD void operator()(long it) const { const int j = (int)(it % MH); const long tk = it / MH; const long tok = tk / 2; const int e = ei[tk]; const u16* x = h2 + tok * DM;
    const float* wg_ = wgate + (long)e * DM * MH + j; const float* wu_ = wup + (long)e * DM * MH + j; float a = 0.f, b = 0.f;
    for (long d = 0; d < DM; ++d) { const float xv = bf2f(x[d]); a += xv * wg_[d * MH]; b += xv * wu_[d * MH]; }
    act[it] = f2bf(siluf_(a) * b); } };
struct MoeDown { const u16* act; const float* wdown; const int* ei; const float* ew; float* x;
  HD long items() const { return (long)NTOK * DM; }
  HD void operator()(long it) const { const int c = (int)(it % DM); const long tok = it / DM; float tot = 0.f;
    for (int k = 0; k < 2; ++k) { const int e = ei[tok * 2 + k]; const u16* a = act + (tok * 2 + k) * MH; const float* w = wdown + (long)e * MH * DM + c; float s = 0.f;
      for (int j = 0; j < MH; ++j) s += bf2f(a[j]) * w[(long)j * DM];
      tot += ew[tok * 2 + k] * s; }
    x[it] += tot; } };

#define NV2_STAGE_PREP(RUN, I, B, out)      { nv::RmsRowsBf f{I.x, I.mix_norm, B.HB, nv::DM}; RUN(f, (long)nv::NTOK); }
#define NV2_STAGE_INPROJ(RUN, I, B, out)    { nv::GemmT<nv::ABf, nv::EpInProj> f{nv::ABf{B.HB, nv::DM}, I.w_in, nv::EpInProj{B, I.dt_bias}, nv::NTOK, nv::INW, nv::DM, nv::INW}; RUN(f, f.items()); }
#define NV2_STAGE_QKNORM(RUN, I, B, out)    { nv::QkNorm f{B.QKV, I.q_gain, I.ks_gain, I.kw_gain}; RUN(f, f.items()); }
#define NV2_STAGE_COMPRESS(RUN, I, B, out)  { \
    { nv::GemmT<nv::ACmp, nv::EpSiluF32> f{nv::ACmp{B.QKV, I.pos_k, nv::O_KC}, I.w1_k, nv::EpSiluF32{B.HID, 128}, (long)nv::NB * nv::G * nv::NCMP, 128, 2048, 128}; RUN(f, f.items()); } \
    { nv::GemmT<nv::AF32, nv::EpF32> f{nv::AF32{B.HID, 128}, I.w2_k, nv::EpF32{B.KTMP, 64}, (long)nv::NB * nv::G * nv::NCMP, 64, 128, 64}; RUN(f, f.items()); } \
    { nv::CmpFinish f{B.KTMP, I.kc_gain, B.KCMP, 1}; RUN(f, f.items()); } \
    { nv::GemmT<nv::ACmp, nv::EpSiluF32> f{nv::ACmp{B.QKV, I.pos_v, nv::O_VC}, I.w1_v, nv::EpSiluF32{B.HID, 128}, (long)nv::NB * nv::G * nv::NCMP, 128, 2048, 128}; RUN(f, f.items()); } \
    { nv::GemmT<nv::AF32, nv::EpF32> f{nv::AF32{B.HID, 128}, I.w2_v, nv::EpF32{B.KTMP, 64}, (long)nv::NB * nv::G * nv::NCMP, 64, 128, 64}; RUN(f, f.items()); } \
    { nv::CmpFinish f{B.KTMP, I.kc_gain, B.VCMP, 0}; RUN(f, f.items()); } }
#define NV2_STAGE_ATTN(RUN, I, B, out)      { \
    { nv::CmpAttn f{B}; RUN(f, f.items()); } { nv::Importance f{B}; RUN(f, f.items()); } { nv::TopSel f{B}; RUN(f, f.items()); } { nv::SelAttn f{B}; RUN(f, f.items()); } { nv::WinAttn f{B}; RUN(f, f.items()); } }
#define NV2_STAGE_SSD(RUN, I, B, out)       { \
    { nv::SsdConv f{B.XBC, I.conv_w, I.conv_b}; RUN(f, f.items()); } { nv::SsdScan f{B, I.a_log}; RUN(f, f.items()); } { nv::SsdOut f{B, I.d_skip, I.ssm_norm}; RUN(f, f.items()); } }
#define NV2_STAGE_MERGE(RUN, I, B, out)     { \
    { nv::GemmT<nv::ABf, nv::EpBf> f{nv::ABf{B.YA, nv::QW}, I.w_a, nv::EpBf{B.T1, nv::DM}, nv::NTOK, nv::DM, nv::QW, nv::DM}; RUN(f, f.items()); } \
    { nv::GemmT<nv::ABf, nv::EpMerge> f{nv::ABf{B.YB, nv::SI}, I.w_b, nv::EpMerge{B.T1, B.BG, B.MERGED}, nv::NTOK, nv::DM, nv::SI, nv::DM}; RUN(f, f.items()); } \
    { nv::GemmT<nv::ABf, nv::EpResid> f{nv::ABf{B.MERGED, nv::DM}, I.w_out, nv::EpResid{I.x, out}, nv::NTOK, nv::DM, nv::DM, nv::DM}; RUN(f, f.items()); } }
#define NV2_STAGE_MOE(RUN, I, B, out)       { \
    { nv::RmsRowsBf f{out, I.moe_norm, B.H2, nv::DM}; RUN(f, (long)nv::NTOK); } \
    { nv::Router f{B.H2, I.w_group, I.b_group, I.w_expert, I.b_expert, B.EI, B.EW}; RUN(f, (long)nv::NTOK); } \
    { nv::MoeHidden f{B.H2, I.w_gate, I.w_up, B.EI, B.ACT}; RUN(f, f.items()); } \
    { nv::MoeDown f{B.ACT, I.w_down, B.EI, B.EW, out}; RUN(f, f.items()); } }
#define NV2_STAGE_PLE(RUN, I, B, out)       { \
    { nv::RmsRowsBf f{out, I.ple_norm, B.H2, nv::DM}; RUN(f, (long)nv::NTOK); } \
    { nv::GemmT<nv::AF32, nv::EpBf> f{nv::AF32{I.p, nv::PLE}, I.ple_wp, nv::EpBf{B.PP, nv::DM}, nv::NTOK, nv::DM, nv::PLE, nv::DM}; RUN(f, f.items()); } \
    { nv::GemmT<nv::ABf, nv::EpPle> f{nv::ABf{B.H2, nv::DM}, I.ple_wg, nv::EpPle{out, B.PP}, nv::NTOK, nv::DM, nv::DM, nv::DM}; RUN(f, f.items()); } }

HD size_t carve(Bufs& B, unsigned char* ws, float* out) {
  size_t off = 0; auto take = [&](size_t bytes) { unsigned char* r = ws + off; off += (bytes + 255) / 256 * 256; return r; };
  const size_t N = NTOK;
  B.BG = (u16*)out;
  unsigned char* R0 = take(N * DM * 2);
  unsigned char* R1 = take(N * QKVW * 2);
  unsigned char* R2 = take(N * SI * 2);
  unsigned char* R3 = take(N * SCD * 2);
  unsigned char* R5 = take(N * 2 * MH * 2 + (size_t)NEXP * 256 * MH * 2);
  B.HB = (u16*)R0; B.H2 = (u16*)R0; B.QKV = (u16*)R1; B.T1 = (u16*)R1; B.Z = (u16*)R2; B.XBC = (u16*)R3; B.MERGED = (u16*)R3; B.PP = (u16*)R3;
  B.YA = (u16*)take(N * QW * 2); B.ACT = (u16*)R5; B.YB = (u16*)take(N * SI * 2);
  B.NG = (float*)take(N * GW * 4); B.DT = (float*)take(N * SH * 4);
  B.KCMP = (u16*)take((size_t)NB * G * NCP * 64 * 2); B.VCMP = (u16*)take((size_t)NB * G * NCP * 64 * 2);
  B.EI = (int*)take(N * 2 * 4); B.EW = (float*)take(N * 2 * 4);
  B.HID = (float*)take((size_t)NB * G * NCMP * 128 * 4); B.KTMP = (float*)take((size_t)NB * G * NCMP * 64 * 4);
  B.ML = (float*)take(N * H * 2 * 4); B.IMP = (float*)take((size_t)NB * G * S * 64 * 4); B.MASK = (u64*)take((size_t)NB * G * S * 8);
  return off;
}
}
struct Params { nv::Inputs I; float* out; unsigned char* ws; };
template <class F> __device__ __forceinline__ void run_phase(const F& f, long n) {
  for (long i = blockIdx.x * 512L + threadIdx.x; i < n; i += (long)gridDim.x * 512L) f(i);
}
__global__ void __launch_bounds__(512) mega_fwd(Params P) {
  cg::grid_group grid = cg::this_grid();
  nv::Bufs B; nv::carve(B, P.ws, P.out);
  float* out = P.out;
#define RUN(f, n) { run_phase(f, n); grid.sync(); }
  NV2_STAGE_PREP(RUN, P.I, B, out)
  NV2_STAGE_INPROJ(RUN, P.I, B, out)
  NV2_STAGE_QKNORM(RUN, P.I, B, out)
  NV2_STAGE_COMPRESS(RUN, P.I, B, out)
  NV2_STAGE_ATTN(RUN, P.I, B, out)
  NV2_STAGE_SSD(RUN, P.I, B, out)
  NV2_STAGE_MERGE(RUN, P.I, B, out)
  NV2_STAGE_MOE(RUN, P.I, B, out)
  NV2_STAGE_PLE(RUN, P.I, B, out)
#undef RUN
}
extern "C" void kernel_launch(void* const* d_in, const int* in_sizes, int n_in, void* d_out, int out_size, void* d_ws, size_t ws_size, hipStream_t stream) {
  static int grid_blocks = 0;
  if (!grid_blocks) {
    int dev = 0, cus = 0, per_cu = 0;
    hipGetDevice(&dev);
    hipDeviceGetAttribute(&cus, hipDeviceAttributeMultiprocessorCount, dev);
    hipOccupancyMaxActiveBlocksPerMultiprocessor(&per_cu, mega_fwd, 512, 0);
    if (per_cu < 1) { fprintf(stderr, "kernel_launch: occupancy query says %d blocks per CU\n", per_cu); per_cu = 1; }
    grid_blocks = cus;
    { nv::Bufs B; size_t need = nv::carve(B, nullptr, nullptr); if (need > ws_size) fprintf(stderr, "kernel_launch: workspace too small: need %zu have %zu\n", need, ws_size); }
  }
  Params p; memset(&p, 0, sizeof(p));
  const float** ip = (const float**)&p.I; for (int i = 0; i < 34; ++i) ip[i] = (const float*)d_in[i];
  p.out = (float*)d_out; p.ws = (unsigned char*)d_ws;
  void* args[] = {&p};
  hipError_t e = hipLaunchCooperativeKernel((void*)mega_fwd, dim3(grid_blocks), dim3(512), args, 0, stream);
  if (e != hipSuccess) fprintf(stderr, "cooperative launch failed: %s (grid %d)\n", hipGetErrorString(e), grid_blocks);
}
```

```cpp
#include <hip/hip_runtime.h>
#include <hip/hip_cooperative_groups.h>
#include <cstdio>
#include <cstring>
namespace cg = cooperative_groups;
#define HD __host__ __device__ inline
#if defined(__HIP_DEVICE_COMPILE__)
#define NV_FENCE() asm volatile("" ::: "memory")
#else
#define NV_FENCE()
#endif
#ifndef CFG_DM
#define CFG_DM 1024
#endif
#ifndef CFG_BATCH
#define CFG_BATCH 8
#endif
#ifndef CFG_SEQ
#define CFG_SEQ 4096
#endif
#ifndef CFG_MH
#define CFG_MH 256
#endif
#ifndef CFG_PLE
#define CFG_PLE 256
#endif

#ifndef NV_FENCE
#define NV_FENCE()
#endif
namespace nv {
typedef unsigned short u16;
typedef unsigned long long u64;
constexpr int DM = CFG_DM, NB = CFG_BATCH, S = CFG_SEQ, MH = CFG_MH, PLE = CFG_PLE;
constexpr int NTOK = NB * S;
constexpr int H = 8, G = 2, E = 4;
constexpr int QW = 512, GW = 24, QKVW = 1280;
constexpr int SH = 16, SP = 64, SI = 1024, SG = 2, SN = 128, SCD = 1536;
constexpr int INW = QW + 6 * 128 + GW + SI + SCD + SH + 2 * DM;
constexpr int O_Q = 0, O_KC = 512, O_VC = 640, O_KS = 768, O_VS = 896, O_KW = 1024, O_VW = 1152, O_NG = 1280, O_Z = 1304, O_XBC = 2328, O_DT = 3864, O_BG = 3880;
static_assert(O_BG + 2 * DM == INW, "in-proj width");
constexpr int NCMP = S / 16 - 1, NCP = S / 16, NSEL = S / 64, NTOP = NSEL < 16 ? NSEL : 16;
constexpr int NEXP = 32;
constexpr float EPS = 1e-6f;

HD float sigmoidf_(float x) { return 1.0f / (1.0f + expf(-x)); }
HD float siluf_(float x) { return x / (1.0f + expf(-x)); }
HD float softplusf_(float x) { return x > 20.f ? x : log1pf(expf(x)); }
HD u16 f2bf(float f) { unsigned u = __builtin_bit_cast(unsigned, f); u += 0x7fffu + ((u >> 16) & 1u); return (u16)(u >> 16); }
HD float bf2f(u16 h) { return __builtin_bit_cast(float, (unsigned)h << 16); }

struct Bufs {
  u16* HB;
  u16* QKV;
  float* NG;
  u16* Z;
  u16* XBC;
  float* DT;
  u16* BG;
  u16* KCMP;
  u16* VCMP;
  u16* YA;
  u16* YB;
  u16* T1;
  u16* MERGED;
  u16* H2;
  u16* ACT;
  u16* PP;
  int* EI;
  float* EW;
  float* HID;
  float* KTMP;
  float* ML;
  float* IMP;
  u64* MASK;
};
struct Inputs { const float *x, *p, *mix_norm, *w_in, *q_gain, *kc_gain, *ks_gain, *kw_gain, *pos_k, *w1_k, *w2_k, *pos_v, *w1_v, *w2_v, *conv_w, *conv_b, *dt_bias, *a_log, *d_skip, *ssm_norm,
  *w_a, *w_b, *w_out, *moe_norm, *w_group, *b_group, *w_expert, *b_expert, *w_gate, *w_up, *w_down, *ple_norm, *ple_wg, *ple_wp; };

struct RmsRowsBf { const float* in; const float* gain; u16* out; long ncols;
  HD void operator()(long r) const { const float* x = in + r * ncols; float s = 0.f; for (long c = 0; c < ncols; ++c) s += x[c] * x[c];
    const float rs = 1.0f / sqrtf(s / (float)ncols + EPS); u16* o = out + r * ncols; for (long c = 0; c < ncols; ++c) o[c] = f2bf(x[c] * rs * gain[c]); } };

template <class AL, class EP> struct GemmT { AL a; const float* B; EP ep; long M, N, K, ldb;
  HD long items() const { return ((M + 7) / 8) * ((N + 3) / 4); }
  HD void operator()(long it) const { const long nt = (N + 3) / 4; const long tm = it / nt, tn = it % nt; const long r0 = tm * 8, c0 = tn * 4;
    float acc[8][4];
#pragma unroll
    for (int i = 0; i < 8; ++i)
#pragma unroll
      for (int j = 0; j < 4; ++j) acc[i][j] = 0.f;
    for (long k = 0; k < K; ++k) { float b[4];
#pragma unroll
      for (int j = 0; j < 4; ++j) b[j] = (c0 + j < N) ? B[k * ldb + c0 + j] : 0.f;
#pragma unroll
      for (int i = 0; i < 8; ++i) { const long r = r0 + i < M ? r0 + i : M - 1; const float av = a(r, k);
#pragma unroll
        for (int j = 0; j < 4; ++j) acc[i][j] += av * b[j]; } }
#pragma unroll
    for (int i = 0; i < 8; ++i) if (r0 + i < M) {
#pragma unroll
      for (int j = 0; j < 4; ++j) if (c0 + j < N) ep(r0 + i, c0 + j, acc[i][j]); } } };
struct ABf { const u16* p; long ld; HD float operator()(long r, long k) const { return bf2f(p[r * ld + k]); } };
struct AF32 { const float* p; long ld; HD float operator()(long r, long k) const { return p[r * ld + k]; } };
struct ACmp { const u16* qkv; const float* pos; long off;
  HD float operator()(long r, long k) const { const long c = r % NCMP, bg = r / NCMP, b = bg / G, g = bg % G; const long l = k / 64, d = k % 64;
    return bf2f(qkv[(b * S + 16 * c + l) * QKVW + off + g * 64 + d]) + pos[k]; } };

struct EpInProj { Bufs B; const float* dt_bias;
  HD void operator()(long r, long c, float v) const {
    if (c < O_NG) B.QKV[r * QKVW + c] = f2bf(v);
    else if (c < O_Z) B.NG[r * GW + (c - O_NG)] = sigmoidf_(v);
    else if (c < O_XBC) B.Z[r * SI + (c - O_Z)] = f2bf(v);
    else if (c < O_DT) B.XBC[r * SCD + (c - O_XBC)] = f2bf(v);
    else if (c < O_BG) B.DT[r * SH + (c - O_DT)] = softplusf_(v + dt_bias[c - O_DT]);
    else B.BG[r * (2 * DM) + (c - O_BG)] = f2bf(sigmoidf_(v)); } };
struct EpSiluF32 { float* o; long ld; HD void operator()(long r, long c, float v) const { o[r * ld + c] = siluf_(v); } };
struct EpF32 { float* o; long ld; HD void operator()(long r, long c, float v) const { o[r * ld + c] = v; } };
struct EpBf { u16* o; long ld; HD void operator()(long r, long c, float v) const { o[r * ld + c] = f2bf(v); } };
struct EpMerge { const u16* t1; const u16* bg; u16* o; HD void operator()(long r, long c, float v) const { const float ga = bf2f(bg[r * (2 * DM) + c]), gb = bf2f(bg[r * (2 * DM) + DM + c]); o[r * DM + c] = f2bf(ga * bf2f(t1[r * DM + c]) + gb * v); } };
struct EpResid { const float* x; float* o; HD void operator()(long r, long c, float v) const { o[r * DM + c] = x[r * DM + c] + v; } };
struct EpPle { float* x; const u16* pp; HD void operator()(long r, long c, float v) const { x[r * DM + c] = x[r * DM + c] + sigmoidf_(v) * bf2f(pp[r * DM + c]); } };

struct QkNorm { u16* qkv; const float* qg; const float* ksg; const float* kwg;
  HD long items() const { return (long)NTOK * 12; }
  HD void operator()(long it) const { const long tok = it / 12; const int w = (int)(it % 12); u16* v; const float* gain;
    if (w < 8) { v = qkv + tok * QKVW + O_Q + w * 64; gain = qg; } else if (w < 10) { v = qkv + tok * QKVW + O_KS + (w - 8) * 64; gain = ksg; } else { v = qkv + tok * QKVW + O_KW + (w - 10) * 64; gain = kwg; }
    float s = 0.f; for (int d = 0; d < 64; ++d) { const float x = bf2f(v[d]); s += x * x; } const float rs = 1.0f / sqrtf(s / 64.f + EPS);
    for (int d = 0; d < 64; ++d) v[d] = f2bf(bf2f(v[d]) * rs * gain[d]); } };
struct CmpFinish { const float* src; const float* gain; u16* dst; long donorm;
  HD long items() const { return (long)NB * G * NCP; }
  HD void operator()(long it) const { const long c = it % NCP, bg = it / NCP; u16* o = dst + it * 64;
    if (c >= NCMP) { for (int d = 0; d < 64; ++d) o[d] = 0; return; }
    const float* x = src + (bg * NCMP + c) * 64; float rs = 1.f;
    if (donorm) { float s = 0.f; for (int d = 0; d < 64; ++d) s += x[d] * x[d]; rs = 1.0f / sqrtf(s / 64.f + EPS); }
    for (int d = 0; d < 64; ++d) o[d] = f2bf(donorm ? x[d] * rs * gain[d] : x[d]); } };

struct CmpAttn { Bufs B;
  HD long items() const { return (long)NB * H * S; }
  HD void operator()(long it) const { const long t = it % S; const int h = (int)((it / S) % H), g = h / E; const long b = it / ((long)S * H); const long tok = b * S + t;
    const u16* q = B.QKV + tok * QKVW + O_Q + h * 64; const u16* kc = B.KCMP + (b * G + g) * (long)NCP * 64; const u16* vc = B.VCMP + (b * G + g) * (long)NCP * 64;
    float qr[64];
#pragma unroll
    for (int d = 0; d < 64; ++d) qr[d] = bf2f(q[d]);
    long nvis = (t - 31 >= 0) ? (t - 31) / 16 + 1 : 0; if (nvis > NCMP) nvis = NCMP;
    float m = -3.0e38f;
    for (long c = 0; c < nvis; ++c) { const u16* k = kc + c * 64; float s = 0.f;
#pragma unroll
      for (int d = 0; d < 64; ++d) s += qr[d] * bf2f(k[d]);
      s *= 0.125f; m = s > m ? s : m; }
    float o[64];
#pragma unroll
    for (int d = 0; d < 64; ++d) o[d] = 0.f;
    float l = 0.f;
    for (long c = 0; c < nvis; ++c) { const u16* k = kc + c * 64; const u16* v = vc + c * 64; float s = 0.f;
#pragma unroll
      for (int d = 0; d < 64; ++d) s += qr[d] * bf2f(k[d]);
      const float p = expf(s * 0.125f - m); l += p;
#pragma unroll
      for (int d = 0; d < 64; ++d) o[d] += p * bf2f(v[d]); }
    const float g0 = B.NG[tok * GW + h * 3 + 0]; const float inv = nvis > 0 ? g0 / l : 0.f;
#pragma unroll
    for (int d = 0; d < 64; ++d) B.YA[tok * QW + h * 64 + d] = f2bf(o[d] * inv);
    B.ML[it * 2] = m; B.ML[it * 2 + 1] = nvis > 0 ? l : 0.f; } };
struct Importance { Bufs B;
  HD long items() const { return (long)NB * G * S * NSEL; }
  HD void operator()(long it) const { const int j = (int)(it % NSEL); const long bgt = it / NSEL; const long t = bgt % S; const long bg = bgt / S; const long b = bg / G; const int g = (int)(bg % G); const long tok = b * S + t;
    long nvis = (t - 31 >= 0) ? (t - 31) / 16 + 1 : 0; if (nvis > NCMP) nvis = NCMP;
    long c0 = 4 * j - 1; if (c0 < 0) c0 = 0; long c1 = 4 * j + 3; if (c1 > nvis - 1) c1 = nvis - 1;
    const u16* kc = B.KCMP + bg * (long)NCP * 64; float acc = 0.f;
    for (int e = 0; e < E; ++e) { const int h = g * E + e; const u16* q = B.QKV + tok * QKVW + O_Q + h * 64; const long mi = ((b * H + h) * (long)S + t) * 2; const float m = B.ML[mi], l = B.ML[mi + 1];
      if (l > 0.f) for (long c = c0; c <= c1; ++c) { const u16* k = kc + c * 64; float s = 0.f; for (int d = 0; d < 64; ++d) s += bf2f(q[d]) * bf2f(k[d]); acc += expf(s * 0.125f - m) / l; } }
    B.IMP[bgt * 64 + j] = acc; } };
struct TopSel { Bufs B;
  HD long items() const { return (long)NB * G * S; }
  HD void operator()(long bgt) const { const long t = bgt % S; const int cur = (int)(t / 64); u64 m = 0ull;
    for (int r = 0; r < NTOP; ++r) { float best = -3.0e38f; int bj = -1;
      for (int j = 0; j <= cur && j < NSEL; ++j) { if ((m >> j) & 1ull) continue; float v = B.IMP[bgt * 64 + j]; if (j == 0 || j == cur || j == cur - 1) v += 1000.f; if (v > best) { best = v; bj = j; } }
      if (bj < 0) break; m |= 1ull << bj; }
    B.MASK[bgt] = m; } };
struct SelAttn { Bufs B;
  HD long items() const { return (long)NB * H * S; }
  HD void operator()(long it) const { const long t = it % S; const int h = (int)((it / S) % H), g = h / E; const long b = it / ((long)S * H); const long tok = b * S + t;
    const u16* q = B.QKV + tok * QKVW + O_Q + h * 64; const u64 mk = B.MASK[(b * G + g) * (long)S + t];
    float qr[64], o[64];
#pragma unroll
    for (int d = 0; d < 64; ++d) { qr[d] = bf2f(q[d]); o[d] = 0.f; }
    float m = -3.0e38f, l = 0.f;
    for (int j = 0; j < NSEL; ++j) { if (!((mk >> j) & 1ull)) continue;
      for (long kp = 64L * j; kp < 64L * j + 64 && kp <= t; ++kp) { const u16* k = B.QKV + (b * S + kp) * QKVW + O_KS + g * 64; const u16* v = B.QKV + (b * S + kp) * QKVW + O_VS + g * 64; float s = 0.f;
#pragma unroll
        for (int d = 0; d < 64; ++d) s += qr[d] * bf2f(k[d]);
        s *= 0.125f;
        if (s > m) { const float f = expf(m - s); l *= f;
#pragma unroll
          for (int d = 0; d < 64; ++d) o[d] *= f;
          m = s; }
        const float p = expf(s - m); l += p;
#pragma unroll
        for (int d = 0; d < 64; ++d) o[d] += p * bf2f(v[d]); } }
    const float g1 = B.NG[tok * GW + h * 3 + 1]; const float inv = g1 / l;
#pragma unroll
    for (int d = 0; d < 64; ++d) { u16* y = B.YA + tok * QW + h * 64 + d; *y = f2bf(bf2f(*y) + o[d] * inv); } } };
struct WinAttn { Bufs B;
  HD long items() const { return (long)NB * H * S; }
  HD void operator()(long it) const { const long t = it % S; const int h = (int)((it / S) % H), g = h / E; const long b = it / ((long)S * H); const long tok = b * S + t;
    const u16* q = B.QKV + tok * QKVW + O_Q + h * 64;
    float qr[64], o[64];
#pragma unroll
    for (int d = 0; d < 64; ++d) { qr[d] = bf2f(q[d]); o[d] = 0.f; }
    float m = -3.0e38f, l = 0.f; long k0 = t - 511; if (k0 < 0) k0 = 0;
    for (long kp = k0; kp <= t; ++kp) { const u16* k = B.QKV + (b * S + kp) * QKVW + O_KW + g * 64; const u16* v = B.QKV + (b * S + kp) * QKVW + O_VW + g * 64; float s = 0.f;
#pragma unroll
      for (int d = 0; d < 64; ++d) s += qr[d] * bf2f(k[d]);
      s *= 0.125f;
      if (s > m) { const float f = expf(m - s); l *= f;
#pragma unroll
        for (int d = 0; d < 64; ++d) o[d] *= f;
        m = s; }
      const float p = expf(s - m); l += p;
#pragma unroll
      for (int d = 0; d < 64; ++d) o[d] += p * bf2f(v[d]); }
    const float g2 = B.NG[tok * GW + h * 3 + 2]; const float inv = g2 / l;
#pragma unroll
    for (int d = 0; d < 64; ++d) { u16* y = B.YA + tok * QW + h * 64 + d; *y = f2bf(bf2f(*y) + o[d] * inv); } } };

struct SsdConv { u16* xbc; const float* cw; const float* cb;
  HD long items() const { return (long)NB * SCD; }
  HD void operator()(long it) const { const int c = (int)(it % SCD); const long b = it / SCD; u16* col = xbc + b * S * SCD + c; const float w0 = cw[c], w1 = cw[SCD + c], w2 = cw[2 * SCD + c], w3 = cw[3 * SCD + c], bias = cb[c];
    for (long t = S - 1; t >= 0; --t) { float a = bias + w3 * bf2f(col[t * SCD]); if (t >= 1) a += w2 * bf2f(col[(t - 1) * SCD]); if (t >= 2) a += w1 * bf2f(col[(t - 2) * SCD]); if (t >= 3) a += w0 * bf2f(col[(t - 3) * SCD]);
      col[t * SCD] = f2bf(siluf_(a)); } } };
struct SsdScan { Bufs B; const float* alog; const float* dskip;
  HD long items() const { return (long)NB * SH * SP; }
  HD void operator()(long it) const { const int p = (int)(it % SP); const int hh = (int)((it / SP) % SH); const long b = it / (SP * SH); const int g = hh / 8;
    const float a = -expf(alog[hh]); float st[128];
#pragma unroll
    for (int n = 0; n < 128; ++n) st[n] = 0.f;
    for (long t = 0; t < S; ++t) { const long tok = b * S + t; const float dt = B.DT[tok * SH + hh]; const float dec = expf(dt * a); const float xd = bf2f(B.XBC[tok * SCD + hh * 64 + p]) * dt;
      const u16* Bv = B.XBC + tok * SCD + SI + g * SN; const u16* Cv = B.XBC + tok * SCD + SI + SG * SN + g * SN; float y = 0.f;
#pragma unroll
      for (int n = 0; n < 128; ++n) { st[n] = st[n] * dec + xd * bf2f(Bv[n]); y += bf2f(Cv[n]) * st[n]; if ((n & 15) == 15) { NV_FENCE(); } }
      B.XBC[tok * SCD + hh * 64 + p] = f2bf(y + bf2f(B.XBC[tok * SCD + hh * 64 + p]) * dskip[hh]); } } };
struct SsdOut { Bufs B; const float* ngain;
  HD long items() const { return (long)NTOK * SG; }
  HD void operator()(long it) const { const long tok = it / SG; const int g = (int)(it % SG); float s = 0.f;
    for (int c = g * 512; c < g * 512 + 512; ++c) { float y = bf2f(B.XBC[tok * SCD + c]); y *= siluf_(bf2f(B.Z[tok * SI + c])); s += y * y; }
    const float rs = 1.0f / sqrtf(s / 512.f + EPS);
    for (int c = g * 512; c < g * 512 + 512; ++c) { float y = bf2f(B.XBC[tok * SCD + c]); y *= siluf_(bf2f(B.Z[tok * SI + c])); B.YB[tok * SI + c] = f2bf(y * rs * ngain[c]); } } };

struct Router { const u16* h2; const float* wg; const float* bg; const float* we; const float* be; int* ei; float* ew;
  HD void operator()(long tok) const { const u16* x = h2 + tok * DM; float gl[4];
#pragma unroll
    for (int j = 0; j < 4; ++j) gl[j] = bg[j];
    for (long d = 0; d < DM; ++d) { const float xv = bf2f(x[d]);
#pragma unroll
      for (int j = 0; j < 4; ++j) gl[j] += xv * wg[d * 4 + j]; }
    int gi = 0; float gm = gl[0];
#pragma unroll
    for (int j = 1; j < 4; ++j) if (gl[j] > gm) { gm = gl[j]; gi = j; }
    float gs = 0.f;
#pragma unroll
    for (int j = 0; j < 4; ++j) gs += expf(gl[j] - gm);
    const float grp_w = 1.0f / gs;
    float el[8];
#pragma unroll
    for (int j = 0; j < 8; ++j) el[j] = be[gi * 8 + j];
    for (long d = 0; d < DM; ++d) { const float xv = bf2f(x[d]);
#pragma unroll
      for (int j = 0; j < 8; ++j) el[j] += xv * we[d * NEXP + gi * 8 + j]; }
    int i0 = 0; float m0 = el[0];
#pragma unroll
    for (int j = 1; j < 8; ++j) if (el[j] > m0) { m0 = el[j]; i0 = j; }
    int i1 = -1; float m1 = -3.0e38f;
#pragma unroll
    for (int j = 0; j < 8; ++j) if (j != i0 && el[j] > m1) { m1 = el[j]; i1 = j; }
    const float r = expf(m1 - m0); const float w0 = 1.0f / (1.0f + r), w1 = r / (1.0f + r);
    ei[tok * 2] = gi * 8 + i0; ei[tok * 2 + 1] = gi * 8 + i1; ew[tok * 2] = grp_w * w0; ew[tok * 2 + 1] = grp_w * w1; } };
struct MoeHidden { const u16* h2; const float* wgate; const float* wup; const int* ei; u16* act;
  HD long items() const { return (long)NTOK * 2 * MH; }
  HD void operator()(long it) const { const int j = (int)(it % MH); const long tk = it / MH; const long tok = tk / 2; const int e = ei[tk]; const u16* x = h2 + tok * DM;
    const float* wg_ = wgate + (long)e * DM * MH + j; const float* wu_ = wup + (long)e * DM * MH + j; float a = 0.f, b = 0.f;
    for (long d = 0; d < DM; ++d) { const float xv = bf2f(x[d]); a += xv * wg_[d * MH]; b += xv * wu_[d * MH]; }
    act[it] = f2bf(siluf_(a) * b); } };
struct MoeDown { const u16* act; const float* wdown; const int* ei; const float* ew; float* x;
  HD long items() const { return (long)NTOK * DM; }
  HD void operator()(long it) const { const int c = (int)(it % DM); const long tok = it / DM; float tot = 0.f;
    for (int k = 0; k < 2; ++k) { const int e = ei[tok * 2 + k]; const u16* a = act + (tok * 2 + k) * MH; const float* w = wdown + (long)e * MH * DM + c; float s = 0.f;
      for (int j = 0; j < MH; ++j) s += bf2f(a[j]) * w[(long)j * DM];
      tot += ew[tok * 2 + k] * s; }
    x[it] += tot; } };

#define NV2_STAGE_PREP(RUN, I, B, out)      { nv::RmsRowsBf f{I.x, I.mix_norm, B.HB, nv::DM}; RUN(f, (long)nv::NTOK); }
#define NV2_STAGE_INPROJ(RUN, I, B, out)    { nv::GemmT<nv::ABf, nv::EpInProj> f{nv::ABf{B.HB, nv::DM}, I.w_in, nv::EpInProj{B, I.dt_bias}, nv::NTOK, nv::INW, nv::DM, nv::INW}; RUN(f, f.items()); }
#define NV2_STAGE_QKNORM(RUN, I, B, out)    { nv::QkNorm f{B.QKV, I.q_gain, I.ks_gain, I.kw_gain}; RUN(f, f.items()); }
#define NV2_STAGE_COMPRESS(RUN, I, B, out)  { \
    { nv::GemmT<nv::ACmp, nv::EpSiluF32> f{nv::ACmp{B.QKV, I.pos_k, nv::O_KC}, I.w1_k, nv::EpSiluF32{B.HID, 128}, (long)nv::NB * nv::G * nv::NCMP, 128, 2048, 128}; RUN(f, f.items()); } \
    { nv::GemmT<nv::AF32, nv::EpF32> f{nv::AF32{B.HID, 128}, I.w2_k, nv::EpF32{B.KTMP, 64}, (long)nv::NB * nv::G * nv::NCMP, 64, 128, 64}; RUN(f, f.items()); } \
    { nv::CmpFinish f{B.KTMP, I.kc_gain, B.KCMP, 1}; RUN(f, f.items()); } \
    { nv::GemmT<nv::ACmp, nv::EpSiluF32> f{nv::ACmp{B.QKV, I.pos_v, nv::O_VC}, I.w1_v, nv::EpSiluF32{B.HID, 128}, (long)nv::NB * nv::G * nv::NCMP, 128, 2048, 128}; RUN(f, f.items()); } \
    { nv::GemmT<nv::AF32, nv::EpF32> f{nv::AF32{B.HID, 128}, I.w2_v, nv::EpF32{B.KTMP, 64}, (long)nv::NB * nv::G * nv::NCMP, 64, 128, 64}; RUN(f, f.items()); } \
    { nv::CmpFinish f{B.KTMP, I.kc_gain, B.VCMP, 0}; RUN(f, f.items()); } }
#define NV2_STAGE_ATTN(RUN, I, B, out)      { \
    { nv::CmpAttn f{B}; RUN(f, f.items()); } { nv::Importance f{B}; RUN(f, f.items()); } { nv::TopSel f{B}; RUN(f, f.items()); } { nv::SelAttn f{B}; RUN(f, f.items()); } { nv::WinAttn f{B}; RUN(f, f.items()); } }
#define NV2_STAGE_SSD(RUN, I, B, out)       { \
    { nv::SsdConv f{B.XBC, I.conv_w, I.conv_b}; RUN(f, f.items()); } { nv::SsdScan f{B, I.a_log, I.d_skip}; RUN(f, f.items()); } { nv::SsdOut f{B, I.ssm_norm}; RUN(f, f.items()); } }
#define NV2_STAGE_MERGE(RUN, I, B, out)     { \
    { nv::GemmT<nv::ABf, nv::EpBf> f{nv::ABf{B.YA, nv::QW}, I.w_a, nv::EpBf{B.T1, nv::DM}, nv::NTOK, nv::DM, nv::QW, nv::DM}; RUN(f, f.items()); } \
    { nv::GemmT<nv::ABf, nv::EpMerge> f{nv::ABf{B.YB, nv::SI}, I.w_b, nv::EpMerge{B.T1, B.BG, B.MERGED}, nv::NTOK, nv::DM, nv::SI, nv::DM}; RUN(f, f.items()); } \
    { nv::GemmT<nv::ABf, nv::EpResid> f{nv::ABf{B.MERGED, nv::DM}, I.w_out, nv::EpResid{I.x, out}, nv::NTOK, nv::DM, nv::DM, nv::DM}; RUN(f, f.items()); } }
#define NV2_STAGE_MOE(RUN, I, B, out)       { \
    { nv::RmsRowsBf f{out, I.moe_norm, B.H2, nv::DM}; RUN(f, (long)nv::NTOK); } \
    { nv::Router f{B.H2, I.w_group, I.b_group, I.w_expert, I.b_expert, B.EI, B.EW}; RUN(f, (long)nv::NTOK); } \
    { nv::MoeHidden f{B.H2, I.w_gate, I.w_up, B.EI, B.ACT}; RUN(f, f.items()); } \
    { nv::MoeDown f{B.ACT, I.w_down, B.EI, B.EW, out}; RUN(f, f.items()); } }
#define NV2_STAGE_PLE(RUN, I, B, out)       { \
    { nv::RmsRowsBf f{out, I.ple_norm, B.H2, nv::DM}; RUN(f, (long)nv::NTOK); } \
    { nv::GemmT<nv::AF32, nv::EpBf> f{nv::AF32{I.p, nv::PLE}, I.ple_wp, nv::EpBf{B.PP, nv::DM}, nv::NTOK, nv::DM, nv::PLE, nv::DM}; RUN(f, f.items()); } \
    { nv::GemmT<nv::ABf, nv::EpPle> f{nv::ABf{B.H2, nv::DM}, I.ple_wg, nv::EpPle{out, B.PP}, nv::NTOK, nv::DM, nv::DM, nv::DM}; RUN(f, f.items()); } }

HD size_t carve(Bufs& B, unsigned char* ws, float* out) {
  size_t off = 0; auto take = [&](size_t bytes) { unsigned char* r = ws + off; off += (bytes + 255) / 256 * 256; return r; };
  const size_t N = NTOK;
  B.BG = (u16*)out;
  unsigned char* R0 = take(N * DM * 2);
  unsigned char* R1 = take(N * QKVW * 2);
  unsigned char* R2 = take(N * SI * 2);
  unsigned char* R3 = take(N * SCD * 2);
  unsigned char* R5 = take(N * 2 * MH * 2 + (size_t)NEXP * 256 * MH * 2);
  B.HB = (u16*)R0; B.H2 = (u16*)R0; B.QKV = (u16*)R1; B.T1 = (u16*)R1; B.Z = (u16*)R2; B.XBC = (u16*)R3; B.MERGED = (u16*)R3; B.PP = (u16*)R3;
  B.YA = (u16*)take(N * QW * 2); B.ACT = (u16*)R5; B.YB = B.Z;
  B.NG = (float*)take(N * GW * 4); B.DT = (float*)take(N * SH * 4);
  B.KCMP = (u16*)take((size_t)NB * G * NCP * 64 * 2); B.VCMP = (u16*)take((size_t)NB * G * NCP * 64 * 2);
  B.EI = (int*)take(N * 2 * 4); B.EW = (float*)take(N * 2 * 4);
  B.HID = (float*)take((size_t)NB * G * NCMP * 128 * 4); B.KTMP = (float*)take((size_t)NB * G * NCMP * 64 * 4);
  B.ML = (float*)take(N * H * 2 * 4); B.IMP = (float*)take((size_t)NB * G * S * 64 * 4); B.MASK = (u64*)take((size_t)NB * G * S * 8);
  return off;
}
}
namespace pg8 {
#define PG8_LAS __attribute__((address_space(3)))
typedef unsigned short bf16_t;
typedef short bf16x8 __attribute__((ext_vector_type(8)));
typedef float f32x4 __attribute__((ext_vector_type(4)));
typedef unsigned u32x4 __attribute__((ext_vector_type(4)));
typedef unsigned u32x2 __attribute__((ext_vector_type(2)));
constexpr int BM = 256, BK = 64, HALF = 128, HTB = HALF * BK * 2  , STAGE_BYTES = 8 * HTB, NXCD = 8, WGM = 8;

__host__ __device__ __forceinline__ int lds_byte(int r, int c) { const int st = (r >> 4) * 2 + (c >> 5), rr = r & 15, cc = c & 31, ob = rr * 64 + cc * 2; return st * 1024 + (ob ^ (((ob >> 9) & 1) << 5)); }
__host__ __device__ __forceinline__ void stage_rc(int b, int& R, int& C) { const int st = b / 1024, sb = b % 1024, swz = sb ^ (((sb >> 9) & 1) << 5); R = (st >> 1) * 16 + swz / 64; C = (st & 1) * 32 + (swz % 64) / 2; }
__host__ __device__ __forceinline__ int perm32(int rho) { const int n = rho >> 4, i = rho & 15; return 8 * (i >> 2) + 4 * n + (i & 3); }

struct Unit { int pm, pn, aux0, aux1; };
struct Gemm { const bf16_t* A; const bf16_t* Bt; int M, N, K, lda, ldb; };

struct StaticOrder {
    int nM, nN, nwg, G, c;
    __device__ void init(int M, int N, int G_, int c_) { nM = M / BM; nN = N / BM; nwg = nM * nN; G = G_; c = c_; }
    __device__ bool next(int i, Unit& u) const {
        const long L = (long)i * G + c; if (L >= nwg) return false;
        int wgid = (int)L; { const int q = nwg / NXCD, r = nwg % NXCD, xcd = wgid % NXCD, off = wgid / NXCD; wgid = (xcd < r ? xcd * (q + 1) : r * (q + 1) + (xcd - r) * q) + off; }
        const int nig = WGM * nN, gid = wgid / nig, fm = gid * WGM, gsz = (nM - fm) < WGM ? (nM - fm) : WGM;
        u.pm = fm + ((wgid % nig) % gsz); u.pn = (wgid % nig) / gsz; u.aux0 = 0; u.aux1 = 0; return true;
    }
    __device__ __forceinline__ const char* a_base(const Gemm& g, const Unit& u) const { return (const char*)g.A + (size_t)u.pm * BM * g.lda * 2; }
    __device__ __forceinline__ const char* b_base(const Gemm& g, const Unit& u) const { return (const char*)g.Bt + (size_t)u.pn * BM * g.ldb * 2; }
    __device__ __forceinline__ int a_row(const Unit&, int) const { return 0; }
};

typedef float f32x2_t __attribute__((ext_vector_type(2))); typedef __bf16 bf16x2_t __attribute__((ext_vector_type(2)));
__device__ __forceinline__ unsigned cvt_pk_bf16(float lo, float hi) { f32x2_t v = {lo, hi}; bf16x2_t b = __builtin_convertvector(v, bf16x2_t); return __builtin_bit_cast(unsigned, b); }


template <class Epi, class Sched, bool ALIGN_EPI = true, bool GATHER = false>
__device__ __forceinline__ void gemm_phase(PG8_LAS unsigned char* lds, const Gemm g, const Sched& S, const Epi& E) {
    int tid_ = threadIdx.x; asm volatile("" : "+v"(tid_));
    const int tid = tid_, wid = __builtin_amdgcn_readfirstlane(tid >> 6), lane = tid & 63, wr = wid >> 2, wc = wid & 3, fr = lane & 15, fq = lane >> 4;
    const int K = g.K, nt = K / BK;
    unsigned voffA[2], voffA1[2], voffB[2];
    int RA[2], CA[2];
#pragma unroll
    for (int i = 0; i < 2; ++i) { int R, C; stage_rc(tid * 16 + i * 8192, R, C); const int Rb = Epi::PERM ? ((R & ~31) + perm32(R & 31)) : R;
        RA[i] = R; CA[i] = C; voffA[i] = (unsigned)(R * g.lda + C) * 2u; voffA1[i] = voffA[i]; voffB[i] = (unsigned)(Rb * g.ldb + C) * 2u; }
    const size_t kstep = (size_t)(BK * 2);
    const size_t hstepA = GATHER ? (size_t)0 : (size_t)HALF * g.lda * 2;
    const size_t hstepB = (size_t)HALF * g.ldb * 2;
    const unsigned ldsw = (unsigned)wid * 1024u;
    const int aoff = lds_byte(wr * 64 + fr, fq * 8), boff = lds_byte(wc * 32 + fr, fq * 8);
#define PG8_SA(b, h) (((b) * 2 + (h)) * HTB)
#define PG8_SB(b, h) ((4 + (b) * 2 + (h)) * HTB)
#define PG8_STAGE(bufoff, gbase, voff) do { _Pragma("unroll") for (int _i = 0; _i < 2; ++_i) \
        __builtin_amdgcn_global_load_lds((const unsigned*)((const char*)(gbase) + (voff)[_i]), (PG8_LAS unsigned*)(lds + (bufoff) + ldsw + _i * 8192), 16, 0, 0); } while (0)
#define PG8_STAGE_A0(bufoff, gbase) PG8_STAGE(bufoff, gbase, voffA)
#define PG8_STAGE_A1(bufoff, gbase) do { if constexpr (GATHER) { PG8_STAGE(bufoff, gbase, voffA1); } else { PG8_STAGE(bufoff, (gbase) + hstepA, voffA); } } while (0)
#define PG8_LDA(dst, b, h) do { _Pragma("unroll") for (int m = 0; m < 4; ++m) _Pragma("unroll") for (int k = 0; k < 2; ++k) dst[m][k] = *(const PG8_LAS bf16x8*)(lds + PG8_SA(b, h) + aoff + m * 2048 + k * 1024); } while (0)
#define PG8_LDB(dst, b, h) do { _Pragma("unroll") for (int n = 0; n < 2; ++n) _Pragma("unroll") for (int k = 0; k < 2; ++k) dst[n][k] = *(const PG8_LAS bf16x8*)(lds + PG8_SB(b, h) + boff + n * 2048 + k * 1024); } while (0)
#define PG8_MMA(ai, bj, At, Bt) do { __builtin_amdgcn_s_setprio(1); _Pragma("unroll") for (int m = 0; m < 4; ++m) _Pragma("unroll") for (int n = 0; n < 2; ++n) _Pragma("unroll") for (int k = 0; k < 2; ++k) \
        acc[ai][bj][m][n] = __builtin_amdgcn_mfma_f32_16x16x32_bf16(Bt[n][k], At[m][k], acc[ai][bj][m][n], 0, 0, 0); __builtin_amdgcn_s_setprio(0); } while (0)
#define PG8_WAIT_V(n) asm volatile("s_waitcnt vmcnt(" #n ")" ::: "memory")
#define PG8_WAIT_L(n) asm volatile("s_waitcnt lgkmcnt(" #n ")" ::: "memory")
#define PG8_BAR __builtin_amdgcn_s_barrier()
#define PG8_SCHED __builtin_amdgcn_sched_barrier(0)
    Unit cur, nxt; int ui = 0;
    if (!S.next(0, cur)) return;
    if constexpr (GATHER) {
#pragma unroll
        for (int i = 0; i < 2; ++i) { voffA[i] = (unsigned)(S.a_row(cur, RA[i]) * g.lda + CA[i]) * 2u; voffA1[i] = (unsigned)(S.a_row(cur, HALF + RA[i]) * g.lda + CA[i]) * 2u; }
    }
    f32x4 acc[2][2][4][2];
#pragma unroll
    for (int a = 0; a < 2; ++a)
#pragma unroll
        for (int b = 0; b < 2; ++b)
#pragma unroll
            for (int m = 0; m < 4; ++m)
#pragma unroll
                for (int n = 0; n < 2; ++n) acc[a][b][m][n] = (f32x4){0.f, 0.f, 0.f, 0.f};
    bf16x8 At[4][2], B0[2][2], B1[2][2];
    const char* cA = S.a_base(g, cur); const char* cB = S.b_base(g, cur);
    PG8_STAGE(PG8_SB(0, 0), cB, voffB); PG8_STAGE(PG8_SB(0, 1), cB + hstepB, voffB); PG8_STAGE_A0(PG8_SA(0, 0), cA); PG8_STAGE_A1(PG8_SA(0, 1), cA);
    if (wr == 1) PG8_BAR;
    PG8_WAIT_V(2); PG8_BAR;
    PG8_STAGE(PG8_SB(1, 0), cB + kstep, voffB); PG8_STAGE_A0(PG8_SA(1, 0), cA + kstep); PG8_STAGE(PG8_SB(1, 1), cB + hstepB + kstep, voffB);
    PG8_WAIT_V(6); PG8_BAR;
    for (;;) {
        const bool has_next = GATHER ? false : S.next(ui + 1, nxt);
        const char* nA = has_next ? S.a_base(g, nxt) : cA; const char* nB = has_next ? S.b_base(g, nxt) : cB;
        for (int t = 0; t < nt; t += 2) {
            const bool last = (t == nt - 2);
            const char* a1 = cA + (size_t)(t + 1) * kstep;
            const char* a2 = last ? nA : cA + (size_t)(t + 2) * kstep; const char* b2 = last ? nB : cB + (size_t)(t + 2) * kstep;
            const char* a3 = a2 + kstep; const char* b3 = b2 + kstep;
            PG8_LDB(B0, 0, 0); PG8_LDB(B1, 0, 1); PG8_SCHED; PG8_LDA(At, 0, 0); PG8_STAGE_A1(PG8_SA(1, 1), a1);
            PG8_WAIT_V(8); PG8_WAIT_L(0); PG8_BAR; PG8_MMA(0, 0, At, B0); PG8_MMA(0, 1, At, B1); PG8_BAR; PG8_SCHED;
            PG8_LDA(At, 0, 1); PG8_STAGE(PG8_SB(0, 0), b2, voffB); PG8_STAGE(PG8_SB(0, 1), b2 + hstepB, voffB); PG8_STAGE_A0(PG8_SA(0, 0), a2);
            PG8_WAIT_V(8); PG8_WAIT_L(0); PG8_BAR; PG8_MMA(1, 0, At, B0); PG8_MMA(1, 1, At, B1); PG8_BAR; PG8_SCHED;
            PG8_LDB(B0, 1, 0); PG8_LDB(B1, 1, 1); PG8_SCHED; PG8_LDA(At, 1, 0); PG8_STAGE_A1(PG8_SA(0, 1), a2);
            PG8_WAIT_V(8); PG8_WAIT_L(0); PG8_BAR; PG8_MMA(0, 0, At, B0); PG8_MMA(0, 1, At, B1); PG8_BAR; PG8_SCHED;
            PG8_LDA(At, 1, 1); PG8_STAGE(PG8_SB(1, 0), b3, voffB); PG8_STAGE(PG8_SB(1, 1), b3 + hstepB, voffB); PG8_STAGE_A0(PG8_SA(1, 0), a3);
            PG8_WAIT_V(8); PG8_WAIT_L(0); PG8_BAR; PG8_MMA(1, 0, At, B0); PG8_MMA(1, 1, At, B1); PG8_BAR; PG8_SCHED;
        }
        if constexpr (ALIGN_EPI) { if (wr == 0) PG8_BAR; }
        E(acc, cur, wr, wc, fr, fq);
        if (!has_next) break;
#pragma unroll
        for (int a = 0; a < 2; ++a)
#pragma unroll
            for (int b = 0; b < 2; ++b)
#pragma unroll
                for (int m = 0; m < 4; ++m)
#pragma unroll
                    for (int n = 0; n < 2; ++n) acc[a][b][m][n] = (f32x4){0.f, 0.f, 0.f, 0.f};
        cur = nxt; cA = nA; cB = nB; ++ui;
        if constexpr (ALIGN_EPI) { if (wr == 1) PG8_BAR; }
    }
    PG8_WAIT_V(0);
    if constexpr (!ALIGN_EPI) { if (wr == 0) PG8_BAR; }
    PG8_BAR;
#undef PG8_SA
#undef PG8_SB
#undef PG8_STAGE
#undef PG8_STAGE_A0
#undef PG8_STAGE_A1
#undef PG8_LDA
#undef PG8_LDB
#undef PG8_MMA
#undef PG8_WAIT_V
#undef PG8_WAIT_L
#undef PG8_BAR
#undef PG8_SCHED
}
}
namespace fx {
using nv::u16; using nv::Bufs; using nv::Inputs;
using pg8::f32x4; using pg8::u32x4; using pg8::Unit;
#define LAS __attribute__((address_space(3)))
static_assert(nv::DM == 1024 && nv::NB == 8 && nv::S == 4096 && nv::MH == 256 && nv::PLE == 256, "fast phases are written for the full-size problem");
constexpr int NTOK = nv::NTOK, DM = 1024;
constexpr int INW_PAD = 6144;
constexpr int C_Z = 1280, C_XBC = 2304, C_BG = 3840, C_NG = 5888, C_DT = 5912, C_END = 5928;

struct WBufs { u16 *WinT, *WaT, *WbT, *WoutT, *PleGT, *PlePT, *WguT, *WdT, *PB; };
__host__ __device__ inline size_t carve_w(WBufs& W, unsigned char* ws, size_t off) {
  auto take = [&](size_t bytes) { unsigned char* r = ws + off; off += (bytes + 255) / 256 * 256; return r; };
  W.WinT = (u16*)take((size_t)INW_PAD * 1024 * 2); W.WaT = (u16*)take((size_t)1024 * 512 * 2); W.WbT = (u16*)take((size_t)1024 * 1024 * 2); W.WoutT = (u16*)take((size_t)1024 * 1024 * 2);
  W.PleGT = (u16*)take((size_t)1024 * 1024 * 2); W.PlePT = (u16*)take((size_t)1024 * 256 * 2); W.WguT = (u16*)take((size_t)32 * 512 * 1024 * 2); W.WdT = (u16*)take((size_t)32 * 1024 * 256 * 2);
  W.PB = (u16*)take((size_t)NTOK * 256 * 2);
  return off;
}

__device__ __forceinline__ float fsig(float x) { return __builtin_amdgcn_rcpf(1.0f + __expf(-x)); }
__device__ __forceinline__ float fsoftplus(float x) { const float e = __expf(x); return x > 20.f ? x : (e < 0.0625f ? e * (1.f - e * (0.5f - e * (0.33333333f - 0.25f * e))) : __logf(1.0f + e)); }
__device__ __forceinline__ unsigned pk2(float lo, float hi) { return pg8::cvt_pk_bf16(lo, hi); }
__device__ __forceinline__ void store8(u16* p, const float (&v)[8]) { u32x4 w; w.x = pk2(v[0], v[1]); w.y = pk2(v[2], v[3]); w.z = pk2(v[4], v[5]); w.w = pk2(v[6], v[7]); *(u32x4*)p = w; }
__device__ __forceinline__ void load8(const u16* p, float (&v)[8]) { const u32x4 w = *(const u32x4*)p;
  v[0] = __uint_as_float(w.x << 16); v[1] = __uint_as_float(w.x & 0xffff0000u); v[2] = __uint_as_float(w.y << 16); v[3] = __uint_as_float(w.y & 0xffff0000u);
  v[4] = __uint_as_float(w.z << 16); v[5] = __uint_as_float(w.z & 0xffff0000u); v[6] = __uint_as_float(w.w << 16); v[7] = __uint_as_float(w.w & 0xffff0000u); }

__device__ __forceinline__ float wave_sum(float v) {
#pragma unroll
  for (int o = 1; o < 64; o <<= 1) v += __shfl_xor(v, o);
  return v; }
__device__ __forceinline__ void rms_row_to_bf16(const float* xrow, const float* gain, u16* orow, int lane) {
  const f32x4* xr = (const f32x4*)xrow + lane; const f32x4* gr = (const f32x4*)gain + lane;
  f32x4 v[4]; float s = 0.f;
#pragma unroll
  for (int j = 0; j < 4; ++j) { v[j] = xr[64 * j]; s += (v[j].x * v[j].x + v[j].y * v[j].y) + (v[j].z * v[j].z + v[j].w * v[j].w); }
  const float rs = 1.0f / sqrtf(wave_sum(s) * (1.f / 1024.f) + nv::EPS);
  unsigned long long* o8 = (unsigned long long*)orow + lane;
#pragma unroll
  for (int j = 0; j < 4; ++j) { const f32x4 g = gr[64 * j]; o8[64 * j] = (unsigned long long)pk2(v[j].x * rs * g.x, v[j].y * rs * g.y) | ((unsigned long long)pk2(v[j].z * rs * g.z, v[j].w * rs * g.w) << 32); }
}
__device__ __forceinline__ void phase_rms_rows(const float* x, const float* gain, u16* out) {
  const int lane = threadIdx.x & 63, gw = blockIdx.x * 8 + (threadIdx.x >> 6), ngw = gridDim.x * 8;
  for (int r = gw; r < NTOK; r += ngw) rms_row_to_bf16(x + (size_t)r * 1024, gain, out + (size_t)r * 1024, lane);
}
template <class CP> __device__ __forceinline__ void transpose_tile(LAS float* scr, const CP cp, u16* dst, int K, int n0, int k0) {
  const int tid = threadIdx.x;
  { const int nn = tid & 127; const float* p = cp(n0 + nn);
#pragma unroll
    for (int i = 0; i < 16; ++i) { const int kk = i * 4 + (tid >> 7); scr[nn * 65 + kk] = p ? p[(size_t)(k0 + kk) * cp.ld] : 0.f; } }
  __syncthreads();
#pragma unroll
  for (int h = 0; h < 2; ++h) { const int it = tid + h * 512, nn = it >> 3, kc = it & 7; const LAS float* s = scr + nn * 65 + kc * 8;
    u32x4 o; o.x = pk2(s[0], s[1]); o.y = pk2(s[2], s[3]); o.z = pk2(s[4], s[5]); o.w = pk2(s[6], s[7]);
    *(u32x4*)(dst + (size_t)(n0 + nn) * K + k0 + kc * 8) = o; }
  __syncthreads();
}
struct CpIdent { const float* src; int ld; __device__ const float* operator()(int n) const { return src + n; } };
struct CpInProj { const float* src; int ld; __device__ const float* operator()(int n) const {
  int c; if (n < C_Z) c = n; else if (n < C_XBC) c = nv::O_Z + (n - C_Z); else if (n < C_BG) c = nv::O_XBC + (n - C_XBC); else if (n < C_NG) c = nv::O_BG + (n - C_BG); else if (n < C_DT) c = nv::O_NG + (n - C_NG); else if (n < C_END) c = nv::O_DT + (n - C_DT); else return nullptr;
  return src + c; } };
struct CpGU { const float* gate; long updelta; int ld; __device__ const float* operator()(int n) const { const int tile = n >> 8, r = n & 255; return gate + (r < 128 ? 0L : updelta) + tile * 128 + (r & 127); } };

__device__ __forceinline__ void phase_prologue(LAS unsigned char* lds, const Inputs& I, const Bufs& B, const WBufs& W) {
  LAS float* scr = (LAS float*)lds;
  constexpr int T_IN = (INW_PAD / 128) * 16, T_A = 8 * 8, T_B = 8 * 16, T_O = 8 * 16, T_PG = 8 * 16, T_PP = 8 * 4, T_GU = 32 * 4 * 16, T_D = 32 * 8 * 4;
  constexpr int TOT = T_IN + T_A + T_B + T_O + T_PG + T_PP + T_GU + T_D;
  for (int t = blockIdx.x; t < TOT; t += gridDim.x) { int r = t;
    if (r < T_IN) { CpInProj cp{I.w_in, nv::INW}; transpose_tile(scr, cp, W.WinT, 1024, (r / 16) * 128, (r % 16) * 64); continue; } r -= T_IN;
    if (r < T_A) { CpIdent cp{I.w_a, 1024}; transpose_tile(scr, cp, W.WaT, 512, (r / 8) * 128, (r % 8) * 64); continue; } r -= T_A;
    if (r < T_B) { CpIdent cp{I.w_b, 1024}; transpose_tile(scr, cp, W.WbT, 1024, (r / 16) * 128, (r % 16) * 64); continue; } r -= T_B;
    if (r < T_O) { CpIdent cp{I.w_out, 1024}; transpose_tile(scr, cp, W.WoutT, 1024, (r / 16) * 128, (r % 16) * 64); continue; } r -= T_O;
    if (r < T_PG) { CpIdent cp{I.ple_wg, 1024}; transpose_tile(scr, cp, W.PleGT, 1024, (r / 16) * 128, (r % 16) * 64); continue; } r -= T_PG;
    if (r < T_PP) { CpIdent cp{I.ple_wp, 1024}; transpose_tile(scr, cp, W.PlePT, 256, (r / 4) * 128, (r % 4) * 64); continue; } r -= T_PP;
    if (r < T_GU) { const int e = r / 64, q = r % 64; CpGU cp{I.w_gate + (size_t)e * 1024 * 256, (long)(I.w_up - I.w_gate), 256}; transpose_tile(scr, cp, W.WguT + (size_t)e * 512 * 1024, 1024, (q / 16) * 128, (q % 16) * 64); continue; } r -= T_GU;
    { const int e = r / 32, q = r % 32; CpIdent cp{I.w_down + (size_t)e * 256 * 1024, 1024}; transpose_tile(scr, cp, W.WdT + (size_t)e * 1024 * 256, 256, (q / 4) * 128, (q % 4) * 64); }
  }
  phase_rms_rows(I.x, I.mix_norm, B.HB);
  for (long i = blockIdx.x * 512L + threadIdx.x; i < (long)NTOK * 256 / 8; i += (long)gridDim.x * 512L) { const f32x4 a = ((const f32x4*)I.p)[2 * i], b = ((const f32x4*)I.p)[2 * i + 1];
    u32x4 o; o.x = pk2(a.x, a.y); o.y = pk2(a.z, a.w); o.z = pk2(b.x, b.y); o.w = pk2(b.z, b.w); ((u32x4*)W.PB)[i] = o; }
}

template <class F> struct Epi8 { static constexpr bool PERM = true; F f;
  __device__ __forceinline__ void operator()(const f32x4 (&acc)[2][2][4][2], const Unit& u, int wr, int wc, int fr, int fq) const {
#pragma unroll
    for (int ai = 0; ai < 2; ++ai)
#pragma unroll
      for (int m = 0; m < 4; ++m) { const int row = u.pm * 256 + ai * 128 + wr * 64 + m * 16 + fr;
#pragma unroll
        for (int bj = 0; bj < 2; ++bj) { const int col = u.pn * 256 + bj * 128 + wc * 32 + 8 * fq; const f32x4 a = acc[ai][bj][m][0], b = acc[ai][bj][m][1];
          const float v[8] = {a.x, a.y, a.z, a.w, b.x, b.y, b.z, b.w}; f(u, row, col, v); } } } };

struct FInProj { u16* QKV; u16* Z; u16* XBC; u16* BG; float* NG; float* DT; const float* dt_bias;
  __device__ __forceinline__ void operator()(const Unit&, int r, int c, const float (&v)[8]) const {
    if (c < C_Z) store8(QKV + (size_t)r * 1280 + c, v);
    else if (c < C_XBC) store8(Z + (size_t)r * 1024 + (c - C_Z), v);
    else if (c < C_BG) store8(XBC + (size_t)r * 1536 + (c - C_XBC), v);
    else if (c < C_NG) { float s[8];
#pragma unroll
      for (int i = 0; i < 8; ++i) s[i] = fsig(v[i]);
      store8(BG + (size_t)r * 2048 + (c - C_BG), s); }
    else if (c < C_DT) { float* o = NG + (size_t)r * 24 + (c - C_NG);
#pragma unroll
      for (int i = 0; i < 8; ++i) o[i] = fsig(v[i]); }
    else if (c < C_END) { float* o = DT + (size_t)r * 16 + (c - C_DT); const float* bi = dt_bias + (c - C_DT);
#pragma unroll
      for (int i = 0; i < 8; ++i) o[i] = fsoftplus(v[i] + bi[i]); } } };
struct FStoreBf { u16* o; int ld; __device__ __forceinline__ void operator()(const Unit&, int r, int c, const float (&v)[8]) const { store8(o + (size_t)r * ld + c, v); } };
struct FMerge { const u16* t1; const u16* bg; u16* o;
  __device__ __forceinline__ void operator()(const Unit&, int r, int c, const float (&v)[8]) const { float t[8], ga[8], gb[8], m[8]; load8(t1 + (size_t)r * 1024 + c, t); load8(bg + (size_t)r * 2048 + c, ga); load8(bg + (size_t)r * 2048 + 1024 + c, gb);
#pragma unroll
    for (int i = 0; i < 8; ++i) m[i] = ga[i] * t[i] + gb[i] * v[i];
    store8(o + (size_t)r * 1024 + c, m); } };
struct FResid { const float* x; float* o;
  __device__ __forceinline__ void operator()(const Unit&, int r, int c, const float (&v)[8]) const { const f32x4 a = *(const f32x4*)(x + (size_t)r * 1024 + c), b = *(const f32x4*)(x + (size_t)r * 1024 + c + 4);
    *(f32x4*)(o + (size_t)r * 1024 + c) = (f32x4){a.x + v[0], a.y + v[1], a.z + v[2], a.w + v[3]}; *(f32x4*)(o + (size_t)r * 1024 + c + 4) = (f32x4){b.x + v[4], b.y + v[5], b.z + v[6], b.w + v[7]}; } };
struct FPle { float* x; const u16* pp;
  __device__ __forceinline__ void operator()(const Unit&, int r, int c, const float (&v)[8]) const { float p[8]; load8(pp + (size_t)r * 1024 + c, p); float* xp = x + (size_t)r * 1024 + c; const f32x4 a = *(const f32x4*)xp, b = *(const f32x4*)(xp + 4);
    *(f32x4*)xp = (f32x4){a.x + fsig(v[0]) * p[0], a.y + fsig(v[1]) * p[1], a.z + fsig(v[2]) * p[2], a.w + fsig(v[3]) * p[3]};
    *(f32x4*)(xp + 4) = (f32x4){b.x + fsig(v[4]) * p[4], b.y + fsig(v[5]) * p[5], b.z + fsig(v[6]) * p[6], b.w + fsig(v[7]) * p[7]}; } };

template <class F> __device__ __forceinline__ void dense_gemm(LAS unsigned char* lds, const u16* A, int lda, const u16* Bt, int ldb, int M, int N, int K, const F& f) {
  pg8::Gemm g{A, Bt, M, N, K, lda, ldb}; pg8::StaticOrder S; S.init(M, N, (int)gridDim.x, (int)blockIdx.x); Epi8<F> E{f};
  pg8::gemm_phase<Epi8<F>, pg8::StaticOrder, true, false>(lds, g, S, E);
}
}
struct Params { nv::Inputs I; float* out; unsigned char* ws; };
constexpr int LDS_BYTES = 147456;
template <class F> __device__ __forceinline__ void run_phase(const F& f, long n) {
  for (long i = blockIdx.x * 512L + threadIdx.x; i < n; i += (long)gridDim.x * 512L) f(i);
}
__global__ void __launch_bounds__(512) mega_fwd(Params P) {
  extern __shared__ __attribute__((aligned(16))) unsigned char lds_raw[];
  LAS unsigned char* lds = (LAS unsigned char*)lds_raw;
  cg::grid_group grid = cg::this_grid();
  nv::Bufs B; const size_t woff = nv::carve(B, P.ws, P.out); fx::WBufs W; fx::carve_w(W, P.ws, woff);
  float* out = P.out;
#define RUN(f, n) { run_phase(f, n); grid.sync(); }
  fx::phase_prologue(lds, P.I, B, W); grid.sync();
  fx::dense_gemm(lds, B.HB, 1024, W.WinT, 1024, nv::NTOK, fx::INW_PAD, 1024, fx::FInProj{B.QKV, B.Z, B.XBC, B.BG, B.NG, B.DT, P.I.dt_bias}); grid.sync();
  NV2_STAGE_QKNORM(RUN, P.I, B, out)
  NV2_STAGE_COMPRESS(RUN, P.I, B, out)
  NV2_STAGE_ATTN(RUN, P.I, B, out)
  NV2_STAGE_SSD(RUN, P.I, B, out)
  fx::dense_gemm(lds, B.YA, 512, W.WaT, 512, nv::NTOK, 1024, 512, fx::FStoreBf{B.T1, 1024});
  fx::dense_gemm(lds, B.YB, 1024, W.WbT, 1024, nv::NTOK, 1024, 1024, fx::FMerge{B.T1, B.BG, B.MERGED}); grid.sync();
  fx::dense_gemm(lds, B.MERGED, 1024, W.WoutT, 1024, nv::NTOK, 1024, 1024, fx::FResid{P.I.x, out}); grid.sync();
  NV2_STAGE_MOE(RUN, P.I, B, out)
  fx::phase_rms_rows(out, P.I.ple_norm, B.H2); grid.sync();
  fx::dense_gemm(lds, W.PB, 256, W.PlePT, 256, nv::NTOK, 1024, 256, fx::FStoreBf{B.PP, 1024});
  fx::dense_gemm(lds, B.H2, 1024, W.PleGT, 1024, nv::NTOK, 1024, 1024, fx::FPle{out, B.PP});
#undef RUN
}
extern "C" void kernel_launch(void* const* d_in, const int* in_sizes, int n_in, void* d_out, int out_size, void* d_ws, size_t ws_size, hipStream_t stream) {
  static int grid_blocks = 0;
  if (!grid_blocks) {
    int dev = 0, cus = 0, per_cu = 0;
    (void)hipGetDevice(&dev);
    (void)hipDeviceGetAttribute(&cus, hipDeviceAttributeMultiprocessorCount, dev);
    if (hipFuncSetAttribute((const void*)mega_fwd, hipFuncAttributeMaxDynamicSharedMemorySize, LDS_BYTES) != hipSuccess) fprintf(stderr, "kernel_launch: hipFuncSetAttribute failed\n");
    if (hipOccupancyMaxActiveBlocksPerMultiprocessor(&per_cu, mega_fwd, 512, LDS_BYTES) != hipSuccess || per_cu < 1) { fprintf(stderr, "kernel_launch: occupancy query says %d blocks per CU\n", per_cu); }
    grid_blocks = cus;
    { nv::Bufs B; fx::WBufs W; size_t need = fx::carve_w(W, nullptr, nv::carve(B, nullptr, nullptr)); if (need > ws_size) fprintf(stderr, "kernel_launch: workspace too small: need %zu have %zu\n", need, ws_size); }
  }
  Params p; memset(&p, 0, sizeof(p));
  const float** ip = (const float**)&p.I; for (int i = 0; i < 34; ++i) ip[i] = (const float*)d_in[i];
  p.out = (float*)d_out; p.ws = (unsigned char*)d_ws;
  void* args[] = {&p};
  hipError_t e = hipLaunchCooperativeKernel((void*)mega_fwd, dim3(grid_blocks), dim3(512), args, LDS_BYTES, stream);
  if (e != hipSuccess) fprintf(stderr, "cooperative launch failed: %s (grid %d)\n", hipGetErrorString(e), grid_blocks);
}
```

```cpp
#include <hip/hip_runtime.h>
#include <hip/hip_cooperative_groups.h>
#include <cstdio>
#include <cstring>
namespace cg = cooperative_groups;
#define HD __host__ __device__ inline
#if defined(__HIP_DEVICE_COMPILE__)
#define NV_FENCE() asm volatile("" ::: "memory")
#else
#define NV_FENCE()
#endif
#ifndef CFG_DM
#define CFG_DM 1024
#endif
#ifndef CFG_BATCH
#define CFG_BATCH 8
#endif
#ifndef CFG_SEQ
#define CFG_SEQ 4096
#endif
#ifndef CFG_MH
#define CFG_MH 256
#endif
#ifndef CFG_PLE
#define CFG_PLE 256
#endif

#ifndef NV_FENCE
#define NV_FENCE()
#endif
namespace nv {
typedef unsigned short u16;
typedef unsigned long long u64;
constexpr int DM = CFG_DM, NB = CFG_BATCH, S = CFG_SEQ, MH = CFG_MH, PLE = CFG_PLE;
constexpr int NTOK = NB * S;
constexpr int H = 8, G = 2, E = 4;
constexpr int QW = 512, GW = 24, QKVW = 1280;
constexpr int SH = 16, SP = 64, SI = 1024, SG = 2, SN = 128, SCD = 1536;
constexpr int INW = QW + 6 * 128 + GW + SI + SCD + SH + 2 * DM;
constexpr int O_Q = 0, O_KC = 512, O_VC = 640, O_KS = 768, O_VS = 896, O_KW = 1024, O_VW = 1152, O_NG = 1280, O_Z = 1304, O_XBC = 2328, O_DT = 3864, O_BG = 3880;
static_assert(O_BG + 2 * DM == INW, "in-proj width");
constexpr int NCMP = S / 16 - 1, NCP = S / 16, NSEL = S / 64, NTOP = NSEL < 16 ? NSEL : 16;
constexpr int NEXP = 32;
constexpr float EPS = 1e-6f;

HD float sigmoidf_(float x) { return 1.0f / (1.0f + expf(-x)); }
HD float siluf_(float x) { return x / (1.0f + expf(-x)); }
HD float softplusf_(float x) { return x > 20.f ? x : log1pf(expf(x)); }
HD u16 f2bf(float f) { unsigned u = __builtin_bit_cast(unsigned, f); u += 0x7fffu + ((u >> 16) & 1u); return (u16)(u >> 16); }
HD float bf2f(u16 h) { return __builtin_bit_cast(float, (unsigned)h << 16); }

struct Bufs {
  u16* HB;
  u16* QKV;
  float* NG;
  u16* Z;
  u16* XBC;
  float* DT;
  u16* BG;
  u16* KCMP;
  u16* VCMP;
  u16* YA;
  u16* YB;
  u16* T1;
  u16* MERGED;
  u16* H2;
  u16* ACT;
  u16* PP;
  int* EI;
  float* EW;
  float* HID;
  float* KTMP;
  float* ML;
  float* IMP;
  u64* MASK;
};
struct Inputs { const float *x, *p, *mix_norm, *w_in, *q_gain, *kc_gain, *ks_gain, *kw_gain, *pos_k, *w1_k, *w2_k, *pos_v, *w1_v, *w2_v, *conv_w, *conv_b, *dt_bias, *a_log, *d_skip, *ssm_norm,
  *w_a, *w_b, *w_out, *moe_norm, *w_group, *b_group, *w_expert, *b_expert, *w_gate, *w_up, *w_down, *ple_norm, *ple_wg, *ple_wp; };

struct RmsRowsBf { const float* in; const float* gain; u16* out; long ncols;
  HD void operator()(long r) const { const float* x = in + r * ncols; float s = 0.f; for (long c = 0; c < ncols; ++c) s += x[c] * x[c];
    const float rs = 1.0f / sqrtf(s / (float)ncols + EPS); u16* o = out + r * ncols; for (long c = 0; c < ncols; ++c) o[c] = f2bf(x[c] * rs * gain[c]); } };

template <class AL, class EP> struct GemmT { AL a; const float* B; EP ep; long M, N, K, ldb;
  HD long items() const { return ((M + 7) / 8) * ((N + 3) / 4); }
  HD void operator()(long it) const { const long nt = (N + 3) / 4; const long tm = it / nt, tn = it % nt; const long r0 = tm * 8, c0 = tn * 4;
    float acc[8][4];
#pragma unroll
    for (int i = 0; i < 8; ++i)
#pragma unroll
      for (int j = 0; j < 4; ++j) acc[i][j] = 0.f;
    for (long k = 0; k < K; ++k) { float b[4];
#pragma unroll
      for (int j = 0; j < 4; ++j) b[j] = (c0 + j < N) ? B[k * ldb + c0 + j] : 0.f;
#pragma unroll
      for (int i = 0; i < 8; ++i) { const long r = r0 + i < M ? r0 + i : M - 1; const float av = a(r, k);
#pragma unroll
        for (int j = 0; j < 4; ++j) acc[i][j] += av * b[j]; } }
#pragma unroll
    for (int i = 0; i < 8; ++i) if (r0 + i < M) {
#pragma unroll
      for (int j = 0; j < 4; ++j) if (c0 + j < N) ep(r0 + i, c0 + j, acc[i][j]); } } };
struct ABf { const u16* p; long ld; HD float operator()(long r, long k) const { return bf2f(p[r * ld + k]); } };
struct AF32 { const float* p; long ld; HD float operator()(long r, long k) const { return p[r * ld + k]; } };
struct ACmp { const u16* qkv; const float* pos; long off;
  HD float operator()(long r, long k) const { const long c = r % NCMP, bg = r / NCMP, b = bg / G, g = bg % G; const long l = k / 64, d = k % 64;
    return bf2f(qkv[(b * S + 16 * c + l) * QKVW + off + g * 64 + d]) + pos[k]; } };

struct EpInProj { Bufs B; const float* dt_bias;
  HD void operator()(long r, long c, float v) const {
    if (c < O_NG) B.QKV[r * QKVW + c] = f2bf(v);
    else if (c < O_Z) B.NG[r * GW + (c - O_NG)] = sigmoidf_(v);
    else if (c < O_XBC) B.Z[r * SI + (c - O_Z)] = f2bf(v);
    else if (c < O_DT) B.XBC[r * SCD + (c - O_XBC)] = f2bf(v);
    else if (c < O_BG) B.DT[r * SH + (c - O_DT)] = softplusf_(v + dt_bias[c - O_DT]);
    else B.BG[r * (2 * DM) + (c - O_BG)] = f2bf(sigmoidf_(v)); } };
struct EpSiluF32 { float* o; long ld; HD void operator()(long r, long c, float v) const { o[r * ld + c] = siluf_(v); } };
struct EpF32 { float* o; long ld; HD void operator()(long r, long c, float v) const { o[r * ld + c] = v; } };
struct EpBf { u16* o; long ld; HD void operator()(long r, long c, float v) const { o[r * ld + c] = f2bf(v); } };
struct EpMerge { const u16* t1; const u16* bg; u16* o; HD void operator()(long r, long c, float v) const { const float ga = bf2f(bg[r * (2 * DM) + c]), gb = bf2f(bg[r * (2 * DM) + DM + c]); o[r * DM + c] = f2bf(ga * bf2f(t1[r * DM + c]) + gb * v); } };
struct EpResid { const float* x; float* o; HD void operator()(long r, long c, float v) const { o[r * DM + c] = x[r * DM + c] + v; } };
struct EpPle { float* x; const u16* pp; HD void operator()(long r, long c, float v) const { x[r * DM + c] = x[r * DM + c] + sigmoidf_(v) * bf2f(pp[r * DM + c]); } };

struct QkNorm { u16* qkv; const float* qg; const float* ksg; const float* kwg;
  HD long items() const { return (long)NTOK * 12; }
  HD void operator()(long it) const { const long tok = it / 12; const int w = (int)(it % 12); u16* v; const float* gain;
    if (w < 8) { v = qkv + tok * QKVW + O_Q + w * 64; gain = qg; } else if (w < 10) { v = qkv + tok * QKVW + O_KS + (w - 8) * 64; gain = ksg; } else { v = qkv + tok * QKVW + O_KW + (w - 10) * 64; gain = kwg; }
    float s = 0.f; for (int d = 0; d < 64; ++d) { const float x = bf2f(v[d]); s += x * x; } const float rs = 1.0f / sqrtf(s / 64.f + EPS);
    for (int d = 0; d < 64; ++d) v[d] = f2bf(bf2f(v[d]) * rs * gain[d]); } };
struct CmpFinish { const float* src; const float* gain; u16* dst; long donorm;
  HD long items() const { return (long)NB * G * NCP; }
  HD void operator()(long it) const { const long c = it % NCP, bg = it / NCP; u16* o = dst + it * 64;
    if (c >= NCMP) { for (int d = 0; d < 64; ++d) o[d] = 0; return; }
    const float* x = src + (bg * NCMP + c) * 64; float rs = 1.f;
    if (donorm) { float s = 0.f; for (int d = 0; d < 64; ++d) s += x[d] * x[d]; rs = 1.0f / sqrtf(s / 64.f + EPS); }
    for (int d = 0; d < 64; ++d) o[d] = f2bf(donorm ? x[d] * rs * gain[d] : x[d]); } };

struct CmpAttn { Bufs B;
  HD long items() const { return (long)NB * H * S; }
  HD void operator()(long it) const { const long t = it % S; const int h = (int)((it / S) % H), g = h / E; const long b = it / ((long)S * H); const long tok = b * S + t;
    const u16* q = B.QKV + tok * QKVW + O_Q + h * 64; const u16* kc = B.KCMP + (b * G + g) * (long)NCP * 64; const u16* vc = B.VCMP + (b * G + g) * (long)NCP * 64;
    float qr[64];
#pragma unroll
    for (int d = 0; d < 64; ++d) qr[d] = bf2f(q[d]);
    long nvis = (t - 31 >= 0) ? (t - 31) / 16 + 1 : 0; if (nvis > NCMP) nvis = NCMP;
    float m = -3.0e38f;
    for (long c = 0; c < nvis; ++c) { const u16* k = kc + c * 64; float s = 0.f;
#pragma unroll
      for (int d = 0; d < 64; ++d) s += qr[d] * bf2f(k[d]);
      s *= 0.125f; m = s > m ? s : m; }
    float o[64];
#pragma unroll
    for (int d = 0; d < 64; ++d) o[d] = 0.f;
    float l = 0.f;
    for (long c = 0; c < nvis; ++c) { const u16* k = kc + c * 64; const u16* v = vc + c * 64; float s = 0.f;
#pragma unroll
      for (int d = 0; d < 64; ++d) s += qr[d] * bf2f(k[d]);
      const float p = expf(s * 0.125f - m); l += p;
#pragma unroll
      for (int d = 0; d < 64; ++d) o[d] += p * bf2f(v[d]); }
    const float g0 = B.NG[tok * GW + h * 3 + 0]; const float inv = nvis > 0 ? g0 / l : 0.f;
#pragma unroll
    for (int d = 0; d < 64; ++d) B.YA[tok * QW + h * 64 + d] = f2bf(o[d] * inv);
    B.ML[it * 2] = m; B.ML[it * 2 + 1] = nvis > 0 ? l : 0.f; } };
struct Importance { Bufs B;
  HD long items() const { return (long)NB * G * S * NSEL; }
  HD void operator()(long it) const { const int j = (int)(it % NSEL); const long bgt = it / NSEL; const long t = bgt % S; const long bg = bgt / S; const long b = bg / G; const int g = (int)(bg % G); const long tok = b * S + t;
    long nvis = (t - 31 >= 0) ? (t - 31) / 16 + 1 : 0; if (nvis > NCMP) nvis = NCMP;
    long c0 = 4 * j - 1; if (c0 < 0) c0 = 0; long c1 = 4 * j + 3; if (c1 > nvis - 1) c1 = nvis - 1;
    const u16* kc = B.KCMP + bg * (long)NCP * 64; float acc = 0.f;
    for (int e = 0; e < E; ++e) { const int h = g * E + e; const u16* q = B.QKV + tok * QKVW + O_Q + h * 64; const long mi = ((b * H + h) * (long)S + t) * 2; const float m = B.ML[mi], l = B.ML[mi + 1];
      if (l > 0.f) for (long c = c0; c <= c1; ++c) { const u16* k = kc + c * 64; float s = 0.f; for (int d = 0; d < 64; ++d) s += bf2f(q[d]) * bf2f(k[d]); acc += expf(s * 0.125f - m) / l; } }
    B.IMP[bgt * 64 + j] = acc; } };
struct TopSel { Bufs B;
  HD long items() const { return (long)NB * G * S; }
  HD void operator()(long bgt) const { const long t = bgt % S; const int cur = (int)(t / 64); u64 m = 0ull;
    for (int r = 0; r < NTOP; ++r) { float best = -3.0e38f; int bj = -1;
      for (int j = 0; j <= cur && j < NSEL; ++j) { if ((m >> j) & 1ull) continue; float v = B.IMP[bgt * 64 + j]; if (j == 0 || j == cur || j == cur - 1) v += 1000.f; if (v > best) { best = v; bj = j; } }
      if (bj < 0) break; m |= 1ull << bj; }
    B.MASK[bgt] = m; } };
struct SelAttn { Bufs B;
  HD long items() const { return (long)NB * H * S; }
  HD void operator()(long it) const { const long t = it % S; const int h = (int)((it / S) % H), g = h / E; const long b = it / ((long)S * H); const long tok = b * S + t;
    const u16* q = B.QKV + tok * QKVW + O_Q + h * 64; const u64 mk = B.MASK[(b * G + g) * (long)S + t];
    float qr[64], o[64];
#pragma unroll
    for (int d = 0; d < 64; ++d) { qr[d] = bf2f(q[d]); o[d] = 0.f; }
    float m = -3.0e38f, l = 0.f;
    for (int j = 0; j < NSEL; ++j) { if (!((mk >> j) & 1ull)) continue;
      for (long kp = 64L * j; kp < 64L * j + 64 && kp <= t; ++kp) { const u16* k = B.QKV + (b * S + kp) * QKVW + O_KS + g * 64; const u16* v = B.QKV + (b * S + kp) * QKVW + O_VS + g * 64; float s = 0.f;
#pragma unroll
        for (int d = 0; d < 64; ++d) s += qr[d] * bf2f(k[d]);
        s *= 0.125f;
        if (s > m) { const float f = expf(m - s); l *= f;
#pragma unroll
          for (int d = 0; d < 64; ++d) o[d] *= f;
          m = s; }
        const float p = expf(s - m); l += p;
#pragma unroll
        for (int d = 0; d < 64; ++d) o[d] += p * bf2f(v[d]); } }
    const float g1 = B.NG[tok * GW + h * 3 + 1]; const float inv = g1 / l;
#pragma unroll
    for (int d = 0; d < 64; ++d) { u16* y = B.YA + tok * QW + h * 64 + d; *y = f2bf(bf2f(*y) + o[d] * inv); } } };
struct WinAttn { Bufs B;
  HD long items() const { return (long)NB * H * S; }
  HD void operator()(long it) const { const long t = it % S; const int h = (int)((it / S) % H), g = h / E; const long b = it / ((long)S * H); const long tok = b * S + t;
    const u16* q = B.QKV + tok * QKVW + O_Q + h * 64;
    float qr[64], o[64];
#pragma unroll
    for (int d = 0; d < 64; ++d) { qr[d] = bf2f(q[d]); o[d] = 0.f; }
    float m = -3.0e38f, l = 0.f; long k0 = t - 511; if (k0 < 0) k0 = 0;
    for (long kp = k0; kp <= t; ++kp) { const u16* k = B.QKV + (b * S + kp) * QKVW + O_KW + g * 64; const u16* v = B.QKV + (b * S + kp) * QKVW + O_VW + g * 64; float s = 0.f;
#pragma unroll
      for (int d = 0; d < 64; ++d) s += qr[d] * bf2f(k[d]);
      s *= 0.125f;
      if (s > m) { const float f = expf(m - s); l *= f;
#pragma unroll
        for (int d = 0; d < 64; ++d) o[d] *= f;
        m = s; }
      const float p = expf(s - m); l += p;
#pragma unroll
      for (int d = 0; d < 64; ++d) o[d] += p * bf2f(v[d]); }
    const float g2 = B.NG[tok * GW + h * 3 + 2]; const float inv = g2 / l;
#pragma unroll
    for (int d = 0; d < 64; ++d) { u16* y = B.YA + tok * QW + h * 64 + d; *y = f2bf(bf2f(*y) + o[d] * inv); } } };

struct SsdConv { u16* xbc; const float* cw; const float* cb;
  HD long items() const { return (long)NB * SCD; }
  HD void operator()(long it) const { const int c = (int)(it % SCD); const long b = it / SCD; u16* col = xbc + b * S * SCD + c; const float w0 = cw[c], w1 = cw[SCD + c], w2 = cw[2 * SCD + c], w3 = cw[3 * SCD + c], bias = cb[c];
    for (long t = S - 1; t >= 0; --t) { float a = bias + w3 * bf2f(col[t * SCD]); if (t >= 1) a += w2 * bf2f(col[(t - 1) * SCD]); if (t >= 2) a += w1 * bf2f(col[(t - 2) * SCD]); if (t >= 3) a += w0 * bf2f(col[(t - 3) * SCD]);
      col[t * SCD] = f2bf(siluf_(a)); } } };
struct SsdScan { Bufs B; const float* alog; const float* dskip;
  HD long items() const { return (long)NB * SH * SP; }
  HD void operator()(long it) const { const int p = (int)(it % SP); const int hh = (int)((it / SP) % SH); const long b = it / (SP * SH); const int g = hh / 8;
    const float a = -expf(alog[hh]); float st[128];
#pragma unroll
    for (int n = 0; n < 128; ++n) st[n] = 0.f;
    for (long t = 0; t < S; ++t) { const long tok = b * S + t; const float dt = B.DT[tok * SH + hh]; const float dec = expf(dt * a); const float xd = bf2f(B.XBC[tok * SCD + hh * 64 + p]) * dt;
      const u16* Bv = B.XBC + tok * SCD + SI + g * SN; const u16* Cv = B.XBC + tok * SCD + SI + SG * SN + g * SN; float y = 0.f;
#pragma unroll
      for (int n = 0; n < 128; ++n) { st[n] = st[n] * dec + xd * bf2f(Bv[n]); y += bf2f(Cv[n]) * st[n]; if ((n & 15) == 15) { NV_FENCE(); } }
      B.XBC[tok * SCD + hh * 64 + p] = f2bf(y + bf2f(B.XBC[tok * SCD + hh * 64 + p]) * dskip[hh]); } } };
struct SsdOut { Bufs B; const float* ngain;
  HD long items() const { return (long)NTOK * SG; }
  HD void operator()(long it) const { const long tok = it / SG; const int g = (int)(it % SG); float s = 0.f;
    for (int c = g * 512; c < g * 512 + 512; ++c) { float y = bf2f(B.XBC[tok * SCD + c]); y *= siluf_(bf2f(B.Z[tok * SI + c])); s += y * y; }
    const float rs = 1.0f / sqrtf(s / 512.f + EPS);
    for (int c = g * 512; c < g * 512 + 512; ++c) { float y = bf2f(B.XBC[tok * SCD + c]); y *= siluf_(bf2f(B.Z[tok * SI + c])); B.YB[tok * SI + c] = f2bf(y * rs * ngain[c]); } } };

struct Router { const u16* h2; const float* wg; const float* bg; const float* we; const float* be; int* ei; float* ew;
  HD void operator()(long tok) const { const u16* x = h2 + tok * DM; float gl[4];
#pragma unroll
    for (int j = 0; j < 4; ++j) gl[j] = bg[j];
    for (long d = 0; d < DM; ++d) { const float xv = bf2f(x[d]);
#pragma unroll
      for (int j = 0; j < 4; ++j) gl[j] += xv * wg[d * 4 + j]; }
    int gi = 0; float gm = gl[0];
#pragma unroll
    for (int j = 1; j < 4; ++j) if (gl[j] > gm) { gm = gl[j]; gi = j; }
    float gs = 0.f;
#pragma unroll
    for (int j = 0; j < 4; ++j) gs += expf(gl[j] - gm);
    const float grp_w = 1.0f / gs;
    float el[8];
#pragma unroll
    for (int j = 0; j < 8; ++j) el[j] = be[gi * 8 + j];
    for (long d = 0; d < DM; ++d) { const float xv = bf2f(x[d]);
#pragma unroll
      for (int j = 0; j < 8; ++j) el[j] += xv * we[d * NEXP + gi * 8 + j]; }
    int i0 = 0; float m0 = el[0];
#pragma unroll
    for (int j = 1; j < 8; ++j) if (el[j] > m0) { m0 = el[j]; i0 = j; }
    int i1 = -1; float m1 = -3.0e38f;
#pragma unroll
    for (int j = 0; j < 8; ++j) if (j != i0 && el[j] > m1) { m1 = el[j]; i1 = j; }
    const float r = expf(m1 - m0); const float w0 = 1.0f / (1.0f + r), w1 = r / (1.0f + r);
    ei[tok * 2] = gi * 8 + i0; ei[tok * 2 + 1] = gi * 8 + i1; ew[tok * 2] = grp_w * w0; ew[tok * 2 + 1] = grp_w * w1; } };
struct MoeHidden { const u16* h2; const float* wgate; const float* wup; const int* ei; u16* act;
  HD long items() const { return (long)NTOK * 2 * MH; }
  HD void operator()(long it) const { const int j = (int)(it % MH); const long tk = it / MH; const long tok = tk / 2; const int e = ei[tk]; const u16* x = h2 + tok * DM;
    const float* wg_ = wgate + (long)e * DM * MH + j; const float* wu_ = wup + (long)e * DM * MH + j; float a = 0.f, b = 0.f;
    for (long d = 0; d < DM; ++d) { const float xv = bf2f(x[d]); a += xv * wg_[d * MH]; b += xv * wu_[d * MH]; }
    act[it] = f2bf(siluf_(a) * b); } };
struct MoeDown { const u16* act; const float* wdown; const int* ei; const float* ew; float* x;
  HD long items() const { return (long)NTOK * DM; }
  HD void operator()(long it) const { const int c = (int)(it % DM); const long tok = it / DM; float tot = 0.f;
    for (int k = 0; k < 2; ++k) { const int e = ei[tok * 2 + k]; const u16* a = act + (tok * 2 + k) * MH; const float* w = wdown + (long)e * MH * DM + c; float s = 0.f;
      for (int j = 0; j < MH; ++j) s += bf2f(a[j]) * w[(long)j * DM];
      tot += ew[tok * 2 + k] * s; }
    x[it] += tot; } };

#define NV2_STAGE_PREP(RUN, I, B, out)      { nv::RmsRowsBf f{I.x, I.mix_norm, B.HB, nv::DM}; RUN(f, (long)nv::NTOK); }
#define NV2_STAGE_INPROJ(RUN, I, B, out)    { nv::GemmT<nv::ABf, nv::EpInProj> f{nv::ABf{B.HB, nv::DM}, I.w_in, nv::EpInProj{B, I.dt_bias}, nv::NTOK, nv::INW, nv::DM, nv::INW}; RUN(f, f.items()); }
#define NV2_STAGE_QKNORM(RUN, I, B, out)    { nv::QkNorm f{B.QKV, I.q_gain, I.ks_gain, I.kw_gain}; RUN(f, f.items()); }
#define NV2_STAGE_COMPRESS(RUN, I, B, out)  { \
    { nv::GemmT<nv::ACmp, nv::EpSiluF32> f{nv::ACmp{B.QKV, I.pos_k, nv::O_KC}, I.w1_k, nv::EpSiluF32{B.HID, 128}, (long)nv::NB * nv::G * nv::NCMP, 128, 2048, 128}; RUN(f, f.items()); } \
    { nv::GemmT<nv::AF32, nv::EpF32> f{nv::AF32{B.HID, 128}, I.w2_k, nv::EpF32{B.KTMP, 64}, (long)nv::NB * nv::G * nv::NCMP, 64, 128, 64}; RUN(f, f.items()); } \
    { nv::CmpFinish f{B.KTMP, I.kc_gain, B.KCMP, 1}; RUN(f, f.items()); } \
    { nv::GemmT<nv::ACmp, nv::EpSiluF32> f{nv::ACmp{B.QKV, I.pos_v, nv::O_VC}, I.w1_v, nv::EpSiluF32{B.HID, 128}, (long)nv::NB * nv::G * nv::NCMP, 128, 2048, 128}; RUN(f, f.items()); } \
    { nv::GemmT<nv::AF32, nv::EpF32> f{nv::AF32{B.HID, 128}, I.w2_v, nv::EpF32{B.KTMP, 64}, (long)nv::NB * nv::G * nv::NCMP, 64, 128, 64}; RUN(f, f.items()); } \
    { nv::CmpFinish f{B.KTMP, I.kc_gain, B.VCMP, 0}; RUN(f, f.items()); } }
#define NV2_STAGE_ATTN(RUN, I, B, out)      { \
    { nv::CmpAttn f{B}; RUN(f, f.items()); } { nv::Importance f{B}; RUN(f, f.items()); } { nv::TopSel f{B}; RUN(f, f.items()); } { nv::SelAttn f{B}; RUN(f, f.items()); } { nv::WinAttn f{B}; RUN(f, f.items()); } }
#define NV2_STAGE_SSD(RUN, I, B, out)       { \
    { nv::SsdConv f{B.XBC, I.conv_w, I.conv_b}; RUN(f, f.items()); } { nv::SsdScan f{B, I.a_log, I.d_skip}; RUN(f, f.items()); } { nv::SsdOut f{B, I.ssm_norm}; RUN(f, f.items()); } }
#define NV2_STAGE_MERGE(RUN, I, B, out)     { \
    { nv::GemmT<nv::ABf, nv::EpBf> f{nv::ABf{B.YA, nv::QW}, I.w_a, nv::EpBf{B.T1, nv::DM}, nv::NTOK, nv::DM, nv::QW, nv::DM}; RUN(f, f.items()); } \
    { nv::GemmT<nv::ABf, nv::EpMerge> f{nv::ABf{B.YB, nv::SI}, I.w_b, nv::EpMerge{B.T1, B.BG, B.MERGED}, nv::NTOK, nv::DM, nv::SI, nv::DM}; RUN(f, f.items()); } \
    { nv::GemmT<nv::ABf, nv::EpResid> f{nv::ABf{B.MERGED, nv::DM}, I.w_out, nv::EpResid{I.x, out}, nv::NTOK, nv::DM, nv::DM, nv::DM}; RUN(f, f.items()); } }
#define NV2_STAGE_MOE(RUN, I, B, out)       { \
    { nv::RmsRowsBf f{out, I.moe_norm, B.H2, nv::DM}; RUN(f, (long)nv::NTOK); } \
    { nv::Router f{B.H2, I.w_group, I.b_group, I.w_expert, I.b_expert, B.EI, B.EW}; RUN(f, (long)nv::NTOK); } \
    { nv::MoeHidden f{B.H2, I.w_gate, I.w_up, B.EI, B.ACT}; RUN(f, f.items()); } \
    { nv::MoeDown f{B.ACT, I.w_down, B.EI, B.EW, out}; RUN(f, f.items()); } }
#define NV2_STAGE_PLE(RUN, I, B, out)       { \
    { nv::RmsRowsBf f{out, I.ple_norm, B.H2, nv::DM}; RUN(f, (long)nv::NTOK); } \
    { nv::GemmT<nv::AF32, nv::EpBf> f{nv::AF32{I.p, nv::PLE}, I.ple_wp, nv::EpBf{B.PP, nv::DM}, nv::NTOK, nv::DM, nv::PLE, nv::DM}; RUN(f, f.items()); } \
    { nv::GemmT<nv::ABf, nv::EpPle> f{nv::ABf{B.H2, nv::DM}, I.ple_wg, nv::EpPle{out, B.PP}, nv::NTOK, nv::DM, nv::DM, nv::DM}; RUN(f, f.items()); } }

HD size_t carve(Bufs& B, unsigned char* ws, float* out) {
  size_t off = 0; auto take = [&](size_t bytes) { unsigned char* r = ws + off; off += (bytes + 255) / 256 * 256; return r; };
  const size_t N = NTOK;
  B.BG = (u16*)out;
  unsigned char* R0 = take(N * DM * 2);
  unsigned char* R1 = take(N * QKVW * 2);
  unsigned char* R2 = take(N * SI * 2);
  unsigned char* R3 = take(N * SCD * 2);
  unsigned char* R5 = take(N * 2 * MH * 2 + (size_t)NEXP * 256 * MH * 2);
  B.HB = (u16*)R0; B.H2 = (u16*)R0; B.QKV = (u16*)R1; B.T1 = (u16*)R1; B.Z = (u16*)R2; B.XBC = (u16*)R3; B.MERGED = (u16*)R3; B.PP = (u16*)R3;
  B.YA = (u16*)take(N * QW * 2); B.ACT = (u16*)R5; B.YB = B.Z;
  B.NG = (float*)take(N * GW * 4); B.DT = (float*)take(N * SH * 4);
  B.KCMP = (u16*)take((size_t)NB * G * NCP * 64 * 2); B.VCMP = (u16*)take((size_t)NB * G * NCP * 64 * 2);
  B.EI = (int*)take(N * 2 * 4); B.EW = (float*)take(N * 2 * 4);
  B.HID = (float*)take((size_t)NB * G * NCMP * 128 * 4); B.KTMP = (float*)take((size_t)NB * G * NCMP * 64 * 4);
  B.ML = (float*)take(N * H * 2 * 4); B.IMP = (float*)take((size_t)NB * G * S * 64 * 4); B.MASK = (u64*)take((size_t)NB * G * S * 8);
  return off;
}
}
namespace pg8 {
#define PG8_LAS __attribute__((address_space(3)))
typedef unsigned short bf16_t;
typedef short bf16x8 __attribute__((ext_vector_type(8)));
typedef float f32x4 __attribute__((ext_vector_type(4)));
typedef unsigned u32x4 __attribute__((ext_vector_type(4)));
typedef unsigned u32x2 __attribute__((ext_vector_type(2)));
constexpr int BM = 256, BK = 64, HALF = 128, HTB = HALF * BK * 2  , STAGE_BYTES = 8 * HTB, NXCD = 8, WGM = 8;

__host__ __device__ __forceinline__ int lds_byte(int r, int c) { const int st = (r >> 4) * 2 + (c >> 5), rr = r & 15, cc = c & 31, ob = rr * 64 + cc * 2; return st * 1024 + (ob ^ (((ob >> 9) & 1) << 5)); }
__host__ __device__ __forceinline__ void stage_rc(int b, int& R, int& C) { const int st = b / 1024, sb = b % 1024, swz = sb ^ (((sb >> 9) & 1) << 5); R = (st >> 1) * 16 + swz / 64; C = (st & 1) * 32 + (swz % 64) / 2; }
__host__ __device__ __forceinline__ int perm32(int rho) { const int n = rho >> 4, i = rho & 15; return 8 * (i >> 2) + 4 * n + (i & 3); }

struct Unit { int pm, pn, aux0, aux1; };
struct Gemm { const bf16_t* A; const bf16_t* Bt; int M, N, K, lda, ldb; };

struct StaticOrder {
    int nM, nN, nwg, G, c;
    __device__ void init(int M, int N, int G_, int c_) { nM = M / BM; nN = N / BM; nwg = nM * nN; G = G_; c = c_; }
    __device__ bool next(int i, Unit& u) const {
        const long L = (long)i * G + c; if (L >= nwg) return false;
        int wgid = (int)L; { const int q = nwg / NXCD, r = nwg % NXCD, xcd = wgid % NXCD, off = wgid / NXCD; wgid = (xcd < r ? xcd * (q + 1) : r * (q + 1) + (xcd - r) * q) + off; }
        const int nig = WGM * nN, gid = wgid / nig, fm = gid * WGM, gsz = (nM - fm) < WGM ? (nM - fm) : WGM;
        u.pm = fm + ((wgid % nig) % gsz); u.pn = (wgid % nig) / gsz; u.aux0 = 0; u.aux1 = 0; return true;
    }
    __device__ __forceinline__ const char* a_base(const Gemm& g, const Unit& u) const { return (const char*)g.A + (size_t)u.pm * BM * g.lda * 2; }
    __device__ __forceinline__ const char* b_base(const Gemm& g, const Unit& u) const { return (const char*)g.Bt + (size_t)u.pn * BM * g.ldb * 2; }
    __device__ __forceinline__ int a_row(const Unit&, int) const { return 0; }
};

typedef float f32x2_t __attribute__((ext_vector_type(2))); typedef __bf16 bf16x2_t __attribute__((ext_vector_type(2)));
__device__ __forceinline__ unsigned cvt_pk_bf16(float lo, float hi) { f32x2_t v = {lo, hi}; bf16x2_t b = __builtin_convertvector(v, bf16x2_t); return __builtin_bit_cast(unsigned, b); }


template <class Epi, class Sched, bool ALIGN_EPI = true, bool GATHER = false>
__device__ __forceinline__ void gemm_phase(PG8_LAS unsigned char* lds, const Gemm g, const Sched& S, const Epi& E) {
    int tid_ = threadIdx.x; asm volatile("" : "+v"(tid_));
    const int tid = tid_, wid = __builtin_amdgcn_readfirstlane(tid >> 6), lane = tid & 63, wr = wid >> 2, wc = wid & 3, fr = lane & 15, fq = lane >> 4;
    const int K = g.K, nt = K / BK;
    unsigned voffA[2], voffA1[2], voffB[2];
    int RA[2], CA[2];
#pragma unroll
    for (int i = 0; i < 2; ++i) { int R, C; stage_rc(tid * 16 + i * 8192, R, C); const int Rb = Epi::PERM ? ((R & ~31) + perm32(R & 31)) : R;
        RA[i] = R; CA[i] = C; voffA[i] = (unsigned)(R * g.lda + C) * 2u; voffA1[i] = voffA[i]; voffB[i] = (unsigned)(Rb * g.ldb + C) * 2u; }
    const size_t kstep = (size_t)(BK * 2);
    const size_t hstepA = GATHER ? (size_t)0 : (size_t)HALF * g.lda * 2;
    const size_t hstepB = (size_t)HALF * g.ldb * 2;
    const unsigned ldsw = (unsigned)wid * 1024u;
    const int aoff = lds_byte(wr * 64 + fr, fq * 8), boff = lds_byte(wc * 32 + fr, fq * 8);
#define PG8_SA(b, h) (((b) * 2 + (h)) * HTB)
#define PG8_SB(b, h) ((4 + (b) * 2 + (h)) * HTB)
#define PG8_STAGE(bufoff, gbase, voff) do { _Pragma("unroll") for (int _i = 0; _i < 2; ++_i) \
        __builtin_amdgcn_global_load_lds((const unsigned*)((const char*)(gbase) + (voff)[_i]), (PG8_LAS unsigned*)(lds + (bufoff) + ldsw + _i * 8192), 16, 0, 0); } while (0)
#define PG8_STAGE_A0(bufoff, gbase) PG8_STAGE(bufoff, gbase, voffA)
#define PG8_STAGE_A1(bufoff, gbase) do { if constexpr (GATHER) { PG8_STAGE(bufoff, gbase, voffA1); } else { PG8_STAGE(bufoff, (gbase) + hstepA, voffA); } } while (0)
#define PG8_LDA(dst, b, h) do { _Pragma("unroll") for (int m = 0; m < 4; ++m) _Pragma("unroll") for (int k = 0; k < 2; ++k) dst[m][k] = *(const PG8_LAS bf16x8*)(lds + PG8_SA(b, h) + aoff + m * 2048 + k * 1024); } while (0)
#define PG8_LDB(dst, b, h) do { _Pragma("unroll") for (int n = 0; n < 2; ++n) _Pragma("unroll") for (int k = 0; k < 2; ++k) dst[n][k] = *(const PG8_LAS bf16x8*)(lds + PG8_SB(b, h) + boff + n * 2048 + k * 1024); } while (0)
#define PG8_MMA(ai, bj, At, Bt) do { __builtin_amdgcn_s_setprio(1); _Pragma("unroll") for (int m = 0; m < 4; ++m) _Pragma("unroll") for (int n = 0; n < 2; ++n) _Pragma("unroll") for (int k = 0; k < 2; ++k) \
        acc[ai][bj][m][n] = __builtin_amdgcn_mfma_f32_16x16x32_bf16(Bt[n][k], At[m][k], acc[ai][bj][m][n], 0, 0, 0); __builtin_amdgcn_s_setprio(0); } while (0)
#define PG8_WAIT_V(n) asm volatile("s_waitcnt vmcnt(" #n ")" ::: "memory")
#define PG8_WAIT_L(n) asm volatile("s_waitcnt lgkmcnt(" #n ")" ::: "memory")
#define PG8_BAR __builtin_amdgcn_s_barrier()
#define PG8_SCHED __builtin_amdgcn_sched_barrier(0)
    Unit cur, nxt; int ui = 0;
    if (!S.next(0, cur)) return;
    if constexpr (GATHER) {
#pragma unroll
        for (int i = 0; i < 2; ++i) { voffA[i] = (unsigned)(S.a_row(cur, RA[i]) * g.lda + CA[i]) * 2u; voffA1[i] = (unsigned)(S.a_row(cur, HALF + RA[i]) * g.lda + CA[i]) * 2u; }
    }
    f32x4 acc[2][2][4][2];
#pragma unroll
    for (int a = 0; a < 2; ++a)
#pragma unroll
        for (int b = 0; b < 2; ++b)
#pragma unroll
            for (int m = 0; m < 4; ++m)
#pragma unroll
                for (int n = 0; n < 2; ++n) acc[a][b][m][n] = (f32x4){0.f, 0.f, 0.f, 0.f};
    bf16x8 At[4][2], B0[2][2], B1[2][2];
    const char* cA = S.a_base(g, cur); const char* cB = S.b_base(g, cur);
    PG8_STAGE(PG8_SB(0, 0), cB, voffB); PG8_STAGE(PG8_SB(0, 1), cB + hstepB, voffB); PG8_STAGE_A0(PG8_SA(0, 0), cA); PG8_STAGE_A1(PG8_SA(0, 1), cA);
    if (wr == 1) PG8_BAR;
    PG8_WAIT_V(2); PG8_BAR;
    PG8_STAGE(PG8_SB(1, 0), cB + kstep, voffB); PG8_STAGE_A0(PG8_SA(1, 0), cA + kstep); PG8_STAGE(PG8_SB(1, 1), cB + hstepB + kstep, voffB);
    PG8_WAIT_V(6); PG8_BAR;
    for (;;) {
        const bool has_next = GATHER ? false : S.next(ui + 1, nxt);
        const char* nA = has_next ? S.a_base(g, nxt) : cA; const char* nB = has_next ? S.b_base(g, nxt) : cB;
        for (int t = 0; t < nt; t += 2) {
            const bool last = (t == nt - 2);
            const char* a1 = cA + (size_t)(t + 1) * kstep;
            const char* a2 = last ? nA : cA + (size_t)(t + 2) * kstep; const char* b2 = last ? nB : cB + (size_t)(t + 2) * kstep;
            const char* a3 = a2 + kstep; const char* b3 = b2 + kstep;
            PG8_LDB(B0, 0, 0); PG8_LDB(B1, 0, 1); PG8_SCHED; PG8_LDA(At, 0, 0); PG8_STAGE_A1(PG8_SA(1, 1), a1);
            PG8_WAIT_V(8); PG8_WAIT_L(0); PG8_BAR; PG8_MMA(0, 0, At, B0); PG8_MMA(0, 1, At, B1); PG8_BAR; PG8_SCHED;
            PG8_LDA(At, 0, 1); PG8_STAGE(PG8_SB(0, 0), b2, voffB); PG8_STAGE(PG8_SB(0, 1), b2 + hstepB, voffB); PG8_STAGE_A0(PG8_SA(0, 0), a2);
            PG8_WAIT_V(8); PG8_WAIT_L(0); PG8_BAR; PG8_MMA(1, 0, At, B0); PG8_MMA(1, 1, At, B1); PG8_BAR; PG8_SCHED;
            PG8_LDB(B0, 1, 0); PG8_LDB(B1, 1, 1); PG8_SCHED; PG8_LDA(At, 1, 0); PG8_STAGE_A1(PG8_SA(0, 1), a2);
            PG8_WAIT_V(8); PG8_WAIT_L(0); PG8_BAR; PG8_MMA(0, 0, At, B0); PG8_MMA(0, 1, At, B1); PG8_BAR; PG8_SCHED;
            PG8_LDA(At, 1, 1); PG8_STAGE(PG8_SB(1, 0), b3, voffB); PG8_STAGE(PG8_SB(1, 1), b3 + hstepB, voffB); PG8_STAGE_A0(PG8_SA(1, 0), a3);
            PG8_WAIT_V(8); PG8_WAIT_L(0); PG8_BAR; PG8_MMA(1, 0, At, B0); PG8_MMA(1, 1, At, B1); PG8_BAR; PG8_SCHED;
        }
        if constexpr (ALIGN_EPI) { if (wr == 0) PG8_BAR; }
        E(acc, cur, wr, wc, fr, fq);
        if (!has_next) break;
#pragma unroll
        for (int a = 0; a < 2; ++a)
#pragma unroll
            for (int b = 0; b < 2; ++b)
#pragma unroll
                for (int m = 0; m < 4; ++m)
#pragma unroll
                    for (int n = 0; n < 2; ++n) acc[a][b][m][n] = (f32x4){0.f, 0.f, 0.f, 0.f};
        cur = nxt; cA = nA; cB = nB; ++ui;
        if constexpr (ALIGN_EPI) { if (wr == 1) PG8_BAR; }
    }
    PG8_WAIT_V(0);
    if constexpr (!ALIGN_EPI) { if (wr == 0) PG8_BAR; }
    PG8_BAR;
#undef PG8_SA
#undef PG8_SB
#undef PG8_STAGE
#undef PG8_STAGE_A0
#undef PG8_STAGE_A1
#undef PG8_LDA
#undef PG8_LDB
#undef PG8_MMA
#undef PG8_WAIT_V
#undef PG8_WAIT_L
#undef PG8_BAR
#undef PG8_SCHED
}
}
namespace fx {
using nv::u16; using nv::Bufs; using nv::Inputs;
using pg8::f32x4; using pg8::u32x4; using pg8::Unit;
#define LAS __attribute__((address_space(3)))
static_assert(nv::DM == 1024 && nv::NB == 8 && nv::S == 4096 && nv::MH == 256 && nv::PLE == 256, "fast phases are written for the full-size problem");
constexpr int NTOK = nv::NTOK, DM = 1024;
constexpr int INW_PAD = 6144;
constexpr int C_Z = 1280, C_XBC = 2304, C_BG = 3840, C_NG = 5888, C_DT = 5912, C_END = 5928;

struct WBufs { u16 *WinT, *WaT, *WbT, *WoutT, *PleGT, *PlePT, *WguT, *WdT, *PB; };
__host__ __device__ inline size_t carve_w(WBufs& W, unsigned char* ws, size_t off) {
  auto take = [&](size_t bytes) { unsigned char* r = ws + off; off += (bytes + 255) / 256 * 256; return r; };
  W.WinT = (u16*)take((size_t)INW_PAD * 1024 * 2); W.WaT = (u16*)take((size_t)1024 * 512 * 2); W.WbT = (u16*)take((size_t)1024 * 1024 * 2); W.WoutT = (u16*)take((size_t)1024 * 1024 * 2);
  W.PleGT = (u16*)take((size_t)1024 * 1024 * 2); W.PlePT = (u16*)take((size_t)1024 * 256 * 2); W.WguT = (u16*)take((size_t)32 * 512 * 1024 * 2); W.WdT = (u16*)take((size_t)32 * 1024 * 256 * 2);
  W.PB = (u16*)take((size_t)NTOK * 256 * 2);
  return off;
}

__device__ __forceinline__ int otid() { int t = threadIdx.x; asm volatile("" : "+v"(t)); return t; }
__device__ __forceinline__ int obid() { int b = blockIdx.x; asm volatile("" : "+s"(b)); return b; }
__device__ __forceinline__ float fsig(float x) { return __builtin_amdgcn_rcpf(1.0f + __expf(-x)); }
__device__ __forceinline__ float fsoftplus(float x) { const float e = __expf(x); return x > 20.f ? x : (e < 0.0625f ? e * (1.f - e * (0.5f - e * (0.33333333f - 0.25f * e))) : __logf(1.0f + e)); }
__device__ __forceinline__ unsigned pk2(float lo, float hi) { return pg8::cvt_pk_bf16(lo, hi); }
__device__ __forceinline__ void store8(u16* p, const float (&v)[8]) { u32x4 w; w.x = pk2(v[0], v[1]); w.y = pk2(v[2], v[3]); w.z = pk2(v[4], v[5]); w.w = pk2(v[6], v[7]); *(u32x4*)p = w; }
__device__ __forceinline__ void load8(const u16* p, float (&v)[8]) { const u32x4 w = *(const u32x4*)p;
  v[0] = __uint_as_float(w.x << 16); v[1] = __uint_as_float(w.x & 0xffff0000u); v[2] = __uint_as_float(w.y << 16); v[3] = __uint_as_float(w.y & 0xffff0000u);
  v[4] = __uint_as_float(w.z << 16); v[5] = __uint_as_float(w.z & 0xffff0000u); v[6] = __uint_as_float(w.w << 16); v[7] = __uint_as_float(w.w & 0xffff0000u); }

__device__ __forceinline__ float wave_sum(float v) {
#pragma unroll
  for (int o = 1; o < 64; o <<= 1) v += __shfl_xor(v, o);
  return v; }
__device__ __forceinline__ void rms_row_to_bf16(const float* xrow, const float* gain, u16* orow, int lane) {
  const f32x4* xr = (const f32x4*)xrow + lane; const f32x4* gr = (const f32x4*)gain + lane;
  f32x4 v[4]; float s = 0.f;
#pragma unroll
  for (int j = 0; j < 4; ++j) { v[j] = xr[64 * j]; s += (v[j].x * v[j].x + v[j].y * v[j].y) + (v[j].z * v[j].z + v[j].w * v[j].w); }
  const float rs = 1.0f / sqrtf(wave_sum(s) * (1.f / 1024.f) + nv::EPS);
  unsigned long long* o8 = (unsigned long long*)orow + lane;
#pragma unroll
  for (int j = 0; j < 4; ++j) { const f32x4 g = gr[64 * j]; o8[64 * j] = (unsigned long long)pk2(v[j].x * rs * g.x, v[j].y * rs * g.y) | ((unsigned long long)pk2(v[j].z * rs * g.z, v[j].w * rs * g.w) << 32); }
}
__device__ __forceinline__ void phase_rms_rows(const float* x, const float* gain, u16* out) {
  const int tid = otid(), lane = tid & 63, gw = obid() * 8 + (tid >> 6), ngw = gridDim.x * 8;
  for (int r = gw; r < NTOK; r += ngw) rms_row_to_bf16(x + (size_t)r * 1024, gain, out + (size_t)r * 1024, lane);
}
template <class CP> __device__ __forceinline__ void transpose_tile(LAS float* scr, const CP cp, u16* dst, int K, int n0, int k0) {
  const int tid = otid();
  { const int nn = tid & 127; const float* p = cp(n0 + nn);
#pragma unroll
    for (int i = 0; i < 16; ++i) { const int kk = i * 4 + (tid >> 7); scr[nn * 65 + kk] = p ? p[(size_t)(k0 + kk) * cp.ld] : 0.f; } }
  __syncthreads();
#pragma unroll
  for (int h = 0; h < 2; ++h) { const int it = tid + h * 512, nn = it >> 3, kc = it & 7; const LAS float* s = scr + nn * 65 + kc * 8;
    u32x4 o; o.x = pk2(s[0], s[1]); o.y = pk2(s[2], s[3]); o.z = pk2(s[4], s[5]); o.w = pk2(s[6], s[7]);
    *(u32x4*)(dst + (size_t)(n0 + nn) * K + k0 + kc * 8) = o; }
  __syncthreads();
}
struct CpIdent { const float* src; int ld; __device__ const float* operator()(int n) const { return src + n; } };
struct CpInProj { const float* src; int ld; __device__ const float* operator()(int n) const {
  int c; if (n < C_Z) c = n; else if (n < C_XBC) c = nv::O_Z + (n - C_Z); else if (n < C_BG) c = nv::O_XBC + (n - C_XBC); else if (n < C_NG) c = nv::O_BG + (n - C_BG); else if (n < C_DT) c = nv::O_NG + (n - C_NG); else if (n < C_END) c = nv::O_DT + (n - C_DT); else return nullptr;
  return src + c; } };
struct CpGU { const float* gate; long updelta; int ld; __device__ const float* operator()(int n) const { const int tile = n >> 8, r = n & 255; return gate + (r < 128 ? 0L : updelta) + tile * 128 + (r & 127); } };

__device__ __forceinline__ void phase_prologue(LAS unsigned char* lds, const Inputs& I, const Bufs& B, const WBufs& W) {
  LAS float* scr = (LAS float*)lds;
  constexpr int T_IN = (INW_PAD / 128) * 16, T_A = 8 * 8, T_B = 8 * 16, T_O = 8 * 16, T_PG = 8 * 16, T_PP = 8 * 4, T_GU = 32 * 4 * 16, T_D = 32 * 8 * 4;
  constexpr int TOT = T_IN + T_A + T_B + T_O + T_PG + T_PP + T_GU + T_D;
  for (int t = blockIdx.x; t < TOT; t += gridDim.x) { int r = t;
    if (r < T_IN) { CpInProj cp{I.w_in, nv::INW}; transpose_tile(scr, cp, W.WinT, 1024, (r / 16) * 128, (r % 16) * 64); continue; } r -= T_IN;
    if (r < T_A) { CpIdent cp{I.w_a, 1024}; transpose_tile(scr, cp, W.WaT, 512, (r / 8) * 128, (r % 8) * 64); continue; } r -= T_A;
    if (r < T_B) { CpIdent cp{I.w_b, 1024}; transpose_tile(scr, cp, W.WbT, 1024, (r / 16) * 128, (r % 16) * 64); continue; } r -= T_B;
    if (r < T_O) { CpIdent cp{I.w_out, 1024}; transpose_tile(scr, cp, W.WoutT, 1024, (r / 16) * 128, (r % 16) * 64); continue; } r -= T_O;
    if (r < T_PG) { CpIdent cp{I.ple_wg, 1024}; transpose_tile(scr, cp, W.PleGT, 1024, (r / 16) * 128, (r % 16) * 64); continue; } r -= T_PG;
    if (r < T_PP) { CpIdent cp{I.ple_wp, 1024}; transpose_tile(scr, cp, W.PlePT, 256, (r / 4) * 128, (r % 4) * 64); continue; } r -= T_PP;
    if (r < T_GU) { const int e = r / 64, q = r % 64; CpGU cp{I.w_gate + (size_t)e * 1024 * 256, (long)(I.w_up - I.w_gate), 256}; transpose_tile(scr, cp, W.WguT + (size_t)e * 512 * 1024, 1024, (q / 16) * 128, (q % 16) * 64); continue; } r -= T_GU;
    { const int e = r / 32, q = r % 32; CpIdent cp{I.w_down + (size_t)e * 256 * 1024, 1024}; transpose_tile(scr, cp, W.WdT + (size_t)e * 1024 * 256, 256, (q / 4) * 128, (q % 4) * 64); }
  }
  phase_rms_rows(I.x, I.mix_norm, B.HB);
  for (long i = blockIdx.x * 512L + otid(); i < (long)NTOK * 256 / 8; i += (long)gridDim.x * 512L) { const f32x4 a = ((const f32x4*)I.p)[2 * i], b = ((const f32x4*)I.p)[2 * i + 1];
    u32x4 o; o.x = pk2(a.x, a.y); o.y = pk2(a.z, a.w); o.z = pk2(b.x, b.y); o.w = pk2(b.z, b.w); ((u32x4*)W.PB)[i] = o; }
}

template <class F> struct Epi8 { static constexpr bool PERM = true; F f;
  __device__ __forceinline__ void operator()(const f32x4 (&acc)[2][2][4][2], const Unit& u, int wr, int wc, int fr, int fq) const {
#pragma unroll
    for (int ai = 0; ai < 2; ++ai)
#pragma unroll
      for (int m = 0; m < 4; ++m) { const int row = u.pm * 256 + ai * 128 + wr * 64 + m * 16 + fr;
#pragma unroll
        for (int bj = 0; bj < 2; ++bj) { const int col = u.pn * 256 + bj * 128 + wc * 32 + 8 * fq; const f32x4 a = acc[ai][bj][m][0], b = acc[ai][bj][m][1];
          const float v[8] = {a.x, a.y, a.z, a.w, b.x, b.y, b.z, b.w}; f(u, row, col, v); }
        if (m & 1) asm volatile("" ::: "memory"); } } };

struct FInProj { u16* QKV; u16* Z; u16* XBC; u16* BG; float* NG; float* DT; const float* dt_bias;
  __device__ __forceinline__ void operator()(const Unit&, int r, int c, const float (&v)[8]) const {
    if (c < C_Z) store8(QKV + (size_t)r * 1280 + c, v);
    else if (c < C_XBC) store8(Z + (size_t)r * 1024 + (c - C_Z), v);
    else if (c < C_BG) store8(XBC + (size_t)r * 1536 + (c - C_XBC), v);
    else if (c < C_NG) { float s[8];
#pragma unroll
      for (int i = 0; i < 8; ++i) s[i] = fsig(v[i]);
      store8(BG + (size_t)r * 2048 + (c - C_BG), s); }
    else if (c < C_DT) { float* o = NG + (size_t)r * 24 + (c - C_NG);
#pragma unroll
      for (int i = 0; i < 8; ++i) o[i] = fsig(v[i]); }
    else if (c < C_END) { float* o = DT + (size_t)r * 16 + (c - C_DT); const float* bi = dt_bias + (c - C_DT);
#pragma unroll
      for (int i = 0; i < 8; ++i) o[i] = fsoftplus(v[i] + bi[i]); } } };
struct FStoreBf { u16* o; int ld; __device__ __forceinline__ void operator()(const Unit&, int r, int c, const float (&v)[8]) const { store8(o + (size_t)r * ld + c, v); } };
struct FMerge { const u16* t1; const u16* bg; u16* o;
  __device__ __forceinline__ void operator()(const Unit&, int r, int c, const float (&v)[8]) const { float t[8], ga[8], gb[8], m[8]; load8(t1 + (size_t)r * 1024 + c, t); load8(bg + (size_t)r * 2048 + c, ga); load8(bg + (size_t)r * 2048 + 1024 + c, gb);
#pragma unroll
    for (int i = 0; i < 8; ++i) m[i] = ga[i] * t[i] + gb[i] * v[i];
    store8(o + (size_t)r * 1024 + c, m); } };
struct FResid { const float* x; float* o;
  __device__ __forceinline__ void operator()(const Unit&, int r, int c, const float (&v)[8]) const { const f32x4 a = *(const f32x4*)(x + (size_t)r * 1024 + c), b = *(const f32x4*)(x + (size_t)r * 1024 + c + 4);
    *(f32x4*)(o + (size_t)r * 1024 + c) = (f32x4){a.x + v[0], a.y + v[1], a.z + v[2], a.w + v[3]}; *(f32x4*)(o + (size_t)r * 1024 + c + 4) = (f32x4){b.x + v[4], b.y + v[5], b.z + v[6], b.w + v[7]}; } };
struct FPle { float* x; const u16* pp;
  __device__ __forceinline__ void operator()(const Unit&, int r, int c, const float (&v)[8]) const { float p[8]; load8(pp + (size_t)r * 1024 + c, p); float* xp = x + (size_t)r * 1024 + c; const f32x4 a = *(const f32x4*)xp, b = *(const f32x4*)(xp + 4);
    *(f32x4*)xp = (f32x4){a.x + fsig(v[0]) * p[0], a.y + fsig(v[1]) * p[1], a.z + fsig(v[2]) * p[2], a.w + fsig(v[3]) * p[3]};
    *(f32x4*)(xp + 4) = (f32x4){b.x + fsig(v[4]) * p[4], b.y + fsig(v[5]) * p[5], b.z + fsig(v[6]) * p[6], b.w + fsig(v[7]) * p[7]}; } };

template <class F> __device__ __forceinline__ void dense_gemm(LAS unsigned char* lds, const u16* A, int lda, const u16* Bt, int ldb, int M, int N, int K, const F& f) {
  pg8::Gemm g{A, Bt, M, N, K, lda, ldb}; pg8::StaticOrder S; S.init(M, N, (int)gridDim.x, (int)blockIdx.x); Epi8<F> E{f};
  pg8::gemm_phase<Epi8<F>, pg8::StaticOrder, true, false>(lds, g, S, E);
}
}
namespace fx {
constexpr int LIST_CAP = 32768;
constexpr int LDS_TAB = 131072;
struct MoeBufs { float* LOGITS; int* CNT; int* LIST; u16* MOEOUT; u16* WrT; };
__host__ __device__ inline size_t carve_moe(MoeBufs& M, const Bufs& B, unsigned char* ws, size_t off) {
  auto take = [&](size_t bytes) { unsigned char* r = ws + off; off += (bytes + 255) / 256 * 256; return r; };
  M.LOGITS = (float*)take((size_t)NTOK * 64 * 4); M.CNT = (int*)take(256); M.LIST = (int*)take((size_t)32 * LIST_CAP * 4); M.WrT = (u16*)take((size_t)256 * 1024 * 2);
  M.MOEOUT = B.QKV;
  return off;
}
__device__ __forceinline__ void prologue_moe(const Inputs& I, const MoeBufs& M) {
  for (long i = blockIdx.x * 512L + otid(); i < 256L * 1024; i += (long)gridDim.x * 512L) { const int n = (int)(i >> 10), k = (int)(i & 1023);
    float v = 0.f; if (n < 4) v = I.w_group[k * 4 + n]; else if (n < 36) v = I.w_expert[k * 32 + (n - 4)];
    M.WrT[i] = nv::f2bf(v); }
  if (blockIdx.x == 0 && threadIdx.x < 64) M.CNT[threadIdx.x] = 0;
}
struct FLogits { float* o; __device__ __forceinline__ void operator()(const Unit&, int r, int c, const float (&v)[8]) const { if (c < 40) { *(f32x4*)(o + (size_t)r * 64 + c) = (f32x4){v[0], v[1], v[2], v[3]}; *(f32x4*)(o + (size_t)r * 64 + c + 4) = (f32x4){v[4], v[5], v[6], v[7]}; } } };
__device__ __forceinline__ void phase_route(const Inputs& I, const Bufs& B, const MoeBufs& M) {
  for (int tok = blockIdx.x * 512 + otid(); tok < NTOK; tok += gridDim.x * 512) { const float* lg = M.LOGITS + (size_t)tok * 64;
    const f32x4 g4 = *(const f32x4*)lg; const float g0 = g4.x + I.b_group[0], g1 = g4.y + I.b_group[1], g2 = g4.z + I.b_group[2], g3 = g4.w + I.b_group[3];
    int gi = 0; float gm = g0; if (g1 > gm) { gm = g1; gi = 1; } if (g2 > gm) { gm = g2; gi = 2; } if (g3 > gm) { gm = g3; gi = 3; }
    const float grp_w = 1.0f / (expf(g0 - gm) + expf(g1 - gm) + expf(g2 - gm) + expf(g3 - gm));
    const f32x4 ea = *(const f32x4*)(lg + 4 + gi * 8), eb = *(const f32x4*)(lg + 8 + gi * 8); const f32x4 ba = *(const f32x4*)(I.b_expert + gi * 8), bb = *(const f32x4*)(I.b_expert + gi * 8 + 4);
    const float el[8] = {ea.x + ba.x, ea.y + ba.y, ea.z + ba.z, ea.w + ba.w, eb.x + bb.x, eb.y + bb.y, eb.z + bb.z, eb.w + bb.w};
    int i0 = 0; float m0 = el[0];
#pragma unroll
    for (int j = 1; j < 8; ++j) if (el[j] > m0) { m0 = el[j]; i0 = j; }
    int i1 = -1; float m1 = -3.0e38f;
#pragma unroll
    for (int j = 0; j < 8; ++j) if (j != i0 && el[j] > m1) { m1 = el[j]; i1 = j; }
    const float r = expf(m1 - m0); const float w0 = grp_w / (1.0f + r), w1 = grp_w * r / (1.0f + r);
    const int e0 = gi * 8 + i0, e1 = gi * 8 + i1;
    const int p0 = atomicAdd(&M.CNT[e0], 1), p1 = atomicAdd(&M.CNT[e1], 1);
    M.LIST[e0 * LIST_CAP + p0] = tok * 2; M.LIST[e1 * LIST_CAP + p1] = tok * 2 + 1; B.EW[tok * 2] = w0; B.EW[tok * 2 + 1] = w1; }
}
__device__ __forceinline__ void build_tile_table(LAS unsigned char* lds, const MoeBufs& M) {
  LAS int* tab = (LAS int*)(lds + LDS_TAB);
  if (threadIdx.x == 0) { int acc = 0; for (int e = 0; e < 32; ++e) { tab[e] = acc; acc += (M.CNT[e] + 255) >> 8; } tab[32] = acc; }
  __syncthreads();
}
__device__ __forceinline__ int tile_expert(const LAS int* tab, int tile) { int e = 0;
#pragma unroll 1
  for (int j = 1; j < 32; ++j) if (tab[j] <= tile) e = j;
  return e; }

struct SchedGU { const int* list; int tile, ct, lbase, nvalid, e;
  __device__ bool next(int i, Unit& u) const { if (i > 0) return false; u.pm = tile; u.pn = ct; u.aux0 = lbase; u.aux1 = nvalid; return true; }
  __device__ __forceinline__ const char* a_base(const pg8::Gemm& g, const Unit&) const { return (const char*)g.A; }
  __device__ __forceinline__ const char* b_base(const pg8::Gemm& g, const Unit&) const { return (const char*)g.Bt + ((size_t)e * 512 + (size_t)ct * 256) * 1024 * 2; }
  __device__ __forceinline__ int a_row(const Unit&, int r) const { return r < nvalid ? (list[lbase + r] >> 1) : 0; } };
struct EpiGU { static constexpr bool PERM = true; u16* act;
  __device__ __forceinline__ void operator()(const f32x4 (&acc)[2][2][4][2], const Unit& u, int wr, int wc, int fr, int fq) const {
#pragma unroll
    for (int ai = 0; ai < 2; ++ai)
#pragma unroll
      for (int m = 0; m < 4; ++m) { const int r = ai * 128 + wr * 64 + m * 16 + fr; const f32x4 g0 = acc[ai][0][m][0], g1 = acc[ai][0][m][1], u0 = acc[ai][1][m][0], u1 = acc[ai][1][m][1];
        const float a[8] = {g0.x * fsig(g0.x) * u0.x, g0.y * fsig(g0.y) * u0.y, g0.z * fsig(g0.z) * u0.z, g0.w * fsig(g0.w) * u0.w, g1.x * fsig(g1.x) * u1.x, g1.y * fsig(g1.y) * u1.y, g1.z * fsig(g1.z) * u1.z, g1.w * fsig(g1.w) * u1.w};
        store8(act + ((size_t)u.pm * 256 + r) * 256 + u.pn * 128 + wc * 32 + 8 * fq, a); } } };
__device__ __forceinline__ void phase_moe_gu(LAS unsigned char* lds, const Bufs& B, const WBufs& W, const MoeBufs& M) {
  const LAS int* tab = (const LAS int*)(lds + LDS_TAB); const int T = tab[32];
  for (int L = blockIdx.x; L < T * 2; L += gridDim.x) { const int tile = L >> 1, ct = L & 1, e = __builtin_amdgcn_readfirstlane(tile_expert(tab, tile)), rt = tile - __builtin_amdgcn_readfirstlane(tab[e]); int nvalid = __builtin_amdgcn_readfirstlane(M.CNT[e]) - rt * 256; nvalid = nvalid > 256 ? 256 : nvalid;
    pg8::Gemm g{B.H2, W.WguT, 256, 256, 1024, 1024, 1024}; SchedGU S{M.LIST, tile, ct, e * LIST_CAP + rt * 256, nvalid, e}; EpiGU E{B.ACT};
    pg8::gemm_phase<EpiGU, SchedGU, true, true>(lds, g, S, E); }
}
struct SchedD { const LAS int* tab; const int* cnt; int T4, G, c;
  __device__ bool next(int i, Unit& u) const { const int L = i * G + c; if (L >= T4) return false; const int tile = L >> 2, e = __builtin_amdgcn_readfirstlane(tile_expert(tab, tile)), rt = tile - __builtin_amdgcn_readfirstlane(tab[e]); int nvalid = __builtin_amdgcn_readfirstlane(cnt[e]) - rt * 256; nvalid = nvalid > 256 ? 256 : nvalid;
    u.pm = tile; u.pn = L & 3; u.aux0 = e * LIST_CAP + rt * 256; u.aux1 = nvalid; return true; }
  __device__ __forceinline__ const char* a_base(const pg8::Gemm& g, const Unit& u) const { return (const char*)g.A + (size_t)u.pm * 256 * 256 * 2; }
  __device__ __forceinline__ const char* b_base(const pg8::Gemm& g, const Unit& u) const { return (const char*)g.Bt + ((size_t)(u.aux0 >> 15) * 1024 + (size_t)u.pn * 256) * 256 * 2; }
  __device__ __forceinline__ int a_row(const Unit&, int) const { return 0; } };
struct FDown { const int* list; const float* ew; u16* o;
  __device__ __forceinline__ void operator()(const Unit& u, int row, int c, const float (&v)[8]) const { const int r = row - u.pm * 256; if (r < u.aux1) { const int asg = list[u.aux0 + r]; const float w = ew[asg];
      const float y[8] = {v[0] * w, v[1] * w, v[2] * w, v[3] * w, v[4] * w, v[5] * w, v[6] * w, v[7] * w}; store8(o + (size_t)asg * 1024 + c, y); } } };
__device__ __forceinline__ void phase_moe_down(LAS unsigned char* lds, const Bufs& B, const WBufs& W, const MoeBufs& M) {
  const LAS int* tab = (const LAS int*)(lds + LDS_TAB);
  pg8::Gemm g{B.ACT, W.WdT, 256, 1024, 256, 256, 256}; SchedD S{tab, M.CNT, tab[32] * 4, (int)gridDim.x, (int)blockIdx.x}; Epi8<FDown> E{FDown{M.LIST, B.EW, M.MOEOUT}};
  pg8::gemm_phase<Epi8<FDown>, SchedD, true, false>(lds, g, S, E);
}
__device__ __forceinline__ void phase_moe_combine(float* out, const u16* moeout, const float* gain, u16* hout) {
  const int tid = otid(), lane = tid & 63, gw = obid() * 8 + (tid >> 6), ngw = gridDim.x * 8;
  for (int tok = gw; tok < NTOK; tok += ngw) { f32x4* xr = (f32x4*)(out + (size_t)tok * 1024) + lane; const pg8::u32x2* o0 = (const pg8::u32x2*)(moeout + (size_t)tok * 2048) + lane; const pg8::u32x2* o1 = o0 + 256;
    const f32x4* gr = (const f32x4*)gain + lane; f32x4 v[4]; float s = 0.f;
#pragma unroll
    for (int j = 0; j < 4; ++j) { const f32x4 x = xr[64 * j]; const pg8::u32x2 a = o0[64 * j], b = o1[64 * j];
      v[j].x = x.x + __uint_as_float(a.x << 16) + __uint_as_float(b.x << 16); v[j].y = x.y + __uint_as_float(a.x & 0xffff0000u) + __uint_as_float(b.x & 0xffff0000u);
      v[j].z = x.z + __uint_as_float(a.y << 16) + __uint_as_float(b.y << 16); v[j].w = x.w + __uint_as_float(a.y & 0xffff0000u) + __uint_as_float(b.y & 0xffff0000u);
      xr[64 * j] = v[j]; s += (v[j].x * v[j].x + v[j].y * v[j].y) + (v[j].z * v[j].z + v[j].w * v[j].w); }
    const float rs = 1.0f / sqrtf(wave_sum(s) * (1.f / 1024.f) + nv::EPS);
    unsigned long long* o8 = (unsigned long long*)(hout + (size_t)tok * 1024) + lane;
#pragma unroll
    for (int j = 0; j < 4; ++j) { const f32x4 g = gr[64 * j]; o8[64 * j] = (unsigned long long)pk2(v[j].x * rs * g.x, v[j].y * rs * g.y) | ((unsigned long long)pk2(v[j].z * rs * g.z, v[j].w * rs * g.w) << 32); } }
}
}
struct Params { nv::Inputs I; float* out; unsigned char* ws; };
constexpr int LDS_BYTES = 147456;
template <class F> __device__ __forceinline__ void run_phase(const F& f, long n) {
  for (long i = blockIdx.x * 512L + fx::otid(); i < n; i += (long)gridDim.x * 512L) f(i);
}
__global__ void __launch_bounds__(512) mega_fwd(Params P) {
  extern __shared__ __attribute__((aligned(16))) unsigned char lds_raw[];
  LAS unsigned char* lds = (LAS unsigned char*)lds_raw;
  cg::grid_group grid = cg::this_grid();
  nv::Bufs B; const size_t woff = nv::carve(B, P.ws, P.out); fx::WBufs W; const size_t moff = fx::carve_w(W, P.ws, woff); fx::MoeBufs M; fx::carve_moe(M, B, P.ws, moff);
  float* out = P.out;
#define RUN(f, n) { run_phase(f, n); grid.sync(); }
  fx::phase_prologue(lds, P.I, B, W); fx::prologue_moe(P.I, M); grid.sync();
  fx::dense_gemm(lds, B.HB, 1024, W.WinT, 1024, nv::NTOK, fx::INW_PAD, 1024, fx::FInProj{B.QKV, B.Z, B.XBC, B.BG, B.NG, B.DT, P.I.dt_bias}); grid.sync();
  NV2_STAGE_QKNORM(RUN, P.I, B, out)
  NV2_STAGE_COMPRESS(RUN, P.I, B, out)
  NV2_STAGE_ATTN(RUN, P.I, B, out)
  NV2_STAGE_SSD(RUN, P.I, B, out)
  fx::dense_gemm(lds, B.YA, 512, W.WaT, 512, nv::NTOK, 1024, 512, fx::FStoreBf{B.T1, 1024});
  fx::dense_gemm(lds, B.YB, 1024, W.WbT, 1024, nv::NTOK, 1024, 1024, fx::FMerge{B.T1, B.BG, B.MERGED}); grid.sync();
  fx::dense_gemm(lds, B.MERGED, 1024, W.WoutT, 1024, nv::NTOK, 1024, 1024, fx::FResid{P.I.x, out}); grid.sync();
  fx::phase_rms_rows(out, P.I.moe_norm, B.H2); grid.sync();
  fx::dense_gemm(lds, B.H2, 1024, M.WrT, 1024, nv::NTOK, 256, 1024, fx::FLogits{M.LOGITS}); grid.sync();
  fx::phase_route(P.I, B, M); grid.sync();
  fx::build_tile_table(lds, M);
  fx::phase_moe_gu(lds, B, W, M); grid.sync();
  fx::phase_moe_down(lds, B, W, M); grid.sync();
  fx::phase_moe_combine(out, M.MOEOUT, P.I.ple_norm, B.H2); grid.sync();
  fx::dense_gemm(lds, W.PB, 256, W.PlePT, 256, nv::NTOK, 1024, 256, fx::FStoreBf{B.PP, 1024});
  fx::dense_gemm(lds, B.H2, 1024, W.PleGT, 1024, nv::NTOK, 1024, 1024, fx::FPle{out, B.PP});
#undef RUN
}
extern "C" void kernel_launch(void* const* d_in, const int* in_sizes, int n_in, void* d_out, int out_size, void* d_ws, size_t ws_size, hipStream_t stream) {
  static int grid_blocks = 0;
  if (!grid_blocks) {
    int dev = 0, cus = 0, per_cu = 0;
    (void)hipGetDevice(&dev);
    (void)hipDeviceGetAttribute(&cus, hipDeviceAttributeMultiprocessorCount, dev);
    if (hipFuncSetAttribute((const void*)mega_fwd, hipFuncAttributeMaxDynamicSharedMemorySize, LDS_BYTES) != hipSuccess) fprintf(stderr, "kernel_launch: hipFuncSetAttribute failed\n");
    if (hipOccupancyMaxActiveBlocksPerMultiprocessor(&per_cu, mega_fwd, 512, LDS_BYTES) != hipSuccess || per_cu < 1) { fprintf(stderr, "kernel_launch: occupancy query says %d blocks per CU\n", per_cu); }
    grid_blocks = cus;
    { nv::Bufs B; fx::WBufs W; fx::MoeBufs M; size_t need = fx::carve_moe(M, B, nullptr, fx::carve_w(W, nullptr, nv::carve(B, nullptr, nullptr))); if (need > ws_size) fprintf(stderr, "kernel_launch: workspace too small: need %zu have %zu\n", need, ws_size); }
  }
  Params p; memset(&p, 0, sizeof(p));
  const float** ip = (const float**)&p.I; for (int i = 0; i < 34; ++i) ip[i] = (const float*)d_in[i];
  p.out = (float*)d_out; p.ws = (unsigned char*)d_ws;
  void* args[] = {&p};
  hipError_t e = hipLaunchCooperativeKernel((void*)mega_fwd, dim3(grid_blocks), dim3(512), args, LDS_BYTES, stream);
  if (e != hipSuccess) fprintf(stderr, "cooperative launch failed: %s (grid %d)\n", hipGetErrorString(e), grid_blocks);
}
```

```cpp
#include <hip/hip_runtime.h>
#include <hip/hip_cooperative_groups.h>
#include <cstdio>
#include <cstring>
namespace cg = cooperative_groups;
#define HD __host__ __device__ inline
#if defined(__HIP_DEVICE_COMPILE__)
#define NV_FENCE() asm volatile("" ::: "memory")
#else
#define NV_FENCE()
#endif
#ifndef CFG_DM
#define CFG_DM 1024
#endif
#ifndef CFG_BATCH
#define CFG_BATCH 8
#endif
#ifndef CFG_SEQ
#define CFG_SEQ 4096
#endif
#ifndef CFG_MH
#define CFG_MH 256
#endif
#ifndef CFG_PLE
#define CFG_PLE 256
#endif

#ifndef NV_FENCE
#define NV_FENCE()
#endif
namespace nv {
typedef unsigned short u16;
typedef unsigned long long u64;
constexpr int DM = CFG_DM, NB = CFG_BATCH, S = CFG_SEQ, MH = CFG_MH, PLE = CFG_PLE;
constexpr int NTOK = NB * S;
constexpr int H = 8, G = 2, E = 4;
constexpr int QW = 512, GW = 24, QKVW = 1280;
constexpr int SH = 16, SP = 64, SI = 1024, SG = 2, SN = 128, SCD = 1536;
constexpr int INW = QW + 6 * 128 + GW + SI + SCD + SH + 2 * DM;
constexpr int O_Q = 0, O_KC = 512, O_VC = 640, O_KS = 768, O_VS = 896, O_KW = 1024, O_VW = 1152, O_NG = 1280, O_Z = 1304, O_XBC = 2328, O_DT = 3864, O_BG = 3880;
static_assert(O_BG + 2 * DM == INW, "in-proj width");
constexpr int NCMP = S / 16 - 1, NCP = S / 16, NSEL = S / 64, NTOP = NSEL < 16 ? NSEL : 16;
constexpr int NEXP = 32;
constexpr float EPS = 1e-6f;

HD float sigmoidf_(float x) { return 1.0f / (1.0f + expf(-x)); }
HD float siluf_(float x) { return x / (1.0f + expf(-x)); }
HD float softplusf_(float x) { return x > 20.f ? x : log1pf(expf(x)); }
HD u16 f2bf(float f) { unsigned u = __builtin_bit_cast(unsigned, f); u += 0x7fffu + ((u >> 16) & 1u); return (u16)(u >> 16); }
HD float bf2f(u16 h) { return __builtin_bit_cast(float, (unsigned)h << 16); }

struct Bufs {
  u16* HB;
  u16* QKV;
  float* NG;
  u16* Z;
  u16* XBC;
  float* DT;
  u16* BG;
  u16* KCMP;
  u16* VCMP;
  u16* YA;
  u16* YB;
  u16* T1;
  u16* MERGED;
  u16* H2;
  u16* ACT;
  u16* PP;
  int* EI;
  float* EW;
  float* HID;
  float* KTMP;
  float* ML;
  float* IMP;
  u64* MASK;
};
struct Inputs { const float *x, *p, *mix_norm, *w_in, *q_gain, *kc_gain, *ks_gain, *kw_gain, *pos_k, *w1_k, *w2_k, *pos_v, *w1_v, *w2_v, *conv_w, *conv_b, *dt_bias, *a_log, *d_skip, *ssm_norm,
  *w_a, *w_b, *w_out, *moe_norm, *w_group, *b_group, *w_expert, *b_expert, *w_gate, *w_up, *w_down, *ple_norm, *ple_wg, *ple_wp; };

struct RmsRowsBf { const float* in; const float* gain; u16* out; long ncols;
  HD void operator()(long r) const { const float* x = in + r * ncols; float s = 0.f; for (long c = 0; c < ncols; ++c) s += x[c] * x[c];
    const float rs = 1.0f / sqrtf(s / (float)ncols + EPS); u16* o = out + r * ncols; for (long c = 0; c < ncols; ++c) o[c] = f2bf(x[c] * rs * gain[c]); } };

template <class AL, class EP> struct GemmT { AL a; const float* B; EP ep; long M, N, K, ldb;
  HD long items() const { return ((M + 7) / 8) * ((N + 3) / 4); }
  HD void operator()(long it) const { const long nt = (N + 3) / 4; const long tm = it / nt, tn = it % nt; const long r0 = tm * 8, c0 = tn * 4;
    float acc[8][4];
#pragma unroll
    for (int i = 0; i < 8; ++i)
#pragma unroll
      for (int j = 0; j < 4; ++j) acc[i][j] = 0.f;
    for (long k = 0; k < K; ++k) { float b[4];
#pragma unroll
      for (int j = 0; j < 4; ++j) b[j] = (c0 + j < N) ? B[k * ldb + c0 + j] : 0.f;
#pragma unroll
      for (int i = 0; i < 8; ++i) { const long r = r0 + i < M ? r0 + i : M - 1; const float av = a(r, k);
#pragma unroll
        for (int j = 0; j < 4; ++j) acc[i][j] += av * b[j]; } }
#pragma unroll
    for (int i = 0; i < 8; ++i) if (r0 + i < M) {
#pragma unroll
      for (int j = 0; j < 4; ++j) if (c0 + j < N) ep(r0 + i, c0 + j, acc[i][j]); } } };
struct ABf { const u16* p; long ld; HD float operator()(long r, long k) const { return bf2f(p[r * ld + k]); } };
struct AF32 { const float* p; long ld; HD float operator()(long r, long k) const { return p[r * ld + k]; } };
struct ACmp { const u16* qkv; const float* pos; long off;
  HD float operator()(long r, long k) const { const long c = r % NCMP, bg = r / NCMP, b = bg / G, g = bg % G; const long l = k / 64, d = k % 64;
    return bf2f(qkv[(b * S + 16 * c + l) * QKVW + off + g * 64 + d]) + pos[k]; } };

struct EpInProj { Bufs B; const float* dt_bias;
  HD void operator()(long r, long c, float v) const {
    if (c < O_NG) B.QKV[r * QKVW + c] = f2bf(v);
    else if (c < O_Z) B.NG[r * GW + (c - O_NG)] = sigmoidf_(v);
    else if (c < O_XBC) B.Z[r * SI + (c - O_Z)] = f2bf(v);
    else if (c < O_DT) B.XBC[r * SCD + (c - O_XBC)] = f2bf(v);
    else if (c < O_BG) B.DT[r * SH + (c - O_DT)] = softplusf_(v + dt_bias[c - O_DT]);
    else B.BG[r * (2 * DM) + (c - O_BG)] = f2bf(sigmoidf_(v)); } };
struct EpSiluF32 { float* o; long ld; HD void operator()(long r, long c, float v) const { o[r * ld + c] = siluf_(v); } };
struct EpF32 { float* o; long ld; HD void operator()(long r, long c, float v) const { o[r * ld + c] = v; } };
struct EpBf { u16* o; long ld; HD void operator()(long r, long c, float v) const { o[r * ld + c] = f2bf(v); } };
struct EpMerge { const u16* t1; const u16* bg; u16* o; HD void operator()(long r, long c, float v) const { const float ga = bf2f(bg[r * (2 * DM) + c]), gb = bf2f(bg[r * (2 * DM) + DM + c]); o[r * DM + c] = f2bf(ga * bf2f(t1[r * DM + c]) + gb * v); } };
struct EpResid { const float* x; float* o; HD void operator()(long r, long c, float v) const { o[r * DM + c] = x[r * DM + c] + v; } };
struct EpPle { float* x; const u16* pp; HD void operator()(long r, long c, float v) const { x[r * DM + c] = x[r * DM + c] + sigmoidf_(v) * bf2f(pp[r * DM + c]); } };

struct QkNorm { u16* qkv; const float* qg; const float* ksg; const float* kwg;
  HD long items() const { return (long)NTOK * 12; }
  HD void operator()(long it) const { const long tok = it / 12; const int w = (int)(it % 12); u16* v; const float* gain;
    if (w < 8) { v = qkv + tok * QKVW + O_Q + w * 64; gain = qg; } else if (w < 10) { v = qkv + tok * QKVW + O_KS + (w - 8) * 64; gain = ksg; } else { v = qkv + tok * QKVW + O_KW + (w - 10) * 64; gain = kwg; }
    float s = 0.f; for (int d = 0; d < 64; ++d) { const float x = bf2f(v[d]); s += x * x; } const float rs = 1.0f / sqrtf(s / 64.f + EPS);
    for (int d = 0; d < 64; ++d) v[d] = f2bf(bf2f(v[d]) * rs * gain[d]); } };
struct CmpFinish { const float* src; const float* gain; u16* dst; long donorm;
  HD long items() const { return (long)NB * G * NCP; }
  HD void operator()(long it) const { const long c = it % NCP, bg = it / NCP; u16* o = dst + it * 64;
    if (c >= NCMP) { for (int d = 0; d < 64; ++d) o[d] = 0; return; }
    const float* x = src + (bg * NCMP + c) * 64; float rs = 1.f;
    if (donorm) { float s = 0.f; for (int d = 0; d < 64; ++d) s += x[d] * x[d]; rs = 1.0f / sqrtf(s / 64.f + EPS); }
    for (int d = 0; d < 64; ++d) o[d] = f2bf(donorm ? x[d] * rs * gain[d] : x[d]); } };

struct CmpAttn { Bufs B;
  HD long items() const { return (long)NB * H * S; }
  HD void operator()(long it) const { const long t = it % S; const int h = (int)((it / S) % H), g = h / E; const long b = it / ((long)S * H); const long tok = b * S + t;
    const u16* q = B.QKV + tok * QKVW + O_Q + h * 64; const u16* kc = B.KCMP + (b * G + g) * (long)NCP * 64; const u16* vc = B.VCMP + (b * G + g) * (long)NCP * 64;
    float qr[64];
#pragma unroll
    for (int d = 0; d < 64; ++d) qr[d] = bf2f(q[d]);
    long nvis = (t - 31 >= 0) ? (t - 31) / 16 + 1 : 0; if (nvis > NCMP) nvis = NCMP;
    float m = -3.0e38f;
    for (long c = 0; c < nvis; ++c) { const u16* k = kc + c * 64; float s = 0.f;
#pragma unroll
      for (int d = 0; d < 64; ++d) s += qr[d] * bf2f(k[d]);
      s *= 0.125f; m = s > m ? s : m; }
    float o[64];
#pragma unroll
    for (int d = 0; d < 64; ++d) o[d] = 0.f;
    float l = 0.f;
    for (long c = 0; c < nvis; ++c) { const u16* k = kc + c * 64; const u16* v = vc + c * 64; float s = 0.f;
#pragma unroll
      for (int d = 0; d < 64; ++d) s += qr[d] * bf2f(k[d]);
      const float p = expf(s * 0.125f - m); l += p;
#pragma unroll
      for (int d = 0; d < 64; ++d) o[d] += p * bf2f(v[d]); }
    const float g0 = B.NG[tok * GW + h * 3 + 0]; const float inv = nvis > 0 ? g0 / l : 0.f;
#pragma unroll
    for (int d = 0; d < 64; ++d) B.YA[tok * QW + h * 64 + d] = f2bf(o[d] * inv);
    B.ML[it * 2] = m; B.ML[it * 2 + 1] = nvis > 0 ? l : 0.f; } };
struct Importance { Bufs B;
  HD long items() const { return (long)NB * G * S * NSEL; }
  HD void operator()(long it) const { const int j = (int)(it % NSEL); const long bgt = it / NSEL; const long t = bgt % S; const long bg = bgt / S; const long b = bg / G; const int g = (int)(bg % G); const long tok = b * S + t;
    long nvis = (t - 31 >= 0) ? (t - 31) / 16 + 1 : 0; if (nvis > NCMP) nvis = NCMP;
    long c0 = 4 * j - 1; if (c0 < 0) c0 = 0; long c1 = 4 * j + 3; if (c1 > nvis - 1) c1 = nvis - 1;
    const u16* kc = B.KCMP + bg * (long)NCP * 64; float acc = 0.f;
    for (int e = 0; e < E; ++e) { const int h = g * E + e; const u16* q = B.QKV + tok * QKVW + O_Q + h * 64; const long mi = ((b * H + h) * (long)S + t) * 2; const float m = B.ML[mi], l = B.ML[mi + 1];
      if (l > 0.f) for (long c = c0; c <= c1; ++c) { const u16* k = kc + c * 64; float s = 0.f; for (int d = 0; d < 64; ++d) s += bf2f(q[d]) * bf2f(k[d]); acc += expf(s * 0.125f - m) / l; } }
    B.IMP[bgt * 64 + j] = acc; } };
struct TopSel { Bufs B;
  HD long items() const { return (long)NB * G * S; }
  HD void operator()(long bgt) const { const long t = bgt % S; const int cur = (int)(t / 64); u64 m = 0ull;
    for (int r = 0; r < NTOP; ++r) { float best = -3.0e38f; int bj = -1;
      for (int j = 0; j <= cur && j < NSEL; ++j) { if ((m >> j) & 1ull) continue; float v = B.IMP[bgt * 64 + j]; if (j == 0 || j == cur || j == cur - 1) v += 1000.f; if (v > best) { best = v; bj = j; } }
      if (bj < 0) break; m |= 1ull << bj; }
    B.MASK[bgt] = m; } };
struct SelAttn { Bufs B;
  HD long items() const { return (long)NB * H * S; }
  HD void operator()(long it) const { const long t = it % S; const int h = (int)((it / S) % H), g = h / E; const long b = it / ((long)S * H); const long tok = b * S + t;
    const u16* q = B.QKV + tok * QKVW + O_Q + h * 64; const u64 mk = B.MASK[(b * G + g) * (long)S + t];
    float qr[64], o[64];
#pragma unroll
    for (int d = 0; d < 64; ++d) { qr[d] = bf2f(q[d]); o[d] = 0.f; }
    float m = -3.0e38f, l = 0.f;
    for (int j = 0; j < NSEL; ++j) { if (!((mk >> j) & 1ull)) continue;
      for (long kp = 64L * j; kp < 64L * j + 64 && kp <= t; ++kp) { const u16* k = B.QKV + (b * S + kp) * QKVW + O_KS + g * 64; const u16* v = B.QKV + (b * S + kp) * QKVW + O_VS + g * 64; float s = 0.f;
#pragma unroll
        for (int d = 0; d < 64; ++d) s += qr[d] * bf2f(k[d]);
        s *= 0.125f;
        if (s > m) { const float f = expf(m - s); l *= f;
#pragma unroll
          for (int d = 0; d < 64; ++d) o[d] *= f;
          m = s; }
        const float p = expf(s - m); l += p;
#pragma unroll
        for (int d = 0; d < 64; ++d) o[d] += p * bf2f(v[d]); } }
    const float g1 = B.NG[tok * GW + h * 3 + 1]; const float inv = g1 / l;
#pragma unroll
    for (int d = 0; d < 64; ++d) { u16* y = B.YA + tok * QW + h * 64 + d; *y = f2bf(bf2f(*y) + o[d] * inv); } } };
struct WinAttn { Bufs B;
  HD long items() const { return (long)NB * H * S; }
  HD void operator()(long it) const { const long t = it % S; const int h = (int)((it / S) % H), g = h / E; const long b = it / ((long)S * H); const long tok = b * S + t;
    const u16* q = B.QKV + tok * QKVW + O_Q + h * 64;
    float qr[64], o[64];
#pragma unroll
    for (int d = 0; d < 64; ++d) { qr[d] = bf2f(q[d]); o[d] = 0.f; }
    float m = -3.0e38f, l = 0.f; long k0 = t - 511; if (k0 < 0) k0 = 0;
    for (long kp = k0; kp <= t; ++kp) { const u16* k = B.QKV + (b * S + kp) * QKVW + O_KW + g * 64; const u16* v = B.QKV + (b * S + kp) * QKVW + O_VW + g * 64; float s = 0.f;
#pragma unroll
      for (int d = 0; d < 64; ++d) s += qr[d] * bf2f(k[d]);
      s *= 0.125f;
      if (s > m) { const float f = expf(m - s); l *= f;
#pragma unroll
        for (int d = 0; d < 64; ++d) o[d] *= f;
        m = s; }
      const float p = expf(s - m); l += p;
#pragma unroll
      for (int d = 0; d < 64; ++d) o[d] += p * bf2f(v[d]); }
    const float g2 = B.NG[tok * GW + h * 3 + 2]; const float inv = g2 / l;
#pragma unroll
    for (int d = 0; d < 64; ++d) { u16* y = B.YA + tok * QW + h * 64 + d; *y = f2bf(bf2f(*y) + o[d] * inv); } } };

struct SsdConv { u16* xbc; const float* cw; const float* cb;
  HD long items() const { return (long)NB * SCD; }
  HD void operator()(long it) const { const int c = (int)(it % SCD); const long b = it / SCD; u16* col = xbc + b * S * SCD + c; const float w0 = cw[c], w1 = cw[SCD + c], w2 = cw[2 * SCD + c], w3 = cw[3 * SCD + c], bias = cb[c];
    for (long t = S - 1; t >= 0; --t) { float a = bias + w3 * bf2f(col[t * SCD]); if (t >= 1) a += w2 * bf2f(col[(t - 1) * SCD]); if (t >= 2) a += w1 * bf2f(col[(t - 2) * SCD]); if (t >= 3) a += w0 * bf2f(col[(t - 3) * SCD]);
      col[t * SCD] = f2bf(siluf_(a)); } } };
struct SsdScan { Bufs B; const float* alog; const float* dskip;
  HD long items() const { return (long)NB * SH * SP; }
  HD void operator()(long it) const { const int p = (int)(it % SP); const int hh = (int)((it / SP) % SH); const long b = it / (SP * SH); const int g = hh / 8;
    const float a = -expf(alog[hh]); float st[128];
#pragma unroll
    for (int n = 0; n < 128; ++n) st[n] = 0.f;
    for (long t = 0; t < S; ++t) { const long tok = b * S + t; const float dt = B.DT[tok * SH + hh]; const float dec = expf(dt * a); const float xd = bf2f(B.XBC[tok * SCD + hh * 64 + p]) * dt;
      const u16* Bv = B.XBC + tok * SCD + SI + g * SN; const u16* Cv = B.XBC + tok * SCD + SI + SG * SN + g * SN; float y = 0.f;
#pragma unroll
      for (int n = 0; n < 128; ++n) { st[n] = st[n] * dec + xd * bf2f(Bv[n]); y += bf2f(Cv[n]) * st[n]; if ((n & 15) == 15) { NV_FENCE(); } }
      B.XBC[tok * SCD + hh * 64 + p] = f2bf(y + bf2f(B.XBC[tok * SCD + hh * 64 + p]) * dskip[hh]); } } };
struct SsdOut { Bufs B; const float* ngain;
  HD long items() const { return (long)NTOK * SG; }
  HD void operator()(long it) const { const long tok = it / SG; const int g = (int)(it % SG); float s = 0.f;
    for (int c = g * 512; c < g * 512 + 512; ++c) { float y = bf2f(B.XBC[tok * SCD + c]); y *= siluf_(bf2f(B.Z[tok * SI + c])); s += y * y; }
    const float rs = 1.0f / sqrtf(s / 512.f + EPS);
    for (int c = g * 512; c < g * 512 + 512; ++c) { float y = bf2f(B.XBC[tok * SCD + c]); y *= siluf_(bf2f(B.Z[tok * SI + c])); B.YB[tok * SI + c] = f2bf(y * rs * ngain[c]); } } };

struct Router { const u16* h2; const float* wg; const float* bg; const float* we; const float* be; int* ei; float* ew;
  HD void operator()(long tok) const { const u16* x = h2 + tok * DM; float gl[4];
#pragma unroll
    for (int j = 0; j < 4; ++j) gl[j] = bg[j];
    for (long d = 0; d < DM; ++d) { const float xv = bf2f(x[d]);
#pragma unroll
      for (int j = 0; j < 4; ++j) gl[j] += xv * wg[d * 4 + j]; }
    int gi = 0; float gm = gl[0];
#pragma unroll
    for (int j = 1; j < 4; ++j) if (gl[j] > gm) { gm = gl[j]; gi = j; }
    float gs = 0.f;
#pragma unroll
    for (int j = 0; j < 4; ++j) gs += expf(gl[j] - gm);
    const float grp_w = 1.0f / gs;
    float el[8];
#pragma unroll
    for (int j = 0; j < 8; ++j) el[j] = be[gi * 8 + j];
    for (long d = 0; d < DM; ++d) { const float xv = bf2f(x[d]);
#pragma unroll
      for (int j = 0; j < 8; ++j) el[j] += xv * we[d * NEXP + gi * 8 + j]; }
    int i0 = 0; float m0 = el[0];
#pragma unroll
    for (int j = 1; j < 8; ++j) if (el[j] > m0) { m0 = el[j]; i0 = j; }
    int i1 = -1; float m1 = -3.0e38f;
#pragma unroll
    for (int j = 0; j < 8; ++j) if (j != i0 && el[j] > m1) { m1 = el[j]; i1 = j; }
    const float r = expf(m1 - m0); const float w0 = 1.0f / (1.0f + r), w1 = r / (1.0f + r);
    ei[tok * 2] = gi * 8 + i0; ei[tok * 2 + 1] = gi * 8 + i1; ew[tok * 2] = grp_w * w0; ew[tok * 2 + 1] = grp_w * w1; } };
struct MoeHidden { const u16* h2; const float* wgate; const float* wup; const int* ei; u16* act;
  HD long items() const { return (long)NTOK * 2 * MH; }
  HD void operator()(long it) const { const int j = (int)(it % MH); const long tk = it / MH; const long tok = tk / 2; const int e = ei[tk]; const u16* x = h2 + tok * DM;
    const float* wg_ = wgate + (long)e * DM * MH + j; const float* wu_ = wup + (long)e * DM * MH + j; float a = 0.f, b = 0.f;
    for (long d = 0; d < DM; ++d) { const float xv = bf2f(x[d]); a += xv * wg_[d * MH]; b += xv * wu_[d * MH]; }
    act[it] = f2bf(siluf_(a) * b); } };
struct MoeDown { const u16* act; const float* wdown; const int* ei; const float* ew; float* x;
  HD long items() const { return (long)NTOK * DM; }
  HD void operator()(long it) const { const int c = (int)(it % DM); const long tok = it / DM; float tot = 0.f;
    for (int k = 0; k < 2; ++k) { const int e = ei[tok * 2 + k]; const u16* a = act + (tok * 2 + k) * MH; const float* w = wdown + (long)e * MH * DM + c; float s = 0.f;
      for (int j = 0; j < MH; ++j) s += bf2f(a[j]) * w[(long)j * DM];
      tot += ew[tok * 2 + k] * s; }
    x[it] += tot; } };

#define NV2_STAGE_PREP(RUN, I, B, out)      { nv::RmsRowsBf f{I.x, I.mix_norm, B.HB, nv::DM}; RUN(f, (long)nv::NTOK); }
#define NV2_STAGE_INPROJ(RUN, I, B, out)    { nv::GemmT<nv::ABf, nv::EpInProj> f{nv::ABf{B.HB, nv::DM}, I.w_in, nv::EpInProj{B, I.dt_bias}, nv::NTOK, nv::INW, nv::DM, nv::INW}; RUN(f, f.items()); }
#define NV2_STAGE_QKNORM(RUN, I, B, out)    { nv::QkNorm f{B.QKV, I.q_gain, I.ks_gain, I.kw_gain}; RUN(f, f.items()); }
#define NV2_STAGE_COMPRESS(RUN, I, B, out)  { \
    { nv::GemmT<nv::ACmp, nv::EpSiluF32> f{nv::ACmp{B.QKV, I.pos_k, nv::O_KC}, I.w1_k, nv::EpSiluF32{B.HID, 128}, (long)nv::NB * nv::G * nv::NCMP, 128, 2048, 128}; RUN(f, f.items()); } \
    { nv::GemmT<nv::AF32, nv::EpF32> f{nv::AF32{B.HID, 128}, I.w2_k, nv::EpF32{B.KTMP, 64}, (long)nv::NB * nv::G * nv::NCMP, 64, 128, 64}; RUN(f, f.items()); } \
    { nv::CmpFinish f{B.KTMP, I.kc_gain, B.KCMP, 1}; RUN(f, f.items()); } \
    { nv::GemmT<nv::ACmp, nv::EpSiluF32> f{nv::ACmp{B.QKV, I.pos_v, nv::O_VC}, I.w1_v, nv::EpSiluF32{B.HID, 128}, (long)nv::NB * nv::G * nv::NCMP, 128, 2048, 128}; RUN(f, f.items()); } \
    { nv::GemmT<nv::AF32, nv::EpF32> f{nv::AF32{B.HID, 128}, I.w2_v, nv::EpF32{B.KTMP, 64}, (long)nv::NB * nv::G * nv::NCMP, 64, 128, 64}; RUN(f, f.items()); } \
    { nv::CmpFinish f{B.KTMP, I.kc_gain, B.VCMP, 0}; RUN(f, f.items()); } }
#define NV2_STAGE_ATTN(RUN, I, B, out)      { \
    { nv::CmpAttn f{B}; RUN(f, f.items()); } { nv::Importance f{B}; RUN(f, f.items()); } { nv::TopSel f{B}; RUN(f, f.items()); } { nv::SelAttn f{B}; RUN(f, f.items()); } { nv::WinAttn f{B}; RUN(f, f.items()); } }
#define NV2_STAGE_SSD(RUN, I, B, out)       { \
    { nv::SsdConv f{B.XBC, I.conv_w, I.conv_b}; RUN(f, f.items()); } { nv::SsdScan f{B, I.a_log, I.d_skip}; RUN(f, f.items()); } { nv::SsdOut f{B, I.ssm_norm}; RUN(f, f.items()); } }
#define NV2_STAGE_MERGE(RUN, I, B, out)     { \
    { nv::GemmT<nv::ABf, nv::EpBf> f{nv::ABf{B.YA, nv::QW}, I.w_a, nv::EpBf{B.T1, nv::DM}, nv::NTOK, nv::DM, nv::QW, nv::DM}; RUN(f, f.items()); } \
    { nv::GemmT<nv::ABf, nv::EpMerge> f{nv::ABf{B.YB, nv::SI}, I.w_b, nv::EpMerge{B.T1, B.BG, B.MERGED}, nv::NTOK, nv::DM, nv::SI, nv::DM}; RUN(f, f.items()); } \
    { nv::GemmT<nv::ABf, nv::EpResid> f{nv::ABf{B.MERGED, nv::DM}, I.w_out, nv::EpResid{I.x, out}, nv::NTOK, nv::DM, nv::DM, nv::DM}; RUN(f, f.items()); } }
#define NV2_STAGE_MOE(RUN, I, B, out)       { \
    { nv::RmsRowsBf f{out, I.moe_norm, B.H2, nv::DM}; RUN(f, (long)nv::NTOK); } \
    { nv::Router f{B.H2, I.w_group, I.b_group, I.w_expert, I.b_expert, B.EI, B.EW}; RUN(f, (long)nv::NTOK); } \
    { nv::MoeHidden f{B.H2, I.w_gate, I.w_up, B.EI, B.ACT}; RUN(f, f.items()); } \
    { nv::MoeDown f{B.ACT, I.w_down, B.EI, B.EW, out}; RUN(f, f.items()); } }
#define NV2_STAGE_PLE(RUN, I, B, out)       { \
    { nv::RmsRowsBf f{out, I.ple_norm, B.H2, nv::DM}; RUN(f, (long)nv::NTOK); } \
    { nv::GemmT<nv::AF32, nv::EpBf> f{nv::AF32{I.p, nv::PLE}, I.ple_wp, nv::EpBf{B.PP, nv::DM}, nv::NTOK, nv::DM, nv::PLE, nv::DM}; RUN(f, f.items()); } \
    { nv::GemmT<nv::ABf, nv::EpPle> f{nv::ABf{B.H2, nv::DM}, I.ple_wg, nv::EpPle{out, B.PP}, nv::NTOK, nv::DM, nv::DM, nv::DM}; RUN(f, f.items()); } }

HD size_t carve(Bufs& B, unsigned char* ws, float* out) {
  size_t off = 0; auto take = [&](size_t bytes) { unsigned char* r = ws + off; off += (bytes + 255) / 256 * 256; return r; };
  const size_t N = NTOK;
  B.BG = (u16*)out;
  unsigned char* R0 = take(N * DM * 2);
  unsigned char* R1 = take(N * QKVW * 2);
  unsigned char* R2 = take(N * SI * 2);
  unsigned char* R3 = take(N * SCD * 2);
  unsigned char* R5 = take(N * 2 * MH * 2 + (size_t)NEXP * 256 * MH * 2);
  B.HB = (u16*)R0; B.H2 = (u16*)R0; B.QKV = (u16*)R1; B.T1 = (u16*)R1; B.Z = (u16*)R2; B.XBC = (u16*)R3; B.MERGED = (u16*)R3; B.PP = (u16*)R3;
  B.YA = (u16*)take(N * QW * 2); B.ACT = (u16*)R5; B.YB = B.Z;
  B.NG = (float*)take(N * GW * 4); B.DT = (float*)take(N * SH * 4);
  B.KCMP = (u16*)take((size_t)NB * G * NCP * 64 * 2); B.VCMP = (u16*)take((size_t)NB * G * NCP * 64 * 2);
  B.EI = (int*)take(N * 2 * 4); B.EW = (float*)take(N * 2 * 4);
  B.HID = (float*)take((size_t)NB * G * NCMP * 128 * 4); B.KTMP = (float*)take((size_t)NB * G * NCMP * 64 * 4);
  B.ML = (float*)take(N * H * 2 * 4); B.IMP = (float*)take((size_t)NB * G * S * 64 * 4); B.MASK = (u64*)take((size_t)NB * G * S * 8);
  return off;
}
}
namespace pg8 {
#define PG8_LAS __attribute__((address_space(3)))
typedef unsigned short bf16_t;
typedef short bf16x8 __attribute__((ext_vector_type(8)));
typedef float f32x4 __attribute__((ext_vector_type(4)));
typedef unsigned u32x4 __attribute__((ext_vector_type(4)));
typedef unsigned u32x2 __attribute__((ext_vector_type(2)));
constexpr int BM = 256, BK = 64, HALF = 128, HTB = HALF * BK * 2  , STAGE_BYTES = 8 * HTB, NXCD = 8, WGM = 8;

__host__ __device__ __forceinline__ int lds_byte(int r, int c) { const int st = (r >> 4) * 2 + (c >> 5), rr = r & 15, cc = c & 31, ob = rr * 64 + cc * 2; return st * 1024 + (ob ^ (((ob >> 9) & 1) << 5)); }
__host__ __device__ __forceinline__ void stage_rc(int b, int& R, int& C) { const int st = b / 1024, sb = b % 1024, swz = sb ^ (((sb >> 9) & 1) << 5); R = (st >> 1) * 16 + swz / 64; C = (st & 1) * 32 + (swz % 64) / 2; }
__host__ __device__ __forceinline__ int perm32(int rho) { const int n = rho >> 4, i = rho & 15; return 8 * (i >> 2) + 4 * n + (i & 3); }

struct Unit { int pm, pn, aux0, aux1; };
struct Gemm { const bf16_t* A; const bf16_t* Bt; int M, N, K, lda, ldb; };

struct StaticOrder {
    int nM, nN, nwg, G, c;
    __device__ void init(int M, int N, int G_, int c_) { nM = M / BM; nN = N / BM; nwg = nM * nN; G = G_; c = c_; }
    __device__ bool next(int i, Unit& u) const {
        const long L = (long)i * G + c; if (L >= nwg) return false;
        int wgid = (int)L; { const int q = nwg / NXCD, r = nwg % NXCD, xcd = wgid % NXCD, off = wgid / NXCD; wgid = (xcd < r ? xcd * (q + 1) : r * (q + 1) + (xcd - r) * q) + off; }
        const int nig = WGM * nN, gid = wgid / nig, fm = gid * WGM, gsz = (nM - fm) < WGM ? (nM - fm) : WGM;
        u.pm = fm + ((wgid % nig) % gsz); u.pn = (wgid % nig) / gsz; u.aux0 = 0; u.aux1 = 0; return true;
    }
    __device__ __forceinline__ const char* a_base(const Gemm& g, const Unit& u) const { return (const char*)g.A + (size_t)u.pm * BM * g.lda * 2; }
    __device__ __forceinline__ const char* b_base(const Gemm& g, const Unit& u) const { return (const char*)g.Bt + (size_t)u.pn * BM * g.ldb * 2; }
    __device__ __forceinline__ int a_row(const Unit&, int) const { return 0; }
};

typedef float f32x2_t __attribute__((ext_vector_type(2))); typedef __bf16 bf16x2_t __attribute__((ext_vector_type(2)));
__device__ __forceinline__ unsigned cvt_pk_bf16(float lo, float hi) { f32x2_t v = {lo, hi}; bf16x2_t b = __builtin_convertvector(v, bf16x2_t); return __builtin_bit_cast(unsigned, b); }


template <class Epi, class Sched, bool ALIGN_EPI = true, bool GATHER = false>
__device__ __forceinline__ void gemm_phase(PG8_LAS unsigned char* lds, const Gemm g, const Sched& S, const Epi& E) {
    int tid_ = threadIdx.x; asm volatile("" : "+v"(tid_));
    const int tid = tid_, wid = __builtin_amdgcn_readfirstlane(tid >> 6), lane = tid & 63, wr = wid >> 2, wc = wid & 3, fr = lane & 15, fq = lane >> 4;
    const int K = g.K, nt = K / BK;
    unsigned voffA[2], voffA1[2], voffB[2];
    int RA[2], CA[2];
#pragma unroll
    for (int i = 0; i < 2; ++i) { int R, C; stage_rc(tid * 16 + i * 8192, R, C); const int Rb = Epi::PERM ? ((R & ~31) + perm32(R & 31)) : R;
        RA[i] = R; CA[i] = C; voffA[i] = (unsigned)(R * g.lda + C) * 2u; voffA1[i] = voffA[i]; voffB[i] = (unsigned)(Rb * g.ldb + C) * 2u; }
    const size_t kstep = (size_t)(BK * 2);
    const size_t hstepA = GATHER ? (size_t)0 : (size_t)HALF * g.lda * 2;
    const size_t hstepB = (size_t)HALF * g.ldb * 2;
    const unsigned ldsw = (unsigned)wid * 1024u;
    const int aoff = lds_byte(wr * 64 + fr, fq * 8), boff = lds_byte(wc * 32 + fr, fq * 8);
#define PG8_SA(b, h) (((b) * 2 + (h)) * HTB)
#define PG8_SB(b, h) ((4 + (b) * 2 + (h)) * HTB)
#define PG8_STAGE(bufoff, gbase, voff) do { _Pragma("unroll") for (int _i = 0; _i < 2; ++_i) \
        __builtin_amdgcn_global_load_lds((const unsigned*)((const char*)(gbase) + (voff)[_i]), (PG8_LAS unsigned*)(lds + (bufoff) + ldsw + _i * 8192), 16, 0, 0); } while (0)
#define PG8_STAGE_A0(bufoff, gbase) PG8_STAGE(bufoff, gbase, voffA)
#define PG8_STAGE_A1(bufoff, gbase) do { if constexpr (GATHER) { PG8_STAGE(bufoff, gbase, voffA1); } else { PG8_STAGE(bufoff, (gbase) + hstepA, voffA); } } while (0)
#define PG8_LDA(dst, b, h) do { _Pragma("unroll") for (int m = 0; m < 4; ++m) _Pragma("unroll") for (int k = 0; k < 2; ++k) dst[m][k] = *(const PG8_LAS bf16x8*)(lds + PG8_SA(b, h) + aoff + m * 2048 + k * 1024); } while (0)
#define PG8_LDB(dst, b, h) do { _Pragma("unroll") for (int n = 0; n < 2; ++n) _Pragma("unroll") for (int k = 0; k < 2; ++k) dst[n][k] = *(const PG8_LAS bf16x8*)(lds + PG8_SB(b, h) + boff + n * 2048 + k * 1024); } while (0)
#define PG8_MMA(ai, bj, At, Bt) do { __builtin_amdgcn_s_setprio(1); _Pragma("unroll") for (int m = 0; m < 4; ++m) _Pragma("unroll") for (int n = 0; n < 2; ++n) _Pragma("unroll") for (int k = 0; k < 2; ++k) \
        acc[ai][bj][m][n] = __builtin_amdgcn_mfma_f32_16x16x32_bf16(Bt[n][k], At[m][k], acc[ai][bj][m][n], 0, 0, 0); __builtin_amdgcn_s_setprio(0); } while (0)
#define PG8_WAIT_V(n) asm volatile("s_waitcnt vmcnt(" #n ")" ::: "memory")
#define PG8_WAIT_L(n) asm volatile("s_waitcnt lgkmcnt(" #n ")" ::: "memory")
#define PG8_BAR __builtin_amdgcn_s_barrier()
#define PG8_SCHED __builtin_amdgcn_sched_barrier(0)
    Unit cur, nxt; int ui = 0;
    if (!S.next(0, cur)) return;
    if constexpr (GATHER) {
#pragma unroll
        for (int i = 0; i < 2; ++i) { voffA[i] = (unsigned)(S.a_row(cur, RA[i]) * g.lda + CA[i]) * 2u; voffA1[i] = (unsigned)(S.a_row(cur, HALF + RA[i]) * g.lda + CA[i]) * 2u; }
    }
    f32x4 acc[2][2][4][2];
#pragma unroll
    for (int a = 0; a < 2; ++a)
#pragma unroll
        for (int b = 0; b < 2; ++b)
#pragma unroll
            for (int m = 0; m < 4; ++m)
#pragma unroll
                for (int n = 0; n < 2; ++n) acc[a][b][m][n] = (f32x4){0.f, 0.f, 0.f, 0.f};
    bf16x8 At[4][2], B0[2][2], B1[2][2];
    const char* cA = S.a_base(g, cur); const char* cB = S.b_base(g, cur);
    PG8_STAGE(PG8_SB(0, 0), cB, voffB); PG8_STAGE(PG8_SB(0, 1), cB + hstepB, voffB); PG8_STAGE_A0(PG8_SA(0, 0), cA); PG8_STAGE_A1(PG8_SA(0, 1), cA);
    if (wr == 1) PG8_BAR;
    PG8_WAIT_V(2); PG8_BAR;
    PG8_STAGE(PG8_SB(1, 0), cB + kstep, voffB); PG8_STAGE_A0(PG8_SA(1, 0), cA + kstep); PG8_STAGE(PG8_SB(1, 1), cB + hstepB + kstep, voffB);
    PG8_WAIT_V(6); PG8_BAR;
    for (;;) {
        const bool has_next = GATHER ? false : S.next(ui + 1, nxt);
        const char* nA = has_next ? S.a_base(g, nxt) : cA; const char* nB = has_next ? S.b_base(g, nxt) : cB;
        for (int t = 0; t < nt; t += 2) {
            const bool last = (t == nt - 2);
            const char* a1 = cA + (size_t)(t + 1) * kstep;
            const char* a2 = last ? nA : cA + (size_t)(t + 2) * kstep; const char* b2 = last ? nB : cB + (size_t)(t + 2) * kstep;
            const char* a3 = a2 + kstep; const char* b3 = b2 + kstep;
            PG8_LDB(B0, 0, 0); PG8_LDB(B1, 0, 1); PG8_SCHED; PG8_LDA(At, 0, 0); PG8_STAGE_A1(PG8_SA(1, 1), a1);
            PG8_WAIT_V(8); PG8_WAIT_L(0); PG8_BAR; PG8_MMA(0, 0, At, B0); PG8_MMA(0, 1, At, B1); PG8_BAR; PG8_SCHED;
            PG8_LDA(At, 0, 1); PG8_STAGE(PG8_SB(0, 0), b2, voffB); PG8_STAGE(PG8_SB(0, 1), b2 + hstepB, voffB); PG8_STAGE_A0(PG8_SA(0, 0), a2);
            PG8_WAIT_V(8); PG8_WAIT_L(0); PG8_BAR; PG8_MMA(1, 0, At, B0); PG8_MMA(1, 1, At, B1); PG8_BAR; PG8_SCHED;
            PG8_LDB(B0, 1, 0); PG8_LDB(B1, 1, 1); PG8_SCHED; PG8_LDA(At, 1, 0); PG8_STAGE_A1(PG8_SA(0, 1), a2);
            PG8_WAIT_V(8); PG8_WAIT_L(0); PG8_BAR; PG8_MMA(0, 0, At, B0); PG8_MMA(0, 1, At, B1); PG8_BAR; PG8_SCHED;
            PG8_LDA(At, 1, 1); PG8_STAGE(PG8_SB(1, 0), b3, voffB); PG8_STAGE(PG8_SB(1, 1), b3 + hstepB, voffB); PG8_STAGE_A0(PG8_SA(1, 0), a3);
            PG8_WAIT_V(8); PG8_WAIT_L(0); PG8_BAR; PG8_MMA(1, 0, At, B0); PG8_MMA(1, 1, At, B1); PG8_BAR; PG8_SCHED;
        }
        if constexpr (ALIGN_EPI) { if (wr == 0) PG8_BAR; }
        E(acc, cur, wr, wc, fr, fq);
        if (!has_next) break;
#pragma unroll
        for (int a = 0; a < 2; ++a)
#pragma unroll
            for (int b = 0; b < 2; ++b)
#pragma unroll
                for (int m = 0; m < 4; ++m)
#pragma unroll
                    for (int n = 0; n < 2; ++n) acc[a][b][m][n] = (f32x4){0.f, 0.f, 0.f, 0.f};
        cur = nxt; cA = nA; cB = nB; ++ui;
        if constexpr (ALIGN_EPI) { if (wr == 1) PG8_BAR; }
    }
    PG8_WAIT_V(0);
    if constexpr (!ALIGN_EPI) { if (wr == 0) PG8_BAR; }
    PG8_BAR;
#undef PG8_SA
#undef PG8_SB
#undef PG8_STAGE
#undef PG8_STAGE_A0
#undef PG8_STAGE_A1
#undef PG8_LDA
#undef PG8_LDB
#undef PG8_MMA
#undef PG8_WAIT_V
#undef PG8_WAIT_L
#undef PG8_BAR
#undef PG8_SCHED
}
}
namespace fx {
using nv::u16; using nv::Bufs; using nv::Inputs;
using pg8::f32x4; using pg8::u32x4; using pg8::Unit;
#define LAS __attribute__((address_space(3)))
static_assert(nv::DM == 1024 && nv::NB == 8 && nv::S == 4096 && nv::MH == 256 && nv::PLE == 256, "fast phases are written for the full-size problem");
constexpr int NTOK = nv::NTOK, DM = 1024;
constexpr int INW_PAD = 6144;
constexpr int C_Z = 1280, C_XBC = 2304, C_BG = 3840, C_NG = 5888, C_DT = 5912, C_END = 5928;

struct WBufs { u16 *WinT, *WaT, *WbT, *WoutT, *PleGT, *PlePT, *WguT, *WdT, *PB; };
__host__ __device__ inline size_t carve_w(WBufs& W, unsigned char* ws, size_t off) {
  auto take = [&](size_t bytes) { unsigned char* r = ws + off; off += (bytes + 255) / 256 * 256; return r; };
  W.WinT = (u16*)take((size_t)INW_PAD * 1024 * 2); W.WaT = (u16*)take((size_t)1024 * 512 * 2); W.WbT = (u16*)take((size_t)1024 * 1024 * 2); W.WoutT = (u16*)take((size_t)1024 * 1024 * 2);
  W.PleGT = (u16*)take((size_t)1024 * 1024 * 2); W.PlePT = (u16*)take((size_t)1024 * 256 * 2); W.WguT = (u16*)take((size_t)32 * 512 * 1024 * 2); W.WdT = (u16*)take((size_t)32 * 1024 * 256 * 2);
  W.PB = (u16*)take((size_t)NTOK * 256 * 2);
  return off;
}

__device__ __forceinline__ int otid() { int t = threadIdx.x; asm volatile("" : "+v"(t)); return t; }
__device__ __forceinline__ int obid() { int b = blockIdx.x; asm volatile("" : "+s"(b)); return b; }
__device__ __forceinline__ float fsig(float x) { return __builtin_amdgcn_rcpf(1.0f + __expf(-x)); }
__device__ __forceinline__ float fsoftplus(float x) { const float e = __expf(x); return x > 20.f ? x : (e < 0.0625f ? e * (1.f - e * (0.5f - e * (0.33333333f - 0.25f * e))) : __logf(1.0f + e)); }
__device__ __forceinline__ unsigned pk2(float lo, float hi) { return pg8::cvt_pk_bf16(lo, hi); }
__device__ __forceinline__ void store8(u16* p, const float (&v)[8]) { u32x4 w; w.x = pk2(v[0], v[1]); w.y = pk2(v[2], v[3]); w.z = pk2(v[4], v[5]); w.w = pk2(v[6], v[7]); *(u32x4*)p = w; }
__device__ __forceinline__ void load8(const u16* p, float (&v)[8]) { const u32x4 w = *(const u32x4*)p;
  v[0] = __uint_as_float(w.x << 16); v[1] = __uint_as_float(w.x & 0xffff0000u); v[2] = __uint_as_float(w.y << 16); v[3] = __uint_as_float(w.y & 0xffff0000u);
  v[4] = __uint_as_float(w.z << 16); v[5] = __uint_as_float(w.z & 0xffff0000u); v[6] = __uint_as_float(w.w << 16); v[7] = __uint_as_float(w.w & 0xffff0000u); }

__device__ __forceinline__ float wave_sum(float v) {
#pragma unroll
  for (int o = 1; o < 64; o <<= 1) v += __shfl_xor(v, o);
  return v; }
__device__ __forceinline__ void rms_row_to_bf16(const float* xrow, const float* gain, u16* orow, int lane) {
  const f32x4* xr = (const f32x4*)xrow + lane; const f32x4* gr = (const f32x4*)gain + lane;
  f32x4 v[4]; float s = 0.f;
#pragma unroll
  for (int j = 0; j < 4; ++j) { v[j] = xr[64 * j]; s += (v[j].x * v[j].x + v[j].y * v[j].y) + (v[j].z * v[j].z + v[j].w * v[j].w); }
  const float rs = 1.0f / sqrtf(wave_sum(s) * (1.f / 1024.f) + nv::EPS);
  unsigned long long* o8 = (unsigned long long*)orow + lane;
#pragma unroll
  for (int j = 0; j < 4; ++j) { const f32x4 g = gr[64 * j]; o8[64 * j] = (unsigned long long)pk2(v[j].x * rs * g.x, v[j].y * rs * g.y) | ((unsigned long long)pk2(v[j].z * rs * g.z, v[j].w * rs * g.w) << 32); }
}
__device__ __forceinline__ void phase_rms_rows(const float* x, const float* gain, u16* out) {
  const int tid = otid(), lane = tid & 63, gw = obid() * 8 + (tid >> 6), ngw = gridDim.x * 8;
  for (int r = gw; r < NTOK; r += ngw) rms_row_to_bf16(x + (size_t)r * 1024, gain, out + (size_t)r * 1024, lane);
}
template <class CP> __device__ __forceinline__ void transpose_tile(LAS float* scr, const CP cp, u16* dst, int K, int n0, int k0) {
  const int tid = otid();
  { const int nn = tid & 127; const float* p = cp(n0 + nn);
#pragma unroll
    for (int i = 0; i < 16; ++i) { const int kk = i * 4 + (tid >> 7); scr[nn * 65 + kk] = p ? p[(size_t)(k0 + kk) * cp.ld] : 0.f; } }
  __syncthreads();
#pragma unroll
  for (int h = 0; h < 2; ++h) { const int it = tid + h * 512, nn = it >> 3, kc = it & 7; const LAS float* s = scr + nn * 65 + kc * 8;
    u32x4 o; o.x = pk2(s[0], s[1]); o.y = pk2(s[2], s[3]); o.z = pk2(s[4], s[5]); o.w = pk2(s[6], s[7]);
    *(u32x4*)(dst + (size_t)(n0 + nn) * K + k0 + kc * 8) = o; }
  __syncthreads();
}
struct CpIdent { const float* src; int ld; __device__ const float* operator()(int n) const { return src + n; } };
struct CpInProj { const float* src; int ld; __device__ const float* operator()(int n) const {
  int c; if (n < C_Z) c = n; else if (n < C_XBC) c = nv::O_Z + (n - C_Z); else if (n < C_BG) c = nv::O_XBC + (n - C_XBC); else if (n < C_NG) c = nv::O_BG + (n - C_BG); else if (n < C_DT) c = nv::O_NG + (n - C_NG); else if (n < C_END) c = nv::O_DT + (n - C_DT); else return nullptr;
  return src + c; } };
struct CpGU { const float* gate; long updelta; int ld; __device__ const float* operator()(int n) const { const int tile = n >> 8, r = n & 255; return gate + (r < 128 ? 0L : updelta) + tile * 128 + (r & 127); } };

__device__ __forceinline__ void phase_prologue(LAS unsigned char* lds, const Inputs& I, const Bufs& B, const WBufs& W) {
  LAS float* scr = (LAS float*)lds;
  constexpr int T_IN = (INW_PAD / 128) * 16, T_A = 8 * 8, T_B = 8 * 16, T_O = 8 * 16, T_PG = 8 * 16, T_PP = 8 * 4, T_GU = 32 * 4 * 16, T_D = 32 * 8 * 4;
  constexpr int TOT = T_IN + T_A + T_B + T_O + T_PG + T_PP + T_GU + T_D;
  for (int t = blockIdx.x; t < TOT; t += gridDim.x) { int r = t;
    if (r < T_IN) { CpInProj cp{I.w_in, nv::INW}; transpose_tile(scr, cp, W.WinT, 1024, (r / 16) * 128, (r % 16) * 64); continue; } r -= T_IN;
    if (r < T_A) { CpIdent cp{I.w_a, 1024}; transpose_tile(scr, cp, W.WaT, 512, (r / 8) * 128, (r % 8) * 64); continue; } r -= T_A;
    if (r < T_B) { CpIdent cp{I.w_b, 1024}; transpose_tile(scr, cp, W.WbT, 1024, (r / 16) * 128, (r % 16) * 64); continue; } r -= T_B;
    if (r < T_O) { CpIdent cp{I.w_out, 1024}; transpose_tile(scr, cp, W.WoutT, 1024, (r / 16) * 128, (r % 16) * 64); continue; } r -= T_O;
    if (r < T_PG) { CpIdent cp{I.ple_wg, 1024}; transpose_tile(scr, cp, W.PleGT, 1024, (r / 16) * 128, (r % 16) * 64); continue; } r -= T_PG;
    if (r < T_PP) { CpIdent cp{I.ple_wp, 1024}; transpose_tile(scr, cp, W.PlePT, 256, (r / 4) * 128, (r % 4) * 64); continue; } r -= T_PP;
    if (r < T_GU) { const int e = r / 64, q = r % 64; CpGU cp{I.w_gate + (size_t)e * 1024 * 256, (long)(I.w_up - I.w_gate), 256}; transpose_tile(scr, cp, W.WguT + (size_t)e * 512 * 1024, 1024, (q / 16) * 128, (q % 16) * 64); continue; } r -= T_GU;
    { const int e = r / 32, q = r % 32; CpIdent cp{I.w_down + (size_t)e * 256 * 1024, 1024}; transpose_tile(scr, cp, W.WdT + (size_t)e * 1024 * 256, 256, (q / 4) * 128, (q % 4) * 64); }
  }
  phase_rms_rows(I.x, I.mix_norm, B.HB);
  for (long i = blockIdx.x * 512L + otid(); i < (long)NTOK * 256 / 8; i += (long)gridDim.x * 512L) { const f32x4 a = ((const f32x4*)I.p)[2 * i], b = ((const f32x4*)I.p)[2 * i + 1];
    u32x4 o; o.x = pk2(a.x, a.y); o.y = pk2(a.z, a.w); o.z = pk2(b.x, b.y); o.w = pk2(b.z, b.w); ((u32x4*)W.PB)[i] = o; }
}

template <class F> struct Epi8 { static constexpr bool PERM = true; F f;
  __device__ __forceinline__ void operator()(const f32x4 (&acc)[2][2][4][2], const Unit& u, int wr, int wc, int fr, int fq) const {
#pragma unroll
    for (int ai = 0; ai < 2; ++ai)
#pragma unroll
      for (int m = 0; m < 4; ++m) { const int row = u.pm * 256 + ai * 128 + wr * 64 + m * 16 + fr;
#pragma unroll
        for (int bj = 0; bj < 2; ++bj) { const int col = u.pn * 256 + bj * 128 + wc * 32 + 8 * fq; const f32x4 a = acc[ai][bj][m][0], b = acc[ai][bj][m][1];
          const float v[8] = {a.x, a.y, a.z, a.w, b.x, b.y, b.z, b.w}; f(u, row, col, v); }
        if (m & 1) asm volatile("" ::: "memory"); } } };

struct FInProj { u16* QKV; u16* Z; u16* XBC; u16* BG; float* NG; float* DT; const float* dt_bias;
  __device__ __forceinline__ void operator()(const Unit&, int r, int c, const float (&v)[8]) const {
    if (c < C_Z) store8(QKV + (size_t)r * 1280 + c, v);
    else if (c < C_XBC) store8(Z + (size_t)r * 1024 + (c - C_Z), v);
    else if (c < C_BG) store8(XBC + (size_t)r * 1536 + (c - C_XBC), v);
    else if (c < C_NG) { float s[8];
#pragma unroll
      for (int i = 0; i < 8; ++i) s[i] = fsig(v[i]);
      store8(BG + (size_t)r * 2048 + (c - C_BG), s); }
    else if (c < C_DT) { float* o = NG + (size_t)r * 24 + (c - C_NG);
#pragma unroll
      for (int i = 0; i < 8; ++i) o[i] = fsig(v[i]); }
    else if (c < C_END) { float* o = DT + (size_t)r * 16 + (c - C_DT); const float* bi = dt_bias + (c - C_DT);
#pragma unroll
      for (int i = 0; i < 8; ++i) o[i] = fsoftplus(v[i] + bi[i]); } } };
struct FStoreBf { u16* o; int ld; __device__ __forceinline__ void operator()(const Unit&, int r, int c, const float (&v)[8]) const { store8(o + (size_t)r * ld + c, v); } };
struct FMerge { const u16* t1; const u16* bg; u16* o;
  __device__ __forceinline__ void operator()(const Unit&, int r, int c, const float (&v)[8]) const { float t[8], ga[8], gb[8], m[8]; load8(t1 + (size_t)r * 1024 + c, t); load8(bg + (size_t)r * 2048 + c, ga); load8(bg + (size_t)r * 2048 + 1024 + c, gb);
#pragma unroll
    for (int i = 0; i < 8; ++i) m[i] = ga[i] * t[i] + gb[i] * v[i];
    store8(o + (size_t)r * 1024 + c, m); } };
struct FResid { const float* x; float* o;
  __device__ __forceinline__ void operator()(const Unit&, int r, int c, const float (&v)[8]) const { const f32x4 a = *(const f32x4*)(x + (size_t)r * 1024 + c), b = *(const f32x4*)(x + (size_t)r * 1024 + c + 4);
    *(f32x4*)(o + (size_t)r * 1024 + c) = (f32x4){a.x + v[0], a.y + v[1], a.z + v[2], a.w + v[3]}; *(f32x4*)(o + (size_t)r * 1024 + c + 4) = (f32x4){b.x + v[4], b.y + v[5], b.z + v[6], b.w + v[7]}; } };
struct FPle { float* x; const u16* pp;
  __device__ __forceinline__ void operator()(const Unit&, int r, int c, const float (&v)[8]) const { float p[8]; load8(pp + (size_t)r * 1024 + c, p); float* xp = x + (size_t)r * 1024 + c; const f32x4 a = *(const f32x4*)xp, b = *(const f32x4*)(xp + 4);
    *(f32x4*)xp = (f32x4){a.x + fsig(v[0]) * p[0], a.y + fsig(v[1]) * p[1], a.z + fsig(v[2]) * p[2], a.w + fsig(v[3]) * p[3]};
    *(f32x4*)(xp + 4) = (f32x4){b.x + fsig(v[4]) * p[4], b.y + fsig(v[5]) * p[5], b.z + fsig(v[6]) * p[6], b.w + fsig(v[7]) * p[7]}; } };

template <class F> __device__ __forceinline__ void dense_gemm(LAS unsigned char* lds, const u16* A, int lda, const u16* Bt, int ldb, int M, int N, int K, const F& f) {
  pg8::Gemm g{A, Bt, M, N, K, lda, ldb}; pg8::StaticOrder S; S.init(M, N, (int)gridDim.x, (int)blockIdx.x); Epi8<F> E{f};
  pg8::gemm_phase<Epi8<F>, pg8::StaticOrder, true, false>(lds, g, S, E);
}
}
namespace fx {
constexpr int LIST_CAP = 32768;
constexpr int LDS_TAB = 131072;
struct MoeBufs { float* LOGITS; int* CNT; int* LIST; u16* MOEOUT; u16* WrT; };
__host__ __device__ inline size_t carve_moe(MoeBufs& M, const Bufs& B, unsigned char* ws, size_t off) {
  auto take = [&](size_t bytes) { unsigned char* r = ws + off; off += (bytes + 255) / 256 * 256; return r; };
  M.LOGITS = (float*)take((size_t)NTOK * 64 * 4); M.CNT = (int*)take(256); M.LIST = (int*)take((size_t)32 * LIST_CAP * 4); M.WrT = (u16*)take((size_t)256 * 1024 * 2);
  M.MOEOUT = B.QKV;
  return off;
}
__device__ __forceinline__ void prologue_moe(const Inputs& I, const MoeBufs& M) {
  for (long i = blockIdx.x * 512L + otid(); i < 256L * 1024; i += (long)gridDim.x * 512L) { const int n = (int)(i >> 10), k = (int)(i & 1023);
    float v = 0.f; if (n < 4) v = I.w_group[k * 4 + n]; else if (n < 36) v = I.w_expert[k * 32 + (n - 4)];
    M.WrT[i] = nv::f2bf(v); }
  if (blockIdx.x == 0 && threadIdx.x < 64) M.CNT[threadIdx.x] = 0;
}
struct FLogits { float* o; __device__ __forceinline__ void operator()(const Unit&, int r, int c, const float (&v)[8]) const { if (c < 40) { *(f32x4*)(o + (size_t)r * 64 + c) = (f32x4){v[0], v[1], v[2], v[3]}; *(f32x4*)(o + (size_t)r * 64 + c + 4) = (f32x4){v[4], v[5], v[6], v[7]}; } } };
__device__ __forceinline__ void phase_route(const Inputs& I, const Bufs& B, const MoeBufs& M) {
  for (int tok = blockIdx.x * 512 + otid(); tok < NTOK; tok += gridDim.x * 512) { const float* lg = M.LOGITS + (size_t)tok * 64;
    const f32x4 g4 = *(const f32x4*)lg; const float g0 = g4.x + I.b_group[0], g1 = g4.y + I.b_group[1], g2 = g4.z + I.b_group[2], g3 = g4.w + I.b_group[3];
    int gi = 0; float gm = g0; if (g1 > gm) { gm = g1; gi = 1; } if (g2 > gm) { gm = g2; gi = 2; } if (g3 > gm) { gm = g3; gi = 3; }
    const float grp_w = 1.0f / (expf(g0 - gm) + expf(g1 - gm) + expf(g2 - gm) + expf(g3 - gm));
    const f32x4 ea = *(const f32x4*)(lg + 4 + gi * 8), eb = *(const f32x4*)(lg + 8 + gi * 8); const f32x4 ba = *(const f32x4*)(I.b_expert + gi * 8), bb = *(const f32x4*)(I.b_expert + gi * 8 + 4);
    const float el[8] = {ea.x + ba.x, ea.y + ba.y, ea.z + ba.z, ea.w + ba.w, eb.x + bb.x, eb.y + bb.y, eb.z + bb.z, eb.w + bb.w};
    int i0 = 0; float m0 = el[0];
#pragma unroll
    for (int j = 1; j < 8; ++j) if (el[j] > m0) { m0 = el[j]; i0 = j; }
    int i1 = -1; float m1 = -3.0e38f;
#pragma unroll
    for (int j = 0; j < 8; ++j) if (j != i0 && el[j] > m1) { m1 = el[j]; i1 = j; }
    const float r = expf(m1 - m0); const float w0 = grp_w / (1.0f + r), w1 = grp_w * r / (1.0f + r);
    const int e0 = gi * 8 + i0, e1 = gi * 8 + i1;
    const int p0 = atomicAdd(&M.CNT[e0], 1), p1 = atomicAdd(&M.CNT[e1], 1);
    M.LIST[e0 * LIST_CAP + p0] = tok * 2; M.LIST[e1 * LIST_CAP + p1] = tok * 2 + 1; B.EW[tok * 2] = w0; B.EW[tok * 2 + 1] = w1; }
}
__device__ __forceinline__ void build_tile_table(LAS unsigned char* lds, const MoeBufs& M) {
  LAS int* tab = (LAS int*)(lds + LDS_TAB);
  if (threadIdx.x == 0) { int acc = 0; for (int e = 0; e < 32; ++e) { tab[e] = acc; acc += (M.CNT[e] + 255) >> 8; } tab[32] = acc; }
  __syncthreads();
}
__device__ __forceinline__ int tile_expert(const LAS int* tab, int tile) { int e = 0;
#pragma unroll 1
  for (int j = 1; j < 32; ++j) if (tab[j] <= tile) e = j;
  return e; }

struct SchedGU { const int* list; int tile, ct, lbase, nvalid, e;
  __device__ bool next(int i, Unit& u) const { if (i > 0) return false; u.pm = tile; u.pn = ct; u.aux0 = lbase; u.aux1 = nvalid; return true; }
  __device__ __forceinline__ const char* a_base(const pg8::Gemm& g, const Unit&) const { return (const char*)g.A; }
  __device__ __forceinline__ const char* b_base(const pg8::Gemm& g, const Unit&) const { return (const char*)g.Bt + ((size_t)e * 512 + (size_t)ct * 256) * 1024 * 2; }
  __device__ __forceinline__ int a_row(const Unit&, int r) const { return r < nvalid ? (list[lbase + r] >> 1) : 0; } };
struct EpiGU { static constexpr bool PERM = true; u16* act;
  __device__ __forceinline__ void operator()(const f32x4 (&acc)[2][2][4][2], const Unit& u, int wr, int wc, int fr, int fq) const {
#pragma unroll
    for (int ai = 0; ai < 2; ++ai)
#pragma unroll
      for (int m = 0; m < 4; ++m) { const int r = ai * 128 + wr * 64 + m * 16 + fr; const f32x4 g0 = acc[ai][0][m][0], g1 = acc[ai][0][m][1], u0 = acc[ai][1][m][0], u1 = acc[ai][1][m][1];
        const float a[8] = {g0.x * fsig(g0.x) * u0.x, g0.y * fsig(g0.y) * u0.y, g0.z * fsig(g0.z) * u0.z, g0.w * fsig(g0.w) * u0.w, g1.x * fsig(g1.x) * u1.x, g1.y * fsig(g1.y) * u1.y, g1.z * fsig(g1.z) * u1.z, g1.w * fsig(g1.w) * u1.w};
        store8(act + ((size_t)u.pm * 256 + r) * 256 + u.pn * 128 + wc * 32 + 8 * fq, a); } } };
__device__ __forceinline__ void phase_moe_gu(LAS unsigned char* lds, const Bufs& B, const WBufs& W, const MoeBufs& M) {
  const LAS int* tab = (const LAS int*)(lds + LDS_TAB); const int T = tab[32];
  for (int L = blockIdx.x; L < T * 2; L += gridDim.x) { const int tile = L >> 1, ct = L & 1, e = __builtin_amdgcn_readfirstlane(tile_expert(tab, tile)), rt = tile - __builtin_amdgcn_readfirstlane(tab[e]); int nvalid = __builtin_amdgcn_readfirstlane(M.CNT[e]) - rt * 256; nvalid = nvalid > 256 ? 256 : nvalid;
    pg8::Gemm g{B.H2, W.WguT, 256, 256, 1024, 1024, 1024}; SchedGU S{M.LIST, tile, ct, e * LIST_CAP + rt * 256, nvalid, e}; EpiGU E{B.ACT};
    pg8::gemm_phase<EpiGU, SchedGU, true, true>(lds, g, S, E); }
}
struct SchedD { const LAS int* tab; const int* cnt; int T4, G, c;
  __device__ bool next(int i, Unit& u) const { const int L = i * G + c; if (L >= T4) return false; const int tile = L >> 2, e = __builtin_amdgcn_readfirstlane(tile_expert(tab, tile)), rt = tile - __builtin_amdgcn_readfirstlane(tab[e]); int nvalid = __builtin_amdgcn_readfirstlane(cnt[e]) - rt * 256; nvalid = nvalid > 256 ? 256 : nvalid;
    u.pm = tile; u.pn = L & 3; u.aux0 = e * LIST_CAP + rt * 256; u.aux1 = nvalid; return true; }
  __device__ __forceinline__ const char* a_base(const pg8::Gemm& g, const Unit& u) const { return (const char*)g.A + (size_t)u.pm * 256 * 256 * 2; }
  __device__ __forceinline__ const char* b_base(const pg8::Gemm& g, const Unit& u) const { return (const char*)g.Bt + ((size_t)(u.aux0 >> 15) * 1024 + (size_t)u.pn * 256) * 256 * 2; }
  __device__ __forceinline__ int a_row(const Unit&, int) const { return 0; } };
struct FDown { const int* list; const float* ew; u16* o;
  __device__ __forceinline__ void operator()(const Unit& u, int row, int c, const float (&v)[8]) const { const int r = row - u.pm * 256; if (r < u.aux1) { const int asg = list[u.aux0 + r]; const float w = ew[asg];
      const float y[8] = {v[0] * w, v[1] * w, v[2] * w, v[3] * w, v[4] * w, v[5] * w, v[6] * w, v[7] * w}; store8(o + (size_t)asg * 1024 + c, y); } } };
__device__ __forceinline__ void phase_moe_down(LAS unsigned char* lds, const Bufs& B, const WBufs& W, const MoeBufs& M) {
  const LAS int* tab = (const LAS int*)(lds + LDS_TAB);
  pg8::Gemm g{B.ACT, W.WdT, 256, 1024, 256, 256, 256}; SchedD S{tab, M.CNT, tab[32] * 4, (int)gridDim.x, (int)blockIdx.x}; Epi8<FDown> E{FDown{M.LIST, B.EW, M.MOEOUT}};
  pg8::gemm_phase<Epi8<FDown>, SchedD, true, false>(lds, g, S, E);
}
__device__ __forceinline__ void phase_moe_combine(float* out, const u16* moeout, const float* gain, u16* hout) {
  const int tid = otid(), lane = tid & 63, gw = obid() * 8 + (tid >> 6), ngw = gridDim.x * 8;
  for (int tok = gw; tok < NTOK; tok += ngw) { f32x4* xr = (f32x4*)(out + (size_t)tok * 1024) + lane; const pg8::u32x2* o0 = (const pg8::u32x2*)(moeout + (size_t)tok * 2048) + lane; const pg8::u32x2* o1 = o0 + 256;
    const f32x4* gr = (const f32x4*)gain + lane; f32x4 v[4]; float s = 0.f;
#pragma unroll
    for (int j = 0; j < 4; ++j) { const f32x4 x = xr[64 * j]; const pg8::u32x2 a = o0[64 * j], b = o1[64 * j];
      v[j].x = x.x + __uint_as_float(a.x << 16) + __uint_as_float(b.x << 16); v[j].y = x.y + __uint_as_float(a.x & 0xffff0000u) + __uint_as_float(b.x & 0xffff0000u);
      v[j].z = x.z + __uint_as_float(a.y << 16) + __uint_as_float(b.y << 16); v[j].w = x.w + __uint_as_float(a.y & 0xffff0000u) + __uint_as_float(b.y & 0xffff0000u);
      xr[64 * j] = v[j]; s += (v[j].x * v[j].x + v[j].y * v[j].y) + (v[j].z * v[j].z + v[j].w * v[j].w); }
    const float rs = 1.0f / sqrtf(wave_sum(s) * (1.f / 1024.f) + nv::EPS);
    unsigned long long* o8 = (unsigned long long*)(hout + (size_t)tok * 1024) + lane;
#pragma unroll
    for (int j = 0; j < 4; ++j) { const f32x4 g = gr[64 * j]; o8[64 * j] = (unsigned long long)pk2(v[j].x * rs * g.x, v[j].y * rs * g.y) | ((unsigned long long)pk2(v[j].z * rs * g.z, v[j].w * rs * g.w) << 32); } }
}
}
namespace fa {
using nv::u16; using nv::Bufs;
typedef short bf16x8 __attribute__((ext_vector_type(8)));
typedef short s16x4 __attribute__((ext_vector_type(4)));
typedef float f32x16 __attribute__((ext_vector_type(16)));
typedef unsigned u32x4 __attribute__((ext_vector_type(4)));
constexpr float C2 = 0.125f * 1.4426950408889634f;
constexpr int S = nv::S, QKVW = 1280;
constexpr int L_K = 0, L_V = 16384, L_WSF = 32768, L_IMP = 34816, L_MASK = L_IMP + 65536, L_OST = L_MASK + 512, L_END = L_OST + 32768;
static_assert(L_END <= 147456, "attention LDS map");

__device__ __forceinline__ int crow(int r, int hi) { return (r & 3) + 8 * (r >> 2) + 4 * hi; }
__device__ __forceinline__ float ex2(float x) { return __builtin_amdgcn_exp2f(x); }
__device__ __forceinline__ float swap_add(float v) { auto rr = __builtin_amdgcn_permlane32_swap(__float_as_uint(v), __float_as_uint(v), false, false); return __uint_as_float(rr[0]) + __uint_as_float(rr[1]); }
__device__ __forceinline__ float swap_max(float v) { auto rr = __builtin_amdgcn_permlane32_swap(__float_as_uint(v), __float_as_uint(v), false, false); return __builtin_fmaxf(__uint_as_float(rr[0]), __uint_as_float(rr[1])); }

__device__ __forceinline__ void phase_qknorm(const nv::Inputs& I, const Bufs& B) {
  for (int it = blockIdx.x * 512 + fx::otid(); it < nv::NTOK * 12; it += gridDim.x * 512) { const int tok = it / 12, w = it % 12; u16* v; const float* gain; float sc = 1.f;
    if (w < 8) { v = B.QKV + (size_t)tok * QKVW + nv::O_Q + w * 64; gain = I.q_gain; sc = C2; } else if (w < 10) { v = B.QKV + (size_t)tok * QKVW + nv::O_KS + (w - 8) * 64; gain = I.ks_gain; } else { v = B.QKV + (size_t)tok * QKVW + nv::O_KW + (w - 10) * 64; gain = I.kw_gain; }
    float x[8][8]; float s = 0.f;
#pragma unroll
    for (int c = 0; c < 8; ++c) { fx::load8(v + c * 8, x[c]);
#pragma unroll
      for (int j = 0; j < 8; ++j) s += x[c][j] * x[c][j]; }
    const float rs = sc / sqrtf(s * (1.f / 64.f) + nv::EPS);
#pragma unroll
    for (int c = 0; c < 8; ++c) { float y[8];
#pragma unroll
      for (int j = 0; j < 8; ++j) y[j] = x[c][j] * rs * gain[c * 8 + j];
      fx::store8(v + c * 8, y); } }
}

__device__ __forceinline__ void stage_kv(LAS unsigned char* lds, int slot, const u16* kbase, const u16* vbase, int stride, int wid, int lane, bool withV) {
  const u16* ksrc = kbase + (size_t)lane * stride + wid * 8;
  __builtin_amdgcn_global_load_lds((const unsigned*)ksrc, (LAS unsigned*)(lds + L_K + slot * 8192 + wid * 1024), 16, 0, 0);
  if (withV) { const u16* vsrc = vbase + (size_t)(16 * (wid & 3) + (lane >> 2)) * stride + (wid >> 2) * 32 + (lane & 3) * 8;
    __builtin_amdgcn_global_load_lds((const unsigned*)vsrc, (LAS unsigned*)(lds + L_V + slot * 8192 + wid * 1024), 16, 0, 0); }
}
__device__ __forceinline__ void qkt(f32x16& p0, f32x16& p1, const LAS unsigned char* Kslot, const bf16x8 (&qr)[4], int r32, int hi) {
  const LAS unsigned char* kb = Kslot + hi * 1024 + r32 * 16; f32x16 z;
#pragma unroll
  for (int r = 0; r < 16; ++r) z[r] = 0.f;
  p0 = z; p1 = z;
#pragma unroll
  for (int d0 = 0; d0 < 4; ++d0) { const bf16x8 b0 = *(const LAS bf16x8*)(kb + d0 * 2048), b1 = *(const LAS bf16x8*)(kb + d0 * 2048 + 512);
    p0 = __builtin_amdgcn_mfma_f32_32x32x16_bf16(b0, qr[d0], p0, 0, 0, 0); p1 = __builtin_amdgcn_mfma_f32_32x32x16_bf16(b1, qr[d0], p1, 0, 0, 0); }
}
__device__ __forceinline__ void pv(f32x16 (&o)[2], int vb, bf16x8 pa0, bf16x8 pa1, bf16x8 pa2, bf16x8 pa3) {
#pragma unroll
  for (int d0 = 0; d0 < 2; ++d0) { s16x4 lo[4], hi[4];
#pragma unroll
    for (int ks = 0; ks < 4; ++ks) {
      asm volatile("ds_read_b64_tr_b16 %0,%1 offset:%c2" : "=&v"(lo[ks]) : "v"(vb), "i"(d0 * 4096 + ks * 1024) : "memory");
      asm volatile("ds_read_b64_tr_b16 %0,%1 offset:%c2" : "=&v"(hi[ks]) : "v"(vb), "i"(d0 * 4096 + ks * 1024 + 512) : "memory"); }
    asm volatile("s_waitcnt lgkmcnt(0)" ::: "memory"); __builtin_amdgcn_sched_barrier(0);
#define FA_PK(k) (bf16x8){lo[k][0], lo[k][1], lo[k][2], lo[k][3], hi[k][0], hi[k][1], hi[k][2], hi[k][3]}
    o[d0] = __builtin_amdgcn_mfma_f32_32x32x16_bf16(pa0, FA_PK(0), o[d0], 0, 0, 0);
    o[d0] = __builtin_amdgcn_mfma_f32_32x32x16_bf16(pa1, FA_PK(1), o[d0], 0, 0, 0);
    o[d0] = __builtin_amdgcn_mfma_f32_32x32x16_bf16(pa2, FA_PK(2), o[d0], 0, 0, 0);
    o[d0] = __builtin_amdgcn_mfma_f32_32x32x16_bf16(pa3, FA_PK(3), o[d0], 0, 0, 0);
#undef FA_PK
  }
}
struct SmState { float m, l; f32x16 o[2]; };
__device__ __forceinline__ void sm_reset(SmState& st) { st.m = -INFINITY; st.l = 0.f;
#pragma unroll
  for (int r = 0; r < 16; ++r) { st.o[0][r] = 0.f; st.o[1][r] = 0.f; } }
__device__ __forceinline__ void mask_range(f32x16& p0, f32x16& p1, int klo, int khi, int hi) {
  if (__all(klo <= 0 && khi >= 63)) return;
#pragma unroll
  for (int r = 0; r < 16; ++r) { const int k0 = crow(r, hi), k1 = k0 + 32; if (k0 < klo || k0 > khi) p0[r] = -INFINITY; if (k1 < klo || k1 > khi) p1[r] = -INFINITY; }
}
__device__ __forceinline__ void tile_step(SmState& st, LAS unsigned char* lds, int slot, const bf16x8 (&qr)[4], LAS float* wsf, int r32, int hi, int vb0, int klo, int khi) {
  f32x16 p0, p1; qkt(p0, p1, lds + L_K + slot * 8192, qr, r32, hi);
  mask_range(p0, p1, klo, khi, hi);
  float rm = p0[0];
#pragma unroll
  for (int r = 1; r < 16; ++r) rm = __builtin_fmaxf(rm, p0[r]);
#pragma unroll
  for (int r = 0; r < 16; ++r) rm = __builtin_fmaxf(rm, p1[r]);
  rm = swap_max(rm);
  const float mn = __builtin_fmaxf(st.m, rm), ms = __builtin_fmaxf(mn, -1.0e30f);
  const float f = ex2(st.m - ms);
  if (__any(mn > st.m)) { if (hi == 0) wsf[r32] = f;
#pragma unroll
    for (int r = 0; r < 16; ++r) { const float fr = wsf[crow(r, hi)]; st.o[0][r] *= fr; st.o[1][r] *= fr; } }
  st.m = mn;
  float rs = 0.f;
#pragma unroll
  for (int r = 0; r < 16; ++r) { p0[r] = ex2(p0[r] - ms); p1[r] = ex2(p1[r] - ms); rs += p0[r] + p1[r]; }
  st.l = st.l * f + rs;
  u32x4 w0, w1, w2, w3;
  w0.x = pg8::cvt_pk_bf16(p0[0], p0[1]); w0.y = pg8::cvt_pk_bf16(p0[2], p0[3]); w0.z = pg8::cvt_pk_bf16(p0[4], p0[5]); w0.w = pg8::cvt_pk_bf16(p0[6], p0[7]);
  w1.x = pg8::cvt_pk_bf16(p0[8], p0[9]); w1.y = pg8::cvt_pk_bf16(p0[10], p0[11]); w1.z = pg8::cvt_pk_bf16(p0[12], p0[13]); w1.w = pg8::cvt_pk_bf16(p0[14], p0[15]);
  w2.x = pg8::cvt_pk_bf16(p1[0], p1[1]); w2.y = pg8::cvt_pk_bf16(p1[2], p1[3]); w2.z = pg8::cvt_pk_bf16(p1[4], p1[5]); w2.w = pg8::cvt_pk_bf16(p1[6], p1[7]);
  w3.x = pg8::cvt_pk_bf16(p1[8], p1[9]); w3.y = pg8::cvt_pk_bf16(p1[10], p1[11]); w3.z = pg8::cvt_pk_bf16(p1[12], p1[13]); w3.w = pg8::cvt_pk_bf16(p1[14], p1[15]);
  pv(st.o, vb0 + L_V + slot * 8192, __builtin_bit_cast(bf16x8, w0), __builtin_bit_cast(bf16x8, w1), __builtin_bit_cast(bf16x8, w2), __builtin_bit_cast(bf16x8, w3));
}
__device__ __forceinline__ void finalize(SmState& st, float gate, f32x16 (&outacc)[2], LAS float* wsf, int r32, int hi, float& msafe, float& invl) {
  const float lt = swap_add(st.l); invl = lt > 0.f ? 1.0f / lt : 0.f; msafe = __builtin_fmaxf(st.m, -1.0e30f);
  if (hi == 0) wsf[r32] = gate * invl;
#pragma unroll
  for (int r = 0; r < 16; ++r) { const float fr = wsf[crow(r, hi)]; outacc[0][r] += st.o[0][r] * fr; outacc[1][r] += st.o[1][r] * fr; }
}
__device__ __forceinline__ void imp_step(LAS unsigned char* lds, int slot, const bf16x8 (&qr)[4], int r32, int hi, int khi, float msafe, float invl, LAS float* imph  , int tq, int T) {
  f32x16 p0, p1; qkt(p0, p1, lds + L_K + slot * 8192, qr, r32, hi);
  mask_range(p0, p1, 0, khi, hi);
#pragma unroll
  for (int r = 0; r < 16; ++r) { p0[r] = ex2(p0[r] - msafe) * invl; p1[r] = ex2(p1[r] - msafe) * invl; }
  LAS float* row = imph + tq * 64 + 16 * T + hi;
#pragma unroll
  for (int gq = 0; gq < 4; ++gq) { row[2 * gq] += (p0[4 * gq] + p0[4 * gq + 1]) + (p0[4 * gq + 2] + p0[4 * gq + 3]); row[2 * gq + 8] += (p1[4 * gq] + p1[4 * gq + 1]) + (p1[4 * gq + 2] + p1[4 * gq + 3]); }
  asm volatile("s_waitcnt lgkmcnt(0)" ::: "memory");
#pragma unroll
  for (int gq = 0; gq < 4; ++gq) { row[2 * gq + 1] += p0[4 * gq + 3]; if (16 * T + hi + 2 * gq + 9 < 64) row[2 * gq + 9] += p1[4 * gq + 3]; }
  asm volatile("s_waitcnt lgkmcnt(0)" ::: "memory");
}
__device__ __forceinline__ void topk_select(LAS unsigned char* lds, int wid, int lane, int i) {
  LAS float* IM = (LAS float*)(lds + L_IMP); LAS unsigned long long* MK = (LAS unsigned long long*)(lds + L_MASK);
  const int j = lane; const int nforced = i == 0 ? 1 : (i == 1 ? 2 : 3);
  const bool forced = (j <= i) && (j == 0 || j == i || j == i - 1); const bool cand = (j >= 1) && (j <= i - 2);
  for (int tq = wid; tq < 64; tq += 8) {
    const float v = (IM[tq * 64 + j] + IM[4096 + tq * 64 + j]) + (IM[8192 + tq * 64 + j] + IM[12288 + tq * 64 + j]);
    IM[tq * 64 + j] = v;
    asm volatile("s_waitcnt lgkmcnt(0)" ::: "memory");
    int cnt = 0;
    for (int jj = 1; jj <= i - 2; ++jj) { const float vv = IM[tq * 64 + jj]; cnt += (vv > v || (vv == v && jj < j)) ? 1 : 0; }
    const bool sel = forced || (cand && cnt < 16 - nforced);
    const unsigned long long mk = __ballot(sel);
    if (lane == 0) MK[tq] = mk;
  }
}

__device__ __forceinline__ void attn_unit(LAS unsigned char* lds, const Bufs& B, int b, int g, int i) {
  const int tid = fx::otid(), lane = tid & 63, wid = __builtin_amdgcn_readfirstlane(tid >> 6), r32 = lane & 31, hi = lane >> 5;
  const int e = wid >> 1, h = g * 4 + e, tq = 32 * (wid & 1) + r32; const size_t tok = (size_t)b * S + 64 * i + tq; const int t = 64 * i + tq;
  LAS float* wsf = (LAS float*)(lds + L_WSF) + wid * 64;
  LAS float* imph = (LAS float*)(lds + L_IMP) + e * 4096;
  const int vb0 = (int)(unsigned)(size_t)lds + ((lane >> 4) & 1) * 32 + (lane & 3) * 8 + (4 * hi + ((lane & 15) >> 2)) * 64;
  bf16x8 qr[4];
#pragma unroll
  for (int d0 = 0; d0 < 4; ++d0) qr[d0] = *(const bf16x8*)(B.QKV + tok * QKVW + h * 64 + d0 * 16 + hi * 8);
  const float g0 = B.NG[tok * 24 + h * 3 + 0], g1 = B.NG[tok * 24 + h * 3 + 1], g2 = B.NG[tok * 24 + h * 3 + 2];
  const u16* kc = B.KCMP + (size_t)(b * 2 + g) * 256 * 64; const u16* vc = B.VCMP + (size_t)(b * 2 + g) * 256 * 64;
  const u16* ksb = B.QKV + (size_t)b * S * QKVW + nv::O_KS + g * 64; const u16* vsb = B.QKV + (size_t)b * S * QKVW + nv::O_VS + g * 64;
  const u16* kwb = B.QKV + (size_t)b * S * QKVW + nv::O_KW + g * 64; const u16* vwb = B.QKV + (size_t)b * S * QKVW + nv::O_VW + g * 64;
  int nvis = t >= 31 ? (t - 31) / 16 + 1 : 0; nvis = nvis > 255 ? 255 : nvis;
  const int ntA = (4 * i + 3 + 63) / 64, nC = (i < 8 ? i : 8) + 1, jC0 = i - (nC - 1);
  const int sI = ntA, sB = 2 * ntA, sC = sB + i + 1, NS = sC + nC;
  { LAS float* IM = (LAS float*)(lds + L_IMP); for (int k = tid; k < 4 * 4096; k += 512) IM[k] = 0.f; }
  f32x16 outacc[2];
#pragma unroll
  for (int r = 0; r < 16; ++r) { outacc[0][r] = 0.f; outacc[1][r] = 0.f; }
  SmState st; sm_reset(st);
  float mA = -1.0e30f, invlA = 0.f; unsigned long long mybits = 0ull;
#define FA_ISSUE(s_) do { const int s__ = (s_); const int sl = s__ & 1; \
    if (s__ < sI) stage_kv(lds, sl, kc + (size_t)s__ * 4096, vc + (size_t)s__ * 4096, 64, wid, lane, true); \
    else if (s__ < sB) stage_kv(lds, sl, kc + (size_t)(s__ - sI) * 4096, vc, 64, wid, lane, false); \
    else if (s__ < sC) stage_kv(lds, sl, ksb + (size_t)(s__ - sB) * 64 * QKVW, vsb + (size_t)(s__ - sB) * 64 * QKVW, QKVW, wid, lane, true); \
    else stage_kv(lds, sl, kwb + (size_t)(jC0 + s__ - sC) * 64 * QKVW, vwb + (size_t)(jC0 + s__ - sC) * 64 * QKVW, QKVW, wid, lane, true); } while (0)
  FA_ISSUE(0);
  for (int s = 0; s < NS; ++s) {
    asm volatile("s_waitcnt vmcnt(0)" ::: "memory"); __syncthreads();
    if (s + 1 < NS) FA_ISSUE(s + 1);
    const int sl = s & 1;
    if (s < sI) { tile_step(st, lds, sl, qr, wsf, r32, hi, vb0, 0, nvis - 64 * s - 1);
      if (s == sI - 1) { finalize(st, g0, outacc, wsf, r32, hi, mA, invlA); sm_reset(st); } }
    else if (s < sB) { imp_step(lds, sl, qr, r32, hi, nvis - 64 * (s - sI) - 1, mA, invlA, imph, tq, s - sI);
      if (s == sB - 1) { __syncthreads(); topk_select(lds, wid, lane, i); __syncthreads(); mybits = ((const LAS unsigned long long*)(lds + L_MASK))[tq]; } }
    else if (s < sC) { const int j = s - sB; const bool selj = (mybits >> j) & 1ull; tile_step(st, lds, sl, qr, wsf, r32, hi, vb0, 0, selj ? (j == i ? tq : 63) : -1);
      if (s == sC - 1) { float d0_, d1_; finalize(st, g1, outacc, wsf, r32, hi, d0_, d1_); sm_reset(st); } }
    else { const int j = jC0 + (s - sC); tile_step(st, lds, sl, qr, wsf, r32, hi, vb0, (i >= 8 && j == i - 8) ? tq + 1 : 0, j == i ? tq : 63);
      if (s == NS - 1) { float d0_, d1_; finalize(st, g2, outacc, wsf, r32, hi, d0_, d1_); } }
  }
#undef FA_ISSUE
  { u16* Ow = B.YA + ((size_t)b * S + 64 * i + 32 * (wid & 1)) * 512 + h * 64; LAS u16* stg = (LAS u16*)(lds + L_OST) + wid * 2048;
#pragma unroll
    for (int r = 0; r < 16; ++r) { const int orow = crow(r, hi); stg[orow * 64 + r32] = nv::f2bf(outacc[0][r]); stg[orow * 64 + 32 + r32] = nv::f2bf(outacc[1][r]); }
    asm volatile("s_waitcnt lgkmcnt(0)" ::: "memory");
#pragma unroll
    for (int q = 0; q < 4; ++q) { const int row = q * 8 + (lane >> 3), ch = lane & 7; const u32x4 v = *(const LAS u32x4*)(stg + row * 64 + ch * 8); *(u32x4*)(Ow + (size_t)row * 512 + ch * 8) = v; } }
  __syncthreads();
}
__device__ __forceinline__ void phase_attention(LAS unsigned char* lds, const Bufs& B) {
  const int G = gridDim.x, bx = blockIdx.x; const int vcu = (G % 8 == 0) ? (bx % 8) * (G / 8) + bx / 8 : bx;
  for (int u = vcu; u < 256; u += G) { const int bg = u >> 4, s = u & 15;
#pragma unroll 1
    for (int k = 0; k < 4; ++k) { const int i = (k == 0) ? s : (k == 1) ? 31 - s : (k == 2) ? 32 + s : 63 - s; attn_unit(lds, B, bg >> 1, bg & 1, i); } }
}
}
struct Params { nv::Inputs I; float* out; unsigned char* ws; };
constexpr int LDS_BYTES = 147456;
template <class F> __device__ __forceinline__ void run_phase(const F& f, long n) {
  for (long i = blockIdx.x * 512L + fx::otid(); i < n; i += (long)gridDim.x * 512L) f(i);
}
__global__ void __launch_bounds__(512) mega_fwd(Params P) {
  extern __shared__ __attribute__((aligned(16))) unsigned char lds_raw[];
  LAS unsigned char* lds = (LAS unsigned char*)lds_raw;
  cg::grid_group grid = cg::this_grid();
  nv::Bufs B; const size_t woff = nv::carve(B, P.ws, P.out); fx::WBufs W; const size_t moff = fx::carve_w(W, P.ws, woff); fx::MoeBufs M; fx::carve_moe(M, B, P.ws, moff);
  float* out = P.out;
#define RUN(f, n) { run_phase(f, n); grid.sync(); }
  fx::phase_prologue(lds, P.I, B, W); fx::prologue_moe(P.I, M); grid.sync();
  fx::dense_gemm(lds, B.HB, 1024, W.WinT, 1024, nv::NTOK, fx::INW_PAD, 1024, fx::FInProj{B.QKV, B.Z, B.XBC, B.BG, B.NG, B.DT, P.I.dt_bias}); grid.sync();
  fa::phase_qknorm(P.I, B); grid.sync();
  NV2_STAGE_COMPRESS(RUN, P.I, B, out)
  fa::phase_attention(lds, B); grid.sync();
  NV2_STAGE_SSD(RUN, P.I, B, out)
  fx::dense_gemm(lds, B.YA, 512, W.WaT, 512, nv::NTOK, 1024, 512, fx::FStoreBf{B.T1, 1024});
  fx::dense_gemm(lds, B.YB, 1024, W.WbT, 1024, nv::NTOK, 1024, 1024, fx::FMerge{B.T1, B.BG, B.MERGED}); grid.sync();
  fx::dense_gemm(lds, B.MERGED, 1024, W.WoutT, 1024, nv::NTOK, 1024, 1024, fx::FResid{P.I.x, out}); grid.sync();
  fx::phase_rms_rows(out, P.I.moe_norm, B.H2); grid.sync();
  fx::dense_gemm(lds, B.H2, 1024, M.WrT, 1024, nv::NTOK, 256, 1024, fx::FLogits{M.LOGITS}); grid.sync();
  fx::phase_route(P.I, B, M); grid.sync();
  fx::build_tile_table(lds, M);
  fx::phase_moe_gu(lds, B, W, M); grid.sync();
  fx::phase_moe_down(lds, B, W, M); grid.sync();
  fx::phase_moe_combine(out, M.MOEOUT, P.I.ple_norm, B.H2); grid.sync();
  fx::dense_gemm(lds, W.PB, 256, W.PlePT, 256, nv::NTOK, 1024, 256, fx::FStoreBf{B.PP, 1024});
  fx::dense_gemm(lds, B.H2, 1024, W.PleGT, 1024, nv::NTOK, 1024, 1024, fx::FPle{out, B.PP});
#undef RUN
}
extern "C" void kernel_launch(void* const* d_in, const int* in_sizes, int n_in, void* d_out, int out_size, void* d_ws, size_t ws_size, hipStream_t stream) {
  static int grid_blocks = 0;
  if (!grid_blocks) {
    int dev = 0, cus = 0, per_cu = 0;
    (void)hipGetDevice(&dev);
    (void)hipDeviceGetAttribute(&cus, hipDeviceAttributeMultiprocessorCount, dev);
    if (hipFuncSetAttribute((const void*)mega_fwd, hipFuncAttributeMaxDynamicSharedMemorySize, LDS_BYTES) != hipSuccess) fprintf(stderr, "kernel_launch: hipFuncSetAttribute failed\n");
    if (hipOccupancyMaxActiveBlocksPerMultiprocessor(&per_cu, mega_fwd, 512, LDS_BYTES) != hipSuccess || per_cu < 1) { fprintf(stderr, "kernel_launch: occupancy query says %d blocks per CU\n", per_cu); }
    grid_blocks = cus;
    { nv::Bufs B; fx::WBufs W; fx::MoeBufs M; size_t need = fx::carve_moe(M, B, nullptr, fx::carve_w(W, nullptr, nv::carve(B, nullptr, nullptr))); if (need > ws_size) fprintf(stderr, "kernel_launch: workspace too small: need %zu have %zu\n", need, ws_size); }
  }
  Params p; memset(&p, 0, sizeof(p));
  const float** ip = (const float**)&p.I; for (int i = 0; i < 34; ++i) ip[i] = (const float*)d_in[i];
  p.out = (float*)d_out; p.ws = (unsigned char*)d_ws;
  void* args[] = {&p};
  hipError_t e = hipLaunchCooperativeKernel((void*)mega_fwd, dim3(grid_blocks), dim3(512), args, LDS_BYTES, stream);
  if (e != hipSuccess) fprintf(stderr, "cooperative launch failed: %s (grid %d)\n", hipGetErrorString(e), grid_blocks);
}
```

```cpp
#include <hip/hip_runtime.h>
#include <hip/hip_cooperative_groups.h>
#include <cstdio>
#include <cstring>
namespace cg = cooperative_groups;
#define HD __host__ __device__ inline
#if defined(__HIP_DEVICE_COMPILE__)
#define NV_FENCE() asm volatile("" ::: "memory")
#else
#define NV_FENCE()
#endif
#ifndef CFG_DM
#define CFG_DM 1024
#endif
#ifndef CFG_BATCH
#define CFG_BATCH 8
#endif
#ifndef CFG_SEQ
#define CFG_SEQ 4096
#endif
#ifndef CFG_MH
#define CFG_MH 256
#endif
#ifndef CFG_PLE
#define CFG_PLE 256
#endif

#ifndef NV_FENCE
#define NV_FENCE()
#endif
namespace nv {
typedef unsigned short u16;
typedef unsigned long long u64;
constexpr int DM = CFG_DM, NB = CFG_BATCH, S = CFG_SEQ, MH = CFG_MH, PLE = CFG_PLE;
constexpr int NTOK = NB * S;
constexpr int H = 8, G = 2, E = 4;
constexpr int QW = 512, GW = 24, QKVW = 1280;
constexpr int SH = 16, SP = 64, SI = 1024, SG = 2, SN = 128, SCD = 1536;
constexpr int INW = QW + 6 * 128 + GW + SI + SCD + SH + 2 * DM;
constexpr int O_Q = 0, O_KC = 512, O_VC = 640, O_KS = 768, O_VS = 896, O_KW = 1024, O_VW = 1152, O_NG = 1280, O_Z = 1304, O_XBC = 2328, O_DT = 3864, O_BG = 3880;
static_assert(O_BG + 2 * DM == INW, "in-proj width");
constexpr int NCMP = S / 16 - 1, NCP = S / 16, NSEL = S / 64, NTOP = NSEL < 16 ? NSEL : 16;
constexpr int NEXP = 32;
constexpr float EPS = 1e-6f;

HD float sigmoidf_(float x) { return 1.0f / (1.0f + expf(-x)); }
HD float siluf_(float x) { return x / (1.0f + expf(-x)); }
HD float softplusf_(float x) { return x > 20.f ? x : log1pf(expf(x)); }
HD u16 f2bf(float f) { unsigned u = __builtin_bit_cast(unsigned, f); u += 0x7fffu + ((u >> 16) & 1u); return (u16)(u >> 16); }
HD float bf2f(u16 h) { return __builtin_bit_cast(float, (unsigned)h << 16); }

struct Bufs {
  u16* HB;
  u16* QKV;
  float* NG;
  u16* Z;
  u16* XBC;
  float* DT;
  u16* BG;
  u16* KCMP;
  u16* VCMP;
  u16* YA;
  u16* YB;
  u16* T1;
  u16* MERGED;
  u16* H2;
  u16* ACT;
  u16* PP;
  int* EI;
  float* EW;
  float* HID;
  float* KTMP;
  float* ML;
  float* IMP;
  u64* MASK;
};
struct Inputs { const float *x, *p, *mix_norm, *w_in, *q_gain, *kc_gain, *ks_gain, *kw_gain, *pos_k, *w1_k, *w2_k, *pos_v, *w1_v, *w2_v, *conv_w, *conv_b, *dt_bias, *a_log, *d_skip, *ssm_norm,
  *w_a, *w_b, *w_out, *moe_norm, *w_group, *b_group, *w_expert, *b_expert, *w_gate, *w_up, *w_down, *ple_norm, *ple_wg, *ple_wp; };

struct RmsRowsBf { const float* in; const float* gain; u16* out; long ncols;
  HD void operator()(long r) const { const float* x = in + r * ncols; float s = 0.f; for (long c = 0; c < ncols; ++c) s += x[c] * x[c];
    const float rs = 1.0f / sqrtf(s / (float)ncols + EPS); u16* o = out + r * ncols; for (long c = 0; c < ncols; ++c) o[c] = f2bf(x[c] * rs * gain[c]); } };

template <class AL, class EP> struct GemmT { AL a; const float* B; EP ep; long M, N, K, ldb;
  HD long items() const { return ((M + 7) / 8) * ((N + 3) / 4); }
  HD void operator()(long it) const { const long nt = (N + 3) / 4; const long tm = it / nt, tn = it % nt; const long r0 = tm * 8, c0 = tn * 4;
    float acc[8][4];
#pragma unroll
    for (int i = 0; i < 8; ++i)
#pragma unroll
      for (int j = 0; j < 4; ++j) acc[i][j] = 0.f;
    for (long k = 0; k < K; ++k) { float b[4];
#pragma unroll
      for (int j = 0; j < 4; ++j) b[j] = (c0 + j < N) ? B[k * ldb + c0 + j] : 0.f;
#pragma unroll
      for (int i = 0; i < 8; ++i) { const long r = r0 + i < M ? r0 + i : M - 1; const float av = a(r, k);
#pragma unroll
        for (int j = 0; j < 4; ++j) acc[i][j] += av * b[j]; } }
#pragma unroll
    for (int i = 0; i < 8; ++i) if (r0 + i < M) {
#pragma unroll
      for (int j = 0; j < 4; ++j) if (c0 + j < N) ep(r0 + i, c0 + j, acc[i][j]); } } };
struct ABf { const u16* p; long ld; HD float operator()(long r, long k) const { return bf2f(p[r * ld + k]); } };
struct AF32 { const float* p; long ld; HD float operator()(long r, long k) const { return p[r * ld + k]; } };
struct ACmp { const u16* qkv; const float* pos; long off;
  HD float operator()(long r, long k) const { const long c = r % NCMP, bg = r / NCMP, b = bg / G, g = bg % G; const long l = k / 64, d = k % 64;
    return bf2f(qkv[(b * S + 16 * c + l) * QKVW + off + g * 64 + d]) + pos[k]; } };

struct EpInProj { Bufs B; const float* dt_bias;
  HD void operator()(long r, long c, float v) const {
    if (c < O_NG) B.QKV[r * QKVW + c] = f2bf(v);
    else if (c < O_Z) B.NG[r * GW + (c - O_NG)] = sigmoidf_(v);
    else if (c < O_XBC) B.Z[r * SI + (c - O_Z)] = f2bf(v);
    else if (c < O_DT) B.XBC[r * SCD + (c - O_XBC)] = f2bf(v);
    else if (c < O_BG) B.DT[r * SH + (c - O_DT)] = softplusf_(v + dt_bias[c - O_DT]);
    else B.BG[r * (2 * DM) + (c - O_BG)] = f2bf(sigmoidf_(v)); } };
struct EpSiluF32 { float* o; long ld; HD void operator()(long r, long c, float v) const { o[r * ld + c] = siluf_(v); } };
struct EpF32 { float* o; long ld; HD void operator()(long r, long c, float v) const { o[r * ld + c] = v; } };
struct EpBf { u16* o; long ld; HD void operator()(long r, long c, float v) const { o[r * ld + c] = f2bf(v); } };
struct EpMerge { const u16* t1; const u16* bg; u16* o; HD void operator()(long r, long c, float v) const { const float ga = bf2f(bg[r * (2 * DM) + c]), gb = bf2f(bg[r * (2 * DM) + DM + c]); o[r * DM + c] = f2bf(ga * bf2f(t1[r * DM + c]) + gb * v); } };
struct EpResid { const float* x; float* o; HD void operator()(long r, long c, float v) const { o[r * DM + c] = x[r * DM + c] + v; } };
struct EpPle { float* x; const u16* pp; HD void operator()(long r, long c, float v) const { x[r * DM + c] = x[r * DM + c] + sigmoidf_(v) * bf2f(pp[r * DM + c]); } };

struct QkNorm { u16* qkv; const float* qg; const float* ksg; const float* kwg;
  HD long items() const { return (long)NTOK * 12; }
  HD void operator()(long it) const { const long tok = it / 12; const int w = (int)(it % 12); u16* v; const float* gain;
    if (w < 8) { v = qkv + tok * QKVW + O_Q + w * 64; gain = qg; } else if (w < 10) { v = qkv + tok * QKVW + O_KS + (w - 8) * 64; gain = ksg; } else { v = qkv + tok * QKVW + O_KW + (w - 10) * 64; gain = kwg; }
    float s = 0.f; for (int d = 0; d < 64; ++d) { const float x = bf2f(v[d]); s += x * x; } const float rs = 1.0f / sqrtf(s / 64.f + EPS);
    for (int d = 0; d < 64; ++d) v[d] = f2bf(bf2f(v[d]) * rs * gain[d]); } };
struct CmpFinish { const float* src; const float* gain; u16* dst; long donorm;
  HD long items() const { return (long)NB * G * NCP; }
  HD void operator()(long it) const { const long c = it % NCP, bg = it / NCP; u16* o = dst + it * 64;
    if (c >= NCMP) { for (int d = 0; d < 64; ++d) o[d] = 0; return; }
    const float* x = src + (bg * NCMP + c) * 64; float rs = 1.f;
    if (donorm) { float s = 0.f; for (int d = 0; d < 64; ++d) s += x[d] * x[d]; rs = 1.0f / sqrtf(s / 64.f + EPS); }
    for (int d = 0; d < 64; ++d) o[d] = f2bf(donorm ? x[d] * rs * gain[d] : x[d]); } };

struct CmpAttn { Bufs B;
  HD long items() const { return (long)NB * H * S; }
  HD void operator()(long it) const { const long t = it % S; const int h = (int)((it / S) % H), g = h / E; const long b = it / ((long)S * H); const long tok = b * S + t;
    const u16* q = B.QKV + tok * QKVW + O_Q + h * 64; const u16* kc = B.KCMP + (b * G + g) * (long)NCP * 64; const u16* vc = B.VCMP + (b * G + g) * (long)NCP * 64;
    float qr[64];
#pragma unroll
    for (int d = 0; d < 64; ++d) qr[d] = bf2f(q[d]);
    long nvis = (t - 31 >= 0) ? (t - 31) / 16 + 1 : 0; if (nvis > NCMP) nvis = NCMP;
    float m = -3.0e38f;
    for (long c = 0; c < nvis; ++c) { const u16* k = kc + c * 64; float s = 0.f;
#pragma unroll
      for (int d = 0; d < 64; ++d) s += qr[d] * bf2f(k[d]);
      s *= 0.125f; m = s > m ? s : m; }
    float o[64];
#pragma unroll
    for (int d = 0; d < 64; ++d) o[d] = 0.f;
    float l = 0.f;
    for (long c = 0; c < nvis; ++c) { const u16* k = kc + c * 64; const u16* v = vc + c * 64; float s = 0.f;
#pragma unroll
      for (int d = 0; d < 64; ++d) s += qr[d] * bf2f(k[d]);
      const float p = expf(s * 0.125f - m); l += p;
#pragma unroll
      for (int d = 0; d < 64; ++d) o[d] += p * bf2f(v[d]); }
    const float g0 = B.NG[tok * GW + h * 3 + 0]; const float inv = nvis > 0 ? g0 / l : 0.f;
#pragma unroll
    for (int d = 0; d < 64; ++d) B.YA[tok * QW + h * 64 + d] = f2bf(o[d] * inv);
    B.ML[it * 2] = m; B.ML[it * 2 + 1] = nvis > 0 ? l : 0.f; } };
struct Importance { Bufs B;
  HD long items() const { return (long)NB * G * S * NSEL; }
  HD void operator()(long it) const { const int j = (int)(it % NSEL); const long bgt = it / NSEL; const long t = bgt % S; const long bg = bgt / S; const long b = bg / G; const int g = (int)(bg % G); const long tok = b * S + t;
    long nvis = (t - 31 >= 0) ? (t - 31) / 16 + 1 : 0; if (nvis > NCMP) nvis = NCMP;
    long c0 = 4 * j - 1; if (c0 < 0) c0 = 0; long c1 = 4 * j + 3; if (c1 > nvis - 1) c1 = nvis - 1;
    const u16* kc = B.KCMP + bg * (long)NCP * 64; float acc = 0.f;
    for (int e = 0; e < E; ++e) { const int h = g * E + e; const u16* q = B.QKV + tok * QKVW + O_Q + h * 64; const long mi = ((b * H + h) * (long)S + t) * 2; const float m = B.ML[mi], l = B.ML[mi + 1];
      if (l > 0.f) for (long c = c0; c <= c1; ++c) { const u16* k = kc + c * 64; float s = 0.f; for (int d = 0; d < 64; ++d) s += bf2f(q[d]) * bf2f(k[d]); acc += expf(s * 0.125f - m) / l; } }
    B.IMP[bgt * 64 + j] = acc; } };
struct TopSel { Bufs B;
  HD long items() const { return (long)NB * G * S; }
  HD void operator()(long bgt) const { const long t = bgt % S; const int cur = (int)(t / 64); u64 m = 0ull;
    for (int r = 0; r < NTOP; ++r) { float best = -3.0e38f; int bj = -1;
      for (int j = 0; j <= cur && j < NSEL; ++j) { if ((m >> j) & 1ull) continue; float v = B.IMP[bgt * 64 + j]; if (j == 0 || j == cur || j == cur - 1) v += 1000.f; if (v > best) { best = v; bj = j; } }
      if (bj < 0) break; m |= 1ull << bj; }
    B.MASK[bgt] = m; } };
struct SelAttn { Bufs B;
  HD long items() const { return (long)NB * H * S; }
  HD void operator()(long it) const { const long t = it % S; const int h = (int)((it / S) % H), g = h / E; const long b = it / ((long)S * H); const long tok = b * S + t;
    const u16* q = B.QKV + tok * QKVW + O_Q + h * 64; const u64 mk = B.MASK[(b * G + g) * (long)S + t];
    float qr[64], o[64];
#pragma unroll
    for (int d = 0; d < 64; ++d) { qr[d] = bf2f(q[d]); o[d] = 0.f; }
    float m = -3.0e38f, l = 0.f;
    for (int j = 0; j < NSEL; ++j) { if (!((mk >> j) & 1ull)) continue;
      for (long kp = 64L * j; kp < 64L * j + 64 && kp <= t; ++kp) { const u16* k = B.QKV + (b * S + kp) * QKVW + O_KS + g * 64; const u16* v = B.QKV + (b * S + kp) * QKVW + O_VS + g * 64; float s = 0.f;
#pragma unroll
        for (int d = 0; d < 64; ++d) s += qr[d] * bf2f(k[d]);
        s *= 0.125f;
        if (s > m) { const float f = expf(m - s); l *= f;
#pragma unroll
          for (int d = 0; d < 64; ++d) o[d] *= f;
          m = s; }
        const float p = expf(s - m); l += p;
#pragma unroll
        for (int d = 0; d < 64; ++d) o[d] += p * bf2f(v[d]); } }
    const float g1 = B.NG[tok * GW + h * 3 + 1]; const float inv = g1 / l;
#pragma unroll
    for (int d = 0; d < 64; ++d) { u16* y = B.YA + tok * QW + h * 64 + d; *y = f2bf(bf2f(*y) + o[d] * inv); } } };
struct WinAttn { Bufs B;
  HD long items() const { return (long)NB * H * S; }
  HD void operator()(long it) const { const long t = it % S; const int h = (int)((it / S) % H), g = h / E; const long b = it / ((long)S * H); const long tok = b * S + t;
    const u16* q = B.QKV + tok * QKVW + O_Q + h * 64;
    float qr[64], o[64];
#pragma unroll
    for (int d = 0; d < 64; ++d) { qr[d] = bf2f(q[d]); o[d] = 0.f; }
    float m = -3.0e38f, l = 0.f; long k0 = t - 511; if (k0 < 0) k0 = 0;
    for (long kp = k0; kp <= t; ++kp) { const u16* k = B.QKV + (b * S + kp) * QKVW + O_KW + g * 64; const u16* v = B.QKV + (b * S + kp) * QKVW + O_VW + g * 64; float s = 0.f;
#pragma unroll
      for (int d = 0; d < 64; ++d) s += qr[d] * bf2f(k[d]);
      s *= 0.125f;
      if (s > m) { const float f = expf(m - s); l *= f;
#pragma unroll
        for (int d = 0; d < 64; ++d) o[d] *= f;
        m = s; }
      const float p = expf(s - m); l += p;
#pragma unroll
      for (int d = 0; d < 64; ++d) o[d] += p * bf2f(v[d]); }
    const float g2 = B.NG[tok * GW + h * 3 + 2]; const float inv = g2 / l;
#pragma unroll
    for (int d = 0; d < 64; ++d) { u16* y = B.YA + tok * QW + h * 64 + d; *y = f2bf(bf2f(*y) + o[d] * inv); } } };

struct SsdConv { u16* xbc; const float* cw; const float* cb;
  HD long items() const { return (long)NB * SCD; }
  HD void operator()(long it) const { const int c = (int)(it % SCD); const long b = it / SCD; u16* col = xbc + b * S * SCD + c; const float w0 = cw[c], w1 = cw[SCD + c], w2 = cw[2 * SCD + c], w3 = cw[3 * SCD + c], bias = cb[c];
    for (long t = S - 1; t >= 0; --t) { float a = bias + w3 * bf2f(col[t * SCD]); if (t >= 1) a += w2 * bf2f(col[(t - 1) * SCD]); if (t >= 2) a += w1 * bf2f(col[(t - 2) * SCD]); if (t >= 3) a += w0 * bf2f(col[(t - 3) * SCD]);
      col[t * SCD] = f2bf(siluf_(a)); } } };
struct SsdScan { Bufs B; const float* alog; const float* dskip;
  HD long items() const { return (long)NB * SH * SP; }
  HD void operator()(long it) const { const int p = (int)(it % SP); const int hh = (int)((it / SP) % SH); const long b = it / (SP * SH); const int g = hh / 8;
    const float a = -expf(alog[hh]); float st[128];
#pragma unroll
    for (int n = 0; n < 128; ++n) st[n] = 0.f;
    for (long t = 0; t < S; ++t) { const long tok = b * S + t; const float dt = B.DT[tok * SH + hh]; const float dec = expf(dt * a); const float xd = bf2f(B.XBC[tok * SCD + hh * 64 + p]) * dt;
      const u16* Bv = B.XBC + tok * SCD + SI + g * SN; const u16* Cv = B.XBC + tok * SCD + SI + SG * SN + g * SN; float y = 0.f;
#pragma unroll
      for (int n = 0; n < 128; ++n) { st[n] = st[n] * dec + xd * bf2f(Bv[n]); y += bf2f(Cv[n]) * st[n]; if ((n & 15) == 15) { NV_FENCE(); } }
      B.XBC[tok * SCD + hh * 64 + p] = f2bf(y + bf2f(B.XBC[tok * SCD + hh * 64 + p]) * dskip[hh]); } } };
struct SsdOut { Bufs B; const float* ngain;
  HD long items() const { return (long)NTOK * SG; }
  HD void operator()(long it) const { const long tok = it / SG; const int g = (int)(it % SG); float s = 0.f;
    for (int c = g * 512; c < g * 512 + 512; ++c) { float y = bf2f(B.XBC[tok * SCD + c]); y *= siluf_(bf2f(B.Z[tok * SI + c])); s += y * y; }
    const float rs = 1.0f / sqrtf(s / 512.f + EPS);
    for (int c = g * 512; c < g * 512 + 512; ++c) { float y = bf2f(B.XBC[tok * SCD + c]); y *= siluf_(bf2f(B.Z[tok * SI + c])); B.YB[tok * SI + c] = f2bf(y * rs * ngain[c]); } } };

struct Router { const u16* h2; const float* wg; const float* bg; const float* we; const float* be; int* ei; float* ew;
  HD void operator()(long tok) const { const u16* x = h2 + tok * DM; float gl[4];
#pragma unroll
    for (int j = 0; j < 4; ++j) gl[j] = bg[j];
    for (long d = 0; d < DM; ++d) { const float xv = bf2f(x[d]);
#pragma unroll
      for (int j = 0; j < 4; ++j) gl[j] += xv * wg[d * 4 + j]; }
    int gi = 0; float gm = gl[0];
#pragma unroll
    for (int j = 1; j < 4; ++j) if (gl[j] > gm) { gm = gl[j]; gi = j; }
    float gs = 0.f;
#pragma unroll
    for (int j = 0; j < 4; ++j) gs += expf(gl[j] - gm);
    const float grp_w = 1.0f / gs;
    float el[8];
#pragma unroll
    for (int j = 0; j < 8; ++j) el[j] = be[gi * 8 + j];
    for (long d = 0; d < DM; ++d) { const float xv = bf2f(x[d]);
#pragma unroll
      for (int j = 0; j < 8; ++j) el[j] += xv * we[d * NEXP + gi * 8 + j]; }
    int i0 = 0; float m0 = el[0];
#pragma unroll
    for (int j = 1; j < 8; ++j) if (el[j] > m0) { m0 = el[j]; i0 = j; }
    int i1 = -1; float m1 = -3.0e38f;
#pragma unroll
    for (int j = 0; j < 8; ++j) if (j != i0 && el[j] > m1) { m1 = el[j]; i1 = j; }
    const float r = expf(m1 - m0); const float w0 = 1.0f / (1.0f + r), w1 = r / (1.0f + r);
    ei[tok * 2] = gi * 8 + i0; ei[tok * 2 + 1] = gi * 8 + i1; ew[tok * 2] = grp_w * w0; ew[tok * 2 + 1] = grp_w * w1; } };
struct MoeHidden { const u16* h2; const float* wgate; const float* wup; const int* ei; u16* act;
  HD long items() const { return (long)NTOK * 2 * MH; }
  HD void operator()(long it) const { const int j = (int)(it % MH); const long tk = it / MH; const long tok = tk / 2; const int e = ei[tk]; const u16* x = h2 + tok * DM;
    const float* wg_ = wgate + (long)e * DM * MH + j; const float* wu_ = wup + (long)e * DM * MH + j; float a = 0.f, b = 0.f;
    for (long d = 0; d < DM; ++d) { const float xv = bf2f(x[d]); a += xv * wg_[d * MH]; b += xv * wu_[d * MH]; }
    act[it] = f2bf(siluf_(a) * b); } };
struct MoeDown { const u16* act; const float* wdown; const int* ei; const float* ew; float* x;
  HD long items() const { return (long)NTOK * DM; }
  HD void operator()(long it) const { const int c = (int)(it % DM); const long tok = it / DM; float tot = 0.f;
    for (int k = 0; k < 2; ++k) { const int e = ei[tok * 2 + k]; const u16* a = act + (tok * 2 + k) * MH; const float* w = wdown + (long)e * MH * DM + c; float s = 0.f;
      for (int j = 0; j < MH; ++j) s += bf2f(a[j]) * w[(long)j * DM];
      tot += ew[tok * 2 + k] * s; }
    x[it] += tot; } };

#define NV2_STAGE_PREP(RUN, I, B, out)      { nv::RmsRowsBf f{I.x, I.mix_norm, B.HB, nv::DM}; RUN(f, (long)nv::NTOK); }
#define NV2_STAGE_INPROJ(RUN, I, B, out)    { nv::GemmT<nv::ABf, nv::EpInProj> f{nv::ABf{B.HB, nv::DM}, I.w_in, nv::EpInProj{B, I.dt_bias}, nv::NTOK, nv::INW, nv::DM, nv::INW}; RUN(f, f.items()); }
#define NV2_STAGE_QKNORM(RUN, I, B, out)    { nv::QkNorm f{B.QKV, I.q_gain, I.ks_gain, I.kw_gain}; RUN(f, f.items()); }
#define NV2_STAGE_COMPRESS(RUN, I, B, out)  { \
    { nv::GemmT<nv::ACmp, nv::EpSiluF32> f{nv::ACmp{B.QKV, I.pos_k, nv::O_KC}, I.w1_k, nv::EpSiluF32{B.HID, 128}, (long)nv::NB * nv::G * nv::NCMP, 128, 2048, 128}; RUN(f, f.items()); } \
    { nv::GemmT<nv::AF32, nv::EpF32> f{nv::AF32{B.HID, 128}, I.w2_k, nv::EpF32{B.KTMP, 64}, (long)nv::NB * nv::G * nv::NCMP, 64, 128, 64}; RUN(f, f.items()); } \
    { nv::CmpFinish f{B.KTMP, I.kc_gain, B.KCMP, 1}; RUN(f, f.items()); } \
    { nv::GemmT<nv::ACmp, nv::EpSiluF32> f{nv::ACmp{B.QKV, I.pos_v, nv::O_VC}, I.w1_v, nv::EpSiluF32{B.HID, 128}, (long)nv::NB * nv::G * nv::NCMP, 128, 2048, 128}; RUN(f, f.items()); } \
    { nv::GemmT<nv::AF32, nv::EpF32> f{nv::AF32{B.HID, 128}, I.w2_v, nv::EpF32{B.KTMP, 64}, (long)nv::NB * nv::G * nv::NCMP, 64, 128, 64}; RUN(f, f.items()); } \
    { nv::CmpFinish f{B.KTMP, I.kc_gain, B.VCMP, 0}; RUN(f, f.items()); } }
#define NV2_STAGE_ATTN(RUN, I, B, out)      { \
    { nv::CmpAttn f{B}; RUN(f, f.items()); } { nv::Importance f{B}; RUN(f, f.items()); } { nv::TopSel f{B}; RUN(f, f.items()); } { nv::SelAttn f{B}; RUN(f, f.items()); } { nv::WinAttn f{B}; RUN(f, f.items()); } }
#define NV2_STAGE_SSD(RUN, I, B, out)       { \
    { nv::SsdConv f{B.XBC, I.conv_w, I.conv_b}; RUN(f, f.items()); } { nv::SsdScan f{B, I.a_log, I.d_skip}; RUN(f, f.items()); } { nv::SsdOut f{B, I.ssm_norm}; RUN(f, f.items()); } }
#define NV2_STAGE_MERGE(RUN, I, B, out)     { \
    { nv::GemmT<nv::ABf, nv::EpBf> f{nv::ABf{B.YA, nv::QW}, I.w_a, nv::EpBf{B.T1, nv::DM}, nv::NTOK, nv::DM, nv::QW, nv::DM}; RUN(f, f.items()); } \
    { nv::GemmT<nv::ABf, nv::EpMerge> f{nv::ABf{B.YB, nv::SI}, I.w_b, nv::EpMerge{B.T1, B.BG, B.MERGED}, nv::NTOK, nv::DM, nv::SI, nv::DM}; RUN(f, f.items()); } \
    { nv::GemmT<nv::ABf, nv::EpResid> f{nv::ABf{B.MERGED, nv::DM}, I.w_out, nv::EpResid{I.x, out}, nv::NTOK, nv::DM, nv::DM, nv::DM}; RUN(f, f.items()); } }
#define NV2_STAGE_MOE(RUN, I, B, out)       { \
    { nv::RmsRowsBf f{out, I.moe_norm, B.H2, nv::DM}; RUN(f, (long)nv::NTOK); } \
    { nv::Router f{B.H2, I.w_group, I.b_group, I.w_expert, I.b_expert, B.EI, B.EW}; RUN(f, (long)nv::NTOK); } \
    { nv::MoeHidden f{B.H2, I.w_gate, I.w_up, B.EI, B.ACT}; RUN(f, f.items()); } \
    { nv::MoeDown f{B.ACT, I.w_down, B.EI, B.EW, out}; RUN(f, f.items()); } }
#define NV2_STAGE_PLE(RUN, I, B, out)       { \
    { nv::RmsRowsBf f{out, I.ple_norm, B.H2, nv::DM}; RUN(f, (long)nv::NTOK); } \
    { nv::GemmT<nv::AF32, nv::EpBf> f{nv::AF32{I.p, nv::PLE}, I.ple_wp, nv::EpBf{B.PP, nv::DM}, nv::NTOK, nv::DM, nv::PLE, nv::DM}; RUN(f, f.items()); } \
    { nv::GemmT<nv::ABf, nv::EpPle> f{nv::ABf{B.H2, nv::DM}, I.ple_wg, nv::EpPle{out, B.PP}, nv::NTOK, nv::DM, nv::DM, nv::DM}; RUN(f, f.items()); } }

HD size_t carve(Bufs& B, unsigned char* ws, float* out) {
  size_t off = 0; auto take = [&](size_t bytes) { unsigned char* r = ws + off; off += (bytes + 255) / 256 * 256; return r; };
  const size_t N = NTOK;
  B.BG = (u16*)out;
  unsigned char* R0 = take(N * DM * 2);
  unsigned char* R5 = take(N * 2 * MH * 2 + (size_t)NEXP * 256 * MH * 2);
  B.YA = (u16*)take(N * QW * 2);
  unsigned char* R1 = take(N * QKVW * 2);
  unsigned char* R2 = take(N * SI * 2);
  unsigned char* R3 = take(N * SCD * 2);
  B.HB = (u16*)R0; B.H2 = (u16*)R0; B.QKV = (u16*)R1; B.T1 = (u16*)R1; B.Z = (u16*)R2; B.XBC = (u16*)R3; B.MERGED = (u16*)R3; B.PP = (u16*)R3;
  B.ACT = (u16*)R5; B.YB = B.Z;
  B.NG = (float*)take(N * GW * 4); B.DT = (float*)take(N * SH * 4);
  B.KCMP = (u16*)take((size_t)NB * G * NCP * 64 * 2); B.VCMP = (u16*)take((size_t)NB * G * NCP * 64 * 2);
  B.EI = (int*)take(N * 2 * 4); B.EW = (float*)take(N * 2 * 4);
  B.HID = (float*)take((size_t)NB * G * NCMP * 128 * 4); B.KTMP = (float*)take((size_t)NB * G * NCMP * 64 * 4);
  B.ML = (float*)take(N * H * 2 * 4); B.IMP = (float*)take((size_t)NB * G * S * 64 * 4); B.MASK = (u64*)take((size_t)NB * G * S * 8);
  return off;
}
}
namespace pg8 {
#define PG8_LAS __attribute__((address_space(3)))
typedef unsigned short bf16_t;
typedef short bf16x8 __attribute__((ext_vector_type(8)));
typedef float f32x4 __attribute__((ext_vector_type(4)));
typedef unsigned u32x4 __attribute__((ext_vector_type(4)));
typedef unsigned u32x2 __attribute__((ext_vector_type(2)));
constexpr int BM = 256, BK = 64, HALF = 128, HTB = HALF * BK * 2  , STAGE_BYTES = 8 * HTB, NXCD = 8, WGM = 8;

__host__ __device__ __forceinline__ int lds_byte(int r, int c) { const int st = (r >> 4) * 2 + (c >> 5), rr = r & 15, cc = c & 31, ob = rr * 64 + cc * 2; return st * 1024 + (ob ^ (((ob >> 9) & 1) << 5)); }
__host__ __device__ __forceinline__ void stage_rc(int b, int& R, int& C) { const int st = b / 1024, sb = b % 1024, swz = sb ^ (((sb >> 9) & 1) << 5); R = (st >> 1) * 16 + swz / 64; C = (st & 1) * 32 + (swz % 64) / 2; }
__host__ __device__ __forceinline__ int perm32(int rho) { const int n = rho >> 4, i = rho & 15; return 8 * (i >> 2) + 4 * n + (i & 3); }

struct Unit { int pm, pn, aux0, aux1; };
struct Gemm { const bf16_t* A; const bf16_t* Bt; int M, N, K, lda, ldb; };

struct StaticOrder {
    int nM, nN, nwg, G, c;
    __device__ void init(int M, int N, int G_, int c_) { nM = M / BM; nN = N / BM; nwg = nM * nN; G = G_; c = c_; }
    __device__ bool next(int i, Unit& u) const {
        const long L = (long)i * G + c; if (L >= nwg) return false;
        int wgid = (int)L; { const int q = nwg / NXCD, r = nwg % NXCD, xcd = wgid % NXCD, off = wgid / NXCD; wgid = (xcd < r ? xcd * (q + 1) : r * (q + 1) + (xcd - r) * q) + off; }
        const int nig = WGM * nN, gid = wgid / nig, fm = gid * WGM, gsz = (nM - fm) < WGM ? (nM - fm) : WGM;
        u.pm = fm + ((wgid % nig) % gsz); u.pn = (wgid % nig) / gsz; u.aux0 = 0; u.aux1 = 0; return true;
    }
    __device__ __forceinline__ const char* a_base(const Gemm& g, const Unit& u) const { return (const char*)g.A + (size_t)u.pm * BM * g.lda * 2; }
    __device__ __forceinline__ const char* b_base(const Gemm& g, const Unit& u) const { return (const char*)g.Bt + (size_t)u.pn * BM * g.ldb * 2; }
    __device__ __forceinline__ int a_row(const Unit&, int) const { return 0; }
};

typedef float f32x2_t __attribute__((ext_vector_type(2))); typedef __bf16 bf16x2_t __attribute__((ext_vector_type(2)));
__device__ __forceinline__ unsigned cvt_pk_bf16(float lo, float hi) { f32x2_t v = {lo, hi}; bf16x2_t b = __builtin_convertvector(v, bf16x2_t); return __builtin_bit_cast(unsigned, b); }


template <class Epi, class Sched, bool ALIGN_EPI = true, bool GATHER = false>
__device__ __forceinline__ void gemm_phase(PG8_LAS unsigned char* lds, const Gemm g, const Sched& S, const Epi& E) {
    int tid_ = threadIdx.x; asm volatile("" : "+v"(tid_));
    const int tid = tid_, wid = __builtin_amdgcn_readfirstlane(tid >> 6), lane = tid & 63, wr = wid >> 2, wc = wid & 3, fr = lane & 15, fq = lane >> 4;
    const int K = g.K, nt = K / BK;
    unsigned voffA[2], voffA1[2], voffB[2];
    int RA[2], CA[2];
#pragma unroll
    for (int i = 0; i < 2; ++i) { int R, C; stage_rc(tid * 16 + i * 8192, R, C); const int Rb = Epi::PERM ? ((R & ~31) + perm32(R & 31)) : R;
        RA[i] = R; CA[i] = C; voffA[i] = (unsigned)(R * g.lda + C) * 2u; voffA1[i] = voffA[i]; voffB[i] = (unsigned)(Rb * g.ldb + C) * 2u; }
    const size_t kstep = (size_t)(BK * 2);
    const size_t hstepA = GATHER ? (size_t)0 : (size_t)HALF * g.lda * 2;
    const size_t hstepB = (size_t)HALF * g.ldb * 2;
    const unsigned ldsw = (unsigned)wid * 1024u;
    const int aoff = lds_byte(wr * 64 + fr, fq * 8), boff = lds_byte(wc * 32 + fr, fq * 8);
#define PG8_SA(b, h) (((b) * 2 + (h)) * HTB)
#define PG8_SB(b, h) ((4 + (b) * 2 + (h)) * HTB)
#define PG8_STAGE(bufoff, gbase, voff) do { _Pragma("unroll") for (int _i = 0; _i < 2; ++_i) \
        __builtin_amdgcn_global_load_lds((const unsigned*)((const char*)(gbase) + (voff)[_i]), (PG8_LAS unsigned*)(lds + (bufoff) + ldsw + _i * 8192), 16, 0, 0); } while (0)
#define PG8_STAGE_A0(bufoff, gbase) PG8_STAGE(bufoff, gbase, voffA)
#define PG8_STAGE_A1(bufoff, gbase) do { if constexpr (GATHER) { PG8_STAGE(bufoff, gbase, voffA1); } else { PG8_STAGE(bufoff, (gbase) + hstepA, voffA); } } while (0)
#define PG8_LDA(dst, b, h) do { _Pragma("unroll") for (int m = 0; m < 4; ++m) _Pragma("unroll") for (int k = 0; k < 2; ++k) dst[m][k] = *(const PG8_LAS bf16x8*)(lds + PG8_SA(b, h) + aoff + m * 2048 + k * 1024); } while (0)
#define PG8_LDB(dst, b, h) do { _Pragma("unroll") for (int n = 0; n < 2; ++n) _Pragma("unroll") for (int k = 0; k < 2; ++k) dst[n][k] = *(const PG8_LAS bf16x8*)(lds + PG8_SB(b, h) + boff + n * 2048 + k * 1024); } while (0)
#define PG8_MMA(ai, bj, At, Bt) do { __builtin_amdgcn_s_setprio(1); _Pragma("unroll") for (int m = 0; m < 4; ++m) _Pragma("unroll") for (int n = 0; n < 2; ++n) _Pragma("unroll") for (int k = 0; k < 2; ++k) \
        acc[ai][bj][m][n] = __builtin_amdgcn_mfma_f32_16x16x32_bf16(Bt[n][k], At[m][k], acc[ai][bj][m][n], 0, 0, 0); __builtin_amdgcn_s_setprio(0); } while (0)
#define PG8_WAIT_V(n) asm volatile("s_waitcnt vmcnt(" #n ")" ::: "memory")
#define PG8_WAIT_L(n) asm volatile("s_waitcnt lgkmcnt(" #n ")" ::: "memory")
#define PG8_BAR __builtin_amdgcn_s_barrier()
#define PG8_SCHED __builtin_amdgcn_sched_barrier(0)
    Unit cur, nxt; int ui = 0;
    if (!S.next(0, cur)) return;
    if constexpr (GATHER) {
#pragma unroll
        for (int i = 0; i < 2; ++i) { voffA[i] = (unsigned)(S.a_row(cur, RA[i]) * g.lda + CA[i]) * 2u; voffA1[i] = (unsigned)(S.a_row(cur, HALF + RA[i]) * g.lda + CA[i]) * 2u; }
    }
    f32x4 acc[2][2][4][2];
#pragma unroll
    for (int a = 0; a < 2; ++a)
#pragma unroll
        for (int b = 0; b < 2; ++b)
#pragma unroll
            for (int m = 0; m < 4; ++m)
#pragma unroll
                for (int n = 0; n < 2; ++n) acc[a][b][m][n] = (f32x4){0.f, 0.f, 0.f, 0.f};
    bf16x8 At[4][2], B0[2][2], B1[2][2];
    const char* cA = S.a_base(g, cur); const char* cB = S.b_base(g, cur);
    PG8_STAGE(PG8_SB(0, 0), cB, voffB); PG8_STAGE(PG8_SB(0, 1), cB + hstepB, voffB); PG8_STAGE_A0(PG8_SA(0, 0), cA); PG8_STAGE_A1(PG8_SA(0, 1), cA);
    if (wr == 1) PG8_BAR;
    PG8_WAIT_V(2); PG8_BAR;
    PG8_STAGE(PG8_SB(1, 0), cB + kstep, voffB); PG8_STAGE_A0(PG8_SA(1, 0), cA + kstep); PG8_STAGE(PG8_SB(1, 1), cB + hstepB + kstep, voffB);
    PG8_WAIT_V(6); PG8_BAR;
    for (;;) {
        const bool has_next = GATHER ? false : S.next(ui + 1, nxt);
        const char* nA = has_next ? S.a_base(g, nxt) : cA; const char* nB = has_next ? S.b_base(g, nxt) : cB;
        for (int t = 0; t < nt; t += 2) {
            const bool last = (t == nt - 2);
            const char* a1 = cA + (size_t)(t + 1) * kstep;
            const char* a2 = last ? nA : cA + (size_t)(t + 2) * kstep; const char* b2 = last ? nB : cB + (size_t)(t + 2) * kstep;
            const char* a3 = a2 + kstep; const char* b3 = b2 + kstep;
            PG8_LDB(B0, 0, 0); PG8_LDB(B1, 0, 1); PG8_SCHED; PG8_LDA(At, 0, 0); PG8_STAGE_A1(PG8_SA(1, 1), a1);
            PG8_WAIT_V(8); PG8_WAIT_L(0); PG8_BAR; PG8_MMA(0, 0, At, B0); PG8_MMA(0, 1, At, B1); PG8_BAR; PG8_SCHED;
            PG8_LDA(At, 0, 1); PG8_STAGE(PG8_SB(0, 0), b2, voffB); PG8_STAGE(PG8_SB(0, 1), b2 + hstepB, voffB); PG8_STAGE_A0(PG8_SA(0, 0), a2);
            PG8_WAIT_V(8); PG8_WAIT_L(0); PG8_BAR; PG8_MMA(1, 0, At, B0); PG8_MMA(1, 1, At, B1); PG8_BAR; PG8_SCHED;
            PG8_LDB(B0, 1, 0); PG8_LDB(B1, 1, 1); PG8_SCHED; PG8_LDA(At, 1, 0); PG8_STAGE_A1(PG8_SA(0, 1), a2);
            PG8_WAIT_V(8); PG8_WAIT_L(0); PG8_BAR; PG8_MMA(0, 0, At, B0); PG8_MMA(0, 1, At, B1); PG8_BAR; PG8_SCHED;
            PG8_LDA(At, 1, 1); PG8_STAGE(PG8_SB(1, 0), b3, voffB); PG8_STAGE(PG8_SB(1, 1), b3 + hstepB, voffB); PG8_STAGE_A0(PG8_SA(1, 0), a3);
            PG8_WAIT_V(8); PG8_WAIT_L(0); PG8_BAR; PG8_MMA(1, 0, At, B0); PG8_MMA(1, 1, At, B1); PG8_BAR; PG8_SCHED;
        }
        if constexpr (ALIGN_EPI) { if (wr == 0) PG8_BAR; }
        E(acc, cur, wr, wc, fr, fq);
        if (!has_next) break;
#pragma unroll
        for (int a = 0; a < 2; ++a)
#pragma unroll
            for (int b = 0; b < 2; ++b)
#pragma unroll
                for (int m = 0; m < 4; ++m)
#pragma unroll
                    for (int n = 0; n < 2; ++n) acc[a][b][m][n] = (f32x4){0.f, 0.f, 0.f, 0.f};
        cur = nxt; cA = nA; cB = nB; ++ui;
        if constexpr (ALIGN_EPI) { if (wr == 1) PG8_BAR; }
    }
    PG8_WAIT_V(0);
    if constexpr (!ALIGN_EPI) { if (wr == 0) PG8_BAR; }
    PG8_BAR;
#undef PG8_SA
#undef PG8_SB
#undef PG8_STAGE
#undef PG8_STAGE_A0
#undef PG8_STAGE_A1
#undef PG8_LDA
#undef PG8_LDB
#undef PG8_MMA
#undef PG8_WAIT_V
#undef PG8_WAIT_L
#undef PG8_BAR
#undef PG8_SCHED
}
}
namespace fx {
using nv::u16; using nv::Bufs; using nv::Inputs;
using pg8::f32x4; using pg8::u32x4; using pg8::Unit;
#define LAS __attribute__((address_space(3)))
static_assert(nv::DM == 1024 && nv::NB == 8 && nv::S == 4096 && nv::MH == 256 && nv::PLE == 256, "fast phases are written for the full-size problem");
constexpr int NTOK = nv::NTOK, DM = 1024;
constexpr int INW_PAD = 6144;
constexpr int C_Z = 1280, C_XBC = 2304, C_BG = 3840, C_NG = 5888, C_DT = 5912, C_END = 5928;

struct WBufs { u16 *WinT, *WaT, *WbT, *WoutT, *PleGT, *PlePT, *WguT, *WdT, *PB; };
__host__ __device__ inline size_t carve_w(WBufs& W, unsigned char* ws, size_t off) {
  auto take = [&](size_t bytes) { unsigned char* r = ws + off; off += (bytes + 255) / 256 * 256; return r; };
  W.WinT = (u16*)take((size_t)INW_PAD * 1024 * 2); W.WaT = (u16*)take((size_t)1024 * 512 * 2); W.WbT = (u16*)take((size_t)1024 * 1024 * 2); W.WoutT = (u16*)take((size_t)1024 * 1024 * 2);
  W.PleGT = (u16*)take((size_t)1024 * 1024 * 2); W.PlePT = (u16*)take((size_t)1024 * 256 * 2); W.WguT = (u16*)take((size_t)32 * 512 * 1024 * 2); W.WdT = (u16*)take((size_t)32 * 1024 * 256 * 2);
  W.PB = (u16*)take((size_t)NTOK * 256 * 2);
  return off;
}

__device__ __forceinline__ int otid() { int t = threadIdx.x; asm volatile("" : "+v"(t)); return t; }
__device__ __forceinline__ int obid() { int b = blockIdx.x; asm volatile("" : "+s"(b)); return b; }
__device__ __forceinline__ float fsig(float x) { return __builtin_amdgcn_rcpf(1.0f + __expf(-x)); }
__device__ __forceinline__ float fsoftplus(float x) { const float e = __expf(x); return x > 20.f ? x : (e < 0.0625f ? e * (1.f - e * (0.5f - e * (0.33333333f - 0.25f * e))) : __logf(1.0f + e)); }
__device__ __forceinline__ unsigned pk2(float lo, float hi) { return pg8::cvt_pk_bf16(lo, hi); }
__device__ __forceinline__ void store8(u16* p, const float (&v)[8]) { u32x4 w; w.x = pk2(v[0], v[1]); w.y = pk2(v[2], v[3]); w.z = pk2(v[4], v[5]); w.w = pk2(v[6], v[7]); *(u32x4*)p = w; }
__device__ __forceinline__ void load8(const u16* p, float (&v)[8]) { const u32x4 w = *(const u32x4*)p;
  v[0] = __uint_as_float(w.x << 16); v[1] = __uint_as_float(w.x & 0xffff0000u); v[2] = __uint_as_float(w.y << 16); v[3] = __uint_as_float(w.y & 0xffff0000u);
  v[4] = __uint_as_float(w.z << 16); v[5] = __uint_as_float(w.z & 0xffff0000u); v[6] = __uint_as_float(w.w << 16); v[7] = __uint_as_float(w.w & 0xffff0000u); }

__device__ __forceinline__ float wave_sum(float v) {
#pragma unroll
  for (int o = 1; o < 64; o <<= 1) v += __shfl_xor(v, o);
  return v; }
__device__ __forceinline__ void rms_row_to_bf16(const float* xrow, const float* gain, u16* orow, int lane) {
  const f32x4* xr = (const f32x4*)xrow + lane; const f32x4* gr = (const f32x4*)gain + lane;
  f32x4 v[4]; float s = 0.f;
#pragma unroll
  for (int j = 0; j < 4; ++j) { v[j] = xr[64 * j]; s += (v[j].x * v[j].x + v[j].y * v[j].y) + (v[j].z * v[j].z + v[j].w * v[j].w); }
  const float rs = 1.0f / sqrtf(wave_sum(s) * (1.f / 1024.f) + nv::EPS);
  unsigned long long* o8 = (unsigned long long*)orow + lane;
#pragma unroll
  for (int j = 0; j < 4; ++j) { const f32x4 g = gr[64 * j]; o8[64 * j] = (unsigned long long)pk2(v[j].x * rs * g.x, v[j].y * rs * g.y) | ((unsigned long long)pk2(v[j].z * rs * g.z, v[j].w * rs * g.w) << 32); }
}
__device__ __forceinline__ void phase_rms_rows(const float* x, const float* gain, u16* out) {
  const int tid = otid(), lane = tid & 63, gw = obid() * 8 + (tid >> 6), ngw = gridDim.x * 8;
  for (int r = gw; r < NTOK; r += ngw) rms_row_to_bf16(x + (size_t)r * 1024, gain, out + (size_t)r * 1024, lane);
}
template <class CP> __device__ __forceinline__ void transpose_tile(LAS float* scr, const CP cp, u16* dst, int K, int n0, int k0) {
  const int tid = otid();
  { const int nn = tid & 127; const float* p = cp(n0 + nn);
#pragma unroll
    for (int i = 0; i < 16; ++i) { const int kk = i * 4 + (tid >> 7); scr[nn * 65 + kk] = p ? p[(size_t)(k0 + kk) * cp.ld] : 0.f; } }
  __syncthreads();
#pragma unroll
  for (int h = 0; h < 2; ++h) { const int it = tid + h * 512, nn = it >> 3, kc = it & 7; const LAS float* s = scr + nn * 65 + kc * 8;
    u32x4 o; o.x = pk2(s[0], s[1]); o.y = pk2(s[2], s[3]); o.z = pk2(s[4], s[5]); o.w = pk2(s[6], s[7]);
    *(u32x4*)(dst + (size_t)(n0 + nn) * K + k0 + kc * 8) = o; }
  __syncthreads();
}
struct CpIdent { const float* src; int ld; __device__ const float* operator()(int n) const { return src + n; } };
struct CpInProj { const float* src; int ld; __device__ const float* operator()(int n) const {
  int c; if (n < C_Z) c = n; else if (n < C_XBC) c = nv::O_Z + (n - C_Z); else if (n < C_BG) c = nv::O_XBC + (n - C_XBC); else if (n < C_NG) c = nv::O_BG + (n - C_BG); else if (n < C_DT) c = nv::O_NG + (n - C_NG); else if (n < C_END) c = nv::O_DT + (n - C_DT); else return nullptr;
  return src + c; } };
struct CpGU { const float* gate; long updelta; int ld; __device__ const float* operator()(int n) const { const int tile = n >> 8, r = n & 255; return gate + (r < 128 ? 0L : updelta) + tile * 128 + (r & 127); } };

__device__ __forceinline__ void phase_prologue(LAS unsigned char* lds, const Inputs& I, const Bufs& B, const WBufs& W) {
  LAS float* scr = (LAS float*)lds;
  constexpr int T_IN = (INW_PAD / 128) * 16, T_A = 8 * 8, T_B = 8 * 16, T_O = 8 * 16, T_PG = 8 * 16, T_PP = 8 * 4, T_GU = 32 * 4 * 16, T_D = 32 * 8 * 4;
  constexpr int TOT = T_IN + T_A + T_B + T_O + T_PG + T_PP + T_GU + T_D;
  for (int t = blockIdx.x; t < TOT; t += gridDim.x) { int r = t;
    if (r < T_IN) { CpInProj cp{I.w_in, nv::INW}; transpose_tile(scr, cp, W.WinT, 1024, (r / 16) * 128, (r % 16) * 64); continue; } r -= T_IN;
    if (r < T_A) { CpIdent cp{I.w_a, 1024}; transpose_tile(scr, cp, W.WaT, 512, (r / 8) * 128, (r % 8) * 64); continue; } r -= T_A;
    if (r < T_B) { CpIdent cp{I.w_b, 1024}; transpose_tile(scr, cp, W.WbT, 1024, (r / 16) * 128, (r % 16) * 64); continue; } r -= T_B;
    if (r < T_O) { CpIdent cp{I.w_out, 1024}; transpose_tile(scr, cp, W.WoutT, 1024, (r / 16) * 128, (r % 16) * 64); continue; } r -= T_O;
    if (r < T_PG) { CpIdent cp{I.ple_wg, 1024}; transpose_tile(scr, cp, W.PleGT, 1024, (r / 16) * 128, (r % 16) * 64); continue; } r -= T_PG;
    if (r < T_PP) { CpIdent cp{I.ple_wp, 1024}; transpose_tile(scr, cp, W.PlePT, 256, (r / 4) * 128, (r % 4) * 64); continue; } r -= T_PP;
    if (r < T_GU) { const int e = r / 64, q = r % 64; CpGU cp{I.w_gate + (size_t)e * 1024 * 256, (long)(I.w_up - I.w_gate), 256}; transpose_tile(scr, cp, W.WguT + (size_t)e * 512 * 1024, 1024, (q / 16) * 128, (q % 16) * 64); continue; } r -= T_GU;
    { const int e = r / 32, q = r % 32; CpIdent cp{I.w_down + (size_t)e * 256 * 1024, 1024}; transpose_tile(scr, cp, W.WdT + (size_t)e * 1024 * 256, 256, (q / 4) * 128, (q % 4) * 64); }
  }
  phase_rms_rows(I.x, I.mix_norm, B.HB);
  for (long i = blockIdx.x * 512L + otid(); i < (long)NTOK * 256 / 8; i += (long)gridDim.x * 512L) { const f32x4 a = ((const f32x4*)I.p)[2 * i], b = ((const f32x4*)I.p)[2 * i + 1];
    u32x4 o; o.x = pk2(a.x, a.y); o.y = pk2(a.z, a.w); o.z = pk2(b.x, b.y); o.w = pk2(b.z, b.w); ((u32x4*)W.PB)[i] = o; }
}

template <class F> struct Epi8 { static constexpr bool PERM = true; F f;
  __device__ __forceinline__ void operator()(const f32x4 (&acc)[2][2][4][2], const Unit& u, int wr, int wc, int fr, int fq) const {
#pragma unroll
    for (int ai = 0; ai < 2; ++ai)
#pragma unroll
      for (int m = 0; m < 4; ++m) { const int row = u.pm * 256 + ai * 128 + wr * 64 + m * 16 + fr;
#pragma unroll
        for (int bj = 0; bj < 2; ++bj) { const int col = u.pn * 256 + bj * 128 + wc * 32 + 8 * fq; const f32x4 a = acc[ai][bj][m][0], b = acc[ai][bj][m][1];
          const float v[8] = {a.x, a.y, a.z, a.w, b.x, b.y, b.z, b.w}; f(u, row, col, v); }
        if (m & 1) asm volatile("" ::: "memory"); } } };

struct FInProj { u16* QKV; u16* Z; u16* XBC; u16* BG; float* NG; float* DT; const float* dt_bias;
  __device__ __forceinline__ void operator()(const Unit&, int r, int c, const float (&v)[8]) const {
    if (c < C_Z) store8(QKV + (size_t)r * 1280 + c, v);
    else if (c < C_XBC) store8(Z + (size_t)r * 1024 + (c - C_Z), v);
    else if (c < C_BG) store8(XBC + (size_t)r * 1536 + (c - C_XBC), v);
    else if (c < C_NG) { float s[8];
#pragma unroll
      for (int i = 0; i < 8; ++i) s[i] = fsig(v[i]);
      store8(BG + (size_t)r * 2048 + (c - C_BG), s); }
    else if (c < C_DT) { float* o = NG + (size_t)r * 24 + (c - C_NG);
#pragma unroll
      for (int i = 0; i < 8; ++i) o[i] = fsig(v[i]); }
    else if (c < C_END) { float* o = DT + (size_t)r * 16 + (c - C_DT); const float* bi = dt_bias + (c - C_DT);
#pragma unroll
      for (int i = 0; i < 8; ++i) o[i] = fsoftplus(v[i] + bi[i]); } } };
struct FStoreBf { u16* o; int ld; __device__ __forceinline__ void operator()(const Unit&, int r, int c, const float (&v)[8]) const { store8(o + (size_t)r * ld + c, v); } };
struct FMerge { const u16* t1; const u16* bg; u16* o;
  __device__ __forceinline__ void operator()(const Unit&, int r, int c, const float (&v)[8]) const { float t[8], ga[8], gb[8], m[8]; load8(t1 + (size_t)r * 1024 + c, t); load8(bg + (size_t)r * 2048 + c, ga); load8(bg + (size_t)r * 2048 + 1024 + c, gb);
#pragma unroll
    for (int i = 0; i < 8; ++i) m[i] = ga[i] * t[i] + gb[i] * v[i];
    store8(o + (size_t)r * 1024 + c, m); } };
struct FResid { const float* x; float* o;
  __device__ __forceinline__ void operator()(const Unit&, int r, int c, const float (&v)[8]) const { const f32x4 a = *(const f32x4*)(x + (size_t)r * 1024 + c), b = *(const f32x4*)(x + (size_t)r * 1024 + c + 4);
    *(f32x4*)(o + (size_t)r * 1024 + c) = (f32x4){a.x + v[0], a.y + v[1], a.z + v[2], a.w + v[3]}; *(f32x4*)(o + (size_t)r * 1024 + c + 4) = (f32x4){b.x + v[4], b.y + v[5], b.z + v[6], b.w + v[7]}; } };
struct FPle { float* x; const u16* pp;
  __device__ __forceinline__ void operator()(const Unit&, int r, int c, const float (&v)[8]) const { float p[8]; load8(pp + (size_t)r * 1024 + c, p); float* xp = x + (size_t)r * 1024 + c; const f32x4 a = *(const f32x4*)xp, b = *(const f32x4*)(xp + 4);
    *(f32x4*)xp = (f32x4){a.x + fsig(v[0]) * p[0], a.y + fsig(v[1]) * p[1], a.z + fsig(v[2]) * p[2], a.w + fsig(v[3]) * p[3]};
    *(f32x4*)(xp + 4) = (f32x4){b.x + fsig(v[4]) * p[4], b.y + fsig(v[5]) * p[5], b.z + fsig(v[6]) * p[6], b.w + fsig(v[7]) * p[7]}; } };

template <class F> __device__ __forceinline__ void dense_gemm(LAS unsigned char* lds, const u16* A, int lda, const u16* Bt, int ldb, int M, int N, int K, const F& f) {
  pg8::Gemm g{A, Bt, M, N, K, lda, ldb}; pg8::StaticOrder S; S.init(M, N, (int)gridDim.x, (int)blockIdx.x); Epi8<F> E{f};
  pg8::gemm_phase<Epi8<F>, pg8::StaticOrder, true, false>(lds, g, S, E);
}
}
namespace fx {
constexpr int LIST_CAP = 32768;
constexpr int LDS_TAB = 131072;
struct MoeBufs { float* LOGITS; int* CNT; int* LIST; u16* MOEOUT; u16* WrT; };
__host__ __device__ inline size_t carve_moe(MoeBufs& M, const Bufs& B, unsigned char* ws, size_t off) {
  auto take = [&](size_t bytes) { unsigned char* r = ws + off; off += (bytes + 255) / 256 * 256; return r; };
  M.LOGITS = (float*)take((size_t)NTOK * 64 * 4); M.CNT = (int*)take(256); M.LIST = (int*)take((size_t)32 * LIST_CAP * 4); M.WrT = (u16*)take((size_t)256 * 1024 * 2);
  M.MOEOUT = B.QKV;
  return off;
}
__device__ __forceinline__ void prologue_moe(const Inputs& I, const MoeBufs& M) {
  for (long i = blockIdx.x * 512L + otid(); i < 256L * 1024; i += (long)gridDim.x * 512L) { const int n = (int)(i >> 10), k = (int)(i & 1023);
    float v = 0.f; if (n < 4) v = I.w_group[k * 4 + n]; else if (n < 36) v = I.w_expert[k * 32 + (n - 4)];
    M.WrT[i] = nv::f2bf(v); }
  if (blockIdx.x == 0 && threadIdx.x < 64) M.CNT[threadIdx.x] = 0;
}
struct FLogits { float* o; __device__ __forceinline__ void operator()(const Unit&, int r, int c, const float (&v)[8]) const { if (c < 40) { *(f32x4*)(o + (size_t)r * 64 + c) = (f32x4){v[0], v[1], v[2], v[3]}; *(f32x4*)(o + (size_t)r * 64 + c + 4) = (f32x4){v[4], v[5], v[6], v[7]}; } } };
__device__ __forceinline__ void phase_route(const Inputs& I, const Bufs& B, const MoeBufs& M) {
  for (int tok = blockIdx.x * 512 + otid(); tok < NTOK; tok += gridDim.x * 512) { const float* lg = M.LOGITS + (size_t)tok * 64;
    const f32x4 g4 = *(const f32x4*)lg; const float g0 = g4.x + I.b_group[0], g1 = g4.y + I.b_group[1], g2 = g4.z + I.b_group[2], g3 = g4.w + I.b_group[3];
    int gi = 0; float gm = g0; if (g1 > gm) { gm = g1; gi = 1; } if (g2 > gm) { gm = g2; gi = 2; } if (g3 > gm) { gm = g3; gi = 3; }
    const float grp_w = 1.0f / (expf(g0 - gm) + expf(g1 - gm) + expf(g2 - gm) + expf(g3 - gm));
    const f32x4 ea = *(const f32x4*)(lg + 4 + gi * 8), eb = *(const f32x4*)(lg + 8 + gi * 8); const f32x4 ba = *(const f32x4*)(I.b_expert + gi * 8), bb = *(const f32x4*)(I.b_expert + gi * 8 + 4);
    const float el[8] = {ea.x + ba.x, ea.y + ba.y, ea.z + ba.z, ea.w + ba.w, eb.x + bb.x, eb.y + bb.y, eb.z + bb.z, eb.w + bb.w};
    int i0 = 0; float m0 = el[0];
#pragma unroll
    for (int j = 1; j < 8; ++j) if (el[j] > m0) { m0 = el[j]; i0 = j; }
    int i1 = -1; float m1 = -3.0e38f;
#pragma unroll
    for (int j = 0; j < 8; ++j) if (j != i0 && el[j] > m1) { m1 = el[j]; i1 = j; }
    const float r = expf(m1 - m0); const float w0 = grp_w / (1.0f + r), w1 = grp_w * r / (1.0f + r);
    const int e0 = gi * 8 + i0, e1 = gi * 8 + i1;
    const int p0 = atomicAdd(&M.CNT[e0], 1), p1 = atomicAdd(&M.CNT[e1], 1);
    M.LIST[e0 * LIST_CAP + p0] = tok * 2; M.LIST[e1 * LIST_CAP + p1] = tok * 2 + 1; B.EW[tok * 2] = w0; B.EW[tok * 2 + 1] = w1; }
}
__device__ __forceinline__ void build_tile_table(LAS unsigned char* lds, const MoeBufs& M) {
  LAS int* tab = (LAS int*)(lds + LDS_TAB);
  if (threadIdx.x == 0) { int acc = 0; for (int e = 0; e < 32; ++e) { tab[e] = acc; acc += (M.CNT[e] + 255) >> 8; } tab[32] = acc; }
  __syncthreads();
}
__device__ __forceinline__ int tile_expert(const LAS int* tab, int tile) { int e = 0;
#pragma unroll 1
  for (int j = 1; j < 32; ++j) if (tab[j] <= tile) e = j;
  return e; }

struct SchedGU { const int* list; int tile, ct, lbase, nvalid, e;
  __device__ bool next(int i, Unit& u) const { if (i > 0) return false; u.pm = tile; u.pn = ct; u.aux0 = lbase; u.aux1 = nvalid; return true; }
  __device__ __forceinline__ const char* a_base(const pg8::Gemm& g, const Unit&) const { return (const char*)g.A; }
  __device__ __forceinline__ const char* b_base(const pg8::Gemm& g, const Unit&) const { return (const char*)g.Bt + ((size_t)e * 512 + (size_t)ct * 256) * 1024 * 2; }
  __device__ __forceinline__ int a_row(const Unit&, int r) const { return r < nvalid ? (list[lbase + r] >> 1) : 0; } };
struct EpiGU { static constexpr bool PERM = true; u16* act;
  __device__ __forceinline__ void operator()(const f32x4 (&acc)[2][2][4][2], const Unit& u, int wr, int wc, int fr, int fq) const {
#pragma unroll
    for (int ai = 0; ai < 2; ++ai)
#pragma unroll
      for (int m = 0; m < 4; ++m) { const int r = ai * 128 + wr * 64 + m * 16 + fr; const f32x4 g0 = acc[ai][0][m][0], g1 = acc[ai][0][m][1], u0 = acc[ai][1][m][0], u1 = acc[ai][1][m][1];
        const float a[8] = {g0.x * fsig(g0.x) * u0.x, g0.y * fsig(g0.y) * u0.y, g0.z * fsig(g0.z) * u0.z, g0.w * fsig(g0.w) * u0.w, g1.x * fsig(g1.x) * u1.x, g1.y * fsig(g1.y) * u1.y, g1.z * fsig(g1.z) * u1.z, g1.w * fsig(g1.w) * u1.w};
        store8(act + ((size_t)u.pm * 256 + r) * 256 + u.pn * 128 + wc * 32 + 8 * fq, a); } } };
__device__ __forceinline__ void phase_moe_gu(LAS unsigned char* lds, const Bufs& B, const WBufs& W, const MoeBufs& M) {
  const LAS int* tab = (const LAS int*)(lds + LDS_TAB); const int T = tab[32];
  for (int L = blockIdx.x; L < T * 2; L += gridDim.x) { const int tile = L >> 1, ct = L & 1, e = __builtin_amdgcn_readfirstlane(tile_expert(tab, tile)), rt = tile - __builtin_amdgcn_readfirstlane(tab[e]); int nvalid = __builtin_amdgcn_readfirstlane(M.CNT[e]) - rt * 256; nvalid = nvalid > 256 ? 256 : nvalid;
    pg8::Gemm g{B.H2, W.WguT, 256, 256, 1024, 1024, 1024}; SchedGU S{M.LIST, tile, ct, e * LIST_CAP + rt * 256, nvalid, e}; EpiGU E{B.ACT};
    pg8::gemm_phase<EpiGU, SchedGU, true, true>(lds, g, S, E); }
}
struct SchedD { const LAS int* tab; const int* cnt; int T4, G, c;
  __device__ bool next(int i, Unit& u) const { const int L = i * G + c; if (L >= T4) return false; const int tile = L >> 2, e = __builtin_amdgcn_readfirstlane(tile_expert(tab, tile)), rt = tile - __builtin_amdgcn_readfirstlane(tab[e]); int nvalid = __builtin_amdgcn_readfirstlane(cnt[e]) - rt * 256; nvalid = nvalid > 256 ? 256 : nvalid;
    u.pm = tile; u.pn = L & 3; u.aux0 = e * LIST_CAP + rt * 256; u.aux1 = nvalid; return true; }
  __device__ __forceinline__ const char* a_base(const pg8::Gemm& g, const Unit& u) const { return (const char*)g.A + (size_t)u.pm * 256 * 256 * 2; }
  __device__ __forceinline__ const char* b_base(const pg8::Gemm& g, const Unit& u) const { return (const char*)g.Bt + ((size_t)(u.aux0 >> 15) * 1024 + (size_t)u.pn * 256) * 256 * 2; }
  __device__ __forceinline__ int a_row(const Unit&, int) const { return 0; } };
struct FDown { const int* list; const float* ew; u16* o;
  __device__ __forceinline__ void operator()(const Unit& u, int row, int c, const float (&v)[8]) const { const int r = row - u.pm * 256; if (r < u.aux1) { const int asg = list[u.aux0 + r]; const float w = ew[asg];
      const float y[8] = {v[0] * w, v[1] * w, v[2] * w, v[3] * w, v[4] * w, v[5] * w, v[6] * w, v[7] * w}; store8(o + (size_t)asg * 1024 + c, y); } } };
__device__ __forceinline__ void phase_moe_down(LAS unsigned char* lds, const Bufs& B, const WBufs& W, const MoeBufs& M) {
  const LAS int* tab = (const LAS int*)(lds + LDS_TAB);
  pg8::Gemm g{B.ACT, W.WdT, 256, 1024, 256, 256, 256}; SchedD S{tab, M.CNT, tab[32] * 4, (int)gridDim.x, (int)blockIdx.x}; Epi8<FDown> E{FDown{M.LIST, B.EW, M.MOEOUT}};
  pg8::gemm_phase<Epi8<FDown>, SchedD, true, false>(lds, g, S, E);
}
__device__ __forceinline__ void phase_moe_combine(float* out, const u16* moeout, const float* gain, u16* hout) {
  const int tid = otid(), lane = tid & 63, gw = obid() * 8 + (tid >> 6), ngw = gridDim.x * 8;
  for (int tok = gw; tok < NTOK; tok += ngw) { f32x4* xr = (f32x4*)(out + (size_t)tok * 1024) + lane; const pg8::u32x2* o0 = (const pg8::u32x2*)(moeout + (size_t)tok * 2048) + lane; const pg8::u32x2* o1 = o0 + 256;
    const f32x4* gr = (const f32x4*)gain + lane; f32x4 v[4]; float s = 0.f;
#pragma unroll
    for (int j = 0; j < 4; ++j) { const f32x4 x = xr[64 * j]; const pg8::u32x2 a = o0[64 * j], b = o1[64 * j];
      v[j].x = x.x + __uint_as_float(a.x << 16) + __uint_as_float(b.x << 16); v[j].y = x.y + __uint_as_float(a.x & 0xffff0000u) + __uint_as_float(b.x & 0xffff0000u);
      v[j].z = x.z + __uint_as_float(a.y << 16) + __uint_as_float(b.y << 16); v[j].w = x.w + __uint_as_float(a.y & 0xffff0000u) + __uint_as_float(b.y & 0xffff0000u);
      xr[64 * j] = v[j]; s += (v[j].x * v[j].x + v[j].y * v[j].y) + (v[j].z * v[j].z + v[j].w * v[j].w); }
    const float rs = 1.0f / sqrtf(wave_sum(s) * (1.f / 1024.f) + nv::EPS);
    unsigned long long* o8 = (unsigned long long*)(hout + (size_t)tok * 1024) + lane;
#pragma unroll
    for (int j = 0; j < 4; ++j) { const f32x4 g = gr[64 * j]; o8[64 * j] = (unsigned long long)pk2(v[j].x * rs * g.x, v[j].y * rs * g.y) | ((unsigned long long)pk2(v[j].z * rs * g.z, v[j].w * rs * g.w) << 32); } }
}
}
namespace fa {
using nv::u16; using nv::Bufs;
typedef short bf16x8 __attribute__((ext_vector_type(8)));
typedef short s16x4 __attribute__((ext_vector_type(4)));
typedef float f32x16 __attribute__((ext_vector_type(16)));
typedef unsigned u32x4 __attribute__((ext_vector_type(4)));
constexpr float C2 = 0.125f * 1.4426950408889634f;
constexpr int S = nv::S, QKVW = 1280;
constexpr int L_K = 0, L_V = 16384, L_WSF = 32768, L_IMP = 34816, L_MASK = L_IMP + 65536, L_OST = L_MASK + 512, L_END = L_OST + 32768;
static_assert(L_END <= 147456, "attention LDS map");

__device__ __forceinline__ int crow(int r, int hi) { return (r & 3) + 8 * (r >> 2) + 4 * hi; }
__device__ __forceinline__ float ex2(float x) { return __builtin_amdgcn_exp2f(x); }
__device__ __forceinline__ float swap_add(float v) { auto rr = __builtin_amdgcn_permlane32_swap(__float_as_uint(v), __float_as_uint(v), false, false); return __uint_as_float(rr[0]) + __uint_as_float(rr[1]); }
__device__ __forceinline__ float swap_max(float v) { auto rr = __builtin_amdgcn_permlane32_swap(__float_as_uint(v), __float_as_uint(v), false, false); return __builtin_fmaxf(__uint_as_float(rr[0]), __uint_as_float(rr[1])); }

__device__ __forceinline__ void phase_qknorm(const nv::Inputs& I, const Bufs& B) {
  for (int it = blockIdx.x * 512 + fx::otid(); it < nv::NTOK * 12; it += gridDim.x * 512) { const int tok = it / 12, w = it % 12; u16* v; const float* gain; float sc = 1.f;
    if (w < 8) { v = B.QKV + (size_t)tok * QKVW + nv::O_Q + w * 64; gain = I.q_gain; sc = C2; } else if (w < 10) { v = B.QKV + (size_t)tok * QKVW + nv::O_KS + (w - 8) * 64; gain = I.ks_gain; } else { v = B.QKV + (size_t)tok * QKVW + nv::O_KW + (w - 10) * 64; gain = I.kw_gain; }
    float x[8][8]; float s = 0.f;
#pragma unroll
    for (int c = 0; c < 8; ++c) { fx::load8(v + c * 8, x[c]);
#pragma unroll
      for (int j = 0; j < 8; ++j) s += x[c][j] * x[c][j]; }
    const float rs = sc / sqrtf(s * (1.f / 64.f) + nv::EPS);
#pragma unroll
    for (int c = 0; c < 8; ++c) { float y[8];
#pragma unroll
      for (int j = 0; j < 8; ++j) y[j] = x[c][j] * rs * gain[c * 8 + j];
      fx::store8(v + c * 8, y); } }
}

__device__ __forceinline__ void stage_kv(LAS unsigned char* lds, int slot, const u16* kbase, const u16* vbase, int stride, int wid, int lane, bool withV) {
  const u16* ksrc = kbase + (size_t)lane * stride + wid * 8;
  __builtin_amdgcn_global_load_lds((const unsigned*)ksrc, (LAS unsigned*)(lds + L_K + slot * 8192 + wid * 1024), 16, 0, 0);
  if (withV) { const u16* vsrc = vbase + (size_t)(16 * (wid & 3) + (lane >> 2)) * stride + (wid >> 2) * 32 + (lane & 3) * 8;
    __builtin_amdgcn_global_load_lds((const unsigned*)vsrc, (LAS unsigned*)(lds + L_V + slot * 8192 + wid * 1024), 16, 0, 0); }
}
__device__ __forceinline__ void qkt(f32x16& p0, f32x16& p1, const LAS unsigned char* Kslot, const bf16x8 (&qr)[4], int r32, int hi) {
  const LAS unsigned char* kb = Kslot + hi * 1024 + r32 * 16; f32x16 z;
#pragma unroll
  for (int r = 0; r < 16; ++r) z[r] = 0.f;
  p0 = z; p1 = z;
#pragma unroll
  for (int d0 = 0; d0 < 4; ++d0) { const bf16x8 b0 = *(const LAS bf16x8*)(kb + d0 * 2048), b1 = *(const LAS bf16x8*)(kb + d0 * 2048 + 512);
    p0 = __builtin_amdgcn_mfma_f32_32x32x16_bf16(b0, qr[d0], p0, 0, 0, 0); p1 = __builtin_amdgcn_mfma_f32_32x32x16_bf16(b1, qr[d0], p1, 0, 0, 0); }
}
__device__ __forceinline__ void pv(f32x16 (&o)[2], int vb, bf16x8 pa0, bf16x8 pa1, bf16x8 pa2, bf16x8 pa3) {
#pragma unroll
  for (int d0 = 0; d0 < 2; ++d0) { s16x4 lo[4], hi[4];
#pragma unroll
    for (int ks = 0; ks < 4; ++ks) {
      asm volatile("ds_read_b64_tr_b16 %0,%1 offset:%c2" : "=&v"(lo[ks]) : "v"(vb), "i"(d0 * 4096 + ks * 1024) : "memory");
      asm volatile("ds_read_b64_tr_b16 %0,%1 offset:%c2" : "=&v"(hi[ks]) : "v"(vb), "i"(d0 * 4096 + ks * 1024 + 512) : "memory"); }
    asm volatile("s_waitcnt lgkmcnt(0)" ::: "memory"); __builtin_amdgcn_sched_barrier(0);
#define FA_PK(k) (bf16x8){lo[k][0], lo[k][1], lo[k][2], lo[k][3], hi[k][0], hi[k][1], hi[k][2], hi[k][3]}
    o[d0] = __builtin_amdgcn_mfma_f32_32x32x16_bf16(pa0, FA_PK(0), o[d0], 0, 0, 0);
    o[d0] = __builtin_amdgcn_mfma_f32_32x32x16_bf16(pa1, FA_PK(1), o[d0], 0, 0, 0);
    o[d0] = __builtin_amdgcn_mfma_f32_32x32x16_bf16(pa2, FA_PK(2), o[d0], 0, 0, 0);
    o[d0] = __builtin_amdgcn_mfma_f32_32x32x16_bf16(pa3, FA_PK(3), o[d0], 0, 0, 0);
#undef FA_PK
  }
}
struct SmState { float m, l; f32x16 o[2]; };
__device__ __forceinline__ void sm_reset(SmState& st) { st.m = -INFINITY; st.l = 0.f;
#pragma unroll
  for (int r = 0; r < 16; ++r) { st.o[0][r] = 0.f; st.o[1][r] = 0.f; } }
__device__ __forceinline__ void mask_range(f32x16& p0, f32x16& p1, int klo, int khi, int hi) {
  if (__all(klo <= 0 && khi >= 63)) return;
#pragma unroll
  for (int r = 0; r < 16; ++r) { const int k0 = crow(r, hi), k1 = k0 + 32; if (k0 < klo || k0 > khi) p0[r] = -INFINITY; if (k1 < klo || k1 > khi) p1[r] = -INFINITY; }
}
__device__ __forceinline__ void tile_step(SmState& st, LAS unsigned char* lds, int slot, const bf16x8 (&qr)[4], LAS float* wsf, int r32, int hi, int vb0, int klo, int khi) {
  f32x16 p0, p1; qkt(p0, p1, lds + L_K + slot * 8192, qr, r32, hi);
  mask_range(p0, p1, klo, khi, hi);
  float rm = p0[0];
#pragma unroll
  for (int r = 1; r < 16; ++r) rm = __builtin_fmaxf(rm, p0[r]);
#pragma unroll
  for (int r = 0; r < 16; ++r) rm = __builtin_fmaxf(rm, p1[r]);
  rm = swap_max(rm);
  const float mn = __builtin_fmaxf(st.m, rm), ms = __builtin_fmaxf(mn, -1.0e30f);
  const float f = ex2(st.m - ms);
  if (__any(mn > st.m)) { if (hi == 0) wsf[r32] = f;
#pragma unroll
    for (int r = 0; r < 16; ++r) { const float fr = wsf[crow(r, hi)]; st.o[0][r] *= fr; st.o[1][r] *= fr; } }
  st.m = mn;
  float rs = 0.f;
#pragma unroll
  for (int r = 0; r < 16; ++r) { p0[r] = ex2(p0[r] - ms); p1[r] = ex2(p1[r] - ms); rs += p0[r] + p1[r]; }
  st.l = st.l * f + rs;
  u32x4 w0, w1, w2, w3;
  w0.x = pg8::cvt_pk_bf16(p0[0], p0[1]); w0.y = pg8::cvt_pk_bf16(p0[2], p0[3]); w0.z = pg8::cvt_pk_bf16(p0[4], p0[5]); w0.w = pg8::cvt_pk_bf16(p0[6], p0[7]);
  w1.x = pg8::cvt_pk_bf16(p0[8], p0[9]); w1.y = pg8::cvt_pk_bf16(p0[10], p0[11]); w1.z = pg8::cvt_pk_bf16(p0[12], p0[13]); w1.w = pg8::cvt_pk_bf16(p0[14], p0[15]);
  w2.x = pg8::cvt_pk_bf16(p1[0], p1[1]); w2.y = pg8::cvt_pk_bf16(p1[2], p1[3]); w2.z = pg8::cvt_pk_bf16(p1[4], p1[5]); w2.w = pg8::cvt_pk_bf16(p1[6], p1[7]);
  w3.x = pg8::cvt_pk_bf16(p1[8], p1[9]); w3.y = pg8::cvt_pk_bf16(p1[10], p1[11]); w3.z = pg8::cvt_pk_bf16(p1[12], p1[13]); w3.w = pg8::cvt_pk_bf16(p1[14], p1[15]);
  pv(st.o, vb0 + L_V + slot * 8192, __builtin_bit_cast(bf16x8, w0), __builtin_bit_cast(bf16x8, w1), __builtin_bit_cast(bf16x8, w2), __builtin_bit_cast(bf16x8, w3));
}
__device__ __forceinline__ void finalize(SmState& st, float gate, f32x16 (&outacc)[2], LAS float* wsf, int r32, int hi, float& msafe, float& invl) {
  const float lt = swap_add(st.l); invl = lt > 0.f ? 1.0f / lt : 0.f; msafe = __builtin_fmaxf(st.m, -1.0e30f);
  if (hi == 0) wsf[r32] = gate * invl;
#pragma unroll
  for (int r = 0; r < 16; ++r) { const float fr = wsf[crow(r, hi)]; outacc[0][r] += st.o[0][r] * fr; outacc[1][r] += st.o[1][r] * fr; }
}
__device__ __forceinline__ void imp_step(LAS unsigned char* lds, int slot, const bf16x8 (&qr)[4], int r32, int hi, int khi, float msafe, float invl, LAS float* imph  , int tq, int T) {
  f32x16 p0, p1; qkt(p0, p1, lds + L_K + slot * 8192, qr, r32, hi);
  mask_range(p0, p1, 0, khi, hi);
#pragma unroll
  for (int r = 0; r < 16; ++r) { p0[r] = ex2(p0[r] - msafe) * invl; p1[r] = ex2(p1[r] - msafe) * invl; }
  LAS float* row = imph + tq * 64 + 16 * T + hi;
#pragma unroll
  for (int gq = 0; gq < 4; ++gq) { row[2 * gq] += (p0[4 * gq] + p0[4 * gq + 1]) + (p0[4 * gq + 2] + p0[4 * gq + 3]); row[2 * gq + 8] += (p1[4 * gq] + p1[4 * gq + 1]) + (p1[4 * gq + 2] + p1[4 * gq + 3]); }
  asm volatile("s_waitcnt lgkmcnt(0)" ::: "memory");
#pragma unroll
  for (int gq = 0; gq < 4; ++gq) { row[2 * gq + 1] += p0[4 * gq + 3]; if (16 * T + hi + 2 * gq + 9 < 64) row[2 * gq + 9] += p1[4 * gq + 3]; }
  asm volatile("s_waitcnt lgkmcnt(0)" ::: "memory");
}
__device__ __forceinline__ void topk_select(LAS unsigned char* lds, int wid, int lane, int i) {
  LAS float* IM = (LAS float*)(lds + L_IMP); LAS unsigned long long* MK = (LAS unsigned long long*)(lds + L_MASK);
  const int j = lane; const int nforced = i == 0 ? 1 : (i == 1 ? 2 : 3);
  const bool forced = (j <= i) && (j == 0 || j == i || j == i - 1); const bool cand = (j >= 1) && (j <= i - 2);
  for (int tq = wid; tq < 64; tq += 8) {
    const float v = (IM[tq * 64 + j] + IM[4096 + tq * 64 + j]) + (IM[8192 + tq * 64 + j] + IM[12288 + tq * 64 + j]);
    IM[tq * 64 + j] = v;
    asm volatile("s_waitcnt lgkmcnt(0)" ::: "memory");
    int cnt = 0;
    for (int jj = 1; jj <= i - 2; ++jj) { const float vv = IM[tq * 64 + jj]; cnt += (vv > v || (vv == v && jj < j)) ? 1 : 0; }
    const bool sel = forced || (cand && cnt < 16 - nforced);
    const unsigned long long mk = __ballot(sel);
    if (lane == 0) MK[tq] = mk;
  }
}

__device__ __forceinline__ void attn_unit(LAS unsigned char* lds, const Bufs& B, int b, int g, int i) {
  const int tid = fx::otid(), lane = tid & 63, wid = __builtin_amdgcn_readfirstlane(tid >> 6), r32 = lane & 31, hi = lane >> 5;
  const int e = wid >> 1, h = g * 4 + e, tq = 32 * (wid & 1) + r32; const size_t tok = (size_t)b * S + 64 * i + tq; const int t = 64 * i + tq;
  LAS float* wsf = (LAS float*)(lds + L_WSF) + wid * 64;
  LAS float* imph = (LAS float*)(lds + L_IMP) + e * 4096;
  const int vb0 = (int)(unsigned)(size_t)lds + ((lane >> 4) & 1) * 32 + (lane & 3) * 8 + (4 * hi + ((lane & 15) >> 2)) * 64;
  bf16x8 qr[4];
#pragma unroll
  for (int d0 = 0; d0 < 4; ++d0) qr[d0] = *(const bf16x8*)(B.QKV + tok * QKVW + h * 64 + d0 * 16 + hi * 8);
  const float g0 = B.NG[tok * 24 + h * 3 + 0], g1 = B.NG[tok * 24 + h * 3 + 1], g2 = B.NG[tok * 24 + h * 3 + 2];
  const u16* kc = B.KCMP + (size_t)(b * 2 + g) * 256 * 64; const u16* vc = B.VCMP + (size_t)(b * 2 + g) * 256 * 64;
  const u16* ksb = B.QKV + (size_t)b * S * QKVW + nv::O_KS + g * 64; const u16* vsb = B.QKV + (size_t)b * S * QKVW + nv::O_VS + g * 64;
  const u16* kwb = B.QKV + (size_t)b * S * QKVW + nv::O_KW + g * 64; const u16* vwb = B.QKV + (size_t)b * S * QKVW + nv::O_VW + g * 64;
  int nvis = t >= 31 ? (t - 31) / 16 + 1 : 0; nvis = nvis > 255 ? 255 : nvis;
  const int ntA = (4 * i + 3 + 63) / 64, nC = (i < 8 ? i : 8) + 1, jC0 = i - (nC - 1);
  const int sI = ntA, sB = 2 * ntA, sC = sB + i + 1, NS = sC + nC;
  { LAS float* IM = (LAS float*)(lds + L_IMP); for (int k = tid; k < 4 * 4096; k += 512) IM[k] = 0.f; }
  f32x16 outacc[2];
#pragma unroll
  for (int r = 0; r < 16; ++r) { outacc[0][r] = 0.f; outacc[1][r] = 0.f; }
  SmState st; sm_reset(st);
  float mA = -1.0e30f, invlA = 0.f; unsigned long long mybits = 0ull;
#define FA_ISSUE(s_) do { const int s__ = (s_); const int sl = s__ & 1; \
    if (s__ < sI) stage_kv(lds, sl, kc + (size_t)s__ * 4096, vc + (size_t)s__ * 4096, 64, wid, lane, true); \
    else if (s__ < sB) stage_kv(lds, sl, kc + (size_t)(s__ - sI) * 4096, vc, 64, wid, lane, false); \
    else if (s__ < sC) stage_kv(lds, sl, ksb + (size_t)(s__ - sB) * 64 * QKVW, vsb + (size_t)(s__ - sB) * 64 * QKVW, QKVW, wid, lane, true); \
    else stage_kv(lds, sl, kwb + (size_t)(jC0 + s__ - sC) * 64 * QKVW, vwb + (size_t)(jC0 + s__ - sC) * 64 * QKVW, QKVW, wid, lane, true); } while (0)
  FA_ISSUE(0);
  for (int s = 0; s < NS; ++s) {
    asm volatile("s_waitcnt vmcnt(0)" ::: "memory"); __syncthreads();
    if (s + 1 < NS) FA_ISSUE(s + 1);
    const int sl = s & 1;
    if (s < sI) { tile_step(st, lds, sl, qr, wsf, r32, hi, vb0, 0, nvis - 64 * s - 1);
      if (s == sI - 1) { finalize(st, g0, outacc, wsf, r32, hi, mA, invlA); sm_reset(st); } }
    else if (s < sB) { imp_step(lds, sl, qr, r32, hi, nvis - 64 * (s - sI) - 1, mA, invlA, imph, tq, s - sI);
      if (s == sB - 1) { __syncthreads(); topk_select(lds, wid, lane, i); __syncthreads(); mybits = ((const LAS unsigned long long*)(lds + L_MASK))[tq]; } }
    else if (s < sC) { const int j = s - sB; const bool selj = (mybits >> j) & 1ull; tile_step(st, lds, sl, qr, wsf, r32, hi, vb0, 0, selj ? (j == i ? tq : 63) : -1);
      if (s == sC - 1) { float d0_, d1_; finalize(st, g1, outacc, wsf, r32, hi, d0_, d1_); sm_reset(st); } }
    else { const int j = jC0 + (s - sC); tile_step(st, lds, sl, qr, wsf, r32, hi, vb0, (i >= 8 && j == i - 8) ? tq + 1 : 0, j == i ? tq : 63);
      if (s == NS - 1) { float d0_, d1_; finalize(st, g2, outacc, wsf, r32, hi, d0_, d1_); } }
  }
#undef FA_ISSUE
  { u16* Ow = B.YA + ((size_t)b * S + 64 * i + 32 * (wid & 1)) * 512 + h * 64; LAS u16* stg = (LAS u16*)(lds + L_OST) + wid * 2048;
#pragma unroll
    for (int r = 0; r < 16; ++r) { const int orow = crow(r, hi); stg[orow * 64 + r32] = nv::f2bf(outacc[0][r]); stg[orow * 64 + 32 + r32] = nv::f2bf(outacc[1][r]); }
    asm volatile("s_waitcnt lgkmcnt(0)" ::: "memory");
#pragma unroll
    for (int q = 0; q < 4; ++q) { const int row = q * 8 + (lane >> 3), ch = lane & 7; const u32x4 v = *(const LAS u32x4*)(stg + row * 64 + ch * 8); *(u32x4*)(Ow + (size_t)row * 512 + ch * 8) = v; } }
  __syncthreads();
}
__device__ __forceinline__ void phase_attention(LAS unsigned char* lds, const Bufs& B) {
  const int G = gridDim.x, bx = blockIdx.x; const int vcu = (G % 8 == 0) ? (bx % 8) * (G / 8) + bx / 8 : bx;
  for (int u = vcu; u < 256; u += G) { const int bg = u >> 4, s = u & 15;
#pragma unroll 1
    for (int k = 0; k < 4; ++k) { const int i = (k == 0) ? s : (k == 1) ? 31 - s : (k == 2) ? 32 + s : 63 - s; attn_unit(lds, B, bg >> 1, bg & 1, i); } }
}
}
namespace fs {
using nv::u16; using nv::Bufs; using nv::Inputs;
using fa::bf16x8; using fa::f32x16; using fa::u32x4; using fa::crow; using fa::ex2;
typedef float f32x4 __attribute__((ext_vector_type(4)));
constexpr int S = nv::S, NTOK = nv::NTOK, SCD = 1536;
constexpr float LOG2E = 1.4426950408889634f;
struct SsdBufs { u16* XC; u16* STATE; float* ACS; float* DEC; };
__host__ __device__ inline size_t carve_ssd(SsdBufs& X, const Bufs& B, unsigned char* ws, size_t off) {
  auto take = [&](size_t bytes) { unsigned char* r = ws + off; off += (bytes + 255) / 256 * 256; return r; };
  X.XC = B.HB;
  X.STATE = B.HB + (size_t)NTOK * SCD;
  X.ACS = (float*)take((size_t)NTOK * 16 * 4); X.DEC = (float*)take((size_t)8 * 16 * 16 * 4);
  return off;
}
constexpr int L_ARR = 101376;
constexpr int L_BT = 0, BT_LD = 264, L_XWT = 67584;
constexpr int L_KIMG = 0, L_XV = 0, L_OST = 65536;
static_assert(L_XWT + 64 * BT_LD * 2 <= L_ARR && L_OST + 32768 <= L_ARR && L_ARR + 16384 <= 147456, "SSD LDS map");

__device__ __forceinline__ void phase_conv(const Inputs& I, const Bufs& B, const SsdBufs& X) {
  for (int it = blockIdx.x * 512 + fx::otid(); it < NTOK * (SCD / 8); it += gridDim.x * 512) { const int tok = it / (SCD / 8), c8 = (it % (SCD / 8)) * 8; const int t = tok & (S - 1);
    float acc[8];
#pragma unroll
    for (int j = 0; j < 8; ++j) acc[j] = I.conv_b[c8 + j];
#pragma unroll
    for (int k = 0; k < 4; ++k) { if (t - 3 + k >= 0) { float x[8]; fx::load8(B.XBC + (size_t)(tok - 3 + k) * SCD + c8, x);
#pragma unroll
        for (int j = 0; j < 8; ++j) acc[j] += I.conv_w[k * SCD + c8 + j] * x[j]; } }
    float y[8];
#pragma unroll
    for (int j = 0; j < 8; ++j) y[j] = acc[j] * fx::fsig(acc[j]);
    fx::store8(X.XC + (size_t)tok * SCD + c8, y); }
}

__device__ __forceinline__ void ssd_x_unit(LAS unsigned char* lds, const Inputs& I, const Bufs& B, const SsdBufs& X, int b, int c, int g) {
  const int tid = fx::otid(), lane = tid & 63, wid = __builtin_amdgcn_readfirstlane(tid >> 6), r32 = lane & 31, hi = lane >> 5, fr = lane & 15, fq = lane >> 4;
  const size_t tok0 = (size_t)b * S + (size_t)c * 256;
  LAS float* acs2 = (LAS float*)(lds + L_ARR); LAS float* dtl = acs2 + 8 * 256;
  { const int hh = g * 8 + wid; const float a = -expf(I.a_log[hh]) * LOG2E; float d[4], sc[4];
#pragma unroll
    for (int k = 0; k < 4; ++k) d[k] = B.DT[(tok0 + 4 * lane + k) * 16 + hh];
    sc[0] = d[0] * a; sc[1] = sc[0] + d[1] * a; sc[2] = sc[1] + d[2] * a; sc[3] = sc[2] + d[3] * a;
    float tot = sc[3];
#pragma unroll
    for (int o = 1; o < 64; o <<= 1) { const float up = __shfl_up(tot, o); if (lane >= o) tot += up; }
    const float excl = tot - sc[3];
#pragma unroll
    for (int k = 0; k < 4; ++k) { const float v = excl + sc[k]; acs2[wid * 256 + 4 * lane + k] = v; dtl[wid * 256 + 4 * lane + k] = d[k]; X.ACS[(tok0 + 4 * lane + k) * 16 + hh] = v; }
    if (lane == 63) X.DEC[((size_t)b * 16 + c) * 16 + hh] = ex2(tot); }
  { LAS u16* BT = (LAS u16*)(lds + L_BT);
#pragma unroll 1
    for (int q = tid; q < 256 * 16; q += 512) { const int l = q >> 4, n8 = (q & 15) * 8; const u32x4 w = *(const u32x4*)(X.XC + (tok0 + l) * SCD + 1024 + g * 128 + n8);
      BT[(n8 + 0) * BT_LD + l] = (u16)(w.x & 0xffff); BT[(n8 + 1) * BT_LD + l] = (u16)(w.x >> 16); BT[(n8 + 2) * BT_LD + l] = (u16)(w.y & 0xffff); BT[(n8 + 3) * BT_LD + l] = (u16)(w.y >> 16);
      BT[(n8 + 4) * BT_LD + l] = (u16)(w.z & 0xffff); BT[(n8 + 5) * BT_LD + l] = (u16)(w.z >> 16); BT[(n8 + 6) * BT_LD + l] = (u16)(w.w & 0xffff); BT[(n8 + 7) * BT_LD + l] = (u16)(w.w >> 16); } }
  __syncthreads();
#pragma unroll 1
  for (int h = 0; h < 8; ++h) { const int hh = g * 8 + h; LAS u16* XwT = (LAS u16*)(lds + L_XWT); const LAS u16* BT = (const LAS u16*)(lds + L_BT);
    const float aend = acs2[h * 256 + 255];
#pragma unroll 1
    for (int q = tid; q < 256 * 8; q += 512) { const int l = q >> 3, p8 = (q & 7) * 8; float x[8]; fx::load8(X.XC + (tok0 + l) * SCD + hh * 64 + p8, x); const float w = ex2(aend - acs2[h * 256 + l]) * dtl[h * 256 + l];
#pragma unroll
      for (int j = 0; j < 8; ++j) XwT[(p8 + j) * BT_LD + l] = nv::f2bf(x[j] * w); }
    __syncthreads();
    { const int pt = wid & 3, nt0 = (wid >> 2) * 4; pg8::f32x4 acc[4];
#pragma unroll
      for (int n = 0; n < 4; ++n) acc[n] = (pg8::f32x4){0.f, 0.f, 0.f, 0.f};
#pragma unroll
      for (int ks = 0; ks < 8; ++ks) { const bf16x8 a = *(const LAS bf16x8*)(XwT + (pt * 16 + fr) * BT_LD + ks * 32 + fq * 8);
#pragma unroll
        for (int n = 0; n < 4; ++n) { const bf16x8 bb = *(const LAS bf16x8*)(BT + ((nt0 + n) * 16 + fr) * BT_LD + ks * 32 + fq * 8); acc[n] = __builtin_amdgcn_mfma_f32_16x16x32_bf16(a, bb, acc[n], 0, 0, 0); } }
      u16* st = X.STATE + (((size_t)b * 16 + c) * 16 + hh) * 8192;
#pragma unroll
      for (int n = 0; n < 4; ++n)
#pragma unroll
        for (int j = 0; j < 4; ++j) st[(pt * 16 + 4 * fq + j) * 128 + (nt0 + n) * 16 + fr] = nv::f2bf(acc[n][j]); }
    __syncthreads(); }
  const int l = 32 * wid + r32;
  bf16x8 qr[8];
#pragma unroll
  for (int d0 = 0; d0 < 8; ++d0) qr[d0] = *(const bf16x8*)(X.XC + (tok0 + l) * SCD + 1280 + g * 128 + d0 * 16 + hi * 8);
  unsigned Sp[4][16];
#define FS_STAGE_K(j_) do { const int j__ = (j_); _Pragma("unroll") for (int q = 0; q < 2; ++q) { const int ch = wid + 8 * q; \
    __builtin_amdgcn_global_load_lds((const unsigned*)(X.XC + (tok0 + 64 * j__ + lane) * SCD + 1024 + g * 128 + ch * 8), (LAS unsigned*)(lds + L_KIMG + (j__ & 1) * 16384 + ch * 1024), 16, 0, 0); } } while (0)
  FS_STAGE_K(0);
#pragma unroll
  for (int j = 0; j < 4; ++j) {
    asm volatile("s_waitcnt vmcnt(0)" ::: "memory"); __syncthreads();
    if (j + 1 < 4) FS_STAGE_K(j + 1);
    f32x16 p0, p1;
#pragma unroll
    for (int r = 0; r < 16; ++r) { p0[r] = 0.f; p1[r] = 0.f; }
    if (64 * j <= 32 * wid + 31) { const LAS unsigned char* kb = lds + L_KIMG + (j & 1) * 16384 + hi * 1024 + r32 * 16;
#pragma unroll
      for (int d0 = 0; d0 < 8; ++d0) { const bf16x8 b0 = *(const LAS bf16x8*)(kb + d0 * 2048), b1 = *(const LAS bf16x8*)(kb + d0 * 2048 + 512);
        p0 = __builtin_amdgcn_mfma_f32_32x32x16_bf16(b0, qr[d0], p0, 0, 0, 0); p1 = __builtin_amdgcn_mfma_f32_32x32x16_bf16(b1, qr[d0], p1, 0, 0, 0); } }
#pragma unroll
    for (int r = 0; r < 8; ++r) { Sp[j][r] = pg8::cvt_pk_bf16(p0[2 * r], p0[2 * r + 1]); Sp[j][8 + r] = pg8::cvt_pk_bf16(p1[2 * r], p1[2 * r + 1]); } }
#undef FS_STAGE_K
  __syncthreads();
#define FS_STAGE_X(h_) do { const int h__ = (h_); _Pragma("unroll") for (int j = 0; j < 4; ++j) \
    __builtin_amdgcn_global_load_lds((const unsigned*)(X.XC + (tok0 + 64 * j + 16 * (wid & 3) + (lane >> 2)) * SCD + (g * 8 + h__) * 64 + (wid >> 2) * 32 + (lane & 3) * 8), \
                                     (LAS unsigned*)(lds + L_XV + (h__ & 1) * 32768 + j * 8192 + wid * 1024), 16, 0, 0); } while (0)
  const int vb0 = (int)(unsigned)(size_t)lds + ((lane >> 4) & 1) * 32 + (lane & 3) * 8 + (4 * hi + ((lane & 15) >> 2)) * 64;
  FS_STAGE_X(0);
#pragma unroll 1
  for (int h = 0; h < 8; ++h) { const int hh = g * 8 + h;
    asm volatile("s_waitcnt vmcnt(0)" ::: "memory"); __syncthreads();
    if (h + 1 < 8) FS_STAGE_X(h + 1);
    const float al = acs2[h * 256 + l]; f32x16 o[2];
#pragma unroll
    for (int r = 0; r < 16; ++r) { o[0][r] = 0.f; o[1][r] = 0.f; }
#pragma unroll
    for (int j = 0; j < 4; ++j) { if (64 * j <= 32 * wid + 31) { f32x16 p0, p1;
#pragma unroll
        for (int r = 0; r < 16; ++r) asm volatile("" : "+v"(Sp[j][r]));
#pragma unroll
        for (int r = 0; r < 8; ++r) { p0[2 * r] = __uint_as_float(Sp[j][r] << 16); p0[2 * r + 1] = __uint_as_float(Sp[j][r] & 0xffff0000u); p1[2 * r] = __uint_as_float(Sp[j][8 + r] << 16); p1[2 * r + 1] = __uint_as_float(Sp[j][8 + r] & 0xffff0000u); }
#pragma unroll
        for (int gq = 0; gq < 4; ++gq) { const int s0 = 64 * j + 8 * gq + 4 * hi; const f32x4 a0 = *(const LAS f32x4*)(acs2 + h * 256 + s0), d0v = *(const LAS f32x4*)(dtl + h * 256 + s0), a1 = *(const LAS f32x4*)(acs2 + h * 256 + s0 + 32), d1v = *(const LAS f32x4*)(dtl + h * 256 + s0 + 32);
#pragma unroll
          for (int k = 0; k < 4; ++k) { const int r = 4 * gq + k, s = s0 + k; p0[r] = (s <= l) ? p0[r] * ex2(al - a0[k]) * d0v[k] : 0.f; p1[r] = (s + 32 <= l) ? p1[r] * ex2(al - a1[k]) * d1v[k] : 0.f; } }
        u32x4 w0, w1, w2, w3;
        w0.x = pg8::cvt_pk_bf16(p0[0], p0[1]); w0.y = pg8::cvt_pk_bf16(p0[2], p0[3]); w0.z = pg8::cvt_pk_bf16(p0[4], p0[5]); w0.w = pg8::cvt_pk_bf16(p0[6], p0[7]);
        w1.x = pg8::cvt_pk_bf16(p0[8], p0[9]); w1.y = pg8::cvt_pk_bf16(p0[10], p0[11]); w1.z = pg8::cvt_pk_bf16(p0[12], p0[13]); w1.w = pg8::cvt_pk_bf16(p0[14], p0[15]);
        w2.x = pg8::cvt_pk_bf16(p1[0], p1[1]); w2.y = pg8::cvt_pk_bf16(p1[2], p1[3]); w2.z = pg8::cvt_pk_bf16(p1[4], p1[5]); w2.w = pg8::cvt_pk_bf16(p1[6], p1[7]);
        w3.x = pg8::cvt_pk_bf16(p1[8], p1[9]); w3.y = pg8::cvt_pk_bf16(p1[10], p1[11]); w3.z = pg8::cvt_pk_bf16(p1[12], p1[13]); w3.w = pg8::cvt_pk_bf16(p1[14], p1[15]);
        fa::pv(o, vb0 + L_XV + (h & 1) * 32768 + j * 8192, __builtin_bit_cast(bf16x8, w0), __builtin_bit_cast(bf16x8, w1), __builtin_bit_cast(bf16x8, w2), __builtin_bit_cast(bf16x8, w3)); } }
    { const float dsk = I.d_skip[hh]; const LAS u16* xi = (const LAS u16*)(lds + L_XV + (h & 1) * 32768 + (wid >> 1) * 8192); LAS u16* stg = (LAS u16*)(lds + L_OST) + wid * 2048;
#pragma unroll
      for (int r = 0; r < 16; ++r) { const int key = 32 * (wid & 1) + crow(r, hi);
#pragma unroll
        for (int d0 = 0; d0 < 2; ++d0) { const float xv = nv::bf2f(xi[d0 * 2048 + (key >> 4) * 512 + (key & 15) * 32 + r32]); stg[crow(r, hi) * 64 + d0 * 32 + r32] = nv::f2bf(o[d0][r] + dsk * xv); } }
      asm volatile("s_waitcnt lgkmcnt(0)" ::: "memory");
      u16* Ow = X.XC + (tok0 + 32 * wid) * SCD + hh * 64;
#pragma unroll
      for (int q = 0; q < 4; ++q) { const int row = q * 8 + (lane >> 3), ch = lane & 7; const u32x4 v = *(const LAS u32x4*)(stg + row * 64 + ch * 8); *(u32x4*)(Ow + (size_t)row * SCD + ch * 8) = v; } } }
#undef FS_STAGE_X
  __syncthreads();
}
__device__ __forceinline__ void phase_ssd_x(LAS unsigned char* lds, const Inputs& I, const Bufs& B, const SsdBufs& X) {
  for (int u = blockIdx.x; u < 256; u += gridDim.x) ssd_x_unit(lds, I, B, X, u >> 5, (u >> 1) & 15, u & 1);
}
__device__ __forceinline__ void phase_ssd_scan(const SsdBufs& X) {
  for (int it = blockIdx.x * 512 + fx::otid(); it < 8 * 16 * 64 * 16; it += gridDim.x * 512) { const int n8 = (it & 15) * 8, p = (it >> 4) & 63, hh = (it >> 10) & 15, b = it >> 14;
    float hrun[8];
#pragma unroll
    for (int j = 0; j < 8; ++j) hrun[j] = 0.f;
#pragma unroll 1
    for (int c = 0; c < 16; ++c) { u16* st = X.STATE + (((size_t)b * 16 + c) * 16 + hh) * 8192 + p * 128 + n8; float v[8]; fx::load8(st, v); const float dec = X.DEC[((size_t)b * 16 + c) * 16 + hh];
      fx::store8(st, hrun);
#pragma unroll
      for (int j = 0; j < 8; ++j) hrun[j] = hrun[j] * dec + v[j]; } }
}
__device__ __forceinline__ void ssd_y_unit(LAS unsigned char* lds, const Inputs& I, const Bufs& B, const SsdBufs& X, int b, int c, int g) {
  const int tid = fx::otid(), lane = tid & 63, wid = __builtin_amdgcn_readfirstlane(tid >> 6), r32 = lane & 31, hi = lane >> 5;
  const size_t tok0 = (size_t)b * S + (size_t)c * 256; const int l = 32 * wid + r32;
  LAS float* acsw = (LAS float*)(lds + 0) + wid * 32 * 8;
  LAS u16* stg1 = (LAS u16*)(lds + 16384) + wid * 2048; LAS u16* stg2 = (LAS u16*)(lds + 49152) + wid * 2048; LAS float* rstdL = (LAS float*)(lds + 81920);
  { const int row = lane >> 1, h4 = (lane & 1) * 4; const f32x4 a = *(const f32x4*)(X.ACS + (tok0 + 32 * wid + row) * 16 + g * 8 + h4); acsw[row * 8 + h4 + 0] = ex2(a.x); acsw[row * 8 + h4 + 1] = ex2(a.y); acsw[row * 8 + h4 + 2] = ex2(a.z); acsw[row * 8 + h4 + 3] = ex2(a.w); }
  bf16x8 qr[8];
#pragma unroll
  for (int d0 = 0; d0 < 8; ++d0) qr[d0] = *(const bf16x8*)(X.XC + (tok0 + l) * SCD + 1280 + g * 128 + d0 * 16 + hi * 8);
  float ssq[16];
#pragma unroll
  for (int r = 0; r < 16; ++r) ssq[r] = 0.f;
#pragma unroll 1
  for (int h = 0; h < 8; ++h) { const int hh = g * 8 + h; const u16* pv_ = X.STATE + (((size_t)b * 16 + c) * 16 + hh) * 8192;
    f32x16 y[2];
#pragma unroll
    for (int r = 0; r < 16; ++r) { y[0][r] = 0.f; y[1][r] = 0.f; }
#pragma unroll
    for (int d0 = 0; d0 < 8; ++d0) { const bf16x8 b0 = *(const bf16x8*)(pv_ + (size_t)r32 * 128 + d0 * 16 + hi * 8), b1 = *(const bf16x8*)(pv_ + (size_t)(32 + r32) * 128 + d0 * 16 + hi * 8);
      y[0] = __builtin_amdgcn_mfma_f32_32x32x16_bf16(qr[d0], b0, y[0], 0, 0, 0); y[1] = __builtin_amdgcn_mfma_f32_32x32x16_bf16(qr[d0], b1, y[1], 0, 0, 0); }
#pragma unroll
    for (int q = 0; q < 4; ++q) { const int row = q * 8 + (lane >> 3), ch = lane & 7;
      *(LAS u32x4*)(stg1 + row * 64 + ch * 8) = *(const u32x4*)(X.XC + (tok0 + 32 * wid + row) * SCD + hh * 64 + ch * 8);
      *(LAS u32x4*)(stg2 + row * 64 + ch * 8) = *(const u32x4*)(B.Z + (tok0 + 32 * wid + row) * 1024 + hh * 64 + ch * 8); }
    asm volatile("s_waitcnt lgkmcnt(0)" ::: "memory");
#pragma unroll
    for (int r = 0; r < 16; ++r) { const int row = crow(r, hi); const float ea = acsw[row * 8 + h];
#pragma unroll
      for (int d0 = 0; d0 < 2; ++d0) { const int idx = row * 64 + d0 * 32 + r32; const float yy = nv::bf2f(stg1[idx]) + ea * y[d0][r]; const float zz = nv::bf2f(stg2[idx]); const float yg = yy * zz * fx::fsig(zz); ssq[r] += yg * yg; stg1[idx] = nv::f2bf(yg); } }
    asm volatile("s_waitcnt lgkmcnt(0)" ::: "memory");
#pragma unroll
    for (int q = 0; q < 4; ++q) { const int row = q * 8 + (lane >> 3), ch = lane & 7; *(u32x4*)(B.YB + (tok0 + 32 * wid + row) * 1024 + hh * 64 + ch * 8) = *(const LAS u32x4*)(stg1 + row * 64 + ch * 8); }
    asm volatile("s_waitcnt lgkmcnt(0)" ::: "memory"); }
#pragma unroll
  for (int r = 0; r < 16; ++r) { float v = ssq[r];
#pragma unroll
    for (int o = 1; o < 32; o <<= 1) v += __shfl_xor(v, o);
    if (r32 == 0) rstdL[32 * wid + crow(r, hi)] = 1.0f / sqrtf(v * (1.f / 512.f) + nv::EPS); }
  __threadfence(); __syncthreads();
#pragma unroll 1
  for (int q = tid; q < 256 * 64; q += 512) { const int row = q >> 6, c8 = (q & 63) * 8; u16* p = B.YB + (tok0 + row) * 1024 + g * 512 + c8; float v[8]; fx::load8(p, v); const float rs = rstdL[row];
#pragma unroll
    for (int j = 0; j < 8; ++j) v[j] = v[j] * rs * I.ssm_norm[g * 512 + c8 + j];
    fx::store8(p, v); }
  __syncthreads();
}
__device__ __forceinline__ void phase_ssd_y(LAS unsigned char* lds, const Inputs& I, const Bufs& B, const SsdBufs& X) {
  for (int u = blockIdx.x; u < 256; u += gridDim.x) ssd_y_unit(lds, I, B, X, u >> 5, (u >> 1) & 15, u & 1);
}
}
struct Params { nv::Inputs I; float* out; unsigned char* ws; };
constexpr int LDS_BYTES = 147456;
template <class F> __device__ __forceinline__ void run_phase(const F& f, long n) {
  for (long i = blockIdx.x * 512L + fx::otid(); i < n; i += (long)gridDim.x * 512L) f(i);
}
__global__ void __launch_bounds__(512) mega_fwd(Params P) {
  extern __shared__ __attribute__((aligned(16))) unsigned char lds_raw[];
  LAS unsigned char* lds = (LAS unsigned char*)lds_raw;
  cg::grid_group grid = cg::this_grid();
  nv::Bufs B; const size_t woff = nv::carve(B, P.ws, P.out); fx::WBufs W; const size_t moff = fx::carve_w(W, P.ws, woff); fx::MoeBufs M; const size_t soff = fx::carve_moe(M, B, P.ws, moff); fs::SsdBufs X; fs::carve_ssd(X, B, P.ws, soff);
  float* out = P.out;
#define RUN(f, n) { run_phase(f, n); grid.sync(); }
  fx::phase_prologue(lds, P.I, B, W); fx::prologue_moe(P.I, M); grid.sync();
  fx::dense_gemm(lds, B.HB, 1024, W.WinT, 1024, nv::NTOK, fx::INW_PAD, 1024, fx::FInProj{B.QKV, B.Z, B.XBC, B.BG, B.NG, B.DT, P.I.dt_bias}); grid.sync();
  fs::phase_conv(P.I, B, X); fa::phase_qknorm(P.I, B); grid.sync();
  fs::phase_ssd_x(lds, P.I, B, X); grid.sync();
  fs::phase_ssd_scan(X); grid.sync();
  fs::phase_ssd_y(lds, P.I, B, X); grid.sync();
  NV2_STAGE_COMPRESS(RUN, P.I, B, out)
  fa::phase_attention(lds, B); grid.sync();
  fx::dense_gemm(lds, B.YA, 512, W.WaT, 512, nv::NTOK, 1024, 512, fx::FStoreBf{B.T1, 1024});
  fx::dense_gemm(lds, B.YB, 1024, W.WbT, 1024, nv::NTOK, 1024, 1024, fx::FMerge{B.T1, B.BG, B.MERGED}); grid.sync();
  fx::dense_gemm(lds, B.MERGED, 1024, W.WoutT, 1024, nv::NTOK, 1024, 1024, fx::FResid{P.I.x, out}); grid.sync();
  fx::phase_rms_rows(out, P.I.moe_norm, B.H2); grid.sync();
  fx::dense_gemm(lds, B.H2, 1024, M.WrT, 1024, nv::NTOK, 256, 1024, fx::FLogits{M.LOGITS}); grid.sync();
  fx::phase_route(P.I, B, M); grid.sync();
  fx::build_tile_table(lds, M);
  fx::phase_moe_gu(lds, B, W, M); grid.sync();
  fx::phase_moe_down(lds, B, W, M); grid.sync();
  fx::phase_moe_combine(out, M.MOEOUT, P.I.ple_norm, B.H2); grid.sync();
  fx::dense_gemm(lds, W.PB, 256, W.PlePT, 256, nv::NTOK, 1024, 256, fx::FStoreBf{B.PP, 1024});
  fx::dense_gemm(lds, B.H2, 1024, W.PleGT, 1024, nv::NTOK, 1024, 1024, fx::FPle{out, B.PP});
#undef RUN
}
extern "C" void kernel_launch(void* const* d_in, const int* in_sizes, int n_in, void* d_out, int out_size, void* d_ws, size_t ws_size, hipStream_t stream) {
  static int grid_blocks = 0;
  if (!grid_blocks) {
    int dev = 0, cus = 0, per_cu = 0;
    (void)hipGetDevice(&dev);
    (void)hipDeviceGetAttribute(&cus, hipDeviceAttributeMultiprocessorCount, dev);
    if (hipFuncSetAttribute((const void*)mega_fwd, hipFuncAttributeMaxDynamicSharedMemorySize, LDS_BYTES) != hipSuccess) fprintf(stderr, "kernel_launch: hipFuncSetAttribute failed\n");
    if (hipOccupancyMaxActiveBlocksPerMultiprocessor(&per_cu, mega_fwd, 512, LDS_BYTES) != hipSuccess || per_cu < 1) { fprintf(stderr, "kernel_launch: occupancy query says %d blocks per CU\n", per_cu); }
    grid_blocks = cus;
    { nv::Bufs B; fx::WBufs W; fx::MoeBufs M; fs::SsdBufs X; size_t need = fs::carve_ssd(X, B, nullptr, fx::carve_moe(M, B, nullptr, fx::carve_w(W, nullptr, nv::carve(B, nullptr, nullptr)))); if (need > ws_size) fprintf(stderr, "kernel_launch: workspace too small: need %zu have %zu\n", need, ws_size); }
  }
  Params p; memset(&p, 0, sizeof(p));
  const float** ip = (const float**)&p.I; for (int i = 0; i < 34; ++i) ip[i] = (const float*)d_in[i];
  p.out = (float*)d_out; p.ws = (unsigned char*)d_ws;
  void* args[] = {&p};
  hipError_t e = hipLaunchCooperativeKernel((void*)mega_fwd, dim3(grid_blocks), dim3(512), args, LDS_BYTES, stream);
  if (e != hipSuccess) fprintf(stderr, "cooperative launch failed: %s (grid %d)\n", hipGetErrorString(e), grid_blocks);
}
```

```cpp
#include <hip/hip_runtime.h>
#include <hip/hip_cooperative_groups.h>
#include <cstdio>
#include <cstring>
namespace cg = cooperative_groups;
#define HD __host__ __device__ inline
#if defined(__HIP_DEVICE_COMPILE__)
#define NV_FENCE() asm volatile("" ::: "memory")
#else
#define NV_FENCE()
#endif
#ifndef CFG_DM
#define CFG_DM 1024
#endif
#ifndef CFG_BATCH
#define CFG_BATCH 8
#endif
#ifndef CFG_SEQ
#define CFG_SEQ 4096
#endif
#ifndef CFG_MH
#define CFG_MH 256
#endif
#ifndef CFG_PLE
#define CFG_PLE 256
#endif

#ifndef NV_FENCE
#define NV_FENCE()
#endif
namespace nv {
typedef unsigned short u16;
typedef unsigned long long u64;
constexpr int DM = CFG_DM, NB = CFG_BATCH, S = CFG_SEQ, MH = CFG_MH, PLE = CFG_PLE;
constexpr int NTOK = NB * S;
constexpr int H = 8, G = 2, E = 4;
constexpr int QW = 512, GW = 24, QKVW = 1280;
constexpr int SH = 16, SP = 64, SI = 1024, SG = 2, SN = 128, SCD = 1536;
constexpr int INW = QW + 6 * 128 + GW + SI + SCD + SH + 2 * DM;
constexpr int O_Q = 0, O_KC = 512, O_VC = 640, O_KS = 768, O_VS = 896, O_KW = 1024, O_VW = 1152, O_NG = 1280, O_Z = 1304, O_XBC = 2328, O_DT = 3864, O_BG = 3880;
static_assert(O_BG + 2 * DM == INW, "in-proj width");
constexpr int NCMP = S / 16 - 1, NCP = S / 16, NSEL = S / 64, NTOP = NSEL < 16 ? NSEL : 16;
constexpr int NEXP = 32;
constexpr float EPS = 1e-6f;

HD float sigmoidf_(float x) { return 1.0f / (1.0f + expf(-x)); }
HD float siluf_(float x) { return x / (1.0f + expf(-x)); }
HD float softplusf_(float x) { return x > 20.f ? x : log1pf(expf(x)); }
HD u16 f2bf(float f) { unsigned u = __builtin_bit_cast(unsigned, f); u += 0x7fffu + ((u >> 16) & 1u); return (u16)(u >> 16); }
HD float bf2f(u16 h) { return __builtin_bit_cast(float, (unsigned)h << 16); }

struct Bufs {
  u16* HB;
  u16* QKV;
  float* NG;
  u16* Z;
  u16* XBC;
  float* DT;
  u16* BG;
  u16* KCMP;
  u16* VCMP;
  u16* YA;
  u16* YB;
  u16* T1;
  u16* MERGED;
  u16* H2;
  u16* ACT;
  u16* PP;
  int* EI;
  float* EW;
  float* HID;
  float* KTMP;
  float* ML;
  float* IMP;
  u64* MASK;
};
struct Inputs { const float *x, *p, *mix_norm, *w_in, *q_gain, *kc_gain, *ks_gain, *kw_gain, *pos_k, *w1_k, *w2_k, *pos_v, *w1_v, *w2_v, *conv_w, *conv_b, *dt_bias, *a_log, *d_skip, *ssm_norm,
  *w_a, *w_b, *w_out, *moe_norm, *w_group, *b_group, *w_expert, *b_expert, *w_gate, *w_up, *w_down, *ple_norm, *ple_wg, *ple_wp; };

struct RmsRowsBf { const float* in; const float* gain; u16* out; long ncols;
  HD void operator()(long r) const { const float* x = in + r * ncols; float s = 0.f; for (long c = 0; c < ncols; ++c) s += x[c] * x[c];
    const float rs = 1.0f / sqrtf(s / (float)ncols + EPS); u16* o = out + r * ncols; for (long c = 0; c < ncols; ++c) o[c] = f2bf(x[c] * rs * gain[c]); } };

template <class AL, class EP> struct GemmT { AL a; const float* B; EP ep; long M, N, K, ldb;
  HD long items() const { return ((M + 7) / 8) * ((N + 3) / 4); }
  HD void operator()(long it) const { const long nt = (N + 3) / 4; const long tm = it / nt, tn = it % nt; const long r0 = tm * 8, c0 = tn * 4;
    float acc[8][4];
#pragma unroll
    for (int i = 0; i < 8; ++i)
#pragma unroll
      for (int j = 0; j < 4; ++j) acc[i][j] = 0.f;
    for (long k = 0; k < K; ++k) { float b[4];
#pragma unroll
      for (int j = 0; j < 4; ++j) b[j] = (c0 + j < N) ? B[k * ldb + c0 + j] : 0.f;
#pragma unroll
      for (int i = 0; i < 8; ++i) { const long r = r0 + i < M ? r0 + i : M - 1; const float av = a(r, k);
#pragma unroll
        for (int j = 0; j < 4; ++j) acc[i][j] += av * b[j]; } }
#pragma unroll
    for (int i = 0; i < 8; ++i) if (r0 + i < M) {
#pragma unroll
      for (int j = 0; j < 4; ++j) if (c0 + j < N) ep(r0 + i, c0 + j, acc[i][j]); } } };
struct ABf { const u16* p; long ld; HD float operator()(long r, long k) const { return bf2f(p[r * ld + k]); } };
struct AF32 { const float* p; long ld; HD float operator()(long r, long k) const { return p[r * ld + k]; } };
struct ACmp { const u16* qkv; const float* pos; long off;
  HD float operator()(long r, long k) const { const long c = r % NCMP, bg = r / NCMP, b = bg / G, g = bg % G; const long l = k / 64, d = k % 64;
    return bf2f(qkv[(b * S + 16 * c + l) * QKVW + off + g * 64 + d]) + pos[k]; } };

struct EpInProj { Bufs B; const float* dt_bias;
  HD void operator()(long r, long c, float v) const {
    if (c < O_NG) B.QKV[r * QKVW + c] = f2bf(v);
    else if (c < O_Z) B.NG[r * GW + (c - O_NG)] = sigmoidf_(v);
    else if (c < O_XBC) B.Z[r * SI + (c - O_Z)] = f2bf(v);
    else if (c < O_DT) B.XBC[r * SCD + (c - O_XBC)] = f2bf(v);
    else if (c < O_BG) B.DT[r * SH + (c - O_DT)] = softplusf_(v + dt_bias[c - O_DT]);
    else B.BG[r * (2 * DM) + (c - O_BG)] = f2bf(sigmoidf_(v)); } };
struct EpSiluF32 { float* o; long ld; HD void operator()(long r, long c, float v) const { o[r * ld + c] = siluf_(v); } };
struct EpF32 { float* o; long ld; HD void operator()(long r, long c, float v) const { o[r * ld + c] = v; } };
struct EpBf { u16* o; long ld; HD void operator()(long r, long c, float v) const { o[r * ld + c] = f2bf(v); } };
struct EpMerge { const u16* t1; const u16* bg; u16* o; HD void operator()(long r, long c, float v) const { const float ga = bf2f(bg[r * (2 * DM) + c]), gb = bf2f(bg[r * (2 * DM) + DM + c]); o[r * DM + c] = f2bf(ga * bf2f(t1[r * DM + c]) + gb * v); } };
struct EpResid { const float* x; float* o; HD void operator()(long r, long c, float v) const { o[r * DM + c] = x[r * DM + c] + v; } };
struct EpPle { float* x; const u16* pp; HD void operator()(long r, long c, float v) const { x[r * DM + c] = x[r * DM + c] + sigmoidf_(v) * bf2f(pp[r * DM + c]); } };

struct QkNorm { u16* qkv; const float* qg; const float* ksg; const float* kwg;
  HD long items() const { return (long)NTOK * 12; }
  HD void operator()(long it) const { const long tok = it / 12; const int w = (int)(it % 12); u16* v; const float* gain;
    if (w < 8) { v = qkv + tok * QKVW + O_Q + w * 64; gain = qg; } else if (w < 10) { v = qkv + tok * QKVW + O_KS + (w - 8) * 64; gain = ksg; } else { v = qkv + tok * QKVW + O_KW + (w - 10) * 64; gain = kwg; }
    float s = 0.f; for (int d = 0; d < 64; ++d) { const float x = bf2f(v[d]); s += x * x; } const float rs = 1.0f / sqrtf(s / 64.f + EPS);
    for (int d = 0; d < 64; ++d) v[d] = f2bf(bf2f(v[d]) * rs * gain[d]); } };
struct CmpFinish { const float* src; const float* gain; u16* dst; long donorm;
  HD long items() const { return (long)NB * G * NCP; }
  HD void operator()(long it) const { const long c = it % NCP, bg = it / NCP; u16* o = dst + it * 64;
    if (c >= NCMP) { for (int d = 0; d < 64; ++d) o[d] = 0; return; }
    const float* x = src + (bg * NCMP + c) * 64; float rs = 1.f;
    if (donorm) { float s = 0.f; for (int d = 0; d < 64; ++d) s += x[d] * x[d]; rs = 1.0f / sqrtf(s / 64.f + EPS); }
    for (int d = 0; d < 64; ++d) o[d] = f2bf(donorm ? x[d] * rs * gain[d] : x[d]); } };

struct CmpAttn { Bufs B;
  HD long items() const { return (long)NB * H * S; }
  HD void operator()(long it) const { const long t = it % S; const int h = (int)((it / S) % H), g = h / E; const long b = it / ((long)S * H); const long tok = b * S + t;
    const u16* q = B.QKV + tok * QKVW + O_Q + h * 64; const u16* kc = B.KCMP + (b * G + g) * (long)NCP * 64; const u16* vc = B.VCMP + (b * G + g) * (long)NCP * 64;
    float qr[64];
#pragma unroll
    for (int d = 0; d < 64; ++d) qr[d] = bf2f(q[d]);
    long nvis = (t - 31 >= 0) ? (t - 31) / 16 + 1 : 0; if (nvis > NCMP) nvis = NCMP;
    float m = -3.0e38f;
    for (long c = 0; c < nvis; ++c) { const u16* k = kc + c * 64; float s = 0.f;
#pragma unroll
      for (int d = 0; d < 64; ++d) s += qr[d] * bf2f(k[d]);
      s *= 0.125f; m = s > m ? s : m; }
    float o[64];
#pragma unroll
    for (int d = 0; d < 64; ++d) o[d] = 0.f;
    float l = 0.f;
    for (long c = 0; c < nvis; ++c) { const u16* k = kc + c * 64; const u16* v = vc + c * 64; float s = 0.f;
#pragma unroll
      for (int d = 0; d < 64; ++d) s += qr[d] * bf2f(k[d]);
      const float p = expf(s * 0.125f - m); l += p;
#pragma unroll
      for (int d = 0; d < 64; ++d) o[d] += p * bf2f(v[d]); }
    const float g0 = B.NG[tok * GW + h * 3 + 0]; const float inv = nvis > 0 ? g0 / l : 0.f;
#pragma unroll
    for (int d = 0; d < 64; ++d) B.YA[tok * QW + h * 64 + d] = f2bf(o[d] * inv);
    B.ML[it * 2] = m; B.ML[it * 2 + 1] = nvis > 0 ? l : 0.f; } };
struct Importance { Bufs B;
  HD long items() const { return (long)NB * G * S * NSEL; }
  HD void operator()(long it) const { const int j = (int)(it % NSEL); const long bgt = it / NSEL; const long t = bgt % S; const long bg = bgt / S; const long b = bg / G; const int g = (int)(bg % G); const long tok = b * S + t;
    long nvis = (t - 31 >= 0) ? (t - 31) / 16 + 1 : 0; if (nvis > NCMP) nvis = NCMP;
    long c0 = 4 * j - 1; if (c0 < 0) c0 = 0; long c1 = 4 * j + 3; if (c1 > nvis - 1) c1 = nvis - 1;
    const u16* kc = B.KCMP + bg * (long)NCP * 64; float acc = 0.f;
    for (int e = 0; e < E; ++e) { const int h = g * E + e; const u16* q = B.QKV + tok * QKVW + O_Q + h * 64; const long mi = ((b * H + h) * (long)S + t) * 2; const float m = B.ML[mi], l = B.ML[mi + 1];
      if (l > 0.f) for (long c = c0; c <= c1; ++c) { const u16* k = kc + c * 64; float s = 0.f; for (int d = 0; d < 64; ++d) s += bf2f(q[d]) * bf2f(k[d]); acc += expf(s * 0.125f - m) / l; } }
    B.IMP[bgt * 64 + j] = acc; } };
struct TopSel { Bufs B;
  HD long items() const { return (long)NB * G * S; }
  HD void operator()(long bgt) const { const long t = bgt % S; const int cur = (int)(t / 64); u64 m = 0ull;
    for (int r = 0; r < NTOP; ++r) { float best = -3.0e38f; int bj = -1;
      for (int j = 0; j <= cur && j < NSEL; ++j) { if ((m >> j) & 1ull) continue; float v = B.IMP[bgt * 64 + j]; if (j == 0 || j == cur || j == cur - 1) v += 1000.f; if (v > best) { best = v; bj = j; } }
      if (bj < 0) break; m |= 1ull << bj; }
    B.MASK[bgt] = m; } };
struct SelAttn { Bufs B;
  HD long items() const { return (long)NB * H * S; }
  HD void operator()(long it) const { const long t = it % S; const int h = (int)((it / S) % H), g = h / E; const long b = it / ((long)S * H); const long tok = b * S + t;
    const u16* q = B.QKV + tok * QKVW + O_Q + h * 64; const u64 mk = B.MASK[(b * G + g) * (long)S + t];
    float qr[64], o[64];
#pragma unroll
    for (int d = 0; d < 64; ++d) { qr[d] = bf2f(q[d]); o[d] = 0.f; }
    float m = -3.0e38f, l = 0.f;
    for (int j = 0; j < NSEL; ++j) { if (!((mk >> j) & 1ull)) continue;
      for (long kp = 64L * j; kp < 64L * j + 64 && kp <= t; ++kp) { const u16* k = B.QKV + (b * S + kp) * QKVW + O_KS + g * 64; const u16* v = B.QKV + (b * S + kp) * QKVW + O_VS + g * 64; float s = 0.f;
#pragma unroll
        for (int d = 0; d < 64; ++d) s += qr[d] * bf2f(k[d]);
        s *= 0.125f;
        if (s > m) { const float f = expf(m - s); l *= f;
#pragma unroll
          for (int d = 0; d < 64; ++d) o[d] *= f;
          m = s; }
        const float p = expf(s - m); l += p;
#pragma unroll
        for (int d = 0; d < 64; ++d) o[d] += p * bf2f(v[d]); } }
    const float g1 = B.NG[tok * GW + h * 3 + 1]; const float inv = g1 / l;
#pragma unroll
    for (int d = 0; d < 64; ++d) { u16* y = B.YA + tok * QW + h * 64 + d; *y = f2bf(bf2f(*y) + o[d] * inv); } } };
struct WinAttn { Bufs B;
  HD long items() const { return (long)NB * H * S; }
  HD void operator()(long it) const { const long t = it % S; const int h = (int)((it / S) % H), g = h / E; const long b = it / ((long)S * H); const long tok = b * S + t;
    const u16* q = B.QKV + tok * QKVW + O_Q + h * 64;
    float qr[64], o[64];
#pragma unroll
    for (int d = 0; d < 64; ++d) { qr[d] = bf2f(q[d]); o[d] = 0.f; }
    float m = -3.0e38f, l = 0.f; long k0 = t - 511; if (k0 < 0) k0 = 0;
    for (long kp = k0; kp <= t; ++kp) { const u16* k = B.QKV + (b * S + kp) * QKVW + O_KW + g * 64; const u16* v = B.QKV + (b * S + kp) * QKVW + O_VW + g * 64; float s = 0.f;
#pragma unroll
      for (int d = 0; d < 64; ++d) s += qr[d] * bf2f(k[d]);
      s *= 0.125f;
      if (s > m) { const float f = expf(m - s); l *= f;
#pragma unroll
        for (int d = 0; d < 64; ++d) o[d] *= f;
        m = s; }
      const float p = expf(s - m); l += p;
#pragma unroll
      for (int d = 0; d < 64; ++d) o[d] += p * bf2f(v[d]); }
    const float g2 = B.NG[tok * GW + h * 3 + 2]; const float inv = g2 / l;
#pragma unroll
    for (int d = 0; d < 64; ++d) { u16* y = B.YA + tok * QW + h * 64 + d; *y = f2bf(bf2f(*y) + o[d] * inv); } } };

struct SsdConv { u16* xbc; const float* cw; const float* cb;
  HD long items() const { return (long)NB * SCD; }
  HD void operator()(long it) const { const int c = (int)(it % SCD); const long b = it / SCD; u16* col = xbc + b * S * SCD + c; const float w0 = cw[c], w1 = cw[SCD + c], w2 = cw[2 * SCD + c], w3 = cw[3 * SCD + c], bias = cb[c];
    for (long t = S - 1; t >= 0; --t) { float a = bias + w3 * bf2f(col[t * SCD]); if (t >= 1) a += w2 * bf2f(col[(t - 1) * SCD]); if (t >= 2) a += w1 * bf2f(col[(t - 2) * SCD]); if (t >= 3) a += w0 * bf2f(col[(t - 3) * SCD]);
      col[t * SCD] = f2bf(siluf_(a)); } } };
struct SsdScan { Bufs B; const float* alog; const float* dskip;
  HD long items() const { return (long)NB * SH * SP; }
  HD void operator()(long it) const { const int p = (int)(it % SP); const int hh = (int)((it / SP) % SH); const long b = it / (SP * SH); const int g = hh / 8;
    const float a = -expf(alog[hh]); float st[128];
#pragma unroll
    for (int n = 0; n < 128; ++n) st[n] = 0.f;
    for (long t = 0; t < S; ++t) { const long tok = b * S + t; const float dt = B.DT[tok * SH + hh]; const float dec = expf(dt * a); const float xd = bf2f(B.XBC[tok * SCD + hh * 64 + p]) * dt;
      const u16* Bv = B.XBC + tok * SCD + SI + g * SN; const u16* Cv = B.XBC + tok * SCD + SI + SG * SN + g * SN; float y = 0.f;
#pragma unroll
      for (int n = 0; n < 128; ++n) { st[n] = st[n] * dec + xd * bf2f(Bv[n]); y += bf2f(Cv[n]) * st[n]; if ((n & 15) == 15) { NV_FENCE(); } }
      B.XBC[tok * SCD + hh * 64 + p] = f2bf(y + bf2f(B.XBC[tok * SCD + hh * 64 + p]) * dskip[hh]); } } };
struct SsdOut { Bufs B; const float* ngain;
  HD long items() const { return (long)NTOK * SG; }
  HD void operator()(long it) const { const long tok = it / SG; const int g = (int)(it % SG); float s = 0.f;
    for (int c = g * 512; c < g * 512 + 512; ++c) { float y = bf2f(B.XBC[tok * SCD + c]); y *= siluf_(bf2f(B.Z[tok * SI + c])); s += y * y; }
    const float rs = 1.0f / sqrtf(s / 512.f + EPS);
    for (int c = g * 512; c < g * 512 + 512; ++c) { float y = bf2f(B.XBC[tok * SCD + c]); y *= siluf_(bf2f(B.Z[tok * SI + c])); B.YB[tok * SI + c] = f2bf(y * rs * ngain[c]); } } };

struct Router { const u16* h2; const float* wg; const float* bg; const float* we; const float* be; int* ei; float* ew;
  HD void operator()(long tok) const { const u16* x = h2 + tok * DM; float gl[4];
#pragma unroll
    for (int j = 0; j < 4; ++j) gl[j] = bg[j];
    for (long d = 0; d < DM; ++d) { const float xv = bf2f(x[d]);
#pragma unroll
      for (int j = 0; j < 4; ++j) gl[j] += xv * wg[d * 4 + j]; }
    int gi = 0; float gm = gl[0];
#pragma unroll
    for (int j = 1; j < 4; ++j) if (gl[j] > gm) { gm = gl[j]; gi = j; }
    float gs = 0.f;
#pragma unroll
    for (int j = 0; j < 4; ++j) gs += expf(gl[j] - gm);
    const float grp_w = 1.0f / gs;
    float el[8];
#pragma unroll
    for (int j = 0; j < 8; ++j) el[j] = be[gi * 8 + j];
    for (long d = 0; d < DM; ++d) { const float xv = bf2f(x[d]);
#pragma unroll
      for (int j = 0; j < 8; ++j) el[j] += xv * we[d * NEXP + gi * 8 + j]; }
    int i0 = 0; float m0 = el[0];
#pragma unroll
    for (int j = 1; j < 8; ++j) if (el[j] > m0) { m0 = el[j]; i0 = j; }
    int i1 = -1; float m1 = -3.0e38f;
#pragma unroll
    for (int j = 0; j < 8; ++j) if (j != i0 && el[j] > m1) { m1 = el[j]; i1 = j; }
    const float r = expf(m1 - m0); const float w0 = 1.0f / (1.0f + r), w1 = r / (1.0f + r);
    ei[tok * 2] = gi * 8 + i0; ei[tok * 2 + 1] = gi * 8 + i1; ew[tok * 2] = grp_w * w0; ew[tok * 2 + 1] = grp_w * w1; } };
struct MoeHidden { const u16* h2; const float* wgate; const float* wup; const int* ei; u16* act;
  HD long items() const { return (long)NTOK * 2 * MH; }
  HD void operator()(long it) const { const int j = (int)(it % MH); const long tk = it / MH; const long tok = tk / 2; const int e = ei[tk]; const u16* x = h2 + tok * DM;
    const float* wg_ = wgate + (long)e * DM * MH + j; const float* wu_ = wup + (long)e * DM * MH + j; float a = 0.f, b = 0.f;
    for (long d = 0; d < DM; ++d) { const float xv = bf2f(x[d]); a += xv * wg_[d * MH]; b += xv * wu_[d * MH]; }
    act[it] = f2bf(siluf_(a) * b); } };
struct MoeDown { const u16* act; const float* wdown; const int* ei; const float* ew; float* x;
  HD long items() const { return (long)NTOK * DM; }
  HD void operator()(long it) const { const int c = (int)(it % DM); const long tok = it / DM; float tot = 0.f;
    for (int k = 0; k < 2; ++k) { const int e = ei[tok * 2 + k]; const u16* a = act + (tok * 2 + k) * MH; const float* w = wdown + (long)e * MH * DM + c; float s = 0.f;
      for (int j = 0; j < MH; ++j) s += bf2f(a[j]) * w[(long)j * DM];
      tot += ew[tok * 2 + k] * s; }
    x[it] += tot; } };

#define NV2_STAGE_PREP(RUN, I, B, out)      { nv::RmsRowsBf f{I.x, I.mix_norm, B.HB, nv::DM}; RUN(f, (long)nv::NTOK); }
#define NV2_STAGE_INPROJ(RUN, I, B, out)    { nv::GemmT<nv::ABf, nv::EpInProj> f{nv::ABf{B.HB, nv::DM}, I.w_in, nv::EpInProj{B, I.dt_bias}, nv::NTOK, nv::INW, nv::DM, nv::INW}; RUN(f, f.items()); }
#define NV2_STAGE_QKNORM(RUN, I, B, out)    { nv::QkNorm f{B.QKV, I.q_gain, I.ks_gain, I.kw_gain}; RUN(f, f.items()); }
#define NV2_STAGE_COMPRESS(RUN, I, B, out)  { \
    { nv::GemmT<nv::ACmp, nv::EpSiluF32> f{nv::ACmp{B.QKV, I.pos_k, nv::O_KC}, I.w1_k, nv::EpSiluF32{B.HID, 128}, (long)nv::NB * nv::G * nv::NCMP, 128, 2048, 128}; RUN(f, f.items()); } \
    { nv::GemmT<nv::AF32, nv::EpF32> f{nv::AF32{B.HID, 128}, I.w2_k, nv::EpF32{B.KTMP, 64}, (long)nv::NB * nv::G * nv::NCMP, 64, 128, 64}; RUN(f, f.items()); } \
    { nv::CmpFinish f{B.KTMP, I.kc_gain, B.KCMP, 1}; RUN(f, f.items()); } \
    { nv::GemmT<nv::ACmp, nv::EpSiluF32> f{nv::ACmp{B.QKV, I.pos_v, nv::O_VC}, I.w1_v, nv::EpSiluF32{B.HID, 128}, (long)nv::NB * nv::G * nv::NCMP, 128, 2048, 128}; RUN(f, f.items()); } \
    { nv::GemmT<nv::AF32, nv::EpF32> f{nv::AF32{B.HID, 128}, I.w2_v, nv::EpF32{B.KTMP, 64}, (long)nv::NB * nv::G * nv::NCMP, 64, 128, 64}; RUN(f, f.items()); } \
    { nv::CmpFinish f{B.KTMP, I.kc_gain, B.VCMP, 0}; RUN(f, f.items()); } }
#define NV2_STAGE_ATTN(RUN, I, B, out)      { \
    { nv::CmpAttn f{B}; RUN(f, f.items()); } { nv::Importance f{B}; RUN(f, f.items()); } { nv::TopSel f{B}; RUN(f, f.items()); } { nv::SelAttn f{B}; RUN(f, f.items()); } { nv::WinAttn f{B}; RUN(f, f.items()); } }
#define NV2_STAGE_SSD(RUN, I, B, out)       { \
    { nv::SsdConv f{B.XBC, I.conv_w, I.conv_b}; RUN(f, f.items()); } { nv::SsdScan f{B, I.a_log, I.d_skip}; RUN(f, f.items()); } { nv::SsdOut f{B, I.ssm_norm}; RUN(f, f.items()); } }
#define NV2_STAGE_MERGE(RUN, I, B, out)     { \
    { nv::GemmT<nv::ABf, nv::EpBf> f{nv::ABf{B.YA, nv::QW}, I.w_a, nv::EpBf{B.T1, nv::DM}, nv::NTOK, nv::DM, nv::QW, nv::DM}; RUN(f, f.items()); } \
    { nv::GemmT<nv::ABf, nv::EpMerge> f{nv::ABf{B.YB, nv::SI}, I.w_b, nv::EpMerge{B.T1, B.BG, B.MERGED}, nv::NTOK, nv::DM, nv::SI, nv::DM}; RUN(f, f.items()); } \
    { nv::GemmT<nv::ABf, nv::EpResid> f{nv::ABf{B.MERGED, nv::DM}, I.w_out, nv::EpResid{I.x, out}, nv::NTOK, nv::DM, nv::DM, nv::DM}; RUN(f, f.items()); } }
#define NV2_STAGE_MOE(RUN, I, B, out)       { \
    { nv::RmsRowsBf f{out, I.moe_norm, B.H2, nv::DM}; RUN(f, (long)nv::NTOK); } \
    { nv::Router f{B.H2, I.w_group, I.b_group, I.w_expert, I.b_expert, B.EI, B.EW}; RUN(f, (long)nv::NTOK); } \
    { nv::MoeHidden f{B.H2, I.w_gate, I.w_up, B.EI, B.ACT}; RUN(f, f.items()); } \
    { nv::MoeDown f{B.ACT, I.w_down, B.EI, B.EW, out}; RUN(f, f.items()); } }
#define NV2_STAGE_PLE(RUN, I, B, out)       { \
    { nv::RmsRowsBf f{out, I.ple_norm, B.H2, nv::DM}; RUN(f, (long)nv::NTOK); } \
    { nv::GemmT<nv::AF32, nv::EpBf> f{nv::AF32{I.p, nv::PLE}, I.ple_wp, nv::EpBf{B.PP, nv::DM}, nv::NTOK, nv::DM, nv::PLE, nv::DM}; RUN(f, f.items()); } \
    { nv::GemmT<nv::ABf, nv::EpPle> f{nv::ABf{B.H2, nv::DM}, I.ple_wg, nv::EpPle{out, B.PP}, nv::NTOK, nv::DM, nv::DM, nv::DM}; RUN(f, f.items()); } }

HD size_t carve(Bufs& B, unsigned char* ws, float* out) {
  size_t off = 0; auto take = [&](size_t bytes) { unsigned char* r = ws + off; off += (bytes + 255) / 256 * 256; return r; };
  const size_t N = NTOK;
  B.BG = (u16*)out;
  unsigned char* R0 = take(N * DM * 2);
  unsigned char* R5 = take(N * 2 * MH * 2 + (size_t)NEXP * 256 * MH * 2);
  B.YA = (u16*)take(N * QW * 2);
  unsigned char* R1 = take(N * QKVW * 2);
  unsigned char* R2 = take(N * SI * 2);
  unsigned char* R3 = take(N * SCD * 2);
  B.HB = (u16*)R0; B.H2 = (u16*)R0; B.QKV = (u16*)R1; B.T1 = (u16*)R1; B.Z = (u16*)R2; B.XBC = (u16*)R3; B.MERGED = (u16*)R3; B.PP = (u16*)R3;
  B.ACT = (u16*)R5; B.YB = B.Z;
  B.NG = (float*)take(N * GW * 4); B.DT = (float*)take(N * SH * 4);
  B.KCMP = (u16*)take((size_t)NB * G * NCP * 64 * 2); B.VCMP = (u16*)take((size_t)NB * G * NCP * 64 * 2);
  B.EI = (int*)take(N * 2 * 4); B.EW = (float*)take(N * 2 * 4);
  B.HID = (float*)take((size_t)NB * G * NCMP * 128 * 4); B.KTMP = (float*)take((size_t)NB * G * NCMP * 64 * 4);
  B.ML = (float*)take(N * H * 2 * 4); B.IMP = (float*)take((size_t)NB * G * S * 64 * 4); B.MASK = (u64*)take((size_t)NB * G * S * 8);
  return off;
}
}
namespace pg8 {
#define PG8_LAS __attribute__((address_space(3)))
typedef unsigned short bf16_t;
typedef short bf16x8 __attribute__((ext_vector_type(8)));
typedef float f32x4 __attribute__((ext_vector_type(4)));
typedef unsigned u32x4 __attribute__((ext_vector_type(4)));
typedef unsigned u32x2 __attribute__((ext_vector_type(2)));
constexpr int BM = 256, BK = 64, HALF = 128, HTB = HALF * BK * 2  , STAGE_BYTES = 8 * HTB, NXCD = 8, WGM = 8;

__host__ __device__ __forceinline__ int lds_byte(int r, int c) { const int st = (r >> 4) * 2 + (c >> 5), rr = r & 15, cc = c & 31, ob = rr * 64 + cc * 2; return st * 1024 + (ob ^ (((ob >> 9) & 1) << 5)); }
__host__ __device__ __forceinline__ void stage_rc(int b, int& R, int& C) { const int st = b / 1024, sb = b % 1024, swz = sb ^ (((sb >> 9) & 1) << 5); R = (st >> 1) * 16 + swz / 64; C = (st & 1) * 32 + (swz % 64) / 2; }
__host__ __device__ __forceinline__ int perm32(int rho) { const int n = rho >> 4, i = rho & 15; return 8 * (i >> 2) + 4 * n + (i & 3); }

struct Unit { int pm, pn, aux0, aux1; };
struct Gemm { const bf16_t* A; const bf16_t* Bt; int M, N, K, lda, ldb, kstepA; };

struct StaticOrder {
    int nM, nN, nwg, G, c;
    __device__ void init(int M, int N, int G_, int c_) { nM = M / BM; nN = N / BM; nwg = nM * nN; G = G_; c = c_; }
    __device__ bool next(int i, Unit& u) const {
        const long L = (long)i * G + c; if (L >= nwg) return false;
        int wgid = (int)L; { const int q = nwg / NXCD, r = nwg % NXCD, xcd = wgid % NXCD, off = wgid / NXCD; wgid = (xcd < r ? xcd * (q + 1) : r * (q + 1) + (xcd - r) * q) + off; }
        const int nig = WGM * nN, gid = wgid / nig, fm = gid * WGM, gsz = (nM - fm) < WGM ? (nM - fm) : WGM;
        u.pm = fm + ((wgid % nig) % gsz); u.pn = (wgid % nig) / gsz; u.aux0 = 0; u.aux1 = 0; return true;
    }
    __device__ __forceinline__ const char* a_base(const Gemm& g, const Unit& u) const { return (const char*)g.A + (size_t)u.pm * BM * g.lda * 2; }
    __device__ __forceinline__ const char* b_base(const Gemm& g, const Unit& u) const { return (const char*)g.Bt + (size_t)u.pn * BM * g.ldb * 2; }
    __device__ __forceinline__ int a_row(const Unit&, int) const { return 0; }
};

typedef float f32x2_t __attribute__((ext_vector_type(2))); typedef __bf16 bf16x2_t __attribute__((ext_vector_type(2)));
__device__ __forceinline__ unsigned cvt_pk_bf16(float lo, float hi) { f32x2_t v = {lo, hi}; bf16x2_t b = __builtin_convertvector(v, bf16x2_t); return __builtin_bit_cast(unsigned, b); }


template <class Epi, class Sched, bool ALIGN_EPI = true, bool GATHER = false>
__device__ __forceinline__ void gemm_phase(PG8_LAS unsigned char* lds, const Gemm g, const Sched& S, const Epi& E) {
    int tid_ = threadIdx.x; asm volatile("" : "+v"(tid_));
    const int tid = tid_, wid = __builtin_amdgcn_readfirstlane(tid >> 6), lane = tid & 63, wr = wid >> 2, wc = wid & 3, fr = lane & 15, fq = lane >> 4;
    const int K = g.K, nt = K / BK;
    unsigned voffA[2], voffA1[2], voffB[2];
    int RA[2], CA[2];
#pragma unroll
    for (int i = 0; i < 2; ++i) { int R, C; stage_rc(tid * 16 + i * 8192, R, C); const int Rb = Epi::PERM ? ((R & ~31) + perm32(R & 31)) : R;
        RA[i] = R; CA[i] = C; voffA[i] = (unsigned)(R * g.lda + C) * 2u; voffA1[i] = voffA[i]; voffB[i] = (unsigned)(Rb * g.ldb + C) * 2u; }
    const size_t kstep = (size_t)(BK * 2);
    const size_t kstepA = (size_t)g.kstepA;
    const size_t hstepA = GATHER ? (size_t)0 : (size_t)HALF * g.lda * 2;
    const size_t hstepB = (size_t)HALF * g.ldb * 2;
    const unsigned ldsw = (unsigned)wid * 1024u;
    const int aoff = lds_byte(wr * 64 + fr, fq * 8), boff = lds_byte(wc * 32 + fr, fq * 8);
#define PG8_SA(b, h) (((b) * 2 + (h)) * HTB)
#define PG8_SB(b, h) ((4 + (b) * 2 + (h)) * HTB)
#define PG8_STAGE(bufoff, gbase, voff) do { _Pragma("unroll") for (int _i = 0; _i < 2; ++_i) \
        __builtin_amdgcn_global_load_lds((const unsigned*)((const char*)(gbase) + (voff)[_i]), (PG8_LAS unsigned*)(lds + (bufoff) + ldsw + _i * 8192), 16, 0, 0); } while (0)
#define PG8_STAGE_A0(bufoff, gbase) PG8_STAGE(bufoff, gbase, voffA)
#define PG8_STAGE_A1(bufoff, gbase) do { if constexpr (GATHER) { PG8_STAGE(bufoff, gbase, voffA1); } else { PG8_STAGE(bufoff, (gbase) + hstepA, voffA); } } while (0)
#define PG8_LDA(dst, b, h) do { _Pragma("unroll") for (int m = 0; m < 4; ++m) _Pragma("unroll") for (int k = 0; k < 2; ++k) dst[m][k] = *(const PG8_LAS bf16x8*)(lds + PG8_SA(b, h) + aoff + m * 2048 + k * 1024); } while (0)
#define PG8_LDB(dst, b, h) do { _Pragma("unroll") for (int n = 0; n < 2; ++n) _Pragma("unroll") for (int k = 0; k < 2; ++k) dst[n][k] = *(const PG8_LAS bf16x8*)(lds + PG8_SB(b, h) + boff + n * 2048 + k * 1024); } while (0)
#define PG8_MMA(ai, bj, At, Bt) do { __builtin_amdgcn_s_setprio(1); _Pragma("unroll") for (int m = 0; m < 4; ++m) _Pragma("unroll") for (int n = 0; n < 2; ++n) _Pragma("unroll") for (int k = 0; k < 2; ++k) \
        acc[ai][bj][m][n] = __builtin_amdgcn_mfma_f32_16x16x32_bf16(Bt[n][k], At[m][k], acc[ai][bj][m][n], 0, 0, 0); __builtin_amdgcn_s_setprio(0); } while (0)
#define PG8_WAIT_V(n) asm volatile("s_waitcnt vmcnt(" #n ")" ::: "memory")
#define PG8_WAIT_L(n) asm volatile("s_waitcnt lgkmcnt(" #n ")" ::: "memory")
#define PG8_BAR __builtin_amdgcn_s_barrier()
#define PG8_SCHED __builtin_amdgcn_sched_barrier(0)
    Unit cur, nxt; int ui = 0;
    if (!S.next(0, cur)) return;
    if constexpr (GATHER) {
#pragma unroll
        for (int i = 0; i < 2; ++i) { voffA[i] = (unsigned)(S.a_row(cur, RA[i]) * g.lda + CA[i]) * 2u; voffA1[i] = (unsigned)(S.a_row(cur, HALF + RA[i]) * g.lda + CA[i]) * 2u; }
    }
    f32x4 acc[2][2][4][2];
#pragma unroll
    for (int a = 0; a < 2; ++a)
#pragma unroll
        for (int b = 0; b < 2; ++b)
#pragma unroll
            for (int m = 0; m < 4; ++m)
#pragma unroll
                for (int n = 0; n < 2; ++n) acc[a][b][m][n] = (f32x4){0.f, 0.f, 0.f, 0.f};
    bf16x8 At[4][2], B0[2][2], B1[2][2];
    const char* cA = S.a_base(g, cur); const char* cB = S.b_base(g, cur);
    PG8_STAGE(PG8_SB(0, 0), cB, voffB); PG8_STAGE(PG8_SB(0, 1), cB + hstepB, voffB); PG8_STAGE_A0(PG8_SA(0, 0), cA); PG8_STAGE_A1(PG8_SA(0, 1), cA);
    if (wr == 1) PG8_BAR;
    PG8_WAIT_V(2); PG8_BAR;
    PG8_STAGE(PG8_SB(1, 0), cB + kstep, voffB); PG8_STAGE_A0(PG8_SA(1, 0), cA + kstepA); PG8_STAGE(PG8_SB(1, 1), cB + hstepB + kstep, voffB);
    PG8_WAIT_V(6); PG8_BAR;
    for (;;) {
        const bool has_next = GATHER ? false : S.next(ui + 1, nxt);
        const char* nA = has_next ? S.a_base(g, nxt) : cA; const char* nB = has_next ? S.b_base(g, nxt) : cB;
        for (int t = 0; t < nt; t += 2) {
            const bool last = (t == nt - 2);
            const char* a1 = cA + (size_t)(t + 1) * kstepA;
            const char* a2 = last ? nA : cA + (size_t)(t + 2) * kstepA; const char* b2 = last ? nB : cB + (size_t)(t + 2) * kstep;
            const char* a3 = a2 + kstepA; const char* b3 = b2 + kstep;
            PG8_LDB(B0, 0, 0); PG8_LDB(B1, 0, 1); PG8_SCHED; PG8_LDA(At, 0, 0); PG8_STAGE_A1(PG8_SA(1, 1), a1);
            PG8_WAIT_V(8); PG8_WAIT_L(0); PG8_BAR; PG8_MMA(0, 0, At, B0); PG8_MMA(0, 1, At, B1); PG8_BAR; PG8_SCHED;
            PG8_LDA(At, 0, 1); PG8_STAGE(PG8_SB(0, 0), b2, voffB); PG8_STAGE(PG8_SB(0, 1), b2 + hstepB, voffB); PG8_STAGE_A0(PG8_SA(0, 0), a2);
            PG8_WAIT_V(8); PG8_WAIT_L(0); PG8_BAR; PG8_MMA(1, 0, At, B0); PG8_MMA(1, 1, At, B1); PG8_BAR; PG8_SCHED;
            PG8_LDB(B0, 1, 0); PG8_LDB(B1, 1, 1); PG8_SCHED; PG8_LDA(At, 1, 0); PG8_STAGE_A1(PG8_SA(0, 1), a2);
            PG8_WAIT_V(8); PG8_WAIT_L(0); PG8_BAR; PG8_MMA(0, 0, At, B0); PG8_MMA(0, 1, At, B1); PG8_BAR; PG8_SCHED;
            PG8_LDA(At, 1, 1); PG8_STAGE(PG8_SB(1, 0), b3, voffB); PG8_STAGE(PG8_SB(1, 1), b3 + hstepB, voffB); PG8_STAGE_A0(PG8_SA(1, 0), a3);
            PG8_WAIT_V(8); PG8_WAIT_L(0); PG8_BAR; PG8_MMA(1, 0, At, B0); PG8_MMA(1, 1, At, B1); PG8_BAR; PG8_SCHED;
        }
        if constexpr (ALIGN_EPI) { if (wr == 0) PG8_BAR; }
        E(acc, cur, wr, wc, fr, fq);
        if (!has_next) break;
#pragma unroll
        for (int a = 0; a < 2; ++a)
#pragma unroll
            for (int b = 0; b < 2; ++b)
#pragma unroll
                for (int m = 0; m < 4; ++m)
#pragma unroll
                    for (int n = 0; n < 2; ++n) acc[a][b][m][n] = (f32x4){0.f, 0.f, 0.f, 0.f};
        cur = nxt; cA = nA; cB = nB; ++ui;
        if constexpr (ALIGN_EPI) { if (wr == 1) PG8_BAR; }
    }
    PG8_WAIT_V(0);
    if constexpr (!ALIGN_EPI) { if (wr == 0) PG8_BAR; }
    PG8_BAR;
#undef PG8_SA
#undef PG8_SB
#undef PG8_STAGE
#undef PG8_STAGE_A0
#undef PG8_STAGE_A1
#undef PG8_LDA
#undef PG8_LDB
#undef PG8_MMA
#undef PG8_WAIT_V
#undef PG8_WAIT_L
#undef PG8_BAR
#undef PG8_SCHED
}
}
namespace fx {
using nv::u16; using nv::Bufs; using nv::Inputs;
using pg8::f32x4; using pg8::u32x4; using pg8::Unit;
#define LAS __attribute__((address_space(3)))
static_assert(nv::DM == 1024 && nv::NB == 8 && nv::S == 4096 && nv::MH == 256 && nv::PLE == 256, "fast phases are written for the full-size problem");
constexpr int NTOK = nv::NTOK, DM = 1024;
constexpr int INW_PAD = 6144;
constexpr int C_Z = 1280, C_XBC = 2304, C_BG = 3840, C_NG = 5888, C_DT = 5912, C_END = 5928;

struct WBufs { u16 *WinT, *WaT, *WbT, *WoutT, *PleGT, *PlePT, *WguT, *WdT, *PB; };
__host__ __device__ inline size_t carve_w(WBufs& W, unsigned char* ws, size_t off) {
  auto take = [&](size_t bytes) { unsigned char* r = ws + off; off += (bytes + 255) / 256 * 256; return r; };
  W.WinT = (u16*)take((size_t)INW_PAD * 1024 * 2); W.WaT = (u16*)take((size_t)1024 * 512 * 2); W.WbT = (u16*)take((size_t)1024 * 1024 * 2); W.WoutT = (u16*)take((size_t)1024 * 1024 * 2);
  W.PleGT = (u16*)take((size_t)1024 * 1024 * 2); W.PlePT = (u16*)take((size_t)1024 * 256 * 2); W.WguT = (u16*)take((size_t)32 * 512 * 1024 * 2); W.WdT = (u16*)take((size_t)32 * 1024 * 256 * 2);
  W.PB = (u16*)take((size_t)NTOK * 256 * 2);
  return off;
}

__device__ __forceinline__ int otid() { int t = threadIdx.x; asm volatile("" : "+v"(t)); return t; }
__device__ __forceinline__ int obid() { int b = blockIdx.x; asm volatile("" : "+s"(b)); return b; }
__device__ __forceinline__ float fsig(float x) { return __builtin_amdgcn_rcpf(1.0f + __expf(-x)); }
__device__ __forceinline__ float fsoftplus(float x) { const float e = __expf(x); return x > 20.f ? x : (e < 0.0625f ? e * (1.f - e * (0.5f - e * (0.33333333f - 0.25f * e))) : __logf(1.0f + e)); }
__device__ __forceinline__ unsigned pk2(float lo, float hi) { return pg8::cvt_pk_bf16(lo, hi); }
__device__ __forceinline__ void store8(u16* p, const float (&v)[8]) { u32x4 w; w.x = pk2(v[0], v[1]); w.y = pk2(v[2], v[3]); w.z = pk2(v[4], v[5]); w.w = pk2(v[6], v[7]); *(u32x4*)p = w; }
__device__ __forceinline__ void load8(const u16* p, float (&v)[8]) { const u32x4 w = *(const u32x4*)p;
  v[0] = __uint_as_float(w.x << 16); v[1] = __uint_as_float(w.x & 0xffff0000u); v[2] = __uint_as_float(w.y << 16); v[3] = __uint_as_float(w.y & 0xffff0000u);
  v[4] = __uint_as_float(w.z << 16); v[5] = __uint_as_float(w.z & 0xffff0000u); v[6] = __uint_as_float(w.w << 16); v[7] = __uint_as_float(w.w & 0xffff0000u); }

__device__ __forceinline__ float wave_sum(float v) {
#pragma unroll
  for (int o = 1; o < 64; o <<= 1) v += __shfl_xor(v, o);
  return v; }
__device__ __forceinline__ void rms_row_to_bf16(const float* xrow, const float* gain, u16* orow, int lane) {
  const f32x4* xr = (const f32x4*)xrow + lane; const f32x4* gr = (const f32x4*)gain + lane;
  f32x4 v[4]; float s = 0.f;
#pragma unroll
  for (int j = 0; j < 4; ++j) { v[j] = xr[64 * j]; s += (v[j].x * v[j].x + v[j].y * v[j].y) + (v[j].z * v[j].z + v[j].w * v[j].w); }
  const float rs = 1.0f / sqrtf(wave_sum(s) * (1.f / 1024.f) + nv::EPS);
  unsigned long long* o8 = (unsigned long long*)orow + lane;
#pragma unroll
  for (int j = 0; j < 4; ++j) { const f32x4 g = gr[64 * j]; o8[64 * j] = (unsigned long long)pk2(v[j].x * rs * g.x, v[j].y * rs * g.y) | ((unsigned long long)pk2(v[j].z * rs * g.z, v[j].w * rs * g.w) << 32); }
}
__device__ __forceinline__ void phase_rms_rows(const float* x, const float* gain, u16* out) {
  const int tid = otid(), lane = tid & 63, gw = obid() * 8 + (tid >> 6), ngw = gridDim.x * 8;
  for (int r = gw; r < NTOK; r += ngw) rms_row_to_bf16(x + (size_t)r * 1024, gain, out + (size_t)r * 1024, lane);
}
template <class CP> __device__ __forceinline__ void transpose_tile(LAS float* scr, const CP cp, u16* dst, int K, int n0, int k0) {
  const int tid = otid();
  { const int nn = tid & 127; const float* p = cp(n0 + nn);
#pragma unroll
    for (int i = 0; i < 16; ++i) { const int kk = i * 4 + (tid >> 7); scr[nn * 65 + kk] = p ? p[(size_t)(k0 + kk) * cp.ld] : 0.f; } }
  __syncthreads();
#pragma unroll
  for (int h = 0; h < 2; ++h) { const int it = tid + h * 512, nn = it >> 3, kc = it & 7; const LAS float* s = scr + nn * 65 + kc * 8;
    u32x4 o; o.x = pk2(s[0], s[1]); o.y = pk2(s[2], s[3]); o.z = pk2(s[4], s[5]); o.w = pk2(s[6], s[7]);
    *(u32x4*)(dst + (size_t)(n0 + nn) * K + k0 + kc * 8) = o; }
  __syncthreads();
}
struct CpIdent { const float* src; int ld; __device__ const float* operator()(int n) const { return src + n; } };
struct CpInProj { const float* src; int ld; __device__ const float* operator()(int n) const {
  int c; if (n < C_Z) c = n; else if (n < C_XBC) c = nv::O_Z + (n - C_Z); else if (n < C_BG) c = nv::O_XBC + (n - C_XBC); else if (n < C_NG) c = nv::O_BG + (n - C_BG); else if (n < C_DT) c = nv::O_NG + (n - C_NG); else if (n < C_END) c = nv::O_DT + (n - C_DT); else return nullptr;
  return src + c; } };
struct CpGU { const float* gate; long updelta; int ld; __device__ const float* operator()(int n) const { const int tile = n >> 8, r = n & 255; return gate + (r < 128 ? 0L : updelta) + tile * 128 + (r & 127); } };

__device__ __forceinline__ void phase_prologue(LAS unsigned char* lds, const Inputs& I, const Bufs& B, const WBufs& W) {
  LAS float* scr = (LAS float*)lds;
  constexpr int T_IN = (INW_PAD / 128) * 16, T_A = 8 * 8, T_B = 8 * 16, T_O = 8 * 16, T_PG = 8 * 16, T_PP = 8 * 4, T_GU = 32 * 4 * 16, T_D = 32 * 8 * 4;
  constexpr int TOT = T_IN + T_A + T_B + T_O + T_PG + T_PP + T_GU + T_D;
  for (int t = blockIdx.x; t < TOT; t += gridDim.x) { int r = t;
    if (r < T_IN) { CpInProj cp{I.w_in, nv::INW}; transpose_tile(scr, cp, W.WinT, 1024, (r / 16) * 128, (r % 16) * 64); continue; } r -= T_IN;
    if (r < T_A) { CpIdent cp{I.w_a, 1024}; transpose_tile(scr, cp, W.WaT, 512, (r / 8) * 128, (r % 8) * 64); continue; } r -= T_A;
    if (r < T_B) { CpIdent cp{I.w_b, 1024}; transpose_tile(scr, cp, W.WbT, 1024, (r / 16) * 128, (r % 16) * 64); continue; } r -= T_B;
    if (r < T_O) { CpIdent cp{I.w_out, 1024}; transpose_tile(scr, cp, W.WoutT, 1024, (r / 16) * 128, (r % 16) * 64); continue; } r -= T_O;
    if (r < T_PG) { CpIdent cp{I.ple_wg, 1024}; transpose_tile(scr, cp, W.PleGT, 1024, (r / 16) * 128, (r % 16) * 64); continue; } r -= T_PG;
    if (r < T_PP) { CpIdent cp{I.ple_wp, 1024}; transpose_tile(scr, cp, W.PlePT, 256, (r / 4) * 128, (r % 4) * 64); continue; } r -= T_PP;
    if (r < T_GU) { const int e = r / 64, q = r % 64; CpGU cp{I.w_gate + (size_t)e * 1024 * 256, (long)(I.w_up - I.w_gate), 256}; transpose_tile(scr, cp, W.WguT + (size_t)e * 512 * 1024, 1024, (q / 16) * 128, (q % 16) * 64); continue; } r -= T_GU;
    { const int e = r / 32, q = r % 32; CpIdent cp{I.w_down + (size_t)e * 256 * 1024, 1024}; transpose_tile(scr, cp, W.WdT + (size_t)e * 1024 * 256, 256, (q / 4) * 128, (q % 4) * 64); }
  }
  phase_rms_rows(I.x, I.mix_norm, B.HB);
  for (long i = blockIdx.x * 512L + otid(); i < (long)NTOK * 256 / 8; i += (long)gridDim.x * 512L) { const f32x4 a = ((const f32x4*)I.p)[2 * i], b = ((const f32x4*)I.p)[2 * i + 1];
    u32x4 o; o.x = pk2(a.x, a.y); o.y = pk2(a.z, a.w); o.z = pk2(b.x, b.y); o.w = pk2(b.z, b.w); ((u32x4*)W.PB)[i] = o; }
}

template <class F> struct Epi8 { static constexpr bool PERM = true; F f;
  __device__ __forceinline__ void operator()(const f32x4 (&acc)[2][2][4][2], const Unit& u, int wr, int wc, int fr, int fq) const {
#pragma unroll
    for (int ai = 0; ai < 2; ++ai)
#pragma unroll
      for (int m = 0; m < 4; ++m) { const int row = u.pm * 256 + ai * 128 + wr * 64 + m * 16 + fr;
#pragma unroll
        for (int bj = 0; bj < 2; ++bj) { const int col = u.pn * 256 + bj * 128 + wc * 32 + 8 * fq; const f32x4 a = acc[ai][bj][m][0], b = acc[ai][bj][m][1];
          const float v[8] = {a.x, a.y, a.z, a.w, b.x, b.y, b.z, b.w}; f(u, row, col, v); }
        if (m & 1) asm volatile("" ::: "memory"); } } };

struct FInProj { u16* QKV; u16* Z; u16* XBC; u16* BG; float* NG; float* DT; const float* dt_bias;
  __device__ __forceinline__ void operator()(const Unit&, int r, int c, const float (&v)[8]) const {
    if (c < C_Z) store8(QKV + (size_t)r * 1280 + c, v);
    else if (c < C_XBC) store8(Z + (size_t)r * 1024 + (c - C_Z), v);
    else if (c < C_BG) store8(XBC + (size_t)r * 1536 + (c - C_XBC), v);
    else if (c < C_NG) { float s[8];
#pragma unroll
      for (int i = 0; i < 8; ++i) s[i] = fsig(v[i]);
      store8(BG + (size_t)r * 2048 + (c - C_BG), s); }
    else if (c < C_DT) { float* o = NG + (size_t)r * 24 + (c - C_NG);
#pragma unroll
      for (int i = 0; i < 8; ++i) o[i] = fsig(v[i]); }
    else if (c < C_END) { float* o = DT + (size_t)r * 16 + (c - C_DT); const float* bi = dt_bias + (c - C_DT);
#pragma unroll
      for (int i = 0; i < 8; ++i) o[i] = fsoftplus(v[i] + bi[i]); } } };
struct FStoreBf { u16* o; int ld; __device__ __forceinline__ void operator()(const Unit&, int r, int c, const float (&v)[8]) const { store8(o + (size_t)r * ld + c, v); } };
struct FMerge { const u16* t1; const u16* bg; u16* o;
  __device__ __forceinline__ void operator()(const Unit&, int r, int c, const float (&v)[8]) const { float t[8], ga[8], gb[8], m[8]; load8(t1 + (size_t)r * 1024 + c, t); load8(bg + (size_t)r * 2048 + c, ga); load8(bg + (size_t)r * 2048 + 1024 + c, gb);
#pragma unroll
    for (int i = 0; i < 8; ++i) m[i] = ga[i] * t[i] + gb[i] * v[i];
    store8(o + (size_t)r * 1024 + c, m); } };
struct FResid { const float* x; float* o;
  __device__ __forceinline__ void operator()(const Unit&, int r, int c, const float (&v)[8]) const { const f32x4 a = *(const f32x4*)(x + (size_t)r * 1024 + c), b = *(const f32x4*)(x + (size_t)r * 1024 + c + 4);
    *(f32x4*)(o + (size_t)r * 1024 + c) = (f32x4){a.x + v[0], a.y + v[1], a.z + v[2], a.w + v[3]}; *(f32x4*)(o + (size_t)r * 1024 + c + 4) = (f32x4){b.x + v[4], b.y + v[5], b.z + v[6], b.w + v[7]}; } };
struct FPle { float* x; const u16* pp;
  __device__ __forceinline__ void operator()(const Unit&, int r, int c, const float (&v)[8]) const { float p[8]; load8(pp + (size_t)r * 1024 + c, p); float* xp = x + (size_t)r * 1024 + c; const f32x4 a = *(const f32x4*)xp, b = *(const f32x4*)(xp + 4);
    *(f32x4*)xp = (f32x4){a.x + fsig(v[0]) * p[0], a.y + fsig(v[1]) * p[1], a.z + fsig(v[2]) * p[2], a.w + fsig(v[3]) * p[3]};
    *(f32x4*)(xp + 4) = (f32x4){b.x + fsig(v[4]) * p[4], b.y + fsig(v[5]) * p[5], b.z + fsig(v[6]) * p[6], b.w + fsig(v[7]) * p[7]}; } };

template <class F> __device__ __forceinline__ void dense_gemm(LAS unsigned char* lds, const u16* A, int lda, const u16* Bt, int ldb, int M, int N, int K, const F& f) {
  pg8::Gemm g{A, Bt, M, N, K, lda, ldb, 128}; pg8::StaticOrder S; S.init(M, N, (int)gridDim.x, (int)blockIdx.x); Epi8<F> E{f};
  pg8::gemm_phase<Epi8<F>, pg8::StaticOrder, true, false>(lds, g, S, E);
}
}
namespace fx {
constexpr int LIST_CAP = 32768;
constexpr int LDS_TAB = 131072;
struct MoeBufs { float* LOGITS; int* CNT; int* LIST; u16* MOEOUT; u16* WrT; };
__host__ __device__ inline size_t carve_moe(MoeBufs& M, const Bufs& B, unsigned char* ws, size_t off) {
  auto take = [&](size_t bytes) { unsigned char* r = ws + off; off += (bytes + 255) / 256 * 256; return r; };
  M.LOGITS = (float*)take((size_t)NTOK * 64 * 4); M.CNT = (int*)take(256); M.LIST = (int*)take((size_t)32 * LIST_CAP * 4); M.WrT = (u16*)take((size_t)256 * 1024 * 2);
  M.MOEOUT = B.QKV;
  return off;
}
__device__ __forceinline__ void prologue_moe(const Inputs& I, const MoeBufs& M) {
  for (long i = blockIdx.x * 512L + otid(); i < 256L * 1024; i += (long)gridDim.x * 512L) { const int n = (int)(i >> 10), k = (int)(i & 1023);
    float v = 0.f; if (n < 4) v = I.w_group[k * 4 + n]; else if (n < 36) v = I.w_expert[k * 32 + (n - 4)];
    M.WrT[i] = nv::f2bf(v); }
  if (blockIdx.x == 0 && threadIdx.x < 64) M.CNT[threadIdx.x] = 0;
}
struct FLogits { float* o; __device__ __forceinline__ void operator()(const Unit&, int r, int c, const float (&v)[8]) const { if (c < 40) { *(f32x4*)(o + (size_t)r * 64 + c) = (f32x4){v[0], v[1], v[2], v[3]}; *(f32x4*)(o + (size_t)r * 64 + c + 4) = (f32x4){v[4], v[5], v[6], v[7]}; } } };
__device__ __forceinline__ void phase_route(const Inputs& I, const Bufs& B, const MoeBufs& M) {
  for (int tok = blockIdx.x * 512 + otid(); tok < NTOK; tok += gridDim.x * 512) { const float* lg = M.LOGITS + (size_t)tok * 64;
    const f32x4 g4 = *(const f32x4*)lg; const float g0 = g4.x + I.b_group[0], g1 = g4.y + I.b_group[1], g2 = g4.z + I.b_group[2], g3 = g4.w + I.b_group[3];
    int gi = 0; float gm = g0; if (g1 > gm) { gm = g1; gi = 1; } if (g2 > gm) { gm = g2; gi = 2; } if (g3 > gm) { gm = g3; gi = 3; }
    const float grp_w = 1.0f / (expf(g0 - gm) + expf(g1 - gm) + expf(g2 - gm) + expf(g3 - gm));
    const f32x4 ea = *(const f32x4*)(lg + 4 + gi * 8), eb = *(const f32x4*)(lg + 8 + gi * 8); const f32x4 ba = *(const f32x4*)(I.b_expert + gi * 8), bb = *(const f32x4*)(I.b_expert + gi * 8 + 4);
    const float el[8] = {ea.x + ba.x, ea.y + ba.y, ea.z + ba.z, ea.w + ba.w, eb.x + bb.x, eb.y + bb.y, eb.z + bb.z, eb.w + bb.w};
    int i0 = 0; float m0 = el[0];
#pragma unroll
    for (int j = 1; j < 8; ++j) if (el[j] > m0) { m0 = el[j]; i0 = j; }
    int i1 = -1; float m1 = -3.0e38f;
#pragma unroll
    for (int j = 0; j < 8; ++j) if (j != i0 && el[j] > m1) { m1 = el[j]; i1 = j; }
    const float r = expf(m1 - m0); const float w0 = grp_w / (1.0f + r), w1 = grp_w * r / (1.0f + r);
    const int e0 = gi * 8 + i0, e1 = gi * 8 + i1;
    const int p0 = atomicAdd(&M.CNT[e0], 1), p1 = atomicAdd(&M.CNT[e1], 1);
    M.LIST[e0 * LIST_CAP + p0] = tok * 2; M.LIST[e1 * LIST_CAP + p1] = tok * 2 + 1; B.EW[tok * 2] = w0; B.EW[tok * 2 + 1] = w1; }
}
__device__ __forceinline__ void build_tile_table(LAS unsigned char* lds, const MoeBufs& M) {
  LAS int* tab = (LAS int*)(lds + LDS_TAB);
  if (threadIdx.x == 0) { int acc = 0; for (int e = 0; e < 32; ++e) { tab[e] = acc; acc += (M.CNT[e] + 255) >> 8; } tab[32] = acc; }
  __syncthreads();
}
__device__ __forceinline__ int tile_expert(const LAS int* tab, int tile) { int e = 0;
#pragma unroll 1
  for (int j = 1; j < 32; ++j) if (tab[j] <= tile) e = j;
  return e; }

struct SchedGU { const int* list; int tile, ct, lbase, nvalid, e;
  __device__ bool next(int i, Unit& u) const { if (i > 0) return false; u.pm = tile; u.pn = ct; u.aux0 = lbase; u.aux1 = nvalid; return true; }
  __device__ __forceinline__ const char* a_base(const pg8::Gemm& g, const Unit&) const { return (const char*)g.A; }
  __device__ __forceinline__ const char* b_base(const pg8::Gemm& g, const Unit&) const { return (const char*)g.Bt + ((size_t)e * 512 + (size_t)ct * 256) * 1024 * 2; }
  __device__ __forceinline__ int a_row(const Unit&, int r) const { return r < nvalid ? (list[lbase + r] >> 1) : 0; } };
struct EpiGU { static constexpr bool PERM = true; u16* act;
  __device__ __forceinline__ void operator()(const f32x4 (&acc)[2][2][4][2], const Unit& u, int wr, int wc, int fr, int fq) const {
#pragma unroll
    for (int ai = 0; ai < 2; ++ai)
#pragma unroll
      for (int m = 0; m < 4; ++m) { const int r = ai * 128 + wr * 64 + m * 16 + fr; const f32x4 g0 = acc[ai][0][m][0], g1 = acc[ai][0][m][1], u0 = acc[ai][1][m][0], u1 = acc[ai][1][m][1];
        const float a[8] = {g0.x * fsig(g0.x) * u0.x, g0.y * fsig(g0.y) * u0.y, g0.z * fsig(g0.z) * u0.z, g0.w * fsig(g0.w) * u0.w, g1.x * fsig(g1.x) * u1.x, g1.y * fsig(g1.y) * u1.y, g1.z * fsig(g1.z) * u1.z, g1.w * fsig(g1.w) * u1.w};
        store8(act + ((size_t)u.pm * 256 + r) * 256 + u.pn * 128 + wc * 32 + 8 * fq, a); } } };
__device__ __forceinline__ void phase_moe_gu(LAS unsigned char* lds, const Bufs& B, const WBufs& W, const MoeBufs& M) {
  const LAS int* tab = (const LAS int*)(lds + LDS_TAB); const int T = tab[32];
  for (int L = blockIdx.x; L < T * 2; L += gridDim.x) { const int tile = L >> 1, ct = L & 1, e = __builtin_amdgcn_readfirstlane(tile_expert(tab, tile)), rt = tile - __builtin_amdgcn_readfirstlane(tab[e]); int nvalid = __builtin_amdgcn_readfirstlane(M.CNT[e]) - rt * 256; nvalid = nvalid > 256 ? 256 : nvalid;
    pg8::Gemm g{B.H2, W.WguT, 256, 256, 1024, 1024, 1024, 128}; SchedGU S{M.LIST, tile, ct, e * LIST_CAP + rt * 256, nvalid, e}; EpiGU E{B.ACT};
    pg8::gemm_phase<EpiGU, SchedGU, true, true>(lds, g, S, E); }
}
struct SchedD { const LAS int* tab; const int* cnt; int T4, G, c;
  __device__ bool next(int i, Unit& u) const { const int L = i * G + c; if (L >= T4) return false; const int tile = L >> 2, e = __builtin_amdgcn_readfirstlane(tile_expert(tab, tile)), rt = tile - __builtin_amdgcn_readfirstlane(tab[e]); int nvalid = __builtin_amdgcn_readfirstlane(cnt[e]) - rt * 256; nvalid = nvalid > 256 ? 256 : nvalid;
    u.pm = tile; u.pn = L & 3; u.aux0 = e * LIST_CAP + rt * 256; u.aux1 = nvalid; return true; }
  __device__ __forceinline__ const char* a_base(const pg8::Gemm& g, const Unit& u) const { return (const char*)g.A + (size_t)u.pm * 256 * 256 * 2; }
  __device__ __forceinline__ const char* b_base(const pg8::Gemm& g, const Unit& u) const { return (const char*)g.Bt + ((size_t)(u.aux0 >> 15) * 1024 + (size_t)u.pn * 256) * 256 * 2; }
  __device__ __forceinline__ int a_row(const Unit&, int) const { return 0; } };
struct FDown { const int* list; const float* ew; u16* o;
  __device__ __forceinline__ void operator()(const Unit& u, int row, int c, const float (&v)[8]) const { const int r = row - u.pm * 256; if (r < u.aux1) { const int asg = list[u.aux0 + r]; const float w = ew[asg];
      const float y[8] = {v[0] * w, v[1] * w, v[2] * w, v[3] * w, v[4] * w, v[5] * w, v[6] * w, v[7] * w}; store8(o + (size_t)asg * 1024 + c, y); } } };
__device__ __forceinline__ void phase_moe_down(LAS unsigned char* lds, const Bufs& B, const WBufs& W, const MoeBufs& M) {
  const LAS int* tab = (const LAS int*)(lds + LDS_TAB);
  pg8::Gemm g{B.ACT, W.WdT, 256, 1024, 256, 256, 256, 128}; SchedD S{tab, M.CNT, tab[32] * 4, (int)gridDim.x, (int)blockIdx.x}; Epi8<FDown> E{FDown{M.LIST, B.EW, M.MOEOUT}};
  pg8::gemm_phase<Epi8<FDown>, SchedD, true, false>(lds, g, S, E);
}
__device__ __forceinline__ void phase_moe_combine(float* out, const u16* moeout, const float* gain, u16* hout) {
  const int tid = otid(), lane = tid & 63, gw = obid() * 8 + (tid >> 6), ngw = gridDim.x * 8;
  for (int tok = gw; tok < NTOK; tok += ngw) { f32x4* xr = (f32x4*)(out + (size_t)tok * 1024) + lane; const pg8::u32x2* o0 = (const pg8::u32x2*)(moeout + (size_t)tok * 2048) + lane; const pg8::u32x2* o1 = o0 + 256;
    const f32x4* gr = (const f32x4*)gain + lane; f32x4 v[4]; float s = 0.f;
#pragma unroll
    for (int j = 0; j < 4; ++j) { const f32x4 x = xr[64 * j]; const pg8::u32x2 a = o0[64 * j], b = o1[64 * j];
      v[j].x = x.x + __uint_as_float(a.x << 16) + __uint_as_float(b.x << 16); v[j].y = x.y + __uint_as_float(a.x & 0xffff0000u) + __uint_as_float(b.x & 0xffff0000u);
      v[j].z = x.z + __uint_as_float(a.y << 16) + __uint_as_float(b.y << 16); v[j].w = x.w + __uint_as_float(a.y & 0xffff0000u) + __uint_as_float(b.y & 0xffff0000u);
      xr[64 * j] = v[j]; s += (v[j].x * v[j].x + v[j].y * v[j].y) + (v[j].z * v[j].z + v[j].w * v[j].w); }
    const float rs = 1.0f / sqrtf(wave_sum(s) * (1.f / 1024.f) + nv::EPS);
    unsigned long long* o8 = (unsigned long long*)(hout + (size_t)tok * 1024) + lane;
#pragma unroll
    for (int j = 0; j < 4; ++j) { const f32x4 g = gr[64 * j]; o8[64 * j] = (unsigned long long)pk2(v[j].x * rs * g.x, v[j].y * rs * g.y) | ((unsigned long long)pk2(v[j].z * rs * g.z, v[j].w * rs * g.w) << 32); } }
}
}
namespace fa {
using nv::u16; using nv::Bufs;
typedef short bf16x8 __attribute__((ext_vector_type(8)));
typedef short s16x4 __attribute__((ext_vector_type(4)));
typedef float f32x16 __attribute__((ext_vector_type(16)));
typedef unsigned u32x4 __attribute__((ext_vector_type(4)));
constexpr float C2 = 0.125f * 1.4426950408889634f;
constexpr int S = nv::S, QKVW = 1280;
constexpr int L_K = 0, L_V = 16384, L_WSF = 32768, L_IMP = 34816, L_MASK = L_IMP + 65536, L_OST = L_MASK + 512, L_END = L_OST + 32768;
static_assert(L_END <= 147456, "attention LDS map");

__device__ __forceinline__ int crow(int r, int hi) { return (r & 3) + 8 * (r >> 2) + 4 * hi; }
__device__ __forceinline__ float ex2(float x) { return __builtin_amdgcn_exp2f(x); }
__device__ __forceinline__ float swap_add(float v) { auto rr = __builtin_amdgcn_permlane32_swap(__float_as_uint(v), __float_as_uint(v), false, false); return __uint_as_float(rr[0]) + __uint_as_float(rr[1]); }
__device__ __forceinline__ float swap_max(float v) { auto rr = __builtin_amdgcn_permlane32_swap(__float_as_uint(v), __float_as_uint(v), false, false); return __builtin_fmaxf(__uint_as_float(rr[0]), __uint_as_float(rr[1])); }

__device__ __forceinline__ void phase_qknorm(const nv::Inputs& I, const Bufs& B) {
  for (int it = blockIdx.x * 512 + fx::otid(); it < nv::NTOK * 12; it += gridDim.x * 512) { const int tok = it / 12, w = it % 12; u16* v; const float* gain; float sc = 1.f;
    if (w < 8) { v = B.QKV + (size_t)tok * QKVW + nv::O_Q + w * 64; gain = I.q_gain; sc = C2; } else if (w < 10) { v = B.QKV + (size_t)tok * QKVW + nv::O_KS + (w - 8) * 64; gain = I.ks_gain; } else { v = B.QKV + (size_t)tok * QKVW + nv::O_KW + (w - 10) * 64; gain = I.kw_gain; }
    float x[8][8]; float s = 0.f;
#pragma unroll
    for (int c = 0; c < 8; ++c) { fx::load8(v + c * 8, x[c]);
#pragma unroll
      for (int j = 0; j < 8; ++j) s += x[c][j] * x[c][j]; }
    const float rs = sc / sqrtf(s * (1.f / 64.f) + nv::EPS);
#pragma unroll
    for (int c = 0; c < 8; ++c) { float y[8];
#pragma unroll
      for (int j = 0; j < 8; ++j) y[j] = x[c][j] * rs * gain[c * 8 + j];
      fx::store8(v + c * 8, y); } }
}

__device__ __forceinline__ void stage_kv(LAS unsigned char* lds, int slot, const u16* kbase, const u16* vbase, int stride, int wid, int lane, bool withV) {
  const u16* ksrc = kbase + (size_t)lane * stride + wid * 8;
  __builtin_amdgcn_global_load_lds((const unsigned*)ksrc, (LAS unsigned*)(lds + L_K + slot * 8192 + wid * 1024), 16, 0, 0);
  if (withV) { const u16* vsrc = vbase + (size_t)(16 * (wid & 3) + (lane >> 2)) * stride + (wid >> 2) * 32 + (lane & 3) * 8;
    __builtin_amdgcn_global_load_lds((const unsigned*)vsrc, (LAS unsigned*)(lds + L_V + slot * 8192 + wid * 1024), 16, 0, 0); }
}
__device__ __forceinline__ void qkt(f32x16& p0, f32x16& p1, const LAS unsigned char* Kslot, const bf16x8 (&qr)[4], int r32, int hi) {
  const LAS unsigned char* kb = Kslot + hi * 1024 + r32 * 16; f32x16 z;
#pragma unroll
  for (int r = 0; r < 16; ++r) z[r] = 0.f;
  p0 = z; p1 = z;
#pragma unroll
  for (int d0 = 0; d0 < 4; ++d0) { const bf16x8 b0 = *(const LAS bf16x8*)(kb + d0 * 2048), b1 = *(const LAS bf16x8*)(kb + d0 * 2048 + 512);
    p0 = __builtin_amdgcn_mfma_f32_32x32x16_bf16(b0, qr[d0], p0, 0, 0, 0); p1 = __builtin_amdgcn_mfma_f32_32x32x16_bf16(b1, qr[d0], p1, 0, 0, 0); }
}
__device__ __forceinline__ void pv(f32x16 (&o)[2], int vb, bf16x8 pa0, bf16x8 pa1, bf16x8 pa2, bf16x8 pa3) {
#pragma unroll
  for (int d0 = 0; d0 < 2; ++d0) { s16x4 lo[4], hi[4];
#pragma unroll
    for (int ks = 0; ks < 4; ++ks) {
      asm volatile("ds_read_b64_tr_b16 %0,%1 offset:%c2" : "=&v"(lo[ks]) : "v"(vb), "i"(d0 * 4096 + ks * 1024) : "memory");
      asm volatile("ds_read_b64_tr_b16 %0,%1 offset:%c2" : "=&v"(hi[ks]) : "v"(vb), "i"(d0 * 4096 + ks * 1024 + 512) : "memory"); }
    asm volatile("s_waitcnt lgkmcnt(0)" ::: "memory"); __builtin_amdgcn_sched_barrier(0);
#define FA_PK(k) (bf16x8){lo[k][0], lo[k][1], lo[k][2], lo[k][3], hi[k][0], hi[k][1], hi[k][2], hi[k][3]}
    o[d0] = __builtin_amdgcn_mfma_f32_32x32x16_bf16(pa0, FA_PK(0), o[d0], 0, 0, 0);
    o[d0] = __builtin_amdgcn_mfma_f32_32x32x16_bf16(pa1, FA_PK(1), o[d0], 0, 0, 0);
    o[d0] = __builtin_amdgcn_mfma_f32_32x32x16_bf16(pa2, FA_PK(2), o[d0], 0, 0, 0);
    o[d0] = __builtin_amdgcn_mfma_f32_32x32x16_bf16(pa3, FA_PK(3), o[d0], 0, 0, 0);
#undef FA_PK
  }
}
struct SmState { float m, l; f32x16 o[2]; };
__device__ __forceinline__ void sm_reset(SmState& st) { st.m = -INFINITY; st.l = 0.f;
#pragma unroll
  for (int r = 0; r < 16; ++r) { st.o[0][r] = 0.f; st.o[1][r] = 0.f; } }
__device__ __forceinline__ void mask_range(f32x16& p0, f32x16& p1, int klo, int khi, int hi) {
  if (__all(klo <= 0 && khi >= 63)) return;
#pragma unroll
  for (int r = 0; r < 16; ++r) { const int k0 = crow(r, hi), k1 = k0 + 32; if (k0 < klo || k0 > khi) p0[r] = -INFINITY; if (k1 < klo || k1 > khi) p1[r] = -INFINITY; }
}
__device__ __forceinline__ void tile_step(SmState& st, LAS unsigned char* lds, int slot, const bf16x8 (&qr)[4], LAS float* wsf, int r32, int hi, int vb0, int klo, int khi) {
  f32x16 p0, p1; qkt(p0, p1, lds + L_K + slot * 8192, qr, r32, hi);
  mask_range(p0, p1, klo, khi, hi);
  float rm = p0[0];
#pragma unroll
  for (int r = 1; r < 16; ++r) rm = __builtin_fmaxf(rm, p0[r]);
#pragma unroll
  for (int r = 0; r < 16; ++r) rm = __builtin_fmaxf(rm, p1[r]);
  rm = swap_max(rm);
  const float mn = __builtin_fmaxf(st.m, rm), ms = __builtin_fmaxf(mn, -1.0e30f);
  const float f = ex2(st.m - ms);
  if (__any(mn > st.m)) { if (hi == 0) wsf[r32] = f;
#pragma unroll
    for (int r = 0; r < 16; ++r) { const float fr = wsf[crow(r, hi)]; st.o[0][r] *= fr; st.o[1][r] *= fr; } }
  st.m = mn;
  float rs = 0.f;
#pragma unroll
  for (int r = 0; r < 16; ++r) { p0[r] = ex2(p0[r] - ms); p1[r] = ex2(p1[r] - ms); rs += p0[r] + p1[r]; }
  st.l = st.l * f + rs;
  u32x4 w0, w1, w2, w3;
  w0.x = pg8::cvt_pk_bf16(p0[0], p0[1]); w0.y = pg8::cvt_pk_bf16(p0[2], p0[3]); w0.z = pg8::cvt_pk_bf16(p0[4], p0[5]); w0.w = pg8::cvt_pk_bf16(p0[6], p0[7]);
  w1.x = pg8::cvt_pk_bf16(p0[8], p0[9]); w1.y = pg8::cvt_pk_bf16(p0[10], p0[11]); w1.z = pg8::cvt_pk_bf16(p0[12], p0[13]); w1.w = pg8::cvt_pk_bf16(p0[14], p0[15]);
  w2.x = pg8::cvt_pk_bf16(p1[0], p1[1]); w2.y = pg8::cvt_pk_bf16(p1[2], p1[3]); w2.z = pg8::cvt_pk_bf16(p1[4], p1[5]); w2.w = pg8::cvt_pk_bf16(p1[6], p1[7]);
  w3.x = pg8::cvt_pk_bf16(p1[8], p1[9]); w3.y = pg8::cvt_pk_bf16(p1[10], p1[11]); w3.z = pg8::cvt_pk_bf16(p1[12], p1[13]); w3.w = pg8::cvt_pk_bf16(p1[14], p1[15]);
  pv(st.o, vb0 + L_V + slot * 8192, __builtin_bit_cast(bf16x8, w0), __builtin_bit_cast(bf16x8, w1), __builtin_bit_cast(bf16x8, w2), __builtin_bit_cast(bf16x8, w3));
}
__device__ __forceinline__ void finalize(SmState& st, float gate, f32x16 (&outacc)[2], LAS float* wsf, int r32, int hi, float& msafe, float& invl) {
  const float lt = swap_add(st.l); invl = lt > 0.f ? 1.0f / lt : 0.f; msafe = __builtin_fmaxf(st.m, -1.0e30f);
  if (hi == 0) wsf[r32] = gate * invl;
#pragma unroll
  for (int r = 0; r < 16; ++r) { const float fr = wsf[crow(r, hi)]; outacc[0][r] += st.o[0][r] * fr; outacc[1][r] += st.o[1][r] * fr; }
}
__device__ __forceinline__ void imp_step(LAS unsigned char* lds, int slot, const bf16x8 (&qr)[4], int r32, int hi, int khi, float msafe, float invl, LAS float* imph  , int tq, int T) {
  f32x16 p0, p1; qkt(p0, p1, lds + L_K + slot * 8192, qr, r32, hi);
  mask_range(p0, p1, 0, khi, hi);
#pragma unroll
  for (int r = 0; r < 16; ++r) { p0[r] = ex2(p0[r] - msafe) * invl; p1[r] = ex2(p1[r] - msafe) * invl; }
  LAS float* row = imph + tq * 64 + 16 * T + hi;
#pragma unroll
  for (int gq = 0; gq < 4; ++gq) { row[2 * gq] += (p0[4 * gq] + p0[4 * gq + 1]) + (p0[4 * gq + 2] + p0[4 * gq + 3]); row[2 * gq + 8] += (p1[4 * gq] + p1[4 * gq + 1]) + (p1[4 * gq + 2] + p1[4 * gq + 3]); }
  asm volatile("s_waitcnt lgkmcnt(0)" ::: "memory");
#pragma unroll
  for (int gq = 0; gq < 4; ++gq) { row[2 * gq + 1] += p0[4 * gq + 3]; if (16 * T + hi + 2 * gq + 9 < 64) row[2 * gq + 9] += p1[4 * gq + 3]; }
  asm volatile("s_waitcnt lgkmcnt(0)" ::: "memory");
}
__device__ __forceinline__ void topk_select(LAS unsigned char* lds, int wid, int lane, int i) {
  LAS float* IM = (LAS float*)(lds + L_IMP); LAS unsigned long long* MK = (LAS unsigned long long*)(lds + L_MASK);
  const int j = lane; const int nforced = i == 0 ? 1 : (i == 1 ? 2 : 3);
  const bool forced = (j <= i) && (j == 0 || j == i || j == i - 1); const bool cand = (j >= 1) && (j <= i - 2);
  for (int tq = wid; tq < 64; tq += 8) {
    const float v = (IM[tq * 64 + j] + IM[4096 + tq * 64 + j]) + (IM[8192 + tq * 64 + j] + IM[12288 + tq * 64 + j]);
    IM[tq * 64 + j] = v;
    asm volatile("s_waitcnt lgkmcnt(0)" ::: "memory");
    int cnt = 0;
    for (int jj = 1; jj <= i - 2; ++jj) { const float vv = IM[tq * 64 + jj]; cnt += (vv > v || (vv == v && jj < j)) ? 1 : 0; }
    const bool sel = forced || (cand && cnt < 16 - nforced);
    const unsigned long long mk = __ballot(sel);
    if (lane == 0) MK[tq] = mk;
  }
}

__device__ __forceinline__ void attn_unit(LAS unsigned char* lds, const Bufs& B, int b, int g, int i) {
  const int tid = fx::otid(), lane = tid & 63, wid = __builtin_amdgcn_readfirstlane(tid >> 6), r32 = lane & 31, hi = lane >> 5;
  const int e = wid >> 1, h = g * 4 + e, tq = 32 * (wid & 1) + r32; const size_t tok = (size_t)b * S + 64 * i + tq; const int t = 64 * i + tq;
  LAS float* wsf = (LAS float*)(lds + L_WSF) + wid * 64;
  LAS float* imph = (LAS float*)(lds + L_IMP) + e * 4096;
  const int vb0 = (int)(unsigned)(size_t)lds + ((lane >> 4) & 1) * 32 + (lane & 3) * 8 + (4 * hi + ((lane & 15) >> 2)) * 64;
  bf16x8 qr[4];
#pragma unroll
  for (int d0 = 0; d0 < 4; ++d0) qr[d0] = *(const bf16x8*)(B.QKV + tok * QKVW + h * 64 + d0 * 16 + hi * 8);
  const float g0 = B.NG[tok * 24 + h * 3 + 0], g1 = B.NG[tok * 24 + h * 3 + 1], g2 = B.NG[tok * 24 + h * 3 + 2];
  const u16* kc = B.KCMP + (size_t)(b * 2 + g) * 256 * 64; const u16* vc = B.VCMP + (size_t)(b * 2 + g) * 256 * 64;
  const u16* ksb = B.QKV + (size_t)b * S * QKVW + nv::O_KS + g * 64; const u16* vsb = B.QKV + (size_t)b * S * QKVW + nv::O_VS + g * 64;
  const u16* kwb = B.QKV + (size_t)b * S * QKVW + nv::O_KW + g * 64; const u16* vwb = B.QKV + (size_t)b * S * QKVW + nv::O_VW + g * 64;
  int nvis = t >= 31 ? (t - 31) / 16 + 1 : 0; nvis = nvis > 255 ? 255 : nvis;
  const int ntA = (4 * i + 3 + 63) / 64, nC = (i < 8 ? i : 8) + 1, jC0 = i - (nC - 1);
  const int sI = ntA, sB = 2 * ntA, sC = sB + i + 1, NS = sC + nC;
  { LAS float* IM = (LAS float*)(lds + L_IMP); for (int k = tid; k < 4 * 4096; k += 512) IM[k] = 0.f; }
  f32x16 outacc[2];
#pragma unroll
  for (int r = 0; r < 16; ++r) { outacc[0][r] = 0.f; outacc[1][r] = 0.f; }
  SmState st; sm_reset(st);
  float mA = -1.0e30f, invlA = 0.f; unsigned long long mybits = 0ull;
#define FA_ISSUE(s_) do { const int s__ = (s_); const int sl = s__ & 1; \
    if (s__ < sI) stage_kv(lds, sl, kc + (size_t)s__ * 4096, vc + (size_t)s__ * 4096, 64, wid, lane, true); \
    else if (s__ < sB) stage_kv(lds, sl, kc + (size_t)(s__ - sI) * 4096, vc, 64, wid, lane, false); \
    else if (s__ < sC) stage_kv(lds, sl, ksb + (size_t)(s__ - sB) * 64 * QKVW, vsb + (size_t)(s__ - sB) * 64 * QKVW, QKVW, wid, lane, true); \
    else stage_kv(lds, sl, kwb + (size_t)(jC0 + s__ - sC) * 64 * QKVW, vwb + (size_t)(jC0 + s__ - sC) * 64 * QKVW, QKVW, wid, lane, true); } while (0)
  FA_ISSUE(0);
  for (int s = 0; s < NS; ++s) {
    asm volatile("s_waitcnt vmcnt(0)" ::: "memory"); __syncthreads();
    if (s + 1 < NS) FA_ISSUE(s + 1);
    const int sl = s & 1;
    if (s < sI) { tile_step(st, lds, sl, qr, wsf, r32, hi, vb0, 0, nvis - 64 * s - 1);
      if (s == sI - 1) { finalize(st, g0, outacc, wsf, r32, hi, mA, invlA); sm_reset(st); } }
    else if (s < sB) { imp_step(lds, sl, qr, r32, hi, nvis - 64 * (s - sI) - 1, mA, invlA, imph, tq, s - sI);
      if (s == sB - 1) { __syncthreads(); topk_select(lds, wid, lane, i); __syncthreads(); mybits = ((const LAS unsigned long long*)(lds + L_MASK))[tq]; } }
    else if (s < sC) { const int j = s - sB; const bool selj = (mybits >> j) & 1ull; tile_step(st, lds, sl, qr, wsf, r32, hi, vb0, 0, selj ? (j == i ? tq : 63) : -1);
      if (s == sC - 1) { float d0_, d1_; finalize(st, g1, outacc, wsf, r32, hi, d0_, d1_); sm_reset(st); } }
    else { const int j = jC0 + (s - sC); tile_step(st, lds, sl, qr, wsf, r32, hi, vb0, (i >= 8 && j == i - 8) ? tq + 1 : 0, j == i ? tq : 63);
      if (s == NS - 1) { float d0_, d1_; finalize(st, g2, outacc, wsf, r32, hi, d0_, d1_); } }
  }
#undef FA_ISSUE
  { u16* Ow = B.YA + ((size_t)b * S + 64 * i + 32 * (wid & 1)) * 512 + h * 64; LAS u16* stg = (LAS u16*)(lds + L_OST) + wid * 2048;
#pragma unroll
    for (int r = 0; r < 16; ++r) { const int orow = crow(r, hi); stg[orow * 64 + r32] = nv::f2bf(outacc[0][r]); stg[orow * 64 + 32 + r32] = nv::f2bf(outacc[1][r]); }
    asm volatile("s_waitcnt lgkmcnt(0)" ::: "memory");
#pragma unroll
    for (int q = 0; q < 4; ++q) { const int row = q * 8 + (lane >> 3), ch = lane & 7; const u32x4 v = *(const LAS u32x4*)(stg + row * 64 + ch * 8); *(u32x4*)(Ow + (size_t)row * 512 + ch * 8) = v; } }
  __syncthreads();
}
__device__ __forceinline__ void phase_attention(LAS unsigned char* lds, const Bufs& B) {
  const int G = gridDim.x, bx = blockIdx.x; const int vcu = (G % 8 == 0) ? (bx % 8) * (G / 8) + bx / 8 : bx;
  for (int u = vcu; u < 256; u += G) { const int bg = u >> 4, s = u & 15;
#pragma unroll 1
    for (int k = 0; k < 4; ++k) { const int i = (k == 0) ? s : (k == 1) ? 31 - s : (k == 2) ? 32 + s : 63 - s; attn_unit(lds, B, bg >> 1, bg & 1, i); } }
}
}
namespace fs {
using nv::u16; using nv::Bufs; using nv::Inputs;
using fa::bf16x8; using fa::f32x16; using fa::u32x4; using fa::crow; using fa::ex2;
typedef float f32x4 __attribute__((ext_vector_type(4)));
constexpr int S = nv::S, NTOK = nv::NTOK, SCD = 1536;
constexpr float LOG2E = 1.4426950408889634f;
struct SsdBufs { u16* XC; u16* STATE; float* ACS; float* DEC; };
__host__ __device__ inline size_t carve_ssd(SsdBufs& X, const Bufs& B, unsigned char* ws, size_t off) {
  auto take = [&](size_t bytes) { unsigned char* r = ws + off; off += (bytes + 255) / 256 * 256; return r; };
  X.XC = B.HB;
  X.STATE = B.HB + (size_t)NTOK * SCD;
  X.ACS = (float*)take((size_t)NTOK * 16 * 4); X.DEC = (float*)take((size_t)8 * 16 * 16 * 4);
  return off;
}
constexpr int L_ARR = 101376;
constexpr int L_BT = 0, BT_LD = 264, L_XWT = 67584;
constexpr int L_KIMG = 0, L_XV = 0, L_OST = 65536;
static_assert(L_XWT + 64 * BT_LD * 2 <= L_ARR && L_OST + 32768 <= L_ARR && L_ARR + 16384 <= 147456, "SSD LDS map");

__device__ __forceinline__ void phase_conv(const Inputs& I, const Bufs& B, const SsdBufs& X) {
  for (int it = blockIdx.x * 512 + fx::otid(); it < NTOK * (SCD / 8); it += gridDim.x * 512) { const int tok = it / (SCD / 8), c8 = (it % (SCD / 8)) * 8; const int t = tok & (S - 1);
    float acc[8];
#pragma unroll
    for (int j = 0; j < 8; ++j) acc[j] = I.conv_b[c8 + j];
#pragma unroll
    for (int k = 0; k < 4; ++k) { if (t - 3 + k >= 0) { float x[8]; fx::load8(B.XBC + (size_t)(tok - 3 + k) * SCD + c8, x);
#pragma unroll
        for (int j = 0; j < 8; ++j) acc[j] += I.conv_w[k * SCD + c8 + j] * x[j]; } }
    float y[8];
#pragma unroll
    for (int j = 0; j < 8; ++j) y[j] = acc[j] * fx::fsig(acc[j]);
    fx::store8(X.XC + (size_t)tok * SCD + c8, y); }
}

__device__ __forceinline__ void ssd_x_unit(LAS unsigned char* lds, const Inputs& I, const Bufs& B, const SsdBufs& X, int b, int c, int g) {
  const int tid = fx::otid(), lane = tid & 63, wid = __builtin_amdgcn_readfirstlane(tid >> 6), r32 = lane & 31, hi = lane >> 5, fr = lane & 15, fq = lane >> 4;
  const size_t tok0 = (size_t)b * S + (size_t)c * 256;
  LAS float* acs2 = (LAS float*)(lds + L_ARR); LAS float* dtl = acs2 + 8 * 256;
  { const int hh = g * 8 + wid; const float a = -expf(I.a_log[hh]) * LOG2E; float d[4], sc[4];
#pragma unroll
    for (int k = 0; k < 4; ++k) d[k] = B.DT[(tok0 + 4 * lane + k) * 16 + hh];
    sc[0] = d[0] * a; sc[1] = sc[0] + d[1] * a; sc[2] = sc[1] + d[2] * a; sc[3] = sc[2] + d[3] * a;
    float tot = sc[3];
#pragma unroll
    for (int o = 1; o < 64; o <<= 1) { const float up = __shfl_up(tot, o); if (lane >= o) tot += up; }
    const float excl = tot - sc[3];
#pragma unroll
    for (int k = 0; k < 4; ++k) { const float v = excl + sc[k]; acs2[wid * 256 + 4 * lane + k] = v; dtl[wid * 256 + 4 * lane + k] = d[k]; X.ACS[(tok0 + 4 * lane + k) * 16 + hh] = v; }
    if (lane == 63) X.DEC[((size_t)b * 16 + c) * 16 + hh] = ex2(tot); }
  { LAS u16* BT = (LAS u16*)(lds + L_BT);
#pragma unroll 1
    for (int q = tid; q < 256 * 16; q += 512) { const int l = q >> 4, n8 = (q & 15) * 8; const u32x4 w = *(const u32x4*)(X.XC + (tok0 + l) * SCD + 1024 + g * 128 + n8);
      BT[(n8 + 0) * BT_LD + l] = (u16)(w.x & 0xffff); BT[(n8 + 1) * BT_LD + l] = (u16)(w.x >> 16); BT[(n8 + 2) * BT_LD + l] = (u16)(w.y & 0xffff); BT[(n8 + 3) * BT_LD + l] = (u16)(w.y >> 16);
      BT[(n8 + 4) * BT_LD + l] = (u16)(w.z & 0xffff); BT[(n8 + 5) * BT_LD + l] = (u16)(w.z >> 16); BT[(n8 + 6) * BT_LD + l] = (u16)(w.w & 0xffff); BT[(n8 + 7) * BT_LD + l] = (u16)(w.w >> 16); } }
  __syncthreads();
#pragma unroll 1
  for (int h = 0; h < 8; ++h) { const int hh = g * 8 + h; LAS u16* XwT = (LAS u16*)(lds + L_XWT); const LAS u16* BT = (const LAS u16*)(lds + L_BT);
    const float aend = acs2[h * 256 + 255];
#pragma unroll 1
    for (int q = tid; q < 256 * 8; q += 512) { const int l = q >> 3, p8 = (q & 7) * 8; float x[8]; fx::load8(X.XC + (tok0 + l) * SCD + hh * 64 + p8, x); const float w = ex2(aend - acs2[h * 256 + l]) * dtl[h * 256 + l];
#pragma unroll
      for (int j = 0; j < 8; ++j) XwT[(p8 + j) * BT_LD + l] = nv::f2bf(x[j] * w); }
    __syncthreads();
    { const int pt = wid & 3, nt0 = (wid >> 2) * 4; pg8::f32x4 acc[4];
#pragma unroll
      for (int n = 0; n < 4; ++n) acc[n] = (pg8::f32x4){0.f, 0.f, 0.f, 0.f};
#pragma unroll
      for (int ks = 0; ks < 8; ++ks) { const bf16x8 a = *(const LAS bf16x8*)(XwT + (pt * 16 + fr) * BT_LD + ks * 32 + fq * 8);
#pragma unroll
        for (int n = 0; n < 4; ++n) { const bf16x8 bb = *(const LAS bf16x8*)(BT + ((nt0 + n) * 16 + fr) * BT_LD + ks * 32 + fq * 8); acc[n] = __builtin_amdgcn_mfma_f32_16x16x32_bf16(a, bb, acc[n], 0, 0, 0); } }
      u16* st = X.STATE + (((size_t)b * 16 + c) * 16 + hh) * 8192;
#pragma unroll
      for (int n = 0; n < 4; ++n)
#pragma unroll
        for (int j = 0; j < 4; ++j) st[(pt * 16 + 4 * fq + j) * 128 + (nt0 + n) * 16 + fr] = nv::f2bf(acc[n][j]); }
    __syncthreads(); }
  const int l = 32 * wid + r32;
  bf16x8 qr[8];
#pragma unroll
  for (int d0 = 0; d0 < 8; ++d0) qr[d0] = *(const bf16x8*)(X.XC + (tok0 + l) * SCD + 1280 + g * 128 + d0 * 16 + hi * 8);
  unsigned Sp[4][16];
#define FS_STAGE_K(j_) do { const int j__ = (j_); _Pragma("unroll") for (int q = 0; q < 2; ++q) { const int ch = wid + 8 * q; \
    __builtin_amdgcn_global_load_lds((const unsigned*)(X.XC + (tok0 + 64 * j__ + lane) * SCD + 1024 + g * 128 + ch * 8), (LAS unsigned*)(lds + L_KIMG + (j__ & 1) * 16384 + ch * 1024), 16, 0, 0); } } while (0)
  FS_STAGE_K(0);
#pragma unroll
  for (int j = 0; j < 4; ++j) {
    asm volatile("s_waitcnt vmcnt(0)" ::: "memory"); __syncthreads();
    if (j + 1 < 4) FS_STAGE_K(j + 1);
    f32x16 p0, p1;
#pragma unroll
    for (int r = 0; r < 16; ++r) { p0[r] = 0.f; p1[r] = 0.f; }
    if (64 * j <= 32 * wid + 31) { const LAS unsigned char* kb = lds + L_KIMG + (j & 1) * 16384 + hi * 1024 + r32 * 16;
#pragma unroll
      for (int d0 = 0; d0 < 8; ++d0) { const bf16x8 b0 = *(const LAS bf16x8*)(kb + d0 * 2048), b1 = *(const LAS bf16x8*)(kb + d0 * 2048 + 512);
        p0 = __builtin_amdgcn_mfma_f32_32x32x16_bf16(b0, qr[d0], p0, 0, 0, 0); p1 = __builtin_amdgcn_mfma_f32_32x32x16_bf16(b1, qr[d0], p1, 0, 0, 0); } }
#pragma unroll
    for (int r = 0; r < 8; ++r) { Sp[j][r] = pg8::cvt_pk_bf16(p0[2 * r], p0[2 * r + 1]); Sp[j][8 + r] = pg8::cvt_pk_bf16(p1[2 * r], p1[2 * r + 1]); } }
#undef FS_STAGE_K
  __syncthreads();
#define FS_STAGE_X(h_) do { const int h__ = (h_); _Pragma("unroll") for (int j = 0; j < 4; ++j) \
    __builtin_amdgcn_global_load_lds((const unsigned*)(X.XC + (tok0 + 64 * j + 16 * (wid & 3) + (lane >> 2)) * SCD + (g * 8 + h__) * 64 + (wid >> 2) * 32 + (lane & 3) * 8), \
                                     (LAS unsigned*)(lds + L_XV + (h__ & 1) * 32768 + j * 8192 + wid * 1024), 16, 0, 0); } while (0)
  const int vb0 = (int)(unsigned)(size_t)lds + ((lane >> 4) & 1) * 32 + (lane & 3) * 8 + (4 * hi + ((lane & 15) >> 2)) * 64;
  FS_STAGE_X(0);
#pragma unroll 1
  for (int h = 0; h < 8; ++h) { const int hh = g * 8 + h;
    asm volatile("s_waitcnt vmcnt(0)" ::: "memory"); __syncthreads();
    if (h + 1 < 8) FS_STAGE_X(h + 1);
    const float al = acs2[h * 256 + l]; f32x16 o[2];
#pragma unroll
    for (int r = 0; r < 16; ++r) { o[0][r] = 0.f; o[1][r] = 0.f; }
#pragma unroll
    for (int j = 0; j < 4; ++j) { if (64 * j <= 32 * wid + 31) { f32x16 p0, p1;
#pragma unroll
        for (int r = 0; r < 16; ++r) asm volatile("" : "+v"(Sp[j][r]));
#pragma unroll
        for (int r = 0; r < 8; ++r) { p0[2 * r] = __uint_as_float(Sp[j][r] << 16); p0[2 * r + 1] = __uint_as_float(Sp[j][r] & 0xffff0000u); p1[2 * r] = __uint_as_float(Sp[j][8 + r] << 16); p1[2 * r + 1] = __uint_as_float(Sp[j][8 + r] & 0xffff0000u); }
#pragma unroll
        for (int gq = 0; gq < 4; ++gq) { const int s0 = 64 * j + 8 * gq + 4 * hi; const f32x4 a0 = *(const LAS f32x4*)(acs2 + h * 256 + s0), d0v = *(const LAS f32x4*)(dtl + h * 256 + s0), a1 = *(const LAS f32x4*)(acs2 + h * 256 + s0 + 32), d1v = *(const LAS f32x4*)(dtl + h * 256 + s0 + 32);
#pragma unroll
          for (int k = 0; k < 4; ++k) { const int r = 4 * gq + k, s = s0 + k; p0[r] = (s <= l) ? p0[r] * ex2(al - a0[k]) * d0v[k] : 0.f; p1[r] = (s + 32 <= l) ? p1[r] * ex2(al - a1[k]) * d1v[k] : 0.f; } }
        u32x4 w0, w1, w2, w3;
        w0.x = pg8::cvt_pk_bf16(p0[0], p0[1]); w0.y = pg8::cvt_pk_bf16(p0[2], p0[3]); w0.z = pg8::cvt_pk_bf16(p0[4], p0[5]); w0.w = pg8::cvt_pk_bf16(p0[6], p0[7]);
        w1.x = pg8::cvt_pk_bf16(p0[8], p0[9]); w1.y = pg8::cvt_pk_bf16(p0[10], p0[11]); w1.z = pg8::cvt_pk_bf16(p0[12], p0[13]); w1.w = pg8::cvt_pk_bf16(p0[14], p0[15]);
        w2.x = pg8::cvt_pk_bf16(p1[0], p1[1]); w2.y = pg8::cvt_pk_bf16(p1[2], p1[3]); w2.z = pg8::cvt_pk_bf16(p1[4], p1[5]); w2.w = pg8::cvt_pk_bf16(p1[6], p1[7]);
        w3.x = pg8::cvt_pk_bf16(p1[8], p1[9]); w3.y = pg8::cvt_pk_bf16(p1[10], p1[11]); w3.z = pg8::cvt_pk_bf16(p1[12], p1[13]); w3.w = pg8::cvt_pk_bf16(p1[14], p1[15]);
        fa::pv(o, vb0 + L_XV + (h & 1) * 32768 + j * 8192, __builtin_bit_cast(bf16x8, w0), __builtin_bit_cast(bf16x8, w1), __builtin_bit_cast(bf16x8, w2), __builtin_bit_cast(bf16x8, w3)); } }
    { const float dsk = I.d_skip[hh]; const LAS u16* xi = (const LAS u16*)(lds + L_XV + (h & 1) * 32768 + (wid >> 1) * 8192); LAS u16* stg = (LAS u16*)(lds + L_OST) + wid * 2048;
#pragma unroll
      for (int r = 0; r < 16; ++r) { const int key = 32 * (wid & 1) + crow(r, hi);
#pragma unroll
        for (int d0 = 0; d0 < 2; ++d0) { const float xv = nv::bf2f(xi[d0 * 2048 + (key >> 4) * 512 + (key & 15) * 32 + r32]); stg[crow(r, hi) * 64 + d0 * 32 + r32] = nv::f2bf(o[d0][r] + dsk * xv); } }
      asm volatile("s_waitcnt lgkmcnt(0)" ::: "memory");
      u16* Ow = X.XC + (tok0 + 32 * wid) * SCD + hh * 64;
#pragma unroll
      for (int q = 0; q < 4; ++q) { const int row = q * 8 + (lane >> 3), ch = lane & 7; const u32x4 v = *(const LAS u32x4*)(stg + row * 64 + ch * 8); *(u32x4*)(Ow + (size_t)row * SCD + ch * 8) = v; } } }
#undef FS_STAGE_X
  __syncthreads();
}
__device__ __forceinline__ void phase_ssd_x(LAS unsigned char* lds, const Inputs& I, const Bufs& B, const SsdBufs& X) {
  for (int u = blockIdx.x; u < 256; u += gridDim.x) ssd_x_unit(lds, I, B, X, u >> 5, (u >> 1) & 15, u & 1);
}
__device__ __forceinline__ void phase_ssd_scan(const SsdBufs& X) {
  for (int it = blockIdx.x * 512 + fx::otid(); it < 8 * 16 * 64 * 16; it += gridDim.x * 512) { const int n8 = (it & 15) * 8, p = (it >> 4) & 63, hh = (it >> 10) & 15, b = it >> 14;
    float hrun[8];
#pragma unroll
    for (int j = 0; j < 8; ++j) hrun[j] = 0.f;
#pragma unroll 1
    for (int c = 0; c < 16; ++c) { u16* st = X.STATE + (((size_t)b * 16 + c) * 16 + hh) * 8192 + p * 128 + n8; float v[8]; fx::load8(st, v); const float dec = X.DEC[((size_t)b * 16 + c) * 16 + hh];
      fx::store8(st, hrun);
#pragma unroll
      for (int j = 0; j < 8; ++j) hrun[j] = hrun[j] * dec + v[j]; } }
}
__device__ __forceinline__ void ssd_y_unit(LAS unsigned char* lds, const Inputs& I, const Bufs& B, const SsdBufs& X, int b, int c, int g) {
  const int tid = fx::otid(), lane = tid & 63, wid = __builtin_amdgcn_readfirstlane(tid >> 6), r32 = lane & 31, hi = lane >> 5;
  const size_t tok0 = (size_t)b * S + (size_t)c * 256; const int l = 32 * wid + r32;
  LAS float* acsw = (LAS float*)(lds + 0) + wid * 32 * 8;
  LAS u16* stg1 = (LAS u16*)(lds + 16384) + wid * 2048; LAS u16* stg2 = (LAS u16*)(lds + 49152) + wid * 2048; LAS float* rstdL = (LAS float*)(lds + 81920);
  { const int row = lane >> 1, h4 = (lane & 1) * 4; const f32x4 a = *(const f32x4*)(X.ACS + (tok0 + 32 * wid + row) * 16 + g * 8 + h4); acsw[row * 8 + h4 + 0] = ex2(a.x); acsw[row * 8 + h4 + 1] = ex2(a.y); acsw[row * 8 + h4 + 2] = ex2(a.z); acsw[row * 8 + h4 + 3] = ex2(a.w); }
  bf16x8 qr[8];
#pragma unroll
  for (int d0 = 0; d0 < 8; ++d0) qr[d0] = *(const bf16x8*)(X.XC + (tok0 + l) * SCD + 1280 + g * 128 + d0 * 16 + hi * 8);
  float ssq[16];
#pragma unroll
  for (int r = 0; r < 16; ++r) ssq[r] = 0.f;
#pragma unroll 1
  for (int h = 0; h < 8; ++h) { const int hh = g * 8 + h; const u16* pv_ = X.STATE + (((size_t)b * 16 + c) * 16 + hh) * 8192;
    f32x16 y[2];
#pragma unroll
    for (int r = 0; r < 16; ++r) { y[0][r] = 0.f; y[1][r] = 0.f; }
#pragma unroll
    for (int d0 = 0; d0 < 8; ++d0) { const bf16x8 b0 = *(const bf16x8*)(pv_ + (size_t)r32 * 128 + d0 * 16 + hi * 8), b1 = *(const bf16x8*)(pv_ + (size_t)(32 + r32) * 128 + d0 * 16 + hi * 8);
      y[0] = __builtin_amdgcn_mfma_f32_32x32x16_bf16(qr[d0], b0, y[0], 0, 0, 0); y[1] = __builtin_amdgcn_mfma_f32_32x32x16_bf16(qr[d0], b1, y[1], 0, 0, 0); }
#pragma unroll
    for (int q = 0; q < 4; ++q) { const int row = q * 8 + (lane >> 3), ch = lane & 7;
      *(LAS u32x4*)(stg1 + row * 64 + ch * 8) = *(const u32x4*)(X.XC + (tok0 + 32 * wid + row) * SCD + hh * 64 + ch * 8);
      *(LAS u32x4*)(stg2 + row * 64 + ch * 8) = *(const u32x4*)(B.Z + (tok0 + 32 * wid + row) * 1024 + hh * 64 + ch * 8); }
    asm volatile("s_waitcnt lgkmcnt(0)" ::: "memory");
#pragma unroll
    for (int r = 0; r < 16; ++r) { const int row = crow(r, hi); const float ea = acsw[row * 8 + h];
#pragma unroll
      for (int d0 = 0; d0 < 2; ++d0) { const int idx = row * 64 + d0 * 32 + r32; const float yy = nv::bf2f(stg1[idx]) + ea * y[d0][r]; const float zz = nv::bf2f(stg2[idx]); const float yg = yy * zz * fx::fsig(zz); ssq[r] += yg * yg; stg1[idx] = nv::f2bf(yg); } }
    asm volatile("s_waitcnt lgkmcnt(0)" ::: "memory");
#pragma unroll
    for (int q = 0; q < 4; ++q) { const int row = q * 8 + (lane >> 3), ch = lane & 7; *(u32x4*)(B.YB + (tok0 + 32 * wid + row) * 1024 + hh * 64 + ch * 8) = *(const LAS u32x4*)(stg1 + row * 64 + ch * 8); }
    asm volatile("s_waitcnt lgkmcnt(0)" ::: "memory"); }
#pragma unroll
  for (int r = 0; r < 16; ++r) { float v = ssq[r];
#pragma unroll
    for (int o = 1; o < 32; o <<= 1) v += __shfl_xor(v, o);
    if (r32 == 0) rstdL[32 * wid + crow(r, hi)] = 1.0f / sqrtf(v * (1.f / 512.f) + nv::EPS); }
  __threadfence(); __syncthreads();
#pragma unroll 1
  for (int q = tid; q < 256 * 64; q += 512) { const int row = q >> 6, c8 = (q & 63) * 8; u16* p = B.YB + (tok0 + row) * 1024 + g * 512 + c8; float v[8]; fx::load8(p, v); const float rs = rstdL[row];
#pragma unroll
    for (int j = 0; j < 8; ++j) v[j] = v[j] * rs * I.ssm_norm[g * 512 + c8 + j];
    fx::store8(p, v); }
  __syncthreads();
}
__device__ __forceinline__ void phase_ssd_y(LAS unsigned char* lds, const Inputs& I, const Bufs& B, const SsdBufs& X) {
  for (int u = blockIdx.x; u < 256; u += gridDim.x) ssd_y_unit(lds, I, B, X, u >> 5, (u >> 1) & 15, u & 1);
}
}
namespace fc {
using nv::u16; using nv::Bufs; using nv::Inputs; using pg8::Unit;
constexpr int S = nv::S;
struct CmpBufs { u16* WcT; float* BIAS1; float* PAB; };
__host__ __device__ inline size_t carve_cmp(CmpBufs& C, unsigned char* ws, size_t off) {
  auto take = [&](size_t bytes) { unsigned char* r = ws + off; off += (bytes + 255) / 256 * 256; return r; };
  C.WcT = (u16*)take((size_t)2 * 256 * 1024 * 2); C.BIAS1 = (float*)take(2 * 128 * 4); C.PAB = (float*)take((size_t)2 * 16 * 256 * 256 * 4);
  return off;
}
struct CpCmp { const float* src; int ld; __device__ const float* operator()(int n) const { return n < 128 ? src + n : src + (size_t)1024 * 128 + (n - 128); } };
__device__ __forceinline__ void prologue_cmp(LAS unsigned char* lds, const Inputs& I, const CmpBufs& C) {
  LAS float* scr = (LAS float*)lds;
  for (int t = blockIdx.x; t < 64; t += gridDim.x) { const int kv = t >> 5, q = t & 31; CpCmp cp{kv ? I.w1_v : I.w1_k, 128}; fx::transpose_tile(scr, cp, C.WcT + (size_t)kv * 256 * 1024, 1024, (q >> 4) * 128, (q & 15) * 64); }
  { const int tid = fx::otid(), lane = tid & 63, gw = fx::obid() * 8 + (tid >> 6);
    if (gw < 256) { const int kv = gw >> 7, n = gw & 127; const float* w1 = kv ? I.w1_v : I.w1_k; const float* pos = kv ? I.pos_v : I.pos_k; float s = 0.f;
      for (int k = lane; k < 2048; k += 64) s += pos[k] * w1[(size_t)k * 128 + n];
      s = fx::wave_sum(s); if (lane == 0) C.BIAS1[kv * 128 + n] = s; } }
}
struct SchedCmp { int kv, bg;
  __device__ bool next(int i, Unit& u) const { if (i > 0) return false; u.pm = kv * 16 + bg; u.pn = 0; u.aux0 = 0; u.aux1 = 0; return true; }
  __device__ __forceinline__ const char* a_base(const pg8::Gemm& g, const Unit&) const { return (const char*)g.A; }
  __device__ __forceinline__ const char* b_base(const pg8::Gemm& g, const Unit&) const { return (const char*)g.Bt + (size_t)kv * 256 * 1024 * 2; }
  __device__ __forceinline__ int a_row(const Unit&, int r) const { return ((bg >> 1) * S + 16 * r) * 1280 + (kv ? nv::O_VC : nv::O_KC) + (bg & 1) * 64; } };
struct FPab { float* o; __device__ __forceinline__ void operator()(const Unit&, int row, int c, const float (&v)[8]) const { float* p = o + (size_t)row * 256 + c; *(pg8::f32x4*)p = (pg8::f32x4){v[0], v[1], v[2], v[3]}; *(pg8::f32x4*)(p + 4) = (pg8::f32x4){v[4], v[5], v[6], v[7]}; } };
__device__ __forceinline__ void phase_cmp_gemm(LAS unsigned char* lds, const Bufs& B, const CmpBufs& C) {
  for (int u = blockIdx.x; u < 32; u += gridDim.x) { pg8::Gemm g{B.QKV, C.WcT, 256, 256, 1024, 1, 1024, 1280 * 2}; SchedCmp S{u >> 4, u & 15}; fx::Epi8<FPab> E{FPab{C.PAB}};
    pg8::gemm_phase<fx::Epi8<FPab>, SchedCmp, true, true>(lds, g, S, E); }
}
__device__ __forceinline__ void phase_cmp_finish(const Inputs& I, const Bufs& B, const CmpBufs& C) {
  const int tid = fx::otid(), lane = tid & 63, gw = fx::obid() * 8 + (tid >> 6), ngw = gridDim.x * 8;
  for (int it = gw; it < 2 * 16 * 256; it += ngw) { const int kv = it >> 12, bg = (it >> 8) & 15, c = it & 255; u16* dst = (kv ? B.VCMP : B.KCMP) + ((size_t)bg * 256 + c) * 64;
    if (c == 255) { dst[lane] = 0; continue; }
    const float* pa = C.PAB + ((size_t)(kv * 16 + bg) * 256 + c) * 256; const float* pb = pa + 256 + 128; const float* b1 = C.BIAS1 + kv * 128; const float* w2 = kv ? I.w2_v : I.w2_k;
    float acc = 0.f;
#pragma unroll 4
    for (int n = 0; n < 128; ++n) { const float h = pa[n] + pb[n] + b1[n]; acc += h * fx::fsig(h) * w2[n * 64 + lane]; }
    if (kv == 0) { const float ss = fx::wave_sum(acc * acc); acc = acc * (1.0f / sqrtf(ss * (1.f / 64.f) + nv::EPS)) * I.kc_gain[lane]; }
    dst[lane] = nv::f2bf(acc); }
}
}
struct Params { nv::Inputs I; float* out; unsigned char* ws; };
constexpr int LDS_BYTES = 147456;
template <class F> __device__ __forceinline__ void run_phase(const F& f, long n) {
  for (long i = blockIdx.x * 512L + fx::otid(); i < n; i += (long)gridDim.x * 512L) f(i);
}
__global__ void __launch_bounds__(512) mega_fwd(Params P) {
  extern __shared__ __attribute__((aligned(16))) unsigned char lds_raw[];
  LAS unsigned char* lds = (LAS unsigned char*)lds_raw;
  cg::grid_group grid = cg::this_grid();
  nv::Bufs B; const size_t woff = nv::carve(B, P.ws, P.out); fx::WBufs W; const size_t moff = fx::carve_w(W, P.ws, woff); fx::MoeBufs M; const size_t soff = fx::carve_moe(M, B, P.ws, moff); fs::SsdBufs X; const size_t coff = fs::carve_ssd(X, B, P.ws, soff); fc::CmpBufs C; fc::carve_cmp(C, P.ws, coff);
  float* out = P.out;
#define RUN(f, n) { run_phase(f, n); grid.sync(); }
  fx::phase_prologue(lds, P.I, B, W); fx::prologue_moe(P.I, M); fc::prologue_cmp(lds, P.I, C); grid.sync();
  fx::dense_gemm(lds, B.HB, 1024, W.WinT, 1024, nv::NTOK, fx::INW_PAD, 1024, fx::FInProj{B.QKV, B.Z, B.XBC, B.BG, B.NG, B.DT, P.I.dt_bias}); grid.sync();
  fc::phase_cmp_gemm(lds, B, C); fs::phase_conv(P.I, B, X); fa::phase_qknorm(P.I, B); grid.sync();
  fs::phase_ssd_x(lds, P.I, B, X); grid.sync();
  fs::phase_ssd_scan(X); fc::phase_cmp_finish(P.I, B, C); grid.sync();
  fs::phase_ssd_y(lds, P.I, B, X); grid.sync();
  fa::phase_attention(lds, B); grid.sync();
  fx::dense_gemm(lds, B.YA, 512, W.WaT, 512, nv::NTOK, 1024, 512, fx::FStoreBf{B.T1, 1024});
  fx::dense_gemm(lds, B.YB, 1024, W.WbT, 1024, nv::NTOK, 1024, 1024, fx::FMerge{B.T1, B.BG, B.MERGED}); grid.sync();
  fx::dense_gemm(lds, B.MERGED, 1024, W.WoutT, 1024, nv::NTOK, 1024, 1024, fx::FResid{P.I.x, out}); grid.sync();
  fx::phase_rms_rows(out, P.I.moe_norm, B.H2); grid.sync();
  fx::dense_gemm(lds, B.H2, 1024, M.WrT, 1024, nv::NTOK, 256, 1024, fx::FLogits{M.LOGITS}); grid.sync();
  fx::phase_route(P.I, B, M); grid.sync();
  fx::build_tile_table(lds, M);
  fx::phase_moe_gu(lds, B, W, M); grid.sync();
  fx::phase_moe_down(lds, B, W, M); grid.sync();
  fx::phase_moe_combine(out, M.MOEOUT, P.I.ple_norm, B.H2); grid.sync();
  fx::dense_gemm(lds, W.PB, 256, W.PlePT, 256, nv::NTOK, 1024, 256, fx::FStoreBf{B.PP, 1024});
  fx::dense_gemm(lds, B.H2, 1024, W.PleGT, 1024, nv::NTOK, 1024, 1024, fx::FPle{out, B.PP});
#undef RUN
}
extern "C" void kernel_launch(void* const* d_in, const int* in_sizes, int n_in, void* d_out, int out_size, void* d_ws, size_t ws_size, hipStream_t stream) {
  static int grid_blocks = 0;
  if (!grid_blocks) {
    int dev = 0, cus = 0, per_cu = 0;
    (void)hipGetDevice(&dev);
    (void)hipDeviceGetAttribute(&cus, hipDeviceAttributeMultiprocessorCount, dev);
    if (hipFuncSetAttribute((const void*)mega_fwd, hipFuncAttributeMaxDynamicSharedMemorySize, LDS_BYTES) != hipSuccess) fprintf(stderr, "kernel_launch: hipFuncSetAttribute failed\n");
    if (hipOccupancyMaxActiveBlocksPerMultiprocessor(&per_cu, mega_fwd, 512, LDS_BYTES) != hipSuccess || per_cu < 1) { fprintf(stderr, "kernel_launch: occupancy query says %d blocks per CU\n", per_cu); }
    grid_blocks = cus;
    { nv::Bufs B; fx::WBufs W; fx::MoeBufs M; fs::SsdBufs X; fc::CmpBufs C; size_t need = fc::carve_cmp(C, nullptr, fs::carve_ssd(X, B, nullptr, fx::carve_moe(M, B, nullptr, fx::carve_w(W, nullptr, nv::carve(B, nullptr, nullptr))))); if (need > ws_size) fprintf(stderr, "kernel_launch: workspace too small: need %zu have %zu\n", need, ws_size); }
  }
  Params p; memset(&p, 0, sizeof(p));
  const float** ip = (const float**)&p.I; for (int i = 0; i < 34; ++i) ip[i] = (const float*)d_in[i];
  p.out = (float*)d_out; p.ws = (unsigned char*)d_ws;
  void* args[] = {&p};
  hipError_t e = hipLaunchCooperativeKernel((void*)mega_fwd, dim3(grid_blocks), dim3(512), args, LDS_BYTES, stream);
  if (e != hipSuccess) fprintf(stderr, "cooperative launch failed: %s (grid %d)\n", hipGetErrorString(e), grid_blocks);
}
```

```cpp
#include <hip/hip_runtime.h>
#include <hip/hip_cooperative_groups.h>
#include <cstdio>
#include <cstring>
namespace cg = cooperative_groups;
#define HD __host__ __device__ inline
#if defined(__HIP_DEVICE_COMPILE__)
#define NV_FENCE() asm volatile("" ::: "memory")
#else
#define NV_FENCE()
#endif
#ifndef CFG_DM
#define CFG_DM 1024
#endif
#ifndef CFG_BATCH
#define CFG_BATCH 8
#endif
#ifndef CFG_SEQ
#define CFG_SEQ 4096
#endif
#ifndef CFG_MH
#define CFG_MH 256
#endif
#ifndef CFG_PLE
#define CFG_PLE 256
#endif

#ifndef NV_FENCE
#define NV_FENCE()
#endif
namespace nv {
typedef unsigned short u16;
typedef unsigned long long u64;
constexpr int DM = CFG_DM, NB = CFG_BATCH, S = CFG_SEQ, MH = CFG_MH, PLE = CFG_PLE;
constexpr int NTOK = NB * S;
constexpr int H = 8, G = 2, E = 4;
constexpr int QW = 512, GW = 24, QKVW = 1280;
constexpr int SH = 16, SP = 64, SI = 1024, SG = 2, SN = 128, SCD = 1536;
constexpr int INW = QW + 6 * 128 + GW + SI + SCD + SH + 2 * DM;
constexpr int O_Q = 0, O_KC = 512, O_VC = 640, O_KS = 768, O_VS = 896, O_KW = 1024, O_VW = 1152, O_NG = 1280, O_Z = 1304, O_XBC = 2328, O_DT = 3864, O_BG = 3880;
static_assert(O_BG + 2 * DM == INW, "in-proj width");
constexpr int NCMP = S / 16 - 1, NCP = S / 16, NSEL = S / 64, NTOP = NSEL < 16 ? NSEL : 16;
constexpr int NEXP = 32;
constexpr float EPS = 1e-6f;

HD float sigmoidf_(float x) { return 1.0f / (1.0f + expf(-x)); }
HD float siluf_(float x) { return x / (1.0f + expf(-x)); }
HD float softplusf_(float x) { return x > 20.f ? x : log1pf(expf(x)); }
HD u16 f2bf(float f) { unsigned u = __builtin_bit_cast(unsigned, f); u += 0x7fffu + ((u >> 16) & 1u); return (u16)(u >> 16); }
HD float bf2f(u16 h) { return __builtin_bit_cast(float, (unsigned)h << 16); }

struct Bufs {
  u16* HB;
  u16* QKV;
  float* NG;
  u16* Z;
  u16* XBC;
  float* DT;
  u16* BG;
  u16* KCMP;
  u16* VCMP;
  u16* YA;
  u16* YB;
  u16* T1;
  u16* MERGED;
  u16* H2;
  u16* ACT;
  u16* PP;
  int* EI;
  float* EW;
  float* HID;
  float* KTMP;
  float* ML;
  float* IMP;
  u64* MASK;
};
struct Inputs { const float *x, *p, *mix_norm, *w_in, *q_gain, *kc_gain, *ks_gain, *kw_gain, *pos_k, *w1_k, *w2_k, *pos_v, *w1_v, *w2_v, *conv_w, *conv_b, *dt_bias, *a_log, *d_skip, *ssm_norm,
  *w_a, *w_b, *w_out, *moe_norm, *w_group, *b_group, *w_expert, *b_expert, *w_gate, *w_up, *w_down, *ple_norm, *ple_wg, *ple_wp; };

struct RmsRowsBf { const float* in; const float* gain; u16* out; long ncols;
  HD void operator()(long r) const { const float* x = in + r * ncols; float s = 0.f; for (long c = 0; c < ncols; ++c) s += x[c] * x[c];
    const float rs = 1.0f / sqrtf(s / (float)ncols + EPS); u16* o = out + r * ncols; for (long c = 0; c < ncols; ++c) o[c] = f2bf(x[c] * rs * gain[c]); } };

template <class AL, class EP> struct GemmT { AL a; const float* B; EP ep; long M, N, K, ldb;
  HD long items() const { return ((M + 7) / 8) * ((N + 3) / 4); }
  HD void operator()(long it) const { const long nt = (N + 3) / 4; const long tm = it / nt, tn = it % nt; const long r0 = tm * 8, c0 = tn * 4;
    float acc[8][4];
#pragma unroll
    for (int i = 0; i < 8; ++i)
#pragma unroll
      for (int j = 0; j < 4; ++j) acc[i][j] = 0.f;
    for (long k = 0; k < K; ++k) { float b[4];
#pragma unroll
      for (int j = 0; j < 4; ++j) b[j] = (c0 + j < N) ? B[k * ldb + c0 + j] : 0.f;
#pragma unroll
      for (int i = 0; i < 8; ++i) { const long r = r0 + i < M ? r0 + i : M - 1; const float av = a(r, k);
#pragma unroll
        for (int j = 0; j < 4; ++j) acc[i][j] += av * b[j]; } }
#pragma unroll
    for (int i = 0; i < 8; ++i) if (r0 + i < M) {
#pragma unroll
      for (int j = 0; j < 4; ++j) if (c0 + j < N) ep(r0 + i, c0 + j, acc[i][j]); } } };
struct ABf { const u16* p; long ld; HD float operator()(long r, long k) const { return bf2f(p[r * ld + k]); } };
struct AF32 { const float* p; long ld; HD float operator()(long r, long k) const { return p[r * ld + k]; } };
struct ACmp { const u16* qkv; const float* pos; long off;
  HD float operator()(long r, long k) const { const long c = r % NCMP, bg = r / NCMP, b = bg / G, g = bg % G; const long l = k / 64, d = k % 64;
    return bf2f(qkv[(b * S + 16 * c + l) * QKVW + off + g * 64 + d]) + pos[k]; } };

struct EpInProj { Bufs B; const float* dt_bias;
  HD void operator()(long r, long c, float v) const {
    if (c < O_NG) B.QKV[r * QKVW + c] = f2bf(v);
    else if (c < O_Z) B.NG[r * GW + (c - O_NG)] = sigmoidf_(v);
    else if (c < O_XBC) B.Z[r * SI + (c - O_Z)] = f2bf(v);
    else if (c < O_DT) B.XBC[r * SCD + (c - O_XBC)] = f2bf(v);
    else if (c < O_BG) B.DT[r * SH + (c - O_DT)] = softplusf_(v + dt_bias[c - O_DT]);
    else B.BG[r * (2 * DM) + (c - O_BG)] = f2bf(sigmoidf_(v)); } };
struct EpSiluF32 { float* o; long ld; HD void operator()(long r, long c, float v) const { o[r * ld + c] = siluf_(v); } };
struct EpF32 { float* o; long ld; HD void operator()(long r, long c, float v) const { o[r * ld + c] = v; } };
struct EpBf { u16* o; long ld; HD void operator()(long r, long c, float v) const { o[r * ld + c] = f2bf(v); } };
struct EpMerge { const u16* t1; const u16* bg; u16* o; HD void operator()(long r, long c, float v) const { const float ga = bf2f(bg[r * (2 * DM) + c]), gb = bf2f(bg[r * (2 * DM) + DM + c]); o[r * DM + c] = f2bf(ga * bf2f(t1[r * DM + c]) + gb * v); } };
struct EpResid { const float* x; float* o; HD void operator()(long r, long c, float v) const { o[r * DM + c] = x[r * DM + c] + v; } };
struct EpPle { float* x; const u16* pp; HD void operator()(long r, long c, float v) const { x[r * DM + c] = x[r * DM + c] + sigmoidf_(v) * bf2f(pp[r * DM + c]); } };

struct QkNorm { u16* qkv; const float* qg; const float* ksg; const float* kwg;
  HD long items() const { return (long)NTOK * 12; }
  HD void operator()(long it) const { const long tok = it / 12; const int w = (int)(it % 12); u16* v; const float* gain;
    if (w < 8) { v = qkv + tok * QKVW + O_Q + w * 64; gain = qg; } else if (w < 10) { v = qkv + tok * QKVW + O_KS + (w - 8) * 64; gain = ksg; } else { v = qkv + tok * QKVW + O_KW + (w - 10) * 64; gain = kwg; }
    float s = 0.f; for (int d = 0; d < 64; ++d) { const float x = bf2f(v[d]); s += x * x; } const float rs = 1.0f / sqrtf(s / 64.f + EPS);
    for (int d = 0; d < 64; ++d) v[d] = f2bf(bf2f(v[d]) * rs * gain[d]); } };
struct CmpFinish { const float* src; const float* gain; u16* dst; long donorm;
  HD long items() const { return (long)NB * G * NCP; }
  HD void operator()(long it) const { const long c = it % NCP, bg = it / NCP; u16* o = dst + it * 64;
    if (c >= NCMP) { for (int d = 0; d < 64; ++d) o[d] = 0; return; }
    const float* x = src + (bg * NCMP + c) * 64; float rs = 1.f;
    if (donorm) { float s = 0.f; for (int d = 0; d < 64; ++d) s += x[d] * x[d]; rs = 1.0f / sqrtf(s / 64.f + EPS); }
    for (int d = 0; d < 64; ++d) o[d] = f2bf(donorm ? x[d] * rs * gain[d] : x[d]); } };

struct CmpAttn { Bufs B;
  HD long items() const { return (long)NB * H * S; }
  HD void operator()(long it) const { const long t = it % S; const int h = (int)((it / S) % H), g = h / E; const long b = it / ((long)S * H); const long tok = b * S + t;
    const u16* q = B.QKV + tok * QKVW + O_Q + h * 64; const u16* kc = B.KCMP + (b * G + g) * (long)NCP * 64; const u16* vc = B.VCMP + (b * G + g) * (long)NCP * 64;
    float qr[64];
#pragma unroll
    for (int d = 0; d < 64; ++d) qr[d] = bf2f(q[d]);
    long nvis = (t - 31 >= 0) ? (t - 31) / 16 + 1 : 0; if (nvis > NCMP) nvis = NCMP;
    float m = -3.0e38f;
    for (long c = 0; c < nvis; ++c) { const u16* k = kc + c * 64; float s = 0.f;
#pragma unroll
      for (int d = 0; d < 64; ++d) s += qr[d] * bf2f(k[d]);
      s *= 0.125f; m = s > m ? s : m; }
    float o[64];
#pragma unroll
    for (int d = 0; d < 64; ++d) o[d] = 0.f;
    float l = 0.f;
    for (long c = 0; c < nvis; ++c) { const u16* k = kc + c * 64; const u16* v = vc + c * 64; float s = 0.f;
#pragma unroll
      for (int d = 0; d < 64; ++d) s += qr[d] * bf2f(k[d]);
      const float p = expf(s * 0.125f - m); l += p;
#pragma unroll
      for (int d = 0; d < 64; ++d) o[d] += p * bf2f(v[d]); }
    const float g0 = B.NG[tok * GW + h * 3 + 0]; const float inv = nvis > 0 ? g0 / l : 0.f;
#pragma unroll
    for (int d = 0; d < 64; ++d) B.YA[tok * QW + h * 64 + d] = f2bf(o[d] * inv);
    B.ML[it * 2] = m; B.ML[it * 2 + 1] = nvis > 0 ? l : 0.f; } };
struct Importance { Bufs B;
  HD long items() const { return (long)NB * G * S * NSEL; }
  HD void operator()(long it) const { const int j = (int)(it % NSEL); const long bgt = it / NSEL; const long t = bgt % S; const long bg = bgt / S; const long b = bg / G; const int g = (int)(bg % G); const long tok = b * S + t;
    long nvis = (t - 31 >= 0) ? (t - 31) / 16 + 1 : 0; if (nvis > NCMP) nvis = NCMP;
    long c0 = 4 * j - 1; if (c0 < 0) c0 = 0; long c1 = 4 * j + 3; if (c1 > nvis - 1) c1 = nvis - 1;
    const u16* kc = B.KCMP + bg * (long)NCP * 64; float acc = 0.f;
    for (int e = 0; e < E; ++e) { const int h = g * E + e; const u16* q = B.QKV + tok * QKVW + O_Q + h * 64; const long mi = ((b * H + h) * (long)S + t) * 2; const float m = B.ML[mi], l = B.ML[mi + 1];
      if (l > 0.f) for (long c = c0; c <= c1; ++c) { const u16* k = kc + c * 64; float s = 0.f; for (int d = 0; d < 64; ++d) s += bf2f(q[d]) * bf2f(k[d]); acc += expf(s * 0.125f - m) / l; } }
    B.IMP[bgt * 64 + j] = acc; } };
struct TopSel { Bufs B;
  HD long items() const { return (long)NB * G * S; }
  HD void operator()(long bgt) const { const long t = bgt % S; const int cur = (int)(t / 64); u64 m = 0ull;
    for (int r = 0; r < NTOP; ++r) { float best = -3.0e38f; int bj = -1;
      for (int j = 0; j <= cur && j < NSEL; ++j) { if ((m >> j) & 1ull) continue; float v = B.IMP[bgt * 64 + j]; if (j == 0 || j == cur || j == cur - 1) v += 1000.f; if (v > best) { best = v; bj = j; } }
      if (bj < 0) break; m |= 1ull << bj; }
    B.MASK[bgt] = m; } };
struct SelAttn { Bufs B;
  HD long items() const { return (long)NB * H * S; }
  HD void operator()(long it) const { const long t = it % S; const int h = (int)((it / S) % H), g = h / E; const long b = it / ((long)S * H); const long tok = b * S + t;
    const u16* q = B.QKV + tok * QKVW + O_Q + h * 64; const u64 mk = B.MASK[(b * G + g) * (long)S + t];
    float qr[64], o[64];
#pragma unroll
    for (int d = 0; d < 64; ++d) { qr[d] = bf2f(q[d]); o[d] = 0.f; }
    float m = -3.0e38f, l = 0.f;
    for (int j = 0; j < NSEL; ++j) { if (!((mk >> j) & 1ull)) continue;
      for (long kp = 64L * j; kp < 64L * j + 64 && kp <= t; ++kp) { const u16* k = B.QKV + (b * S + kp) * QKVW + O_KS + g * 64; const u16* v = B.QKV + (b * S + kp) * QKVW + O_VS + g * 64; float s = 0.f;
#pragma unroll
        for (int d = 0; d < 64; ++d) s += qr[d] * bf2f(k[d]);
        s *= 0.125f;
        if (s > m) { const float f = expf(m - s); l *= f;
#pragma unroll
          for (int d = 0; d < 64; ++d) o[d] *= f;
          m = s; }
        const float p = expf(s - m); l += p;
#pragma unroll
        for (int d = 0; d < 64; ++d) o[d] += p * bf2f(v[d]); } }
    const float g1 = B.NG[tok * GW + h * 3 + 1]; const float inv = g1 / l;
#pragma unroll
    for (int d = 0; d < 64; ++d) { u16* y = B.YA + tok * QW + h * 64 + d; *y = f2bf(bf2f(*y) + o[d] * inv); } } };
struct WinAttn { Bufs B;
  HD long items() const { return (long)NB * H * S; }
  HD void operator()(long it) const { const long t = it % S; const int h = (int)((it / S) % H), g = h / E; const long b = it / ((long)S * H); const long tok = b * S + t;
    const u16* q = B.QKV + tok * QKVW + O_Q + h * 64;
    float qr[64], o[64];
#pragma unroll
    for (int d = 0; d < 64; ++d) { qr[d] = bf2f(q[d]); o[d] = 0.f; }
    float m = -3.0e38f, l = 0.f; long k0 = t - 511; if (k0 < 0) k0 = 0;
    for (long kp = k0; kp <= t; ++kp) { const u16* k = B.QKV + (b * S + kp) * QKVW + O_KW + g * 64; const u16* v = B.QKV + (b * S + kp) * QKVW + O_VW + g * 64; float s = 0.f;
#pragma unroll
      for (int d = 0; d < 64; ++d) s += qr[d] * bf2f(k[d]);
      s *= 0.125f;
      if (s > m) { const float f = expf(m - s); l *= f;
#pragma unroll
        for (int d = 0; d < 64; ++d) o[d] *= f;
        m = s; }
      const float p = expf(s - m); l += p;
#pragma unroll
      for (int d = 0; d < 64; ++d) o[d] += p * bf2f(v[d]); }
    const float g2 = B.NG[tok * GW + h * 3 + 2]; const float inv = g2 / l;
#pragma unroll
    for (int d = 0; d < 64; ++d) { u16* y = B.YA + tok * QW + h * 64 + d; *y = f2bf(bf2f(*y) + o[d] * inv); } } };

struct SsdConv { u16* xbc; const float* cw; const float* cb;
  HD long items() const { return (long)NB * SCD; }
  HD void operator()(long it) const { const int c = (int)(it % SCD); const long b = it / SCD; u16* col = xbc + b * S * SCD + c; const float w0 = cw[c], w1 = cw[SCD + c], w2 = cw[2 * SCD + c], w3 = cw[3 * SCD + c], bias = cb[c];
    for (long t = S - 1; t >= 0; --t) { float a = bias + w3 * bf2f(col[t * SCD]); if (t >= 1) a += w2 * bf2f(col[(t - 1) * SCD]); if (t >= 2) a += w1 * bf2f(col[(t - 2) * SCD]); if (t >= 3) a += w0 * bf2f(col[(t - 3) * SCD]);
      col[t * SCD] = f2bf(siluf_(a)); } } };
struct SsdScan { Bufs B; const float* alog; const float* dskip;
  HD long items() const { return (long)NB * SH * SP; }
  HD void operator()(long it) const { const int p = (int)(it % SP); const int hh = (int)((it / SP) % SH); const long b = it / (SP * SH); const int g = hh / 8;
    const float a = -expf(alog[hh]); float st[128];
#pragma unroll
    for (int n = 0; n < 128; ++n) st[n] = 0.f;
    for (long t = 0; t < S; ++t) { const long tok = b * S + t; const float dt = B.DT[tok * SH + hh]; const float dec = expf(dt * a); const float xd = bf2f(B.XBC[tok * SCD + hh * 64 + p]) * dt;
      const u16* Bv = B.XBC + tok * SCD + SI + g * SN; const u16* Cv = B.XBC + tok * SCD + SI + SG * SN + g * SN; float y = 0.f;
#pragma unroll
      for (int n = 0; n < 128; ++n) { st[n] = st[n] * dec + xd * bf2f(Bv[n]); y += bf2f(Cv[n]) * st[n]; if ((n & 15) == 15) { NV_FENCE(); } }
      B.XBC[tok * SCD + hh * 64 + p] = f2bf(y + bf2f(B.XBC[tok * SCD + hh * 64 + p]) * dskip[hh]); } } };
struct SsdOut { Bufs B; const float* ngain;
  HD long items() const { return (long)NTOK * SG; }
  HD void operator()(long it) const { const long tok = it / SG; const int g = (int)(it % SG); float s = 0.f;
    for (int c = g * 512; c < g * 512 + 512; ++c) { float y = bf2f(B.XBC[tok * SCD + c]); y *= siluf_(bf2f(B.Z[tok * SI + c])); s += y * y; }
    const float rs = 1.0f / sqrtf(s / 512.f + EPS);
    for (int c = g * 512; c < g * 512 + 512; ++c) { float y = bf2f(B.XBC[tok * SCD + c]); y *= siluf_(bf2f(B.Z[tok * SI + c])); B.YB[tok * SI + c] = f2bf(y * rs * ngain[c]); } } };

struct Router { const u16* h2; const float* wg; const float* bg; const float* we; const float* be; int* ei; float* ew;
  HD void operator()(long tok) const { const u16* x = h2 + tok * DM; float gl[4];
#pragma unroll
    for (int j = 0; j < 4; ++j) gl[j] = bg[j];
    for (long d = 0; d < DM; ++d) { const float xv = bf2f(x[d]);
#pragma unroll
      for (int j = 0; j < 4; ++j) gl[j] += xv * wg[d * 4 + j]; }
    int gi = 0; float gm = gl[0];
#pragma unroll
    for (int j = 1; j < 4; ++j) if (gl[j] > gm) { gm = gl[j]; gi = j; }
    float gs = 0.f;
#pragma unroll
    for (int j = 0; j < 4; ++j) gs += expf(gl[j] - gm);
    const float grp_w = 1.0f / gs;
    float el[8];
#pragma unroll
    for (int j = 0; j < 8; ++j) el[j] = be[gi * 8 + j];
    for (long d = 0; d < DM; ++d) { const float xv = bf2f(x[d]);
#pragma unroll
      for (int j = 0; j < 8; ++j) el[j] += xv * we[d * NEXP + gi * 8 + j]; }
    int i0 = 0; float m0 = el[0];
#pragma unroll
    for (int j = 1; j < 8; ++j) if (el[j] > m0) { m0 = el[j]; i0 = j; }
    int i1 = -1; float m1 = -3.0e38f;
#pragma unroll
    for (int j = 0; j < 8; ++j) if (j != i0 && el[j] > m1) { m1 = el[j]; i1 = j; }
    const float r = expf(m1 - m0); const float w0 = 1.0f / (1.0f + r), w1 = r / (1.0f + r);
    ei[tok * 2] = gi * 8 + i0; ei[tok * 2 + 1] = gi * 8 + i1; ew[tok * 2] = grp_w * w0; ew[tok * 2 + 1] = grp_w * w1; } };
struct MoeHidden { const u16* h2; const float* wgate; const float* wup; const int* ei; u16* act;
  HD long items() const { return (long)NTOK * 2 * MH; }
  HD void operator()(long it) const { const int j = (int)(it % MH); const long tk = it / MH; const long tok = tk / 2; const int e = ei[tk]; const u16* x = h2 + tok * DM;
    const float* wg_ = wgate + (long)e * DM * MH + j; const float* wu_ = wup + (long)e * DM * MH + j; float a = 0.f, b = 0.f;
    for (long d = 0; d < DM; ++d) { const float xv = bf2f(x[d]); a += xv * wg_[d * MH]; b += xv * wu_[d * MH]; }
    act[it] = f2bf(siluf_(a) * b); } };
struct MoeDown { const u16* act; const float* wdown; const int* ei; const float* ew; float* x;
  HD long items() const { return (long)NTOK * DM; }
  HD void operator()(long it) const { const int c = (int)(it % DM); const long tok = it / DM; float tot = 0.f;
    for (int k = 0; k < 2; ++k) { const int e = ei[tok * 2 + k]; const u16* a = act + (tok * 2 + k) * MH; const float* w = wdown + (long)e * MH * DM + c; float s = 0.f;
      for (int j = 0; j < MH; ++j) s += bf2f(a[j]) * w[(long)j * DM];
      tot += ew[tok * 2 + k] * s; }
    x[it] += tot; } };

#define NV2_STAGE_PREP(RUN, I, B, out)      { nv::RmsRowsBf f{I.x, I.mix_norm, B.HB, nv::DM}; RUN(f, (long)nv::NTOK); }
#define NV2_STAGE_INPROJ(RUN, I, B, out)    { nv::GemmT<nv::ABf, nv::EpInProj> f{nv::ABf{B.HB, nv::DM}, I.w_in, nv::EpInProj{B, I.dt_bias}, nv::NTOK, nv::INW, nv::DM, nv::INW}; RUN(f, f.items()); }
#define NV2_STAGE_QKNORM(RUN, I, B, out)    { nv::QkNorm f{B.QKV, I.q_gain, I.ks_gain, I.kw_gain}; RUN(f, f.items()); }
#define NV2_STAGE_COMPRESS(RUN, I, B, out)  { \
    { nv::GemmT<nv::ACmp, nv::EpSiluF32> f{nv::ACmp{B.QKV, I.pos_k, nv::O_KC}, I.w1_k, nv::EpSiluF32{B.HID, 128}, (long)nv::NB * nv::G * nv::NCMP, 128, 2048, 128}; RUN(f, f.items()); } \
    { nv::GemmT<nv::AF32, nv::EpF32> f{nv::AF32{B.HID, 128}, I.w2_k, nv::EpF32{B.KTMP, 64}, (long)nv::NB * nv::G * nv::NCMP, 64, 128, 64}; RUN(f, f.items()); } \
    { nv::CmpFinish f{B.KTMP, I.kc_gain, B.KCMP, 1}; RUN(f, f.items()); } \
    { nv::GemmT<nv::ACmp, nv::EpSiluF32> f{nv::ACmp{B.QKV, I.pos_v, nv::O_VC}, I.w1_v, nv::EpSiluF32{B.HID, 128}, (long)nv::NB * nv::G * nv::NCMP, 128, 2048, 128}; RUN(f, f.items()); } \
    { nv::GemmT<nv::AF32, nv::EpF32> f{nv::AF32{B.HID, 128}, I.w2_v, nv::EpF32{B.KTMP, 64}, (long)nv::NB * nv::G * nv::NCMP, 64, 128, 64}; RUN(f, f.items()); } \
    { nv::CmpFinish f{B.KTMP, I.kc_gain, B.VCMP, 0}; RUN(f, f.items()); } }
#define NV2_STAGE_ATTN(RUN, I, B, out)      { \
    { nv::CmpAttn f{B}; RUN(f, f.items()); } { nv::Importance f{B}; RUN(f, f.items()); } { nv::TopSel f{B}; RUN(f, f.items()); } { nv::SelAttn f{B}; RUN(f, f.items()); } { nv::WinAttn f{B}; RUN(f, f.items()); } }
#define NV2_STAGE_SSD(RUN, I, B, out)       { \
    { nv::SsdConv f{B.XBC, I.conv_w, I.conv_b}; RUN(f, f.items()); } { nv::SsdScan f{B, I.a_log, I.d_skip}; RUN(f, f.items()); } { nv::SsdOut f{B, I.ssm_norm}; RUN(f, f.items()); } }
#define NV2_STAGE_MERGE(RUN, I, B, out)     { \
    { nv::GemmT<nv::ABf, nv::EpBf> f{nv::ABf{B.YA, nv::QW}, I.w_a, nv::EpBf{B.T1, nv::DM}, nv::NTOK, nv::DM, nv::QW, nv::DM}; RUN(f, f.items()); } \
    { nv::GemmT<nv::ABf, nv::EpMerge> f{nv::ABf{B.YB, nv::SI}, I.w_b, nv::EpMerge{B.T1, B.BG, B.MERGED}, nv::NTOK, nv::DM, nv::SI, nv::DM}; RUN(f, f.items()); } \
    { nv::GemmT<nv::ABf, nv::EpResid> f{nv::ABf{B.MERGED, nv::DM}, I.w_out, nv::EpResid{I.x, out}, nv::NTOK, nv::DM, nv::DM, nv::DM}; RUN(f, f.items()); } }
#define NV2_STAGE_MOE(RUN, I, B, out)       { \
    { nv::RmsRowsBf f{out, I.moe_norm, B.H2, nv::DM}; RUN(f, (long)nv::NTOK); } \
    { nv::Router f{B.H2, I.w_group, I.b_group, I.w_expert, I.b_expert, B.EI, B.EW}; RUN(f, (long)nv::NTOK); } \
    { nv::MoeHidden f{B.H2, I.w_gate, I.w_up, B.EI, B.ACT}; RUN(f, f.items()); } \
    { nv::MoeDown f{B.ACT, I.w_down, B.EI, B.EW, out}; RUN(f, f.items()); } }
#define NV2_STAGE_PLE(RUN, I, B, out)       { \
    { nv::RmsRowsBf f{out, I.ple_norm, B.H2, nv::DM}; RUN(f, (long)nv::NTOK); } \
    { nv::GemmT<nv::AF32, nv::EpBf> f{nv::AF32{I.p, nv::PLE}, I.ple_wp, nv::EpBf{B.PP, nv::DM}, nv::NTOK, nv::DM, nv::PLE, nv::DM}; RUN(f, f.items()); } \
    { nv::GemmT<nv::ABf, nv::EpPle> f{nv::ABf{B.H2, nv::DM}, I.ple_wg, nv::EpPle{out, B.PP}, nv::NTOK, nv::DM, nv::DM, nv::DM}; RUN(f, f.items()); } }

HD size_t carve(Bufs& B, unsigned char* ws, float* out) {
  size_t off = 0; auto take = [&](size_t bytes) { unsigned char* r = ws + off; off += (bytes + 255) / 256 * 256; return r; };
  const size_t N = NTOK;
  B.BG = (u16*)out;
  unsigned char* R0 = take(N * DM * 2);
  unsigned char* R5 = take(N * 2 * MH * 2 + (size_t)NEXP * 256 * MH * 2);
  B.YA = (u16*)take(N * QW * 2);
  unsigned char* R1 = take(N * QKVW * 2);
  unsigned char* R2 = take(N * SI * 2);
  unsigned char* R3 = take(N * SCD * 2);
  B.HB = (u16*)R0; B.H2 = (u16*)R0; B.QKV = (u16*)R1; B.T1 = (u16*)R1; B.Z = (u16*)R2; B.XBC = (u16*)R3; B.MERGED = (u16*)R3; B.PP = (u16*)R3;
  B.ACT = (u16*)R5; B.YB = B.Z;
  B.NG = (float*)take(N * GW * 4); B.DT = (float*)take(N * SH * 4);
  B.KCMP = (u16*)take((size_t)NB * G * NCP * 64 * 2); B.VCMP = (u16*)take((size_t)NB * G * NCP * 64 * 2);
  B.EI = (int*)take(N * 2 * 4); B.EW = (float*)take(N * 2 * 4);
  B.HID = (float*)take((size_t)NB * G * NCMP * 128 * 4); B.KTMP = (float*)take((size_t)NB * G * NCMP * 64 * 4);
  B.ML = (float*)take(N * H * 2 * 4); B.IMP = (float*)take((size_t)NB * G * S * 64 * 4); B.MASK = (u64*)take((size_t)NB * G * S * 8);
  return off;
}
}
namespace xb {
#define LAS __attribute__((address_space(3)))
#define XB_TMO      128
#define XB_XCNT(j)  (256  + 64 * (j))
#define XB_XSUB(j)  (1280 + 64 * (j))
#define XB_XGEN(j)  (2304 + 64 * (j))
#define XB_TOP      3328
#define XB_TOPGEN   3392
#define XCD_BAR_WORDS 3456
#define XB_SPIN_CAP (1u << 22)

__device__ __forceinline__ unsigned xb_ld(unsigned* p)              { return __hip_atomic_load(p, __ATOMIC_RELAXED, __HIP_MEMORY_SCOPE_AGENT); }
__device__ __forceinline__ unsigned xb_add(unsigned* p, unsigned v) { return __hip_atomic_fetch_add(p, v, __ATOMIC_RELAXED, __HIP_MEMORY_SCOPE_AGENT); }
__device__ __forceinline__ unsigned xb_xcc_id() { return (unsigned)__builtin_amdgcn_s_getreg((3 << 11) | 20) & 0xFu; }
#define XB_SPIN(cond, bar) do { unsigned _sp = 0; while (cond) { __builtin_amdgcn_s_sleep(1); \
    if ((++_sp & 255u) == 0u) { if (xb_ld(&(bar)[XB_TMO])) break; if (_sp > XB_SPIN_CAP) { atomicAdd(&(bar)[XB_TMO], 1u); break; } } } } while (0)

struct XcdBarrier {
    unsigned* bar; unsigned x;
    volatile LAS unsigned* st;
};

__device__ __forceinline__ XcdBarrier xcd_barrier_post(unsigned* bar, volatile LAS unsigned* st) {
    XcdBarrier b; b.bar = bar; b.x = xb_xcc_id(); b.st = st;
    if (threadIdx.x == 0) (void)xb_add(&bar[XB_XCNT(b.x)], 1u);
    return b;
}
__device__ __forceinline__ void xcd_barrier_complete(unsigned* bar, unsigned x, unsigned& nloc, unsigned& nx) {
    const unsigned G = gridDim.x * gridDim.y * gridDim.z;
    unsigned sum, cnt, mine, sp = 0u;
    for (;;) {
        sum = 0u; cnt = 0u; mine = 0u;
#pragma unroll
        for (unsigned j = 0; j < 16; ++j) { const unsigned c = xb_ld(&bar[XB_XCNT(j)]); sum += c; cnt += (c > 0u) ? 1u : 0u; mine = (j == x) ? c : mine; }
        if (sum == G) break;
        __builtin_amdgcn_s_sleep(1);
        if ((++sp & 255u) == 0u) { if (xb_ld(&bar[XB_TMO])) break; if (sp > XB_SPIN_CAP) { atomicAdd(&bar[XB_TMO], 1u); break; } }
    }
    nloc = mine > 0u ? mine : 1u; nx = cnt > 0u ? cnt : 1u;
}

__device__ __forceinline__ void xcd_barrier(const XcdBarrier& b) {
    asm volatile("s_waitcnt vmcnt(0)" ::: "memory");
    __syncthreads();
    if (threadIdx.x == 0) {
        unsigned* bar = b.bar;
        __builtin_amdgcn_s_waitcnt(0);
        unsigned nloc = b.st[0], nx = b.st[1];
        if (nloc == 0u) { xcd_barrier_complete(bar, b.x, nloc, nx); b.st[0] = nloc; b.st[1] = nx; }
        const unsigned old = xb_add(&bar[XB_XSUB(b.x)], 1u);
        const unsigned gen = old / nloc;
        if (old + 1u == (gen + 1u) * nloc) {
            __builtin_amdgcn_fence(__ATOMIC_RELEASE, "agent");
            asm volatile("s_waitcnt vmcnt(0)" ::: "memory");
            const unsigned og = xb_add(&bar[XB_TOP], 1u);
            const unsigned tg = og / nx;
            if (og + 1u == (tg + 1u) * nx) xb_add(&bar[XB_TOPGEN], 1u);
            else XB_SPIN(xb_ld(&bar[XB_TOPGEN]) == tg, bar);
            __builtin_amdgcn_fence(__ATOMIC_ACQUIRE, "agent");
            xb_add(&bar[XB_XGEN(b.x)], 1u);
            asm volatile("s_waitcnt vmcnt(0)" ::: "memory");
        } else {
            XB_SPIN(xb_ld(&bar[XB_XGEN(b.x)]) == gen, bar);
            __builtin_amdgcn_fence(__ATOMIC_ACQUIRE, "agent");
            asm volatile("s_waitcnt vmcnt(0)" ::: "memory");
        }
    }
    __syncthreads();
}
}
namespace pg8 {
#define PG8_LAS __attribute__((address_space(3)))
typedef unsigned short bf16_t;
typedef short bf16x8 __attribute__((ext_vector_type(8)));
typedef float f32x4 __attribute__((ext_vector_type(4)));
typedef unsigned u32x4 __attribute__((ext_vector_type(4)));
typedef unsigned u32x2 __attribute__((ext_vector_type(2)));
constexpr int BM = 256, BK = 64, HALF = 128, HTB = HALF * BK * 2  , STAGE_BYTES = 8 * HTB, NXCD = 8, WGM = 8;

__host__ __device__ __forceinline__ int lds_byte(int r, int c) { const int st = (r >> 4) * 2 + (c >> 5), rr = r & 15, cc = c & 31, ob = rr * 64 + cc * 2; return st * 1024 + (ob ^ (((ob >> 9) & 1) << 5)); }
__host__ __device__ __forceinline__ void stage_rc(int b, int& R, int& C) { const int st = b / 1024, sb = b % 1024, swz = sb ^ (((sb >> 9) & 1) << 5); R = (st >> 1) * 16 + swz / 64; C = (st & 1) * 32 + (swz % 64) / 2; }
__host__ __device__ __forceinline__ int perm32(int rho) { const int n = rho >> 4, i = rho & 15; return 8 * (i >> 2) + 4 * n + (i & 3); }

struct Unit { int pm, pn, aux0, aux1; };
struct Gemm { const bf16_t* A; const bf16_t* Bt; int M, N, K, lda, ldb, kstepA; };

struct StaticOrder {
    int nM, nN, nwg, G, c;
    __device__ void init(int M, int N, int G_, int c_) { nM = M / BM; nN = N / BM; nwg = nM * nN; G = G_; c = c_; }
    __device__ bool next(int i, Unit& u) const {
        const long L = (long)i * G + c; if (L >= nwg) return false;
        int wgid = (int)L; { const int q = nwg / NXCD, r = nwg % NXCD, xcd = wgid % NXCD, off = wgid / NXCD; wgid = (xcd < r ? xcd * (q + 1) : r * (q + 1) + (xcd - r) * q) + off; }
        const int nig = WGM * nN, gid = wgid / nig, fm = gid * WGM, gsz = (nM - fm) < WGM ? (nM - fm) : WGM;
        u.pm = fm + ((wgid % nig) % gsz); u.pn = (wgid % nig) / gsz; u.aux0 = 0; u.aux1 = 0; return true;
    }
    __device__ __forceinline__ const char* a_base(const Gemm& g, const Unit& u) const { return (const char*)g.A + (size_t)u.pm * BM * g.lda * 2; }
    __device__ __forceinline__ const char* b_base(const Gemm& g, const Unit& u) const { return (const char*)g.Bt + (size_t)u.pn * BM * g.ldb * 2; }
    __device__ __forceinline__ int a_row(const Unit&, int) const { return 0; }
};

typedef float f32x2_t __attribute__((ext_vector_type(2))); typedef __bf16 bf16x2_t __attribute__((ext_vector_type(2)));
__device__ __forceinline__ unsigned cvt_pk_bf16(float lo, float hi) { f32x2_t v = {lo, hi}; bf16x2_t b = __builtin_convertvector(v, bf16x2_t); return __builtin_bit_cast(unsigned, b); }


template <class Epi, class Sched, bool ALIGN_EPI = true, bool GATHER = false>
__device__ __forceinline__ void gemm_phase(PG8_LAS unsigned char* lds, const Gemm g, const Sched& S, const Epi& E) {
    int tid_ = threadIdx.x; asm volatile("" : "+v"(tid_));
    const int tid = tid_, wid = __builtin_amdgcn_readfirstlane(tid >> 6), lane = tid & 63, wr = wid >> 2, wc = wid & 3, fr = lane & 15, fq = lane >> 4;
    const int K = g.K, nt = K / BK;
    unsigned voffA[2], voffA1[2], voffB[2];
    int RA[2], CA[2];
#pragma unroll
    for (int i = 0; i < 2; ++i) { int R, C; stage_rc(tid * 16 + i * 8192, R, C); const int Rb = Epi::PERM ? ((R & ~31) + perm32(R & 31)) : R;
        RA[i] = R; CA[i] = C; voffA[i] = (unsigned)(R * g.lda + C) * 2u; voffA1[i] = voffA[i]; voffB[i] = (unsigned)(Rb * g.ldb + C) * 2u; }
    const size_t kstep = (size_t)(BK * 2);
    const size_t kstepA = (size_t)g.kstepA;
    const size_t hstepA = GATHER ? (size_t)0 : (size_t)HALF * g.lda * 2;
    const size_t hstepB = (size_t)HALF * g.ldb * 2;
    const unsigned ldsw = (unsigned)wid * 1024u;
    const int aoff = lds_byte(wr * 64 + fr, fq * 8), boff = lds_byte(wc * 32 + fr, fq * 8);
#define PG8_SA(b, h) (((b) * 2 + (h)) * HTB)
#define PG8_SB(b, h) ((4 + (b) * 2 + (h)) * HTB)
#define PG8_STAGE(bufoff, gbase, voff) do { _Pragma("unroll") for (int _i = 0; _i < 2; ++_i) \
        __builtin_amdgcn_global_load_lds((const unsigned*)((const char*)(gbase) + (voff)[_i]), (PG8_LAS unsigned*)(lds + (bufoff) + ldsw + _i * 8192), 16, 0, 0); } while (0)
#define PG8_STAGE_A0(bufoff, gbase) PG8_STAGE(bufoff, gbase, voffA)
#define PG8_STAGE_A1(bufoff, gbase) do { if constexpr (GATHER) { PG8_STAGE(bufoff, gbase, voffA1); } else { PG8_STAGE(bufoff, (gbase) + hstepA, voffA); } } while (0)
#define PG8_LDA(dst, b, h) do { _Pragma("unroll") for (int m = 0; m < 4; ++m) _Pragma("unroll") for (int k = 0; k < 2; ++k) dst[m][k] = *(const PG8_LAS bf16x8*)(lds + PG8_SA(b, h) + aoff + m * 2048 + k * 1024); } while (0)
#define PG8_LDB(dst, b, h) do { _Pragma("unroll") for (int n = 0; n < 2; ++n) _Pragma("unroll") for (int k = 0; k < 2; ++k) dst[n][k] = *(const PG8_LAS bf16x8*)(lds + PG8_SB(b, h) + boff + n * 2048 + k * 1024); } while (0)
#define PG8_MMA(ai, bj, At, Bt) do { __builtin_amdgcn_s_setprio(1); _Pragma("unroll") for (int m = 0; m < 4; ++m) _Pragma("unroll") for (int n = 0; n < 2; ++n) _Pragma("unroll") for (int k = 0; k < 2; ++k) \
        acc[ai][bj][m][n] = __builtin_amdgcn_mfma_f32_16x16x32_bf16(Bt[n][k], At[m][k], acc[ai][bj][m][n], 0, 0, 0); __builtin_amdgcn_s_setprio(0); } while (0)
#define PG8_WAIT_V(n) asm volatile("s_waitcnt vmcnt(" #n ")" ::: "memory")
#define PG8_WAIT_L(n) asm volatile("s_waitcnt lgkmcnt(" #n ")" ::: "memory")
#define PG8_BAR __builtin_amdgcn_s_barrier()
#define PG8_SCHED __builtin_amdgcn_sched_barrier(0)
    Unit cur, nxt; int ui = 0;
    if (!S.next(0, cur)) return;
    if constexpr (GATHER) {
#pragma unroll
        for (int i = 0; i < 2; ++i) { voffA[i] = (unsigned)(S.a_row(cur, RA[i]) * g.lda + CA[i]) * 2u; voffA1[i] = (unsigned)(S.a_row(cur, HALF + RA[i]) * g.lda + CA[i]) * 2u; }
    }
    f32x4 acc[2][2][4][2];
#pragma unroll
    for (int a = 0; a < 2; ++a)
#pragma unroll
        for (int b = 0; b < 2; ++b)
#pragma unroll
            for (int m = 0; m < 4; ++m)
#pragma unroll
                for (int n = 0; n < 2; ++n) acc[a][b][m][n] = (f32x4){0.f, 0.f, 0.f, 0.f};
    bf16x8 At[4][2], B0[2][2], B1[2][2];
    const char* cA = S.a_base(g, cur); const char* cB = S.b_base(g, cur);
    PG8_STAGE(PG8_SB(0, 0), cB, voffB); PG8_STAGE(PG8_SB(0, 1), cB + hstepB, voffB); PG8_STAGE_A0(PG8_SA(0, 0), cA); PG8_STAGE_A1(PG8_SA(0, 1), cA);
    if (wr == 1) PG8_BAR;
    PG8_WAIT_V(2); PG8_BAR;
    PG8_STAGE(PG8_SB(1, 0), cB + kstep, voffB); PG8_STAGE_A0(PG8_SA(1, 0), cA + kstepA); PG8_STAGE(PG8_SB(1, 1), cB + hstepB + kstep, voffB);
    PG8_WAIT_V(6); PG8_BAR;
    for (;;) {
        const bool has_next = GATHER ? false : S.next(ui + 1, nxt);
        const char* nA = has_next ? S.a_base(g, nxt) : cA; const char* nB = has_next ? S.b_base(g, nxt) : cB;
#pragma unroll 1
        for (int t = 0; t < nt; t += 2) {
            const bool last = (t == nt - 2);
            const char* a1 = cA + (size_t)(t + 1) * kstepA;
            const char* a2 = last ? nA : cA + (size_t)(t + 2) * kstepA; const char* b2 = last ? nB : cB + (size_t)(t + 2) * kstep;
            const char* a3 = a2 + kstepA; const char* b3 = b2 + kstep;
            PG8_LDB(B0, 0, 0); PG8_LDB(B1, 0, 1); PG8_SCHED; PG8_LDA(At, 0, 0); PG8_STAGE_A1(PG8_SA(1, 1), a1);
            PG8_WAIT_V(8); PG8_WAIT_L(0); PG8_BAR; PG8_MMA(0, 0, At, B0); PG8_MMA(0, 1, At, B1); PG8_BAR; PG8_SCHED;
            PG8_LDA(At, 0, 1); PG8_STAGE(PG8_SB(0, 0), b2, voffB); PG8_STAGE(PG8_SB(0, 1), b2 + hstepB, voffB); PG8_STAGE_A0(PG8_SA(0, 0), a2);
            PG8_WAIT_V(8); PG8_WAIT_L(0); PG8_BAR; PG8_MMA(1, 0, At, B0); PG8_MMA(1, 1, At, B1); PG8_BAR; PG8_SCHED;
            PG8_LDB(B0, 1, 0); PG8_LDB(B1, 1, 1); PG8_SCHED; PG8_LDA(At, 1, 0); PG8_STAGE_A1(PG8_SA(0, 1), a2);
            PG8_WAIT_V(8); PG8_WAIT_L(0); PG8_BAR; PG8_MMA(0, 0, At, B0); PG8_MMA(0, 1, At, B1); PG8_BAR; PG8_SCHED;
            PG8_LDA(At, 1, 1); PG8_STAGE(PG8_SB(1, 0), b3, voffB); PG8_STAGE(PG8_SB(1, 1), b3 + hstepB, voffB); PG8_STAGE_A0(PG8_SA(1, 0), a3);
            PG8_WAIT_V(8); PG8_WAIT_L(0); PG8_BAR; PG8_MMA(1, 0, At, B0); PG8_MMA(1, 1, At, B1); PG8_BAR; PG8_SCHED;
        }
        if constexpr (ALIGN_EPI) { if (wr == 0) PG8_BAR; }
        E(acc, cur, wr, wc, fr, fq);
        if (!has_next) break;
#pragma unroll
        for (int a = 0; a < 2; ++a)
#pragma unroll
            for (int b = 0; b < 2; ++b)
#pragma unroll
                for (int m = 0; m < 4; ++m)
#pragma unroll
                    for (int n = 0; n < 2; ++n) acc[a][b][m][n] = (f32x4){0.f, 0.f, 0.f, 0.f};
        cur = nxt; cA = nA; cB = nB; ++ui;
        if constexpr (ALIGN_EPI) { if (wr == 1) PG8_BAR; }
    }
    PG8_WAIT_V(0);
    if constexpr (!ALIGN_EPI) { if (wr == 0) PG8_BAR; }
    PG8_BAR;
#undef PG8_SA
#undef PG8_SB
#undef PG8_STAGE
#undef PG8_STAGE_A0
#undef PG8_STAGE_A1
#undef PG8_LDA
#undef PG8_LDB
#undef PG8_MMA
#undef PG8_WAIT_V
#undef PG8_WAIT_L
#undef PG8_BAR
#undef PG8_SCHED
}
}
namespace fx {
using nv::u16; using nv::Bufs; using nv::Inputs;
using pg8::f32x4; using pg8::u32x4; using pg8::Unit;
#define LAS __attribute__((address_space(3)))
static_assert(nv::DM == 1024 && nv::NB == 8 && nv::S == 4096 && nv::MH == 256 && nv::PLE == 256, "fast phases are written for the full-size problem");
constexpr int NTOK = nv::NTOK, DM = 1024;
constexpr int INW_PAD = 6144;
constexpr int C_Z = 1280, C_XBC = 2304, C_BG = 3840, C_NG = 5888, C_DT = 5912, C_END = 5928;

struct WBufs { u16 *WinT, *WaT, *WbT, *WoutT, *PleGT, *PlePT, *WguT, *WdT, *PB; };
__host__ __device__ inline size_t carve_w(WBufs& W, unsigned char* ws, size_t off) {
  auto take = [&](size_t bytes) { unsigned char* r = ws + off; off += (bytes + 255) / 256 * 256; return r; };
  W.WinT = (u16*)take((size_t)INW_PAD * 1024 * 2); W.WaT = (u16*)take((size_t)1024 * 512 * 2); W.WbT = (u16*)take((size_t)1024 * 1024 * 2); W.WoutT = (u16*)take((size_t)1024 * 1024 * 2);
  W.PleGT = (u16*)take((size_t)1024 * 1024 * 2); W.PlePT = (u16*)take((size_t)1024 * 256 * 2); W.WguT = (u16*)take((size_t)32 * 512 * 1024 * 2); W.WdT = (u16*)take((size_t)32 * 1024 * 256 * 2);
  W.PB = (u16*)take((size_t)NTOK * 256 * 2);
  return off;
}

__device__ __forceinline__ int otid() { int t = threadIdx.x; asm volatile("" : "+v"(t)); return t; }
__device__ __forceinline__ int obid() { int b = blockIdx.x; asm volatile("" : "+s"(b)); return b; }
__device__ __forceinline__ float fsig(float x) { return __builtin_amdgcn_rcpf(1.0f + __expf(-x)); }
__device__ __forceinline__ float fsoftplus(float x) { const float e = __expf(x); return x > 20.f ? x : (e < 0.0625f ? e * (1.f - e * (0.5f - e * (0.33333333f - 0.25f * e))) : __logf(1.0f + e)); }
__device__ __forceinline__ unsigned pk2(float lo, float hi) { return pg8::cvt_pk_bf16(lo, hi); }
__device__ __forceinline__ void store8(u16* p, const float (&v)[8]) { u32x4 w; w.x = pk2(v[0], v[1]); w.y = pk2(v[2], v[3]); w.z = pk2(v[4], v[5]); w.w = pk2(v[6], v[7]); *(u32x4*)p = w; }
__device__ __forceinline__ void load8(const u16* p, float (&v)[8]) { const u32x4 w = *(const u32x4*)p;
  v[0] = __uint_as_float(w.x << 16); v[1] = __uint_as_float(w.x & 0xffff0000u); v[2] = __uint_as_float(w.y << 16); v[3] = __uint_as_float(w.y & 0xffff0000u);
  v[4] = __uint_as_float(w.z << 16); v[5] = __uint_as_float(w.z & 0xffff0000u); v[6] = __uint_as_float(w.w << 16); v[7] = __uint_as_float(w.w & 0xffff0000u); }

__device__ __forceinline__ float wave_sum(float v) {
#pragma unroll
  for (int o = 1; o < 64; o <<= 1) v += __shfl_xor(v, o);
  return v; }
__device__ __forceinline__ void rms_row_to_bf16(const float* xrow, const float* gain, u16* orow, int lane) {
  const f32x4* xr = (const f32x4*)xrow + lane; const f32x4* gr = (const f32x4*)gain + lane;
  f32x4 v[4]; float s = 0.f;
#pragma unroll
  for (int j = 0; j < 4; ++j) { v[j] = xr[64 * j]; s += (v[j].x * v[j].x + v[j].y * v[j].y) + (v[j].z * v[j].z + v[j].w * v[j].w); }
  const float rs = 1.0f / sqrtf(wave_sum(s) * (1.f / 1024.f) + nv::EPS);
  unsigned long long* o8 = (unsigned long long*)orow + lane;
#pragma unroll
  for (int j = 0; j < 4; ++j) { const f32x4 g = gr[64 * j]; o8[64 * j] = (unsigned long long)pk2(v[j].x * rs * g.x, v[j].y * rs * g.y) | ((unsigned long long)pk2(v[j].z * rs * g.z, v[j].w * rs * g.w) << 32); }
}
__device__ __forceinline__ void phase_rms_rows(const float* x, const float* gain, u16* out) {
  const int tid = otid(), lane = tid & 63, gw = obid() * 8 + (tid >> 6), ngw = gridDim.x * 8;
  for (int r = gw; r < NTOK; r += 4 * ngw) { f32x4 v[4][4]; float s[4];
#pragma unroll
    for (int q = 0; q < 4; ++q) { const int rq = (r + q * ngw < NTOK) ? r + q * ngw : r; const f32x4* xr = (const f32x4*)(x + (size_t)rq * 1024) + lane;
#pragma unroll
      for (int j = 0; j < 4; ++j) v[q][j] = xr[64 * j]; }
#pragma unroll
    for (int q = 0; q < 4; ++q) { s[q] = 0.f;
#pragma unroll
      for (int j = 0; j < 4; ++j) s[q] += (v[q][j].x * v[q][j].x + v[q][j].y * v[q][j].y) + (v[q][j].z * v[q][j].z + v[q][j].w * v[q][j].w);
      s[q] = 1.0f / sqrtf(wave_sum(s[q]) * (1.f / 1024.f) + nv::EPS); }
#pragma unroll
    for (int q = 0; q < 4; ++q) { if (r + q * ngw >= NTOK) break; unsigned long long* o8 = (unsigned long long*)(out + (size_t)(r + q * ngw) * 1024) + lane; const f32x4* gr = (const f32x4*)gain + lane;
#pragma unroll
      for (int j = 0; j < 4; ++j) { const f32x4 g = gr[64 * j]; o8[64 * j] = (unsigned long long)pk2(v[q][j].x * s[q] * g.x, v[q][j].y * s[q] * g.y) | ((unsigned long long)pk2(v[q][j].z * s[q] * g.z, v[q][j].w * s[q] * g.w) << 32); } } }
}
template <class CP> __device__ __forceinline__ void transpose_item(LAS float* scr, const CP cp, u16* dst, int K, int n0, int k0, int lane) {
  { const float* p = cp(n0 + (lane & 31));
#pragma unroll 8
    for (int i = 0; i < 32; ++i) { const int kk = 2 * i + (lane >> 5); scr[kk * 33 + (lane & 31)] = p ? p[(size_t)(k0 + kk) * cp.ld] : 0.f; } }
  asm volatile("s_waitcnt lgkmcnt(0)" ::: "memory");
  const int c = lane & 7;
#pragma unroll
  for (int j = 0; j < 4; ++j) { const int n = (lane >> 3) + 8 * j; const LAS float* s = scr + (8 * c) * 33 + n;
    u32x4 o; o.x = pk2(s[0 * 33], s[1 * 33]); o.y = pk2(s[2 * 33], s[3 * 33]); o.z = pk2(s[4 * 33], s[5 * 33]); o.w = pk2(s[6 * 33], s[7 * 33]);
    *(u32x4*)(dst + (size_t)(n0 + n) * K + k0 + 8 * c) = o; }
  asm volatile("s_waitcnt lgkmcnt(0)" ::: "memory");
}
struct CpIdent { const float* src; int ld; __device__ const float* operator()(int n) const { return src + n; } };
struct CpInProj { const float* src; int ld; __device__ const float* operator()(int n) const {
  int c; if (n < C_Z) c = n; else if (n < C_XBC) c = nv::O_Z + (n - C_Z); else if (n < C_BG) c = nv::O_XBC + (n - C_XBC); else if (n < C_NG) c = nv::O_BG + (n - C_BG); else if (n < C_DT) c = nv::O_NG + (n - C_NG); else if (n < C_END) c = nv::O_DT + (n - C_DT); else return nullptr;
  return src + c; } };
struct CpGU { const float* gate; long updelta; int ld; __device__ const float* operator()(int n) const { const int tile = n >> 8, r = n & 255; return gate + (r < 128 ? 0L : updelta) + tile * 128 + (r & 127); } };

struct WJob { const float* src; int ld; u16* dst; int K, n0, k0; };
__device__ __forceinline__ WJob wjob_decode(int t, const Inputs& I, const WBufs& W, int lane) {
  constexpr int T_IN = (INW_PAD / 32) * 16, T_A = 32 * 8, T_B = 32 * 16, T_O = 32 * 16, T_PG = 32 * 16, T_PP = 32 * 4, T_GU = 32 * 16 * 16;
  WJob j; int r = t; const int c = lane & 31;
  if (r < T_IN) { CpInProj cp{I.w_in, nv::INW}; j.n0 = (r / 16) * 32; j.k0 = (r % 16) * 64; j.src = cp(j.n0 + c); j.ld = nv::INW; j.dst = W.WinT; j.K = 1024; return j; } r -= T_IN;
  if (r < T_A) { j.n0 = (r / 8) * 32; j.k0 = (r % 8) * 64; j.src = I.w_a + j.n0 + c; j.ld = 1024; j.dst = W.WaT; j.K = 512; return j; } r -= T_A;
  if (r < T_B) { j.n0 = (r / 16) * 32; j.k0 = (r % 16) * 64; j.src = I.w_b + j.n0 + c; j.ld = 1024; j.dst = W.WbT; j.K = 1024; return j; } r -= T_B;
  if (r < T_O) { j.n0 = (r / 16) * 32; j.k0 = (r % 16) * 64; j.src = I.w_out + j.n0 + c; j.ld = 1024; j.dst = W.WoutT; j.K = 1024; return j; } r -= T_O;
  if (r < T_PG) { j.n0 = (r / 16) * 32; j.k0 = (r % 16) * 64; j.src = I.ple_wg + j.n0 + c; j.ld = 1024; j.dst = W.PleGT; j.K = 1024; return j; } r -= T_PG;
  if (r < T_PP) { j.n0 = (r / 4) * 32; j.k0 = (r % 4) * 64; j.src = I.ple_wp + j.n0 + c; j.ld = 1024; j.dst = W.PlePT; j.K = 256; return j; } r -= T_PP;
  if (r < T_GU) { const int e = r / 256, q = r % 256; CpGU cp{I.w_gate + (size_t)e * 1024 * 256, (long)(I.w_up - I.w_gate), 256}; j.n0 = (q / 16) * 32; j.k0 = (q % 16) * 64; j.src = cp(j.n0 + c); j.ld = 256; j.dst = W.WguT + (size_t)e * 512 * 1024; j.K = 1024; return j; } r -= T_GU;
  { const int e = r / 128, q = r % 128; j.n0 = (q / 4) * 32; j.k0 = (q % 4) * 64; j.src = I.w_down + (size_t)e * 256 * 1024 + j.n0 + c; j.ld = 1024; j.dst = W.WdT + (size_t)e * 1024 * 256; j.K = 256; return j; }
}
__device__ __forceinline__ void phase_prologue(LAS unsigned char* lds, const Inputs& I, const Bufs& B, const WBufs& W) {
  const int tid = otid(), lane = tid & 63, wv = tid >> 6, gw = obid() * 8 + wv, ngw = gridDim.x * 8;
  LAS float* scr = (LAS float*)lds + wv * (64 * 33);
  constexpr int TOT = (INW_PAD / 32) * 16 + 32 * 8 + 32 * 16 * 3 + 32 * 4 + 32 * 16 * 16 + 32 * 32 * 4;
  float cur[32];
  int t = gw; WJob jb;
  if (t < TOT) { jb = wjob_decode(t, I, W, lane);
#pragma unroll
    for (int i = 0; i < 32; ++i) cur[i] = jb.src ? jb.src[(size_t)(jb.k0 + 2 * i + (lane >> 5)) * jb.ld] : 0.f; }
  while (t < TOT) { const int tn = t + ngw; WJob jn = jb; float nxt[32];
    if (tn < TOT) { jn = wjob_decode(tn, I, W, lane);
#pragma unroll
      for (int i = 0; i < 32; ++i) nxt[i] = jn.src ? jn.src[(size_t)(jn.k0 + 2 * i + (lane >> 5)) * jn.ld] : 0.f; }
#pragma unroll
    for (int i = 0; i < 32; ++i) scr[(2 * i + (lane >> 5)) * 33 + (lane & 31)] = cur[i];
    asm volatile("s_waitcnt lgkmcnt(0)" ::: "memory");
    { const int c = lane & 7;
#pragma unroll
      for (int j = 0; j < 4; ++j) { const int n = (lane >> 3) + 8 * j; const LAS float* s = scr + (8 * c) * 33 + n;
        u32x4 o; o.x = pk2(s[0 * 33], s[1 * 33]); o.y = pk2(s[2 * 33], s[3 * 33]); o.z = pk2(s[4 * 33], s[5 * 33]); o.w = pk2(s[6 * 33], s[7 * 33]);
        *(u32x4*)(jb.dst + (size_t)(jb.n0 + n) * jb.K + jb.k0 + 8 * c) = o; } }
    asm volatile("s_waitcnt lgkmcnt(0)" ::: "memory");
    if (tn < TOT) {
#pragma unroll
      for (int i = 0; i < 32; ++i) cur[i] = nxt[i]; }
    jb = jn; t = tn; }
}
__device__ __forceinline__ void prologue_pb(const Inputs& I, const WBufs& W) {
  for (long i = blockIdx.x * 512L + otid(); i < (long)NTOK * 256 / 8; i += (long)gridDim.x * 512L) { const f32x4 a = ((const f32x4*)I.p)[2 * i], b = ((const f32x4*)I.p)[2 * i + 1];
    u32x4 o; o.x = pk2(a.x, a.y); o.y = pk2(a.z, a.w); o.z = pk2(b.x, b.y); o.w = pk2(b.z, b.w); ((u32x4*)W.PB)[i] = o; }
}

template <class F> struct Epi8 { static constexpr bool PERM = true; F f;
  __device__ __forceinline__ void operator()(const f32x4 (&acc)[2][2][4][2], const Unit& u, int wr, int wc, int fr, int fq) const {
#pragma unroll
    for (int ai = 0; ai < 2; ++ai)
#pragma unroll
      for (int m = 0; m < 4; ++m) { const int row = u.pm * 256 + ai * 128 + wr * 64 + m * 16 + fr;
#pragma unroll
        for (int bj = 0; bj < 2; ++bj) { const int col = u.pn * 256 + bj * 128 + wc * 32 + 8 * fq; const f32x4 a = acc[ai][bj][m][0], b = acc[ai][bj][m][1];
          const float v[8] = {a.x, a.y, a.z, a.w, b.x, b.y, b.z, b.w}; f(u, row, col, v); }
        if (m & 1) asm volatile("" ::: "memory"); } } };

struct FInProj { u16* QKV; u16* Z; u16* XBC; u16* BG; float* NG; float* DT; const float* dt_bias;
  __device__ __forceinline__ void operator()(const Unit&, int r, int c, const float (&v)[8]) const {
    if (c < C_Z) store8(QKV + (size_t)r * 1280 + c, v);
    else if (c < C_XBC) store8(Z + (size_t)r * 1024 + (c - C_Z), v);
    else if (c < C_BG) store8(XBC + (size_t)r * 1536 + (c - C_XBC), v);
    else if (c < C_NG) { float s[8];
#pragma unroll
      for (int i = 0; i < 8; ++i) s[i] = fsig(v[i]);
      store8(BG + (size_t)r * 2048 + (c - C_BG), s); }
    else if (c < C_DT) { float* o = NG + (size_t)r * 24 + (c - C_NG);
#pragma unroll
      for (int i = 0; i < 8; ++i) o[i] = fsig(v[i]); }
    else if (c < C_END) { float* o = DT + (size_t)r * 16 + (c - C_DT); const float* bi = dt_bias + (c - C_DT);
#pragma unroll
      for (int i = 0; i < 8; ++i) o[i] = fsoftplus(v[i] + bi[i]); } } };
struct FStoreBf { u16* o; int ld; __device__ __forceinline__ void operator()(const Unit&, int r, int c, const float (&v)[8]) const { store8(o + (size_t)r * ld + c, v); } };
struct FMerge { const u16* t1; const u16* bg; u16* o;
  __device__ __forceinline__ void operator()(const Unit&, int r, int c, const float (&v)[8]) const { float t[8], ga[8], gb[8], m[8]; load8(t1 + (size_t)r * 1024 + c, t); load8(bg + (size_t)r * 2048 + c, ga); load8(bg + (size_t)r * 2048 + 1024 + c, gb);
#pragma unroll
    for (int i = 0; i < 8; ++i) m[i] = ga[i] * t[i] + gb[i] * v[i];
    store8(o + (size_t)r * 1024 + c, m); } };
struct FResid { const float* x; float* o;
  __device__ __forceinline__ void operator()(const Unit&, int r, int c, const float (&v)[8]) const { const f32x4 a = *(const f32x4*)(x + (size_t)r * 1024 + c), b = *(const f32x4*)(x + (size_t)r * 1024 + c + 4);
    *(f32x4*)(o + (size_t)r * 1024 + c) = (f32x4){a.x + v[0], a.y + v[1], a.z + v[2], a.w + v[3]}; *(f32x4*)(o + (size_t)r * 1024 + c + 4) = (f32x4){b.x + v[4], b.y + v[5], b.z + v[6], b.w + v[7]}; } };
struct FPle { float* x; const u16* pp;
  __device__ __forceinline__ void operator()(const Unit&, int r, int c, const float (&v)[8]) const { float p[8]; load8(pp + (size_t)r * 1024 + c, p); float* xp = x + (size_t)r * 1024 + c; const f32x4 a = *(const f32x4*)xp, b = *(const f32x4*)(xp + 4);
    *(f32x4*)xp = (f32x4){a.x + fsig(v[0]) * p[0], a.y + fsig(v[1]) * p[1], a.z + fsig(v[2]) * p[2], a.w + fsig(v[3]) * p[3]};
    *(f32x4*)(xp + 4) = (f32x4){b.x + fsig(v[4]) * p[4], b.y + fsig(v[5]) * p[5], b.z + fsig(v[6]) * p[6], b.w + fsig(v[7]) * p[7]}; } };

template <class F> __device__ __forceinline__ void dense_gemm(LAS unsigned char* lds, const u16* A, int lda, const u16* Bt, int ldb, int M, int N, int K, const F& f) {
  pg8::Gemm g{A, Bt, M, N, K, lda, ldb, 128}; pg8::StaticOrder S; S.init(M, N, (int)gridDim.x, (int)blockIdx.x); Epi8<F> E{f};
  pg8::gemm_phase<Epi8<F>, pg8::StaticOrder, true, false>(lds, g, S, E);
}
}
namespace fx {
constexpr int LIST_CAP = 32768;
constexpr int LDS_TAB = 131072;
struct MoeBufs { float* LOGITS; int* CNT; int* LIST; int* ASG; u16* MOEOUT; u16* WrT; };
__host__ __device__ inline size_t carve_moe(MoeBufs& M, const Bufs& B, unsigned char* ws, size_t off) {
  auto take = [&](size_t bytes) { unsigned char* r = ws + off; off += (bytes + 255) / 256 * 256; return r; };
  M.LOGITS = (float*)take((size_t)NTOK * 64 * 4); M.CNT = (int*)take(32 * 256); M.LIST = (int*)take((size_t)32 * LIST_CAP * 4); M.WrT = (u16*)take((size_t)256 * 1024 * 2); M.ASG = (int*)take((size_t)NTOK * 2 * 4);
  M.MOEOUT = B.QKV;
  return off;
}
__device__ __forceinline__ void prologue_moe(const Inputs& I, const MoeBufs& M) {
  for (long i = blockIdx.x * 512L + otid(); i < 256L * 1024; i += (long)gridDim.x * 512L) { const int n = (int)(i >> 10), k = (int)(i & 1023);
    float v = 0.f; if (n < 4) v = I.w_group[k * 4 + n]; else if (n < 36) v = I.w_expert[k * 32 + (n - 4)];
    M.WrT[i] = nv::f2bf(v); }
  if (blockIdx.x == 0 && threadIdx.x < 32) M.CNT[threadIdx.x * 64] = 0;
}
struct FLogits { float* o; __device__ __forceinline__ void operator()(const Unit&, int r, int c, const float (&v)[8]) const { if (c < 40) { *(f32x4*)(o + (size_t)r * 64 + c) = (f32x4){v[0], v[1], v[2], v[3]}; *(f32x4*)(o + (size_t)r * 64 + c + 4) = (f32x4){v[4], v[5], v[6], v[7]}; } } };
__device__ __forceinline__ void phase_route(LAS unsigned char* lds, const Inputs& I, const Bufs& B, const MoeBufs& M) {
  LAS int* lcnt = (LAS int*)lds; LAS int* lbase = lcnt + 32; const int tid = otid();
  for (int blk = blockIdx.x; blk < NTOK / 128; blk += gridDim.x) {
    if (tid < 32) lcnt[tid] = 0;
    __syncthreads();
    int e0 = 0, e1 = 0, r0 = 0, r1 = 0; float w0 = 0.f, w1 = 0.f; const int tok = blk * 128 + tid;
    if (tid < 128) { const float* lg = M.LOGITS + (size_t)tok * 64;
      const f32x4 g4 = *(const f32x4*)lg; const float g0 = g4.x + I.b_group[0], g1 = g4.y + I.b_group[1], g2 = g4.z + I.b_group[2], g3 = g4.w + I.b_group[3];
      int gi = 0; float gm = g0; if (g1 > gm) { gm = g1; gi = 1; } if (g2 > gm) { gm = g2; gi = 2; } if (g3 > gm) { gm = g3; gi = 3; }
      const float grp_w = 1.0f / (expf(g0 - gm) + expf(g1 - gm) + expf(g2 - gm) + expf(g3 - gm));
      const f32x4 ea = *(const f32x4*)(lg + 4 + gi * 8), eb = *(const f32x4*)(lg + 8 + gi * 8); const f32x4 ba = *(const f32x4*)(I.b_expert + gi * 8), bb = *(const f32x4*)(I.b_expert + gi * 8 + 4);
      const float el[8] = {ea.x + ba.x, ea.y + ba.y, ea.z + ba.z, ea.w + ba.w, eb.x + bb.x, eb.y + bb.y, eb.z + bb.z, eb.w + bb.w};
      int i0 = 0; float m0 = el[0];
#pragma unroll
      for (int j = 1; j < 8; ++j) if (el[j] > m0) { m0 = el[j]; i0 = j; }
      int i1 = -1; float m1 = -3.0e38f;
#pragma unroll
      for (int j = 0; j < 8; ++j) if (j != i0 && el[j] > m1) { m1 = el[j]; i1 = j; }
      const float r = expf(m1 - m0); w0 = grp_w / (1.0f + r); w1 = grp_w * r / (1.0f + r);
      e0 = gi * 8 + i0; e1 = gi * 8 + i1;
      r0 = __hip_atomic_fetch_add(lcnt + e0, 1, __ATOMIC_RELAXED, __HIP_MEMORY_SCOPE_WORKGROUP); r1 = __hip_atomic_fetch_add(lcnt + e1, 1, __ATOMIC_RELAXED, __HIP_MEMORY_SCOPE_WORKGROUP); }
    __syncthreads();
    if (tid < 32) { const int n = lcnt[tid]; lbase[tid] = n > 0 ? atomicAdd(&M.CNT[tid * 64], n) : 0; }
    __syncthreads();
    if (tid < 128) { const int p0 = lbase[e0] + r0, p1 = lbase[e1] + r1;
      M.LIST[e0 * LIST_CAP + p0] = tok * 2; M.LIST[e1 * LIST_CAP + p1] = tok * 2 + 1; M.ASG[tok * 2] = (e0 << 16) | p0; M.ASG[tok * 2 + 1] = (e1 << 16) | p1; B.EW[tok * 2] = w0; B.EW[tok * 2 + 1] = w1; }
    __syncthreads(); }
}
__device__ __forceinline__ void build_tile_table(LAS unsigned char* lds, const MoeBufs& M) {
  LAS int* tab = (LAS int*)(lds + LDS_TAB);
  if (threadIdx.x == 0) { int acc = 0; for (int e = 0; e < 32; ++e) { tab[e] = acc; acc += (M.CNT[e * 64] + 255) >> 8; } tab[32] = acc; }
  __syncthreads();
}
__device__ __forceinline__ int tile_expert(const LAS int* tab, int tile) { int e = 0;
#pragma unroll 1
  for (int j = 1; j < 32; ++j) if (tab[j] <= tile) e = j;
  return e; }

struct SchedGU { const int* list; int tile, ct, lbase, nvalid, e;
  __device__ bool next(int i, Unit& u) const { if (i > 0) return false; u.pm = tile; u.pn = ct; u.aux0 = lbase; u.aux1 = nvalid; return true; }
  __device__ __forceinline__ const char* a_base(const pg8::Gemm& g, const Unit&) const { return (const char*)g.A; }
  __device__ __forceinline__ const char* b_base(const pg8::Gemm& g, const Unit&) const { return (const char*)g.Bt + ((size_t)e * 512 + (size_t)ct * 256) * 1024 * 2; }
  __device__ __forceinline__ int a_row(const Unit&, int r) const { return r < nvalid ? (list[lbase + r] >> 1) : 0; } };
struct EpiGU { static constexpr bool PERM = true; u16* act;
  __device__ __forceinline__ void operator()(const f32x4 (&acc)[2][2][4][2], const Unit& u, int wr, int wc, int fr, int fq) const {
#pragma unroll
    for (int ai = 0; ai < 2; ++ai)
#pragma unroll
      for (int m = 0; m < 4; ++m) { const int r = ai * 128 + wr * 64 + m * 16 + fr; const f32x4 g0 = acc[ai][0][m][0], g1 = acc[ai][0][m][1], u0 = acc[ai][1][m][0], u1 = acc[ai][1][m][1];
        const float a[8] = {g0.x * fsig(g0.x) * u0.x, g0.y * fsig(g0.y) * u0.y, g0.z * fsig(g0.z) * u0.z, g0.w * fsig(g0.w) * u0.w, g1.x * fsig(g1.x) * u1.x, g1.y * fsig(g1.y) * u1.y, g1.z * fsig(g1.z) * u1.z, g1.w * fsig(g1.w) * u1.w};
        store8(act + ((size_t)u.pm * 256 + r) * 256 + u.pn * 128 + wc * 32 + 8 * fq, a); } } };
__device__ __forceinline__ void phase_moe_gu(LAS unsigned char* lds, const Bufs& B, const WBufs& W, const MoeBufs& M) {
  const LAS int* tab = (const LAS int*)(lds + LDS_TAB); const int T = tab[32];
  for (int L = blockIdx.x; L < T * 2; L += gridDim.x) { const int tile = L >> 1, ct = L & 1, e = __builtin_amdgcn_readfirstlane(tile_expert(tab, tile)), rt = tile - __builtin_amdgcn_readfirstlane(tab[e]); int nvalid = __builtin_amdgcn_readfirstlane(M.CNT[e * 64]) - rt * 256; nvalid = nvalid > 256 ? 256 : nvalid;
    pg8::Gemm g{B.H2, W.WguT, 256, 256, 1024, 1024, 1024, 128}; SchedGU S{M.LIST, tile, ct, e * LIST_CAP + rt * 256, nvalid, e}; EpiGU E{B.ACT};
    pg8::gemm_phase<EpiGU, SchedGU, true, true>(lds, g, S, E); }
}
struct SchedD { const LAS int* tab; int T4, G, c;
  __device__ bool next(int i, Unit& u) const { const int L = i * G + c; if (L >= T4) return false; const int tile = L >> 2; u.pm = tile; u.pn = L & 3; u.aux0 = __builtin_amdgcn_readfirstlane(tile_expert(tab, tile)); u.aux1 = 0; return true; }
  __device__ __forceinline__ const char* a_base(const pg8::Gemm& g, const Unit& u) const { return (const char*)g.A + (size_t)u.pm * 256 * 256 * 2; }
  __device__ __forceinline__ const char* b_base(const pg8::Gemm& g, const Unit& u) const { return (const char*)g.Bt + ((size_t)u.aux0 * 1024 + (size_t)u.pn * 256) * 256 * 2; }
  __device__ __forceinline__ int a_row(const Unit&, int) const { return 0; } };
__device__ __forceinline__ void phase_moe_down(LAS unsigned char* lds, const Bufs& B, const WBufs& W, const MoeBufs& M) {
  const LAS int* tab = (const LAS int*)(lds + LDS_TAB);
  pg8::Gemm g{B.ACT, W.WdT, 256, 1024, 256, 256, 256, 128}; SchedD S{tab, tab[32] * 4, (int)gridDim.x, (int)blockIdx.x}; Epi8<FStoreBf> E{FStoreBf{M.MOEOUT, 1024}};
  pg8::gemm_phase<Epi8<FStoreBf>, SchedD, true, false>(lds, g, S, E);
}
__device__ __forceinline__ void phase_moe_combine(LAS unsigned char* lds, float* out, const MoeBufs& M, const float* ew, const float* gain, u16* hout) {
  const LAS int* tab = (const LAS int*)(lds + LDS_TAB);
  const int tid = otid(), lane = tid & 63, gw = obid() * 8 + (tid >> 6), ngw = gridDim.x * 8;
  for (int tk = gw; tk < NTOK; tk += 2 * ngw) { f32x4 v[2][4]; float rs[2];
    pg8::u32x2 a[2][4], b[2][4]; float w0[2], w1[2];
#pragma unroll
    for (int q = 0; q < 2; ++q) { const int tok = (tk + q * ngw < NTOK) ? tk + q * ngw : tk; const int a0 = M.ASG[tok * 2], a1 = M.ASG[tok * 2 + 1]; w0[q] = ew[tok * 2]; w1[q] = ew[tok * 2 + 1];
      const int s0 = (tab[a0 >> 16] + ((a0 & 0xffff) >> 8)) * 256 + (a0 & 255), s1 = (tab[a1 >> 16] + ((a1 & 0xffff) >> 8)) * 256 + (a1 & 255);
      const f32x4* xr = (const f32x4*)(out + (size_t)tok * 1024) + lane; const pg8::u32x2* o0 = (const pg8::u32x2*)(M.MOEOUT + (size_t)s0 * 1024) + lane; const pg8::u32x2* o1 = (const pg8::u32x2*)(M.MOEOUT + (size_t)s1 * 1024) + lane;
#pragma unroll
      for (int j = 0; j < 4; ++j) { v[q][j] = xr[64 * j]; a[q][j] = o0[64 * j]; b[q][j] = o1[64 * j]; } }
#pragma unroll
    for (int q = 0; q < 2; ++q) { float s = 0.f;
#pragma unroll
      for (int j = 0; j < 4; ++j) { f32x4& x = v[q][j];
        x.x += w0[q] * __uint_as_float(a[q][j].x << 16) + w1[q] * __uint_as_float(b[q][j].x << 16); x.y += w0[q] * __uint_as_float(a[q][j].x & 0xffff0000u) + w1[q] * __uint_as_float(b[q][j].x & 0xffff0000u);
        x.z += w0[q] * __uint_as_float(a[q][j].y << 16) + w1[q] * __uint_as_float(b[q][j].y << 16); x.w += w0[q] * __uint_as_float(a[q][j].y & 0xffff0000u) + w1[q] * __uint_as_float(b[q][j].y & 0xffff0000u);
        s += (x.x * x.x + x.y * x.y) + (x.z * x.z + x.w * x.w); }
      rs[q] = 1.0f / sqrtf(wave_sum(s) * (1.f / 1024.f) + nv::EPS); }
#pragma unroll
    for (int q = 0; q < 2; ++q) { if (tk + q * ngw >= NTOK) break; const int tok = tk + q * ngw; f32x4* xr = (f32x4*)(out + (size_t)tok * 1024) + lane; const f32x4* gr = (const f32x4*)gain + lane;
      unsigned long long* o8 = (unsigned long long*)(hout + (size_t)tok * 1024) + lane;
#pragma unroll
      for (int j = 0; j < 4; ++j) { const f32x4 g = gr[64 * j]; const f32x4 x = v[q][j]; xr[64 * j] = x; o8[64 * j] = (unsigned long long)pk2(x.x * rs[q] * g.x, x.y * rs[q] * g.y) | ((unsigned long long)pk2(x.z * rs[q] * g.z, x.w * rs[q] * g.w) << 32); } } }
}
}
namespace fa {
using nv::u16; using nv::Bufs;
typedef short bf16x8 __attribute__((ext_vector_type(8)));
typedef short s16x4 __attribute__((ext_vector_type(4)));
typedef float f32x16 __attribute__((ext_vector_type(16)));
typedef unsigned u32x4 __attribute__((ext_vector_type(4)));
constexpr float C2 = 0.125f * 1.4426950408889634f;
constexpr int S = nv::S, QKVW = 1280;
constexpr int L_K = 0, L_V = 16384, L_WSF = 32768, L_IMP = 34816, L_MASK = L_IMP + 65536, L_OST = L_MASK + 512, L_END = L_OST + 32768;
static_assert(L_END <= 147456, "attention LDS map");

__device__ __forceinline__ int crow(int r, int hi) { return (r & 3) + 8 * (r >> 2) + 4 * hi; }
__device__ __forceinline__ float ex2(float x) { return __builtin_amdgcn_exp2f(x); }
__device__ __forceinline__ float swap_add(float v) { auto rr = __builtin_amdgcn_permlane32_swap(__float_as_uint(v), __float_as_uint(v), false, false); return __uint_as_float(rr[0]) + __uint_as_float(rr[1]); }
__device__ __forceinline__ float swap_max(float v) { auto rr = __builtin_amdgcn_permlane32_swap(__float_as_uint(v), __float_as_uint(v), false, false); return __builtin_fmaxf(__uint_as_float(rr[0]), __uint_as_float(rr[1])); }

__device__ __forceinline__ void phase_qknorm(const nv::Inputs& I, const Bufs& B) {
  const int nwg = (int)gridDim.x > 32 ? (int)gridDim.x - 32 : (int)gridDim.x;
  if ((int)blockIdx.x >= nwg) return;
  for (int it = blockIdx.x * 512 + fx::otid(); it < nv::NTOK * 12; it += nwg * 512) { const int tok = it / 12, w = it % 12; u16* v; const float* gain; float sc = 1.f;
    if (w < 8) { v = B.QKV + (size_t)tok * QKVW + nv::O_Q + w * 64; gain = I.q_gain; sc = C2; } else if (w < 10) { v = B.QKV + (size_t)tok * QKVW + nv::O_KS + (w - 8) * 64; gain = I.ks_gain; } else { v = B.QKV + (size_t)tok * QKVW + nv::O_KW + (w - 10) * 64; gain = I.kw_gain; }
    float x[8][8]; float s = 0.f;
#pragma unroll
    for (int c = 0; c < 8; ++c) { fx::load8(v + c * 8, x[c]);
#pragma unroll
      for (int j = 0; j < 8; ++j) s += x[c][j] * x[c][j]; }
    const float rs = sc / sqrtf(s * (1.f / 64.f) + nv::EPS);
#pragma unroll
    for (int c = 0; c < 8; ++c) { float y[8];
#pragma unroll
      for (int j = 0; j < 8; ++j) y[j] = x[c][j] * rs * gain[c * 8 + j];
      fx::store8(v + c * 8, y); } }
}

__device__ __forceinline__ void stage_kv(LAS unsigned char* lds, int slot, const u16* kbase, const u16* vbase, int stride, int wid, int lane, bool withV) {
  const u16* ksrc = kbase + (size_t)lane * stride + wid * 8;
  __builtin_amdgcn_global_load_lds((const unsigned*)ksrc, (LAS unsigned*)(lds + L_K + slot * 8192 + wid * 1024), 16, 0, 0);
  if (withV) { const u16* vsrc = vbase + (size_t)(16 * (wid & 3) + (lane >> 2)) * stride + (wid >> 2) * 32 + (lane & 3) * 8;
    __builtin_amdgcn_global_load_lds((const unsigned*)vsrc, (LAS unsigned*)(lds + L_V + slot * 8192 + wid * 1024), 16, 0, 0); }
}
__device__ __forceinline__ void qkt(f32x16& p0, f32x16& p1, const LAS unsigned char* Kslot, const bf16x8 (&qr)[4], int r32, int hi) {
  const LAS unsigned char* kb = Kslot + hi * 1024 + r32 * 16; f32x16 z;
#pragma unroll
  for (int r = 0; r < 16; ++r) z[r] = 0.f;
  p0 = z; p1 = z;
#pragma unroll
  for (int d0 = 0; d0 < 4; ++d0) { const bf16x8 b0 = *(const LAS bf16x8*)(kb + d0 * 2048), b1 = *(const LAS bf16x8*)(kb + d0 * 2048 + 512);
    p0 = __builtin_amdgcn_mfma_f32_32x32x16_bf16(b0, qr[d0], p0, 0, 0, 0); p1 = __builtin_amdgcn_mfma_f32_32x32x16_bf16(b1, qr[d0], p1, 0, 0, 0); }
}
__device__ __forceinline__ void pv(f32x16 (&o)[2], int vb, bf16x8 pa0, bf16x8 pa1, bf16x8 pa2, bf16x8 pa3) {
#pragma unroll
  for (int d0 = 0; d0 < 2; ++d0) { s16x4 lo[4], hi[4];
#pragma unroll
    for (int ks = 0; ks < 4; ++ks) {
      asm volatile("ds_read_b64_tr_b16 %0,%1 offset:%c2" : "=&v"(lo[ks]) : "v"(vb), "i"(d0 * 4096 + ks * 1024) : "memory");
      asm volatile("ds_read_b64_tr_b16 %0,%1 offset:%c2" : "=&v"(hi[ks]) : "v"(vb), "i"(d0 * 4096 + ks * 1024 + 512) : "memory"); }
    asm volatile("s_waitcnt lgkmcnt(0)" ::: "memory"); __builtin_amdgcn_sched_barrier(0);
#define FA_PK(k) (bf16x8){lo[k][0], lo[k][1], lo[k][2], lo[k][3], hi[k][0], hi[k][1], hi[k][2], hi[k][3]}
    o[d0] = __builtin_amdgcn_mfma_f32_32x32x16_bf16(pa0, FA_PK(0), o[d0], 0, 0, 0);
    o[d0] = __builtin_amdgcn_mfma_f32_32x32x16_bf16(pa1, FA_PK(1), o[d0], 0, 0, 0);
    o[d0] = __builtin_amdgcn_mfma_f32_32x32x16_bf16(pa2, FA_PK(2), o[d0], 0, 0, 0);
    o[d0] = __builtin_amdgcn_mfma_f32_32x32x16_bf16(pa3, FA_PK(3), o[d0], 0, 0, 0);
#undef FA_PK
  }
}
struct SmState { float m, l; f32x16 o[2]; };
__device__ __forceinline__ void sm_reset(SmState& st) { st.m = -INFINITY; st.l = 0.f;
#pragma unroll
  for (int r = 0; r < 16; ++r) { st.o[0][r] = 0.f; st.o[1][r] = 0.f; } }
__device__ __forceinline__ void mask_range(f32x16& p0, f32x16& p1, int klo, int khi, int hi) {
  if (__all(klo <= 0 && khi >= 63)) return;
#pragma unroll
  for (int r = 0; r < 16; ++r) { const int k0 = crow(r, hi), k1 = k0 + 32; if (k0 < klo || k0 > khi) p0[r] = -INFINITY; if (k1 < klo || k1 > khi) p1[r] = -INFINITY; }
}
__device__ __forceinline__ void tile_step(SmState& st, LAS unsigned char* lds, int slot, const bf16x8 (&qr)[4], LAS float* wsf, int r32, int hi, int vb0, int klo, int khi) {
  f32x16 p0, p1; qkt(p0, p1, lds + L_K + slot * 8192, qr, r32, hi);
  mask_range(p0, p1, klo, khi, hi);
  float rm = p0[0];
#pragma unroll
  for (int r = 1; r < 16; ++r) rm = __builtin_fmaxf(rm, p0[r]);
#pragma unroll
  for (int r = 0; r < 16; ++r) rm = __builtin_fmaxf(rm, p1[r]);
  rm = swap_max(rm);
  const float mn = __builtin_fmaxf(st.m, rm), ms = __builtin_fmaxf(mn, -1.0e30f);
  const float f = ex2(st.m - ms);
  if (__any(mn > st.m)) { if (hi == 0) wsf[r32] = f;
#pragma unroll
    for (int r = 0; r < 16; ++r) { const float fr = wsf[crow(r, hi)]; st.o[0][r] *= fr; st.o[1][r] *= fr; } }
  st.m = mn;
  float rs = 0.f;
#pragma unroll
  for (int r = 0; r < 16; ++r) { p0[r] = ex2(p0[r] - ms); p1[r] = ex2(p1[r] - ms); rs += p0[r] + p1[r]; }
  st.l = st.l * f + rs;
  u32x4 w0, w1, w2, w3;
  w0.x = pg8::cvt_pk_bf16(p0[0], p0[1]); w0.y = pg8::cvt_pk_bf16(p0[2], p0[3]); w0.z = pg8::cvt_pk_bf16(p0[4], p0[5]); w0.w = pg8::cvt_pk_bf16(p0[6], p0[7]);
  w1.x = pg8::cvt_pk_bf16(p0[8], p0[9]); w1.y = pg8::cvt_pk_bf16(p0[10], p0[11]); w1.z = pg8::cvt_pk_bf16(p0[12], p0[13]); w1.w = pg8::cvt_pk_bf16(p0[14], p0[15]);
  w2.x = pg8::cvt_pk_bf16(p1[0], p1[1]); w2.y = pg8::cvt_pk_bf16(p1[2], p1[3]); w2.z = pg8::cvt_pk_bf16(p1[4], p1[5]); w2.w = pg8::cvt_pk_bf16(p1[6], p1[7]);
  w3.x = pg8::cvt_pk_bf16(p1[8], p1[9]); w3.y = pg8::cvt_pk_bf16(p1[10], p1[11]); w3.z = pg8::cvt_pk_bf16(p1[12], p1[13]); w3.w = pg8::cvt_pk_bf16(p1[14], p1[15]);
  pv(st.o, vb0 + L_V + slot * 8192, __builtin_bit_cast(bf16x8, w0), __builtin_bit_cast(bf16x8, w1), __builtin_bit_cast(bf16x8, w2), __builtin_bit_cast(bf16x8, w3));
}
__device__ __forceinline__ void finalize(SmState& st, float gate, f32x16 (&outacc)[2], LAS float* wsf, int r32, int hi, float& msafe, float& invl) {
  const float lt = swap_add(st.l); invl = lt > 0.f ? 1.0f / lt : 0.f; msafe = __builtin_fmaxf(st.m, -1.0e30f);
  if (hi == 0) wsf[r32] = gate * invl;
#pragma unroll
  for (int r = 0; r < 16; ++r) { const float fr = wsf[crow(r, hi)]; outacc[0][r] += st.o[0][r] * fr; outacc[1][r] += st.o[1][r] * fr; }
}
__device__ __forceinline__ void imp_step(LAS unsigned char* lds, int slot, const bf16x8 (&qr)[4], int r32, int hi, int khi, float msafe, float invl, LAS float* imph  , int tq, int T) {
  f32x16 p0, p1; qkt(p0, p1, lds + L_K + slot * 8192, qr, r32, hi);
  mask_range(p0, p1, 0, khi, hi);
#pragma unroll
  for (int r = 0; r < 16; ++r) { p0[r] = ex2(p0[r] - msafe) * invl; p1[r] = ex2(p1[r] - msafe) * invl; }
  LAS float* row = imph + tq * 64 + 16 * T + hi;
#pragma unroll
  for (int gq = 0; gq < 4; ++gq) { row[2 * gq] += (p0[4 * gq] + p0[4 * gq + 1]) + (p0[4 * gq + 2] + p0[4 * gq + 3]); row[2 * gq + 8] += (p1[4 * gq] + p1[4 * gq + 1]) + (p1[4 * gq + 2] + p1[4 * gq + 3]); }
  asm volatile("s_waitcnt lgkmcnt(0)" ::: "memory");
#pragma unroll
  for (int gq = 0; gq < 4; ++gq) { row[2 * gq + 1] += p0[4 * gq + 3]; if (16 * T + hi + 2 * gq + 9 < 64) row[2 * gq + 9] += p1[4 * gq + 3]; }
  asm volatile("s_waitcnt lgkmcnt(0)" ::: "memory");
}
__device__ __forceinline__ void topk_select(LAS unsigned char* lds, int wid, int lane, int i) {
  LAS float* IM = (LAS float*)(lds + L_IMP); LAS unsigned long long* MK = (LAS unsigned long long*)(lds + L_MASK);
  const int j = lane; const int nforced = i == 0 ? 1 : (i == 1 ? 2 : 3);
  const bool forced = (j <= i) && (j == 0 || j == i || j == i - 1); const bool cand = (j >= 1) && (j <= i - 2);
  for (int tq = wid; tq < 64; tq += 8) {
    const float v = (IM[tq * 64 + j] + IM[4096 + tq * 64 + j]) + (IM[8192 + tq * 64 + j] + IM[12288 + tq * 64 + j]);
    IM[tq * 64 + j] = v;
    asm volatile("s_waitcnt lgkmcnt(0)" ::: "memory");
    int cnt = 0;
    for (int jj = 1; jj <= i - 2; ++jj) { const float vv = IM[tq * 64 + jj]; cnt += (vv > v || (vv == v && jj < j)) ? 1 : 0; }
    const bool sel = forced || (cand && cnt < 16 - nforced);
    const unsigned long long mk = __ballot(sel);
    if (lane == 0) MK[tq] = mk;
  }
}

__device__ __forceinline__ void attn_unit(LAS unsigned char* lds, const Bufs& B, int b, int g, int i) {
  const int tid = fx::otid(), lane = tid & 63, wid = __builtin_amdgcn_readfirstlane(tid >> 6), r32 = lane & 31, hi = lane >> 5;
  const int e = wid >> 1, h = g * 4 + e, tq = 32 * (wid & 1) + r32; const size_t tok = (size_t)b * S + 64 * i + tq; const int t = 64 * i + tq;
  LAS float* wsf = (LAS float*)(lds + L_WSF) + wid * 64;
  LAS float* imph = (LAS float*)(lds + L_IMP) + e * 4096;
  const int vb0 = (int)(unsigned)(size_t)lds + ((lane >> 4) & 1) * 32 + (lane & 3) * 8 + (4 * hi + ((lane & 15) >> 2)) * 64;
  bf16x8 qr[4];
#pragma unroll
  for (int d0 = 0; d0 < 4; ++d0) qr[d0] = *(const bf16x8*)(B.QKV + tok * QKVW + h * 64 + d0 * 16 + hi * 8);
  const float g0 = B.NG[tok * 24 + h * 3 + 0], g1 = B.NG[tok * 24 + h * 3 + 1], g2 = B.NG[tok * 24 + h * 3 + 2];
  const u16* kc = B.KCMP + (size_t)(b * 2 + g) * 256 * 64; const u16* vc = B.VCMP + (size_t)(b * 2 + g) * 256 * 64;
  const u16* ksb = B.QKV + (size_t)b * S * QKVW + nv::O_KS + g * 64; const u16* vsb = B.QKV + (size_t)b * S * QKVW + nv::O_VS + g * 64;
  const u16* kwb = B.QKV + (size_t)b * S * QKVW + nv::O_KW + g * 64; const u16* vwb = B.QKV + (size_t)b * S * QKVW + nv::O_VW + g * 64;
  int nvis = t >= 31 ? (t - 31) / 16 + 1 : 0; nvis = nvis > 255 ? 255 : nvis;
  const int ntA = (4 * i + 3 + 63) / 64, nC = (i < 8 ? i : 8) + 1, jC0 = i - (nC - 1);
  const int sI = ntA, sB = 2 * ntA, sC = sB + i + 1, NS = sC + nC;
  { LAS float* IM = (LAS float*)(lds + L_IMP); for (int k = tid; k < 4 * 4096; k += 512) IM[k] = 0.f; }
  f32x16 outacc[2];
#pragma unroll
  for (int r = 0; r < 16; ++r) { outacc[0][r] = 0.f; outacc[1][r] = 0.f; }
  SmState st; sm_reset(st);
  float mA = -1.0e30f, invlA = 0.f; unsigned long long mybits = 0ull;
#define FA_ISSUE(s_) do { const int s__ = (s_); const int sl = s__ & 1; \
    if (s__ < sI) stage_kv(lds, sl, kc + (size_t)s__ * 4096, vc + (size_t)s__ * 4096, 64, wid, lane, true); \
    else if (s__ < sB) stage_kv(lds, sl, kc + (size_t)(s__ - sI) * 4096, vc, 64, wid, lane, false); \
    else if (s__ < sC) stage_kv(lds, sl, ksb + (size_t)(s__ - sB) * 64 * QKVW, vsb + (size_t)(s__ - sB) * 64 * QKVW, QKVW, wid, lane, true); \
    else stage_kv(lds, sl, kwb + (size_t)(jC0 + s__ - sC) * 64 * QKVW, vwb + (size_t)(jC0 + s__ - sC) * 64 * QKVW, QKVW, wid, lane, true); } while (0)
  FA_ISSUE(0);
  for (int s = 0; s < NS; ++s) {
    asm volatile("s_waitcnt vmcnt(0)" ::: "memory"); __syncthreads();
    if (s + 1 < NS) FA_ISSUE(s + 1);
    const int sl = s & 1;
    if (s < sI) { tile_step(st, lds, sl, qr, wsf, r32, hi, vb0, 0, nvis - 64 * s - 1);
      if (s == sI - 1) { finalize(st, g0, outacc, wsf, r32, hi, mA, invlA); sm_reset(st); } }
    else if (s < sB) { imp_step(lds, sl, qr, r32, hi, nvis - 64 * (s - sI) - 1, mA, invlA, imph, tq, s - sI);
      if (s == sB - 1) { __syncthreads(); topk_select(lds, wid, lane, i); __syncthreads(); mybits = ((const LAS unsigned long long*)(lds + L_MASK))[tq]; } }
    else if (s < sC) { const int j = s - sB; const bool selj = (mybits >> j) & 1ull; tile_step(st, lds, sl, qr, wsf, r32, hi, vb0, 0, selj ? (j == i ? tq : 63) : -1);
      if (s == sC - 1) { float d0_, d1_; finalize(st, g1, outacc, wsf, r32, hi, d0_, d1_); sm_reset(st); } }
    else { const int j = jC0 + (s - sC); tile_step(st, lds, sl, qr, wsf, r32, hi, vb0, (i >= 8 && j == i - 8) ? tq + 1 : 0, j == i ? tq : 63);
      if (s == NS - 1) { float d0_, d1_; finalize(st, g2, outacc, wsf, r32, hi, d0_, d1_); } }
  }
#undef FA_ISSUE
  { u16* Ow = B.YA + ((size_t)b * S + 64 * i + 32 * (wid & 1)) * 512 + h * 64; LAS u16* stg = (LAS u16*)(lds + L_OST) + wid * 2048;
#pragma unroll
    for (int r = 0; r < 16; ++r) { const int orow = crow(r, hi); stg[orow * 64 + r32] = nv::f2bf(outacc[0][r]); stg[orow * 64 + 32 + r32] = nv::f2bf(outacc[1][r]); }
    asm volatile("s_waitcnt lgkmcnt(0)" ::: "memory");
#pragma unroll
    for (int q = 0; q < 4; ++q) { const int row = q * 8 + (lane >> 3), ch = lane & 7; const u32x4 v = *(const LAS u32x4*)(stg + row * 64 + ch * 8); *(u32x4*)(Ow + (size_t)row * 512 + ch * 8) = v; } }
  __syncthreads();
}
__device__ __forceinline__ void phase_attention(LAS unsigned char* lds, const Bufs& B) {
  const int G = gridDim.x, bx = blockIdx.x; const int vcu = (G % 8 == 0) ? (bx % 8) * (G / 8) + bx / 8 : bx;
  for (int u = vcu; u < 256; u += G) { const int bg = u >> 4, s = u & 15;
#pragma unroll 1
    for (int k = 0; k < 4; ++k) { const int i = (k == 0) ? s : (k == 1) ? 31 - s : (k == 2) ? 32 + s : 63 - s; attn_unit(lds, B, bg >> 1, bg & 1, i); } }
}
}
namespace fs {
using nv::u16; using nv::Bufs; using nv::Inputs;
using fa::bf16x8; using fa::f32x16; using fa::u32x4; using fa::crow; using fa::ex2;
typedef float f32x4 __attribute__((ext_vector_type(4)));
constexpr int S = nv::S, NTOK = nv::NTOK, SCD = 1536;
constexpr float LOG2E = 1.4426950408889634f;
struct SsdBufs { u16* XC; u16* STATE; float* ACS; float* DEC; };
__host__ __device__ inline size_t carve_ssd(SsdBufs& X, const Bufs& B, unsigned char* ws, size_t off) {
  auto take = [&](size_t bytes) { unsigned char* r = ws + off; off += (bytes + 255) / 256 * 256; return r; };
  X.XC = B.HB;
  X.STATE = B.HB + (size_t)NTOK * SCD;
  X.ACS = (float*)take((size_t)NTOK * 16 * 4); X.DEC = (float*)take((size_t)8 * 16 * 16 * 4);
  return off;
}
constexpr int L_ARR = 101376;
constexpr int L_BT = 0, BT_LD = 264, L_XWT = 67584;
constexpr int L_KIMG = 0, L_XV = 0, L_OST = 65536;
static_assert(L_XWT + 64 * BT_LD * 2 <= L_ARR && L_OST + 32768 <= L_ARR && L_ARR + 16384 <= 147456, "SSD LDS map");

__device__ __forceinline__ void phase_conv(const Inputs& I, const Bufs& B, const SsdBufs& X) {
  const int id = blockIdx.x * 512 + fx::otid(); if (id >= 192 * 512) return;
  const int c8 = (id % 192) * 8, run = id / 192; const int tok0 = run * 64; const int t0 = tok0 & (S - 1);
  float w[4][8], bias[8], h0[8], h1[8], h2[8];
#pragma unroll
  for (int j = 0; j < 8; ++j) { bias[j] = I.conv_b[c8 + j];
#pragma unroll
    for (int k = 0; k < 4; ++k) w[k][j] = I.conv_w[k * SCD + c8 + j]; }
  if (t0 >= 3) { fx::load8(B.XBC + (size_t)(tok0 - 3) * SCD + c8, h0); fx::load8(B.XBC + (size_t)(tok0 - 2) * SCD + c8, h1); fx::load8(B.XBC + (size_t)(tok0 - 1) * SCD + c8, h2); }
  else {
#pragma unroll
    for (int j = 0; j < 8; ++j) { h0[j] = 0.f; h1[j] = 0.f; h2[j] = 0.f; } }
#pragma unroll 4
  for (int t = 0; t < 64; ++t) { float x[8], y[8]; fx::load8(B.XBC + (size_t)(tok0 + t) * SCD + c8, x);
#pragma unroll
    for (int j = 0; j < 8; ++j) { const float a = bias[j] + w[0][j] * h0[j] + w[1][j] * h1[j] + w[2][j] * h2[j] + w[3][j] * x[j]; y[j] = a * fx::fsig(a); h0[j] = h1[j]; h1[j] = h2[j]; h2[j] = x[j]; }
    fx::store8(X.XC + (size_t)(tok0 + t) * SCD + c8, y); }
}

__device__ __forceinline__ void ssd_x_unit(LAS unsigned char* lds, const Inputs& I, const Bufs& B, const SsdBufs& X, int b, int c, int g) {
  const int tid = fx::otid(), lane = tid & 63, wid = __builtin_amdgcn_readfirstlane(tid >> 6), r32 = lane & 31, hi = lane >> 5, fr = lane & 15, fq = lane >> 4;
  const size_t tok0 = (size_t)b * S + (size_t)c * 256;
  LAS float* acs2 = (LAS float*)(lds + L_ARR); LAS float* dtl = acs2 + 8 * 256;
  { const int hh = g * 8 + wid; const float a = -expf(I.a_log[hh]) * LOG2E; float d[4], sc[4];
#pragma unroll
    for (int k = 0; k < 4; ++k) d[k] = B.DT[(tok0 + 4 * lane + k) * 16 + hh];
    sc[0] = d[0] * a; sc[1] = sc[0] + d[1] * a; sc[2] = sc[1] + d[2] * a; sc[3] = sc[2] + d[3] * a;
    float tot = sc[3];
#pragma unroll
    for (int o = 1; o < 64; o <<= 1) { const float up = __shfl_up(tot, o); if (lane >= o) tot += up; }
    const float excl = tot - sc[3];
#pragma unroll
    for (int k = 0; k < 4; ++k) { const float v = excl + sc[k]; acs2[wid * 256 + 4 * lane + k] = v; dtl[wid * 256 + 4 * lane + k] = d[k]; X.ACS[(tok0 + 4 * lane + k) * 16 + hh] = v; }
    if (lane == 63) X.DEC[((size_t)b * 16 + c) * 16 + hh] = ex2(tot); }
  { LAS u16* BT = (LAS u16*)(lds + L_BT);
#pragma unroll 1
    for (int q = tid; q < 256 * 16; q += 512) { const int l = q >> 4, n8 = (q & 15) * 8; const u32x4 w = *(const u32x4*)(X.XC + (tok0 + l) * SCD + 1024 + g * 128 + n8);
      BT[(n8 + 0) * BT_LD + l] = (u16)(w.x & 0xffff); BT[(n8 + 1) * BT_LD + l] = (u16)(w.x >> 16); BT[(n8 + 2) * BT_LD + l] = (u16)(w.y & 0xffff); BT[(n8 + 3) * BT_LD + l] = (u16)(w.y >> 16);
      BT[(n8 + 4) * BT_LD + l] = (u16)(w.z & 0xffff); BT[(n8 + 5) * BT_LD + l] = (u16)(w.z >> 16); BT[(n8 + 6) * BT_LD + l] = (u16)(w.w & 0xffff); BT[(n8 + 7) * BT_LD + l] = (u16)(w.w >> 16); } }
  __syncthreads();
#pragma unroll 1
  for (int h = 0; h < 8; ++h) { const int hh = g * 8 + h; LAS u16* XwT = (LAS u16*)(lds + L_XWT); const LAS u16* BT = (const LAS u16*)(lds + L_BT);
    const float aend = acs2[h * 256 + 255];
#pragma unroll 1
    for (int q = tid; q < 256 * 8; q += 512) { const int l = q >> 3, p8 = (q & 7) * 8; float x[8]; fx::load8(X.XC + (tok0 + l) * SCD + hh * 64 + p8, x); const float w = ex2(aend - acs2[h * 256 + l]) * dtl[h * 256 + l];
#pragma unroll
      for (int j = 0; j < 8; ++j) XwT[(p8 + j) * BT_LD + l] = nv::f2bf(x[j] * w); }
    __syncthreads();
    { const int pt = wid & 3, nt0 = (wid >> 2) * 4; pg8::f32x4 acc[4];
#pragma unroll
      for (int n = 0; n < 4; ++n) acc[n] = (pg8::f32x4){0.f, 0.f, 0.f, 0.f};
#pragma unroll
      for (int ks = 0; ks < 8; ++ks) { const bf16x8 a = *(const LAS bf16x8*)(XwT + (pt * 16 + fr) * BT_LD + ks * 32 + fq * 8);
#pragma unroll
        for (int n = 0; n < 4; ++n) { const bf16x8 bb = *(const LAS bf16x8*)(BT + ((nt0 + n) * 16 + fr) * BT_LD + ks * 32 + fq * 8); acc[n] = __builtin_amdgcn_mfma_f32_16x16x32_bf16(a, bb, acc[n], 0, 0, 0); } }
      u16* st = X.STATE + (((size_t)b * 16 + c) * 16 + hh) * 8192;
#pragma unroll
      for (int n = 0; n < 4; ++n)
#pragma unroll
        for (int j = 0; j < 4; ++j) st[(pt * 16 + 4 * fq + j) * 128 + (nt0 + n) * 16 + fr] = nv::f2bf(acc[n][j]); }
    __syncthreads(); }
  const int l = 32 * wid + r32;
  bf16x8 qr[8];
#pragma unroll
  for (int d0 = 0; d0 < 8; ++d0) qr[d0] = *(const bf16x8*)(X.XC + (tok0 + l) * SCD + 1280 + g * 128 + d0 * 16 + hi * 8);
  unsigned Sp[4][16];
#define FS_STAGE_K(j_) do { const int j__ = (j_); _Pragma("unroll") for (int q = 0; q < 2; ++q) { const int ch = wid + 8 * q; \
    __builtin_amdgcn_global_load_lds((const unsigned*)(X.XC + (tok0 + 64 * j__ + lane) * SCD + 1024 + g * 128 + ch * 8), (LAS unsigned*)(lds + L_KIMG + (j__ & 1) * 16384 + ch * 1024), 16, 0, 0); } } while (0)
  FS_STAGE_K(0);
#pragma unroll
  for (int j = 0; j < 4; ++j) {
    asm volatile("s_waitcnt vmcnt(0)" ::: "memory"); __syncthreads();
    if (j + 1 < 4) FS_STAGE_K(j + 1);
    f32x16 p0, p1;
#pragma unroll
    for (int r = 0; r < 16; ++r) { p0[r] = 0.f; p1[r] = 0.f; }
    if (64 * j <= 32 * wid + 31) { const LAS unsigned char* kb = lds + L_KIMG + (j & 1) * 16384 + hi * 1024 + r32 * 16;
#pragma unroll
      for (int d0 = 0; d0 < 8; ++d0) { const bf16x8 b0 = *(const LAS bf16x8*)(kb + d0 * 2048), b1 = *(const LAS bf16x8*)(kb + d0 * 2048 + 512);
        p0 = __builtin_amdgcn_mfma_f32_32x32x16_bf16(b0, qr[d0], p0, 0, 0, 0); p1 = __builtin_amdgcn_mfma_f32_32x32x16_bf16(b1, qr[d0], p1, 0, 0, 0); } }
#pragma unroll
    for (int r = 0; r < 8; ++r) { Sp[j][r] = pg8::cvt_pk_bf16(p0[2 * r], p0[2 * r + 1]); Sp[j][8 + r] = pg8::cvt_pk_bf16(p1[2 * r], p1[2 * r + 1]); } }
#undef FS_STAGE_K
  __syncthreads();
#define FS_STAGE_X(h_) do { const int h__ = (h_); _Pragma("unroll") for (int j = 0; j < 4; ++j) \
    __builtin_amdgcn_global_load_lds((const unsigned*)(X.XC + (tok0 + 64 * j + 16 * (wid & 3) + (lane >> 2)) * SCD + (g * 8 + h__) * 64 + (wid >> 2) * 32 + (lane & 3) * 8), \
                                     (LAS unsigned*)(lds + L_XV + (h__ & 1) * 32768 + j * 8192 + wid * 1024), 16, 0, 0); } while (0)
  const int vb0 = (int)(unsigned)(size_t)lds + ((lane >> 4) & 1) * 32 + (lane & 3) * 8 + (4 * hi + ((lane & 15) >> 2)) * 64;
  FS_STAGE_X(0);
#pragma unroll 1
  for (int h = 0; h < 8; ++h) { const int hh = g * 8 + h;
    asm volatile("s_waitcnt vmcnt(0)" ::: "memory"); __syncthreads();
    if (h + 1 < 8) FS_STAGE_X(h + 1);
    const float al = acs2[h * 256 + l]; f32x16 o[2];
#pragma unroll
    for (int r = 0; r < 16; ++r) { o[0][r] = 0.f; o[1][r] = 0.f; }
#pragma unroll
    for (int j = 0; j < 4; ++j) { if (64 * j <= 32 * wid + 31) { f32x16 p0, p1;
#pragma unroll
        for (int r = 0; r < 16; ++r) asm volatile("" : "+v"(Sp[j][r]));
#pragma unroll
        for (int r = 0; r < 8; ++r) { p0[2 * r] = __uint_as_float(Sp[j][r] << 16); p0[2 * r + 1] = __uint_as_float(Sp[j][r] & 0xffff0000u); p1[2 * r] = __uint_as_float(Sp[j][8 + r] << 16); p1[2 * r + 1] = __uint_as_float(Sp[j][8 + r] & 0xffff0000u); }
#pragma unroll
        for (int gq = 0; gq < 4; ++gq) { const int s0 = 64 * j + 8 * gq + 4 * hi; const f32x4 a0 = *(const LAS f32x4*)(acs2 + h * 256 + s0), d0v = *(const LAS f32x4*)(dtl + h * 256 + s0), a1 = *(const LAS f32x4*)(acs2 + h * 256 + s0 + 32), d1v = *(const LAS f32x4*)(dtl + h * 256 + s0 + 32);
#pragma unroll
          for (int k = 0; k < 4; ++k) { const int r = 4 * gq + k, s = s0 + k; p0[r] = (s <= l) ? p0[r] * ex2(al - a0[k]) * d0v[k] : 0.f; p1[r] = (s + 32 <= l) ? p1[r] * ex2(al - a1[k]) * d1v[k] : 0.f; } }
        u32x4 w0, w1, w2, w3;
        w0.x = pg8::cvt_pk_bf16(p0[0], p0[1]); w0.y = pg8::cvt_pk_bf16(p0[2], p0[3]); w0.z = pg8::cvt_pk_bf16(p0[4], p0[5]); w0.w = pg8::cvt_pk_bf16(p0[6], p0[7]);
        w1.x = pg8::cvt_pk_bf16(p0[8], p0[9]); w1.y = pg8::cvt_pk_bf16(p0[10], p0[11]); w1.z = pg8::cvt_pk_bf16(p0[12], p0[13]); w1.w = pg8::cvt_pk_bf16(p0[14], p0[15]);
        w2.x = pg8::cvt_pk_bf16(p1[0], p1[1]); w2.y = pg8::cvt_pk_bf16(p1[2], p1[3]); w2.z = pg8::cvt_pk_bf16(p1[4], p1[5]); w2.w = pg8::cvt_pk_bf16(p1[6], p1[7]);
        w3.x = pg8::cvt_pk_bf16(p1[8], p1[9]); w3.y = pg8::cvt_pk_bf16(p1[10], p1[11]); w3.z = pg8::cvt_pk_bf16(p1[12], p1[13]); w3.w = pg8::cvt_pk_bf16(p1[14], p1[15]);
        fa::pv(o, vb0 + L_XV + (h & 1) * 32768 + j * 8192, __builtin_bit_cast(bf16x8, w0), __builtin_bit_cast(bf16x8, w1), __builtin_bit_cast(bf16x8, w2), __builtin_bit_cast(bf16x8, w3)); } }
    { const float dsk = I.d_skip[hh]; const LAS u16* xi = (const LAS u16*)(lds + L_XV + (h & 1) * 32768 + (wid >> 1) * 8192); LAS u16* stg = (LAS u16*)(lds + L_OST) + wid * 2048;
#pragma unroll
      for (int r = 0; r < 16; ++r) { const int key = 32 * (wid & 1) + crow(r, hi);
#pragma unroll
        for (int d0 = 0; d0 < 2; ++d0) { const float xv = nv::bf2f(xi[d0 * 2048 + (key >> 4) * 512 + (key & 15) * 32 + r32]); stg[crow(r, hi) * 64 + d0 * 32 + r32] = nv::f2bf(o[d0][r] + dsk * xv); } }
      asm volatile("s_waitcnt lgkmcnt(0)" ::: "memory");
      u16* Ow = X.XC + (tok0 + 32 * wid) * SCD + hh * 64;
#pragma unroll
      for (int q = 0; q < 4; ++q) { const int row = q * 8 + (lane >> 3), ch = lane & 7; const u32x4 v = *(const LAS u32x4*)(stg + row * 64 + ch * 8); *(u32x4*)(Ow + (size_t)row * SCD + ch * 8) = v; } } }
#undef FS_STAGE_X
  __syncthreads();
}
__device__ __forceinline__ void phase_ssd_x(LAS unsigned char* lds, const Inputs& I, const Bufs& B, const SsdBufs& X) {
  for (int u = blockIdx.x; u < 256; u += gridDim.x) ssd_x_unit(lds, I, B, X, u >> 5, (u >> 1) & 15, u & 1);
}
__device__ __forceinline__ void phase_ssd_scan(const SsdBufs& X) {
  for (int it = blockIdx.x * 512 + fx::otid(); it < 8 * 16 * 64 * 32; it += gridDim.x * 512) { const int n4 = (it & 31) * 4, p = (it >> 5) & 63, hh = (it >> 11) & 15, b = it >> 15;
    pg8::u32x2 v[16]; float dec[16];
#pragma unroll
    for (int c = 0; c < 16; ++c) { v[c] = *(const pg8::u32x2*)(X.STATE + (((size_t)b * 16 + c) * 16 + hh) * 8192 + p * 128 + n4); dec[c] = X.DEC[((size_t)b * 16 + c) * 16 + hh]; }
    float h0 = 0.f, h1 = 0.f, h2 = 0.f, h3 = 0.f;
#pragma unroll
    for (int c = 0; c < 16; ++c) { pg8::u32x2 o; o.x = fx::pk2(h0, h1); o.y = fx::pk2(h2, h3); *(pg8::u32x2*)(X.STATE + (((size_t)b * 16 + c) * 16 + hh) * 8192 + p * 128 + n4) = o;
      h0 = h0 * dec[c] + __uint_as_float(v[c].x << 16); h1 = h1 * dec[c] + __uint_as_float(v[c].x & 0xffff0000u); h2 = h2 * dec[c] + __uint_as_float(v[c].y << 16); h3 = h3 * dec[c] + __uint_as_float(v[c].y & 0xffff0000u); } }
}
__device__ __forceinline__ void ssd_y_unit(LAS unsigned char* lds, const Inputs& I, const Bufs& B, const SsdBufs& X, int b, int c, int g) {
  const int tid = fx::otid(), lane = tid & 63, wid = __builtin_amdgcn_readfirstlane(tid >> 6), r32 = lane & 31, hi = lane >> 5;
  const size_t tok0 = (size_t)b * S + (size_t)c * 256; const int l = 32 * wid + r32;
  LAS float* acsw = (LAS float*)(lds + 0) + wid * 32 * 8;
  LAS u16* stg1 = (LAS u16*)(lds + 16384) + wid * 2048; LAS u16* stg2 = (LAS u16*)(lds + 49152) + wid * 2048; LAS float* rstdL = (LAS float*)(lds + 81920);
  { const int row = lane >> 1, h4 = (lane & 1) * 4; const f32x4 a = *(const f32x4*)(X.ACS + (tok0 + 32 * wid + row) * 16 + g * 8 + h4); acsw[row * 8 + h4 + 0] = ex2(a.x); acsw[row * 8 + h4 + 1] = ex2(a.y); acsw[row * 8 + h4 + 2] = ex2(a.z); acsw[row * 8 + h4 + 3] = ex2(a.w); }
  bf16x8 qr[8];
#pragma unroll
  for (int d0 = 0; d0 < 8; ++d0) qr[d0] = *(const bf16x8*)(X.XC + (tok0 + l) * SCD + 1280 + g * 128 + d0 * 16 + hi * 8);
  float ssq[16];
#pragma unroll
  for (int r = 0; r < 16; ++r) ssq[r] = 0.f;
#pragma unroll 1
  for (int h = 0; h < 8; ++h) { const int hh = g * 8 + h; const u16* pv_ = X.STATE + (((size_t)b * 16 + c) * 16 + hh) * 8192;
    f32x16 y[2];
#pragma unroll
    for (int r = 0; r < 16; ++r) { y[0][r] = 0.f; y[1][r] = 0.f; }
#pragma unroll
    for (int d0 = 0; d0 < 8; ++d0) { const bf16x8 b0 = *(const bf16x8*)(pv_ + (size_t)r32 * 128 + d0 * 16 + hi * 8), b1 = *(const bf16x8*)(pv_ + (size_t)(32 + r32) * 128 + d0 * 16 + hi * 8);
      y[0] = __builtin_amdgcn_mfma_f32_32x32x16_bf16(qr[d0], b0, y[0], 0, 0, 0); y[1] = __builtin_amdgcn_mfma_f32_32x32x16_bf16(qr[d0], b1, y[1], 0, 0, 0); }
#pragma unroll
    for (int q = 0; q < 4; ++q) { const int row = q * 8 + (lane >> 3), ch = lane & 7;
      *(LAS u32x4*)(stg1 + row * 64 + ch * 8) = *(const u32x4*)(X.XC + (tok0 + 32 * wid + row) * SCD + hh * 64 + ch * 8);
      *(LAS u32x4*)(stg2 + row * 64 + ch * 8) = *(const u32x4*)(B.Z + (tok0 + 32 * wid + row) * 1024 + hh * 64 + ch * 8); }
    asm volatile("s_waitcnt lgkmcnt(0)" ::: "memory");
#pragma unroll
    for (int r = 0; r < 16; ++r) { const int row = crow(r, hi); const float ea = acsw[row * 8 + h];
#pragma unroll
      for (int d0 = 0; d0 < 2; ++d0) { const int idx = row * 64 + d0 * 32 + r32; const float yy = nv::bf2f(stg1[idx]) + ea * y[d0][r]; const float zz = nv::bf2f(stg2[idx]); const float yg = yy * zz * fx::fsig(zz); ssq[r] += yg * yg; stg1[idx] = nv::f2bf(yg); } }
    asm volatile("s_waitcnt lgkmcnt(0)" ::: "memory");
#pragma unroll
    for (int q = 0; q < 4; ++q) { const int row = q * 8 + (lane >> 3), ch = lane & 7; *(u32x4*)(B.YB + (tok0 + 32 * wid + row) * 1024 + hh * 64 + ch * 8) = *(const LAS u32x4*)(stg1 + row * 64 + ch * 8); }
    asm volatile("s_waitcnt lgkmcnt(0)" ::: "memory"); }
#pragma unroll
  for (int r = 0; r < 16; ++r) { float v = ssq[r];
#pragma unroll
    for (int o = 1; o < 32; o <<= 1) v += __shfl_xor(v, o);
    if (r32 == 0) rstdL[32 * wid + crow(r, hi)] = 1.0f / sqrtf(v * (1.f / 512.f) + nv::EPS); }
  __threadfence(); __syncthreads();
#pragma unroll 1
  for (int q0 = tid; q0 < 256 * 64; q0 += 512 * 8) { float v[8][8];
#pragma unroll
    for (int u = 0; u < 8; ++u) { const int q = q0 + u * 512, row = q >> 6, c8 = (q & 63) * 8; fx::load8(B.YB + (tok0 + row) * 1024 + g * 512 + c8, v[u]); }
#pragma unroll
    for (int u = 0; u < 8; ++u) { const int q = q0 + u * 512, row = q >> 6, c8 = (q & 63) * 8; const float rs = rstdL[row];
#pragma unroll
      for (int j = 0; j < 8; ++j) v[u][j] = v[u][j] * rs * I.ssm_norm[g * 512 + c8 + j];
      fx::store8(B.YB + (tok0 + row) * 1024 + g * 512 + c8, v[u]); } }
  __syncthreads();
}
__device__ __forceinline__ void phase_ssd_y(LAS unsigned char* lds, const Inputs& I, const Bufs& B, const SsdBufs& X) {
  for (int u = blockIdx.x; u < 256; u += gridDim.x) ssd_y_unit(lds, I, B, X, u >> 5, (u >> 1) & 15, u & 1);
}
}
namespace fc {
using nv::u16; using nv::Bufs; using nv::Inputs; using pg8::Unit;
constexpr int S = nv::S;
struct CmpBufs { u16* WcT; float* BIAS1; float* PAB; };
__host__ __device__ inline size_t carve_cmp(CmpBufs& C, unsigned char* ws, size_t off) {
  auto take = [&](size_t bytes) { unsigned char* r = ws + off; off += (bytes + 255) / 256 * 256; return r; };
  C.WcT = (u16*)take((size_t)2 * 256 * 1024 * 2); C.BIAS1 = (float*)take(2 * 128 * 4); C.PAB = (float*)take((size_t)2 * 16 * 256 * 256 * 4);
  return off;
}
struct CpCmp { const float* src; int ld; __device__ const float* operator()(int n) const { return n < 128 ? src + n : src + (size_t)1024 * 128 + (n - 128); } };
__device__ __forceinline__ void prologue_cmp(LAS unsigned char* lds, const Inputs& I, const CmpBufs& C) {
  { const int tid = fx::otid(), lane = tid & 63, wv = tid >> 6, gw = fx::obid() * 8 + wv, ngw = gridDim.x * 8; LAS float* scr = (LAS float*)lds + wv * (64 * 33);
    for (int t = gw; t < 2 * 8 * 16; t += ngw) { const int kv = t >> 7, q = t & 127; CpCmp cp{kv ? I.w1_v : I.w1_k, 128}; fx::transpose_item(scr, cp, C.WcT + (size_t)kv * 256 * 1024, 1024, (q >> 4) * 32, (q & 15) * 64, lane); } }
  { const int tid = fx::otid(), lane = tid & 63, gw = fx::obid() * 8 + (tid >> 6);
    if (gw < 256) { const int kv = gw >> 7, n = gw & 127; const float* w1 = kv ? I.w1_v : I.w1_k; const float* pos = kv ? I.pos_v : I.pos_k; float s = 0.f;
      for (int k = lane; k < 2048; k += 64) s += pos[k] * w1[(size_t)k * 128 + n];
      s = fx::wave_sum(s); if (lane == 0) C.BIAS1[kv * 128 + n] = s; } }
}
struct SchedCmp { int kv, bg;
  __device__ bool next(int i, Unit& u) const { if (i > 0) return false; u.pm = kv * 16 + bg; u.pn = 0; u.aux0 = 0; u.aux1 = 0; return true; }
  __device__ __forceinline__ const char* a_base(const pg8::Gemm& g, const Unit&) const { return (const char*)g.A; }
  __device__ __forceinline__ const char* b_base(const pg8::Gemm& g, const Unit&) const { return (const char*)g.Bt + (size_t)kv * 256 * 1024 * 2; }
  __device__ __forceinline__ int a_row(const Unit&, int r) const { return ((bg >> 1) * S + 16 * r) * 1280 + (kv ? nv::O_VC : nv::O_KC) + (bg & 1) * 64; } };
struct FPab { float* o; __device__ __forceinline__ void operator()(const Unit&, int row, int c, const float (&v)[8]) const { float* p = o + (size_t)row * 256 + c; *(pg8::f32x4*)p = (pg8::f32x4){v[0], v[1], v[2], v[3]}; *(pg8::f32x4*)(p + 4) = (pg8::f32x4){v[4], v[5], v[6], v[7]}; } };
__device__ __forceinline__ void phase_cmp_gemm(LAS unsigned char* lds, const Bufs& B, const CmpBufs& C) {
  for (int u = (int)blockIdx.x - ((int)gridDim.x - 32); u >= 0 && u < 32; u += gridDim.x) { pg8::Gemm g{B.QKV, C.WcT, 256, 256, 1024, 1, 1024, 1280 * 2}; SchedCmp S{u >> 4, u & 15}; fx::Epi8<FPab> E{FPab{C.PAB}};
    pg8::gemm_phase<fx::Epi8<FPab>, SchedCmp, true, true>(lds, g, S, E); }
}
__device__ __forceinline__ void phase_cmp_finish(LAS unsigned char* lds, const Inputs& I, const Bufs& B, const CmpBufs& C) {
  const int tid = fx::otid(), lane = tid & 63, wv = tid >> 6, gw = fx::obid() * 8 + wv, ngw = gridDim.x * 8;
  LAS float* w2s = (LAS float*)lds; LAS float* hs = (LAS float*)(lds + 65536) + wv * 128;
  for (int k = tid; k < 2 * 128 * 64 / 4; k += 512) { const int kv = k >> 11, q = k & 2047; *(LAS pg8::f32x4*)(w2s + kv * 8192 + q * 4) = *(const pg8::f32x4*)((kv ? I.w2_v : I.w2_k) + q * 4); }
  __syncthreads();
  for (int it = gw; it < 2 * 16 * 256; it += ngw) { const int kv = it >> 12, bg = (it >> 8) & 15, c = it & 255; u16* dst = (kv ? B.VCMP : B.KCMP) + ((size_t)bg * 256 + c) * 64;
    if (c == 255) { dst[lane] = 0; continue; }
    const float* pa = C.PAB + ((size_t)(kv * 16 + bg) * 256 + c) * 256; const float* pb = pa + 256 + 128; const float* b1 = C.BIAS1 + kv * 128;
    { const float ha = pa[lane] + pb[lane] + b1[lane], hb = pa[64 + lane] + pb[64 + lane] + b1[64 + lane]; hs[lane] = ha * fx::fsig(ha); hs[64 + lane] = hb * fx::fsig(hb); }
    const LAS float* w2 = w2s + kv * 8192; float acc = 0.f;
#pragma unroll 8
    for (int n = 0; n < 128; ++n) acc += hs[n] * w2[n * 64 + lane];
    if (kv == 0) { const float ss = fx::wave_sum(acc * acc); acc = acc * (1.0f / sqrtf(ss * (1.f / 64.f) + nv::EPS)) * I.kc_gain[lane]; }
    dst[lane] = nv::f2bf(acc); }
  __syncthreads();
}
}
struct Params { nv::Inputs I; float* out; unsigned char* ws; };
constexpr int LDS_BYTES = 147456;
template <class F> __device__ __forceinline__ void run_phase(const F& f, long n) {
  for (long i = blockIdx.x * 512L + fx::otid(); i < n; i += (long)gridDim.x * 512L) f(i);
}
__global__ void __launch_bounds__(512) mega_fwd(Params P) {
  extern __shared__ __attribute__((aligned(16))) unsigned char lds_raw[];
  LAS unsigned char* lds = (LAS unsigned char*)lds_raw;
  cg::grid_group grid = cg::this_grid();
#define PH(...) { unsigned char* ws_ = P.ws; float* out = P.out; asm volatile("" : "+s"(ws_), "+s"(out)); nv::Bufs B; const size_t woff = nv::carve(B, ws_, out); fx::WBufs W; const size_t moff = fx::carve_w(W, ws_, woff); \
    fx::MoeBufs M; const size_t soff = fx::carve_moe(M, B, ws_, moff); fs::SsdBufs X; const size_t coff = fs::carve_ssd(X, B, ws_, soff); fc::CmpBufs C; const size_t boff = fc::carve_cmp(C, ws_, coff); unsigned* barw = (unsigned*)(ws_ + boff); (void)barw; (void)W; (void)M; (void)X; (void)C; __VA_ARGS__ }
  if (threadIdx.x < 4) ((LAS unsigned*)(lds + LDS_BYTES - 16))[threadIdx.x] = 0u;
  __syncthreads();
  xb::XcdBarrier bar; PH( bar = xb::xcd_barrier_post(barw, (volatile LAS unsigned*)(lds + LDS_BYTES - 16)); )
#define GSYNC() xb::xcd_barrier(bar)
  PH( fx::phase_prologue(lds, P.I, B, W); fx::phase_rms_rows(P.I.x, P.I.mix_norm, B.HB); fx::prologue_pb(P.I, W); fx::prologue_moe(P.I, M); fc::prologue_cmp(lds, P.I, C); ) grid.sync();
  PH( fx::dense_gemm(lds, B.HB, 1024, W.WinT, 1024, nv::NTOK, fx::INW_PAD, 1024, fx::FInProj{B.QKV, B.Z, B.XBC, B.BG, B.NG, B.DT, P.I.dt_bias}); ) GSYNC();
  PH( fc::phase_cmp_gemm(lds, B, C); fs::phase_conv(P.I, B, X); fa::phase_qknorm(P.I, B); ) GSYNC();
  PH( fs::phase_ssd_x(lds, P.I, B, X); ) GSYNC();
  PH( fs::phase_ssd_scan(X); fc::phase_cmp_finish(lds, P.I, B, C); ) GSYNC();
  PH( fs::phase_ssd_y(lds, P.I, B, X); ) GSYNC();
  PH( fa::phase_attention(lds, B); ) GSYNC();
  PH( fx::dense_gemm(lds, B.YA, 512, W.WaT, 512, nv::NTOK, 1024, 512, fx::FStoreBf{B.T1, 1024}); )
  PH( fx::dense_gemm(lds, B.YB, 1024, W.WbT, 1024, nv::NTOK, 1024, 1024, fx::FMerge{B.T1, B.BG, B.MERGED}); ) GSYNC();
  PH( fx::dense_gemm(lds, B.MERGED, 1024, W.WoutT, 1024, nv::NTOK, 1024, 1024, fx::FResid{P.I.x, out}); ) GSYNC();
  PH( fx::phase_rms_rows(out, P.I.moe_norm, B.H2); ) GSYNC();
  PH( fx::dense_gemm(lds, B.H2, 1024, M.WrT, 1024, nv::NTOK, 256, 1024, fx::FLogits{M.LOGITS}); ) GSYNC();
  PH( fx::phase_route(lds, P.I, B, M); ) GSYNC();
  PH( fx::build_tile_table(lds, M); )
  PH( fx::phase_moe_gu(lds, B, W, M); ) GSYNC();
  PH( fx::phase_moe_down(lds, B, W, M); ) GSYNC();
  PH( fx::phase_moe_combine(lds, out, M, B.EW, P.I.ple_norm, B.H2); ) GSYNC();
  PH( fx::dense_gemm(lds, W.PB, 256, W.PlePT, 256, nv::NTOK, 1024, 256, fx::FStoreBf{B.PP, 1024}); )
  PH( fx::dense_gemm(lds, B.H2, 1024, W.PleGT, 1024, nv::NTOK, 1024, 1024, fx::FPle{out, B.PP}); )
#undef GSYNC
}
extern "C" void kernel_launch(void* const* d_in, const int* in_sizes, int n_in, void* d_out, int out_size, void* d_ws, size_t ws_size, hipStream_t stream) {
  static int grid_blocks = 0;
  if (!grid_blocks) {
    int dev = 0, cus = 0, per_cu = 0;
    (void)hipGetDevice(&dev);
    (void)hipDeviceGetAttribute(&cus, hipDeviceAttributeMultiprocessorCount, dev);
    if (hipFuncSetAttribute((const void*)mega_fwd, hipFuncAttributeMaxDynamicSharedMemorySize, LDS_BYTES) != hipSuccess) fprintf(stderr, "kernel_launch: hipFuncSetAttribute failed\n");
    if (hipOccupancyMaxActiveBlocksPerMultiprocessor(&per_cu, mega_fwd, 512, LDS_BYTES) != hipSuccess || per_cu < 1) { fprintf(stderr, "kernel_launch: occupancy query says %d blocks per CU\n", per_cu); }
    grid_blocks = cus;
    { nv::Bufs B; fx::WBufs W; fx::MoeBufs M; fs::SsdBufs X; fc::CmpBufs C; size_t need = 16384 + fc::carve_cmp(C, nullptr, fs::carve_ssd(X, B, nullptr, fx::carve_moe(M, B, nullptr, fx::carve_w(W, nullptr, nv::carve(B, nullptr, nullptr))))); if (need > ws_size) fprintf(stderr, "kernel_launch: workspace too small: need %zu have %zu\n", need, ws_size); }
  }
  static size_t bar_off = 0;
  if (!bar_off) { nv::Bufs B; fx::WBufs W; fx::MoeBufs M; fs::SsdBufs X; fc::CmpBufs C; bar_off = fc::carve_cmp(C, nullptr, fs::carve_ssd(X, B, nullptr, fx::carve_moe(M, B, nullptr, fx::carve_w(W, nullptr, nv::carve(B, nullptr, nullptr))))); }
  (void)hipMemsetAsync((char*)d_ws + bar_off, 0, 16384, stream);
  Params p; memset(&p, 0, sizeof(p));
  const float** ip = (const float**)&p.I; for (int i = 0; i < 34; ++i) ip[i] = (const float*)d_in[i];
  p.out = (float*)d_out; p.ws = (unsigned char*)d_ws;
  void* args[] = {&p};
  hipError_t e = hipLaunchCooperativeKernel((void*)mega_fwd, dim3(grid_blocks), dim3(512), args, LDS_BYTES, stream);
  if (e != hipSuccess) fprintf(stderr, "cooperative launch failed: %s (grid %d)\n", hipGetErrorString(e), grid_blocks);
}
```

```cpp
#include <hip/hip_runtime.h>
#include <hip/hip_cooperative_groups.h>
#include <cstdio>
#include <cstring>
namespace cg = cooperative_groups;
#define HD __host__ __device__ inline
#if defined(__HIP_DEVICE_COMPILE__)
#define NV_FENCE() asm volatile("" ::: "memory")
#else
#define NV_FENCE()
#endif
#ifndef CFG_DM
#define CFG_DM 1024
#endif
#ifndef CFG_BATCH
#define CFG_BATCH 8
#endif
#ifndef CFG_SEQ
#define CFG_SEQ 4096
#endif
#ifndef CFG_MH
#define CFG_MH 256
#endif
#ifndef CFG_PLE
#define CFG_PLE 256
#endif

#ifndef NV_FENCE
#define NV_FENCE()
#endif
namespace nv {
typedef unsigned short u16;
typedef unsigned long long u64;
constexpr int DM = CFG_DM, NB = CFG_BATCH, S = CFG_SEQ, MH = CFG_MH, PLE = CFG_PLE;
constexpr int NTOK = NB * S;
constexpr int H = 8, G = 2, E = 4;
constexpr int QW = 512, GW = 24, QKVW = 1280;
constexpr int SH = 16, SP = 64, SI = 1024, SG = 2, SN = 128, SCD = 1536;
constexpr int INW = QW + 6 * 128 + GW + SI + SCD + SH + 2 * DM;
constexpr int O_Q = 0, O_KC = 512, O_VC = 640, O_KS = 768, O_VS = 896, O_KW = 1024, O_VW = 1152, O_NG = 1280, O_Z = 1304, O_XBC = 2328, O_DT = 3864, O_BG = 3880;
static_assert(O_BG + 2 * DM == INW, "in-proj width");
constexpr int NCMP = S / 16 - 1, NCP = S / 16, NSEL = S / 64, NTOP = NSEL < 16 ? NSEL : 16;
constexpr int NEXP = 32;
constexpr float EPS = 1e-6f;

HD float sigmoidf_(float x) { return 1.0f / (1.0f + expf(-x)); }
HD float siluf_(float x) { return x / (1.0f + expf(-x)); }
HD float softplusf_(float x) { return x > 20.f ? x : log1pf(expf(x)); }
HD u16 f2bf(float f) { unsigned u = __builtin_bit_cast(unsigned, f); u += 0x7fffu + ((u >> 16) & 1u); return (u16)(u >> 16); }
HD float bf2f(u16 h) { return __builtin_bit_cast(float, (unsigned)h << 16); }

struct Bufs {
  u16* HB;
  u16* QKV;
  float* NG;
  u16* Z;
  u16* XBC;
  float* DT;
  u16* BG;
  u16* KCMP;
  u16* VCMP;
  u16* YA;
  u16* YB;
  u16* T1;
  u16* MERGED;
  u16* H2;
  u16* ACT;
  u16* PP;
  int* EI;
  float* EW;
  float* HID;
  float* KTMP;
  float* ML;
  float* IMP;
  u64* MASK;
};
struct Inputs { const float *x, *p, *mix_norm, *w_in, *q_gain, *kc_gain, *ks_gain, *kw_gain, *pos_k, *w1_k, *w2_k, *pos_v, *w1_v, *w2_v, *conv_w, *conv_b, *dt_bias, *a_log, *d_skip, *ssm_norm,
  *w_a, *w_b, *w_out, *moe_norm, *w_group, *b_group, *w_expert, *b_expert, *w_gate, *w_up, *w_down, *ple_norm, *ple_wg, *ple_wp; };

struct RmsRowsBf { const float* in; const float* gain; u16* out; long ncols;
  HD void operator()(long r) const { const float* x = in + r * ncols; float s = 0.f; for (long c = 0; c < ncols; ++c) s += x[c] * x[c];
    const float rs = 1.0f / sqrtf(s / (float)ncols + EPS); u16* o = out + r * ncols; for (long c = 0; c < ncols; ++c) o[c] = f2bf(x[c] * rs * gain[c]); } };

template <class AL, class EP> struct GemmT { AL a; const float* B; EP ep; long M, N, K, ldb;
  HD long items() const { return ((M + 7) / 8) * ((N + 3) / 4); }
  HD void operator()(long it) const { const long nt = (N + 3) / 4; const long tm = it / nt, tn = it % nt; const long r0 = tm * 8, c0 = tn * 4;
    float acc[8][4];
#pragma unroll
    for (int i = 0; i < 8; ++i)
#pragma unroll
      for (int j = 0; j < 4; ++j) acc[i][j] = 0.f;
    for (long k = 0; k < K; ++k) { float b[4];
#pragma unroll
      for (int j = 0; j < 4; ++j) b[j] = (c0 + j < N) ? B[k * ldb + c0 + j] : 0.f;
#pragma unroll
      for (int i = 0; i < 8; ++i) { const long r = r0 + i < M ? r0 + i : M - 1; const float av = a(r, k);
#pragma unroll
        for (int j = 0; j < 4; ++j) acc[i][j] += av * b[j]; } }
#pragma unroll
    for (int i = 0; i < 8; ++i) if (r0 + i < M) {
#pragma unroll
      for (int j = 0; j < 4; ++j) if (c0 + j < N) ep(r0 + i, c0 + j, acc[i][j]); } } };
struct ABf { const u16* p; long ld; HD float operator()(long r, long k) const { return bf2f(p[r * ld + k]); } };
struct AF32 { const float* p; long ld; HD float operator()(long r, long k) const { return p[r * ld + k]; } };
struct ACmp { const u16* qkv; const float* pos; long off;
  HD float operator()(long r, long k) const { const long c = r % NCMP, bg = r / NCMP, b = bg / G, g = bg % G; const long l = k / 64, d = k % 64;
    return bf2f(qkv[(b * S + 16 * c + l) * QKVW + off + g * 64 + d]) + pos[k]; } };

struct EpInProj { Bufs B; const float* dt_bias;
  HD void operator()(long r, long c, float v) const {
    if (c < O_NG) B.QKV[r * QKVW + c] = f2bf(v);
    else if (c < O_Z) B.NG[r * GW + (c - O_NG)] = sigmoidf_(v);
    else if (c < O_XBC) B.Z[r * SI + (c - O_Z)] = f2bf(v);
    else if (c < O_DT) B.XBC[r * SCD + (c - O_XBC)] = f2bf(v);
    else if (c < O_BG) B.DT[r * SH + (c - O_DT)] = softplusf_(v + dt_bias[c - O_DT]);
    else B.BG[r * (2 * DM) + (c - O_BG)] = f2bf(sigmoidf_(v)); } };
struct EpSiluF32 { float* o; long ld; HD void operator()(long r, long c, float v) const { o[r * ld + c] = siluf_(v); } };
struct EpF32 { float* o; long ld; HD void operator()(long r, long c, float v) const { o[r * ld + c] = v; } };
struct EpBf { u16* o; long ld; HD void operator()(long r, long c, float v) const { o[r * ld + c] = f2bf(v); } };
struct EpMerge { const u16* t1; const u16* bg; u16* o; HD void operator()(long r, long c, float v) const { const float ga = bf2f(bg[r * (2 * DM) + c]), gb = bf2f(bg[r * (2 * DM) + DM + c]); o[r * DM + c] = f2bf(ga * bf2f(t1[r * DM + c]) + gb * v); } };
struct EpResid { const float* x; float* o; HD void operator()(long r, long c, float v) const { o[r * DM + c] = x[r * DM + c] + v; } };
struct EpPle { float* x; const u16* pp; HD void operator()(long r, long c, float v) const { x[r * DM + c] = x[r * DM + c] + sigmoidf_(v) * bf2f(pp[r * DM + c]); } };

struct QkNorm { u16* qkv; const float* qg; const float* ksg; const float* kwg;
  HD long items() const { return (long)NTOK * 12; }
  HD void operator()(long it) const { const long tok = it / 12; const int w = (int)(it % 12); u16* v; const float* gain;
    if (w < 8) { v = qkv + tok * QKVW + O_Q + w * 64; gain = qg; } else if (w < 10) { v = qkv + tok * QKVW + O_KS + (w - 8) * 64; gain = ksg; } else { v = qkv + tok * QKVW + O_KW + (w - 10) * 64; gain = kwg; }
    float s = 0.f; for (int d = 0; d < 64; ++d) { const float x = bf2f(v[d]); s += x * x; } const float rs = 1.0f / sqrtf(s / 64.f + EPS);
    for (int d = 0; d < 64; ++d) v[d] = f2bf(bf2f(v[d]) * rs * gain[d]); } };
struct CmpFinish { const float* src; const float* gain; u16* dst; long donorm;
  HD long items() const { return (long)NB * G * NCP; }
  HD void operator()(long it) const { const long c = it % NCP, bg = it / NCP; u16* o = dst + it * 64;
    if (c >= NCMP) { for (int d = 0; d < 64; ++d) o[d] = 0; return; }
    const float* x = src + (bg * NCMP + c) * 64; float rs = 1.f;
    if (donorm) { float s = 0.f; for (int d = 0; d < 64; ++d) s += x[d] * x[d]; rs = 1.0f / sqrtf(s / 64.f + EPS); }
    for (int d = 0; d < 64; ++d) o[d] = f2bf(donorm ? x[d] * rs * gain[d] : x[d]); } };

struct CmpAttn { Bufs B;
  HD long items() const { return (long)NB * H * S; }
  HD void operator()(long it) const { const long t = it % S; const int h = (int)((it / S) % H), g = h / E; const long b = it / ((long)S * H); const long tok = b * S + t;
    const u16* q = B.QKV + tok * QKVW + O_Q + h * 64; const u16* kc = B.KCMP + (b * G + g) * (long)NCP * 64; const u16* vc = B.VCMP + (b * G + g) * (long)NCP * 64;
    float qr[64];
#pragma unroll
    for (int d = 0; d < 64; ++d) qr[d] = bf2f(q[d]);
    long nvis = (t - 31 >= 0) ? (t - 31) / 16 + 1 : 0; if (nvis > NCMP) nvis = NCMP;
    float m = -3.0e38f;
    for (long c = 0; c < nvis; ++c) { const u16* k = kc + c * 64; float s = 0.f;
#pragma unroll
      for (int d = 0; d < 64; ++d) s += qr[d] * bf2f(k[d]);
      s *= 0.125f; m = s > m ? s : m; }
    float o[64];
#pragma unroll
    for (int d = 0; d < 64; ++d) o[d] = 0.f;
    float l = 0.f;
    for (long c = 0; c < nvis; ++c) { const u16* k = kc + c * 64; const u16* v = vc + c * 64; float s = 0.f;
#pragma unroll
      for (int d = 0; d < 64; ++d) s += qr[d] * bf2f(k[d]);
      const float p = expf(s * 0.125f - m); l += p;
#pragma unroll
      for (int d = 0; d < 64; ++d) o[d] += p * bf2f(v[d]); }
    const float g0 = B.NG[tok * GW + h * 3 + 0]; const float inv = nvis > 0 ? g0 / l : 0.f;
#pragma unroll
    for (int d = 0; d < 64; ++d) B.YA[tok * QW + h * 64 + d] = f2bf(o[d] * inv);
    B.ML[it * 2] = m; B.ML[it * 2 + 1] = nvis > 0 ? l : 0.f; } };
struct Importance { Bufs B;
  HD long items() const { return (long)NB * G * S * NSEL; }
  HD void operator()(long it) const { const int j = (int)(it % NSEL); const long bgt = it / NSEL; const long t = bgt % S; const long bg = bgt / S; const long b = bg / G; const int g = (int)(bg % G); const long tok = b * S + t;
    long nvis = (t - 31 >= 0) ? (t - 31) / 16 + 1 : 0; if (nvis > NCMP) nvis = NCMP;
    long c0 = 4 * j - 1; if (c0 < 0) c0 = 0; long c1 = 4 * j + 3; if (c1 > nvis - 1) c1 = nvis - 1;
    const u16* kc = B.KCMP + bg * (long)NCP * 64; float acc = 0.f;
    for (int e = 0; e < E; ++e) { const int h = g * E + e; const u16* q = B.QKV + tok * QKVW + O_Q + h * 64; const long mi = ((b * H + h) * (long)S + t) * 2; const float m = B.ML[mi], l = B.ML[mi + 1];
      if (l > 0.f) for (long c = c0; c <= c1; ++c) { const u16* k = kc + c * 64; float s = 0.f; for (int d = 0; d < 64; ++d) s += bf2f(q[d]) * bf2f(k[d]); acc += expf(s * 0.125f - m) / l; } }
    B.IMP[bgt * 64 + j] = acc; } };
struct TopSel { Bufs B;
  HD long items() const { return (long)NB * G * S; }
  HD void operator()(long bgt) const { const long t = bgt % S; const int cur = (int)(t / 64); u64 m = 0ull;
    for (int r = 0; r < NTOP; ++r) { float best = -3.0e38f; int bj = -1;
      for (int j = 0; j <= cur && j < NSEL; ++j) { if ((m >> j) & 1ull) continue; float v = B.IMP[bgt * 64 + j]; if (j == 0 || j == cur || j == cur - 1) v += 1000.f; if (v > best) { best = v; bj = j; } }
      if (bj < 0) break; m |= 1ull << bj; }
    B.MASK[bgt] = m; } };
struct SelAttn { Bufs B;
  HD long items() const { return (long)NB * H * S; }
  HD void operator()(long it) const { const long t = it % S; const int h = (int)((it / S) % H), g = h / E; const long b = it / ((long)S * H); const long tok = b * S + t;
    const u16* q = B.QKV + tok * QKVW + O_Q + h * 64; const u64 mk = B.MASK[(b * G + g) * (long)S + t];
    float qr[64], o[64];
#pragma unroll
    for (int d = 0; d < 64; ++d) { qr[d] = bf2f(q[d]); o[d] = 0.f; }
    float m = -3.0e38f, l = 0.f;
    for (int j = 0; j < NSEL; ++j) { if (!((mk >> j) & 1ull)) continue;
      for (long kp = 64L * j; kp < 64L * j + 64 && kp <= t; ++kp) { const u16* k = B.QKV + (b * S + kp) * QKVW + O_KS + g * 64; const u16* v = B.QKV + (b * S + kp) * QKVW + O_VS + g * 64; float s = 0.f;
#pragma unroll
        for (int d = 0; d < 64; ++d) s += qr[d] * bf2f(k[d]);
        s *= 0.125f;
        if (s > m) { const float f = expf(m - s); l *= f;
#pragma unroll
          for (int d = 0; d < 64; ++d) o[d] *= f;
          m = s; }
        const float p = expf(s - m); l += p;
#pragma unroll
        for (int d = 0; d < 64; ++d) o[d] += p * bf2f(v[d]); } }
    const float g1 = B.NG[tok * GW + h * 3 + 1]; const float inv = g1 / l;
#pragma unroll
    for (int d = 0; d < 64; ++d) { u16* y = B.YA + tok * QW + h * 64 + d; *y = f2bf(bf2f(*y) + o[d] * inv); } } };
struct WinAttn { Bufs B;
  HD long items() const { return (long)NB * H * S; }
  HD void operator()(long it) const { const long t = it % S; const int h = (int)((it / S) % H), g = h / E; const long b = it / ((long)S * H); const long tok = b * S + t;
    const u16* q = B.QKV + tok * QKVW + O_Q + h * 64;
    float qr[64], o[64];
#pragma unroll
    for (int d = 0; d < 64; ++d) { qr[d] = bf2f(q[d]); o[d] = 0.f; }
    float m = -3.0e38f, l = 0.f; long k0 = t - 511; if (k0 < 0) k0 = 0;
    for (long kp = k0; kp <= t; ++kp) { const u16* k = B.QKV + (b * S + kp) * QKVW + O_KW + g * 64; const u16* v = B.QKV + (b * S + kp) * QKVW + O_VW + g * 64; float s = 0.f;
#pragma unroll
      for (int d = 0; d < 64; ++d) s += qr[d] * bf2f(k[d]);
      s *= 0.125f;
      if (s > m) { const float f = expf(m - s); l *= f;
#pragma unroll
        for (int d = 0; d < 64; ++d) o[d] *= f;
        m = s; }
      const float p = expf(s - m); l += p;
#pragma unroll
      for (int d = 0; d < 64; ++d) o[d] += p * bf2f(v[d]); }
    const float g2 = B.NG[tok * GW + h * 3 + 2]; const float inv = g2 / l;
#pragma unroll
    for (int d = 0; d < 64; ++d) { u16* y = B.YA + tok * QW + h * 64 + d; *y = f2bf(bf2f(*y) + o[d] * inv); } } };

struct SsdConv { u16* xbc; const float* cw; const float* cb;
  HD long items() const { return (long)NB * SCD; }
  HD void operator()(long it) const { const int c = (int)(it % SCD); const long b = it / SCD; u16* col = xbc + b * S * SCD + c; const float w0 = cw[c], w1 = cw[SCD + c], w2 = cw[2 * SCD + c], w3 = cw[3 * SCD + c], bias = cb[c];
    for (long t = S - 1; t >= 0; --t) { float a = bias + w3 * bf2f(col[t * SCD]); if (t >= 1) a += w2 * bf2f(col[(t - 1) * SCD]); if (t >= 2) a += w1 * bf2f(col[(t - 2) * SCD]); if (t >= 3) a += w0 * bf2f(col[(t - 3) * SCD]);
      col[t * SCD] = f2bf(siluf_(a)); } } };
struct SsdScan { Bufs B; const float* alog; const float* dskip;
  HD long items() const { return (long)NB * SH * SP; }
  HD void operator()(long it) const { const int p = (int)(it % SP); const int hh = (int)((it / SP) % SH); const long b = it / (SP * SH); const int g = hh / 8;
    const float a = -expf(alog[hh]); float st[128];
#pragma unroll
    for (int n = 0; n < 128; ++n) st[n] = 0.f;
    for (long t = 0; t < S; ++t) { const long tok = b * S + t; const float dt = B.DT[tok * SH + hh]; const float dec = expf(dt * a); const float xd = bf2f(B.XBC[tok * SCD + hh * 64 + p]) * dt;
      const u16* Bv = B.XBC + tok * SCD + SI + g * SN; const u16* Cv = B.XBC + tok * SCD + SI + SG * SN + g * SN; float y = 0.f;
#pragma unroll
      for (int n = 0; n < 128; ++n) { st[n] = st[n] * dec + xd * bf2f(Bv[n]); y += bf2f(Cv[n]) * st[n]; if ((n & 15) == 15) { NV_FENCE(); } }
      B.XBC[tok * SCD + hh * 64 + p] = f2bf(y + bf2f(B.XBC[tok * SCD + hh * 64 + p]) * dskip[hh]); } } };
struct SsdOut { Bufs B; const float* ngain;
  HD long items() const { return (long)NTOK * SG; }
  HD void operator()(long it) const { const long tok = it / SG; const int g = (int)(it % SG); float s = 0.f;
    for (int c = g * 512; c < g * 512 + 512; ++c) { float y = bf2f(B.XBC[tok * SCD + c]); y *= siluf_(bf2f(B.Z[tok * SI + c])); s += y * y; }
    const float rs = 1.0f / sqrtf(s / 512.f + EPS);
    for (int c = g * 512; c < g * 512 + 512; ++c) { float y = bf2f(B.XBC[tok * SCD + c]); y *= siluf_(bf2f(B.Z[tok * SI + c])); B.YB[tok * SI + c] = f2bf(y * rs * ngain[c]); } } };

struct Router { const u16* h2; const float* wg; const float* bg; const float* we; const float* be; int* ei; float* ew;
  HD void operator()(long tok) const { const u16* x = h2 + tok * DM; float gl[4];
#pragma unroll
    for (int j = 0; j < 4; ++j) gl[j] = bg[j];
    for (long d = 0; d < DM; ++d) { const float xv = bf2f(x[d]);
#pragma unroll
      for (int j = 0; j < 4; ++j) gl[j] += xv * wg[d * 4 + j]; }
    int gi = 0; float gm = gl[0];
#pragma unroll
    for (int j = 1; j < 4; ++j) if (gl[j] > gm) { gm = gl[j]; gi = j; }
    float gs = 0.f;
#pragma unroll
    for (int j = 0; j < 4; ++j) gs += expf(gl[j] - gm);
    const float grp_w = 1.0f / gs;
    float el[8];
#pragma unroll
    for (int j = 0; j < 8; ++j) el[j] = be[gi * 8 + j];
    for (long d = 0; d < DM; ++d) { const float xv = bf2f(x[d]);
#pragma unroll
      for (int j = 0; j < 8; ++j) el[j] += xv * we[d * NEXP + gi * 8 + j]; }
    int i0 = 0; float m0 = el[0];
#pragma unroll
    for (int j = 1; j < 8; ++j) if (el[j] > m0) { m0 = el[j]; i0 = j; }
    int i1 = -1; float m1 = -3.0e38f;
#pragma unroll
    for (int j = 0; j < 8; ++j) if (j != i0 && el[j] > m1) { m1 = el[j]; i1 = j; }
    const float r = expf(m1 - m0); const float w0 = 1.0f / (1.0f + r), w1 = r / (1.0f + r);
    ei[tok * 2] = gi * 8 + i0; ei[tok * 2 + 1] = gi * 8 + i1; ew[tok * 2] = grp_w * w0; ew[tok * 2 + 1] = grp_w * w1; } };
struct MoeHidden { const u16* h2; const float* wgate; const float* wup; const int* ei; u16* act;
  HD long items() const { return (long)NTOK * 2 * MH; }
  HD void operator()(long it) const { const int j = (int)(it % MH); const long tk = it / MH; const long tok = tk / 2; const int e = ei[tk]; const u16* x = h2 + tok * DM;
    const float* wg_ = wgate + (long)e * DM * MH + j; const float* wu_ = wup + (long)e * DM * MH + j; float a = 0.f, b = 0.f;
    for (long d = 0; d < DM; ++d) { const float xv = bf2f(x[d]); a += xv * wg_[d * MH]; b += xv * wu_[d * MH]; }
    act[it] = f2bf(siluf_(a) * b); } };
struct MoeDown { const u16* act; const float* wdown; const int* ei; const float* ew; float* x;
  HD long items() const { return (long)NTOK * DM; }
  HD void operator()(long it) const { const int c = (int)(it % DM); const long tok = it / DM; float tot = 0.f;
    for (int k = 0; k < 2; ++k) { const int e = ei[tok * 2 + k]; const u16* a = act + (tok * 2 + k) * MH; const float* w = wdown + (long)e * MH * DM + c; float s = 0.f;
      for (int j = 0; j < MH; ++j) s += bf2f(a[j]) * w[(long)j * DM];
      tot += ew[tok * 2 + k] * s; }
    x[it] += tot; } };

#define NV2_STAGE_PREP(RUN, I, B, out)      { nv::RmsRowsBf f{I.x, I.mix_norm, B.HB, nv::DM}; RUN(f, (long)nv::NTOK); }
#define NV2_STAGE_INPROJ(RUN, I, B, out)    { nv::GemmT<nv::ABf, nv::EpInProj> f{nv::ABf{B.HB, nv::DM}, I.w_in, nv::EpInProj{B, I.dt_bias}, nv::NTOK, nv::INW, nv::DM, nv::INW}; RUN(f, f.items()); }
#define NV2_STAGE_QKNORM(RUN, I, B, out)    { nv::QkNorm f{B.QKV, I.q_gain, I.ks_gain, I.kw_gain}; RUN(f, f.items()); }
#define NV2_STAGE_COMPRESS(RUN, I, B, out)  { \
    { nv::GemmT<nv::ACmp, nv::EpSiluF32> f{nv::ACmp{B.QKV, I.pos_k, nv::O_KC}, I.w1_k, nv::EpSiluF32{B.HID, 128}, (long)nv::NB * nv::G * nv::NCMP, 128, 2048, 128}; RUN(f, f.items()); } \
    { nv::GemmT<nv::AF32, nv::EpF32> f{nv::AF32{B.HID, 128}, I.w2_k, nv::EpF32{B.KTMP, 64}, (long)nv::NB * nv::G * nv::NCMP, 64, 128, 64}; RUN(f, f.items()); } \
    { nv::CmpFinish f{B.KTMP, I.kc_gain, B.KCMP, 1}; RUN(f, f.items()); } \
    { nv::GemmT<nv::ACmp, nv::EpSiluF32> f{nv::ACmp{B.QKV, I.pos_v, nv::O_VC}, I.w1_v, nv::EpSiluF32{B.HID, 128}, (long)nv::NB * nv::G * nv::NCMP, 128, 2048, 128}; RUN(f, f.items()); } \
    { nv::GemmT<nv::AF32, nv::EpF32> f{nv::AF32{B.HID, 128}, I.w2_v, nv::EpF32{B.KTMP, 64}, (long)nv::NB * nv::G * nv::NCMP, 64, 128, 64}; RUN(f, f.items()); } \
    { nv::CmpFinish f{B.KTMP, I.kc_gain, B.VCMP, 0}; RUN(f, f.items()); } }
#define NV2_STAGE_ATTN(RUN, I, B, out)      { \
    { nv::CmpAttn f{B}; RUN(f, f.items()); } { nv::Importance f{B}; RUN(f, f.items()); } { nv::TopSel f{B}; RUN(f, f.items()); } { nv::SelAttn f{B}; RUN(f, f.items()); } { nv::WinAttn f{B}; RUN(f, f.items()); } }
#define NV2_STAGE_SSD(RUN, I, B, out)       { \
    { nv::SsdConv f{B.XBC, I.conv_w, I.conv_b}; RUN(f, f.items()); } { nv::SsdScan f{B, I.a_log, I.d_skip}; RUN(f, f.items()); } { nv::SsdOut f{B, I.ssm_norm}; RUN(f, f.items()); } }
#define NV2_STAGE_MERGE(RUN, I, B, out)     { \
    { nv::GemmT<nv::ABf, nv::EpBf> f{nv::ABf{B.YA, nv::QW}, I.w_a, nv::EpBf{B.T1, nv::DM}, nv::NTOK, nv::DM, nv::QW, nv::DM}; RUN(f, f.items()); } \
    { nv::GemmT<nv::ABf, nv::EpMerge> f{nv::ABf{B.YB, nv::SI}, I.w_b, nv::EpMerge{B.T1, B.BG, B.MERGED}, nv::NTOK, nv::DM, nv::SI, nv::DM}; RUN(f, f.items()); } \
    { nv::GemmT<nv::ABf, nv::EpResid> f{nv::ABf{B.MERGED, nv::DM}, I.w_out, nv::EpResid{I.x, out}, nv::NTOK, nv::DM, nv::DM, nv::DM}; RUN(f, f.items()); } }
#define NV2_STAGE_MOE(RUN, I, B, out)       { \
    { nv::RmsRowsBf f{out, I.moe_norm, B.H2, nv::DM}; RUN(f, (long)nv::NTOK); } \
    { nv::Router f{B.H2, I.w_group, I.b_group, I.w_expert, I.b_expert, B.EI, B.EW}; RUN(f, (long)nv::NTOK); } \
    { nv::MoeHidden f{B.H2, I.w_gate, I.w_up, B.EI, B.ACT}; RUN(f, f.items()); } \
    { nv::MoeDown f{B.ACT, I.w_down, B.EI, B.EW, out}; RUN(f, f.items()); } }
#define NV2_STAGE_PLE(RUN, I, B, out)       { \
    { nv::RmsRowsBf f{out, I.ple_norm, B.H2, nv::DM}; RUN(f, (long)nv::NTOK); } \
    { nv::GemmT<nv::AF32, nv::EpBf> f{nv::AF32{I.p, nv::PLE}, I.ple_wp, nv::EpBf{B.PP, nv::DM}, nv::NTOK, nv::DM, nv::PLE, nv::DM}; RUN(f, f.items()); } \
    { nv::GemmT<nv::ABf, nv::EpPle> f{nv::ABf{B.H2, nv::DM}, I.ple_wg, nv::EpPle{out, B.PP}, nv::NTOK, nv::DM, nv::DM, nv::DM}; RUN(f, f.items()); } }

HD size_t carve(Bufs& B, unsigned char* ws, float* out) {
  size_t off = 0; auto take = [&](size_t bytes) { unsigned char* r = ws + off; off += (bytes + 255) / 256 * 256; return r; };
  const size_t N = NTOK;
  B.BG = (u16*)out;
  unsigned char* R0 = take(N * DM * 2);
  unsigned char* R5 = take(N * 2 * MH * 2 + (size_t)NEXP * 256 * MH * 2);
  B.YA = (u16*)take(N * QW * 2);
  unsigned char* R1 = take(N * QKVW * 2);
  unsigned char* R2 = take(N * SI * 2);
  unsigned char* R3 = take(N * SCD * 2);
  B.HB = (u16*)R0; B.H2 = (u16*)R0; B.QKV = (u16*)R1; B.T1 = (u16*)R1; B.Z = (u16*)R2; B.XBC = (u16*)R3; B.MERGED = (u16*)R3; B.PP = (u16*)R3;
  B.ACT = (u16*)R5; B.YB = B.Z;
  B.NG = (float*)take(N * GW * 4); B.DT = (float*)take(N * SH * 4);
  B.KCMP = (u16*)take((size_t)NB * G * NCP * 64 * 2); B.VCMP = (u16*)take((size_t)NB * G * NCP * 64 * 2);
  B.EI = (int*)take(N * 2 * 4); B.EW = (float*)take(N * 2 * 4);
#ifdef NV2_NAIVE_SCRATCH
  B.HID = (float*)take((size_t)NB * G * NCMP * 128 * 4); B.KTMP = (float*)take((size_t)NB * G * NCMP * 64 * 4);
  B.ML = (float*)take(N * H * 2 * 4); B.IMP = (float*)take((size_t)NB * G * S * 64 * 4); B.MASK = (u64*)take((size_t)NB * G * S * 8);
#else
  B.HID = nullptr; B.KTMP = nullptr; B.ML = nullptr; B.IMP = nullptr; B.MASK = nullptr;
#endif
  return off;
}
}
namespace xb {
#define LAS __attribute__((address_space(3)))
#define XB_TMO      128
#define XB_XCNT(j)  (256  + 64 * (j))
#define XB_XSUB(j)  (1280 + 64 * (j))
#define XB_XGEN(j)  (2304 + 64 * (j))
#define XB_TOP      3328
#define XB_TOPGEN   3392
#define XCD_BAR_WORDS 3456
#define XB_SPIN_CAP (1u << 22)

__device__ __forceinline__ unsigned xb_ld(unsigned* p)              { return __hip_atomic_load(p, __ATOMIC_RELAXED, __HIP_MEMORY_SCOPE_AGENT); }
__device__ __forceinline__ unsigned xb_add(unsigned* p, unsigned v) { return __hip_atomic_fetch_add(p, v, __ATOMIC_RELAXED, __HIP_MEMORY_SCOPE_AGENT); }
__device__ __forceinline__ unsigned xb_xcc_id() { return (unsigned)__builtin_amdgcn_s_getreg((3 << 11) | 20) & 0xFu; }
#define XB_SPIN(cond, bar) do { unsigned _sp = 0; while (cond) { __builtin_amdgcn_s_sleep(1); \
    if ((++_sp & 255u) == 0u) { if (xb_ld(&(bar)[XB_TMO])) break; if (_sp > XB_SPIN_CAP) { atomicAdd(&(bar)[XB_TMO], 1u); break; } } } } while (0)

struct XcdBarrier {
    unsigned* bar; unsigned x;
    volatile LAS unsigned* st;
};

__device__ __forceinline__ XcdBarrier xcd_barrier_post(unsigned* bar, volatile LAS unsigned* st) {
    XcdBarrier b; b.bar = bar; b.x = xb_xcc_id(); b.st = st;
    if (threadIdx.x == 0) (void)xb_add(&bar[XB_XCNT(b.x)], 1u);
    return b;
}
__device__ __forceinline__ void xcd_barrier_complete(unsigned* bar, unsigned x, unsigned& nloc, unsigned& nx) {
    const unsigned G = gridDim.x * gridDim.y * gridDim.z;
    unsigned sum, cnt, mine, sp = 0u;
    for (;;) {
        sum = 0u; cnt = 0u; mine = 0u;
#pragma unroll
        for (unsigned j = 0; j < 16; ++j) { const unsigned c = xb_ld(&bar[XB_XCNT(j)]); sum += c; cnt += (c > 0u) ? 1u : 0u; mine = (j == x) ? c : mine; }
        if (sum == G) break;
        __builtin_amdgcn_s_sleep(1);
        if ((++sp & 255u) == 0u) { if (xb_ld(&bar[XB_TMO])) break; if (sp > XB_SPIN_CAP) { atomicAdd(&bar[XB_TMO], 1u); break; } }
    }
    nloc = mine > 0u ? mine : 1u; nx = cnt > 0u ? cnt : 1u;
}

__device__ __forceinline__ void xcd_barrier(const XcdBarrier& b) {
    asm volatile("s_waitcnt vmcnt(0)" ::: "memory");
    __syncthreads();
    if (threadIdx.x == 0) {
        unsigned* bar = b.bar;
        __builtin_amdgcn_s_waitcnt(0);
        unsigned nloc = b.st[0], nx = b.st[1];
        if (nloc == 0u) { xcd_barrier_complete(bar, b.x, nloc, nx); b.st[0] = nloc; b.st[1] = nx; }
        const unsigned old = xb_add(&bar[XB_XSUB(b.x)], 1u);
        const unsigned gen = old / nloc;
        if (old + 1u == (gen + 1u) * nloc) {
            __builtin_amdgcn_fence(__ATOMIC_RELEASE, "agent");
            asm volatile("s_waitcnt vmcnt(0)" ::: "memory");
            const unsigned og = xb_add(&bar[XB_TOP], 1u);
            const unsigned tg = og / nx;
            if (og + 1u == (tg + 1u) * nx) xb_add(&bar[XB_TOPGEN], 1u);
            else XB_SPIN(xb_ld(&bar[XB_TOPGEN]) == tg, bar);
            __builtin_amdgcn_fence(__ATOMIC_ACQUIRE, "agent");
            xb_add(&bar[XB_XGEN(b.x)], 1u);
            asm volatile("s_waitcnt vmcnt(0)" ::: "memory");
        } else {
            XB_SPIN(xb_ld(&bar[XB_XGEN(b.x)]) == gen, bar);
            __builtin_amdgcn_fence(__ATOMIC_ACQUIRE, "agent");
            asm volatile("s_waitcnt vmcnt(0)" ::: "memory");
        }
    }
    __syncthreads();
}
}
namespace pg8 {
#define PG8_LAS __attribute__((address_space(3)))
typedef unsigned short bf16_t;
typedef short bf16x8 __attribute__((ext_vector_type(8)));
typedef float f32x4 __attribute__((ext_vector_type(4)));
typedef unsigned u32x4 __attribute__((ext_vector_type(4)));
typedef unsigned u32x2 __attribute__((ext_vector_type(2)));
constexpr int BM = 256, BK = 64, HALF = 128, HTB = HALF * BK * 2  , STAGE_BYTES = 8 * HTB, NXCD = 8, WGM = 8;

__host__ __device__ __forceinline__ int lds_byte(int r, int c) { const int st = (r >> 4) * 2 + (c >> 5), rr = r & 15, cc = c & 31, ob = rr * 64 + cc * 2; return st * 1024 + (ob ^ (((ob >> 9) & 1) << 5)); }
__host__ __device__ __forceinline__ void stage_rc(int b, int& R, int& C) { const int st = b / 1024, sb = b % 1024, swz = sb ^ (((sb >> 9) & 1) << 5); R = (st >> 1) * 16 + swz / 64; C = (st & 1) * 32 + (swz % 64) / 2; }
__host__ __device__ __forceinline__ int perm32(int rho) { const int n = rho >> 4, i = rho & 15; return 8 * (i >> 2) + 4 * n + (i & 3); }

struct Unit { int pm, pn, aux0, aux1; };
struct Gemm { const bf16_t* A; const bf16_t* Bt; int M, N, K, lda, ldb, kstepA; };

struct StaticOrder {
    int nM, nN, nwg, G, c;
    __device__ void init(int M, int N, int G_, int c_) { nM = M / BM; nN = N / BM; nwg = nM * nN; G = G_; c = c_; }
    __device__ bool next(int i, Unit& u) const {
        const long L = (long)i * G + c; if (L >= nwg) return false;
        int wgid = (int)L; { const int q = nwg / NXCD, r = nwg % NXCD, xcd = wgid % NXCD, off = wgid / NXCD; wgid = (xcd < r ? xcd * (q + 1) : r * (q + 1) + (xcd - r) * q) + off; }
        const int nig = WGM * nN, gid = wgid / nig, fm = gid * WGM, gsz = (nM - fm) < WGM ? (nM - fm) : WGM;
        u.pm = fm + ((wgid % nig) % gsz); u.pn = (wgid % nig) / gsz; u.aux0 = 0; u.aux1 = 0; return true;
    }
    __device__ __forceinline__ const char* a_base(const Gemm& g, const Unit& u) const { return (const char*)g.A + (size_t)u.pm * BM * g.lda * 2; }
    __device__ __forceinline__ const char* b_base(const Gemm& g, const Unit& u) const { return (const char*)g.Bt + (size_t)u.pn * BM * g.ldb * 2; }
    __device__ __forceinline__ int a_row(const Unit&, int) const { return 0; }
};

typedef float f32x2_t __attribute__((ext_vector_type(2))); typedef __bf16 bf16x2_t __attribute__((ext_vector_type(2)));
__device__ __forceinline__ unsigned cvt_pk_bf16(float lo, float hi) { f32x2_t v = {lo, hi}; bf16x2_t b = __builtin_convertvector(v, bf16x2_t); return __builtin_bit_cast(unsigned, b); }


template <class Epi, class Sched, bool ALIGN_EPI = true, bool GATHER = false>
__device__ __forceinline__ void gemm_phase(PG8_LAS unsigned char* lds, const Gemm g, const Sched& S, const Epi& E) {
    int tid_ = threadIdx.x; asm volatile("" : "+v"(tid_));
    const int tid = tid_, wid = __builtin_amdgcn_readfirstlane(tid >> 6), lane = tid & 63, wr = wid >> 2, wc = wid & 3, fr = lane & 15, fq = lane >> 4;
    const int K = g.K, nt = K / BK;
    unsigned voffA[2], voffA1[2], voffB[2];
    int RA[2], CA[2];
#pragma unroll
    for (int i = 0; i < 2; ++i) { int R, C; stage_rc(tid * 16 + i * 8192, R, C); const int Rb = Epi::PERM ? ((R & ~31) + perm32(R & 31)) : R;
        RA[i] = R; CA[i] = C; voffA[i] = (unsigned)(R * g.lda + C) * 2u; voffA1[i] = voffA[i]; voffB[i] = (unsigned)(Rb * g.ldb + C) * 2u; }
    const size_t kstep = (size_t)(BK * 2);
    const size_t kstepA = (size_t)g.kstepA;
    const size_t hstepA = GATHER ? (size_t)0 : (size_t)HALF * g.lda * 2;
    const size_t hstepB = (size_t)HALF * g.ldb * 2;
    const unsigned ldsw = (unsigned)wid * 1024u;
    const int aoff = lds_byte(wr * 64 + fr, fq * 8), boff = lds_byte(wc * 32 + fr, fq * 8);
#define PG8_SA(b, h) (((b) * 2 + (h)) * HTB)
#define PG8_SB(b, h) ((4 + (b) * 2 + (h)) * HTB)
#define PG8_STAGE(bufoff, gbase, voff) do { _Pragma("unroll") for (int _i = 0; _i < 2; ++_i) \
        __builtin_amdgcn_global_load_lds((const unsigned*)((const char*)(gbase) + (voff)[_i]), (PG8_LAS unsigned*)(lds + (bufoff) + ldsw + _i * 8192), 16, 0, 0); } while (0)
#define PG8_STAGE_A0(bufoff, gbase) PG8_STAGE(bufoff, gbase, voffA)
#define PG8_STAGE_A1(bufoff, gbase) do { if constexpr (GATHER) { PG8_STAGE(bufoff, gbase, voffA1); } else { PG8_STAGE(bufoff, (gbase) + hstepA, voffA); } } while (0)
#define PG8_LDA(dst, b, h) do { _Pragma("unroll") for (int m = 0; m < 4; ++m) _Pragma("unroll") for (int k = 0; k < 2; ++k) dst[m][k] = *(const PG8_LAS bf16x8*)(lds + PG8_SA(b, h) + aoff + m * 2048 + k * 1024); } while (0)
#define PG8_LDB(dst, b, h) do { _Pragma("unroll") for (int n = 0; n < 2; ++n) _Pragma("unroll") for (int k = 0; k < 2; ++k) dst[n][k] = *(const PG8_LAS bf16x8*)(lds + PG8_SB(b, h) + boff + n * 2048 + k * 1024); } while (0)
#define PG8_MMA(ai, bj, At, Bt) do { __builtin_amdgcn_s_setprio(1); _Pragma("unroll") for (int m = 0; m < 4; ++m) _Pragma("unroll") for (int n = 0; n < 2; ++n) _Pragma("unroll") for (int k = 0; k < 2; ++k) \
        acc[ai][bj][m][n] = __builtin_amdgcn_mfma_f32_16x16x32_bf16(Bt[n][k], At[m][k], acc[ai][bj][m][n], 0, 0, 0); __builtin_amdgcn_s_setprio(0); } while (0)
#define PG8_WAIT_V(n) asm volatile("s_waitcnt vmcnt(" #n ")" ::: "memory")
#define PG8_WAIT_L(n) asm volatile("s_waitcnt lgkmcnt(" #n ")" ::: "memory")
#define PG8_BAR __builtin_amdgcn_s_barrier()
#define PG8_SCHED __builtin_amdgcn_sched_barrier(0)
    Unit cur, nxt; int ui = 0;
    if (!S.next(0, cur)) return;
    if constexpr (GATHER) {
#pragma unroll
        for (int i = 0; i < 2; ++i) { voffA[i] = (unsigned)(S.a_row(cur, RA[i]) * g.lda + CA[i]) * 2u; voffA1[i] = (unsigned)(S.a_row(cur, HALF + RA[i]) * g.lda + CA[i]) * 2u; }
    }
    f32x4 acc[2][2][4][2];
#pragma unroll
    for (int a = 0; a < 2; ++a)
#pragma unroll
        for (int b = 0; b < 2; ++b)
#pragma unroll
            for (int m = 0; m < 4; ++m)
#pragma unroll
                for (int n = 0; n < 2; ++n) acc[a][b][m][n] = (f32x4){0.f, 0.f, 0.f, 0.f};
    bf16x8 At[4][2], B0[2][2], B1[2][2];
    const char* cA = S.a_base(g, cur); const char* cB = S.b_base(g, cur);
    PG8_STAGE(PG8_SB(0, 0), cB, voffB); PG8_STAGE(PG8_SB(0, 1), cB + hstepB, voffB); PG8_STAGE_A0(PG8_SA(0, 0), cA); PG8_STAGE_A1(PG8_SA(0, 1), cA);
    if (wr == 1) PG8_BAR;
    PG8_WAIT_V(2); PG8_BAR;
    PG8_STAGE(PG8_SB(1, 0), cB + kstep, voffB); PG8_STAGE_A0(PG8_SA(1, 0), cA + kstepA); PG8_STAGE(PG8_SB(1, 1), cB + hstepB + kstep, voffB);
    PG8_WAIT_V(6); PG8_BAR;
    for (;;) {
        const bool has_next = GATHER ? false : S.next(ui + 1, nxt);
        const char* nA = has_next ? S.a_base(g, nxt) : cA; const char* nB = has_next ? S.b_base(g, nxt) : cB;
#pragma unroll 1
        for (int t = 0; t < nt; t += 2) {
            const bool last = (t == nt - 2);
            const char* a1 = cA + (size_t)(t + 1) * kstepA;
            const char* a2 = last ? nA : cA + (size_t)(t + 2) * kstepA; const char* b2 = last ? nB : cB + (size_t)(t + 2) * kstep;
            const char* a3 = a2 + kstepA; const char* b3 = b2 + kstep;
            PG8_LDB(B0, 0, 0); PG8_LDB(B1, 0, 1); PG8_SCHED; PG8_LDA(At, 0, 0); PG8_STAGE_A1(PG8_SA(1, 1), a1);
            PG8_WAIT_V(8); PG8_WAIT_L(0); PG8_BAR; PG8_MMA(0, 0, At, B0); PG8_MMA(0, 1, At, B1); PG8_BAR; PG8_SCHED;
            PG8_LDA(At, 0, 1); PG8_STAGE(PG8_SB(0, 0), b2, voffB); PG8_STAGE(PG8_SB(0, 1), b2 + hstepB, voffB); PG8_STAGE_A0(PG8_SA(0, 0), a2);
            PG8_WAIT_V(8); PG8_WAIT_L(0); PG8_BAR; PG8_MMA(1, 0, At, B0); PG8_MMA(1, 1, At, B1); PG8_BAR; PG8_SCHED;
            PG8_LDB(B0, 1, 0); PG8_LDB(B1, 1, 1); PG8_SCHED; PG8_LDA(At, 1, 0); PG8_STAGE_A1(PG8_SA(0, 1), a2);
            PG8_WAIT_V(8); PG8_WAIT_L(0); PG8_BAR; PG8_MMA(0, 0, At, B0); PG8_MMA(0, 1, At, B1); PG8_BAR; PG8_SCHED;
            PG8_LDA(At, 1, 1); PG8_STAGE(PG8_SB(1, 0), b3, voffB); PG8_STAGE(PG8_SB(1, 1), b3 + hstepB, voffB); PG8_STAGE_A0(PG8_SA(1, 0), a3);
            PG8_WAIT_V(8); PG8_WAIT_L(0); PG8_BAR; PG8_MMA(1, 0, At, B0); PG8_MMA(1, 1, At, B1); PG8_BAR; PG8_SCHED;
        }
        if constexpr (ALIGN_EPI) { if (wr == 0) PG8_BAR; }
        E(acc, cur, wr, wc, fr, fq);
        if (!has_next) break;
#pragma unroll
        for (int a = 0; a < 2; ++a)
#pragma unroll
            for (int b = 0; b < 2; ++b)
#pragma unroll
                for (int m = 0; m < 4; ++m)
#pragma unroll
                    for (int n = 0; n < 2; ++n) acc[a][b][m][n] = (f32x4){0.f, 0.f, 0.f, 0.f};
        cur = nxt; cA = nA; cB = nB; ++ui;
        if constexpr (ALIGN_EPI) { if (wr == 1) PG8_BAR; }
    }
    PG8_WAIT_V(0);
    if constexpr (!ALIGN_EPI) { if (wr == 0) PG8_BAR; }
    PG8_BAR;
#undef PG8_SA
#undef PG8_SB
#undef PG8_STAGE
#undef PG8_STAGE_A0
#undef PG8_STAGE_A1
#undef PG8_LDA
#undef PG8_LDB
#undef PG8_MMA
#undef PG8_WAIT_V
#undef PG8_WAIT_L
#undef PG8_BAR
#undef PG8_SCHED
}
}
namespace fx {
using nv::u16; using nv::Bufs; using nv::Inputs;
using pg8::f32x4; using pg8::u32x4; using pg8::Unit;
#define LAS __attribute__((address_space(3)))
static_assert(nv::DM == 1024 && nv::NB == 8 && nv::S == 4096 && nv::MH == 256 && nv::PLE == 256, "fast phases are written for the full-size problem");
constexpr int NTOK = nv::NTOK, DM = 1024;
constexpr int INW_PAD = 6144;
constexpr int C_Z = 1280, C_XBC = 2304, C_BG = 3840, C_NG = 5888, C_DT = 5912, C_END = 5928;

struct WBufs { u16 *WinT, *WaT, *WbT, *WoutT, *PleGT, *PlePT, *WguT, *WdT, *PB; };
__host__ __device__ inline size_t carve_w(WBufs& W, unsigned char* ws, size_t off) {
  auto take = [&](size_t bytes) { unsigned char* r = ws + off; off += (bytes + 255) / 256 * 256; return r; };
  W.WinT = (u16*)take((size_t)INW_PAD * 1024 * 2); W.WaT = (u16*)take((size_t)1024 * 512 * 2); W.WbT = (u16*)take((size_t)1024 * 1024 * 2); W.WoutT = (u16*)take((size_t)1024 * 1024 * 2);
  W.PleGT = (u16*)take((size_t)1024 * 1024 * 2); W.PlePT = (u16*)take((size_t)1024 * 256 * 2); W.WguT = (u16*)take((size_t)32 * 512 * 1024 * 2); W.WdT = (u16*)take((size_t)32 * 1024 * 256 * 2);
  W.PB = (u16*)take((size_t)NTOK * 256 * 2);
  return off;
}

__device__ __forceinline__ int otid() { int t = threadIdx.x; asm volatile("" : "+v"(t)); return t; }
__device__ __forceinline__ int obid() { int b = blockIdx.x; asm volatile("" : "+s"(b)); return b; }
__device__ __forceinline__ float fsig(float x) { return __builtin_amdgcn_rcpf(1.0f + __expf(-x)); }
__device__ __forceinline__ float fsoftplus(float x) { const float e = __expf(x); return x > 20.f ? x : (e < 0.0625f ? e * (1.f - e * (0.5f - e * (0.33333333f - 0.25f * e))) : __logf(1.0f + e)); }
__device__ __forceinline__ unsigned pk2(float lo, float hi) { return pg8::cvt_pk_bf16(lo, hi); }
__device__ __forceinline__ void store8(u16* p, const float (&v)[8]) { u32x4 w; w.x = pk2(v[0], v[1]); w.y = pk2(v[2], v[3]); w.z = pk2(v[4], v[5]); w.w = pk2(v[6], v[7]); *(u32x4*)p = w; }
__device__ __forceinline__ void load8(const u16* p, float (&v)[8]) { const u32x4 w = *(const u32x4*)p;
  v[0] = __uint_as_float(w.x << 16); v[1] = __uint_as_float(w.x & 0xffff0000u); v[2] = __uint_as_float(w.y << 16); v[3] = __uint_as_float(w.y & 0xffff0000u);
  v[4] = __uint_as_float(w.z << 16); v[5] = __uint_as_float(w.z & 0xffff0000u); v[6] = __uint_as_float(w.w << 16); v[7] = __uint_as_float(w.w & 0xffff0000u); }

__device__ __forceinline__ float wave_sum(float v) {
#pragma unroll
  for (int o = 1; o < 64; o <<= 1) v += __shfl_xor(v, o);
  return v; }
__device__ __forceinline__ void rms_row_to_bf16(const float* xrow, const float* gain, u16* orow, int lane) {
  const f32x4* xr = (const f32x4*)xrow + lane; const f32x4* gr = (const f32x4*)gain + lane;
  f32x4 v[4]; float s = 0.f;
#pragma unroll
  for (int j = 0; j < 4; ++j) { v[j] = xr[64 * j]; s += (v[j].x * v[j].x + v[j].y * v[j].y) + (v[j].z * v[j].z + v[j].w * v[j].w); }
  const float rs = 1.0f / sqrtf(wave_sum(s) * (1.f / 1024.f) + nv::EPS);
  unsigned long long* o8 = (unsigned long long*)orow + lane;
#pragma unroll
  for (int j = 0; j < 4; ++j) { const f32x4 g = gr[64 * j]; o8[64 * j] = (unsigned long long)pk2(v[j].x * rs * g.x, v[j].y * rs * g.y) | ((unsigned long long)pk2(v[j].z * rs * g.z, v[j].w * rs * g.w) << 32); }
}
__device__ __forceinline__ void phase_rms_rows(const float* x, const float* gain, u16* out) {
  const int tid = otid(), lane = tid & 63, gw = obid() * 8 + (tid >> 6), ngw = gridDim.x * 8;
  for (int r = gw; r < NTOK; r += 4 * ngw) { f32x4 v[4][4]; float s[4];
#pragma unroll
    for (int q = 0; q < 4; ++q) { const int rq = (r + q * ngw < NTOK) ? r + q * ngw : r; const f32x4* xr = (const f32x4*)(x + (size_t)rq * 1024) + lane;
#pragma unroll
      for (int j = 0; j < 4; ++j) v[q][j] = xr[64 * j]; }
#pragma unroll
    for (int q = 0; q < 4; ++q) { s[q] = 0.f;
#pragma unroll
      for (int j = 0; j < 4; ++j) s[q] += (v[q][j].x * v[q][j].x + v[q][j].y * v[q][j].y) + (v[q][j].z * v[q][j].z + v[q][j].w * v[q][j].w);
      s[q] = 1.0f / sqrtf(wave_sum(s[q]) * (1.f / 1024.f) + nv::EPS); }
#pragma unroll
    for (int q = 0; q < 4; ++q) { if (r + q * ngw >= NTOK) break; unsigned long long* o8 = (unsigned long long*)(out + (size_t)(r + q * ngw) * 1024) + lane; const f32x4* gr = (const f32x4*)gain + lane;
#pragma unroll
      for (int j = 0; j < 4; ++j) { const f32x4 g = gr[64 * j]; o8[64 * j] = (unsigned long long)pk2(v[q][j].x * s[q] * g.x, v[q][j].y * s[q] * g.y) | ((unsigned long long)pk2(v[q][j].z * s[q] * g.z, v[q][j].w * s[q] * g.w) << 32); } } }
}
template <class CP> __device__ __forceinline__ void transpose_item(LAS float* scr, const CP cp, u16* dst, int K, int n0, int k0, int lane) {
  { const float* p = cp(n0 + (lane & 31));
#pragma unroll 8
    for (int i = 0; i < 32; ++i) { const int kk = 2 * i + (lane >> 5); scr[kk * 33 + (lane & 31)] = p ? p[(size_t)(k0 + kk) * cp.ld] : 0.f; } }
  asm volatile("s_waitcnt lgkmcnt(0)" ::: "memory");
  const int c = lane & 7;
#pragma unroll
  for (int j = 0; j < 4; ++j) { const int n = (lane >> 3) + 8 * j; const LAS float* s = scr + (8 * c) * 33 + n;
    u32x4 o; o.x = pk2(s[0 * 33], s[1 * 33]); o.y = pk2(s[2 * 33], s[3 * 33]); o.z = pk2(s[4 * 33], s[5 * 33]); o.w = pk2(s[6 * 33], s[7 * 33]);
    *(u32x4*)(dst + (size_t)(n0 + n) * K + k0 + 8 * c) = o; }
  asm volatile("s_waitcnt lgkmcnt(0)" ::: "memory");
}
struct CpIdent { const float* src; int ld; __device__ const float* operator()(int n) const { return src + n; } };
struct CpInProj { const float* src; int ld; __device__ const float* operator()(int n) const {
  int c; if (n < C_Z) c = n; else if (n < C_XBC) c = nv::O_Z + (n - C_Z); else if (n < C_BG) c = nv::O_XBC + (n - C_XBC); else if (n < C_NG) c = nv::O_BG + (n - C_BG); else if (n < C_DT) c = nv::O_NG + (n - C_NG); else if (n < C_END) c = nv::O_DT + (n - C_DT); else return nullptr;
  return src + c; } };
struct CpGU { const float* gate; long updelta; int ld; __device__ const float* operator()(int n) const { const int tile = n >> 8, r = n & 255; return gate + (r < 128 ? 0L : updelta) + tile * 128 + (r & 127); } };

struct WJob { const float* src; int ld; u16* dst; int K, n0, k0; };
__device__ __forceinline__ WJob wjob_decode(int t, const Inputs& I, const WBufs& W, int lane) {
  constexpr int T_IN = (INW_PAD / 32) * 16, T_A = 32 * 8, T_B = 32 * 16, T_O = 32 * 16, T_PG = 32 * 16, T_PP = 32 * 4, T_GU = 32 * 16 * 16;
  WJob j; int r = t; const int c = lane & 31;
  if (r < T_IN) { CpInProj cp{I.w_in, nv::INW}; j.n0 = (r / 16) * 32; j.k0 = (r % 16) * 64; j.src = cp(j.n0 + c); j.ld = nv::INW; j.dst = W.WinT; j.K = 1024; return j; } r -= T_IN;
  if (r < T_A) { j.n0 = (r / 8) * 32; j.k0 = (r % 8) * 64; j.src = I.w_a + j.n0 + c; j.ld = 1024; j.dst = W.WaT; j.K = 512; return j; } r -= T_A;
  if (r < T_B) { j.n0 = (r / 16) * 32; j.k0 = (r % 16) * 64; j.src = I.w_b + j.n0 + c; j.ld = 1024; j.dst = W.WbT; j.K = 1024; return j; } r -= T_B;
  if (r < T_O) { j.n0 = (r / 16) * 32; j.k0 = (r % 16) * 64; j.src = I.w_out + j.n0 + c; j.ld = 1024; j.dst = W.WoutT; j.K = 1024; return j; } r -= T_O;
  if (r < T_PG) { j.n0 = (r / 16) * 32; j.k0 = (r % 16) * 64; j.src = I.ple_wg + j.n0 + c; j.ld = 1024; j.dst = W.PleGT; j.K = 1024; return j; } r -= T_PG;
  if (r < T_PP) { j.n0 = (r / 4) * 32; j.k0 = (r % 4) * 64; j.src = I.ple_wp + j.n0 + c; j.ld = 1024; j.dst = W.PlePT; j.K = 256; return j; } r -= T_PP;
  if (r < T_GU) { const int e = r / 256, q = r % 256; CpGU cp{I.w_gate + (size_t)e * 1024 * 256, (long)(I.w_up - I.w_gate), 256}; j.n0 = (q / 16) * 32; j.k0 = (q % 16) * 64; j.src = cp(j.n0 + c); j.ld = 256; j.dst = W.WguT + (size_t)e * 512 * 1024; j.K = 1024; return j; } r -= T_GU;
  { const int e = r / 128, q = r % 128; j.n0 = (q / 4) * 32; j.k0 = (q % 4) * 64; j.src = I.w_down + (size_t)e * 256 * 1024 + j.n0 + c; j.ld = 1024; j.dst = W.WdT + (size_t)e * 1024 * 256; j.K = 256; return j; }
}
__device__ __forceinline__ void phase_prologue(LAS unsigned char* lds, const Inputs& I, const Bufs& B, const WBufs& W) {
  const int tid = otid(), lane = tid & 63, wv = tid >> 6, gw = obid() * 8 + wv, ngw = gridDim.x * 8;
  LAS float* scr = (LAS float*)lds + wv * (64 * 33);
  constexpr int TOT = (INW_PAD / 32) * 16 + 32 * 8 + 32 * 16 * 3 + 32 * 4 + 32 * 16 * 16 + 32 * 32 * 4;
  float cur[32];
  int t = gw; WJob jb;
  if (t < TOT) { jb = wjob_decode(t, I, W, lane);
#pragma unroll
    for (int i = 0; i < 32; ++i) cur[i] = jb.src ? jb.src[(size_t)(jb.k0 + 2 * i + (lane >> 5)) * jb.ld] : 0.f; }
  while (t < TOT) { const int tn = t + ngw; WJob jn = jb; float nxt[32];
    if (tn < TOT) { jn = wjob_decode(tn, I, W, lane);
#pragma unroll
      for (int i = 0; i < 32; ++i) nxt[i] = jn.src ? jn.src[(size_t)(jn.k0 + 2 * i + (lane >> 5)) * jn.ld] : 0.f; }
#pragma unroll
    for (int i = 0; i < 32; ++i) scr[(2 * i + (lane >> 5)) * 33 + (lane & 31)] = cur[i];
    asm volatile("s_waitcnt lgkmcnt(0)" ::: "memory");
    { const int c = lane & 7;
#pragma unroll
      for (int j = 0; j < 4; ++j) { const int n = (lane >> 3) + 8 * j; const LAS float* s = scr + (8 * c) * 33 + n;
        u32x4 o; o.x = pk2(s[0 * 33], s[1 * 33]); o.y = pk2(s[2 * 33], s[3 * 33]); o.z = pk2(s[4 * 33], s[5 * 33]); o.w = pk2(s[6 * 33], s[7 * 33]);
        *(u32x4*)(jb.dst + (size_t)(jb.n0 + n) * jb.K + jb.k0 + 8 * c) = o; } }
    asm volatile("s_waitcnt lgkmcnt(0)" ::: "memory");
    if (tn < TOT) {
#pragma unroll
      for (int i = 0; i < 32; ++i) cur[i] = nxt[i]; }
    jb = jn; t = tn; }
}
__device__ __forceinline__ void prologue_pb(const Inputs& I, const WBufs& W) {
  for (long i = blockIdx.x * 512L + otid(); i < (long)NTOK * 256 / 8; i += (long)gridDim.x * 512L) { const f32x4 a = ((const f32x4*)I.p)[2 * i], b = ((const f32x4*)I.p)[2 * i + 1];
    u32x4 o; o.x = pk2(a.x, a.y); o.y = pk2(a.z, a.w); o.z = pk2(b.x, b.y); o.w = pk2(b.z, b.w); ((u32x4*)W.PB)[i] = o; }
}

template <class F> struct Epi8 { static constexpr bool PERM = true; F f;
  __device__ __forceinline__ void operator()(const f32x4 (&acc)[2][2][4][2], const Unit& u, int wr, int wc, int fr, int fq) const {
#pragma unroll
    for (int ai = 0; ai < 2; ++ai)
#pragma unroll
      for (int m = 0; m < 4; ++m) { const int row = u.pm * 256 + ai * 128 + wr * 64 + m * 16 + fr;
#pragma unroll
        for (int bj = 0; bj < 2; ++bj) { const int col = u.pn * 256 + bj * 128 + wc * 32 + 8 * fq; const f32x4 a = acc[ai][bj][m][0], b = acc[ai][bj][m][1];
          const float v[8] = {a.x, a.y, a.z, a.w, b.x, b.y, b.z, b.w}; f(u, row, col, v); }
        if (m & 1) asm volatile("" ::: "memory"); } } };

struct FInProj { u16* QKV; u16* Z; u16* XBC; u16* BG; float* NG; float* DT; const float* dt_bias;
  __device__ __forceinline__ void operator()(const Unit&, int r, int c, const float (&v)[8]) const {
    if (c < C_Z) store8(QKV + (size_t)r * 1280 + c, v);
    else if (c < C_XBC) store8(Z + (size_t)r * 1024 + (c - C_Z), v);
    else if (c < C_BG) store8(XBC + (size_t)r * 1536 + (c - C_XBC), v);
    else if (c < C_NG) { float s[8];
#pragma unroll
      for (int i = 0; i < 8; ++i) s[i] = fsig(v[i]);
      store8(BG + (size_t)r * 2048 + (c - C_BG), s); }
    else if (c < C_DT) { float* o = NG + (size_t)r * 24 + (c - C_NG);
#pragma unroll
      for (int i = 0; i < 8; ++i) o[i] = fsig(v[i]); }
    else if (c < C_END) { float* o = DT + (size_t)r * 16 + (c - C_DT); const float* bi = dt_bias + (c - C_DT);
#pragma unroll
      for (int i = 0; i < 8; ++i) o[i] = fsoftplus(v[i] + bi[i]); } } };
struct FStoreBf { u16* o; int ld; __device__ __forceinline__ void operator()(const Unit&, int r, int c, const float (&v)[8]) const { store8(o + (size_t)r * ld + c, v); } };
struct FMerge { const u16* t1; const u16* bg; u16* o;
  __device__ __forceinline__ void operator()(const Unit&, int r, int c, const float (&v)[8]) const { float t[8], ga[8], gb[8], m[8]; load8(t1 + (size_t)r * 1024 + c, t); load8(bg + (size_t)r * 2048 + c, ga); load8(bg + (size_t)r * 2048 + 1024 + c, gb);
#pragma unroll
    for (int i = 0; i < 8; ++i) m[i] = ga[i] * t[i] + gb[i] * v[i];
    store8(o + (size_t)r * 1024 + c, m); } };
struct FResid { const float* x; float* o;
  __device__ __forceinline__ void operator()(const Unit&, int r, int c, const float (&v)[8]) const { const f32x4 a = *(const f32x4*)(x + (size_t)r * 1024 + c), b = *(const f32x4*)(x + (size_t)r * 1024 + c + 4);
    *(f32x4*)(o + (size_t)r * 1024 + c) = (f32x4){a.x + v[0], a.y + v[1], a.z + v[2], a.w + v[3]}; *(f32x4*)(o + (size_t)r * 1024 + c + 4) = (f32x4){b.x + v[4], b.y + v[5], b.z + v[6], b.w + v[7]}; } };
struct FPle { float* x; const u16* pp;
  __device__ __forceinline__ void operator()(const Unit&, int r, int c, const float (&v)[8]) const { float p[8]; load8(pp + (size_t)r * 1024 + c, p); float* xp = x + (size_t)r * 1024 + c; const f32x4 a = *(const f32x4*)xp, b = *(const f32x4*)(xp + 4);
    *(f32x4*)xp = (f32x4){a.x + fsig(v[0]) * p[0], a.y + fsig(v[1]) * p[1], a.z + fsig(v[2]) * p[2], a.w + fsig(v[3]) * p[3]};
    *(f32x4*)(xp + 4) = (f32x4){b.x + fsig(v[4]) * p[4], b.y + fsig(v[5]) * p[5], b.z + fsig(v[6]) * p[6], b.w + fsig(v[7]) * p[7]}; } };

struct EpiResidNorm { static constexpr bool PERM = true; const float* x; float* o; const float* gain; u16* h; float* ssq;
  __device__ __forceinline__ void operator()(const f32x4 (&acc)[2][2][4][2], const Unit& u, int wr, int wc, int fr, int fq) const {
#pragma unroll
    for (int ai = 0; ai < 2; ++ai)
#pragma unroll
      for (int m = 0; m < 4; ++m) { const int row = u.pm * 256 + ai * 128 + wr * 64 + m * 16 + fr; float part = 0.f;
#pragma unroll
        for (int bj = 0; bj < 2; ++bj) { const int c = u.pn * 256 + bj * 128 + wc * 32 + 8 * fq; const f32x4 a = acc[ai][bj][m][0], b = acc[ai][bj][m][1];
          const f32x4 xa = *(const f32x4*)(x + (size_t)row * 1024 + c), xb = *(const f32x4*)(x + (size_t)row * 1024 + c + 4); const f32x4 ga = *(const f32x4*)(gain + c), gb = *(const f32x4*)(gain + c + 4);
          const f32x4 va = {xa.x + a.x, xa.y + a.y, xa.z + a.z, xa.w + a.w}, vb = {xb.x + b.x, xb.y + b.y, xb.z + b.z, xb.w + b.w};
          *(f32x4*)(o + (size_t)row * 1024 + c) = va; *(f32x4*)(o + (size_t)row * 1024 + c + 4) = vb;
          part += (va.x * va.x + va.y * va.y) + (va.z * va.z + va.w * va.w) + (vb.x * vb.x + vb.y * vb.y) + (vb.z * vb.z + vb.w * vb.w);
          const float hv[8] = {va.x * ga.x, va.y * ga.y, va.z * ga.z, va.w * ga.w, vb.x * gb.x, vb.y * gb.y, vb.z * gb.z, vb.w * gb.w}; store8(h + (size_t)row * 1024 + c, hv); }
        part += __shfl_xor(part, 16); part += __shfl_xor(part, 32);
        if (fq == 0) atomicAdd(ssq + row, part);
        if (m & 1) asm volatile("" ::: "memory"); } } };
template <class F> __device__ __forceinline__ void dense_gemm(LAS unsigned char* lds, const u16* A, int lda, const u16* Bt, int ldb, int M, int N, int K, const F& f) {
  pg8::Gemm g{A, Bt, M, N, K, lda, ldb, 128}; pg8::StaticOrder S; S.init(M, N, (int)gridDim.x, (int)blockIdx.x); Epi8<F> E{f};
  pg8::gemm_phase<Epi8<F>, pg8::StaticOrder, true, false>(lds, g, S, E);
}
}
namespace fx {
constexpr int LIST_CAP = 32768;
constexpr int LDS_TAB = 131072;
struct MoeBufs { float* LOGITS; int* CNT; int* LIST; int* ASG; u16* MOEOUT; u16* WrT; float* SSQ; };
__host__ __device__ inline size_t carve_moe(MoeBufs& M, const Bufs& B, unsigned char* ws, size_t off) {
  auto take = [&](size_t bytes) { unsigned char* r = ws + off; off += (bytes + 255) / 256 * 256; return r; };
  M.LOGITS = (float*)take((size_t)NTOK * 64 * 4); M.CNT = (int*)take(32 * 256); M.LIST = (int*)take((size_t)32 * LIST_CAP * 4); M.WrT = (u16*)take((size_t)256 * 1024 * 2); M.ASG = (int*)take((size_t)NTOK * 2 * 4); M.SSQ = (float*)take((size_t)NTOK * 4);
  M.MOEOUT = B.QKV;
  return off;
}
__device__ __forceinline__ void prologue_moe(const Inputs& I, const MoeBufs& M) {
  for (long i = blockIdx.x * 512L + otid(); i < 256L * 1024; i += (long)gridDim.x * 512L) { const int n = (int)(i >> 10), k = (int)(i & 1023);
    float v = 0.f; if (n < 4) v = I.w_group[k * 4 + n]; else if (n < 36) v = I.w_expert[k * 32 + (n - 4)];
    M.WrT[i] = nv::f2bf(v); }
  if (blockIdx.x == 0 && threadIdx.x < 32) M.CNT[threadIdx.x * 64] = 0;
  for (int i = blockIdx.x * 512 + otid(); i < NTOK; i += gridDim.x * 512) M.SSQ[i] = 0.f;
}
struct FLogits { float* o; __device__ __forceinline__ void operator()(const Unit&, int r, int c, const float (&v)[8]) const { if (c < 40) { *(f32x4*)(o + (size_t)r * 64 + c) = (f32x4){v[0], v[1], v[2], v[3]}; *(f32x4*)(o + (size_t)r * 64 + c + 4) = (f32x4){v[4], v[5], v[6], v[7]}; } } };
__device__ __forceinline__ void phase_route(LAS unsigned char* lds, const Inputs& I, const Bufs& B, const MoeBufs& M) {
  LAS int* lcnt = (LAS int*)lds; LAS int* lbase = lcnt + 32; const int tid = otid();
  for (int blk = blockIdx.x; blk < NTOK / 128; blk += gridDim.x) {
    if (tid < 32) lcnt[tid] = 0;
    __syncthreads();
    int e0 = 0, e1 = 0, r0 = 0, r1 = 0; float w0 = 0.f, w1 = 0.f; const int tok = blk * 128 + tid;
    if (tid < 128) { const float* lg = M.LOGITS + (size_t)tok * 64;
      const float rsd = 1.0f;
      const f32x4 g4 = *(const f32x4*)lg; const float g0 = rsd * g4.x + I.b_group[0], g1 = rsd * g4.y + I.b_group[1], g2 = rsd * g4.z + I.b_group[2], g3 = rsd * g4.w + I.b_group[3];
      int gi = 0; float gm = g0; if (g1 > gm) { gm = g1; gi = 1; } if (g2 > gm) { gm = g2; gi = 2; } if (g3 > gm) { gm = g3; gi = 3; }
      const float grp_w = 1.0f / (expf(g0 - gm) + expf(g1 - gm) + expf(g2 - gm) + expf(g3 - gm));
      const f32x4 ea = *(const f32x4*)(lg + 4 + gi * 8), eb = *(const f32x4*)(lg + 8 + gi * 8); const f32x4 ba = *(const f32x4*)(I.b_expert + gi * 8), bb = *(const f32x4*)(I.b_expert + gi * 8 + 4);
      const float el[8] = {rsd * ea.x + ba.x, rsd * ea.y + ba.y, rsd * ea.z + ba.z, rsd * ea.w + ba.w, rsd * eb.x + bb.x, rsd * eb.y + bb.y, rsd * eb.z + bb.z, rsd * eb.w + bb.w};
      int i0 = 0; float m0 = el[0];
#pragma unroll
      for (int j = 1; j < 8; ++j) if (el[j] > m0) { m0 = el[j]; i0 = j; }
      int i1 = -1; float m1 = -3.0e38f;
#pragma unroll
      for (int j = 0; j < 8; ++j) if (j != i0 && el[j] > m1) { m1 = el[j]; i1 = j; }
      const float r = expf(m1 - m0); w0 = grp_w / (1.0f + r); w1 = grp_w * r / (1.0f + r);
      e0 = gi * 8 + i0; e1 = gi * 8 + i1;
      r0 = __hip_atomic_fetch_add(lcnt + e0, 1, __ATOMIC_RELAXED, __HIP_MEMORY_SCOPE_WORKGROUP); r1 = __hip_atomic_fetch_add(lcnt + e1, 1, __ATOMIC_RELAXED, __HIP_MEMORY_SCOPE_WORKGROUP); }
    __syncthreads();
    if (tid < 32) { const int n = lcnt[tid]; lbase[tid] = n > 0 ? atomicAdd(&M.CNT[tid * 64], n) : 0; }
    __syncthreads();
    if (tid < 128) { const int p0 = lbase[e0] + r0, p1 = lbase[e1] + r1;
      M.LIST[e0 * LIST_CAP + p0] = tok * 2; M.LIST[e1 * LIST_CAP + p1] = tok * 2 + 1; M.ASG[tok * 2] = (e0 << 16) | p0; M.ASG[tok * 2 + 1] = (e1 << 16) | p1; B.EW[tok * 2] = w0; B.EW[tok * 2 + 1] = w1; }
    __syncthreads(); }
}
__device__ __forceinline__ void build_tile_table(LAS unsigned char* lds, const MoeBufs& M) {
  LAS int* tab = (LAS int*)(lds + LDS_TAB);
  if (threadIdx.x == 0) { int acc = 0; for (int e = 0; e < 32; ++e) { tab[e] = acc; acc += (M.CNT[e * 64] + 255) >> 8; } tab[32] = acc; }
  __syncthreads();
}
__device__ __forceinline__ int tile_expert(const LAS int* tab, int tile) { int e = 0;
#pragma unroll 1
  for (int j = 1; j < 32; ++j) if (tab[j] <= tile) e = j;
  return e; }

struct SchedGU { const int* list; int tile, ct, lbase, nvalid, e;
  __device__ bool next(int i, Unit& u) const { if (i > 0) return false; u.pm = tile; u.pn = ct; u.aux0 = lbase; u.aux1 = nvalid; return true; }
  __device__ __forceinline__ const char* a_base(const pg8::Gemm& g, const Unit&) const { return (const char*)g.A; }
  __device__ __forceinline__ const char* b_base(const pg8::Gemm& g, const Unit&) const { return (const char*)g.Bt + ((size_t)e * 512 + (size_t)ct * 256) * 1024 * 2; }
  __device__ __forceinline__ int a_row(const Unit&, int r) const { return r < nvalid ? (list[lbase + r] >> 1) : 0; } };
struct EpiGU { static constexpr bool PERM = true; u16* act; const int* list; const float* ssq;
  __device__ __forceinline__ void operator()(const f32x4 (&acc)[2][2][4][2], const Unit& u, int wr, int wc, int fr, int fq) const {
#pragma unroll
    for (int ai = 0; ai < 2; ++ai)
#pragma unroll
      for (int m = 0; m < 4; ++m) { const int r = ai * 128 + wr * 64 + m * 16 + fr; const float rs = 1.0f;
        const f32x4 g0 = acc[ai][0][m][0] * rs, g1 = acc[ai][0][m][1] * rs, u0 = acc[ai][1][m][0] * rs, u1 = acc[ai][1][m][1] * rs;
        const float a[8] = {g0.x * fsig(g0.x) * u0.x, g0.y * fsig(g0.y) * u0.y, g0.z * fsig(g0.z) * u0.z, g0.w * fsig(g0.w) * u0.w, g1.x * fsig(g1.x) * u1.x, g1.y * fsig(g1.y) * u1.y, g1.z * fsig(g1.z) * u1.z, g1.w * fsig(g1.w) * u1.w};
        store8(act + ((size_t)u.pm * 256 + r) * 256 + u.pn * 128 + wc * 32 + 8 * fq, a);
        if (m & 1) asm volatile("" ::: "memory"); } } };
__device__ __forceinline__ void phase_moe_gu(LAS unsigned char* lds, const Bufs& B, const WBufs& W, const MoeBufs& M) {
  const LAS int* tab = (const LAS int*)(lds + LDS_TAB); const int T = tab[32];
  for (int L = blockIdx.x; L < T * 2; L += gridDim.x) { const int tile = L >> 1, ct = L & 1, e = __builtin_amdgcn_readfirstlane(tile_expert(tab, tile)), rt = tile - __builtin_amdgcn_readfirstlane(tab[e]); int nvalid = __builtin_amdgcn_readfirstlane(M.CNT[e * 64]) - rt * 256; nvalid = nvalid > 256 ? 256 : nvalid;
    pg8::Gemm g{B.H2, W.WguT, 256, 256, 1024, 1024, 1024, 128}; SchedGU S{M.LIST, tile, ct, e * LIST_CAP + rt * 256, nvalid, e}; EpiGU E{B.ACT, M.LIST, M.SSQ};
    pg8::gemm_phase<EpiGU, SchedGU, true, true>(lds, g, S, E); }
}
struct SchedD { const LAS int* tab; int T4, G, c;
  __device__ bool next(int i, Unit& u) const { const int L = i * G + c; if (L >= T4) return false; const int tile = L >> 2; u.pm = tile; u.pn = L & 3; u.aux0 = __builtin_amdgcn_readfirstlane(tile_expert(tab, tile)); u.aux1 = 0; return true; }
  __device__ __forceinline__ const char* a_base(const pg8::Gemm& g, const Unit& u) const { return (const char*)g.A + (size_t)u.pm * 256 * 256 * 2; }
  __device__ __forceinline__ const char* b_base(const pg8::Gemm& g, const Unit& u) const { return (const char*)g.Bt + ((size_t)u.aux0 * 1024 + (size_t)u.pn * 256) * 256 * 2; }
  __device__ __forceinline__ int a_row(const Unit&, int) const { return 0; } };
__device__ __forceinline__ void phase_moe_down(LAS unsigned char* lds, const Bufs& B, const WBufs& W, const MoeBufs& M) {
  const LAS int* tab = (const LAS int*)(lds + LDS_TAB);
  pg8::Gemm g{B.ACT, W.WdT, 256, 1024, 256, 256, 256, 128}; SchedD S{tab, tab[32] * 4, (int)gridDim.x, (int)blockIdx.x}; Epi8<FStoreBf> E{FStoreBf{M.MOEOUT, 1024}};
  pg8::gemm_phase<Epi8<FStoreBf>, SchedD, true, false>(lds, g, S, E);
}
__device__ __forceinline__ void phase_moe_combine(LAS unsigned char* lds, float* out, const MoeBufs& M, const float* ew, const float* gain, u16* hout) {
  const LAS int* tab = (const LAS int*)(lds + LDS_TAB);
  const int tid = otid(), lane = tid & 63, gw = obid() * 8 + (tid >> 6), ngw = gridDim.x * 8;
  for (int tk = gw; tk < NTOK; tk += 2 * ngw) { f32x4 v[2][4]; float rs[2];
    pg8::u32x2 a[2][4], b[2][4]; float w0[2], w1[2];
#pragma unroll
    for (int q = 0; q < 2; ++q) { const int tok = (tk + q * ngw < NTOK) ? tk + q * ngw : tk; const int a0 = M.ASG[tok * 2], a1 = M.ASG[tok * 2 + 1]; w0[q] = ew[tok * 2]; w1[q] = ew[tok * 2 + 1];
      const int s0 = (tab[a0 >> 16] + ((a0 & 0xffff) >> 8)) * 256 + (a0 & 255), s1 = (tab[a1 >> 16] + ((a1 & 0xffff) >> 8)) * 256 + (a1 & 255);
      const f32x4* xr = (const f32x4*)(out + (size_t)tok * 1024) + lane; const pg8::u32x2* o0 = (const pg8::u32x2*)(M.MOEOUT + (size_t)s0 * 1024) + lane; const pg8::u32x2* o1 = (const pg8::u32x2*)(M.MOEOUT + (size_t)s1 * 1024) + lane;
#pragma unroll
      for (int j = 0; j < 4; ++j) { v[q][j] = xr[64 * j]; a[q][j] = o0[64 * j]; b[q][j] = o1[64 * j]; } }
#pragma unroll
    for (int q = 0; q < 2; ++q) { float s = 0.f;
#pragma unroll
      for (int j = 0; j < 4; ++j) { f32x4& x = v[q][j];
        x.x += w0[q] * __uint_as_float(a[q][j].x << 16) + w1[q] * __uint_as_float(b[q][j].x << 16); x.y += w0[q] * __uint_as_float(a[q][j].x & 0xffff0000u) + w1[q] * __uint_as_float(b[q][j].x & 0xffff0000u);
        x.z += w0[q] * __uint_as_float(a[q][j].y << 16) + w1[q] * __uint_as_float(b[q][j].y << 16); x.w += w0[q] * __uint_as_float(a[q][j].y & 0xffff0000u) + w1[q] * __uint_as_float(b[q][j].y & 0xffff0000u);
        s += (x.x * x.x + x.y * x.y) + (x.z * x.z + x.w * x.w); }
      rs[q] = 1.0f / sqrtf(wave_sum(s) * (1.f / 1024.f) + nv::EPS); }
#pragma unroll
    for (int q = 0; q < 2; ++q) { if (tk + q * ngw >= NTOK) break; const int tok = tk + q * ngw; f32x4* xr = (f32x4*)(out + (size_t)tok * 1024) + lane; const f32x4* gr = (const f32x4*)gain + lane;
      unsigned long long* o8 = (unsigned long long*)(hout + (size_t)tok * 1024) + lane;
#pragma unroll
      for (int j = 0; j < 4; ++j) { const f32x4 g = gr[64 * j]; const f32x4 x = v[q][j]; xr[64 * j] = x; o8[64 * j] = (unsigned long long)pk2(x.x * rs[q] * g.x, x.y * rs[q] * g.y) | ((unsigned long long)pk2(x.z * rs[q] * g.z, x.w * rs[q] * g.w) << 32); } } }
}
}
namespace fa {
using nv::u16; using nv::Bufs;
typedef short bf16x8 __attribute__((ext_vector_type(8)));
typedef short s16x4 __attribute__((ext_vector_type(4)));
typedef float f32x16 __attribute__((ext_vector_type(16)));
typedef unsigned u32x4 __attribute__((ext_vector_type(4)));
constexpr float C2 = 0.125f * 1.4426950408889634f;
constexpr int S = nv::S, QKVW = 1280;
constexpr int IMP_LD = 65, IMP_HEAD = 64 * IMP_LD;
constexpr int L_K = 0, L_V = 32768, L_WSF = 65536, L_IMP = 67584, L_MASK = L_IMP + 4 * IMP_HEAD * 4 + 64  , L_OST = L_IMP  , L_END = L_MASK + 512;
static_assert(L_END <= 147456, "attention LDS map");

__device__ __forceinline__ int crow(int r, int hi) { return (r & 3) + 8 * (r >> 2) + 4 * hi; }
__device__ __forceinline__ float ex2(float x) { return __builtin_amdgcn_exp2f(x); }
__device__ __forceinline__ float max3f(float a, float b, float c) { float r; asm("v_max3_f32 %0, %1, %2, %3" : "=v"(r) : "v"(a), "v"(b), "v"(c)); return r; }
__device__ __forceinline__ float max2f(float a, float b) { float r; asm("v_max_f32_e32 %0, %1, %2" : "=v"(r) : "v"(a), "v"(b)); return r; }
__device__ __forceinline__ float swap_add(float v) { auto rr = __builtin_amdgcn_permlane32_swap(__float_as_uint(v), __float_as_uint(v), false, false); return __uint_as_float(rr[0]) + __uint_as_float(rr[1]); }
__device__ __forceinline__ float swap_max(float v) { auto rr = __builtin_amdgcn_permlane32_swap(__float_as_uint(v), __float_as_uint(v), false, false); return __builtin_fmaxf(__uint_as_float(rr[0]), __uint_as_float(rr[1])); }

__device__ __forceinline__ void phase_qknorm(const nv::Inputs& I, const Bufs& B) {
  const int nwg = (int)gridDim.x > 64 ? (int)gridDim.x - 64 : (int)gridDim.x;
  if ((int)blockIdx.x >= nwg) return;
  for (int it = blockIdx.x * 512 + fx::otid(); it < nv::NTOK * 4; it += nwg * 512) { const int tok = it >> 2, w = it & 3; u16* v; const float* gain;
    if (w < 2) { v = B.QKV + (size_t)tok * QKVW + nv::O_KS + w * 64; gain = I.ks_gain; } else { v = B.QKV + (size_t)tok * QKVW + nv::O_KW + (w - 2) * 64; gain = I.kw_gain; }
    float x[8][8]; float s = 0.f;
#pragma unroll
    for (int c = 0; c < 8; ++c) { fx::load8(v + c * 8, x[c]);
#pragma unroll
      for (int j = 0; j < 8; ++j) s += x[c][j] * x[c][j]; }
    const float rs = 1.0f / sqrtf(s * (1.f / 64.f) + nv::EPS);
#pragma unroll
    for (int c = 0; c < 8; ++c) { float y[8];
#pragma unroll
      for (int j = 0; j < 8; ++j) y[j] = x[c][j] * rs * gain[c * 8 + j];
      fx::store8(v + c * 8, y); } }
}

__device__ __forceinline__ void stage_kv(LAS unsigned char* lds, int slot, const u16* kbase, const u16* vbase, int stride, int wid, int lane, bool withV) {
  { const int row = 8 * wid + (lane >> 3), ch = lane & 7; const u16* ksrc = kbase + (size_t)row * stride + ((ch ^ (row & 7)) * 8);
    __builtin_amdgcn_global_load_lds((const unsigned*)ksrc, (LAS unsigned*)(lds + L_K + slot * 8192 + wid * 1024), 16, 0, 0); }
  if (withV) { const u16* vsrc = vbase + (size_t)(16 * (wid & 3) + (lane >> 2)) * stride + (wid >> 2) * 32 + (lane & 3) * 8;
    __builtin_amdgcn_global_load_lds((const unsigned*)vsrc, (LAS unsigned*)(lds + L_V + slot * 8192 + wid * 1024), 16, 0, 0); }
}
__device__ __forceinline__ void qkt(f32x16& p0, f32x16& p1, const LAS unsigned char* Kslot, const bf16x8 (&qr)[4], int r32, int hi, float bias = 0.f) {
  const LAS unsigned char* kb = Kslot + r32 * 128; const int sw = r32 & 7;
  bf16x8 kf[8];
#pragma unroll
  for (int d0 = 0; d0 < 4; ++d0) { const int o = ((2 * d0 + hi) ^ sw) << 4; kf[2 * d0] = *(const LAS bf16x8*)(kb + o); kf[2 * d0 + 1] = *(const LAS bf16x8*)(kb + 4096 + o); }
  f32x16 z;
#pragma unroll
  for (int r = 0; r < 16; ++r) z[r] = bias;
  asm volatile("s_waitcnt lgkmcnt(0)" ::: "memory"); __builtin_amdgcn_sched_barrier(0);
  p0 = __builtin_amdgcn_mfma_f32_32x32x16_bf16(kf[0], qr[0], z, 0, 0, 0); p1 = __builtin_amdgcn_mfma_f32_32x32x16_bf16(kf[1], qr[0], z, 0, 0, 0);
#pragma unroll
  for (int d0 = 1; d0 < 4; ++d0) { p0 = __builtin_amdgcn_mfma_f32_32x32x16_bf16(kf[2 * d0], qr[d0], p0, 0, 0, 0); p1 = __builtin_amdgcn_mfma_f32_32x32x16_bf16(kf[2 * d0 + 1], qr[d0], p1, 0, 0, 0); }
}
__device__ __forceinline__ void pv(f32x16 (&o)[2], int vb, bf16x8 pa0, bf16x8 pa1, bf16x8 pa2, bf16x8 pa3) {
#define FA_PK(k) (bf16x8){lo[k][0], lo[k][1], lo[k][2], lo[k][3], hi[k][0], hi[k][1], hi[k][2], hi[k][3]}
  s16x4 lo[8], hi[8];
#pragma unroll
  for (int d0 = 0; d0 < 2; ++d0)
#pragma unroll
    for (int ks = 0; ks < 4; ++ks) {
      asm volatile("ds_read_b64_tr_b16 %0,%1 offset:%c2" : "=&v"(lo[d0 * 4 + ks]) : "v"(vb), "i"(d0 * 4096 + ks * 1024) : "memory");
      asm volatile("ds_read_b64_tr_b16 %0,%1 offset:%c2" : "=&v"(hi[d0 * 4 + ks]) : "v"(vb), "i"(d0 * 4096 + ks * 1024 + 512) : "memory"); }
  asm volatile("s_waitcnt lgkmcnt(0)" ::: "memory"); __builtin_amdgcn_sched_barrier(0);
  o[0] = __builtin_amdgcn_mfma_f32_32x32x16_bf16(pa0, FA_PK(0), o[0], 0, 0, 0); o[1] = __builtin_amdgcn_mfma_f32_32x32x16_bf16(pa0, FA_PK(4), o[1], 0, 0, 0);
  o[0] = __builtin_amdgcn_mfma_f32_32x32x16_bf16(pa1, FA_PK(1), o[0], 0, 0, 0); o[1] = __builtin_amdgcn_mfma_f32_32x32x16_bf16(pa1, FA_PK(5), o[1], 0, 0, 0);
  o[0] = __builtin_amdgcn_mfma_f32_32x32x16_bf16(pa2, FA_PK(2), o[0], 0, 0, 0); o[1] = __builtin_amdgcn_mfma_f32_32x32x16_bf16(pa2, FA_PK(6), o[1], 0, 0, 0);
  o[0] = __builtin_amdgcn_mfma_f32_32x32x16_bf16(pa3, FA_PK(3), o[0], 0, 0, 0); o[1] = __builtin_amdgcn_mfma_f32_32x32x16_bf16(pa3, FA_PK(7), o[1], 0, 0, 0);
#undef FA_PK
}
struct SmState { float m, l; f32x16 o[2]; };
#ifdef PROBE_STAMPS
struct Prof { unsigned long long t, a[4]; };
#define FA_PROF_DECL Prof prof; prof.t = __builtin_amdgcn_s_memrealtime(); prof.a[0] = prof.a[1] = prof.a[2] = prof.a[3] = 0;
#define FA_PROF(k) do { __builtin_amdgcn_sched_barrier(0); const unsigned long long n_ = __builtin_amdgcn_s_memrealtime(); prof.a[k] += n_ - prof.t; prof.t = n_; __builtin_amdgcn_sched_barrier(0); } while (0)
#define FA_PROF_ARG , Prof& prof
#define FA_PROF_PASS , prof
#else
#define FA_PROF_DECL
#define FA_PROF(k) do {} while (0)
#define FA_PROF_ARG
#define FA_PROF_PASS
#endif
__device__ __forceinline__ void sm_reset(SmState& st) { st.m = 0.f; st.l = 0.f;
#pragma unroll
  for (int r = 0; r < 16; ++r) { st.o[0][r] = 0.f; st.o[1][r] = 0.f; } }
__device__ __forceinline__ void mask_range(f32x16& p0, f32x16& p1, int klo, int khi, int hi) {
  if (__all(klo <= 0 && khi >= 63)) return;
#pragma unroll
  for (int r = 0; r < 16; ++r) { const int k0 = crow(r, hi), k1 = k0 + 32; if (k0 < klo || k0 > khi) p0[r] = -INFINITY; if (k1 < klo || k1 > khi) p1[r] = -INFINITY; }
}
__device__ __forceinline__ void tile_step(SmState& st, LAS unsigned char* lds, int slot, const bf16x8 (&qr)[4], LAS float* wsf, int r32, int hi, int vb0, int klo, int khi, float bias FA_PROF_ARG) {
  FA_PROF(0);
  f32x16 p0, p1; qkt(p0, p1, lds + L_K + slot * 8192, qr, r32, hi, bias);
  asm volatile("" : "+v"(p0), "+v"(p1)); FA_PROF(1);
  mask_range(p0, p1, klo, khi, hi);
  float rs = 0.f;
#pragma unroll
  for (int r = 0; r < 16; ++r) { p0[r] = ex2(p0[r] - st.m); p1[r] = ex2(p1[r] - st.m); rs += p0[r] + p1[r]; }
  if (__builtin_expect(__any(!(rs < 1.0e30f)), 0)) {
    qkt(p0, p1, lds + L_K + slot * 8192, qr, r32, hi, bias); mask_range(p0, p1, klo, khi, hi);
    float rm = max2f(p0[0], p1[0]);
#pragma unroll
    for (int r = 1; r < 16; ++r) rm = max3f(rm, p0[r], p1[r]);
    rm = swap_max(rm) - st.m; const float d = rm > 24.f ? rm : 0.f; const float f = ex2(-d); st.m += d; st.l *= f;
    if (hi == 0) wsf[r32] = f;
    rs = 0.f;
#pragma unroll
    for (int r = 0; r < 16; ++r) { p0[r] = ex2(p0[r] - st.m); p1[r] = ex2(p1[r] - st.m); rs += p0[r] + p1[r]; const float fr = wsf[crow(r, hi)]; st.o[0][r] *= fr; st.o[1][r] *= fr; } }
  st.l += rs;
  u32x4 w0, w1, w2, w3;
  w0.x = pg8::cvt_pk_bf16(p0[0], p0[1]); w0.y = pg8::cvt_pk_bf16(p0[2], p0[3]); w0.z = pg8::cvt_pk_bf16(p0[4], p0[5]); w0.w = pg8::cvt_pk_bf16(p0[6], p0[7]);
  w1.x = pg8::cvt_pk_bf16(p0[8], p0[9]); w1.y = pg8::cvt_pk_bf16(p0[10], p0[11]); w1.z = pg8::cvt_pk_bf16(p0[12], p0[13]); w1.w = pg8::cvt_pk_bf16(p0[14], p0[15]);
  w2.x = pg8::cvt_pk_bf16(p1[0], p1[1]); w2.y = pg8::cvt_pk_bf16(p1[2], p1[3]); w2.z = pg8::cvt_pk_bf16(p1[4], p1[5]); w2.w = pg8::cvt_pk_bf16(p1[6], p1[7]);
  w3.x = pg8::cvt_pk_bf16(p1[8], p1[9]); w3.y = pg8::cvt_pk_bf16(p1[10], p1[11]); w3.z = pg8::cvt_pk_bf16(p1[12], p1[13]); w3.w = pg8::cvt_pk_bf16(p1[14], p1[15]);
  asm volatile("" : "+v"(w0), "+v"(w1), "+v"(w2), "+v"(w3)); FA_PROF(2);
  pv(st.o, vb0 + L_V + slot * 8192, __builtin_bit_cast(bf16x8, w0), __builtin_bit_cast(bf16x8, w1), __builtin_bit_cast(bf16x8, w2), __builtin_bit_cast(bf16x8, w3));
  asm volatile("" : "+v"(st.o[0]), "+v"(st.o[1])); FA_PROF(3);
}
template <int MODE> __device__ __forceinline__ void finalize(SmState& st, float gate, f32x16 (&outacc)[2], LAS float* slab, LAS float* wsf, int r32, int hi, int lane, float& msafe, float& invl) {
  const float lt = swap_add(st.l); invl = lt > 0.f ? 1.0f / lt : 0.f; msafe = st.m;
  if (hi == 0) wsf[r32] = gate * invl;
#pragma unroll
  for (int r = 0; r < 16; ++r) { const float fr = wsf[crow(r, hi)];
    if (MODE == 0) { outacc[0][r] = st.o[0][r] * fr; outacc[1][r] = st.o[1][r] * fr; }
    else if (MODE == 1) { slab[r * 64 + lane] += st.o[0][r] * fr; slab[(16 + r) * 64 + lane] += st.o[1][r] * fr; }
    else { outacc[0][r] = slab[r * 64 + lane] + st.o[0][r] * fr; outacc[1][r] = slab[(16 + r) * 64 + lane] + st.o[1][r] * fr; } }
}
__device__ __forceinline__ void imp_step(LAS unsigned char* lds, int slot, const bf16x8 (&qr)[4], int r32, int hi, int khi, float msafe, float invl, LAS float* imph  , int tq, int T) {
  f32x16 p0, p1; qkt(p0, p1, lds + L_K + slot * 8192, qr, r32, hi);
  mask_range(p0, p1, 0, khi, hi);
#pragma unroll
  for (int r = 0; r < 16; ++r) { p0[r] = ex2(p0[r] - msafe) * invl; p1[r] = ex2(p1[r] - msafe) * invl; }
  LAS float* row = imph + tq * IMP_LD + 16 * T + hi;
#pragma unroll
  for (int gq = 0; gq < 4; ++gq) { row[2 * gq] += (p0[4 * gq] + p0[4 * gq + 1]) + (p0[4 * gq + 2] + p0[4 * gq + 3]); row[2 * gq + 8] += (p1[4 * gq] + p1[4 * gq + 1]) + (p1[4 * gq + 2] + p1[4 * gq + 3]); }
  asm volatile("s_waitcnt lgkmcnt(0)" ::: "memory");
#pragma unroll
  for (int gq = 0; gq < 4; ++gq) { row[2 * gq + 1] += p0[4 * gq + 3]; if (16 * T + hi + 2 * gq + 9 < 64) row[2 * gq + 9] += p1[4 * gq + 3]; }
  asm volatile("s_waitcnt lgkmcnt(0)" ::: "memory");
}
__device__ __forceinline__ void topk_select(LAS unsigned char* lds, LAS float* wsf, int wid, int lane, int i) {
  LAS float* IM = (LAS float*)(lds + L_IMP); LAS unsigned long long* MK = (LAS unsigned long long*)(lds + L_MASK);
  const int j = lane; const int nforced = i == 0 ? 1 : (i == 1 ? 2 : 3);
  const bool forced = (j <= i) && (j == 0 || j == i || j == i - 1); const bool cand = (j >= 1) && (j <= i - 2);
  for (int tq = wid; tq < 64; tq += 8) {
    const float v = (IM[tq * IMP_LD + j] + IM[IMP_HEAD + tq * IMP_LD + j]) + (IM[2 * IMP_HEAD + tq * IMP_LD + j] + IM[3 * IMP_HEAD + tq * IMP_LD + j]);
    int cnt = 0;
#pragma unroll 4
    for (int jj = 1; jj <= i - 2; ++jj) { const float vv = __uint_as_float(__builtin_amdgcn_readlane(__float_as_uint(v), jj)); cnt += (vv > v || (vv == v && jj < j)) ? 1 : 0; }
    const bool sel = forced || (cand && cnt < 16 - nforced);
    const unsigned long long mk = __ballot(sel);
    if (lane == 0) MK[tq] = mk;
  }
}
__device__ __forceinline__ void attn_unit(LAS unsigned char* lds, const nv::Inputs& I, const Bufs& B, int b, int g, int i) {
  const int tid = fx::otid(), lane = tid & 63, wid = __builtin_amdgcn_readfirstlane(tid >> 6), r32 = lane & 31, hi = lane >> 5;
  const int e = wid >> 1, h = g * 4 + e, tq = 32 * (wid & 1) + r32; const size_t tok = (size_t)b * S + 64 * i + tq; const int t = 64 * i + tq;
  LAS float* wsf = (LAS float*)(lds + L_WSF) + wid * 64;
  LAS float* imph = (LAS float*)(lds + L_IMP) + e * IMP_HEAD;
  const int vb0 = (int)(unsigned)(size_t)lds + ((lane >> 4) & 1) * 32 + (lane & 3) * 8 + (4 * hi + ((lane & 15) >> 2)) * 64;
  bf16x8 qr[4];
  {
    float qv[4][8]; float ss = 0.f;
#pragma unroll
    for (int d0 = 0; d0 < 4; ++d0) { fx::load8(B.QKV + tok * QKVW + h * 64 + d0 * 16 + hi * 8, qv[d0]);
#pragma unroll
      for (int j = 0; j < 8; ++j) ss += qv[d0][j] * qv[d0][j]; }
    ss = swap_add(ss); const float rs = C2 / sqrtf(ss * (1.f / 64.f) + nv::EPS);
#pragma unroll
    for (int d0 = 0; d0 < 4; ++d0) { u32x4 w; const float* gq = I.q_gain + d0 * 16 + hi * 8;
      w.x = pg8::cvt_pk_bf16(qv[d0][0] * rs * gq[0], qv[d0][1] * rs * gq[1]); w.y = pg8::cvt_pk_bf16(qv[d0][2] * rs * gq[2], qv[d0][3] * rs * gq[3]);
      w.z = pg8::cvt_pk_bf16(qv[d0][4] * rs * gq[4], qv[d0][5] * rs * gq[5]); w.w = pg8::cvt_pk_bf16(qv[d0][6] * rs * gq[6], qv[d0][7] * rs * gq[7]); qr[d0] = __builtin_bit_cast(bf16x8, w); } }
  const float g0 = B.NG[tok * 24 + h * 3 + 0], g1 = B.NG[tok * 24 + h * 3 + 1], g2 = B.NG[tok * 24 + h * 3 + 2];
  const u16* kc = B.KCMP + (size_t)(b * 2 + g) * 256 * 64; const u16* vc = B.VCMP + (size_t)(b * 2 + g) * 256 * 64;
  const u16* ksb = B.QKV + (size_t)b * S * QKVW + nv::O_KS + g * 64; const u16* vsb = B.QKV + (size_t)b * S * QKVW + nv::O_VS + g * 64;
  const u16* kwb = B.QKV + (size_t)b * S * QKVW + nv::O_KW + g * 64; const u16* vwb = B.QKV + (size_t)b * S * QKVW + nv::O_VW + g * 64;
  int nvis = t >= 31 ? (t - 31) / 16 + 1 : 0; nvis = nvis > 255 ? 255 : nvis;
  const int ntA = (4 * i + 3 + 63) / 64, nC = (i < 8 ? i : 8) + 1, jC0 = i - (nC - 1);
  const int sI = ntA, sB = 2 * ntA, sC = sB + i + 1, NS = sC + nC;
  { LAS float* IM = (LAS float*)(lds + L_IMP); for (int k = tid; k < 4 * IMP_HEAD; k += 512) IM[k] = 0.f; }
  f32x16 outacc[2];
  LAS float* slab = (LAS float*)(lds + L_IMP) + wid * 2048;
  SmState st; sm_reset(st);
  float mA = 0.f, invlA = 0.f; unsigned long long mybits = 0ull;
  FA_PROF_DECL
#ifdef PROBE_STAMPS
  const unsigned long long ck0 = __builtin_amdgcn_s_memtime(), rt0 = __builtin_amdgcn_s_memrealtime();
#endif
#define FA_ISSUE1(s_) do { const int s__ = (s_); const int sl = s__ & 3; \
    if (s__ < sI) stage_kv(lds, sl, kc + (size_t)s__ * 4096, vc + (size_t)s__ * 4096, 64, wid, lane, true); \
    else if (s__ < sB) stage_kv(lds, sl, kc + (size_t)(s__ - sI) * 4096, vc + (size_t)(s__ - sI) * 4096, 64, wid, lane, true); \
    else if (s__ < sC) stage_kv(lds, sl, ksb + (size_t)(s__ - sB) * 64 * QKVW, vsb + (size_t)(s__ - sB) * 64 * QKVW, QKVW, wid, lane, true); \
    else stage_kv(lds, sl, kwb + (size_t)(jC0 + s__ - sC) * 64 * QKVW, vwb + (size_t)(jC0 + s__ - sC) * 64 * QKVW, QKVW, wid, lane, true); } while (0)
  FA_ISSUE1(0);
  int s = 0;
#define FA_TOP(n_) do { asm volatile("s_waitcnt vmcnt(0)" ::: "memory"); __syncthreads(); if (s + 1 < NS) FA_ISSUE1(s + 1); } while (0)
#pragma unroll 1
  for (; s < sI; ++s) { FA_TOP(1); tile_step(st, lds, s & 3, qr, wsf, r32, hi, vb0, 0, nvis - 64 * s - 1, 0.f FA_PROF_PASS); }
  finalize<0>(st, g0, outacc, slab, wsf, r32, hi, lane, mA, invlA);
#pragma unroll 1
  for (; s < sB; ++s) { FA_TOP(1); imp_step(lds, s & 3, qr, r32, hi, nvis - 64 * (s - sI) - 1, mA, invlA, imph, tq, s - sI); }
  asm volatile("s_waitcnt lgkmcnt(0)\n\ts_barrier" ::: "memory");
  topk_select(lds, wsf, wid, lane, i);
  asm volatile("s_waitcnt lgkmcnt(0)\n\ts_barrier" ::: "memory"); mybits = ((const LAS unsigned long long*)(lds + L_MASK))[tq];
#pragma unroll
  for (int r = 0; r < 16; ++r) { slab[r * 64 + lane] = outacc[0][r]; slab[(16 + r) * 64 + lane] = outacc[1][r]; }
  sm_reset(st);
#pragma unroll 1
  for (; s < sC; ++s) { FA_TOP(1); const int j = s - sB; const bool selj = (mybits >> j) & 1ull;
    tile_step(st, lds, s & 3, qr, wsf, r32, hi, vb0, 0, j == i ? tq : 63, selj ? 0.f : -INFINITY FA_PROF_PASS); }
  { float d0_, d1_; finalize<1>(st, g1, outacc, slab, wsf, r32, hi, lane, d0_, d1_); sm_reset(st); }
#pragma unroll 1
  for (; s < NS; ++s) { FA_TOP(1); const int j = jC0 + (s - sC);
    tile_step(st, lds, s & 3, qr, wsf, r32, hi, vb0, (i >= 8 && j == i - 8) ? tq + 1 : 0, j == i ? tq : 63, 0.f FA_PROF_PASS); }
  { float d0_, d1_; finalize<2>(st, g2, outacc, slab, wsf, r32, hi, lane, d0_, d1_); }
#undef FA_ISSUE1
#undef FA_TOP
  { u16* Ow = B.YA + ((size_t)b * S + 64 * i + 32 * (wid & 1)) * 512 + h * 64; LAS u16* stg = (LAS u16*)(lds + L_OST) + wid * 4096;
#pragma unroll
    for (int r = 0; r < 16; ++r) { const int orow = crow(r, hi); stg[orow * 64 + r32] = nv::f2bf(outacc[0][r]); stg[orow * 64 + 32 + r32] = nv::f2bf(outacc[1][r]); }
    asm volatile("s_waitcnt lgkmcnt(0)" ::: "memory");
#pragma unroll
    for (int q = 0; q < 4; ++q) { const int row = q * 8 + (lane >> 3), ch = lane & 7; const u32x4 v = *(const LAS u32x4*)(stg + row * 64 + ch * 8); *(u32x4*)(Ow + (size_t)row * 512 + ch * 8) = v; } }
#ifdef PROBE_STAMPS
  if (blockIdx.x == 0 && threadIdx.x == PROBE_TID) { volatile LAS unsigned long long* ts = (volatile LAS unsigned long long*)(lds + 147120); for (int k = 0; k < 4; ++k) ts[20 + k] += prof.a[k]; ts[24] += (__builtin_amdgcn_s_memtime() - ck0) / 10; ts[25] += __builtin_amdgcn_s_memrealtime() - rt0; }
#endif
  __syncthreads();
}
__device__ __forceinline__ void phase_attention(LAS unsigned char* lds, const nv::Inputs& I, const Bufs& B) {
  const int G = gridDim.x, bx = blockIdx.x; const int vcu = (G % 8 == 0) ? (bx % 8) * (G / 8) + bx / 8 : bx;
  for (int u = vcu; u < 256; u += G) { const int bg = u >> 4, s = u & 15;
#pragma unroll 1
    for (int k = 0; k < 4; ++k) { const int i = (k == 0) ? s : (k == 1) ? 31 - s : (k == 2) ? 32 + s : 63 - s; attn_unit(lds, I, B, bg >> 1, bg & 1, i); } }
}
}
namespace fs {
#ifdef PROBE_STAMPS
#define FS_STAMP(k) do { if (blockIdx.x == 0 && threadIdx.x == 0) *(volatile LAS unsigned long long*)(lds + 147120 + 8 * (k)) = __builtin_amdgcn_s_memrealtime(); } while (0)
#else
#define FS_STAMP(k) do {} while (0)
#endif
using nv::u16; using nv::Bufs; using nv::Inputs;
using fa::bf16x8; using fa::f32x16; using fa::u32x4; using fa::crow; using fa::ex2;
typedef float f32x4 __attribute__((ext_vector_type(4)));
constexpr int S = nv::S, NTOK = nv::NTOK, SCD = 1536;
constexpr float LOG2E = 1.4426950408889634f;
struct SsdBufs { u16* XC; u16* STATE; float* ACS; float* DEC; };
__host__ __device__ inline size_t carve_ssd(SsdBufs& X, const Bufs& B, unsigned char* ws, size_t off) {
  auto take = [&](size_t bytes) { unsigned char* r = ws + off; off += (bytes + 255) / 256 * 256; return r; };
  X.XC = B.HB;
  X.STATE = B.HB + (size_t)NTOK * SCD;
  X.ACS = (float*)take((size_t)NTOK * 16 * 4); X.DEC = (float*)take((size_t)8 * 16 * 16 * 4);
  return off;
}
constexpr int L_ARR = 101376;
constexpr int L_BT = 0, BT_LD = 264, L_XWT = 67584;
constexpr int L_KIMG = 0, L_XV = 0, L_OST = 65536;
static_assert(L_XWT + 64 * BT_LD * 2 <= L_ARR && L_OST + 32768 <= L_ARR && L_ARR + 16384 <= 147456, "SSD LDS map");

__device__ __forceinline__ void phase_conv(const Inputs& I, const Bufs& B, const SsdBufs& X) {
  const int id = blockIdx.x * 512 + fx::otid(); if (id >= 192 * 512) return;
  const int c8 = (id % 192) * 8, run = id / 192; const int tok0 = run * 64; const int t0 = tok0 & (S - 1);
  float w[4][8], bias[8], h0[8], h1[8], h2[8];
#pragma unroll
  for (int j = 0; j < 8; ++j) { bias[j] = I.conv_b[c8 + j];
#pragma unroll
    for (int k = 0; k < 4; ++k) w[k][j] = I.conv_w[k * SCD + c8 + j]; }
  if (t0 >= 3) { fx::load8(B.XBC + (size_t)(tok0 - 3) * SCD + c8, h0); fx::load8(B.XBC + (size_t)(tok0 - 2) * SCD + c8, h1); fx::load8(B.XBC + (size_t)(tok0 - 1) * SCD + c8, h2); }
  else {
#pragma unroll
    for (int j = 0; j < 8; ++j) { h0[j] = 0.f; h1[j] = 0.f; h2[j] = 0.f; } }
#pragma unroll 8
  for (int t = 0; t < 64; ++t) { float x[8], y[8]; fx::load8(B.XBC + (size_t)(tok0 + t) * SCD + c8, x);
#pragma unroll
    for (int j = 0; j < 8; ++j) { const float a = bias[j] + w[0][j] * h0[j] + w[1][j] * h1[j] + w[2][j] * h2[j] + w[3][j] * x[j]; y[j] = a * fx::fsig(a); h0[j] = h1[j]; h1[j] = h2[j]; h2[j] = x[j]; }
    fx::store8(X.XC + (size_t)(tok0 + t) * SCD + c8, y); }
}

__device__ __forceinline__ void ssd_x_unit(LAS unsigned char* lds, const Inputs& I, const Bufs& B, const SsdBufs& X, int b, int c, int g) {
  const int tid = fx::otid(), lane = tid & 63, wid = __builtin_amdgcn_readfirstlane(tid >> 6), r32 = lane & 31, hi = lane >> 5, fr = lane & 15, fq = lane >> 4;
  const size_t tok0 = (size_t)b * S + (size_t)c * 256;
  LAS float* acs2 = (LAS float*)(lds + L_ARR); LAS float* dtl = acs2 + 8 * 256;
  { const int hh = g * 8 + wid; const float a = -expf(I.a_log[hh]) * LOG2E; float d[4], sc[4];
#pragma unroll
    for (int k = 0; k < 4; ++k) d[k] = B.DT[(tok0 + 4 * lane + k) * 16 + hh];
    sc[0] = d[0] * a; sc[1] = sc[0] + d[1] * a; sc[2] = sc[1] + d[2] * a; sc[3] = sc[2] + d[3] * a;
    float tot = sc[3];
#pragma unroll
    for (int o = 1; o < 64; o <<= 1) { const float up = __shfl_up(tot, o); if (lane >= o) tot += up; }
    const float excl = tot - sc[3];
#pragma unroll
    for (int k = 0; k < 4; ++k) { const float v = excl + sc[k]; acs2[wid * 256 + 4 * lane + k] = v; dtl[wid * 256 + 4 * lane + k] = d[k]; X.ACS[(tok0 + 4 * lane + k) * 16 + hh] = v; }
    if (lane == 63) X.DEC[((size_t)b * 16 + c) * 16 + hh] = ex2(tot); }
  { LAS u16* BT = (LAS u16*)(lds + L_BT);
#pragma unroll 1
    for (int q = tid; q < 256 * 16; q += 512) { const int l = q >> 4, n8 = (q & 15) * 8; const u32x4 w = *(const u32x4*)(X.XC + (tok0 + l) * SCD + 1024 + g * 128 + n8);
      BT[(n8 + 0) * BT_LD + l] = (u16)(w.x & 0xffff); BT[(n8 + 1) * BT_LD + l] = (u16)(w.x >> 16); BT[(n8 + 2) * BT_LD + l] = (u16)(w.y & 0xffff); BT[(n8 + 3) * BT_LD + l] = (u16)(w.y >> 16);
      BT[(n8 + 4) * BT_LD + l] = (u16)(w.z & 0xffff); BT[(n8 + 5) * BT_LD + l] = (u16)(w.z >> 16); BT[(n8 + 6) * BT_LD + l] = (u16)(w.w & 0xffff); BT[(n8 + 7) * BT_LD + l] = (u16)(w.w >> 16); } }
  __syncthreads();
  FS_STAMP(30);
  u32x4 nx[4];
#define FSX_LOAD_X(h_) do { _Pragma("unroll") for (int u = 0; u < 4; ++u) { const int q = tid + u * 512; nx[u] = *(const u32x4*)(X.XC + (tok0 + (q >> 3)) * SCD + (g * 8 + (h_)) * 64 + (q & 7) * 8); } } while (0)
  FSX_LOAD_X(0);
#pragma unroll 1
  for (int h = 0; h < 8; ++h) { const int hh = g * 8 + h; LAS u16* XwT = (LAS u16*)(lds + L_XWT); const LAS u16* BT = (const LAS u16*)(lds + L_BT);
    const float aend = acs2[h * 256 + 255];
#pragma unroll
    for (int u = 0; u < 4; ++u) { const int q = tid + u * 512, l = q >> 3, p8 = (q & 7) * 8; const float w = ex2(aend - acs2[h * 256 + l]) * dtl[h * 256 + l]; const u32x4 xv = nx[u];
      XwT[(p8 + 0) * BT_LD + l] = nv::f2bf(__uint_as_float(xv.x << 16) * w); XwT[(p8 + 1) * BT_LD + l] = nv::f2bf(__uint_as_float(xv.x & 0xffff0000u) * w);
      XwT[(p8 + 2) * BT_LD + l] = nv::f2bf(__uint_as_float(xv.y << 16) * w); XwT[(p8 + 3) * BT_LD + l] = nv::f2bf(__uint_as_float(xv.y & 0xffff0000u) * w);
      XwT[(p8 + 4) * BT_LD + l] = nv::f2bf(__uint_as_float(xv.z << 16) * w); XwT[(p8 + 5) * BT_LD + l] = nv::f2bf(__uint_as_float(xv.z & 0xffff0000u) * w);
      XwT[(p8 + 6) * BT_LD + l] = nv::f2bf(__uint_as_float(xv.w << 16) * w); XwT[(p8 + 7) * BT_LD + l] = nv::f2bf(__uint_as_float(xv.w & 0xffff0000u) * w); }
    if (h + 1 < 8) FSX_LOAD_X(h + 1);
    asm volatile("s_waitcnt lgkmcnt(0)\n\ts_barrier" ::: "memory");
    { const int pt = wid & 3, nt0 = (wid >> 2) * 4; pg8::f32x4 acc[4];
#pragma unroll
      for (int n = 0; n < 4; ++n) acc[n] = (pg8::f32x4){0.f, 0.f, 0.f, 0.f};
#pragma unroll
      for (int ks = 0; ks < 8; ++ks) { const bf16x8 a = *(const LAS bf16x8*)(XwT + (pt * 16 + fr) * BT_LD + ks * 32 + fq * 8);
#pragma unroll
        for (int n = 0; n < 4; ++n) { const bf16x8 bb = *(const LAS bf16x8*)(BT + ((nt0 + n) * 16 + fr) * BT_LD + ks * 32 + fq * 8); acc[n] = __builtin_amdgcn_mfma_f32_16x16x32_bf16(a, bb, acc[n], 0, 0, 0); } }
      u16* st = X.STATE + (((size_t)b * 16 + c) * 16 + hh) * 8192;
#pragma unroll
      for (int n = 0; n < 4; ++n)
#pragma unroll
        for (int j = 0; j < 4; ++j) st[(pt * 16 + 4 * fq + j) * 128 + (nt0 + n) * 16 + fr] = nv::f2bf(acc[n][j]); }
    asm volatile("s_waitcnt lgkmcnt(0)\n\ts_barrier" ::: "memory"); }
#undef FSX_LOAD_X
  FS_STAMP(31);
  const int lt = wid < 4 ? wid : 11 - wid;
  const int l = 32 * lt + r32;
  for (int k = tid; k < 8 * 256; k += 512) { const int h_ = k >> 8, s_ = k & 255; dtl[k] = ex2(acs2[h_ * 256 + (s_ & ~15)] - acs2[k]) * dtl[k]; }
  bf16x8 qr[8];
#pragma unroll
  for (int d0 = 0; d0 < 8; ++d0) qr[d0] = *(const bf16x8*)(X.XC + (tok0 + l) * SCD + 1280 + g * 128 + d0 * 16 + hi * 8);
  unsigned Sp[4][16];
#define FS_STAGE_K(j_) do { const int j__ = (j_); _Pragma("unroll") for (int q = 0; q < 2; ++q) { const int ch = wid + 8 * q; \
    __builtin_amdgcn_global_load_lds((const unsigned*)(X.XC + (tok0 + 64 * j__ + lane) * SCD + 1024 + g * 128 + ch * 8), (LAS unsigned*)(lds + L_KIMG + (j__ & 1) * 16384 + ch * 1024), 16, 0, 0); } } while (0)
  FS_STAGE_K(0);
#pragma unroll
  for (int j = 0; j < 4; ++j) {
    asm volatile("s_waitcnt vmcnt(0)" ::: "memory"); __syncthreads();
    if (j + 1 < 4) FS_STAGE_K(j + 1);
    f32x16 p0, p1;
#pragma unroll
    for (int r = 0; r < 16; ++r) { p0[r] = 0.f; p1[r] = 0.f; }
    if (64 * j <= 32 * lt + 31) { const LAS unsigned char* kb = lds + L_KIMG + (j & 1) * 16384 + hi * 1024 + r32 * 16;
#pragma unroll
      for (int d0 = 0; d0 < 8; ++d0) { const bf16x8 b0 = *(const LAS bf16x8*)(kb + d0 * 2048), b1 = *(const LAS bf16x8*)(kb + d0 * 2048 + 512);
        p0 = __builtin_amdgcn_mfma_f32_32x32x16_bf16(b0, qr[d0], p0, 0, 0, 0); p1 = __builtin_amdgcn_mfma_f32_32x32x16_bf16(b1, qr[d0], p1, 0, 0, 0); } }
#pragma unroll
    for (int r = 0; r < 8; ++r) { Sp[j][r] = pg8::cvt_pk_bf16(p0[2 * r], p0[2 * r + 1]); Sp[j][8 + r] = pg8::cvt_pk_bf16(p1[2 * r], p1[2 * r + 1]); } }
#undef FS_STAGE_K
  FS_STAMP(32);
  __syncthreads();
#define FS_STAGE_X(h_) do { const int h__ = (h_); _Pragma("unroll") for (int j = 0; j < 4; ++j) \
    __builtin_amdgcn_global_load_lds((const unsigned*)(X.XC + (tok0 + 64 * j + 16 * (wid & 3) + (lane >> 2)) * SCD + (g * 8 + h__) * 64 + (wid >> 2) * 32 + (lane & 3) * 8), \
                                     (LAS unsigned*)(lds + L_XV + (h__ & 1) * 32768 + j * 8192 + wid * 1024), 16, 0, 0); } while (0)
  const int vb0 = (int)(unsigned)(size_t)lds + ((lane >> 4) & 1) * 32 + (lane & 3) * 8 + (4 * hi + ((lane & 15) >> 2)) * 64;
  FS_STAGE_X(0);
#pragma unroll 1
  for (int h = 0; h < 8; ++h) { const int hh = g * 8 + h;
    if (h == 0) asm volatile("s_waitcnt vmcnt(0) lgkmcnt(0)\n\ts_barrier" ::: "memory"); else asm volatile("s_waitcnt vmcnt(4) lgkmcnt(0)\n\ts_barrier" ::: "memory");
    if (h + 1 < 8) FS_STAGE_X(h + 1);
    const float al = acs2[h * 256 + l]; f32x16 o[2];
#pragma unroll
    for (int r = 0; r < 16; ++r) { o[0][r] = 0.f; o[1][r] = 0.f; }
#pragma unroll
    for (int j = 0; j < 4; ++j) { if (64 * j <= 32 * lt + 31) { f32x16 p0, p1;
#pragma unroll
        for (int r = 0; r < 16; ++r) asm volatile("" : "+v"(Sp[j][r]));
#pragma unroll
        for (int r = 0; r < 8; ++r) { p0[2 * r] = __uint_as_float(Sp[j][r] << 16); p0[2 * r + 1] = __uint_as_float(Sp[j][r] & 0xffff0000u); p1[2 * r] = __uint_as_float(Sp[j][8 + r] << 16); p1[2 * r + 1] = __uint_as_float(Sp[j][8 + r] & 0xffff0000u); }
        float e1[4];
#pragma unroll
        for (int q = 0; q < 4; ++q) e1[q] = ex2(al - acs2[h * 256 + 64 * j + 16 * q]);
#pragma unroll
        for (int gq = 0; gq < 4; ++gq) { const int s0 = 64 * j + 8 * gq + 4 * hi; const f32x4 d0v = *(const LAS f32x4*)(dtl + h * 256 + s0), d1v = *(const LAS f32x4*)(dtl + h * 256 + s0 + 32);
#pragma unroll
          for (int k = 0; k < 4; ++k) { const int r = 4 * gq + k, s = s0 + k; p0[r] = (s <= l) ? p0[r] * (e1[gq >> 1] * d0v[k]) : 0.f; p1[r] = (s + 32 <= l) ? p1[r] * (e1[2 + (gq >> 1)] * d1v[k]) : 0.f; } }
        u32x4 w0, w1, w2, w3;
        w0.x = pg8::cvt_pk_bf16(p0[0], p0[1]); w0.y = pg8::cvt_pk_bf16(p0[2], p0[3]); w0.z = pg8::cvt_pk_bf16(p0[4], p0[5]); w0.w = pg8::cvt_pk_bf16(p0[6], p0[7]);
        w1.x = pg8::cvt_pk_bf16(p0[8], p0[9]); w1.y = pg8::cvt_pk_bf16(p0[10], p0[11]); w1.z = pg8::cvt_pk_bf16(p0[12], p0[13]); w1.w = pg8::cvt_pk_bf16(p0[14], p0[15]);
        w2.x = pg8::cvt_pk_bf16(p1[0], p1[1]); w2.y = pg8::cvt_pk_bf16(p1[2], p1[3]); w2.z = pg8::cvt_pk_bf16(p1[4], p1[5]); w2.w = pg8::cvt_pk_bf16(p1[6], p1[7]);
        w3.x = pg8::cvt_pk_bf16(p1[8], p1[9]); w3.y = pg8::cvt_pk_bf16(p1[10], p1[11]); w3.z = pg8::cvt_pk_bf16(p1[12], p1[13]); w3.w = pg8::cvt_pk_bf16(p1[14], p1[15]);
        fa::pv(o, vb0 + L_XV + (h & 1) * 32768 + j * 8192, __builtin_bit_cast(bf16x8, w0), __builtin_bit_cast(bf16x8, w1), __builtin_bit_cast(bf16x8, w2), __builtin_bit_cast(bf16x8, w3)); } }
    { const float dsk = I.d_skip[hh]; const LAS u16* xi = (const LAS u16*)(lds + L_XV + (h & 1) * 32768 + (lt >> 1) * 8192); LAS u16* stg = (LAS u16*)(lds + L_OST) + wid * 2048;
#pragma unroll
      for (int r = 0; r < 16; ++r) { const int key = 32 * (lt & 1) + crow(r, hi);
#pragma unroll
        for (int d0 = 0; d0 < 2; ++d0) { const float xv = nv::bf2f(xi[d0 * 2048 + (key >> 4) * 512 + (key & 15) * 32 + r32]); stg[crow(r, hi) * 64 + d0 * 32 + r32] = nv::f2bf(o[d0][r] + dsk * xv); } }
      asm volatile("s_waitcnt lgkmcnt(0)" ::: "memory");
      u16* Ow = X.XC + (tok0 + 32 * lt) * SCD + hh * 64;
#pragma unroll
      for (int q = 0; q < 4; ++q) { const int row = q * 8 + (lane >> 3), ch = lane & 7; const u32x4 v = *(const LAS u32x4*)(stg + row * 64 + ch * 8); *(u32x4*)(Ow + (size_t)row * SCD + ch * 8) = v; } } }
#undef FS_STAMP_DUMMY
#undef FS_STAGE_X
  __syncthreads(); FS_STAMP(33);
}
__device__ __forceinline__ void phase_ssd_x(LAS unsigned char* lds, const Inputs& I, const Bufs& B, const SsdBufs& X) {
  for (int u = blockIdx.x; u < 256; u += gridDim.x) ssd_x_unit(lds, I, B, X, u >> 5, (u >> 1) & 15, u & 1);
}
__device__ __forceinline__ void phase_ssd_scan(const SsdBufs& X) {
  for (int it = blockIdx.x * 512 + fx::otid(); it < 8 * 16 * 64 * 32; it += gridDim.x * 512) { const int n4 = (it & 31) * 4, p = (it >> 5) & 63, hh = (it >> 11) & 15, b = it >> 15;
    pg8::u32x2 v[16]; float dec[16];
#pragma unroll
    for (int c = 0; c < 16; ++c) { v[c] = *(const pg8::u32x2*)(X.STATE + (((size_t)b * 16 + c) * 16 + hh) * 8192 + p * 128 + n4); dec[c] = X.DEC[((size_t)b * 16 + c) * 16 + hh]; }
    float h0 = 0.f, h1 = 0.f, h2 = 0.f, h3 = 0.f;
#pragma unroll
    for (int c = 0; c < 16; ++c) { pg8::u32x2 o; o.x = fx::pk2(h0, h1); o.y = fx::pk2(h2, h3); *(pg8::u32x2*)(X.STATE + (((size_t)b * 16 + c) * 16 + hh) * 8192 + p * 128 + n4) = o;
      h0 = h0 * dec[c] + __uint_as_float(v[c].x << 16); h1 = h1 * dec[c] + __uint_as_float(v[c].x & 0xffff0000u); h2 = h2 * dec[c] + __uint_as_float(v[c].y << 16); h3 = h3 * dec[c] + __uint_as_float(v[c].y & 0xffff0000u); } }
}
__device__ __forceinline__ void ssd_y_unit(LAS unsigned char* lds, const Inputs& I, const Bufs& B, const SsdBufs& X, int b, int c, int g) {
  const int tid = fx::otid(), lane = tid & 63, wid = __builtin_amdgcn_readfirstlane(tid >> 6), r32 = lane & 31, hi = lane >> 5;
  const size_t tok0 = (size_t)b * S + (size_t)c * 256; const int l = 32 * wid + r32;
  LAS float* acsw = (LAS float*)(lds + 0) + wid * 32 * 8;
  LAS u16* stg1 = (LAS u16*)(lds + 16384) + wid * 2048; LAS u16* stg2 = (LAS u16*)(lds + 49152) + wid * 2048; LAS float* rstdL = (LAS float*)(lds + 81920);
  { const int row = lane >> 1, h4 = (lane & 1) * 4; const f32x4 a = *(const f32x4*)(X.ACS + (tok0 + 32 * wid + row) * 16 + g * 8 + h4); acsw[row * 8 + h4 + 0] = ex2(a.x); acsw[row * 8 + h4 + 1] = ex2(a.y); acsw[row * 8 + h4 + 2] = ex2(a.z); acsw[row * 8 + h4 + 3] = ex2(a.w); }
  bf16x8 qr[8];
#pragma unroll
  for (int d0 = 0; d0 < 8; ++d0) qr[d0] = *(const bf16x8*)(X.XC + (tok0 + l) * SCD + 1280 + g * 128 + d0 * 16 + hi * 8);
  float ssq[16];
#pragma unroll
  for (int r = 0; r < 16; ++r) ssq[r] = 0.f;
#define FSY_STAGE_P(h_) do { const int h__ = (h_); const u16* pp_ = X.STATE + (((size_t)b * 16 + c) * 16 + g * 8 + h__) * 8192; _Pragma("unroll") for (int q = 0; q < 2; ++q) { const int ch = wid + 8 * q; \
    __builtin_amdgcn_global_load_lds((const unsigned*)(pp_ + (size_t)lane * 128 + ch * 8), (LAS unsigned*)(lds + 90112 + (h__ & 1) * 16384 + ch * 1024), 16, 0, 0); } } while (0)
#define FSY_LOAD_YZ(h_) do { const int hh__ = g * 8 + (h_); _Pragma("unroll") for (int q = 0; q < 4; ++q) { const int row = q * 8 + (lane >> 3), ch = lane & 7; \
    ny1[q] = *(const u32x4*)(X.XC + (tok0 + 32 * wid + row) * SCD + hh__ * 64 + ch * 8); nz[q] = *(const u32x4*)(B.Z + (tok0 + 32 * wid + row) * 1024 + hh__ * 64 + ch * 8); } } while (0)
  u32x4 ny1[4], nz[4];
  FS_STAMP(34);
  FSY_STAGE_P(0); FSY_LOAD_YZ(0);
#pragma unroll 1
  for (int h = 0; h < 8; ++h) { const int hh = g * 8 + h;
    if (h == 0) asm volatile("s_waitcnt vmcnt(0) lgkmcnt(0)\n\ts_barrier" ::: "memory"); else asm volatile("s_waitcnt vmcnt(4) lgkmcnt(0)\n\ts_barrier" ::: "memory");
#pragma unroll
    for (int q = 0; q < 4; ++q) { const int row = q * 8 + (lane >> 3), ch = lane & 7; *(LAS u32x4*)(stg1 + row * 64 + ch * 8) = ny1[q]; *(LAS u32x4*)(stg2 + row * 64 + ch * 8) = nz[q]; }
    if (h + 1 < 8) { FSY_STAGE_P(h + 1); FSY_LOAD_YZ(h + 1); }
    f32x16 y[2];
#pragma unroll
    for (int r = 0; r < 16; ++r) { y[0][r] = 0.f; y[1][r] = 0.f; }
    { const LAS unsigned char* pb = lds + 90112 + (h & 1) * 16384 + hi * 1024 + r32 * 16;
#pragma unroll
      for (int d0 = 0; d0 < 8; ++d0) { const bf16x8 b0 = *(const LAS bf16x8*)(pb + d0 * 2048), b1 = *(const LAS bf16x8*)(pb + d0 * 2048 + 512);
        y[0] = __builtin_amdgcn_mfma_f32_32x32x16_bf16(qr[d0], b0, y[0], 0, 0, 0); y[1] = __builtin_amdgcn_mfma_f32_32x32x16_bf16(qr[d0], b1, y[1], 0, 0, 0); } }
    asm volatile("s_waitcnt lgkmcnt(0)" ::: "memory");
#pragma unroll
    for (int r = 0; r < 16; ++r) { const int row = crow(r, hi); const float ea = acsw[row * 8 + h];
#pragma unroll
      for (int d0 = 0; d0 < 2; ++d0) { const int idx = row * 64 + d0 * 32 + r32; const float yy = nv::bf2f(stg1[idx]) + ea * y[d0][r]; const float zz = nv::bf2f(stg2[idx]); const float yg = yy * zz * fx::fsig(zz); ssq[r] += yg * yg; stg1[idx] = nv::f2bf(yg); } }
    asm volatile("s_waitcnt lgkmcnt(0)" ::: "memory");
#pragma unroll
    for (int q = 0; q < 4; ++q) { const int row = q * 8 + (lane >> 3), ch = lane & 7; *(u32x4*)(B.YB + (tok0 + 32 * wid + row) * 1024 + hh * 64 + ch * 8) = *(const LAS u32x4*)(stg1 + row * 64 + ch * 8); }
    asm volatile("s_waitcnt lgkmcnt(0)" ::: "memory"); }
  FS_STAMP(35);
#pragma unroll
  for (int r = 0; r < 16; ++r) { float v = ssq[r];
#pragma unroll
    for (int o = 1; o < 32; o <<= 1) v += __shfl_xor(v, o);
    if (r32 == 0) rstdL[32 * wid + crow(r, hi)] = 1.0f / sqrtf(v * (1.f / 512.f) + nv::EPS); }
#undef FSY_STAGE_P
#undef FSY_LOAD_YZ
  asm volatile("s_waitcnt vmcnt(0) lgkmcnt(0)\n\ts_barrier" ::: "memory"); FS_STAMP(36);
#pragma unroll 1
  for (int q0 = tid; q0 < 256 * 64; q0 += 512 * 8) { float v[8][8];
#pragma unroll
    for (int u = 0; u < 8; ++u) { const int q = q0 + u * 512, row = q >> 6, c8 = (q & 63) * 8; fx::load8(B.YB + (tok0 + row) * 1024 + g * 512 + c8, v[u]); }
#pragma unroll
    for (int u = 0; u < 8; ++u) { const int q = q0 + u * 512, row = q >> 6, c8 = (q & 63) * 8; const float rs = rstdL[row];
#pragma unroll
      for (int j = 0; j < 8; ++j) v[u][j] = v[u][j] * rs * I.ssm_norm[g * 512 + c8 + j];
      fx::store8(B.YB + (tok0 + row) * 1024 + g * 512 + c8, v[u]); } }
  __syncthreads();
}
__device__ __forceinline__ void phase_ssd_y(LAS unsigned char* lds, const Inputs& I, const Bufs& B, const SsdBufs& X) {
  for (int u = blockIdx.x; u < 256; u += gridDim.x) ssd_y_unit(lds, I, B, X, u >> 5, (u >> 1) & 15, u & 1);
}
}
namespace fc {
using nv::u16; using nv::Bufs; using nv::Inputs; using pg8::Unit;
constexpr int S = nv::S;
struct CmpBufs { u16* WcT; float* BIAS1; float* PAB; };
__host__ __device__ inline size_t carve_cmp(CmpBufs& C, unsigned char* ws, size_t off) {
  auto take = [&](size_t bytes) { unsigned char* r = ws + off; off += (bytes + 255) / 256 * 256; return r; };
  C.WcT = (u16*)take((size_t)2 * 256 * 1024 * 2); C.BIAS1 = (float*)take(2 * 128 * 4); C.PAB = (float*)take((size_t)2 * 2 * 16 * 256 * 256 * 4);
  return off;
}
struct CpCmp { const float* src; int ld; __device__ const float* operator()(int n) const { return n < 128 ? src + n : src + (size_t)1024 * 128 + (n - 128); } };
__device__ __forceinline__ void prologue_cmp(LAS unsigned char* lds, const Inputs& I, const CmpBufs& C) {
  { const int tid = fx::otid(), lane = tid & 63, wv = tid >> 6, gw = fx::obid() * 8 + wv, ngw = gridDim.x * 8; LAS float* scr = (LAS float*)lds + wv * (64 * 33);
    for (int t = gw; t < 2 * 8 * 16; t += ngw) { const int kv = t >> 7, q = t & 127; CpCmp cp{kv ? I.w1_v : I.w1_k, 128}; fx::transpose_item(scr, cp, C.WcT + (size_t)kv * 256 * 1024, 1024, (q >> 4) * 32, (q & 15) * 64, lane); } }
  { const int tid = fx::otid(), lane = tid & 63, gw = fx::obid() * 8 + (tid >> 6);
    if (gw < 256) { const int kv = gw >> 7, n = gw & 127; const float* w1 = kv ? I.w1_v : I.w1_k; const float* pos = kv ? I.pos_v : I.pos_k; float s = 0.f;
      for (int k = lane; k < 2048; k += 64) s += pos[k] * w1[(size_t)k * 128 + n];
      s = fx::wave_sum(s); if (lane == 0) C.BIAS1[kv * 128 + n] = s; } }
}
struct SchedCmp { int kv, bg, kh;
  __device__ bool next(int i, Unit& u) const { if (i > 0) return false; u.pm = (kh * 2 + kv) * 16 + bg; u.pn = 0; u.aux0 = 0; u.aux1 = 0; return true; }
  __device__ __forceinline__ const char* a_base(const pg8::Gemm& g, const Unit&) const { return (const char*)g.A + (size_t)kh * 8 * 1280 * 2; }
  __device__ __forceinline__ const char* b_base(const pg8::Gemm& g, const Unit&) const { return (const char*)g.Bt + ((size_t)kv * 256 * 1024 + (size_t)kh * 512) * 2; }
  __device__ __forceinline__ int a_row(const Unit&, int r) const { return ((bg >> 1) * S + 16 * r) * 1280 + (kv ? nv::O_VC : nv::O_KC) + (bg & 1) * 64; } };
struct FPab { float* o; __device__ __forceinline__ void operator()(const Unit&, int row, int c, const float (&v)[8]) const { float* p = o + (size_t)row * 256 + c; *(pg8::f32x4*)p = (pg8::f32x4){v[0], v[1], v[2], v[3]}; *(pg8::f32x4*)(p + 4) = (pg8::f32x4){v[4], v[5], v[6], v[7]}; } };
__device__ __forceinline__ void phase_cmp_gemm(LAS unsigned char* lds, const Bufs& B, const CmpBufs& C) {
  for (int u = (int)blockIdx.x - ((int)gridDim.x - 64); u >= 0 && u < 64; u += gridDim.x) { pg8::Gemm g{B.QKV, C.WcT, 256, 256, 512, 1, 1024, 1280 * 2}; SchedCmp S{(u >> 4) & 1, u & 15, u >> 5}; fx::Epi8<FPab> E{FPab{C.PAB}};
    pg8::gemm_phase<fx::Epi8<FPab>, SchedCmp, true, true>(lds, g, S, E); }
}
__device__ __forceinline__ void phase_cmp_finish(LAS unsigned char* lds, const Inputs& I, const Bufs& B, const CmpBufs& C) {
  const int tid = fx::otid(), lane = tid & 63, wv = tid >> 6, gw = fx::obid() * 8 + wv, ngw = gridDim.x * 8;
  LAS float* w2s = (LAS float*)lds; LAS float* hs = (LAS float*)(lds + 65536) + wv * 128;
  for (int k = tid; k < 2 * 128 * 64 / 4; k += 512) { const int kv = k >> 11, q = k & 2047; *(LAS pg8::f32x4*)(w2s + kv * 8192 + q * 4) = *(const pg8::f32x4*)((kv ? I.w2_v : I.w2_k) + q * 4); }
  __syncthreads();
  for (int it = gw; it < 2 * 16 * 256; it += ngw) { const int kv = it >> 12, bg = (it >> 8) & 15, c = it & 255; u16* dst = (kv ? B.VCMP : B.KCMP) + ((size_t)bg * 256 + c) * 64;
    if (c == 255) { dst[lane] = 0; continue; }
    const float* pa = C.PAB + ((size_t)(kv * 16 + bg) * 256 + c) * 256; const float* pb = pa + 256 + 128; const float* b1 = C.BIAS1 + kv * 128;
    const float* pa2 = pa + (size_t)2 * 16 * 256 * 256; const float* pb2 = pb + (size_t)2 * 16 * 256 * 256;
    { const float ha = (pa[lane] + pa2[lane]) + (pb[lane] + pb2[lane]) + b1[lane], hb = (pa[64 + lane] + pa2[64 + lane]) + (pb[64 + lane] + pb2[64 + lane]) + b1[64 + lane]; hs[lane] = ha * fx::fsig(ha); hs[64 + lane] = hb * fx::fsig(hb); }
    const LAS float* w2 = w2s + kv * 8192; float acc = 0.f;
#pragma unroll 8
    for (int n = 0; n < 128; ++n) acc += hs[n] * w2[n * 64 + lane];
    if (kv == 0) { const float ss = fx::wave_sum(acc * acc); acc = acc * (1.0f / sqrtf(ss * (1.f / 64.f) + nv::EPS)) * I.kc_gain[lane]; }
    dst[lane] = nv::f2bf(acc); }
  __syncthreads();
}
}
struct Params { nv::Inputs I; float* out; unsigned char* ws; };
constexpr int LDS_BYTES = 147456;
template <class F> __device__ __forceinline__ void run_phase(const F& f, long n) {
  for (long i = blockIdx.x * 512L + fx::otid(); i < n; i += (long)gridDim.x * 512L) f(i);
}
__global__ void __launch_bounds__(512) mega_fwd(Params P) {
  extern __shared__ __attribute__((aligned(16))) unsigned char lds_raw[];
  LAS unsigned char* lds = (LAS unsigned char*)lds_raw;
  cg::grid_group grid = cg::this_grid();
#define PH(...) { unsigned char* ws_ = P.ws; float* out = P.out; asm volatile("" : "+s"(ws_), "+s"(out)); nv::Bufs B; const size_t woff = nv::carve(B, ws_, out); fx::WBufs W; const size_t moff = fx::carve_w(W, ws_, woff); \
    fx::MoeBufs M; const size_t soff = fx::carve_moe(M, B, ws_, moff); fs::SsdBufs X; const size_t coff = fs::carve_ssd(X, B, ws_, soff); fc::CmpBufs C; const size_t boff = fc::carve_cmp(C, ws_, coff); unsigned* barw = (unsigned*)(ws_ + boff); (void)barw; (void)W; (void)M; (void)X; (void)C; __VA_ARGS__ }
  if (threadIdx.x < 4) ((LAS unsigned*)(lds + LDS_BYTES - 16))[threadIdx.x] = 0u;
  __syncthreads();
  xb::XcdBarrier bar; PH( bar = xb::xcd_barrier_post(barw, (volatile LAS unsigned*)(lds + LDS_BYTES - 16)); )
#define GSYNC() xb::xcd_barrier(bar)
  PH( fx::phase_prologue(lds, P.I, B, W); fx::phase_rms_rows(P.I.x, P.I.mix_norm, B.HB); fx::prologue_pb(P.I, W); fx::prologue_moe(P.I, M); fc::prologue_cmp(lds, P.I, C); ) grid.sync();
  PH( fx::dense_gemm(lds, B.HB, 1024, W.WinT, 1024, nv::NTOK, fx::INW_PAD, 1024, fx::FInProj{B.QKV, B.Z, B.XBC, B.BG, B.NG, B.DT, P.I.dt_bias}); ) GSYNC();
  PH( fc::phase_cmp_gemm(lds, B, C); fs::phase_conv(P.I, B, X); fa::phase_qknorm(P.I, B); ) GSYNC();
  PH( fs::phase_ssd_x(lds, P.I, B, X); ) GSYNC();
  PH( fs::phase_ssd_scan(X); fc::phase_cmp_finish(lds, P.I, B, C); ) GSYNC();
  PH( fs::phase_ssd_y(lds, P.I, B, X); ) GSYNC();
  PH( fa::phase_attention(lds, P.I, B); ) GSYNC();
  PH( fx::dense_gemm(lds, B.YA, 512, W.WaT, 512, nv::NTOK, 1024, 512, fx::FStoreBf{B.T1, 1024}); )
  PH( fx::dense_gemm(lds, B.YB, 1024, W.WbT, 1024, nv::NTOK, 1024, 1024, fx::FMerge{B.T1, B.BG, B.MERGED}); ) GSYNC();
  PH( fx::dense_gemm(lds, B.MERGED, 1024, W.WoutT, 1024, nv::NTOK, 1024, 1024, fx::FResid{P.I.x, out}); ) GSYNC();
  PH( fx::phase_rms_rows(out, P.I.moe_norm, B.H2); ) GSYNC();
  PH( fx::dense_gemm(lds, B.H2, 1024, M.WrT, 1024, nv::NTOK, 256, 1024, fx::FLogits{M.LOGITS}); ) GSYNC();
  PH( fx::phase_route(lds, P.I, B, M); ) GSYNC();
  PH( fx::build_tile_table(lds, M); )
  PH( fx::phase_moe_gu(lds, B, W, M); ) GSYNC();
  PH( fx::phase_moe_down(lds, B, W, M); ) GSYNC();
  PH( fx::phase_moe_combine(lds, out, M, B.EW, P.I.ple_norm, B.H2); ) GSYNC();
  PH( fx::dense_gemm(lds, W.PB, 256, W.PlePT, 256, nv::NTOK, 1024, 256, fx::FStoreBf{B.PP, 1024}); )
  PH( fx::dense_gemm(lds, B.H2, 1024, W.PleGT, 1024, nv::NTOK, 1024, 1024, fx::FPle{out, B.PP}); )
#undef GSYNC
}
extern "C" void kernel_launch(void* const* d_in, const int* in_sizes, int n_in, void* d_out, int out_size, void* d_ws, size_t ws_size, hipStream_t stream) {
  static int grid_blocks = 0;
  if (!grid_blocks) {
    int dev = 0, cus = 0, per_cu = 0;
    (void)hipGetDevice(&dev);
    (void)hipDeviceGetAttribute(&cus, hipDeviceAttributeMultiprocessorCount, dev);
    if (hipFuncSetAttribute((const void*)mega_fwd, hipFuncAttributeMaxDynamicSharedMemorySize, LDS_BYTES) != hipSuccess) fprintf(stderr, "kernel_launch: hipFuncSetAttribute failed\n");
    if (hipOccupancyMaxActiveBlocksPerMultiprocessor(&per_cu, mega_fwd, 512, LDS_BYTES) != hipSuccess || per_cu < 1) { fprintf(stderr, "kernel_launch: occupancy query says %d blocks per CU\n", per_cu); }
    grid_blocks = cus;
    { nv::Bufs B; fx::WBufs W; fx::MoeBufs M; fs::SsdBufs X; fc::CmpBufs C; size_t need = 16384 + fc::carve_cmp(C, nullptr, fs::carve_ssd(X, B, nullptr, fx::carve_moe(M, B, nullptr, fx::carve_w(W, nullptr, nv::carve(B, nullptr, nullptr))))); if (need > ws_size) fprintf(stderr, "kernel_launch: workspace too small: need %zu have %zu\n", need, ws_size); }
  }
  static size_t bar_off = 0;
  if (!bar_off) { nv::Bufs B; fx::WBufs W; fx::MoeBufs M; fs::SsdBufs X; fc::CmpBufs C; bar_off = fc::carve_cmp(C, nullptr, fs::carve_ssd(X, B, nullptr, fx::carve_moe(M, B, nullptr, fx::carve_w(W, nullptr, nv::carve(B, nullptr, nullptr))))); }
  (void)hipMemsetAsync((char*)d_ws + bar_off, 0, 16384, stream);
  Params p; memset(&p, 0, sizeof(p));
  const float** ip = (const float**)&p.I; for (int i = 0; i < 34; ++i) ip[i] = (const float*)d_in[i];
  p.out = (float*)d_out; p.ws = (unsigned char*)d_ws;
  void* args[] = {&p};
  hipError_t e = hipLaunchCooperativeKernel((void*)mega_fwd, dim3(grid_blocks), dim3(512), args, LDS_BYTES, stream);
  if (e != hipSuccess) fprintf(stderr, "cooperative launch failed: %s (grid %d)\n", hipGetErrorString(e), grid_blocks);
}
```

```cpp
#include <hip/hip_runtime.h>
#include <hip/hip_cooperative_groups.h>
#include <cstdio>
#include <cstring>
namespace cg = cooperative_groups;
#define HD __host__ __device__ inline
#if defined(__HIP_DEVICE_COMPILE__)
#define NV_FENCE() asm volatile("" ::: "memory")
#else
#define NV_FENCE()
#endif
#ifndef CFG_DM
#define CFG_DM 1024
#endif
#ifndef CFG_BATCH
#define CFG_BATCH 8
#endif
#ifndef CFG_SEQ
#define CFG_SEQ 4096
#endif
#ifndef CFG_MH
#define CFG_MH 256
#endif
#ifndef CFG_PLE
#define CFG_PLE 256
#endif

#ifndef NV_FENCE
#define NV_FENCE()
#endif
namespace nv {
typedef unsigned short u16;
typedef unsigned long long u64;
constexpr int DM = CFG_DM, NB = CFG_BATCH, S = CFG_SEQ, MH = CFG_MH, PLE = CFG_PLE;
constexpr int NTOK = NB * S;
constexpr int H = 8, G = 2, E = 4;
constexpr int QW = 512, GW = 24, QKVW = 1280;
constexpr int SH = 16, SP = 64, SI = 1024, SG = 2, SN = 128, SCD = 1536;
constexpr int INW = QW + 6 * 128 + GW + SI + SCD + SH + 2 * DM;
constexpr int O_Q = 0, O_KC = 512, O_VC = 640, O_KS = 768, O_VS = 896, O_KW = 1024, O_VW = 1152, O_NG = 1280, O_Z = 1304, O_XBC = 2328, O_DT = 3864, O_BG = 3880;
static_assert(O_BG + 2 * DM == INW, "in-proj width");
constexpr int NCMP = S / 16 - 1, NCP = S / 16, NSEL = S / 64, NTOP = NSEL < 16 ? NSEL : 16;
constexpr int NEXP = 32;
constexpr float EPS = 1e-6f;

HD float sigmoidf_(float x) { return 1.0f / (1.0f + expf(-x)); }
HD float siluf_(float x) { return x / (1.0f + expf(-x)); }
HD float softplusf_(float x) { return x > 20.f ? x : log1pf(expf(x)); }
HD u16 f2bf(float f) { unsigned u = __builtin_bit_cast(unsigned, f); u += 0x7fffu + ((u >> 16) & 1u); return (u16)(u >> 16); }
HD float bf2f(u16 h) { return __builtin_bit_cast(float, (unsigned)h << 16); }

struct Bufs {
  u16* HB;
  u16* QKV;
  float* NG;
  u16* Z;
  u16* XBC;
  float* DT;
  u16* BG;
  u16* KCMP;
  u16* VCMP;
  u16* YA;
  u16* YB;
  u16* T1;
  u16* MERGED;
  u16* H2;
  u16* ACT;
  u16* PP;
  int* EI;
  float* EW;
  float* HID;
  float* KTMP;
  float* ML;
  float* IMP;
  u64* MASK;
};
struct Inputs { const float *x, *p, *mix_norm, *w_in, *q_gain, *kc_gain, *ks_gain, *kw_gain, *pos_k, *w1_k, *w2_k, *pos_v, *w1_v, *w2_v, *conv_w, *conv_b, *dt_bias, *a_log, *d_skip, *ssm_norm,
  *w_a, *w_b, *w_out, *moe_norm, *w_group, *b_group, *w_expert, *b_expert, *w_gate, *w_up, *w_down, *ple_norm, *ple_wg, *ple_wp; };

HD size_t carve(Bufs& B, unsigned char* ws, float* out) {
  size_t off = 0; auto take = [&](size_t bytes) { unsigned char* r = ws + off; off += (bytes + 255) / 256 * 256; return r; };
  const size_t N = NTOK;
  B.BG = (u16*)out;
  unsigned char* R0 = take(N * DM * 2);
  unsigned char* R5 = take(N * 2 * MH * 2 + (size_t)NEXP * 256 * MH * 2);
  B.YA = (u16*)take(N * QW * 2);
  unsigned char* R1 = take(N * QKVW * 2);
  unsigned char* R2 = take(N * SI * 2);
  unsigned char* R3 = take(N * SCD * 2);
  B.HB = (u16*)R0; B.H2 = (u16*)R0; B.QKV = (u16*)R1; B.T1 = (u16*)R1; B.Z = (u16*)R2; B.XBC = (u16*)R3; B.MERGED = (u16*)R3; B.PP = (u16*)R3;
  B.ACT = (u16*)R5; B.YB = B.Z;
  B.NG = (float*)take(N * GW * 4); B.DT = (float*)take(N * SH * 4);
  B.KCMP = (u16*)take((size_t)NB * G * NCP * 64 * 2); B.VCMP = (u16*)take((size_t)NB * G * NCP * 64 * 2);
  B.EI = (int*)take(N * 2 * 4); B.EW = (float*)take(N * 2 * 4);
#ifdef NV2_NAIVE_SCRATCH
  B.HID = (float*)take((size_t)NB * G * NCMP * 128 * 4); B.KTMP = (float*)take((size_t)NB * G * NCMP * 64 * 4);
  B.ML = (float*)take(N * H * 2 * 4); B.IMP = (float*)take((size_t)NB * G * S * 64 * 4); B.MASK = (u64*)take((size_t)NB * G * S * 8);
#else
  B.HID = nullptr; B.KTMP = nullptr; B.ML = nullptr; B.IMP = nullptr; B.MASK = nullptr;
#endif
  return off;
}
}
namespace xb {
#define LAS __attribute__((address_space(3)))
#define XB_TMO      128
#define XB_XCNT(j)  (256  + 64 * (j))
#define XB_XSUB(j)  (1280 + 64 * (j))
#define XB_XGEN(j)  (2304 + 64 * (j))
#define XB_TOP      3328
#define XB_TOPGEN   3392
#define XCD_BAR_WORDS 3456
#define XB_SPIN_CAP (1u << 22)

__device__ __forceinline__ unsigned xb_ld(unsigned* p)              { return __hip_atomic_load(p, __ATOMIC_RELAXED, __HIP_MEMORY_SCOPE_AGENT); }
__device__ __forceinline__ unsigned xb_add(unsigned* p, unsigned v) { return __hip_atomic_fetch_add(p, v, __ATOMIC_RELAXED, __HIP_MEMORY_SCOPE_AGENT); }
__device__ __forceinline__ unsigned xb_xcc_id() { return (unsigned)__builtin_amdgcn_s_getreg((3 << 11) | 20) & 0xFu; }
#define XB_SPIN(cond, bar) do { unsigned _sp = 0; while (cond) { __builtin_amdgcn_s_sleep(1); \
    if ((++_sp & 255u) == 0u) { if (xb_ld(&(bar)[XB_TMO])) break; if (_sp > XB_SPIN_CAP) { atomicAdd(&(bar)[XB_TMO], 1u); break; } } } } while (0)

struct XcdBarrier {
    unsigned* bar; unsigned x;
    volatile LAS unsigned* st;
};

__device__ __forceinline__ XcdBarrier xcd_barrier_post(unsigned* bar, volatile LAS unsigned* st) {
    XcdBarrier b; b.bar = bar; b.x = xb_xcc_id(); b.st = st;
    if (threadIdx.x == 0) (void)xb_add(&bar[XB_XCNT(b.x)], 1u);
    return b;
}
__device__ __forceinline__ void xcd_barrier_complete(unsigned* bar, unsigned x, unsigned& nloc, unsigned& nx) {
    const unsigned G = gridDim.x * gridDim.y * gridDim.z;
    unsigned sum, cnt, mine, sp = 0u;
    for (;;) {
        sum = 0u; cnt = 0u; mine = 0u;
#pragma unroll
        for (unsigned j = 0; j < 16; ++j) { const unsigned c = xb_ld(&bar[XB_XCNT(j)]); sum += c; cnt += (c > 0u) ? 1u : 0u; mine = (j == x) ? c : mine; }
        if (sum == G) break;
        __builtin_amdgcn_s_sleep(1);
        if ((++sp & 255u) == 0u) { if (xb_ld(&bar[XB_TMO])) break; if (sp > XB_SPIN_CAP) { atomicAdd(&bar[XB_TMO], 1u); break; } }
    }
    nloc = mine > 0u ? mine : 1u; nx = cnt > 0u ? cnt : 1u;
}

__device__ __forceinline__ void xcd_barrier(const XcdBarrier& b) {
    asm volatile("s_waitcnt vmcnt(0)" ::: "memory");
    __syncthreads();
    if (threadIdx.x == 0) {
        unsigned* bar = b.bar;
        __builtin_amdgcn_s_waitcnt(0);
        unsigned nloc = b.st[0], nx = b.st[1];
        if (nloc == 0u) { xcd_barrier_complete(bar, b.x, nloc, nx); b.st[0] = nloc; b.st[1] = nx; }
        const unsigned old = xb_add(&bar[XB_XSUB(b.x)], 1u);
        const unsigned gen = old / nloc;
        if (old + 1u == (gen + 1u) * nloc) {
            __builtin_amdgcn_fence(__ATOMIC_RELEASE, "agent");
            asm volatile("s_waitcnt vmcnt(0)" ::: "memory");
            const unsigned og = xb_add(&bar[XB_TOP], 1u);
            const unsigned tg = og / nx;
            if (og + 1u == (tg + 1u) * nx) xb_add(&bar[XB_TOPGEN], 1u);
            else XB_SPIN(xb_ld(&bar[XB_TOPGEN]) == tg, bar);
            __builtin_amdgcn_fence(__ATOMIC_ACQUIRE, "agent");
            xb_add(&bar[XB_XGEN(b.x)], 1u);
            asm volatile("s_waitcnt vmcnt(0)" ::: "memory");
        } else {
            XB_SPIN(xb_ld(&bar[XB_XGEN(b.x)]) == gen, bar);
            __builtin_amdgcn_fence(__ATOMIC_ACQUIRE, "agent");
            asm volatile("s_waitcnt vmcnt(0)" ::: "memory");
        }
    }
    __syncthreads();
}
}
namespace pg8 {
#define PG8_LAS __attribute__((address_space(3)))
typedef unsigned short bf16_t;
typedef short bf16x8 __attribute__((ext_vector_type(8)));
typedef float f32x4 __attribute__((ext_vector_type(4)));
typedef unsigned u32x4 __attribute__((ext_vector_type(4)));
typedef unsigned u32x2 __attribute__((ext_vector_type(2)));
constexpr int BM = 256, BK = 64, HALF = 128, HTB = HALF * BK * 2  , STAGE_BYTES = 8 * HTB, NXCD = 8, WGM = 8;

__host__ __device__ __forceinline__ int lds_byte(int r, int c) { const int st = (r >> 4) * 2 + (c >> 5), rr = r & 15, cc = c & 31, ob = rr * 64 + cc * 2; return st * 1024 + (ob ^ (((ob >> 9) & 1) << 5)); }
__host__ __device__ __forceinline__ void stage_rc(int b, int& R, int& C) { const int st = b / 1024, sb = b % 1024, swz = sb ^ (((sb >> 9) & 1) << 5); R = (st >> 1) * 16 + swz / 64; C = (st & 1) * 32 + (swz % 64) / 2; }
__host__ __device__ __forceinline__ int perm32(int rho) { const int n = rho >> 4, i = rho & 15; return 8 * (i >> 2) + 4 * n + (i & 3); }

struct Unit { int pm, pn, aux0, aux1; };
struct Gemm { const bf16_t* A; const bf16_t* Bt; int M, N, K, lda, ldb, kstepA; };

struct StaticOrder {
    int nM, nN, nwg, G, c;
    __device__ void init(int M, int N, int G_, int c_) { nM = M / BM; nN = N / BM; nwg = nM * nN; G = G_; c = c_; }
    __device__ bool next(int i, Unit& u) const {
        const long L = (long)i * G + c; if (L >= nwg) return false;
        int wgid = (int)L; { const int q = nwg / NXCD, r = nwg % NXCD, xcd = wgid % NXCD, off = wgid / NXCD; wgid = (xcd < r ? xcd * (q + 1) : r * (q + 1) + (xcd - r) * q) + off; }
        const int nig = WGM * nN, gid = wgid / nig, fm = gid * WGM, gsz = (nM - fm) < WGM ? (nM - fm) : WGM;
        u.pm = fm + ((wgid % nig) % gsz); u.pn = (wgid % nig) / gsz; u.aux0 = 0; u.aux1 = 0; return true;
    }
    __device__ __forceinline__ const char* a_base(const Gemm& g, const Unit& u) const { return (const char*)g.A + (size_t)u.pm * BM * g.lda * 2; }
    __device__ __forceinline__ const char* b_base(const Gemm& g, const Unit& u) const { return (const char*)g.Bt + (size_t)u.pn * BM * g.ldb * 2; }
    __device__ __forceinline__ int a_row(const Unit&, int) const { return 0; }
};

typedef float f32x2_t __attribute__((ext_vector_type(2))); typedef __bf16 bf16x2_t __attribute__((ext_vector_type(2)));
__device__ __forceinline__ unsigned cvt_pk_bf16(float lo, float hi) { f32x2_t v = {lo, hi}; bf16x2_t b = __builtin_convertvector(v, bf16x2_t); return __builtin_bit_cast(unsigned, b); }


template <class Epi, class Sched, bool ALIGN_EPI = true, bool GATHER = false>
__device__ __forceinline__ void gemm_phase(PG8_LAS unsigned char* lds, const Gemm g, const Sched& S, const Epi& E) {
    int tid_ = threadIdx.x; asm volatile("" : "+v"(tid_));
    const int tid = tid_, wid = __builtin_amdgcn_readfirstlane(tid >> 6), lane = tid & 63, wr = wid >> 2, wc = wid & 3, fr = lane & 15, fq = lane >> 4;
    const int K = g.K, nt = K / BK;
    unsigned voffA[2], voffA1[2], voffB[2];
    int RA[2], CA[2];
#pragma unroll
    for (int i = 0; i < 2; ++i) { int R, C; stage_rc(tid * 16 + i * 8192, R, C); const int Rb = Epi::PERM ? ((R & ~31) + perm32(R & 31)) : R;
        RA[i] = R; CA[i] = C; voffA[i] = (unsigned)(R * g.lda + C) * 2u; voffA1[i] = voffA[i]; voffB[i] = (unsigned)(Rb * g.ldb + C) * 2u; }
    const size_t kstep = (size_t)(BK * 2);
    const size_t kstepA = (size_t)g.kstepA;
    const size_t hstepA = GATHER ? (size_t)0 : (size_t)HALF * g.lda * 2;
    const size_t hstepB = (size_t)HALF * g.ldb * 2;
    const unsigned ldsw = (unsigned)wid * 1024u;
    const int aoff = lds_byte(wr * 64 + fr, fq * 8), boff = lds_byte(wc * 32 + fr, fq * 8);
#define PG8_SA(b, h) (((b) * 2 + (h)) * HTB)
#define PG8_SB(b, h) ((4 + (b) * 2 + (h)) * HTB)
#define PG8_STAGE(bufoff, gbase, voff) do { _Pragma("unroll") for (int _i = 0; _i < 2; ++_i) \
        __builtin_amdgcn_global_load_lds((const unsigned*)((const char*)(gbase) + (voff)[_i]), (PG8_LAS unsigned*)(lds + (bufoff) + ldsw + _i * 8192), 16, 0, 0); } while (0)
#define PG8_STAGE_A0(bufoff, gbase) PG8_STAGE(bufoff, gbase, voffA)
#define PG8_STAGE_A1(bufoff, gbase) do { if constexpr (GATHER) { PG8_STAGE(bufoff, gbase, voffA1); } else { PG8_STAGE(bufoff, (gbase) + hstepA, voffA); } } while (0)
#define PG8_LDA(dst, b, h) do { _Pragma("unroll") for (int m = 0; m < 4; ++m) _Pragma("unroll") for (int k = 0; k < 2; ++k) dst[m][k] = *(const PG8_LAS bf16x8*)(lds + PG8_SA(b, h) + aoff + m * 2048 + k * 1024); } while (0)
#define PG8_LDB(dst, b, h) do { _Pragma("unroll") for (int n = 0; n < 2; ++n) _Pragma("unroll") for (int k = 0; k < 2; ++k) dst[n][k] = *(const PG8_LAS bf16x8*)(lds + PG8_SB(b, h) + boff + n * 2048 + k * 1024); } while (0)
#define PG8_MMA(ai, bj, At, Bt) do { __builtin_amdgcn_s_setprio(1); _Pragma("unroll") for (int m = 0; m < 4; ++m) _Pragma("unroll") for (int n = 0; n < 2; ++n) _Pragma("unroll") for (int k = 0; k < 2; ++k) \
        acc[ai][bj][m][n] = __builtin_amdgcn_mfma_f32_16x16x32_bf16(Bt[n][k], At[m][k], acc[ai][bj][m][n], 0, 0, 0); __builtin_amdgcn_s_setprio(0); } while (0)
#define PG8_WAIT_V(n) asm volatile("s_waitcnt vmcnt(" #n ")" ::: "memory")
#define PG8_WAIT_L(n) asm volatile("s_waitcnt lgkmcnt(" #n ")" ::: "memory")
#define PG8_BAR __builtin_amdgcn_s_barrier()
#define PG8_SCHED __builtin_amdgcn_sched_barrier(0)
    Unit cur, nxt; int ui = 0;
    if (!S.next(0, cur)) return;
    if constexpr (GATHER) {
#pragma unroll
        for (int i = 0; i < 2; ++i) { voffA[i] = (unsigned)(S.a_row(cur, RA[i]) * g.lda + CA[i]) * 2u; voffA1[i] = (unsigned)(S.a_row(cur, HALF + RA[i]) * g.lda + CA[i]) * 2u; }
    }
    f32x4 acc[2][2][4][2];
#pragma unroll
    for (int a = 0; a < 2; ++a)
#pragma unroll
        for (int b = 0; b < 2; ++b)
#pragma unroll
            for (int m = 0; m < 4; ++m)
#pragma unroll
                for (int n = 0; n < 2; ++n) acc[a][b][m][n] = (f32x4){0.f, 0.f, 0.f, 0.f};
    bf16x8 At[4][2], B0[2][2], B1[2][2];
    const char* cA = S.a_base(g, cur); const char* cB = S.b_base(g, cur);
    PG8_STAGE(PG8_SB(0, 0), cB, voffB); PG8_STAGE(PG8_SB(0, 1), cB + hstepB, voffB); PG8_STAGE_A0(PG8_SA(0, 0), cA); PG8_STAGE_A1(PG8_SA(0, 1), cA);
    if (wr == 1) PG8_BAR;
    PG8_WAIT_V(2); PG8_BAR;
    PG8_STAGE(PG8_SB(1, 0), cB + kstep, voffB); PG8_STAGE_A0(PG8_SA(1, 0), cA + kstepA); PG8_STAGE(PG8_SB(1, 1), cB + hstepB + kstep, voffB);
    PG8_WAIT_V(6); PG8_BAR;
    for (;;) {
        const bool has_next = GATHER ? false : S.next(ui + 1, nxt);
        const char* nA = has_next ? S.a_base(g, nxt) : cA; const char* nB = has_next ? S.b_base(g, nxt) : cB;
#pragma unroll 1
        for (int t = 0; t < nt; t += 2) {
            const bool last = (t == nt - 2);
            const char* a1 = cA + (size_t)(t + 1) * kstepA;
            const char* a2 = last ? nA : cA + (size_t)(t + 2) * kstepA; const char* b2 = last ? nB : cB + (size_t)(t + 2) * kstep;
            const char* a3 = a2 + kstepA; const char* b3 = b2 + kstep;
            PG8_LDB(B0, 0, 0); PG8_LDB(B1, 0, 1); PG8_SCHED; PG8_LDA(At, 0, 0); PG8_STAGE_A1(PG8_SA(1, 1), a1);
            PG8_WAIT_V(8); PG8_WAIT_L(0); PG8_BAR; PG8_MMA(0, 0, At, B0); PG8_MMA(0, 1, At, B1); PG8_BAR; PG8_SCHED;
            PG8_LDA(At, 0, 1); PG8_STAGE(PG8_SB(0, 0), b2, voffB); PG8_STAGE(PG8_SB(0, 1), b2 + hstepB, voffB); PG8_STAGE_A0(PG8_SA(0, 0), a2);
            PG8_WAIT_V(8); PG8_WAIT_L(0); PG8_BAR; PG8_MMA(1, 0, At, B0); PG8_MMA(1, 1, At, B1); PG8_BAR; PG8_SCHED;
            PG8_LDB(B0, 1, 0); PG8_LDB(B1, 1, 1); PG8_SCHED; PG8_LDA(At, 1, 0); PG8_STAGE_A1(PG8_SA(0, 1), a2);
            PG8_WAIT_V(8); PG8_WAIT_L(0); PG8_BAR; PG8_MMA(0, 0, At, B0); PG8_MMA(0, 1, At, B1); PG8_BAR; PG8_SCHED;
            PG8_LDA(At, 1, 1); PG8_STAGE(PG8_SB(1, 0), b3, voffB); PG8_STAGE(PG8_SB(1, 1), b3 + hstepB, voffB); PG8_STAGE_A0(PG8_SA(1, 0), a3);
            PG8_WAIT_V(8); PG8_WAIT_L(0); PG8_BAR; PG8_MMA(1, 0, At, B0); PG8_MMA(1, 1, At, B1); PG8_BAR; PG8_SCHED;
        }
        if constexpr (ALIGN_EPI) { if (wr == 0) PG8_BAR; }
        E(acc, cur, wr, wc, fr, fq);
        if (!has_next) break;
#pragma unroll
        for (int a = 0; a < 2; ++a)
#pragma unroll
            for (int b = 0; b < 2; ++b)
#pragma unroll
                for (int m = 0; m < 4; ++m)
#pragma unroll
                    for (int n = 0; n < 2; ++n) acc[a][b][m][n] = (f32x4){0.f, 0.f, 0.f, 0.f};
        cur = nxt; cA = nA; cB = nB; ++ui;
        if constexpr (ALIGN_EPI) { if (wr == 1) PG8_BAR; }
    }
    PG8_WAIT_V(0);
    if constexpr (!ALIGN_EPI) { if (wr == 0) PG8_BAR; }
    PG8_BAR;
#undef PG8_SA
#undef PG8_SB
#undef PG8_STAGE
#undef PG8_STAGE_A0
#undef PG8_STAGE_A1
#undef PG8_LDA
#undef PG8_LDB
#undef PG8_MMA
#undef PG8_WAIT_V
#undef PG8_WAIT_L
#undef PG8_BAR
#undef PG8_SCHED
}
}
namespace fx {
using nv::u16; using nv::Bufs; using nv::Inputs;
using pg8::f32x4; using pg8::u32x4; using pg8::Unit;
#define LAS __attribute__((address_space(3)))
static_assert(nv::DM == 1024 && nv::NB == 8 && nv::S == 4096 && nv::MH == 256 && nv::PLE == 256, "fast phases are written for the full-size problem");
constexpr int NTOK = nv::NTOK, DM = 1024;
constexpr int INW_PAD = 6144;
constexpr int C_Z = 1280, C_XBC = 2304, C_BG = 3840, C_NG = 5888, C_DT = 5912, C_END = 5928;

struct WBufs { u16 *WinT, *WaT, *WbT, *WoutT, *PleGT, *PlePT, *WguT, *WdT, *PB; };
__host__ __device__ inline size_t carve_w(WBufs& W, unsigned char* ws, size_t off) {
  auto take = [&](size_t bytes) { unsigned char* r = ws + off; off += (bytes + 255) / 256 * 256; return r; };
  W.WinT = (u16*)take((size_t)INW_PAD * 1024 * 2); W.WaT = (u16*)take((size_t)1024 * 512 * 2); W.WbT = (u16*)take((size_t)1024 * 1024 * 2); W.WoutT = (u16*)take((size_t)1024 * 1024 * 2);
  W.PleGT = (u16*)take((size_t)1024 * 1024 * 2); W.PlePT = (u16*)take((size_t)1024 * 256 * 2); W.WguT = (u16*)take((size_t)32 * 512 * 1024 * 2); W.WdT = (u16*)take((size_t)32 * 1024 * 256 * 2);
  W.PB = (u16*)take((size_t)NTOK * 256 * 2);
  return off;
}

__device__ __forceinline__ int otid() { int t = threadIdx.x; asm volatile("" : "+v"(t)); return t; }
__device__ __forceinline__ int obid() { int b = blockIdx.x; asm volatile("" : "+s"(b)); return b; }
__device__ __forceinline__ float fsig(float x) { return __builtin_amdgcn_rcpf(1.0f + __expf(-x)); }
__device__ __forceinline__ float fsoftplus(float x) { const float e = __expf(x); return x > 20.f ? x : (e < 0.0625f ? e * (1.f - e * (0.5f - e * (0.33333333f - 0.25f * e))) : __logf(1.0f + e)); }
__device__ __forceinline__ unsigned pk2(float lo, float hi) { return pg8::cvt_pk_bf16(lo, hi); }
__device__ __forceinline__ void store8(u16* p, const float (&v)[8]) { u32x4 w; w.x = pk2(v[0], v[1]); w.y = pk2(v[2], v[3]); w.z = pk2(v[4], v[5]); w.w = pk2(v[6], v[7]); *(u32x4*)p = w; }
__device__ __forceinline__ void load8(const u16* p, float (&v)[8]) { const u32x4 w = *(const u32x4*)p;
  v[0] = __uint_as_float(w.x << 16); v[1] = __uint_as_float(w.x & 0xffff0000u); v[2] = __uint_as_float(w.y << 16); v[3] = __uint_as_float(w.y & 0xffff0000u);
  v[4] = __uint_as_float(w.z << 16); v[5] = __uint_as_float(w.z & 0xffff0000u); v[6] = __uint_as_float(w.w << 16); v[7] = __uint_as_float(w.w & 0xffff0000u); }

__device__ __forceinline__ float wave_sum(float v) {
#pragma unroll
  for (int o = 1; o < 64; o <<= 1) v += __shfl_xor(v, o);
  return v; }
__device__ __forceinline__ void rms_row_to_bf16(const float* xrow, const float* gain, u16* orow, int lane) {
  const f32x4* xr = (const f32x4*)xrow + lane; const f32x4* gr = (const f32x4*)gain + lane;
  f32x4 v[4]; float s = 0.f;
#pragma unroll
  for (int j = 0; j < 4; ++j) { v[j] = xr[64 * j]; s += (v[j].x * v[j].x + v[j].y * v[j].y) + (v[j].z * v[j].z + v[j].w * v[j].w); }
  const float rs = 1.0f / sqrtf(wave_sum(s) * (1.f / 1024.f) + nv::EPS);
  unsigned long long* o8 = (unsigned long long*)orow + lane;
#pragma unroll
  for (int j = 0; j < 4; ++j) { const f32x4 g = gr[64 * j]; o8[64 * j] = (unsigned long long)pk2(v[j].x * rs * g.x, v[j].y * rs * g.y) | ((unsigned long long)pk2(v[j].z * rs * g.z, v[j].w * rs * g.w) << 32); }
}
__device__ __forceinline__ void phase_rms_rows(const float* x, const float* gain, u16* out) {
  const int tid = otid(), lane = tid & 63, gw = obid() * 8 + (tid >> 6), ngw = gridDim.x * 8;
  for (int r = gw; r < NTOK; r += 4 * ngw) { f32x4 v[4][4]; float s[4];
#pragma unroll
    for (int q = 0; q < 4; ++q) { const int rq = (r + q * ngw < NTOK) ? r + q * ngw : r; const f32x4* xr = (const f32x4*)(x + (size_t)rq * 1024) + lane;
#pragma unroll
      for (int j = 0; j < 4; ++j) v[q][j] = xr[64 * j]; }
#pragma unroll
    for (int q = 0; q < 4; ++q) { s[q] = 0.f;
#pragma unroll
      for (int j = 0; j < 4; ++j) s[q] += (v[q][j].x * v[q][j].x + v[q][j].y * v[q][j].y) + (v[q][j].z * v[q][j].z + v[q][j].w * v[q][j].w);
      s[q] = 1.0f / sqrtf(wave_sum(s[q]) * (1.f / 1024.f) + nv::EPS); }
#pragma unroll
    for (int q = 0; q < 4; ++q) { if (r + q * ngw >= NTOK) break; unsigned long long* o8 = (unsigned long long*)(out + (size_t)(r + q * ngw) * 1024) + lane; const f32x4* gr = (const f32x4*)gain + lane;
#pragma unroll
      for (int j = 0; j < 4; ++j) { const f32x4 g = gr[64 * j]; o8[64 * j] = (unsigned long long)pk2(v[q][j].x * s[q] * g.x, v[q][j].y * s[q] * g.y) | ((unsigned long long)pk2(v[q][j].z * s[q] * g.z, v[q][j].w * s[q] * g.w) << 32); } } }
}
template <class CP> __device__ __forceinline__ void transpose_item(LAS float* scr, const CP cp, u16* dst, int K, int n0, int k0, int lane) {
  { const float* p = cp(n0 + (lane & 31));
#pragma unroll 8
    for (int i = 0; i < 32; ++i) { const int kk = 2 * i + (lane >> 5); scr[kk * 33 + (lane & 31)] = p ? p[(size_t)(k0 + kk) * cp.ld] : 0.f; } }
  asm volatile("s_waitcnt lgkmcnt(0)" ::: "memory");
  const int c = lane & 7;
#pragma unroll
  for (int j = 0; j < 4; ++j) { const int n = (lane >> 3) + 8 * j; const LAS float* s = scr + (8 * c) * 33 + n;
    u32x4 o; o.x = pk2(s[0 * 33], s[1 * 33]); o.y = pk2(s[2 * 33], s[3 * 33]); o.z = pk2(s[4 * 33], s[5 * 33]); o.w = pk2(s[6 * 33], s[7 * 33]);
    *(u32x4*)(dst + (size_t)(n0 + n) * K + k0 + 8 * c) = o; }
  asm volatile("s_waitcnt lgkmcnt(0)" ::: "memory");
}
struct CpIdent { const float* src; int ld; __device__ const float* operator()(int n) const { return src + n; } };
struct CpInProj { const float* src; int ld; __device__ const float* operator()(int n) const {
  int c; if (n < C_Z) c = n; else if (n < C_XBC) c = nv::O_Z + (n - C_Z); else if (n < C_BG) c = nv::O_XBC + (n - C_XBC); else if (n < C_NG) c = nv::O_BG + (n - C_BG); else if (n < C_DT) c = nv::O_NG + (n - C_NG); else if (n < C_END) c = nv::O_DT + (n - C_DT); else return nullptr;
  return src + c; } };
struct CpGU { const float* gate; long updelta; int ld; __device__ const float* operator()(int n) const { const int tile = n >> 8, r = n & 255; return gate + (r < 128 ? 0L : updelta) + tile * 128 + (r & 127); } };

struct WJob { const float* src; int ld; u16* dst; int K, n0, k0; };
__device__ __forceinline__ WJob wjob_decode(int t, const Inputs& I, const WBufs& W, int lane) {
  constexpr int T_IN = (INW_PAD / 32) * 16, T_A = 32 * 8, T_B = 32 * 16, T_O = 32 * 16, T_PG = 32 * 16, T_PP = 32 * 4, T_GU = 32 * 16 * 16;
  WJob j; int r = t; const int c = lane & 31;
  if (r < T_IN) { CpInProj cp{I.w_in, nv::INW}; j.n0 = (r / 16) * 32; j.k0 = (r % 16) * 64; j.src = cp(j.n0 + c); j.ld = nv::INW; j.dst = W.WinT; j.K = 1024; return j; } r -= T_IN;
  if (r < T_A) { j.n0 = (r / 8) * 32; j.k0 = (r % 8) * 64; j.src = I.w_a + j.n0 + c; j.ld = 1024; j.dst = W.WaT; j.K = 512; return j; } r -= T_A;
  if (r < T_B) { j.n0 = (r / 16) * 32; j.k0 = (r % 16) * 64; j.src = I.w_b + j.n0 + c; j.ld = 1024; j.dst = W.WbT; j.K = 1024; return j; } r -= T_B;
  if (r < T_O) { j.n0 = (r / 16) * 32; j.k0 = (r % 16) * 64; j.src = I.w_out + j.n0 + c; j.ld = 1024; j.dst = W.WoutT; j.K = 1024; return j; } r -= T_O;
  if (r < T_PG) { j.n0 = (r / 16) * 32; j.k0 = (r % 16) * 64; j.src = I.ple_wg + j.n0 + c; j.ld = 1024; j.dst = W.PleGT; j.K = 1024; return j; } r -= T_PG;
  if (r < T_PP) { j.n0 = (r / 4) * 32; j.k0 = (r % 4) * 64; j.src = I.ple_wp + j.n0 + c; j.ld = 1024; j.dst = W.PlePT; j.K = 256; return j; } r -= T_PP;
  if (r < T_GU) { const int e = r / 256, q = r % 256; CpGU cp{I.w_gate + (size_t)e * 1024 * 256, (long)(I.w_up - I.w_gate), 256}; j.n0 = (q / 16) * 32; j.k0 = (q % 16) * 64; j.src = cp(j.n0 + c); j.ld = 256; j.dst = W.WguT + (size_t)e * 512 * 1024; j.K = 1024; return j; } r -= T_GU;
  { const int e = r / 128, q = r % 128; j.n0 = (q / 4) * 32; j.k0 = (q % 4) * 64; j.src = I.w_down + (size_t)e * 256 * 1024 + j.n0 + c; j.ld = 1024; j.dst = W.WdT + (size_t)e * 1024 * 256; j.K = 256; return j; }
}
__device__ __forceinline__ void phase_prologue(LAS unsigned char* lds, const Inputs& I, const Bufs& B, const WBufs& W) {
  const int tid = otid(), lane = tid & 63, wv = tid >> 6, gw = obid() * 8 + wv, ngw = gridDim.x * 8;
  LAS float* scr = (LAS float*)lds + wv * (64 * 33);
  constexpr int TOT = (INW_PAD / 32) * 16 + 32 * 8 + 32 * 16 * 3 + 32 * 4 + 32 * 16 * 16 + 32 * 32 * 4;
  float cur[32];
  int t = gw; WJob jb;
  if (t < TOT) { jb = wjob_decode(t, I, W, lane);
#pragma unroll
    for (int i = 0; i < 32; ++i) cur[i] = jb.src ? jb.src[(size_t)(jb.k0 + 2 * i + (lane >> 5)) * jb.ld] : 0.f; }
  while (t < TOT) { const int tn = t + ngw; WJob jn = jb; float nxt[32];
    if (tn < TOT) { jn = wjob_decode(tn, I, W, lane);
#pragma unroll
      for (int i = 0; i < 32; ++i) nxt[i] = jn.src ? jn.src[(size_t)(jn.k0 + 2 * i + (lane >> 5)) * jn.ld] : 0.f; }
#pragma unroll
    for (int i = 0; i < 32; ++i) scr[(2 * i + (lane >> 5)) * 33 + (lane & 31)] = cur[i];
    asm volatile("s_waitcnt lgkmcnt(0)" ::: "memory");
    { const int c = lane & 7;
#pragma unroll
      for (int j = 0; j < 4; ++j) { const int n = (lane >> 3) + 8 * j; const LAS float* s = scr + (8 * c) * 33 + n;
        u32x4 o; o.x = pk2(s[0 * 33], s[1 * 33]); o.y = pk2(s[2 * 33], s[3 * 33]); o.z = pk2(s[4 * 33], s[5 * 33]); o.w = pk2(s[6 * 33], s[7 * 33]);
        *(u32x4*)(jb.dst + (size_t)(jb.n0 + n) * jb.K + jb.k0 + 8 * c) = o; } }
    asm volatile("s_waitcnt lgkmcnt(0)" ::: "memory");
    if (tn < TOT) {
#pragma unroll
      for (int i = 0; i < 32; ++i) cur[i] = nxt[i]; }
    jb = jn; t = tn; }
}
__device__ __forceinline__ void prologue_pb(const Inputs& I, const WBufs& W) {
  for (long i = blockIdx.x * 512L + otid(); i < (long)NTOK * 256 / 8; i += (long)gridDim.x * 512L) { const f32x4 a = ((const f32x4*)I.p)[2 * i], b = ((const f32x4*)I.p)[2 * i + 1];
    u32x4 o; o.x = pk2(a.x, a.y); o.y = pk2(a.z, a.w); o.z = pk2(b.x, b.y); o.w = pk2(b.z, b.w); ((u32x4*)W.PB)[i] = o; }
}

template <class F> struct Epi8 { static constexpr bool PERM = true; F f;
  __device__ __forceinline__ void operator()(const f32x4 (&acc)[2][2][4][2], const Unit& u, int wr, int wc, int fr, int fq) const {
#pragma unroll
    for (int ai = 0; ai < 2; ++ai)
#pragma unroll
      for (int m = 0; m < 4; ++m) { const int row = u.pm * 256 + ai * 128 + wr * 64 + m * 16 + fr;
#pragma unroll
        for (int bj = 0; bj < 2; ++bj) { const int col = u.pn * 256 + bj * 128 + wc * 32 + 8 * fq; const f32x4 a = acc[ai][bj][m][0], b = acc[ai][bj][m][1];
          const float v[8] = {a.x, a.y, a.z, a.w, b.x, b.y, b.z, b.w}; f(u, row, col, v); }
        if (m & 1) asm volatile("" ::: "memory"); } } };

struct FInProj { u16* QKV; u16* Z; u16* XBC; u16* BG; float* NG; float* DT; const float* dt_bias;
  __device__ __forceinline__ void operator()(const Unit&, int r, int c, const float (&v)[8]) const {
    if (c < C_Z) store8(QKV + (size_t)r * 1280 + c, v);
    else if (c < C_XBC) store8(Z + (size_t)r * 1024 + (c - C_Z), v);
    else if (c < C_BG) store8(XBC + (size_t)r * 1536 + (c - C_XBC), v);
    else if (c < C_NG) { float s[8];
#pragma unroll
      for (int i = 0; i < 8; ++i) s[i] = fsig(v[i]);
      store8(BG + (size_t)r * 2048 + (c - C_BG), s); }
    else if (c < C_DT) { float* o = NG + (size_t)r * 24 + (c - C_NG);
#pragma unroll
      for (int i = 0; i < 8; ++i) o[i] = fsig(v[i]); }
    else if (c < C_END) { float* o = DT + (size_t)r * 16 + (c - C_DT); const float* bi = dt_bias + (c - C_DT);
#pragma unroll
      for (int i = 0; i < 8; ++i) o[i] = fsoftplus(v[i] + bi[i]); } } };
struct FStoreBf { u16* o; int ld; __device__ __forceinline__ void operator()(const Unit&, int r, int c, const float (&v)[8]) const { store8(o + (size_t)r * ld + c, v); } };
struct FMerge { const u16* t1; const u16* bg; u16* o;
  __device__ __forceinline__ void operator()(const Unit&, int r, int c, const float (&v)[8]) const { float t[8], ga[8], gb[8], m[8]; load8(t1 + (size_t)r * 1024 + c, t); load8(bg + (size_t)r * 2048 + c, ga); load8(bg + (size_t)r * 2048 + 1024 + c, gb);
#pragma unroll
    for (int i = 0; i < 8; ++i) m[i] = ga[i] * t[i] + gb[i] * v[i];
    store8(o + (size_t)r * 1024 + c, m); } };
struct FResid { const float* x; float* o;
  __device__ __forceinline__ void operator()(const Unit&, int r, int c, const float (&v)[8]) const { const f32x4 a = *(const f32x4*)(x + (size_t)r * 1024 + c), b = *(const f32x4*)(x + (size_t)r * 1024 + c + 4);
    *(f32x4*)(o + (size_t)r * 1024 + c) = (f32x4){a.x + v[0], a.y + v[1], a.z + v[2], a.w + v[3]}; *(f32x4*)(o + (size_t)r * 1024 + c + 4) = (f32x4){b.x + v[4], b.y + v[5], b.z + v[6], b.w + v[7]}; } };
struct FPle { float* x; const u16* pp;
  __device__ __forceinline__ void operator()(const Unit&, int r, int c, const float (&v)[8]) const { float p[8]; load8(pp + (size_t)r * 1024 + c, p); float* xp = x + (size_t)r * 1024 + c; const f32x4 a = *(const f32x4*)xp, b = *(const f32x4*)(xp + 4);
    *(f32x4*)xp = (f32x4){a.x + fsig(v[0]) * p[0], a.y + fsig(v[1]) * p[1], a.z + fsig(v[2]) * p[2], a.w + fsig(v[3]) * p[3]};
    *(f32x4*)(xp + 4) = (f32x4){b.x + fsig(v[4]) * p[4], b.y + fsig(v[5]) * p[5], b.z + fsig(v[6]) * p[6], b.w + fsig(v[7]) * p[7]}; } };

struct EpiResidNorm { static constexpr bool PERM = true; const float* x; float* o; const float* gain; u16* h; float* ssq;
  __device__ __forceinline__ void operator()(const f32x4 (&acc)[2][2][4][2], const Unit& u, int wr, int wc, int fr, int fq) const {
#pragma unroll
    for (int ai = 0; ai < 2; ++ai)
#pragma unroll
      for (int m = 0; m < 4; ++m) { const int row = u.pm * 256 + ai * 128 + wr * 64 + m * 16 + fr; float part = 0.f;
#pragma unroll
        for (int bj = 0; bj < 2; ++bj) { const int c = u.pn * 256 + bj * 128 + wc * 32 + 8 * fq; const f32x4 a = acc[ai][bj][m][0], b = acc[ai][bj][m][1];
          const f32x4 xa = *(const f32x4*)(x + (size_t)row * 1024 + c), xb = *(const f32x4*)(x + (size_t)row * 1024 + c + 4); const f32x4 ga = *(const f32x4*)(gain + c), gb = *(const f32x4*)(gain + c + 4);
          const f32x4 va = {xa.x + a.x, xa.y + a.y, xa.z + a.z, xa.w + a.w}, vb = {xb.x + b.x, xb.y + b.y, xb.z + b.z, xb.w + b.w};
          *(f32x4*)(o + (size_t)row * 1024 + c) = va; *(f32x4*)(o + (size_t)row * 1024 + c + 4) = vb;
          part += (va.x * va.x + va.y * va.y) + (va.z * va.z + va.w * va.w) + (vb.x * vb.x + vb.y * vb.y) + (vb.z * vb.z + vb.w * vb.w);
          const float hv[8] = {va.x * ga.x, va.y * ga.y, va.z * ga.z, va.w * ga.w, vb.x * gb.x, vb.y * gb.y, vb.z * gb.z, vb.w * gb.w}; store8(h + (size_t)row * 1024 + c, hv); }
        part += __shfl_xor(part, 16); part += __shfl_xor(part, 32);
        if (fq == 0) atomicAdd(ssq + row, part);
        if (m & 1) asm volatile("" ::: "memory"); } } };
template <class F, bool ALIGN = true> __device__ __forceinline__ void dense_gemm(LAS unsigned char* lds, const u16* A, int lda, const u16* Bt, int ldb, int M, int N, int K, const F& f) {
  pg8::Gemm g{A, Bt, M, N, K, lda, ldb, 128}; pg8::StaticOrder S; S.init(M, N, (int)gridDim.x, (int)blockIdx.x); Epi8<F> E{f};
  pg8::gemm_phase<Epi8<F>, pg8::StaticOrder, ALIGN, false>(lds, g, S, E);
}
}
namespace fx {
constexpr int LIST_CAP = 32768;
constexpr int LDS_TAB = 131072;
struct MoeBufs { float* LOGITS; int* CNT; int* LIST; int* ASG; u16* MOEOUT; u16* WrT; float* SSQ; };
__host__ __device__ inline size_t carve_moe(MoeBufs& M, const Bufs& B, unsigned char* ws, size_t off) {
  auto take = [&](size_t bytes) { unsigned char* r = ws + off; off += (bytes + 255) / 256 * 256; return r; };
  M.LOGITS = (float*)take((size_t)NTOK * 64 * 4); M.CNT = (int*)take(32 * 256); M.LIST = (int*)take((size_t)32 * LIST_CAP * 4); M.WrT = (u16*)take((size_t)256 * 1024 * 2); M.ASG = (int*)take((size_t)NTOK * 2 * 4); M.SSQ = (float*)take((size_t)NTOK * 4);
  M.MOEOUT = B.QKV;
  return off;
}
__device__ __forceinline__ void prologue_moe(const Inputs& I, const MoeBufs& M) {
  for (long i = blockIdx.x * 512L + otid(); i < 256L * 1024; i += (long)gridDim.x * 512L) { const int n = (int)(i >> 10), k = (int)(i & 1023);
    float v = 0.f; if (n < 4) v = I.w_group[k * 4 + n]; else if (n < 36) v = I.w_expert[k * 32 + (n - 4)];
    M.WrT[i] = nv::f2bf(v); }
  if (blockIdx.x == 0 && threadIdx.x < 32) M.CNT[threadIdx.x * 64] = 0;
  for (int i = blockIdx.x * 512 + otid(); i < NTOK; i += gridDim.x * 512) M.SSQ[i] = 0.f;
}
struct FLogits { float* o; __device__ __forceinline__ void operator()(const Unit&, int r, int c, const float (&v)[8]) const { if (c < 40) { *(f32x4*)(o + (size_t)r * 64 + c) = (f32x4){v[0], v[1], v[2], v[3]}; *(f32x4*)(o + (size_t)r * 64 + c + 4) = (f32x4){v[4], v[5], v[6], v[7]}; } } };
__device__ __forceinline__ void phase_route(LAS unsigned char* lds, const Inputs& I, const Bufs& B, const MoeBufs& M) {
  LAS int* lcnt = (LAS int*)lds; LAS int* lbase = lcnt + 32; const int tid = otid();
  for (int blk = blockIdx.x; blk < NTOK / 128; blk += gridDim.x) {
    if (tid < 32) lcnt[tid] = 0;
    __syncthreads();
    int e0 = 0, e1 = 0, r0 = 0, r1 = 0; float w0 = 0.f, w1 = 0.f; const int tok = blk * 128 + tid;
    if (tid < 128) { const float* lg = M.LOGITS + (size_t)tok * 64;
      const float rsd = 1.0f;
      const f32x4 g4 = *(const f32x4*)lg; const float g0 = rsd * g4.x + I.b_group[0], g1 = rsd * g4.y + I.b_group[1], g2 = rsd * g4.z + I.b_group[2], g3 = rsd * g4.w + I.b_group[3];
      int gi = 0; float gm = g0; if (g1 > gm) { gm = g1; gi = 1; } if (g2 > gm) { gm = g2; gi = 2; } if (g3 > gm) { gm = g3; gi = 3; }
      const float grp_w = 1.0f / (expf(g0 - gm) + expf(g1 - gm) + expf(g2 - gm) + expf(g3 - gm));
      const f32x4 ea = *(const f32x4*)(lg + 4 + gi * 8), eb = *(const f32x4*)(lg + 8 + gi * 8); const f32x4 ba = *(const f32x4*)(I.b_expert + gi * 8), bb = *(const f32x4*)(I.b_expert + gi * 8 + 4);
      const float el[8] = {rsd * ea.x + ba.x, rsd * ea.y + ba.y, rsd * ea.z + ba.z, rsd * ea.w + ba.w, rsd * eb.x + bb.x, rsd * eb.y + bb.y, rsd * eb.z + bb.z, rsd * eb.w + bb.w};
      int i0 = 0; float m0 = el[0];
#pragma unroll
      for (int j = 1; j < 8; ++j) if (el[j] > m0) { m0 = el[j]; i0 = j; }
      int i1 = -1; float m1 = -3.0e38f;
#pragma unroll
      for (int j = 0; j < 8; ++j) if (j != i0 && el[j] > m1) { m1 = el[j]; i1 = j; }
      const float r = expf(m1 - m0); w0 = grp_w / (1.0f + r); w1 = grp_w * r / (1.0f + r);
      e0 = gi * 8 + i0; e1 = gi * 8 + i1;
      r0 = __hip_atomic_fetch_add(lcnt + e0, 1, __ATOMIC_RELAXED, __HIP_MEMORY_SCOPE_WORKGROUP); r1 = __hip_atomic_fetch_add(lcnt + e1, 1, __ATOMIC_RELAXED, __HIP_MEMORY_SCOPE_WORKGROUP); }
    __syncthreads();
    if (tid < 32) { const int n = lcnt[tid]; lbase[tid] = n > 0 ? atomicAdd(&M.CNT[tid * 64], n) : 0; }
    __syncthreads();
    if (tid < 128) { const int p0 = lbase[e0] + r0, p1 = lbase[e1] + r1;
      M.LIST[e0 * LIST_CAP + p0] = tok * 2; M.LIST[e1 * LIST_CAP + p1] = tok * 2 + 1; M.ASG[tok * 2] = (e0 << 16) | p0; M.ASG[tok * 2 + 1] = (e1 << 16) | p1; B.EW[tok * 2] = w0; B.EW[tok * 2 + 1] = w1; }
    __syncthreads(); }
}
__device__ __forceinline__ void build_tile_table(LAS unsigned char* lds, const MoeBufs& M) {
  LAS int* tab = (LAS int*)(lds + LDS_TAB);
  if (threadIdx.x == 0) { int acc = 0; for (int e = 0; e < 32; ++e) { tab[e] = acc; acc += (M.CNT[e * 64] + 255) >> 8; } tab[32] = acc; }
  __syncthreads();
}
__device__ __forceinline__ int tile_expert(const LAS int* tab, int tile) { int e = 0;
#pragma unroll 1
  for (int j = 1; j < 32; ++j) if (tab[j] <= tile) e = j;
  return e; }

struct SchedGU { const int* list; int tile, ct, lbase, nvalid, e;
  __device__ bool next(int i, Unit& u) const { if (i > 0) return false; u.pm = tile; u.pn = ct; u.aux0 = lbase; u.aux1 = nvalid; return true; }
  __device__ __forceinline__ const char* a_base(const pg8::Gemm& g, const Unit&) const { return (const char*)g.A; }
  __device__ __forceinline__ const char* b_base(const pg8::Gemm& g, const Unit&) const { return (const char*)g.Bt + ((size_t)e * 512 + (size_t)ct * 256) * 1024 * 2; }
  __device__ __forceinline__ int a_row(const Unit&, int r) const { return r < nvalid ? (list[lbase + r] >> 1) : 0; } };
struct EpiGU { static constexpr bool PERM = true; u16* act; const int* list; const float* ssq;
  __device__ __forceinline__ void operator()(const f32x4 (&acc)[2][2][4][2], const Unit& u, int wr, int wc, int fr, int fq) const {
#pragma unroll
    for (int ai = 0; ai < 2; ++ai)
#pragma unroll
      for (int m = 0; m < 4; ++m) { const int r = ai * 128 + wr * 64 + m * 16 + fr; const float rs = 1.0f;
        const f32x4 g0 = acc[ai][0][m][0] * rs, g1 = acc[ai][0][m][1] * rs, u0 = acc[ai][1][m][0] * rs, u1 = acc[ai][1][m][1] * rs;
        const float a[8] = {g0.x * fsig(g0.x) * u0.x, g0.y * fsig(g0.y) * u0.y, g0.z * fsig(g0.z) * u0.z, g0.w * fsig(g0.w) * u0.w, g1.x * fsig(g1.x) * u1.x, g1.y * fsig(g1.y) * u1.y, g1.z * fsig(g1.z) * u1.z, g1.w * fsig(g1.w) * u1.w};
        store8(act + ((size_t)u.pm * 256 + r) * 256 + u.pn * 128 + wc * 32 + 8 * fq, a);
        if (m & 1) asm volatile("" ::: "memory"); } } };
__device__ __forceinline__ void phase_moe_gu(LAS unsigned char* lds, const Bufs& B, const WBufs& W, const MoeBufs& M) {
  const LAS int* tab = (const LAS int*)(lds + LDS_TAB); const int T = tab[32];
  for (int L = blockIdx.x; L < T * 2; L += gridDim.x) { const int tile = L >> 1, ct = L & 1, e = __builtin_amdgcn_readfirstlane(tile_expert(tab, tile)), rt = tile - __builtin_amdgcn_readfirstlane(tab[e]); int nvalid = __builtin_amdgcn_readfirstlane(M.CNT[e * 64]) - rt * 256; nvalid = nvalid > 256 ? 256 : nvalid;
    pg8::Gemm g{B.H2, W.WguT, 256, 256, 1024, 1024, 1024, 128}; SchedGU S{M.LIST, tile, ct, e * LIST_CAP + rt * 256, nvalid, e}; EpiGU E{B.ACT, M.LIST, M.SSQ};
    pg8::gemm_phase<EpiGU, SchedGU, true, true>(lds, g, S, E); }
}
struct SchedD { const LAS int* tab; int T4, G, c;
  __device__ bool next(int i, Unit& u) const { const int L = i * G + c; if (L >= T4) return false; const int tile = L >> 2; u.pm = tile; u.pn = L & 3; u.aux0 = __builtin_amdgcn_readfirstlane(tile_expert(tab, tile)); u.aux1 = 0; return true; }
  __device__ __forceinline__ const char* a_base(const pg8::Gemm& g, const Unit& u) const { return (const char*)g.A + (size_t)u.pm * 256 * 256 * 2; }
  __device__ __forceinline__ const char* b_base(const pg8::Gemm& g, const Unit& u) const { return (const char*)g.Bt + ((size_t)u.aux0 * 1024 + (size_t)u.pn * 256) * 256 * 2; }
  __device__ __forceinline__ int a_row(const Unit&, int) const { return 0; } };
__device__ __forceinline__ void phase_moe_down(LAS unsigned char* lds, const Bufs& B, const WBufs& W, const MoeBufs& M) {
  const LAS int* tab = (const LAS int*)(lds + LDS_TAB);
  pg8::Gemm g{B.ACT, W.WdT, 256, 1024, 256, 256, 256, 128}; SchedD S{tab, tab[32] * 4, (int)gridDim.x, (int)blockIdx.x}; Epi8<FStoreBf> E{FStoreBf{M.MOEOUT, 1024}};
  pg8::gemm_phase<Epi8<FStoreBf>, SchedD, true, false>(lds, g, S, E);
}
__device__ __forceinline__ void phase_moe_combine(LAS unsigned char* lds, float* out, const MoeBufs& M, const float* ew, const float* gain, u16* hout) {
  const LAS int* tab = (const LAS int*)(lds + LDS_TAB);
  const int tid = otid(), lane = tid & 63, gw = obid() * 8 + (tid >> 6), ngw = gridDim.x * 8;
  for (int tk = gw; tk < NTOK; tk += 2 * ngw) { f32x4 v[2][4]; float rs[2];
    pg8::u32x2 a[2][4], b[2][4]; float w0[2], w1[2];
#pragma unroll
    for (int q = 0; q < 2; ++q) { const int tok = (tk + q * ngw < NTOK) ? tk + q * ngw : tk; const int a0 = M.ASG[tok * 2], a1 = M.ASG[tok * 2 + 1]; w0[q] = ew[tok * 2]; w1[q] = ew[tok * 2 + 1];
      const int s0 = (tab[a0 >> 16] + ((a0 & 0xffff) >> 8)) * 256 + (a0 & 255), s1 = (tab[a1 >> 16] + ((a1 & 0xffff) >> 8)) * 256 + (a1 & 255);
      const f32x4* xr = (const f32x4*)(out + (size_t)tok * 1024) + lane; const pg8::u32x2* o0 = (const pg8::u32x2*)(M.MOEOUT + (size_t)s0 * 1024) + lane; const pg8::u32x2* o1 = (const pg8::u32x2*)(M.MOEOUT + (size_t)s1 * 1024) + lane;
#pragma unroll
      for (int j = 0; j < 4; ++j) { v[q][j] = xr[64 * j]; a[q][j] = o0[64 * j]; b[q][j] = o1[64 * j]; } }
#pragma unroll
    for (int q = 0; q < 2; ++q) { float s = 0.f;
#pragma unroll
      for (int j = 0; j < 4; ++j) { f32x4& x = v[q][j];
        x.x += w0[q] * __uint_as_float(a[q][j].x << 16) + w1[q] * __uint_as_float(b[q][j].x << 16); x.y += w0[q] * __uint_as_float(a[q][j].x & 0xffff0000u) + w1[q] * __uint_as_float(b[q][j].x & 0xffff0000u);
        x.z += w0[q] * __uint_as_float(a[q][j].y << 16) + w1[q] * __uint_as_float(b[q][j].y << 16); x.w += w0[q] * __uint_as_float(a[q][j].y & 0xffff0000u) + w1[q] * __uint_as_float(b[q][j].y & 0xffff0000u);
        s += (x.x * x.x + x.y * x.y) + (x.z * x.z + x.w * x.w); }
      rs[q] = 1.0f / sqrtf(wave_sum(s) * (1.f / 1024.f) + nv::EPS); }
#pragma unroll
    for (int q = 0; q < 2; ++q) { if (tk + q * ngw >= NTOK) break; const int tok = tk + q * ngw; f32x4* xr = (f32x4*)(out + (size_t)tok * 1024) + lane; const f32x4* gr = (const f32x4*)gain + lane;
      unsigned long long* o8 = (unsigned long long*)(hout + (size_t)tok * 1024) + lane;
#pragma unroll
      for (int j = 0; j < 4; ++j) { const f32x4 g = gr[64 * j]; const f32x4 x = v[q][j]; xr[64 * j] = x; o8[64 * j] = (unsigned long long)pk2(x.x * rs[q] * g.x, x.y * rs[q] * g.y) | ((unsigned long long)pk2(x.z * rs[q] * g.z, x.w * rs[q] * g.w) << 32); } } }
}
}
namespace fa {
using nv::u16; using nv::Bufs;
typedef short bf16x8 __attribute__((ext_vector_type(8)));
typedef short s16x4 __attribute__((ext_vector_type(4)));
typedef float f32x16 __attribute__((ext_vector_type(16)));
typedef unsigned u32x4 __attribute__((ext_vector_type(4)));
constexpr float C2 = 0.125f * 1.4426950408889634f;
constexpr int S = nv::S, QKVW = 1280;
constexpr int IMP_LD = 65, IMP_HEAD = 64 * IMP_LD;
constexpr int L_K = 0, L_V = 32768, L_WSF = 65536, L_IMP = 67584, L_MASK = L_IMP + 4 * IMP_HEAD * 4 + 64  , L_OST = L_IMP  , L_END = L_MASK + 512;
static_assert(L_END <= 147456, "attention LDS map");

__device__ __forceinline__ int crow(int r, int hi) { return (r & 3) + 8 * (r >> 2) + 4 * hi; }
__device__ __forceinline__ float ex2(float x) { return __builtin_amdgcn_exp2f(x); }
__device__ __forceinline__ float max3f(float a, float b, float c) { float r; asm("v_max3_f32 %0, %1, %2, %3" : "=v"(r) : "v"(a), "v"(b), "v"(c)); return r; }
__device__ __forceinline__ float max2f(float a, float b) { float r; asm("v_max_f32_e32 %0, %1, %2" : "=v"(r) : "v"(a), "v"(b)); return r; }
__device__ __forceinline__ float swap_add(float v) { auto rr = __builtin_amdgcn_permlane32_swap(__float_as_uint(v), __float_as_uint(v), false, false); return __uint_as_float(rr[0]) + __uint_as_float(rr[1]); }
__device__ __forceinline__ float swap_max(float v) { auto rr = __builtin_amdgcn_permlane32_swap(__float_as_uint(v), __float_as_uint(v), false, false); return __builtin_fmaxf(__uint_as_float(rr[0]), __uint_as_float(rr[1])); }

__device__ __forceinline__ void phase_qknorm(const nv::Inputs& I, const Bufs& B) {
  const int nwg = (int)gridDim.x > 64 ? (int)gridDim.x - 64 : (int)gridDim.x;
  if ((int)blockIdx.x >= nwg) return;
  for (int it = blockIdx.x * 512 + fx::otid(); it < nv::NTOK * 4; it += nwg * 512) { const int tok = it >> 2, w = it & 3; u16* v; const float* gain;
    if (w < 2) { v = B.QKV + (size_t)tok * QKVW + nv::O_KS + w * 64; gain = I.ks_gain; } else { v = B.QKV + (size_t)tok * QKVW + nv::O_KW + (w - 2) * 64; gain = I.kw_gain; }
    float x[8][8]; float s = 0.f;
#pragma unroll
    for (int c = 0; c < 8; ++c) { fx::load8(v + c * 8, x[c]);
#pragma unroll
      for (int j = 0; j < 8; ++j) s += x[c][j] * x[c][j]; }
    const float rs = 1.0f / sqrtf(s * (1.f / 64.f) + nv::EPS);
#pragma unroll
    for (int c = 0; c < 8; ++c) { float y[8];
#pragma unroll
      for (int j = 0; j < 8; ++j) y[j] = x[c][j] * rs * gain[c * 8 + j];
      fx::store8(v + c * 8, y); } }
}

__device__ __forceinline__ void stage_kv(LAS unsigned char* lds, int slot, const u16* kbase, const u16* vbase, int stride, int wid, int lane, bool withV) {
  { const int row = 8 * wid + (lane >> 3), ch = lane & 7; const u16* ksrc = kbase + (size_t)row * stride + ((ch ^ (row & 7)) * 8);
    __builtin_amdgcn_global_load_lds((const unsigned*)ksrc, (LAS unsigned*)(lds + L_K + slot * 8192 + wid * 1024), 16, 0, 0); }
  if (withV) { const u16* vsrc = vbase + (size_t)(16 * (wid & 3) + (lane >> 2)) * stride + (wid >> 2) * 32 + (lane & 3) * 8;
    __builtin_amdgcn_global_load_lds((const unsigned*)vsrc, (LAS unsigned*)(lds + L_V + slot * 8192 + wid * 1024), 16, 0, 0); }
}
__device__ __forceinline__ void qkt(f32x16& p0, f32x16& p1, const LAS unsigned char* Kslot, const bf16x8 (&qr)[4], int r32, int hi, float bias = 0.f) {
  const LAS unsigned char* kb = Kslot + r32 * 128; const int sw = r32 & 7;
  bf16x8 kf[8];
#pragma unroll
  for (int d0 = 0; d0 < 4; ++d0) { const int o = ((2 * d0 + hi) ^ sw) << 4; kf[2 * d0] = *(const LAS bf16x8*)(kb + o); kf[2 * d0 + 1] = *(const LAS bf16x8*)(kb + 4096 + o); }
  f32x16 z;
#pragma unroll
  for (int r = 0; r < 16; ++r) z[r] = bias;
  asm volatile("s_waitcnt lgkmcnt(0)" ::: "memory"); __builtin_amdgcn_sched_barrier(0);
  p0 = __builtin_amdgcn_mfma_f32_32x32x16_bf16(kf[0], qr[0], z, 0, 0, 0); p1 = __builtin_amdgcn_mfma_f32_32x32x16_bf16(kf[1], qr[0], z, 0, 0, 0);
#pragma unroll
  for (int d0 = 1; d0 < 4; ++d0) { p0 = __builtin_amdgcn_mfma_f32_32x32x16_bf16(kf[2 * d0], qr[d0], p0, 0, 0, 0); p1 = __builtin_amdgcn_mfma_f32_32x32x16_bf16(kf[2 * d0 + 1], qr[d0], p1, 0, 0, 0); }
}
__device__ __forceinline__ void pv(f32x16 (&o)[2], int vb, bf16x8 pa0, bf16x8 pa1, bf16x8 pa2, bf16x8 pa3) {
#define FA_PK(k) (bf16x8){lo[k][0], lo[k][1], lo[k][2], lo[k][3], hi[k][0], hi[k][1], hi[k][2], hi[k][3]}
  s16x4 lo[8], hi[8];
#pragma unroll
  for (int d0 = 0; d0 < 2; ++d0)
#pragma unroll
    for (int ks = 0; ks < 4; ++ks) {
      asm volatile("ds_read_b64_tr_b16 %0,%1 offset:%c2" : "=&v"(lo[d0 * 4 + ks]) : "v"(vb), "i"(d0 * 4096 + ks * 1024) : "memory");
      asm volatile("ds_read_b64_tr_b16 %0,%1 offset:%c2" : "=&v"(hi[d0 * 4 + ks]) : "v"(vb), "i"(d0 * 4096 + ks * 1024 + 512) : "memory"); }
  asm volatile("s_waitcnt lgkmcnt(0)" ::: "memory"); __builtin_amdgcn_sched_barrier(0);
  o[0] = __builtin_amdgcn_mfma_f32_32x32x16_bf16(pa0, FA_PK(0), o[0], 0, 0, 0); o[1] = __builtin_amdgcn_mfma_f32_32x32x16_bf16(pa0, FA_PK(4), o[1], 0, 0, 0);
  o[0] = __builtin_amdgcn_mfma_f32_32x32x16_bf16(pa1, FA_PK(1), o[0], 0, 0, 0); o[1] = __builtin_amdgcn_mfma_f32_32x32x16_bf16(pa1, FA_PK(5), o[1], 0, 0, 0);
  o[0] = __builtin_amdgcn_mfma_f32_32x32x16_bf16(pa2, FA_PK(2), o[0], 0, 0, 0); o[1] = __builtin_amdgcn_mfma_f32_32x32x16_bf16(pa2, FA_PK(6), o[1], 0, 0, 0);
  o[0] = __builtin_amdgcn_mfma_f32_32x32x16_bf16(pa3, FA_PK(3), o[0], 0, 0, 0); o[1] = __builtin_amdgcn_mfma_f32_32x32x16_bf16(pa3, FA_PK(7), o[1], 0, 0, 0);
#undef FA_PK
}
struct SmState { float m, l; f32x16 o[2]; };
#ifdef PROBE_STAMPS
struct Prof { unsigned long long t, a[4]; };
#define FA_PROF_DECL Prof prof; prof.t = __builtin_amdgcn_s_memrealtime(); prof.a[0] = prof.a[1] = prof.a[2] = prof.a[3] = 0;
#define FA_PROF(k) do { __builtin_amdgcn_sched_barrier(0); const unsigned long long n_ = __builtin_amdgcn_s_memrealtime(); prof.a[k] += n_ - prof.t; prof.t = n_; __builtin_amdgcn_sched_barrier(0); } while (0)
#define FA_PROF_ARG , Prof& prof
#define FA_PROF_PASS , prof
#else
#define FA_PROF_DECL
#define FA_PROF(k) do {} while (0)
#define FA_PROF_ARG
#define FA_PROF_PASS
#endif
__device__ __forceinline__ void sm_reset(SmState& st) { st.m = 0.f; st.l = 0.f;
#pragma unroll
  for (int r = 0; r < 16; ++r) { st.o[0][r] = 0.f; st.o[1][r] = 0.f; } }
__device__ __forceinline__ void mask_range(f32x16& p0, f32x16& p1, int klo, int khi, int hi) {
  if (__all(klo <= 0 && khi >= 63)) return;
#pragma unroll
  for (int r = 0; r < 16; ++r) { const int k0 = crow(r, hi), k1 = k0 + 32; if (k0 < klo || k0 > khi) p0[r] = -INFINITY; if (k1 < klo || k1 > khi) p1[r] = -INFINITY; }
}
__device__ __forceinline__ void tile_step(SmState& st, LAS unsigned char* lds, int slot, const bf16x8 (&qr)[4], LAS float* wsf, int r32, int hi, int vb0, int klo, int khi, float bias FA_PROF_ARG) {
  FA_PROF(0);
  f32x16 p0, p1; qkt(p0, p1, lds + L_K + slot * 8192, qr, r32, hi, bias);
  asm volatile("" : "+v"(p0), "+v"(p1)); FA_PROF(1);
  mask_range(p0, p1, klo, khi, hi);
  float rs = 0.f;
#pragma unroll
  for (int r = 0; r < 16; ++r) { p0[r] = ex2(p0[r] - st.m); p1[r] = ex2(p1[r] - st.m); rs += p0[r] + p1[r]; }
  if (__builtin_expect(__any(!(rs < 1.0e30f)), 0)) {
    qkt(p0, p1, lds + L_K + slot * 8192, qr, r32, hi, bias); mask_range(p0, p1, klo, khi, hi);
    float rm = max2f(p0[0], p1[0]);
#pragma unroll
    for (int r = 1; r < 16; ++r) rm = max3f(rm, p0[r], p1[r]);
    rm = swap_max(rm) - st.m; const float d = rm > 24.f ? rm : 0.f; const float f = ex2(-d); st.m += d; st.l *= f;
    if (hi == 0) wsf[r32] = f;
    rs = 0.f;
#pragma unroll
    for (int r = 0; r < 16; ++r) { p0[r] = ex2(p0[r] - st.m); p1[r] = ex2(p1[r] - st.m); rs += p0[r] + p1[r]; const float fr = wsf[crow(r, hi)]; st.o[0][r] *= fr; st.o[1][r] *= fr; } }
  st.l += rs;
  u32x4 w0, w1, w2, w3;
  w0.x = pg8::cvt_pk_bf16(p0[0], p0[1]); w0.y = pg8::cvt_pk_bf16(p0[2], p0[3]); w0.z = pg8::cvt_pk_bf16(p0[4], p0[5]); w0.w = pg8::cvt_pk_bf16(p0[6], p0[7]);
  w1.x = pg8::cvt_pk_bf16(p0[8], p0[9]); w1.y = pg8::cvt_pk_bf16(p0[10], p0[11]); w1.z = pg8::cvt_pk_bf16(p0[12], p0[13]); w1.w = pg8::cvt_pk_bf16(p0[14], p0[15]);
  w2.x = pg8::cvt_pk_bf16(p1[0], p1[1]); w2.y = pg8::cvt_pk_bf16(p1[2], p1[3]); w2.z = pg8::cvt_pk_bf16(p1[4], p1[5]); w2.w = pg8::cvt_pk_bf16(p1[6], p1[7]);
  w3.x = pg8::cvt_pk_bf16(p1[8], p1[9]); w3.y = pg8::cvt_pk_bf16(p1[10], p1[11]); w3.z = pg8::cvt_pk_bf16(p1[12], p1[13]); w3.w = pg8::cvt_pk_bf16(p1[14], p1[15]);
  asm volatile("" : "+v"(w0), "+v"(w1), "+v"(w2), "+v"(w3)); FA_PROF(2);
  pv(st.o, vb0 + L_V + slot * 8192, __builtin_bit_cast(bf16x8, w0), __builtin_bit_cast(bf16x8, w1), __builtin_bit_cast(bf16x8, w2), __builtin_bit_cast(bf16x8, w3));
  asm volatile("" : "+v"(st.o[0]), "+v"(st.o[1])); FA_PROF(3);
}
template <int MODE> __device__ __forceinline__ void finalize(SmState& st, float gate, f32x16 (&outacc)[2], LAS float* slab, LAS float* wsf, int r32, int hi, int lane, float& msafe, float& invl) {
  const float lt = swap_add(st.l); invl = lt > 0.f ? 1.0f / lt : 0.f; msafe = st.m;
  if (hi == 0) wsf[r32] = gate * invl;
#pragma unroll
  for (int r = 0; r < 16; ++r) { const float fr = wsf[crow(r, hi)];
    if (MODE == 0) { outacc[0][r] = st.o[0][r] * fr; outacc[1][r] = st.o[1][r] * fr; }
    else if (MODE == 1) { slab[r * 64 + lane] += st.o[0][r] * fr; slab[(16 + r) * 64 + lane] += st.o[1][r] * fr; }
    else { outacc[0][r] = slab[r * 64 + lane] + st.o[0][r] * fr; outacc[1][r] = slab[(16 + r) * 64 + lane] + st.o[1][r] * fr; } }
}
__device__ __forceinline__ void imp_step(LAS unsigned char* lds, int slot, const bf16x8 (&qr)[4], int r32, int hi, int khi, float msafe, float invl, LAS float* imph  , int tq, int T) {
  f32x16 p0, p1; qkt(p0, p1, lds + L_K + slot * 8192, qr, r32, hi);
  mask_range(p0, p1, 0, khi, hi);
#pragma unroll
  for (int r = 0; r < 16; ++r) { p0[r] = ex2(p0[r] - msafe) * invl; p1[r] = ex2(p1[r] - msafe) * invl; }
  LAS float* row = imph + tq * IMP_LD + 16 * T + hi;
#pragma unroll
  for (int gq = 0; gq < 4; ++gq) { row[2 * gq] += (p0[4 * gq] + p0[4 * gq + 1]) + (p0[4 * gq + 2] + p0[4 * gq + 3]); row[2 * gq + 8] += (p1[4 * gq] + p1[4 * gq + 1]) + (p1[4 * gq + 2] + p1[4 * gq + 3]); }
  asm volatile("s_waitcnt lgkmcnt(0)" ::: "memory");
#pragma unroll
  for (int gq = 0; gq < 4; ++gq) { row[2 * gq + 1] += p0[4 * gq + 3]; if (16 * T + hi + 2 * gq + 9 < 64) row[2 * gq + 9] += p1[4 * gq + 3]; }
  asm volatile("s_waitcnt lgkmcnt(0)" ::: "memory");
}
__device__ __forceinline__ void topk_select(LAS unsigned char* lds, LAS float* wsf, int wid, int lane, int i) {
  LAS float* IM = (LAS float*)(lds + L_IMP); LAS unsigned long long* MK = (LAS unsigned long long*)(lds + L_MASK);
  const int j = lane; const int nforced = i == 0 ? 1 : (i == 1 ? 2 : 3);
  const bool forced = (j <= i) && (j == 0 || j == i || j == i - 1); const bool cand = (j >= 1) && (j <= i - 2);
  for (int tq = wid; tq < 64; tq += 8) {
    const float v = (IM[tq * IMP_LD + j] + IM[IMP_HEAD + tq * IMP_LD + j]) + (IM[2 * IMP_HEAD + tq * IMP_LD + j] + IM[3 * IMP_HEAD + tq * IMP_LD + j]);
    int cnt = 0;
#pragma unroll 4
    for (int jj = 1; jj <= i - 2; ++jj) { const float vv = __uint_as_float(__builtin_amdgcn_readlane(__float_as_uint(v), jj)); cnt += (vv > v || (vv == v && jj < j)) ? 1 : 0; }
    const bool sel = forced || (cand && cnt < 16 - nforced);
    const unsigned long long mk = __ballot(sel);
    if (lane == 0) MK[tq] = mk;
  }
}
__device__ __forceinline__ void attn_unit(LAS unsigned char* lds, const nv::Inputs& I, const Bufs& B, int b, int g, int i) {
  const int tid = fx::otid(), lane = tid & 63, wid = __builtin_amdgcn_readfirstlane(tid >> 6), r32 = lane & 31, hi = lane >> 5;
  const int e = wid >> 1, h = g * 4 + e, tq = 32 * (wid & 1) + r32; const size_t tok = (size_t)b * S + 64 * i + tq; const int t = 64 * i + tq;
  LAS float* wsf = (LAS float*)(lds + L_WSF) + wid * 64;
  LAS float* imph = (LAS float*)(lds + L_IMP) + e * IMP_HEAD;
  const int vb0 = (int)(unsigned)(size_t)lds + ((lane >> 4) & 1) * 32 + (lane & 3) * 8 + (4 * hi + ((lane & 15) >> 2)) * 64;
  bf16x8 qr[4];
  {
    float qv[4][8]; float ss = 0.f;
#pragma unroll
    for (int d0 = 0; d0 < 4; ++d0) { fx::load8(B.QKV + tok * QKVW + h * 64 + d0 * 16 + hi * 8, qv[d0]);
#pragma unroll
      for (int j = 0; j < 8; ++j) ss += qv[d0][j] * qv[d0][j]; }
    ss = swap_add(ss); const float rs = C2 / sqrtf(ss * (1.f / 64.f) + nv::EPS);
#pragma unroll
    for (int d0 = 0; d0 < 4; ++d0) { u32x4 w; const float* gq = I.q_gain + d0 * 16 + hi * 8;
      w.x = pg8::cvt_pk_bf16(qv[d0][0] * rs * gq[0], qv[d0][1] * rs * gq[1]); w.y = pg8::cvt_pk_bf16(qv[d0][2] * rs * gq[2], qv[d0][3] * rs * gq[3]);
      w.z = pg8::cvt_pk_bf16(qv[d0][4] * rs * gq[4], qv[d0][5] * rs * gq[5]); w.w = pg8::cvt_pk_bf16(qv[d0][6] * rs * gq[6], qv[d0][7] * rs * gq[7]); qr[d0] = __builtin_bit_cast(bf16x8, w); } }
  const float g0 = B.NG[tok * 24 + h * 3 + 0], g1 = B.NG[tok * 24 + h * 3 + 1], g2 = B.NG[tok * 24 + h * 3 + 2];
  const u16* kc = B.KCMP + (size_t)(b * 2 + g) * 256 * 64; const u16* vc = B.VCMP + (size_t)(b * 2 + g) * 256 * 64;
  const u16* ksb = B.QKV + (size_t)b * S * QKVW + nv::O_KS + g * 64; const u16* vsb = B.QKV + (size_t)b * S * QKVW + nv::O_VS + g * 64;
  const u16* kwb = B.QKV + (size_t)b * S * QKVW + nv::O_KW + g * 64; const u16* vwb = B.QKV + (size_t)b * S * QKVW + nv::O_VW + g * 64;
  int nvis = t >= 31 ? (t - 31) / 16 + 1 : 0; nvis = nvis > 255 ? 255 : nvis;
  const int ntA = (4 * i + 3 + 63) / 64, nC = (i < 8 ? i : 8) + 1, jC0 = i - (nC - 1);
  const int sI = ntA, sB = 2 * ntA, sC = sB + i + 1, NS = sC + nC;
  { LAS float* IM = (LAS float*)(lds + L_IMP); for (int k = tid; k < 4 * IMP_HEAD; k += 512) IM[k] = 0.f; }
  f32x16 outacc[2];
  LAS float* slab = (LAS float*)(lds + L_IMP) + wid * 2048;
  SmState st; sm_reset(st);
  float mA = 0.f, invlA = 0.f; unsigned long long mybits = 0ull;
  FA_PROF_DECL
#ifdef PROBE_STAMPS
  const unsigned long long ck0 = __builtin_amdgcn_s_memtime(), rt0 = __builtin_amdgcn_s_memrealtime();
#endif
#define FA_ISSUE1(s_) do { const int s__ = (s_); const int sl = s__ & 3; \
    if (s__ < sI) stage_kv(lds, sl, kc + (size_t)s__ * 4096, vc + (size_t)s__ * 4096, 64, wid, lane, true); \
    else if (s__ < sB) stage_kv(lds, sl, kc + (size_t)(s__ - sI) * 4096, vc + (size_t)(s__ - sI) * 4096, 64, wid, lane, true); \
    else if (s__ < sC) stage_kv(lds, sl, ksb + (size_t)(s__ - sB) * 64 * QKVW, vsb + (size_t)(s__ - sB) * 64 * QKVW, QKVW, wid, lane, true); \
    else stage_kv(lds, sl, kwb + (size_t)(jC0 + s__ - sC) * 64 * QKVW, vwb + (size_t)(jC0 + s__ - sC) * 64 * QKVW, QKVW, wid, lane, true); } while (0)
  FA_ISSUE1(0);
  int s = 0;
#define FA_TOP(n_) do { asm volatile("s_waitcnt vmcnt(0)" ::: "memory"); __syncthreads(); if (s + 1 < NS) FA_ISSUE1(s + 1); } while (0)
#pragma unroll 1
  for (; s < sI; ++s) { FA_TOP(1); tile_step(st, lds, s & 3, qr, wsf, r32, hi, vb0, 0, nvis - 64 * s - 1, 0.f FA_PROF_PASS); }
  finalize<0>(st, g0, outacc, slab, wsf, r32, hi, lane, mA, invlA);
#pragma unroll 1
  for (; s < sB; ++s) { FA_TOP(1); imp_step(lds, s & 3, qr, r32, hi, nvis - 64 * (s - sI) - 1, mA, invlA, imph, tq, s - sI); }
  asm volatile("s_waitcnt lgkmcnt(0)\n\ts_barrier" ::: "memory");
  topk_select(lds, wsf, wid, lane, i);
  asm volatile("s_waitcnt lgkmcnt(0)\n\ts_barrier" ::: "memory"); mybits = ((const LAS unsigned long long*)(lds + L_MASK))[tq];
#pragma unroll
  for (int r = 0; r < 16; ++r) { slab[r * 64 + lane] = outacc[0][r]; slab[(16 + r) * 64 + lane] = outacc[1][r]; }
  sm_reset(st);
#pragma unroll 1
  for (; s < sC; ++s) { FA_TOP(1); const int j = s - sB; const bool selj = (mybits >> j) & 1ull;
    tile_step(st, lds, s & 3, qr, wsf, r32, hi, vb0, 0, j == i ? tq : 63, selj ? 0.f : -INFINITY FA_PROF_PASS); }
  { float d0_, d1_; finalize<1>(st, g1, outacc, slab, wsf, r32, hi, lane, d0_, d1_); sm_reset(st); }
#pragma unroll 1
  for (; s < NS; ++s) { FA_TOP(1); const int j = jC0 + (s - sC);
    tile_step(st, lds, s & 3, qr, wsf, r32, hi, vb0, (i >= 8 && j == i - 8) ? tq + 1 : 0, j == i ? tq : 63, 0.f FA_PROF_PASS); }
  { float d0_, d1_; finalize<2>(st, g2, outacc, slab, wsf, r32, hi, lane, d0_, d1_); }
#undef FA_ISSUE1
#undef FA_TOP
  { u16* Ow = B.YA + ((size_t)b * S + 64 * i + 32 * (wid & 1)) * 512 + h * 64; LAS u16* stg = (LAS u16*)(lds + L_OST) + wid * 4096;
#pragma unroll
    for (int r = 0; r < 16; ++r) { const int orow = crow(r, hi); stg[orow * 64 + r32] = nv::f2bf(outacc[0][r]); stg[orow * 64 + 32 + r32] = nv::f2bf(outacc[1][r]); }
    asm volatile("s_waitcnt lgkmcnt(0)" ::: "memory");
#pragma unroll
    for (int q = 0; q < 4; ++q) { const int row = q * 8 + (lane >> 3), ch = lane & 7; const u32x4 v = *(const LAS u32x4*)(stg + row * 64 + ch * 8); *(u32x4*)(Ow + (size_t)row * 512 + ch * 8) = v; } }
#ifdef PROBE_STAMPS
  if (blockIdx.x == 0 && threadIdx.x == PROBE_TID) { volatile LAS unsigned long long* ts = (volatile LAS unsigned long long*)(lds + 147120); for (int k = 0; k < 4; ++k) ts[20 + k] += prof.a[k]; ts[24] += (__builtin_amdgcn_s_memtime() - ck0) / 10; ts[25] += __builtin_amdgcn_s_memrealtime() - rt0; }
#endif
  __syncthreads();
}
__device__ __forceinline__ void phase_attention(LAS unsigned char* lds, const nv::Inputs& I, const Bufs& B) {
  const int G = gridDim.x, bx = blockIdx.x; const int vcu = (G % 8 == 0) ? (bx % 8) * (G / 8) + bx / 8 : bx;
  for (int u = vcu; u < 256; u += G) { const int bg = u >> 4, s = u & 15;
#pragma unroll 1
    for (int k = 0; k < 4; ++k) { const int i = (k == 0) ? s : (k == 1) ? 31 - s : (k == 2) ? 32 + s : 63 - s; attn_unit(lds, I, B, bg >> 1, bg & 1, i); } }
}
}
namespace fs {
#ifdef PROBE_STAMPS
#define FS_STAMP(k) do { if (blockIdx.x == 0 && threadIdx.x == 0) *(volatile LAS unsigned long long*)(lds + 147120 + 8 * (k)) = __builtin_amdgcn_s_memrealtime(); } while (0)
#else
#define FS_STAMP(k) do {} while (0)
#endif
using nv::u16; using nv::Bufs; using nv::Inputs;
using fa::bf16x8; using fa::f32x16; using fa::u32x4; using fa::crow; using fa::ex2;
typedef float f32x4 __attribute__((ext_vector_type(4)));
constexpr int S = nv::S, NTOK = nv::NTOK, SCD = 1536;
constexpr float LOG2E = 1.4426950408889634f;
struct SsdBufs { u16* XC; u16* STATE; float* ACS; float* DEC; };
__host__ __device__ inline size_t carve_ssd(SsdBufs& X, const Bufs& B, unsigned char* ws, size_t off) {
  auto take = [&](size_t bytes) { unsigned char* r = ws + off; off += (bytes + 255) / 256 * 256; return r; };
  X.XC = B.HB;
  X.STATE = B.HB + (size_t)NTOK * SCD;
  X.ACS = (float*)take((size_t)NTOK * 16 * 4); X.DEC = (float*)take((size_t)8 * 16 * 16 * 4);
  return off;
}
constexpr int L_ARR = 101376;
constexpr int L_BT = 0, BT_LD = 264, L_XWT = 67584;
constexpr int L_KIMG = 0, L_XV = 0, L_OST = 65536;
static_assert(L_XWT + 64 * BT_LD * 2 <= L_ARR && L_OST + 32768 <= L_ARR && L_ARR + 16384 <= 147456, "SSD LDS map");

__device__ __forceinline__ void phase_conv(const Inputs& I, const Bufs& B, const SsdBufs& X) {
  const int id = blockIdx.x * 512 + fx::otid(); if (id >= 192 * 512) return;
  const int c8 = (id % 192) * 8, run = id / 192; const int tok0 = run * 64; const int t0 = tok0 & (S - 1);
  float w[4][8], bias[8], h0[8], h1[8], h2[8];
#pragma unroll
  for (int j = 0; j < 8; ++j) { bias[j] = I.conv_b[c8 + j];
#pragma unroll
    for (int k = 0; k < 4; ++k) w[k][j] = I.conv_w[k * SCD + c8 + j]; }
  if (t0 >= 3) { fx::load8(B.XBC + (size_t)(tok0 - 3) * SCD + c8, h0); fx::load8(B.XBC + (size_t)(tok0 - 2) * SCD + c8, h1); fx::load8(B.XBC + (size_t)(tok0 - 1) * SCD + c8, h2); }
  else {
#pragma unroll
    for (int j = 0; j < 8; ++j) { h0[j] = 0.f; h1[j] = 0.f; h2[j] = 0.f; } }
#pragma unroll 8
  for (int t = 0; t < 64; ++t) { float x[8], y[8]; fx::load8(B.XBC + (size_t)(tok0 + t) * SCD + c8, x);
#pragma unroll
    for (int j = 0; j < 8; ++j) { const float a = bias[j] + w[0][j] * h0[j] + w[1][j] * h1[j] + w[2][j] * h2[j] + w[3][j] * x[j]; y[j] = a * fx::fsig(a); h0[j] = h1[j]; h1[j] = h2[j]; h2[j] = x[j]; }
    fx::store8(X.XC + (size_t)(tok0 + t) * SCD + c8, y); }
}

__device__ __forceinline__ void ssd_x_unit(LAS unsigned char* lds, const Inputs& I, const Bufs& B, const SsdBufs& X, int b, int c, int g) {
  const int tid = fx::otid(), lane = tid & 63, wid = __builtin_amdgcn_readfirstlane(tid >> 6), r32 = lane & 31, hi = lane >> 5, fr = lane & 15, fq = lane >> 4;
  const size_t tok0 = (size_t)b * S + (size_t)c * 256;
  LAS float* acs2 = (LAS float*)(lds + L_ARR); LAS float* dtl = acs2 + 8 * 256;
  { const int hh = g * 8 + wid; const float a = -expf(I.a_log[hh]) * LOG2E; float d[4], sc[4];
#pragma unroll
    for (int k = 0; k < 4; ++k) d[k] = B.DT[(tok0 + 4 * lane + k) * 16 + hh];
    sc[0] = d[0] * a; sc[1] = sc[0] + d[1] * a; sc[2] = sc[1] + d[2] * a; sc[3] = sc[2] + d[3] * a;
    float tot = sc[3];
#pragma unroll
    for (int o = 1; o < 64; o <<= 1) { const float up = __shfl_up(tot, o); if (lane >= o) tot += up; }
    const float excl = tot - sc[3];
#pragma unroll
    for (int k = 0; k < 4; ++k) { const float v = excl + sc[k]; acs2[wid * 256 + 4 * lane + k] = v; dtl[wid * 256 + 4 * lane + k] = d[k]; X.ACS[(tok0 + 4 * lane + k) * 16 + hh] = v; }
    if (lane == 63) X.DEC[((size_t)b * 16 + c) * 16 + hh] = ex2(tot); }
  { LAS u16* BT = (LAS u16*)(lds + L_BT);
#pragma unroll 1
    for (int q = tid; q < 256 * 16; q += 512) { const int l = q >> 4, n8 = (q & 15) * 8; const u32x4 w = *(const u32x4*)(X.XC + (tok0 + l) * SCD + 1024 + g * 128 + n8);
      BT[(n8 + 0) * BT_LD + l] = (u16)(w.x & 0xffff); BT[(n8 + 1) * BT_LD + l] = (u16)(w.x >> 16); BT[(n8 + 2) * BT_LD + l] = (u16)(w.y & 0xffff); BT[(n8 + 3) * BT_LD + l] = (u16)(w.y >> 16);
      BT[(n8 + 4) * BT_LD + l] = (u16)(w.z & 0xffff); BT[(n8 + 5) * BT_LD + l] = (u16)(w.z >> 16); BT[(n8 + 6) * BT_LD + l] = (u16)(w.w & 0xffff); BT[(n8 + 7) * BT_LD + l] = (u16)(w.w >> 16); } }
  __syncthreads();
  FS_STAMP(30);
  u32x4 nx[4];
#define FSX_LOAD_X(h_) do { _Pragma("unroll") for (int u = 0; u < 4; ++u) { const int q = tid + u * 512; nx[u] = *(const u32x4*)(X.XC + (tok0 + (q >> 3)) * SCD + (g * 8 + (h_)) * 64 + (q & 7) * 8); } } while (0)
  FSX_LOAD_X(0);
#pragma unroll 1
  for (int h = 0; h < 8; ++h) { const int hh = g * 8 + h; LAS u16* XwT = (LAS u16*)(lds + L_XWT); const LAS u16* BT = (const LAS u16*)(lds + L_BT);
    const float aend = acs2[h * 256 + 255];
#pragma unroll
    for (int u = 0; u < 4; ++u) { const int q = tid + u * 512, l = q >> 3, p8 = (q & 7) * 8; const float w = ex2(aend - acs2[h * 256 + l]) * dtl[h * 256 + l]; const u32x4 xv = nx[u];
      XwT[(p8 + 0) * BT_LD + l] = nv::f2bf(__uint_as_float(xv.x << 16) * w); XwT[(p8 + 1) * BT_LD + l] = nv::f2bf(__uint_as_float(xv.x & 0xffff0000u) * w);
      XwT[(p8 + 2) * BT_LD + l] = nv::f2bf(__uint_as_float(xv.y << 16) * w); XwT[(p8 + 3) * BT_LD + l] = nv::f2bf(__uint_as_float(xv.y & 0xffff0000u) * w);
      XwT[(p8 + 4) * BT_LD + l] = nv::f2bf(__uint_as_float(xv.z << 16) * w); XwT[(p8 + 5) * BT_LD + l] = nv::f2bf(__uint_as_float(xv.z & 0xffff0000u) * w);
      XwT[(p8 + 6) * BT_LD + l] = nv::f2bf(__uint_as_float(xv.w << 16) * w); XwT[(p8 + 7) * BT_LD + l] = nv::f2bf(__uint_as_float(xv.w & 0xffff0000u) * w); }
    if (h + 1 < 8) FSX_LOAD_X(h + 1);
    asm volatile("s_waitcnt lgkmcnt(0)\n\ts_barrier" ::: "memory");
    { const int pt = wid & 3, nt0 = (wid >> 2) * 4; pg8::f32x4 acc[4];
#pragma unroll
      for (int n = 0; n < 4; ++n) acc[n] = (pg8::f32x4){0.f, 0.f, 0.f, 0.f};
#pragma unroll
      for (int ks = 0; ks < 8; ++ks) { const bf16x8 a = *(const LAS bf16x8*)(XwT + (pt * 16 + fr) * BT_LD + ks * 32 + fq * 8);
#pragma unroll
        for (int n = 0; n < 4; ++n) { const bf16x8 bb = *(const LAS bf16x8*)(BT + ((nt0 + n) * 16 + fr) * BT_LD + ks * 32 + fq * 8); acc[n] = __builtin_amdgcn_mfma_f32_16x16x32_bf16(a, bb, acc[n], 0, 0, 0); } }
      u16* st = X.STATE + (((size_t)b * 16 + c) * 16 + hh) * 8192;
#pragma unroll
      for (int n = 0; n < 4; ++n)
#pragma unroll
        for (int j = 0; j < 4; ++j) st[(pt * 16 + 4 * fq + j) * 128 + (nt0 + n) * 16 + fr] = nv::f2bf(acc[n][j]); }
    asm volatile("s_waitcnt lgkmcnt(0)\n\ts_barrier" ::: "memory"); }
#undef FSX_LOAD_X
  FS_STAMP(31);
  const int lt = wid < 4 ? wid : 11 - wid;
  const int l = 32 * lt + r32;
  for (int k = tid; k < 8 * 256; k += 512) { const int h_ = k >> 8, s_ = k & 255; dtl[k] = ex2(acs2[h_ * 256 + (s_ & ~15)] - acs2[k]) * dtl[k]; }
  bf16x8 qr[8];
#pragma unroll
  for (int d0 = 0; d0 < 8; ++d0) qr[d0] = *(const bf16x8*)(X.XC + (tok0 + l) * SCD + 1280 + g * 128 + d0 * 16 + hi * 8);
  unsigned Sp[4][16];
#define FS_STAGE_K(j_) do { const int j__ = (j_); _Pragma("unroll") for (int q = 0; q < 2; ++q) { const int ch = wid + 8 * q; \
    __builtin_amdgcn_global_load_lds((const unsigned*)(X.XC + (tok0 + 64 * j__ + lane) * SCD + 1024 + g * 128 + ch * 8), (LAS unsigned*)(lds + L_KIMG + (j__ & 1) * 16384 + ch * 1024), 16, 0, 0); } } while (0)
  FS_STAGE_K(0);
#pragma unroll
  for (int j = 0; j < 4; ++j) {
    asm volatile("s_waitcnt vmcnt(0)" ::: "memory"); __syncthreads();
    if (j + 1 < 4) FS_STAGE_K(j + 1);
    f32x16 p0, p1;
#pragma unroll
    for (int r = 0; r < 16; ++r) { p0[r] = 0.f; p1[r] = 0.f; }
    if (64 * j <= 32 * lt + 31) { const LAS unsigned char* kb = lds + L_KIMG + (j & 1) * 16384 + hi * 1024 + r32 * 16;
#pragma unroll
      for (int d0 = 0; d0 < 8; ++d0) { const bf16x8 b0 = *(const LAS bf16x8*)(kb + d0 * 2048), b1 = *(const LAS bf16x8*)(kb + d0 * 2048 + 512);
        p0 = __builtin_amdgcn_mfma_f32_32x32x16_bf16(b0, qr[d0], p0, 0, 0, 0); p1 = __builtin_amdgcn_mfma_f32_32x32x16_bf16(b1, qr[d0], p1, 0, 0, 0); } }
#pragma unroll
    for (int r = 0; r < 8; ++r) { Sp[j][r] = pg8::cvt_pk_bf16(p0[2 * r], p0[2 * r + 1]); Sp[j][8 + r] = pg8::cvt_pk_bf16(p1[2 * r], p1[2 * r + 1]); } }
#undef FS_STAGE_K
  FS_STAMP(32);
  __syncthreads();
#define FS_STAGE_X(h_) do { const int h__ = (h_); _Pragma("unroll") for (int j = 0; j < 4; ++j) \
    __builtin_amdgcn_global_load_lds((const unsigned*)(X.XC + (tok0 + 64 * j + 16 * (wid & 3) + (lane >> 2)) * SCD + (g * 8 + h__) * 64 + (wid >> 2) * 32 + (lane & 3) * 8), \
                                     (LAS unsigned*)(lds + L_XV + (h__ & 1) * 32768 + j * 8192 + wid * 1024), 16, 0, 0); } while (0)
  const int vb0 = (int)(unsigned)(size_t)lds + ((lane >> 4) & 1) * 32 + (lane & 3) * 8 + (4 * hi + ((lane & 15) >> 2)) * 64;
  FS_STAGE_X(0);
#pragma unroll 1
  for (int h = 0; h < 8; ++h) { const int hh = g * 8 + h;
    if (h == 0) asm volatile("s_waitcnt vmcnt(0) lgkmcnt(0)\n\ts_barrier" ::: "memory"); else asm volatile("s_waitcnt vmcnt(4) lgkmcnt(0)\n\ts_barrier" ::: "memory");
    if (h + 1 < 8) FS_STAGE_X(h + 1);
    const float al = acs2[h * 256 + l]; f32x16 o[2];
#pragma unroll
    for (int r = 0; r < 16; ++r) { o[0][r] = 0.f; o[1][r] = 0.f; }
#pragma unroll
    for (int j = 0; j < 4; ++j) { if (64 * j <= 32 * lt + 31) { f32x16 p0, p1;
#pragma unroll
        for (int r = 0; r < 16; ++r) asm volatile("" : "+v"(Sp[j][r]));
#pragma unroll
        for (int r = 0; r < 8; ++r) { p0[2 * r] = __uint_as_float(Sp[j][r] << 16); p0[2 * r + 1] = __uint_as_float(Sp[j][r] & 0xffff0000u); p1[2 * r] = __uint_as_float(Sp[j][8 + r] << 16); p1[2 * r + 1] = __uint_as_float(Sp[j][8 + r] & 0xffff0000u); }
        float e1[4];
#pragma unroll
        for (int q = 0; q < 4; ++q) e1[q] = ex2(al - acs2[h * 256 + 64 * j + 16 * q]);
#pragma unroll
        for (int gq = 0; gq < 4; ++gq) { const int s0 = 64 * j + 8 * gq + 4 * hi; const f32x4 d0v = *(const LAS f32x4*)(dtl + h * 256 + s0), d1v = *(const LAS f32x4*)(dtl + h * 256 + s0 + 32);
#pragma unroll
          for (int k = 0; k < 4; ++k) { const int r = 4 * gq + k, s = s0 + k; p0[r] = (s <= l) ? p0[r] * (e1[gq >> 1] * d0v[k]) : 0.f; p1[r] = (s + 32 <= l) ? p1[r] * (e1[2 + (gq >> 1)] * d1v[k]) : 0.f; } }
        u32x4 w0, w1, w2, w3;
        w0.x = pg8::cvt_pk_bf16(p0[0], p0[1]); w0.y = pg8::cvt_pk_bf16(p0[2], p0[3]); w0.z = pg8::cvt_pk_bf16(p0[4], p0[5]); w0.w = pg8::cvt_pk_bf16(p0[6], p0[7]);
        w1.x = pg8::cvt_pk_bf16(p0[8], p0[9]); w1.y = pg8::cvt_pk_bf16(p0[10], p0[11]); w1.z = pg8::cvt_pk_bf16(p0[12], p0[13]); w1.w = pg8::cvt_pk_bf16(p0[14], p0[15]);
        w2.x = pg8::cvt_pk_bf16(p1[0], p1[1]); w2.y = pg8::cvt_pk_bf16(p1[2], p1[3]); w2.z = pg8::cvt_pk_bf16(p1[4], p1[5]); w2.w = pg8::cvt_pk_bf16(p1[6], p1[7]);
        w3.x = pg8::cvt_pk_bf16(p1[8], p1[9]); w3.y = pg8::cvt_pk_bf16(p1[10], p1[11]); w3.z = pg8::cvt_pk_bf16(p1[12], p1[13]); w3.w = pg8::cvt_pk_bf16(p1[14], p1[15]);
        fa::pv(o, vb0 + L_XV + (h & 1) * 32768 + j * 8192, __builtin_bit_cast(bf16x8, w0), __builtin_bit_cast(bf16x8, w1), __builtin_bit_cast(bf16x8, w2), __builtin_bit_cast(bf16x8, w3)); } }
    { const float dsk = I.d_skip[hh]; const LAS u16* xi = (const LAS u16*)(lds + L_XV + (h & 1) * 32768 + (lt >> 1) * 8192); LAS u16* stg = (LAS u16*)(lds + L_OST) + wid * 2048;
#pragma unroll
      for (int r = 0; r < 16; ++r) { const int key = 32 * (lt & 1) + crow(r, hi);
#pragma unroll
        for (int d0 = 0; d0 < 2; ++d0) { const float xv = nv::bf2f(xi[d0 * 2048 + (key >> 4) * 512 + (key & 15) * 32 + r32]); stg[crow(r, hi) * 64 + d0 * 32 + r32] = nv::f2bf(o[d0][r] + dsk * xv); } }
      asm volatile("s_waitcnt lgkmcnt(0)" ::: "memory");
      u16* Ow = X.XC + (tok0 + 32 * lt) * SCD + hh * 64;
#pragma unroll
      for (int q = 0; q < 4; ++q) { const int row = q * 8 + (lane >> 3), ch = lane & 7; const u32x4 v = *(const LAS u32x4*)(stg + row * 64 + ch * 8); *(u32x4*)(Ow + (size_t)row * SCD + ch * 8) = v; } } }
#undef FS_STAMP_DUMMY
#undef FS_STAGE_X
  __syncthreads(); FS_STAMP(33);
}
__device__ __forceinline__ void phase_ssd_x(LAS unsigned char* lds, const Inputs& I, const Bufs& B, const SsdBufs& X) {
  for (int u = blockIdx.x; u < 256; u += gridDim.x) ssd_x_unit(lds, I, B, X, u >> 5, (u >> 1) & 15, u & 1);
}
__device__ __forceinline__ void phase_ssd_scan(const SsdBufs& X) {
  for (int it = blockIdx.x * 512 + fx::otid(); it < 8 * 16 * 64 * 32; it += gridDim.x * 512) { const int n4 = (it & 31) * 4, p = (it >> 5) & 63, hh = (it >> 11) & 15, b = it >> 15;
    pg8::u32x2 v[16]; float dec[16];
#pragma unroll
    for (int c = 0; c < 16; ++c) { v[c] = *(const pg8::u32x2*)(X.STATE + (((size_t)b * 16 + c) * 16 + hh) * 8192 + p * 128 + n4); dec[c] = X.DEC[((size_t)b * 16 + c) * 16 + hh]; }
    float h0 = 0.f, h1 = 0.f, h2 = 0.f, h3 = 0.f;
#pragma unroll
    for (int c = 0; c < 16; ++c) { pg8::u32x2 o; o.x = fx::pk2(h0, h1); o.y = fx::pk2(h2, h3); *(pg8::u32x2*)(X.STATE + (((size_t)b * 16 + c) * 16 + hh) * 8192 + p * 128 + n4) = o;
      h0 = h0 * dec[c] + __uint_as_float(v[c].x << 16); h1 = h1 * dec[c] + __uint_as_float(v[c].x & 0xffff0000u); h2 = h2 * dec[c] + __uint_as_float(v[c].y << 16); h3 = h3 * dec[c] + __uint_as_float(v[c].y & 0xffff0000u); } }
}
__device__ __forceinline__ void ssd_y_unit(LAS unsigned char* lds, const Inputs& I, const Bufs& B, const SsdBufs& X, int b, int c, int g) {
  const int tid = fx::otid(), lane = tid & 63, wid = __builtin_amdgcn_readfirstlane(tid >> 6), r32 = lane & 31, hi = lane >> 5;
  const size_t tok0 = (size_t)b * S + (size_t)c * 256; const int l = 32 * wid + r32;
  LAS float* acsw = (LAS float*)(lds + 0) + wid * 32 * 8;
  LAS u16* stg1 = (LAS u16*)(lds + 16384) + wid * 2048; LAS u16* stg2 = (LAS u16*)(lds + 49152) + wid * 2048; LAS float* rstdL = (LAS float*)(lds + 81920);
  { const int row = lane >> 1, h4 = (lane & 1) * 4; const f32x4 a = *(const f32x4*)(X.ACS + (tok0 + 32 * wid + row) * 16 + g * 8 + h4); acsw[row * 8 + h4 + 0] = ex2(a.x); acsw[row * 8 + h4 + 1] = ex2(a.y); acsw[row * 8 + h4 + 2] = ex2(a.z); acsw[row * 8 + h4 + 3] = ex2(a.w); }
  bf16x8 qr[8];
#pragma unroll
  for (int d0 = 0; d0 < 8; ++d0) qr[d0] = *(const bf16x8*)(X.XC + (tok0 + l) * SCD + 1280 + g * 128 + d0 * 16 + hi * 8);
  float ssq[16];
#pragma unroll
  for (int r = 0; r < 16; ++r) ssq[r] = 0.f;
#define FSY_STAGE_P(h_) do { const int h__ = (h_); const u16* pp_ = X.STATE + (((size_t)b * 16 + c) * 16 + g * 8 + h__) * 8192; _Pragma("unroll") for (int q = 0; q < 2; ++q) { const int ch = wid + 8 * q; \
    __builtin_amdgcn_global_load_lds((const unsigned*)(pp_ + (size_t)lane * 128 + ch * 8), (LAS unsigned*)(lds + 90112 + (h__ & 1) * 16384 + ch * 1024), 16, 0, 0); } } while (0)
#define FSY_LOAD_YZ(h_) do { const int hh__ = g * 8 + (h_); _Pragma("unroll") for (int q = 0; q < 4; ++q) { const int row = q * 8 + (lane >> 3), ch = lane & 7; \
    ny1[q] = *(const u32x4*)(X.XC + (tok0 + 32 * wid + row) * SCD + hh__ * 64 + ch * 8); nz[q] = *(const u32x4*)(B.Z + (tok0 + 32 * wid + row) * 1024 + hh__ * 64 + ch * 8); } } while (0)
  u32x4 ny1[4], nz[4];
  FS_STAMP(34);
  FSY_STAGE_P(0); FSY_LOAD_YZ(0);
#pragma unroll 1
  for (int h = 0; h < 8; ++h) { const int hh = g * 8 + h;
    if (h == 0) asm volatile("s_waitcnt vmcnt(0) lgkmcnt(0)\n\ts_barrier" ::: "memory"); else asm volatile("s_waitcnt vmcnt(4) lgkmcnt(0)\n\ts_barrier" ::: "memory");
#pragma unroll
    for (int q = 0; q < 4; ++q) { const int row = q * 8 + (lane >> 3), ch = lane & 7; *(LAS u32x4*)(stg1 + row * 64 + ch * 8) = ny1[q]; *(LAS u32x4*)(stg2 + row * 64 + ch * 8) = nz[q]; }
    if (h + 1 < 8) { FSY_STAGE_P(h + 1); FSY_LOAD_YZ(h + 1); }
    f32x16 y[2];
#pragma unroll
    for (int r = 0; r < 16; ++r) { y[0][r] = 0.f; y[1][r] = 0.f; }
    { const LAS unsigned char* pb = lds + 90112 + (h & 1) * 16384 + hi * 1024 + r32 * 16;
#pragma unroll
      for (int d0 = 0; d0 < 8; ++d0) { const bf16x8 b0 = *(const LAS bf16x8*)(pb + d0 * 2048), b1 = *(const LAS bf16x8*)(pb + d0 * 2048 + 512);
        y[0] = __builtin_amdgcn_mfma_f32_32x32x16_bf16(qr[d0], b0, y[0], 0, 0, 0); y[1] = __builtin_amdgcn_mfma_f32_32x32x16_bf16(qr[d0], b1, y[1], 0, 0, 0); } }
    asm volatile("s_waitcnt lgkmcnt(0)" ::: "memory");
#pragma unroll
    for (int r = 0; r < 16; ++r) { const int row = crow(r, hi); const float ea = acsw[row * 8 + h];
#pragma unroll
      for (int d0 = 0; d0 < 2; ++d0) { const int idx = row * 64 + d0 * 32 + r32; const float yy = nv::bf2f(stg1[idx]) + ea * y[d0][r]; const float zz = nv::bf2f(stg2[idx]); const float yg = yy * zz * fx::fsig(zz); ssq[r] += yg * yg; stg1[idx] = nv::f2bf(yg); } }
    asm volatile("s_waitcnt lgkmcnt(0)" ::: "memory");
#pragma unroll
    for (int q = 0; q < 4; ++q) { const int row = q * 8 + (lane >> 3), ch = lane & 7; *(u32x4*)(B.YB + (tok0 + 32 * wid + row) * 1024 + hh * 64 + ch * 8) = *(const LAS u32x4*)(stg1 + row * 64 + ch * 8); }
    asm volatile("s_waitcnt lgkmcnt(0)" ::: "memory"); }
  FS_STAMP(35);
#pragma unroll
  for (int r = 0; r < 16; ++r) { float v = ssq[r];
#pragma unroll
    for (int o = 1; o < 32; o <<= 1) v += __shfl_xor(v, o);
    if (r32 == 0) rstdL[32 * wid + crow(r, hi)] = 1.0f / sqrtf(v * (1.f / 512.f) + nv::EPS); }
#undef FSY_STAGE_P
#undef FSY_LOAD_YZ
  asm volatile("s_waitcnt vmcnt(0) lgkmcnt(0)\n\ts_barrier" ::: "memory"); FS_STAMP(36);
#pragma unroll 1
  for (int q0 = tid; q0 < 256 * 64; q0 += 512 * 8) { float v[8][8];
#pragma unroll
    for (int u = 0; u < 8; ++u) { const int q = q0 + u * 512, row = q >> 6, c8 = (q & 63) * 8; fx::load8(B.YB + (tok0 + row) * 1024 + g * 512 + c8, v[u]); }
#pragma unroll
    for (int u = 0; u < 8; ++u) { const int q = q0 + u * 512, row = q >> 6, c8 = (q & 63) * 8; const float rs = rstdL[row];
#pragma unroll
      for (int j = 0; j < 8; ++j) v[u][j] = v[u][j] * rs * I.ssm_norm[g * 512 + c8 + j];
      fx::store8(B.YB + (tok0 + row) * 1024 + g * 512 + c8, v[u]); } }
  __syncthreads();
}
__device__ __forceinline__ void phase_ssd_y(LAS unsigned char* lds, const Inputs& I, const Bufs& B, const SsdBufs& X) {
  for (int u = blockIdx.x; u < 256; u += gridDim.x) ssd_y_unit(lds, I, B, X, u >> 5, (u >> 1) & 15, u & 1);
}
}
namespace fc {
using nv::u16; using nv::Bufs; using nv::Inputs; using pg8::Unit;
constexpr int S = nv::S;
struct CmpBufs { u16* WcT; float* BIAS1; float* PAB; };
__host__ __device__ inline size_t carve_cmp(CmpBufs& C, unsigned char* ws, size_t off) {
  auto take = [&](size_t bytes) { unsigned char* r = ws + off; off += (bytes + 255) / 256 * 256; return r; };
  C.WcT = (u16*)take((size_t)2 * 256 * 1024 * 2); C.BIAS1 = (float*)take(2 * 128 * 4); C.PAB = (float*)take((size_t)2 * 2 * 16 * 256 * 256 * 4);
  return off;
}
struct CpCmp { const float* src; int ld; __device__ const float* operator()(int n) const { return n < 128 ? src + n : src + (size_t)1024 * 128 + (n - 128); } };
__device__ __forceinline__ void prologue_cmp(LAS unsigned char* lds, const Inputs& I, const CmpBufs& C) {
  { const int tid = fx::otid(), lane = tid & 63, wv = tid >> 6, gw = fx::obid() * 8 + wv, ngw = gridDim.x * 8; LAS float* scr = (LAS float*)lds + wv * (64 * 33);
    for (int t = gw; t < 2 * 8 * 16; t += ngw) { const int kv = t >> 7, q = t & 127; CpCmp cp{kv ? I.w1_v : I.w1_k, 128}; fx::transpose_item(scr, cp, C.WcT + (size_t)kv * 256 * 1024, 1024, (q >> 4) * 32, (q & 15) * 64, lane); } }
  { const int tid = fx::otid(), lane = tid & 63, gw = fx::obid() * 8 + (tid >> 6);
    if (gw < 256) { const int kv = gw >> 7, n = gw & 127; const float* w1 = kv ? I.w1_v : I.w1_k; const float* pos = kv ? I.pos_v : I.pos_k; float s = 0.f;
      for (int k = lane; k < 2048; k += 64) s += pos[k] * w1[(size_t)k * 128 + n];
      s = fx::wave_sum(s); if (lane == 0) C.BIAS1[kv * 128 + n] = s; } }
}
struct SchedCmp { int kv, bg, kh;
  __device__ bool next(int i, Unit& u) const { if (i > 0) return false; u.pm = (kh * 2 + kv) * 16 + bg; u.pn = 0; u.aux0 = 0; u.aux1 = 0; return true; }
  __device__ __forceinline__ const char* a_base(const pg8::Gemm& g, const Unit&) const { return (const char*)g.A + (size_t)kh * 8 * 1280 * 2; }
  __device__ __forceinline__ const char* b_base(const pg8::Gemm& g, const Unit&) const { return (const char*)g.Bt + ((size_t)kv * 256 * 1024 + (size_t)kh * 512) * 2; }
  __device__ __forceinline__ int a_row(const Unit&, int r) const { return ((bg >> 1) * S + 16 * r) * 1280 + (kv ? nv::O_VC : nv::O_KC) + (bg & 1) * 64; } };
struct FPab { float* o; __device__ __forceinline__ void operator()(const Unit&, int row, int c, const float (&v)[8]) const { float* p = o + (size_t)row * 256 + c; *(pg8::f32x4*)p = (pg8::f32x4){v[0], v[1], v[2], v[3]}; *(pg8::f32x4*)(p + 4) = (pg8::f32x4){v[4], v[5], v[6], v[7]}; } };
__device__ __forceinline__ void phase_cmp_gemm(LAS unsigned char* lds, const Bufs& B, const CmpBufs& C) {
  for (int u = (int)blockIdx.x - ((int)gridDim.x - 64); u >= 0 && u < 64; u += gridDim.x) { pg8::Gemm g{B.QKV, C.WcT, 256, 256, 512, 1, 1024, 1280 * 2}; SchedCmp S{(u >> 4) & 1, u & 15, u >> 5}; fx::Epi8<FPab> E{FPab{C.PAB}};
    pg8::gemm_phase<fx::Epi8<FPab>, SchedCmp, true, true>(lds, g, S, E); }
}
__device__ __forceinline__ void phase_cmp_finish(LAS unsigned char* lds, const Inputs& I, const Bufs& B, const CmpBufs& C) {
  const int tid = fx::otid(), lane = tid & 63, wv = tid >> 6, gw = fx::obid() * 8 + wv, ngw = gridDim.x * 8;
  LAS float* w2s = (LAS float*)lds; LAS float* hs = (LAS float*)(lds + 65536) + wv * 128;
  for (int k = tid; k < 2 * 128 * 64 / 4; k += 512) { const int kv = k >> 11, q = k & 2047; *(LAS pg8::f32x4*)(w2s + kv * 8192 + q * 4) = *(const pg8::f32x4*)((kv ? I.w2_v : I.w2_k) + q * 4); }
  __syncthreads();
  for (int it = gw; it < 2 * 16 * 256; it += ngw) { const int kv = it >> 12, bg = (it >> 8) & 15, c = it & 255; u16* dst = (kv ? B.VCMP : B.KCMP) + ((size_t)bg * 256 + c) * 64;
    if (c == 255) { dst[lane] = 0; continue; }
    const float* pa = C.PAB + ((size_t)(kv * 16 + bg) * 256 + c) * 256; const float* pb = pa + 256 + 128; const float* b1 = C.BIAS1 + kv * 128;
    const float* pa2 = pa + (size_t)2 * 16 * 256 * 256; const float* pb2 = pb + (size_t)2 * 16 * 256 * 256;
    { const float ha = (pa[lane] + pa2[lane]) + (pb[lane] + pb2[lane]) + b1[lane], hb = (pa[64 + lane] + pa2[64 + lane]) + (pb[64 + lane] + pb2[64 + lane]) + b1[64 + lane]; hs[lane] = ha * fx::fsig(ha); hs[64 + lane] = hb * fx::fsig(hb); }
    const LAS float* w2 = w2s + kv * 8192; float acc = 0.f;
#pragma unroll 8
    for (int n = 0; n < 128; ++n) acc += hs[n] * w2[n * 64 + lane];
    if (kv == 0) { const float ss = fx::wave_sum(acc * acc); acc = acc * (1.0f / sqrtf(ss * (1.f / 64.f) + nv::EPS)) * I.kc_gain[lane]; }
    dst[lane] = nv::f2bf(acc); }
  __syncthreads();
}
}
struct Params { nv::Inputs I; float* out; unsigned char* ws; };
constexpr int LDS_BYTES = 147456;
template <class F> __device__ __forceinline__ void run_phase(const F& f, long n) {
  for (long i = blockIdx.x * 512L + fx::otid(); i < n; i += (long)gridDim.x * 512L) f(i);
}
__global__ void __launch_bounds__(512) mega_fwd(Params P) {
  extern __shared__ __attribute__((aligned(16))) unsigned char lds_raw[];
  LAS unsigned char* lds = (LAS unsigned char*)lds_raw;
  cg::grid_group grid = cg::this_grid();
#define PH(...) { unsigned char* ws_ = P.ws; float* out = P.out; asm volatile("" : "+s"(ws_), "+s"(out)); nv::Bufs B; const size_t woff = nv::carve(B, ws_, out); fx::WBufs W; const size_t moff = fx::carve_w(W, ws_, woff); \
    fx::MoeBufs M; const size_t soff = fx::carve_moe(M, B, ws_, moff); fs::SsdBufs X; const size_t coff = fs::carve_ssd(X, B, ws_, soff); fc::CmpBufs C; const size_t boff = fc::carve_cmp(C, ws_, coff); unsigned* barw = (unsigned*)(ws_ + boff); (void)barw; (void)W; (void)M; (void)X; (void)C; __VA_ARGS__ }
  if (threadIdx.x < 4) ((LAS unsigned*)(lds + LDS_BYTES - 16))[threadIdx.x] = 0u;
  __syncthreads();
  xb::XcdBarrier bar; PH( bar = xb::xcd_barrier_post(barw, (volatile LAS unsigned*)(lds + LDS_BYTES - 16)); )
#define GSYNC() xb::xcd_barrier(bar)
  PH( fx::phase_prologue(lds, P.I, B, W); fx::phase_rms_rows(P.I.x, P.I.mix_norm, B.HB); fx::prologue_pb(P.I, W); fx::prologue_moe(P.I, M); fc::prologue_cmp(lds, P.I, C); ) grid.sync();
  PH( fx::dense_gemm(lds, B.HB, 1024, W.WinT, 1024, nv::NTOK, fx::INW_PAD, 1024, fx::FInProj{B.QKV, B.Z, B.XBC, B.BG, B.NG, B.DT, P.I.dt_bias}); ) GSYNC();
  PH( fc::phase_cmp_gemm(lds, B, C); fs::phase_conv(P.I, B, X); fa::phase_qknorm(P.I, B); ) GSYNC();
  PH( fs::phase_ssd_x(lds, P.I, B, X); ) GSYNC();
  PH( fs::phase_ssd_scan(X); fc::phase_cmp_finish(lds, P.I, B, C); ) GSYNC();
  PH( fs::phase_ssd_y(lds, P.I, B, X); ) GSYNC();
  PH( fa::phase_attention(lds, P.I, B); ) GSYNC();
  PH( fx::dense_gemm(lds, B.YA, 512, W.WaT, 512, nv::NTOK, 1024, 512, fx::FStoreBf{B.T1, 1024}); )
  PH( fx::dense_gemm(lds, B.YB, 1024, W.WbT, 1024, nv::NTOK, 1024, 1024, fx::FMerge{B.T1, B.BG, B.MERGED}); ) GSYNC();
  PH( fx::dense_gemm(lds, B.MERGED, 1024, W.WoutT, 1024, nv::NTOK, 1024, 1024, fx::FResid{P.I.x, out}); ) GSYNC();
  PH( fx::phase_rms_rows(out, P.I.moe_norm, B.H2); ) GSYNC();
  PH( fx::dense_gemm(lds, B.H2, 1024, M.WrT, 1024, nv::NTOK, 256, 1024, fx::FLogits{M.LOGITS}); ) GSYNC();
  PH( fx::phase_route(lds, P.I, B, M); ) GSYNC();
  PH( fx::build_tile_table(lds, M); )
  PH( fx::phase_moe_gu(lds, B, W, M); ) GSYNC();
  PH( fx::phase_moe_down(lds, B, W, M); ) GSYNC();
  PH( fx::phase_moe_combine(lds, out, M, B.EW, P.I.ple_norm, B.H2); ) GSYNC();
  PH( fx::dense_gemm(lds, W.PB, 256, W.PlePT, 256, nv::NTOK, 1024, 256, fx::FStoreBf{B.PP, 1024}); )
  PH( fx::dense_gemm(lds, B.H2, 1024, W.PleGT, 1024, nv::NTOK, 1024, 1024, fx::FPle{out, B.PP}); )
#undef GSYNC
}
extern "C" void kernel_launch(void* const* d_in, const int* in_sizes, int n_in, void* d_out, int out_size, void* d_ws, size_t ws_size, hipStream_t stream) {
  static int grid_blocks = 0;
  if (!grid_blocks) {
    int dev = 0, cus = 0, per_cu = 0;
    (void)hipGetDevice(&dev);
    (void)hipDeviceGetAttribute(&cus, hipDeviceAttributeMultiprocessorCount, dev);
    if (hipFuncSetAttribute((const void*)mega_fwd, hipFuncAttributeMaxDynamicSharedMemorySize, LDS_BYTES) != hipSuccess) fprintf(stderr, "kernel_launch: hipFuncSetAttribute failed\n");
    if (hipOccupancyMaxActiveBlocksPerMultiprocessor(&per_cu, mega_fwd, 512, LDS_BYTES) != hipSuccess || per_cu < 1) { fprintf(stderr, "kernel_launch: occupancy query says %d blocks per CU\n", per_cu); }
    grid_blocks = cus;
    { nv::Bufs B; fx::WBufs W; fx::MoeBufs M; fs::SsdBufs X; fc::CmpBufs C; size_t need = 16384 + fc::carve_cmp(C, nullptr, fs::carve_ssd(X, B, nullptr, fx::carve_moe(M, B, nullptr, fx::carve_w(W, nullptr, nv::carve(B, nullptr, nullptr))))); if (need > ws_size) fprintf(stderr, "kernel_launch: workspace too small: need %zu have %zu\n", need, ws_size); }
  }
  static size_t bar_off = 0;
  if (!bar_off) { nv::Bufs B; fx::WBufs W; fx::MoeBufs M; fs::SsdBufs X; fc::CmpBufs C; bar_off = fc::carve_cmp(C, nullptr, fs::carve_ssd(X, B, nullptr, fx::carve_moe(M, B, nullptr, fx::carve_w(W, nullptr, nv::carve(B, nullptr, nullptr))))); }
  (void)hipMemsetAsync((char*)d_ws + bar_off, 0, 16384, stream);
  Params p; memset(&p, 0, sizeof(p));
  const float** ip = (const float**)&p.I; for (int i = 0; i < 34; ++i) ip[i] = (const float*)d_in[i];
  p.out = (float*)d_out; p.ws = (unsigned char*)d_ws;
  void* args[] = {&p};
  hipError_t e = hipLaunchCooperativeKernel((void*)mega_fwd, dim3(grid_blocks), dim3(512), args, LDS_BYTES, stream);
  if (e != hipSuccess) fprintf(stderr, "cooperative launch failed: %s (grid %d)\n", hipGetErrorString(e), grid_blocks);
}
```

```cpp
#include <hip/hip_runtime.h>
#include <hip/hip_cooperative_groups.h>
#include <cstdio>
#include <cstring>
namespace cg = cooperative_groups;
#define HD __host__ __device__ inline
#if defined(__HIP_DEVICE_COMPILE__)
#define NV_FENCE() asm volatile("" ::: "memory")
#else
#define NV_FENCE()
#endif
#ifndef CFG_DM
#define CFG_DM 1024
#endif
#ifndef CFG_BATCH
#define CFG_BATCH 8
#endif
#ifndef CFG_SEQ
#define CFG_SEQ 4096
#endif
#ifndef CFG_MH
#define CFG_MH 256
#endif
#ifndef CFG_PLE
#define CFG_PLE 256
#endif

#ifndef NV_FENCE
#define NV_FENCE()
#endif
namespace nv {
typedef unsigned short u16;
typedef unsigned long long u64;
constexpr int DM = CFG_DM, NB = CFG_BATCH, S = CFG_SEQ, MH = CFG_MH, PLE = CFG_PLE;
constexpr int NTOK = NB * S;
constexpr int H = 8, G = 2, E = 4;
constexpr int QW = 512, GW = 24, QKVW = 1280;
constexpr int SH = 16, SP = 64, SI = 1024, SG = 2, SN = 128, SCD = 1536;
constexpr int INW = QW + 6 * 128 + GW + SI + SCD + SH + 2 * DM;
constexpr int O_Q = 0, O_KC = 512, O_VC = 640, O_KS = 768, O_VS = 896, O_KW = 1024, O_VW = 1152, O_NG = 1280, O_Z = 1304, O_XBC = 2328, O_DT = 3864, O_BG = 3880;
static_assert(O_BG + 2 * DM == INW, "in-proj width");
constexpr int NCMP = S / 16 - 1, NCP = S / 16, NSEL = S / 64, NTOP = NSEL < 16 ? NSEL : 16;
constexpr int NEXP = 32;
constexpr float EPS = 1e-6f;

HD float sigmoidf_(float x) { return 1.0f / (1.0f + expf(-x)); }
HD float siluf_(float x) { return x / (1.0f + expf(-x)); }
HD float softplusf_(float x) { return x > 20.f ? x : log1pf(expf(x)); }
HD u16 f2bf(float f) { unsigned u = __builtin_bit_cast(unsigned, f); u += 0x7fffu + ((u >> 16) & 1u); return (u16)(u >> 16); }
HD float bf2f(u16 h) { return __builtin_bit_cast(float, (unsigned)h << 16); }

struct Bufs {
  u16* HB;
  u16* QKV;
  float* NG;
  u16* Z;
  u16* XBC;
  float* DT;
  u16* BG;
  u16* KCMP;
  u16* VCMP;
  u16* YA;
  u16* YB;
  u16* T1;
  u16* MERGED;
  u16* H2;
  u16* ACT;
  u16* PP;
  int* EI;
  float* EW;
  float* HID;
  float* KTMP;
  float* ML;
  float* IMP;
  u64* MASK;
};
struct Inputs { const float *x, *p, *mix_norm, *w_in, *q_gain, *kc_gain, *ks_gain, *kw_gain, *pos_k, *w1_k, *w2_k, *pos_v, *w1_v, *w2_v, *conv_w, *conv_b, *dt_bias, *a_log, *d_skip, *ssm_norm,
  *w_a, *w_b, *w_out, *moe_norm, *w_group, *b_group, *w_expert, *b_expert, *w_gate, *w_up, *w_down, *ple_norm, *ple_wg, *ple_wp; };

HD size_t carve(Bufs& B, unsigned char* ws, float* out) {
  size_t off = 0; auto take = [&](size_t bytes) { unsigned char* r = ws + off; off += (bytes + 255) / 256 * 256; return r; };
  const size_t N = NTOK;
  B.BG = (u16*)out;
  unsigned char* R0 = take(N * DM * 2);
  unsigned char* R5 = take(N * 2 * MH * 2 + (size_t)NEXP * 256 * MH * 2);
  B.YA = (u16*)take(N * QW * 2);
  unsigned char* R1 = take(N * QKVW * 2);
  unsigned char* R2 = take(N * SI * 2);
  unsigned char* R3 = take(N * SCD * 2);
  B.HB = (u16*)R0; B.H2 = (u16*)R0; B.QKV = (u16*)R1; B.T1 = (u16*)R1; B.Z = (u16*)R2; B.XBC = (u16*)R3; B.MERGED = (u16*)R3; B.PP = (u16*)R3;
  B.ACT = (u16*)R5; B.YB = B.Z;
  B.NG = (float*)take(N * GW * 4); B.DT = (float*)take(N * SH * 4);
  B.KCMP = (u16*)take((size_t)NB * G * NCP * 64 * 2); B.VCMP = (u16*)take((size_t)NB * G * NCP * 64 * 2);
  B.EI = (int*)take(N * 2 * 4); B.EW = (float*)take(N * 2 * 4);
#ifdef NV2_NAIVE_SCRATCH
  B.HID = (float*)take((size_t)NB * G * NCMP * 128 * 4); B.KTMP = (float*)take((size_t)NB * G * NCMP * 64 * 4);
  B.ML = (float*)take(N * H * 2 * 4); B.IMP = (float*)take((size_t)NB * G * S * 64 * 4); B.MASK = (u64*)take((size_t)NB * G * S * 8);
#else
  B.HID = nullptr; B.KTMP = nullptr; B.ML = nullptr; B.IMP = nullptr; B.MASK = nullptr;
#endif
  return off;
}
}
namespace xb {
#define LAS __attribute__((address_space(3)))
#define XB_TMO      128
#define XB_XCNT(j)  (256  + 64 * (j))
#define XB_XSUB(j)  (1280 + 64 * (j))
#define XB_XGEN(j)  (2304 + 64 * (j))
#define XB_TOP      3328
#define XB_TOPGEN   3392
#define XCD_BAR_WORDS 3456
#define XB_SPIN_CAP (1u << 22)

__device__ __forceinline__ unsigned xb_ld(unsigned* p)              { return __hip_atomic_load(p, __ATOMIC_RELAXED, __HIP_MEMORY_SCOPE_AGENT); }
__device__ __forceinline__ unsigned xb_add(unsigned* p, unsigned v) { return __hip_atomic_fetch_add(p, v, __ATOMIC_RELAXED, __HIP_MEMORY_SCOPE_AGENT); }
__device__ __forceinline__ unsigned xb_xcc_id() { return (unsigned)__builtin_amdgcn_s_getreg((3 << 11) | 20) & 0xFu; }
#define XB_SPIN(cond, bar) do { unsigned _sp = 0; while (cond) { __builtin_amdgcn_s_sleep(1); \
    if ((++_sp & 255u) == 0u) { if (xb_ld(&(bar)[XB_TMO])) break; if (_sp > XB_SPIN_CAP) { atomicAdd(&(bar)[XB_TMO], 1u); break; } } } } while (0)

struct XcdBarrier {
    unsigned* bar; unsigned x;
    volatile LAS unsigned* st;
};

__device__ __forceinline__ XcdBarrier xcd_barrier_post(unsigned* bar, volatile LAS unsigned* st) {
    XcdBarrier b; b.bar = bar; b.x = xb_xcc_id(); b.st = st;
    if (threadIdx.x == 0) (void)xb_add(&bar[XB_XCNT(b.x)], 1u);
    return b;
}
__device__ __forceinline__ void xcd_barrier_complete(unsigned* bar, unsigned x, unsigned& nloc, unsigned& nx) {
    const unsigned G = gridDim.x * gridDim.y * gridDim.z;
    unsigned sum, cnt, mine, sp = 0u;
    for (;;) {
        sum = 0u; cnt = 0u; mine = 0u;
#pragma unroll
        for (unsigned j = 0; j < 16; ++j) { const unsigned c = xb_ld(&bar[XB_XCNT(j)]); sum += c; cnt += (c > 0u) ? 1u : 0u; mine = (j == x) ? c : mine; }
        if (sum == G) break;
        __builtin_amdgcn_s_sleep(1);
        if ((++sp & 255u) == 0u) { if (xb_ld(&bar[XB_TMO])) break; if (sp > XB_SPIN_CAP) { atomicAdd(&bar[XB_TMO], 1u); break; } }
    }
    nloc = mine > 0u ? mine : 1u; nx = cnt > 0u ? cnt : 1u;
}

__device__ __forceinline__ void xcd_barrier(const XcdBarrier& b) {
    asm volatile("s_waitcnt vmcnt(0)" ::: "memory");
    __syncthreads();
    if (threadIdx.x == 0) {
        unsigned* bar = b.bar;
        __builtin_amdgcn_s_waitcnt(0);
        unsigned nloc = b.st[0], nx = b.st[1];
        if (nloc == 0u) { xcd_barrier_complete(bar, b.x, nloc, nx); b.st[0] = nloc; b.st[1] = nx; }
        const unsigned old = xb_add(&bar[XB_XSUB(b.x)], 1u);
        const unsigned gen = old / nloc;
        if (old + 1u == (gen + 1u) * nloc) {
            __builtin_amdgcn_fence(__ATOMIC_RELEASE, "agent");
            asm volatile("s_waitcnt vmcnt(0)" ::: "memory");
            const unsigned og = xb_add(&bar[XB_TOP], 1u);
            const unsigned tg = og / nx;
            if (og + 1u == (tg + 1u) * nx) xb_add(&bar[XB_TOPGEN], 1u);
            else XB_SPIN(xb_ld(&bar[XB_TOPGEN]) == tg, bar);
            __builtin_amdgcn_fence(__ATOMIC_ACQUIRE, "agent");
            xb_add(&bar[XB_XGEN(b.x)], 1u);
            asm volatile("s_waitcnt vmcnt(0)" ::: "memory");
        } else {
            XB_SPIN(xb_ld(&bar[XB_XGEN(b.x)]) == gen, bar);
            __builtin_amdgcn_fence(__ATOMIC_ACQUIRE, "agent");
            asm volatile("s_waitcnt vmcnt(0)" ::: "memory");
        }
    }
    __syncthreads();
}
}
namespace pg8 {
#define PG8_LAS __attribute__((address_space(3)))
typedef unsigned short bf16_t;
typedef short bf16x8 __attribute__((ext_vector_type(8)));
typedef float f32x4 __attribute__((ext_vector_type(4)));
typedef unsigned u32x4 __attribute__((ext_vector_type(4)));
typedef unsigned u32x2 __attribute__((ext_vector_type(2)));
constexpr int BM = 256, BK = 64, HALF = 128, HTB = HALF * BK * 2  , STAGE_BYTES = 8 * HTB, NXCD = 8, WGM = 8;

__host__ __device__ __forceinline__ int lds_byte(int r, int c) { const int st = (r >> 4) * 2 + (c >> 5), rr = r & 15, cc = c & 31, ob = rr * 64 + cc * 2; return st * 1024 + (ob ^ (((ob >> 9) & 1) << 5)); }
__host__ __device__ __forceinline__ void stage_rc(int b, int& R, int& C) { const int st = b / 1024, sb = b % 1024, swz = sb ^ (((sb >> 9) & 1) << 5); R = (st >> 1) * 16 + swz / 64; C = (st & 1) * 32 + (swz % 64) / 2; }
__host__ __device__ __forceinline__ int perm32(int rho) { const int n = rho >> 4, i = rho & 15; return 8 * (i >> 2) + 4 * n + (i & 3); }

struct Unit { int pm, pn, aux0, aux1; };
struct Gemm { const bf16_t* A; const bf16_t* Bt; int M, N, K, lda, ldb, kstepA; };

struct StaticOrder {
    int nM, nN, nwg, G, c;
    __device__ void init(int M, int N, int G_, int c_) { nM = M / BM; nN = N / BM; nwg = nM * nN; G = G_; c = c_; }
    __device__ bool next(int i, Unit& u) const {
        const long L = (long)i * G + c; if (L >= nwg) return false;
        int wgid = (int)L; { const int q = nwg / NXCD, r = nwg % NXCD, xcd = wgid % NXCD, off = wgid / NXCD; wgid = (xcd < r ? xcd * (q + 1) : r * (q + 1) + (xcd - r) * q) + off; }
        const int nig = WGM * nN, gid = wgid / nig, fm = gid * WGM, gsz = (nM - fm) < WGM ? (nM - fm) : WGM;
        u.pm = fm + ((wgid % nig) % gsz); u.pn = (wgid % nig) / gsz; u.aux0 = 0; u.aux1 = 0; return true;
    }
    __device__ __forceinline__ const char* a_base(const Gemm& g, const Unit& u) const { return (const char*)g.A + (size_t)u.pm * BM * g.lda * 2; }
    __device__ __forceinline__ const char* b_base(const Gemm& g, const Unit& u) const { return (const char*)g.Bt + (size_t)u.pn * BM * g.ldb * 2; }
    __device__ __forceinline__ int a_row(const Unit&, int) const { return 0; }
};

typedef float f32x2_t __attribute__((ext_vector_type(2))); typedef __bf16 bf16x2_t __attribute__((ext_vector_type(2)));
__device__ __forceinline__ unsigned cvt_pk_bf16(float lo, float hi) { f32x2_t v = {lo, hi}; bf16x2_t b = __builtin_convertvector(v, bf16x2_t); return __builtin_bit_cast(unsigned, b); }


template <class Epi, class Sched, bool ALIGN_EPI = true, bool GATHER = false>
__device__ __forceinline__ void gemm_phase(PG8_LAS unsigned char* lds, const Gemm g, const Sched& S, const Epi& E) {
    int tid_ = threadIdx.x; asm volatile("" : "+v"(tid_));
    const int tid = tid_, wid = __builtin_amdgcn_readfirstlane(tid >> 6), lane = tid & 63, wr = wid >> 2, wc = wid & 3, fr = lane & 15, fq = lane >> 4;
    const int K = g.K, nt = K / BK;
    unsigned voffA[2], voffA1[2], voffB[2];
    int RA[2], CA[2];
#pragma unroll
    for (int i = 0; i < 2; ++i) { int R, C; stage_rc(tid * 16 + i * 8192, R, C); const int Rb = Epi::PERM ? ((R & ~31) + perm32(R & 31)) : R;
        RA[i] = R; CA[i] = C; voffA[i] = (unsigned)(R * g.lda + C) * 2u; voffA1[i] = voffA[i]; voffB[i] = (unsigned)(Rb * g.ldb + C) * 2u; }
    const size_t kstep = (size_t)(BK * 2);
    const size_t kstepA = (size_t)g.kstepA;
    const size_t hstepA = GATHER ? (size_t)0 : (size_t)HALF * g.lda * 2;
    const size_t hstepB = (size_t)HALF * g.ldb * 2;
    const unsigned ldsw = (unsigned)wid * 1024u;
    const int aoff = lds_byte(wr * 64 + fr, fq * 8), boff = lds_byte(wc * 32 + fr, fq * 8);
#define PG8_SA(b, h) (((b) * 2 + (h)) * HTB)
#define PG8_SB(b, h) ((4 + (b) * 2 + (h)) * HTB)
#define PG8_STAGE(bufoff, gbase, voff) do { _Pragma("unroll") for (int _i = 0; _i < 2; ++_i) \
        __builtin_amdgcn_global_load_lds((const unsigned*)((const char*)(gbase) + (voff)[_i]), (PG8_LAS unsigned*)(lds + (bufoff) + ldsw + _i * 8192), 16, 0, 0); } while (0)
#define PG8_STAGE_A0(bufoff, gbase) PG8_STAGE(bufoff, gbase, voffA)
#define PG8_STAGE_A1(bufoff, gbase) do { if constexpr (GATHER) { PG8_STAGE(bufoff, gbase, voffA1); } else { PG8_STAGE(bufoff, (gbase) + hstepA, voffA); } } while (0)
#define PG8_LDA(dst, b, h) do { _Pragma("unroll") for (int m = 0; m < 4; ++m) _Pragma("unroll") for (int k = 0; k < 2; ++k) dst[m][k] = *(const PG8_LAS bf16x8*)(lds + PG8_SA(b, h) + aoff + m * 2048 + k * 1024); } while (0)
#define PG8_LDB(dst, b, h) do { _Pragma("unroll") for (int n = 0; n < 2; ++n) _Pragma("unroll") for (int k = 0; k < 2; ++k) dst[n][k] = *(const PG8_LAS bf16x8*)(lds + PG8_SB(b, h) + boff + n * 2048 + k * 1024); } while (0)
#define PG8_MMA(ai, bj, At, Bt) do { __builtin_amdgcn_s_setprio(1); _Pragma("unroll") for (int m = 0; m < 4; ++m) _Pragma("unroll") for (int n = 0; n < 2; ++n) _Pragma("unroll") for (int k = 0; k < 2; ++k) \
        acc[ai][bj][m][n] = __builtin_amdgcn_mfma_f32_16x16x32_bf16(Bt[n][k], At[m][k], acc[ai][bj][m][n], 0, 0, 0); __builtin_amdgcn_s_setprio(0); } while (0)
#define PG8_WAIT_V(n) asm volatile("s_waitcnt vmcnt(" #n ")" ::: "memory")
#define PG8_WAIT_L(n) asm volatile("s_waitcnt lgkmcnt(" #n ")" ::: "memory")
#define PG8_BAR __builtin_amdgcn_s_barrier()
#define PG8_SCHED __builtin_amdgcn_sched_barrier(0)
    Unit cur, nxt; int ui = 0;
    if (!S.next(0, cur)) return;
    if constexpr (GATHER) {
#pragma unroll
        for (int i = 0; i < 2; ++i) { voffA[i] = (unsigned)(S.a_row(cur, RA[i]) * g.lda + CA[i]) * 2u; voffA1[i] = (unsigned)(S.a_row(cur, HALF + RA[i]) * g.lda + CA[i]) * 2u; }
    }
    f32x4 acc[2][2][4][2];
#pragma unroll
    for (int a = 0; a < 2; ++a)
#pragma unroll
        for (int b = 0; b < 2; ++b)
#pragma unroll
            for (int m = 0; m < 4; ++m)
#pragma unroll
                for (int n = 0; n < 2; ++n) acc[a][b][m][n] = (f32x4){0.f, 0.f, 0.f, 0.f};
    bf16x8 At[4][2], B0[2][2], B1[2][2];
    const char* cA = S.a_base(g, cur); const char* cB = S.b_base(g, cur);
    PG8_STAGE(PG8_SB(0, 0), cB, voffB); PG8_STAGE(PG8_SB(0, 1), cB + hstepB, voffB); PG8_STAGE_A0(PG8_SA(0, 0), cA); PG8_STAGE_A1(PG8_SA(0, 1), cA);
    if (wr == 1) PG8_BAR;
    PG8_WAIT_V(2); PG8_BAR;
    PG8_STAGE(PG8_SB(1, 0), cB + kstep, voffB); PG8_STAGE_A0(PG8_SA(1, 0), cA + kstepA); PG8_STAGE(PG8_SB(1, 1), cB + hstepB + kstep, voffB);
    PG8_WAIT_V(6); PG8_BAR;
    for (;;) {
        const bool has_next = GATHER ? false : S.next(ui + 1, nxt);
        const char* nA = has_next ? S.a_base(g, nxt) : cA; const char* nB = has_next ? S.b_base(g, nxt) : cB;
#pragma unroll 1
        for (int t = 0; t < nt; t += 2) {
            const bool last = (t == nt - 2);
            const char* a1 = cA + (size_t)(t + 1) * kstepA;
            const char* a2 = last ? nA : cA + (size_t)(t + 2) * kstepA; const char* b2 = last ? nB : cB + (size_t)(t + 2) * kstep;
            const char* a3 = a2 + kstepA; const char* b3 = b2 + kstep;
            PG8_LDB(B0, 0, 0); PG8_LDB(B1, 0, 1); PG8_SCHED; PG8_LDA(At, 0, 0); PG8_STAGE_A1(PG8_SA(1, 1), a1);
            PG8_WAIT_V(8); PG8_WAIT_L(0); PG8_BAR; PG8_MMA(0, 0, At, B0); PG8_MMA(0, 1, At, B1); PG8_BAR; PG8_SCHED;
            PG8_LDA(At, 0, 1); PG8_STAGE(PG8_SB(0, 0), b2, voffB); PG8_STAGE(PG8_SB(0, 1), b2 + hstepB, voffB); PG8_STAGE_A0(PG8_SA(0, 0), a2);
            PG8_WAIT_V(8); PG8_WAIT_L(0); PG8_BAR; PG8_MMA(1, 0, At, B0); PG8_MMA(1, 1, At, B1); PG8_BAR; PG8_SCHED;
            PG8_LDB(B0, 1, 0); PG8_LDB(B1, 1, 1); PG8_SCHED; PG8_LDA(At, 1, 0); PG8_STAGE_A1(PG8_SA(0, 1), a2);
            PG8_WAIT_V(8); PG8_WAIT_L(0); PG8_BAR; PG8_MMA(0, 0, At, B0); PG8_MMA(0, 1, At, B1); PG8_BAR; PG8_SCHED;
            PG8_LDA(At, 1, 1); PG8_STAGE(PG8_SB(1, 0), b3, voffB); PG8_STAGE(PG8_SB(1, 1), b3 + hstepB, voffB); PG8_STAGE_A0(PG8_SA(1, 0), a3);
            PG8_WAIT_V(8); PG8_WAIT_L(0); PG8_BAR; PG8_MMA(1, 0, At, B0); PG8_MMA(1, 1, At, B1); PG8_BAR; PG8_SCHED;
        }
        if constexpr (ALIGN_EPI) { if (wr == 0) PG8_BAR; }
        E(acc, cur, wr, wc, fr, fq);
        if (!has_next) break;
#pragma unroll
        for (int a = 0; a < 2; ++a)
#pragma unroll
            for (int b = 0; b < 2; ++b)
#pragma unroll
                for (int m = 0; m < 4; ++m)
#pragma unroll
                    for (int n = 0; n < 2; ++n) acc[a][b][m][n] = (f32x4){0.f, 0.f, 0.f, 0.f};
        cur = nxt; cA = nA; cB = nB; ++ui;
        if constexpr (ALIGN_EPI) { if (wr == 1) PG8_BAR; }
    }
    PG8_WAIT_V(0);
    if constexpr (!ALIGN_EPI) { if (wr == 0) PG8_BAR; }
    PG8_BAR;
#undef PG8_SA
#undef PG8_SB
#undef PG8_STAGE
#undef PG8_STAGE_A0
#undef PG8_STAGE_A1
#undef PG8_LDA
#undef PG8_LDB
#undef PG8_MMA
#undef PG8_WAIT_V
#undef PG8_WAIT_L
#undef PG8_BAR
#undef PG8_SCHED
}
}
namespace fx {
using nv::u16; using nv::Bufs; using nv::Inputs;
using pg8::f32x4; using pg8::u32x4; using pg8::Unit;
#define LAS __attribute__((address_space(3)))
static_assert(nv::DM == 1024 && nv::NB == 8 && nv::S == 4096 && nv::MH == 256 && nv::PLE == 256, "fast phases are written for the full-size problem");
constexpr int NTOK = nv::NTOK, DM = 1024;
constexpr int INW_PAD = 6144;
constexpr int C_Z = 1280, C_XBC = 2304, C_BG = 3840, C_NG = 5888, C_DT = 5912, C_END = 5928;

struct WBufs { u16 *WinT, *WaT, *WbT, *WoutT, *PleGT, *PlePT, *WguT, *WdT, *PB; };
__host__ __device__ inline size_t carve_w(WBufs& W, unsigned char* ws, size_t off) {
  auto take = [&](size_t bytes) { unsigned char* r = ws + off; off += (bytes + 255) / 256 * 256; return r; };
  W.WinT = (u16*)take((size_t)INW_PAD * 1024 * 2); W.WaT = (u16*)take((size_t)1024 * 512 * 2); W.WbT = (u16*)take((size_t)1024 * 1024 * 2); W.WoutT = (u16*)take((size_t)1024 * 1024 * 2);
  W.PleGT = (u16*)take((size_t)1024 * 1024 * 2); W.PlePT = (u16*)take((size_t)1024 * 256 * 2); W.WguT = (u16*)take((size_t)32 * 512 * 1024 * 2); W.WdT = (u16*)take((size_t)32 * 1024 * 256 * 2);
  W.PB = (u16*)take((size_t)NTOK * 256 * 2);
  return off;
}

__device__ __forceinline__ int otid() { int t = threadIdx.x; asm volatile("" : "+v"(t)); return t; }
__device__ __forceinline__ int obid() { int b = blockIdx.x; asm volatile("" : "+s"(b)); return b; }
__device__ __forceinline__ float fsig(float x) { return __builtin_amdgcn_rcpf(1.0f + __expf(-x)); }
__device__ __forceinline__ float fsoftplus(float x) { const float e = __expf(x); return x > 20.f ? x : (e < 0.0625f ? e * (1.f - e * (0.5f - e * (0.33333333f - 0.25f * e))) : __logf(1.0f + e)); }
__device__ __forceinline__ unsigned pk2(float lo, float hi) { return pg8::cvt_pk_bf16(lo, hi); }
__device__ __forceinline__ void store8(u16* p, const float (&v)[8]) { u32x4 w; w.x = pk2(v[0], v[1]); w.y = pk2(v[2], v[3]); w.z = pk2(v[4], v[5]); w.w = pk2(v[6], v[7]); *(u32x4*)p = w; }
__device__ __forceinline__ void load8(const u16* p, float (&v)[8]) { const u32x4 w = *(const u32x4*)p;
  v[0] = __uint_as_float(w.x << 16); v[1] = __uint_as_float(w.x & 0xffff0000u); v[2] = __uint_as_float(w.y << 16); v[3] = __uint_as_float(w.y & 0xffff0000u);
  v[4] = __uint_as_float(w.z << 16); v[5] = __uint_as_float(w.z & 0xffff0000u); v[6] = __uint_as_float(w.w << 16); v[7] = __uint_as_float(w.w & 0xffff0000u); }

__device__ __forceinline__ float wave_sum(float v) {
#pragma unroll
  for (int o = 1; o < 64; o <<= 1) v += __shfl_xor(v, o);
  return v; }
__device__ __forceinline__ void rms_row_to_bf16(const float* xrow, const float* gain, u16* orow, int lane) {
  const f32x4* xr = (const f32x4*)xrow + lane; const f32x4* gr = (const f32x4*)gain + lane;
  f32x4 v[4]; float s = 0.f;
#pragma unroll
  for (int j = 0; j < 4; ++j) { v[j] = xr[64 * j]; s += (v[j].x * v[j].x + v[j].y * v[j].y) + (v[j].z * v[j].z + v[j].w * v[j].w); }
  const float rs = 1.0f / sqrtf(wave_sum(s) * (1.f / 1024.f) + nv::EPS);
  unsigned long long* o8 = (unsigned long long*)orow + lane;
#pragma unroll
  for (int j = 0; j < 4; ++j) { const f32x4 g = gr[64 * j]; o8[64 * j] = (unsigned long long)pk2(v[j].x * rs * g.x, v[j].y * rs * g.y) | ((unsigned long long)pk2(v[j].z * rs * g.z, v[j].w * rs * g.w) << 32); }
}
__device__ __forceinline__ void phase_rms_rows(const float* x, const float* gain, u16* out) {
  const int tid = otid(), lane = tid & 63, gw = obid() * 8 + (tid >> 6), ngw = gridDim.x * 8;
  for (int r = gw; r < NTOK; r += 4 * ngw) { f32x4 v[4][4]; float s[4];
#pragma unroll
    for (int q = 0; q < 4; ++q) { const int rq = (r + q * ngw < NTOK) ? r + q * ngw : r; const f32x4* xr = (const f32x4*)(x + (size_t)rq * 1024) + lane;
#pragma unroll
      for (int j = 0; j < 4; ++j) v[q][j] = xr[64 * j]; }
#pragma unroll
    for (int q = 0; q < 4; ++q) { s[q] = 0.f;
#pragma unroll
      for (int j = 0; j < 4; ++j) s[q] += (v[q][j].x * v[q][j].x + v[q][j].y * v[q][j].y) + (v[q][j].z * v[q][j].z + v[q][j].w * v[q][j].w);
      s[q] = 1.0f / sqrtf(wave_sum(s[q]) * (1.f / 1024.f) + nv::EPS); }
#pragma unroll
    for (int q = 0; q < 4; ++q) { if (r + q * ngw >= NTOK) break; unsigned long long* o8 = (unsigned long long*)(out + (size_t)(r + q * ngw) * 1024) + lane; const f32x4* gr = (const f32x4*)gain + lane;
#pragma unroll
      for (int j = 0; j < 4; ++j) { const f32x4 g = gr[64 * j]; o8[64 * j] = (unsigned long long)pk2(v[q][j].x * s[q] * g.x, v[q][j].y * s[q] * g.y) | ((unsigned long long)pk2(v[q][j].z * s[q] * g.z, v[q][j].w * s[q] * g.w) << 32); } } }
}
__device__ __forceinline__ void phase_rms_rows_bf(const u16* x, const float* gain, u16* out) {
  const int tid = otid(), lane = tid & 63, gw = obid() * 8 + (tid >> 6), ngw = gridDim.x * 8;
  for (int r = gw; r < NTOK; r += 4 * ngw) { u32x4 w[4][2]; float s[4];
#pragma unroll
    for (int q = 0; q < 4; ++q) { const int rq = (r + q * ngw < NTOK) ? r + q * ngw : r; const u32x4* xr = (const u32x4*)(x + (size_t)rq * 1024) + lane; w[q][0] = xr[0]; w[q][1] = xr[64]; }
#pragma unroll
    for (int q = 0; q < 4; ++q) { s[q] = 0.f;
#pragma unroll
      for (int j = 0; j < 2; ++j) { const unsigned e[4] = {w[q][j].x, w[q][j].y, w[q][j].z, w[q][j].w};
#pragma unroll
        for (int i = 0; i < 4; ++i) { const float lo = __uint_as_float(e[i] << 16), hi = __uint_as_float(e[i] & 0xffff0000u); s[q] += lo * lo + hi * hi; } }
      s[q] = 1.0f / sqrtf(wave_sum(s[q]) * (1.f / 1024.f) + nv::EPS); }
#pragma unroll
    for (int q = 0; q < 4; ++q) { if (r + q * ngw >= NTOK) break; u32x4* o = (u32x4*)(out + (size_t)(r + q * ngw) * 1024) + lane;
#pragma unroll
      for (int j = 0; j < 2; ++j) { const f32x4 g0 = *(const f32x4*)(gain + 512 * j + 8 * lane), g1 = *(const f32x4*)(gain + 512 * j + 8 * lane + 4); const u32x4 e = w[q][j]; const float rs = s[q]; u32x4 ov;
        ov.x = pk2(__uint_as_float(e.x << 16) * rs * g0.x, __uint_as_float(e.x & 0xffff0000u) * rs * g0.y); ov.y = pk2(__uint_as_float(e.y << 16) * rs * g0.z, __uint_as_float(e.y & 0xffff0000u) * rs * g0.w);
        ov.z = pk2(__uint_as_float(e.z << 16) * rs * g1.x, __uint_as_float(e.z & 0xffff0000u) * rs * g1.y); ov.w = pk2(__uint_as_float(e.w << 16) * rs * g1.z, __uint_as_float(e.w & 0xffff0000u) * rs * g1.w);
        o[64 * j] = ov; } } }
}
template <class CP> __device__ __forceinline__ void transpose_item(LAS float* scr, const CP cp, u16* dst, int K, int n0, int k0, int lane) {
  { const float* p = cp(n0 + (lane & 31));
#pragma unroll 8
    for (int i = 0; i < 32; ++i) { const int kk = 2 * i + (lane >> 5); scr[kk * 33 + (lane & 31)] = p ? p[(size_t)(k0 + kk) * cp.ld] : 0.f; } }
  asm volatile("s_waitcnt lgkmcnt(0)" ::: "memory");
  const int c = lane & 7;
#pragma unroll
  for (int j = 0; j < 4; ++j) { const int n = (lane >> 3) + 8 * j; const LAS float* s = scr + (8 * c) * 33 + n;
    u32x4 o; o.x = pk2(s[0 * 33], s[1 * 33]); o.y = pk2(s[2 * 33], s[3 * 33]); o.z = pk2(s[4 * 33], s[5 * 33]); o.w = pk2(s[6 * 33], s[7 * 33]);
    *(u32x4*)(dst + (size_t)(n0 + n) * K + k0 + 8 * c) = o; }
  asm volatile("s_waitcnt lgkmcnt(0)" ::: "memory");
}
struct CpIdent { const float* src; int ld; __device__ const float* operator()(int n) const { return src + n; } };
struct CpInProj { const float* src; int ld; __device__ const float* operator()(int n) const {
  int c; if (n < C_Z) c = n; else if (n < C_XBC) c = nv::O_Z + (n - C_Z); else if (n < C_BG) c = nv::O_XBC + (n - C_XBC); else if (n < C_NG) c = nv::O_BG + (n - C_BG); else if (n < C_DT) c = nv::O_NG + (n - C_NG); else if (n < C_END) c = nv::O_DT + (n - C_DT); else return nullptr;
  return src + c; } };
struct CpGU { const float* gate; long updelta; int ld; __device__ const float* operator()(int n) const { const int tile = n >> 8, r = n & 255; return gate + (r < 128 ? 0L : updelta) + tile * 128 + (r & 127); } };

struct WJob { const float* src; int ld; u16* dst; int K, n0, k0; };
__device__ __forceinline__ WJob wjob_decode(int t, const Inputs& I, const WBufs& W, int lane) {
  constexpr int T_IN = (INW_PAD / 32) * 16, T_A = 32 * 8, T_B = 32 * 16, T_O = 32 * 16, T_PG = 32 * 16, T_PP = 32 * 4, T_GU = 32 * 16 * 16;
  WJob j; int r = t; const int c = lane & 31;
  if (r < T_IN) { CpInProj cp{I.w_in, nv::INW}; j.n0 = (r / 16) * 32; j.k0 = (r % 16) * 64; j.src = cp(j.n0 + c); j.ld = nv::INW; j.dst = W.WinT; j.K = 1024; return j; } r -= T_IN;
  if (r < T_A) { j.n0 = (r / 8) * 32; j.k0 = (r % 8) * 64; j.src = I.w_a + j.n0 + c; j.ld = 1024; j.dst = W.WaT; j.K = 512; return j; } r -= T_A;
  if (r < T_B) { j.n0 = (r / 16) * 32; j.k0 = (r % 16) * 64; j.src = I.w_b + j.n0 + c; j.ld = 1024; j.dst = W.WbT; j.K = 1024; return j; } r -= T_B;
  if (r < T_O) { j.n0 = (r / 16) * 32; j.k0 = (r % 16) * 64; j.src = I.w_out + j.n0 + c; j.ld = 1024; j.dst = W.WoutT; j.K = 1024; return j; } r -= T_O;
  if (r < T_PG) { j.n0 = (r / 16) * 32; j.k0 = (r % 16) * 64; j.src = I.ple_wg + j.n0 + c; j.ld = 1024; j.dst = W.PleGT; j.K = 1024; return j; } r -= T_PG;
  if (r < T_PP) { j.n0 = (r / 4) * 32; j.k0 = (r % 4) * 64; j.src = I.ple_wp + j.n0 + c; j.ld = 1024; j.dst = W.PlePT; j.K = 256; return j; } r -= T_PP;
  if (r < T_GU) { const int e = r / 256, q = r % 256; CpGU cp{I.w_gate + (size_t)e * 1024 * 256, (long)(I.w_up - I.w_gate), 256}; j.n0 = (q / 16) * 32; j.k0 = (q % 16) * 64; j.src = cp(j.n0 + c); j.ld = 256; j.dst = W.WguT + (size_t)e * 512 * 1024; j.K = 1024; return j; } r -= T_GU;
  { const int e = r / 128, q = r % 128; j.n0 = (q / 4) * 32; j.k0 = (q % 4) * 64; j.src = I.w_down + (size_t)e * 256 * 1024 + j.n0 + c; j.ld = 1024; j.dst = W.WdT + (size_t)e * 1024 * 256; j.K = 256; return j; }
}
__device__ __forceinline__ void phase_prologue(LAS unsigned char* lds, const Inputs& I, const Bufs& B, const WBufs& W) {
  const int tid = otid(), lane = tid & 63, wv = tid >> 6, gw = obid() * 8 + wv, ngw = gridDim.x * 8;
  LAS float* scr = (LAS float*)lds + wv * (64 * 33);
  constexpr int TOT = (INW_PAD / 32) * 16 + 32 * 8 + 32 * 16 * 3 + 32 * 4 + 32 * 16 * 16 + 32 * 32 * 4;
  float cur[32];
  int t = gw; WJob jb;
  if (t < TOT) { jb = wjob_decode(t, I, W, lane);
#pragma unroll
    for (int i = 0; i < 32; ++i) cur[i] = jb.src ? jb.src[(size_t)(jb.k0 + 2 * i + (lane >> 5)) * jb.ld] : 0.f; }
  while (t < TOT) { const int tn = t + ngw; WJob jn = jb; float nxt[32];
    if (tn < TOT) { jn = wjob_decode(tn, I, W, lane);
#pragma unroll
      for (int i = 0; i < 32; ++i) nxt[i] = jn.src ? jn.src[(size_t)(jn.k0 + 2 * i + (lane >> 5)) * jn.ld] : 0.f; }
#pragma unroll
    for (int i = 0; i < 32; ++i) scr[(2 * i + (lane >> 5)) * 33 + (lane & 31)] = cur[i];
    asm volatile("s_waitcnt lgkmcnt(0)" ::: "memory");
    { const int c = lane & 7;
#pragma unroll
      for (int j = 0; j < 4; ++j) { const int n = (lane >> 3) + 8 * j; const LAS float* s = scr + (8 * c) * 33 + n;
        u32x4 o; o.x = pk2(s[0 * 33], s[1 * 33]); o.y = pk2(s[2 * 33], s[3 * 33]); o.z = pk2(s[4 * 33], s[5 * 33]); o.w = pk2(s[6 * 33], s[7 * 33]);
        *(u32x4*)(jb.dst + (size_t)(jb.n0 + n) * jb.K + jb.k0 + 8 * c) = o; } }
    asm volatile("s_waitcnt lgkmcnt(0)" ::: "memory");
    if (tn < TOT) {
#pragma unroll
      for (int i = 0; i < 32; ++i) cur[i] = nxt[i]; }
    jb = jn; t = tn; }
}
__device__ __forceinline__ void prologue_pb(const Inputs& I, const WBufs& W) {
  for (long i = blockIdx.x * 512L + otid(); i < (long)NTOK * 256 / 8; i += (long)gridDim.x * 512L) { const f32x4 a = ((const f32x4*)I.p)[2 * i], b = ((const f32x4*)I.p)[2 * i + 1];
    u32x4 o; o.x = pk2(a.x, a.y); o.y = pk2(a.z, a.w); o.z = pk2(b.x, b.y); o.w = pk2(b.z, b.w); ((u32x4*)W.PB)[i] = o; }
}

template <class F> struct Epi8 { static constexpr bool PERM = true; F f;
  __device__ __forceinline__ void operator()(const f32x4 (&acc)[2][2][4][2], const Unit& u, int wr, int wc, int fr, int fq) const {
#pragma unroll
    for (int ai = 0; ai < 2; ++ai)
#pragma unroll
      for (int m = 0; m < 4; ++m) { const int row = u.pm * 256 + ai * 128 + wr * 64 + m * 16 + fr;
#pragma unroll
        for (int bj = 0; bj < 2; ++bj) { const int col = u.pn * 256 + bj * 128 + wc * 32 + 8 * fq; const f32x4 a = acc[ai][bj][m][0], b = acc[ai][bj][m][1];
          const float v[8] = {a.x, a.y, a.z, a.w, b.x, b.y, b.z, b.w}; f(u, row, col, v); }
        if (m & 1) asm volatile("" ::: "memory"); } } };

struct FInProj { u16* QKV; u16* Z; u16* XBC; u16* BG; float* NG; float* DT; const float* dt_bias;
  __device__ __forceinline__ void operator()(const Unit&, int r, int c, const float (&v)[8]) const {
    if (c < C_Z) store8(QKV + (size_t)r * 1280 + c, v);
    else if (c < C_XBC) store8(Z + (size_t)r * 1024 + (c - C_Z), v);
    else if (c < C_BG) store8(XBC + (size_t)r * 1536 + (c - C_XBC), v);
    else if (c < C_NG) { float s[8];
#pragma unroll
      for (int i = 0; i < 8; ++i) s[i] = fsig(v[i]);
      store8(BG + (size_t)r * 2048 + (c - C_BG), s); }
    else if (c < C_DT) { float* o = NG + (size_t)r * 24 + (c - C_NG);
#pragma unroll
      for (int i = 0; i < 8; ++i) o[i] = fsig(v[i]); }
    else if (c < C_END) { float* o = DT + (size_t)r * 16 + (c - C_DT); const float* bi = dt_bias + (c - C_DT);
#pragma unroll
      for (int i = 0; i < 8; ++i) o[i] = fsoftplus(v[i] + bi[i]); } } };
struct FStoreBf { u16* o; int ld; __device__ __forceinline__ void operator()(const Unit&, int r, int c, const float (&v)[8]) const { store8(o + (size_t)r * ld + c, v); } };
struct FMerge { const u16* t1; const u16* bg; u16* o;
  __device__ __forceinline__ void operator()(const Unit&, int r, int c, const float (&v)[8]) const { float t[8], ga[8], gb[8], m[8]; load8(t1 + (size_t)r * 1024 + c, t); load8(bg + (size_t)r * 2048 + c, ga); load8(bg + (size_t)r * 2048 + 1024 + c, gb);
#pragma unroll
    for (int i = 0; i < 8; ++i) m[i] = ga[i] * t[i] + gb[i] * v[i];
    store8(o + (size_t)r * 1024 + c, m); } };
struct FResid { const float* x; u16* o;
  __device__ __forceinline__ void operator()(const Unit&, int r, int c, const float (&v)[8]) const { const f32x4 a = *(const f32x4*)(x + (size_t)r * 1024 + c), b = *(const f32x4*)(x + (size_t)r * 1024 + c + 4);
    const float t[8] = {a.x + v[0], a.y + v[1], a.z + v[2], a.w + v[3], b.x + v[4], b.y + v[5], b.z + v[6], b.w + v[7]}; store8(o + (size_t)r * 1024 + c, t); } };
struct FPle { const u16* x2; float* o; const u16* pp;
  __device__ __forceinline__ void operator()(const Unit&, int r, int c, const float (&v)[8]) const { float p[8], x[8]; load8(pp + (size_t)r * 1024 + c, p); load8(x2 + (size_t)r * 1024 + c, x); float* xp = o + (size_t)r * 1024 + c;
    *(f32x4*)xp = (f32x4){x[0] + fsig(v[0]) * p[0], x[1] + fsig(v[1]) * p[1], x[2] + fsig(v[2]) * p[2], x[3] + fsig(v[3]) * p[3]};
    *(f32x4*)(xp + 4) = (f32x4){x[4] + fsig(v[4]) * p[4], x[5] + fsig(v[5]) * p[5], x[6] + fsig(v[6]) * p[6], x[7] + fsig(v[7]) * p[7]}; } };

template <class F, bool ALIGN = true> __device__ __forceinline__ void dense_gemm(LAS unsigned char* lds, const u16* A, int lda, const u16* Bt, int ldb, int M, int N, int K, const F& f) {
  pg8::Gemm g{A, Bt, M, N, K, lda, ldb, 128}; pg8::StaticOrder S; S.init(M, N, (int)gridDim.x, (int)blockIdx.x); Epi8<F> E{f};
  pg8::gemm_phase<Epi8<F>, pg8::StaticOrder, ALIGN, false>(lds, g, S, E);
}
}
namespace fx {
constexpr int LIST_CAP = 32768;
constexpr int LDS_TAB = 131072;
struct MoeBufs { float* LOGITS; int* CNT; int* LIST; int* ASG; u16* MOEOUT; u16* WrT; float* SSQ; };
__host__ __device__ inline size_t carve_moe(MoeBufs& M, const Bufs& B, unsigned char* ws, size_t off) {
  auto take = [&](size_t bytes) { unsigned char* r = ws + off; off += (bytes + 255) / 256 * 256; return r; };
  M.LOGITS = (float*)take((size_t)NTOK * 64 * 4); M.CNT = (int*)take(32 * 256); M.LIST = (int*)take((size_t)32 * LIST_CAP * 4); M.WrT = (u16*)take((size_t)256 * 1024 * 2); M.ASG = (int*)take((size_t)NTOK * 2 * 4); M.SSQ = (float*)take((size_t)NTOK * 4);
  M.MOEOUT = B.QKV;
  return off;
}
__device__ __forceinline__ void prologue_moe(const Inputs& I, const MoeBufs& M) {
  for (long i = blockIdx.x * 512L + otid(); i < 256L * 1024; i += (long)gridDim.x * 512L) { const int n = (int)(i >> 10), k = (int)(i & 1023);
    float v = 0.f; if (n < 4) v = I.w_group[k * 4 + n]; else if (n < 36) v = I.w_expert[k * 32 + (n - 4)];
    M.WrT[i] = nv::f2bf(v); }
  if (blockIdx.x == 0 && threadIdx.x < 32) M.CNT[threadIdx.x * 64] = 0;
  for (int i = blockIdx.x * 512 + otid(); i < NTOK; i += gridDim.x * 512) M.SSQ[i] = 0.f;
}
struct FLogits { float* o; __device__ __forceinline__ void operator()(const Unit&, int r, int c, const float (&v)[8]) const { if (c < 40) { *(f32x4*)(o + (size_t)r * 64 + c) = (f32x4){v[0], v[1], v[2], v[3]}; *(f32x4*)(o + (size_t)r * 64 + c + 4) = (f32x4){v[4], v[5], v[6], v[7]}; } } };
__device__ __forceinline__ void phase_route(LAS unsigned char* lds, const Inputs& I, const Bufs& B, const MoeBufs& M) {
  LAS int* lcnt = (LAS int*)lds; LAS int* lbase = lcnt + 32; const int tid = otid();
  for (int blk = blockIdx.x; blk < NTOK / 128; blk += gridDim.x) {
    if (tid < 32) lcnt[tid] = 0;
    __syncthreads();
    int e0 = 0, e1 = 0, r0 = 0, r1 = 0; float w0 = 0.f, w1 = 0.f; const int tok = blk * 128 + tid;
    if (tid < 128) { const float* lg = M.LOGITS + (size_t)tok * 64;
      const float rsd = 1.0f;
      const f32x4 g4 = *(const f32x4*)lg; const float g0 = rsd * g4.x + I.b_group[0], g1 = rsd * g4.y + I.b_group[1], g2 = rsd * g4.z + I.b_group[2], g3 = rsd * g4.w + I.b_group[3];
      int gi = 0; float gm = g0; if (g1 > gm) { gm = g1; gi = 1; } if (g2 > gm) { gm = g2; gi = 2; } if (g3 > gm) { gm = g3; gi = 3; }
      const float grp_w = 1.0f / (expf(g0 - gm) + expf(g1 - gm) + expf(g2 - gm) + expf(g3 - gm));
      const f32x4 ea = *(const f32x4*)(lg + 4 + gi * 8), eb = *(const f32x4*)(lg + 8 + gi * 8); const f32x4 ba = *(const f32x4*)(I.b_expert + gi * 8), bb = *(const f32x4*)(I.b_expert + gi * 8 + 4);
      const float el[8] = {rsd * ea.x + ba.x, rsd * ea.y + ba.y, rsd * ea.z + ba.z, rsd * ea.w + ba.w, rsd * eb.x + bb.x, rsd * eb.y + bb.y, rsd * eb.z + bb.z, rsd * eb.w + bb.w};
      int i0 = 0; float m0 = el[0];
#pragma unroll
      for (int j = 1; j < 8; ++j) if (el[j] > m0) { m0 = el[j]; i0 = j; }
      int i1 = -1; float m1 = -3.0e38f;
#pragma unroll
      for (int j = 0; j < 8; ++j) if (j != i0 && el[j] > m1) { m1 = el[j]; i1 = j; }
      const float r = expf(m1 - m0); w0 = grp_w / (1.0f + r); w1 = grp_w * r / (1.0f + r);
      e0 = gi * 8 + i0; e1 = gi * 8 + i1;
      r0 = __hip_atomic_fetch_add(lcnt + e0, 1, __ATOMIC_RELAXED, __HIP_MEMORY_SCOPE_WORKGROUP); r1 = __hip_atomic_fetch_add(lcnt + e1, 1, __ATOMIC_RELAXED, __HIP_MEMORY_SCOPE_WORKGROUP); }
    __syncthreads();
    if (tid < 32) { const int n = lcnt[tid]; lbase[tid] = n > 0 ? atomicAdd(&M.CNT[tid * 64], n) : 0; }
    __syncthreads();
    if (tid < 128) { const int p0 = lbase[e0] + r0, p1 = lbase[e1] + r1;
      M.LIST[e0 * LIST_CAP + p0] = tok * 2; M.LIST[e1 * LIST_CAP + p1] = tok * 2 + 1; M.ASG[tok * 2] = (e0 << 16) | p0; M.ASG[tok * 2 + 1] = (e1 << 16) | p1; B.EW[tok * 2] = w0; B.EW[tok * 2 + 1] = w1; }
    __syncthreads(); }
}
__device__ __forceinline__ void build_tile_table(LAS unsigned char* lds, const MoeBufs& M) {
  LAS int* tab = (LAS int*)(lds + LDS_TAB);
  if (threadIdx.x == 0) { int acc = 0; for (int e = 0; e < 32; ++e) { tab[e] = acc; acc += (M.CNT[e * 64] + 255) >> 8; } tab[32] = acc; }
  __syncthreads();
}
__device__ __forceinline__ int tile_expert(const LAS int* tab, int tile) { int e = 0;
#pragma unroll 1
  for (int j = 1; j < 32; ++j) if (tab[j] <= tile) e = j;
  return e; }

struct SchedGU { const int* list; int tile, ct, lbase, nvalid, e;
  __device__ bool next(int i, Unit& u) const { if (i > 0) return false; u.pm = tile; u.pn = ct; u.aux0 = lbase; u.aux1 = nvalid; return true; }
  __device__ __forceinline__ const char* a_base(const pg8::Gemm& g, const Unit&) const { return (const char*)g.A; }
  __device__ __forceinline__ const char* b_base(const pg8::Gemm& g, const Unit&) const { return (const char*)g.Bt + ((size_t)e * 512 + (size_t)ct * 256) * 1024 * 2; }
  __device__ __forceinline__ int a_row(const Unit&, int r) const { return r < nvalid ? (list[lbase + r] >> 1) : 0; } };
struct EpiGU { static constexpr bool PERM = true; u16* act; const int* list; const float* ssq;
  __device__ __forceinline__ void operator()(const f32x4 (&acc)[2][2][4][2], const Unit& u, int wr, int wc, int fr, int fq) const {
#pragma unroll
    for (int ai = 0; ai < 2; ++ai)
#pragma unroll
      for (int m = 0; m < 4; ++m) { const int r = ai * 128 + wr * 64 + m * 16 + fr; const float rs = 1.0f;
        const f32x4 g0 = acc[ai][0][m][0] * rs, g1 = acc[ai][0][m][1] * rs, u0 = acc[ai][1][m][0] * rs, u1 = acc[ai][1][m][1] * rs;
        const float a[8] = {g0.x * fsig(g0.x) * u0.x, g0.y * fsig(g0.y) * u0.y, g0.z * fsig(g0.z) * u0.z, g0.w * fsig(g0.w) * u0.w, g1.x * fsig(g1.x) * u1.x, g1.y * fsig(g1.y) * u1.y, g1.z * fsig(g1.z) * u1.z, g1.w * fsig(g1.w) * u1.w};
        store8(act + ((size_t)u.pm * 256 + r) * 256 + u.pn * 128 + wc * 32 + 8 * fq, a);
        if (m & 1) asm volatile("" ::: "memory"); } } };
__device__ __forceinline__ void phase_moe_gu(LAS unsigned char* lds, const Bufs& B, const WBufs& W, const MoeBufs& M) {
  const LAS int* tab = (const LAS int*)(lds + LDS_TAB); const int T = tab[32];
  for (int L = blockIdx.x; L < T * 2; L += gridDim.x) { const int tile = L >> 1, ct = L & 1, e = __builtin_amdgcn_readfirstlane(tile_expert(tab, tile)), rt = tile - __builtin_amdgcn_readfirstlane(tab[e]); int nvalid = __builtin_amdgcn_readfirstlane(M.CNT[e * 64]) - rt * 256; nvalid = nvalid > 256 ? 256 : nvalid;
    pg8::Gemm g{B.H2, W.WguT, 256, 256, 1024, 1024, 1024, 128}; SchedGU S{M.LIST, tile, ct, e * LIST_CAP + rt * 256, nvalid, e}; EpiGU E{B.ACT, M.LIST, M.SSQ};
    pg8::gemm_phase<EpiGU, SchedGU, true, true>(lds, g, S, E); }
}
struct SchedD { const LAS int* tab; int T4, G, c;
  __device__ bool next(int i, Unit& u) const { const int L = i * G + c; if (L >= T4) return false; const int tile = L >> 2; u.pm = tile; u.pn = L & 3; u.aux0 = __builtin_amdgcn_readfirstlane(tile_expert(tab, tile)); u.aux1 = 0; return true; }
  __device__ __forceinline__ const char* a_base(const pg8::Gemm& g, const Unit& u) const { return (const char*)g.A + (size_t)u.pm * 256 * 256 * 2; }
  __device__ __forceinline__ const char* b_base(const pg8::Gemm& g, const Unit& u) const { return (const char*)g.Bt + ((size_t)u.aux0 * 1024 + (size_t)u.pn * 256) * 256 * 2; }
  __device__ __forceinline__ int a_row(const Unit&, int) const { return 0; } };
__device__ __forceinline__ void phase_moe_down(LAS unsigned char* lds, const Bufs& B, const WBufs& W, const MoeBufs& M) {
  const LAS int* tab = (const LAS int*)(lds + LDS_TAB);
  pg8::Gemm g{B.ACT, W.WdT, 256, 1024, 256, 256, 256, 128}; SchedD S{tab, tab[32] * 4, (int)gridDim.x, (int)blockIdx.x}; Epi8<FStoreBf> E{FStoreBf{M.MOEOUT, 1024}};
  pg8::gemm_phase<Epi8<FStoreBf>, SchedD, true, false>(lds, g, S, E);
}
__device__ __forceinline__ void phase_moe_combine(LAS unsigned char* lds, const u16* x1, u16* x2, const MoeBufs& M, const float* ew, const float* gain, u16* hout) {
  const LAS int* tab = (const LAS int*)(lds + LDS_TAB);
  const int tid = otid(), lane = tid & 63, gw = obid() * 8 + (tid >> 6), ngw = gridDim.x * 8;
  for (int tk = gw; tk < NTOK; tk += 2 * ngw) { float v[2][2][8]; float rs[2];
    u32x4 xw[2][2], a[2][2], b[2][2]; float w0[2], w1[2];
#pragma unroll
    for (int q = 0; q < 2; ++q) { const int tok = (tk + q * ngw < NTOK) ? tk + q * ngw : tk; const int a0 = M.ASG[tok * 2], a1 = M.ASG[tok * 2 + 1]; w0[q] = ew[tok * 2]; w1[q] = ew[tok * 2 + 1];
      const int s0 = (tab[a0 >> 16] + ((a0 & 0xffff) >> 8)) * 256 + (a0 & 255), s1 = (tab[a1 >> 16] + ((a1 & 0xffff) >> 8)) * 256 + (a1 & 255);
      const u32x4* xr = (const u32x4*)(x1 + (size_t)tok * 1024) + lane; const u32x4* o0 = (const u32x4*)(M.MOEOUT + (size_t)s0 * 1024) + lane; const u32x4* o1 = (const u32x4*)(M.MOEOUT + (size_t)s1 * 1024) + lane;
#pragma unroll
      for (int j = 0; j < 2; ++j) { xw[q][j] = xr[64 * j]; a[q][j] = o0[64 * j]; b[q][j] = o1[64 * j]; } }
#pragma unroll
    for (int q = 0; q < 2; ++q) { float s = 0.f;
#pragma unroll
      for (int j = 0; j < 2; ++j) { const unsigned xe[4] = {xw[q][j].x, xw[q][j].y, xw[q][j].z, xw[q][j].w}, ae[4] = {a[q][j].x, a[q][j].y, a[q][j].z, a[q][j].w}, be[4] = {b[q][j].x, b[q][j].y, b[q][j].z, b[q][j].w};
#pragma unroll
        for (int i = 0; i < 4; ++i) { const float lo = __uint_as_float(xe[i] << 16) + (w0[q] * __uint_as_float(ae[i] << 16) + w1[q] * __uint_as_float(be[i] << 16));
          const float hi = __uint_as_float(xe[i] & 0xffff0000u) + (w0[q] * __uint_as_float(ae[i] & 0xffff0000u) + w1[q] * __uint_as_float(be[i] & 0xffff0000u));
          v[q][j][2 * i] = lo; v[q][j][2 * i + 1] = hi; s += lo * lo + hi * hi; } }
      rs[q] = 1.0f / sqrtf(wave_sum(s) * (1.f / 1024.f) + nv::EPS); }
#pragma unroll
    for (int q = 0; q < 2; ++q) { if (tk + q * ngw >= NTOK) break; const int tok = tk + q * ngw; u32x4* xo = (u32x4*)(x2 + (size_t)tok * 1024) + lane; u32x4* ho = (u32x4*)(hout + (size_t)tok * 1024) + lane;
#pragma unroll
      for (int j = 0; j < 2; ++j) { const f32x4 g0 = *(const f32x4*)(gain + 512 * j + 8 * lane), g1 = *(const f32x4*)(gain + 512 * j + 8 * lane + 4); const float (&x)[8] = v[q][j]; const float r = rs[q]; u32x4 ox, oh;
        ox.x = pk2(x[0], x[1]); ox.y = pk2(x[2], x[3]); ox.z = pk2(x[4], x[5]); ox.w = pk2(x[6], x[7]);
        oh.x = pk2(x[0] * r * g0.x, x[1] * r * g0.y); oh.y = pk2(x[2] * r * g0.z, x[3] * r * g0.w); oh.z = pk2(x[4] * r * g1.x, x[5] * r * g1.y); oh.w = pk2(x[6] * r * g1.z, x[7] * r * g1.w);
        xo[64 * j] = ox; ho[64 * j] = oh; } } }
}
}
namespace fa {
using nv::u16; using nv::Bufs;
typedef short bf16x8 __attribute__((ext_vector_type(8)));
typedef short s16x4 __attribute__((ext_vector_type(4)));
typedef float f32x16 __attribute__((ext_vector_type(16)));
typedef unsigned u32x4 __attribute__((ext_vector_type(4)));
constexpr float C2 = 0.125f * 1.4426950408889634f;
constexpr int S = nv::S, QKVW = 1280;
constexpr int IMP_LD = 65, IMP_HEAD = 64 * IMP_LD;
constexpr int L_K = 0, L_V = 32768, L_WSF = 65536, L_IMP = 67584, L_MASK = L_IMP + 4 * IMP_HEAD * 4 + 64  , L_OST = L_IMP  , L_END = L_MASK + 512;
static_assert(L_END <= 147456, "attention LDS map");

__device__ __forceinline__ int crow(int r, int hi) { return (r & 3) + 8 * (r >> 2) + 4 * hi; }
__device__ __forceinline__ float ex2(float x) { return __builtin_amdgcn_exp2f(x); }
__device__ __forceinline__ float max3f(float a, float b, float c) { float r; asm("v_max3_f32 %0, %1, %2, %3" : "=v"(r) : "v"(a), "v"(b), "v"(c)); return r; }
__device__ __forceinline__ float max2f(float a, float b) { float r; asm("v_max_f32_e32 %0, %1, %2" : "=v"(r) : "v"(a), "v"(b)); return r; }
__device__ __forceinline__ float swap_add(float v) { auto rr = __builtin_amdgcn_permlane32_swap(__float_as_uint(v), __float_as_uint(v), false, false); return __uint_as_float(rr[0]) + __uint_as_float(rr[1]); }
__device__ __forceinline__ float swap_max(float v) { auto rr = __builtin_amdgcn_permlane32_swap(__float_as_uint(v), __float_as_uint(v), false, false); return __builtin_fmaxf(__uint_as_float(rr[0]), __uint_as_float(rr[1])); }

__device__ __forceinline__ void phase_qknorm(const nv::Inputs& I, const Bufs& B) {
  const int nwg = (int)gridDim.x > 64 ? (int)gridDim.x - 64 : (int)gridDim.x;
  if ((int)blockIdx.x >= nwg) return;
  for (int it = blockIdx.x * 512 + fx::otid(); it < nv::NTOK * 4; it += nwg * 512) { const int tok = it >> 2, w = it & 3; u16* v; const float* gain;
    if (w < 2) { v = B.QKV + (size_t)tok * QKVW + nv::O_KS + w * 64; gain = I.ks_gain; } else { v = B.QKV + (size_t)tok * QKVW + nv::O_KW + (w - 2) * 64; gain = I.kw_gain; }
    float x[8][8]; float s = 0.f;
#pragma unroll
    for (int c = 0; c < 8; ++c) { fx::load8(v + c * 8, x[c]);
#pragma unroll
      for (int j = 0; j < 8; ++j) s += x[c][j] * x[c][j]; }
    const float rs = 1.0f / sqrtf(s * (1.f / 64.f) + nv::EPS);
#pragma unroll
    for (int c = 0; c < 8; ++c) { float y[8];
#pragma unroll
      for (int j = 0; j < 8; ++j) y[j] = x[c][j] * rs * gain[c * 8 + j];
      fx::store8(v + c * 8, y); } }
}

__device__ __forceinline__ void stage_kv(LAS unsigned char* lds, int slot, const u16* kbase, const u16* vbase, int stride, int wid, int lane, bool withV) {
  { const int row = 8 * wid + (lane >> 3), ch = lane & 7; const u16* ksrc = kbase + (size_t)row * stride + ((ch ^ (row & 7)) * 8);
    __builtin_amdgcn_global_load_lds((const unsigned*)ksrc, (LAS unsigned*)(lds + L_K + slot * 8192 + wid * 1024), 16, 0, 0); }
  if (withV) { const u16* vsrc = vbase + (size_t)(16 * (wid & 3) + (lane >> 2)) * stride + (wid >> 2) * 32 + (lane & 3) * 8;
    __builtin_amdgcn_global_load_lds((const unsigned*)vsrc, (LAS unsigned*)(lds + L_V + slot * 8192 + wid * 1024), 16, 0, 0); }
}
__device__ __forceinline__ void qkt(f32x16& p0, f32x16& p1, const LAS unsigned char* Kslot, const bf16x8 (&qr)[4], int r32, int hi, float bias = 0.f) {
  const LAS unsigned char* kb = Kslot + r32 * 128; const int sw = r32 & 7;
  bf16x8 kf[8];
#pragma unroll
  for (int d0 = 0; d0 < 4; ++d0) { const int o = ((2 * d0 + hi) ^ sw) << 4; kf[2 * d0] = *(const LAS bf16x8*)(kb + o); kf[2 * d0 + 1] = *(const LAS bf16x8*)(kb + 4096 + o); }
  f32x16 z;
#pragma unroll
  for (int r = 0; r < 16; ++r) z[r] = bias;
  asm volatile("s_waitcnt lgkmcnt(0)" ::: "memory"); __builtin_amdgcn_sched_barrier(0);
  p0 = __builtin_amdgcn_mfma_f32_32x32x16_bf16(kf[0], qr[0], z, 0, 0, 0); p1 = __builtin_amdgcn_mfma_f32_32x32x16_bf16(kf[1], qr[0], z, 0, 0, 0);
#pragma unroll
  for (int d0 = 1; d0 < 4; ++d0) { p0 = __builtin_amdgcn_mfma_f32_32x32x16_bf16(kf[2 * d0], qr[d0], p0, 0, 0, 0); p1 = __builtin_amdgcn_mfma_f32_32x32x16_bf16(kf[2 * d0 + 1], qr[d0], p1, 0, 0, 0); }
}
__device__ __forceinline__ void pv(f32x16 (&o)[2], int vb, bf16x8 pa0, bf16x8 pa1, bf16x8 pa2, bf16x8 pa3) {
#define FA_PK(k) (bf16x8){lo[k][0], lo[k][1], lo[k][2], lo[k][3], hi[k][0], hi[k][1], hi[k][2], hi[k][3]}
  s16x4 lo[8], hi[8];
#pragma unroll
  for (int d0 = 0; d0 < 2; ++d0)
#pragma unroll
    for (int ks = 0; ks < 4; ++ks) {
      asm volatile("ds_read_b64_tr_b16 %0,%1 offset:%c2" : "=&v"(lo[d0 * 4 + ks]) : "v"(vb), "i"(d0 * 4096 + ks * 1024) : "memory");
      asm volatile("ds_read_b64_tr_b16 %0,%1 offset:%c2" : "=&v"(hi[d0 * 4 + ks]) : "v"(vb), "i"(d0 * 4096 + ks * 1024 + 512) : "memory"); }
  asm volatile("s_waitcnt lgkmcnt(0)" ::: "memory"); __builtin_amdgcn_sched_barrier(0);
  o[0] = __builtin_amdgcn_mfma_f32_32x32x16_bf16(pa0, FA_PK(0), o[0], 0, 0, 0); o[1] = __builtin_amdgcn_mfma_f32_32x32x16_bf16(pa0, FA_PK(4), o[1], 0, 0, 0);
  o[0] = __builtin_amdgcn_mfma_f32_32x32x16_bf16(pa1, FA_PK(1), o[0], 0, 0, 0); o[1] = __builtin_amdgcn_mfma_f32_32x32x16_bf16(pa1, FA_PK(5), o[1], 0, 0, 0);
  o[0] = __builtin_amdgcn_mfma_f32_32x32x16_bf16(pa2, FA_PK(2), o[0], 0, 0, 0); o[1] = __builtin_amdgcn_mfma_f32_32x32x16_bf16(pa2, FA_PK(6), o[1], 0, 0, 0);
  o[0] = __builtin_amdgcn_mfma_f32_32x32x16_bf16(pa3, FA_PK(3), o[0], 0, 0, 0); o[1] = __builtin_amdgcn_mfma_f32_32x32x16_bf16(pa3, FA_PK(7), o[1], 0, 0, 0);
#undef FA_PK
}
struct SmState { float m, l; f32x16 o[2]; };
#ifdef PROBE_STAMPS
struct Prof { unsigned long long t, a[4]; };
#define FA_PROF_DECL Prof prof; prof.t = __builtin_amdgcn_s_memrealtime(); prof.a[0] = prof.a[1] = prof.a[2] = prof.a[3] = 0;
#define FA_PROF(k) do { __builtin_amdgcn_sched_barrier(0); const unsigned long long n_ = __builtin_amdgcn_s_memrealtime(); prof.a[k] += n_ - prof.t; prof.t = n_; __builtin_amdgcn_sched_barrier(0); } while (0)
#define FA_PROF_ARG , Prof& prof
#define FA_PROF_PASS , prof
#else
#define FA_PROF_DECL
#define FA_PROF(k) do {} while (0)
#define FA_PROF_ARG
#define FA_PROF_PASS
#endif
__device__ __forceinline__ void sm_reset(SmState& st) { st.m = 0.f; st.l = 0.f;
#pragma unroll
  for (int r = 0; r < 16; ++r) { st.o[0][r] = 0.f; st.o[1][r] = 0.f; } }
__device__ __forceinline__ void mask_range(f32x16& p0, f32x16& p1, int klo, int khi, int hi) {
  if (__all(klo <= 0 && khi >= 63)) return;
#pragma unroll
  for (int r = 0; r < 16; ++r) { const int k0 = crow(r, hi), k1 = k0 + 32; if (k0 < klo || k0 > khi) p0[r] = -INFINITY; if (k1 < klo || k1 > khi) p1[r] = -INFINITY; }
}
__device__ __forceinline__ void tile_step(SmState& st, LAS unsigned char* lds, int slot, const bf16x8 (&qr)[4], LAS float* wsf, int r32, int hi, int vb0, int klo, int khi, float bias FA_PROF_ARG) {
  FA_PROF(0);
  f32x16 p0, p1; qkt(p0, p1, lds + L_K + slot * 8192, qr, r32, hi, bias);
  asm volatile("" : "+v"(p0), "+v"(p1)); FA_PROF(1);
  mask_range(p0, p1, klo, khi, hi);
  float rs = 0.f;
#pragma unroll
  for (int r = 0; r < 16; ++r) { p0[r] = ex2(p0[r] - st.m); p1[r] = ex2(p1[r] - st.m); rs += p0[r] + p1[r]; }
  if (__builtin_expect(__any(!(rs < 1.0e30f)), 0)) {
    qkt(p0, p1, lds + L_K + slot * 8192, qr, r32, hi, bias); mask_range(p0, p1, klo, khi, hi);
    float rm = max2f(p0[0], p1[0]);
#pragma unroll
    for (int r = 1; r < 16; ++r) rm = max3f(rm, p0[r], p1[r]);
    rm = swap_max(rm) - st.m; const float d = rm > 24.f ? rm : 0.f; const float f = ex2(-d); st.m += d; st.l *= f;
    if (hi == 0) wsf[r32] = f;
    rs = 0.f;
#pragma unroll
    for (int r = 0; r < 16; ++r) { p0[r] = ex2(p0[r] - st.m); p1[r] = ex2(p1[r] - st.m); rs += p0[r] + p1[r]; const float fr = wsf[crow(r, hi)]; st.o[0][r] *= fr; st.o[1][r] *= fr; } }
  st.l += rs;
  u32x4 w0, w1, w2, w3;
  w0.x = pg8::cvt_pk_bf16(p0[0], p0[1]); w0.y = pg8::cvt_pk_bf16(p0[2], p0[3]); w0.z = pg8::cvt_pk_bf16(p0[4], p0[5]); w0.w = pg8::cvt_pk_bf16(p0[6], p0[7]);
  w1.x = pg8::cvt_pk_bf16(p0[8], p0[9]); w1.y = pg8::cvt_pk_bf16(p0[10], p0[11]); w1.z = pg8::cvt_pk_bf16(p0[12], p0[13]); w1.w = pg8::cvt_pk_bf16(p0[14], p0[15]);
  w2.x = pg8::cvt_pk_bf16(p1[0], p1[1]); w2.y = pg8::cvt_pk_bf16(p1[2], p1[3]); w2.z = pg8::cvt_pk_bf16(p1[4], p1[5]); w2.w = pg8::cvt_pk_bf16(p1[6], p1[7]);
  w3.x = pg8::cvt_pk_bf16(p1[8], p1[9]); w3.y = pg8::cvt_pk_bf16(p1[10], p1[11]); w3.z = pg8::cvt_pk_bf16(p1[12], p1[13]); w3.w = pg8::cvt_pk_bf16(p1[14], p1[15]);
  asm volatile("" : "+v"(w0), "+v"(w1), "+v"(w2), "+v"(w3)); FA_PROF(2);
  pv(st.o, vb0 + L_V + slot * 8192, __builtin_bit_cast(bf16x8, w0), __builtin_bit_cast(bf16x8, w1), __builtin_bit_cast(bf16x8, w2), __builtin_bit_cast(bf16x8, w3));
  asm volatile("" : "+v"(st.o[0]), "+v"(st.o[1])); FA_PROF(3);
}
template <int MODE> __device__ __forceinline__ void finalize(SmState& st, float gate, f32x16 (&outacc)[2], LAS float* slab, LAS float* wsf, int r32, int hi, int lane, float& msafe, float& invl) {
  const float lt = swap_add(st.l); invl = lt > 0.f ? 1.0f / lt : 0.f; msafe = st.m;
  if (hi == 0) wsf[r32] = gate * invl;
#pragma unroll
  for (int r = 0; r < 16; ++r) { const float fr = wsf[crow(r, hi)];
    if (MODE == 0) { outacc[0][r] = st.o[0][r] * fr; outacc[1][r] = st.o[1][r] * fr; }
    else if (MODE == 1) { slab[r * 64 + lane] += st.o[0][r] * fr; slab[(16 + r) * 64 + lane] += st.o[1][r] * fr; }
    else { outacc[0][r] = slab[r * 64 + lane] + st.o[0][r] * fr; outacc[1][r] = slab[(16 + r) * 64 + lane] + st.o[1][r] * fr; } }
}
__device__ __forceinline__ void imp_step(LAS unsigned char* lds, int slot, const bf16x8 (&qr)[4], int r32, int hi, int khi, float msafe, float invl, LAS float* imph  , int tq, int T) {
  f32x16 p0, p1; qkt(p0, p1, lds + L_K + slot * 8192, qr, r32, hi);
  mask_range(p0, p1, 0, khi, hi);
#pragma unroll
  for (int r = 0; r < 16; ++r) { p0[r] = ex2(p0[r] - msafe) * invl; p1[r] = ex2(p1[r] - msafe) * invl; }
  LAS float* row = imph + tq * IMP_LD + 16 * T + hi;
#pragma unroll
  for (int gq = 0; gq < 4; ++gq) { row[2 * gq] += (p0[4 * gq] + p0[4 * gq + 1]) + (p0[4 * gq + 2] + p0[4 * gq + 3]); row[2 * gq + 8] += (p1[4 * gq] + p1[4 * gq + 1]) + (p1[4 * gq + 2] + p1[4 * gq + 3]); }
  asm volatile("s_waitcnt lgkmcnt(0)" ::: "memory");
#pragma unroll
  for (int gq = 0; gq < 4; ++gq) { row[2 * gq + 1] += p0[4 * gq + 3]; if (16 * T + hi + 2 * gq + 9 < 64) row[2 * gq + 9] += p1[4 * gq + 3]; }
  asm volatile("s_waitcnt lgkmcnt(0)" ::: "memory");
}
__device__ __forceinline__ void topk_select(LAS unsigned char* lds, LAS float* wsf, int wid, int lane, int i) {
  LAS float* IM = (LAS float*)(lds + L_IMP); LAS unsigned long long* MK = (LAS unsigned long long*)(lds + L_MASK);
  const int j = lane; const int nforced = i == 0 ? 1 : (i == 1 ? 2 : 3);
  const bool forced = (j <= i) && (j == 0 || j == i || j == i - 1); const bool cand = (j >= 1) && (j <= i - 2);
  for (int tq = wid; tq < 64; tq += 8) {
    const float v = (IM[tq * IMP_LD + j] + IM[IMP_HEAD + tq * IMP_LD + j]) + (IM[2 * IMP_HEAD + tq * IMP_LD + j] + IM[3 * IMP_HEAD + tq * IMP_LD + j]);
    int cnt = 0;
#pragma unroll 4
    for (int jj = 1; jj <= i - 2; ++jj) { const float vv = __uint_as_float(__builtin_amdgcn_readlane(__float_as_uint(v), jj)); cnt += (vv > v || (vv == v && jj < j)) ? 1 : 0; }
    const bool sel = forced || (cand && cnt < 16 - nforced);
    const unsigned long long mk = __ballot(sel);
    if (lane == 0) MK[tq] = mk;
  }
}
__device__ __forceinline__ void attn_unit(LAS unsigned char* lds, const nv::Inputs& I, const Bufs& B, int b, int g, int i) {
  const int tid = fx::otid(), lane = tid & 63, wid = __builtin_amdgcn_readfirstlane(tid >> 6), r32 = lane & 31, hi = lane >> 5;
  const int e = wid >> 1, h = g * 4 + e, tq = 32 * (wid & 1) + r32; const size_t tok = (size_t)b * S + 64 * i + tq; const int t = 64 * i + tq;
  LAS float* wsf = (LAS float*)(lds + L_WSF) + wid * 64;
  LAS float* imph = (LAS float*)(lds + L_IMP) + e * IMP_HEAD;
  const int vb0 = (int)(unsigned)(size_t)lds + ((lane >> 4) & 1) * 32 + (lane & 3) * 8 + (4 * hi + ((lane & 15) >> 2)) * 64;
  bf16x8 qr[4];
  {
    float qv[4][8]; float ss = 0.f;
#pragma unroll
    for (int d0 = 0; d0 < 4; ++d0) { fx::load8(B.QKV + tok * QKVW + h * 64 + d0 * 16 + hi * 8, qv[d0]);
#pragma unroll
      for (int j = 0; j < 8; ++j) ss += qv[d0][j] * qv[d0][j]; }
    ss = swap_add(ss); const float rs = C2 / sqrtf(ss * (1.f / 64.f) + nv::EPS);
#pragma unroll
    for (int d0 = 0; d0 < 4; ++d0) { u32x4 w; const float* gq = I.q_gain + d0 * 16 + hi * 8;
      w.x = pg8::cvt_pk_bf16(qv[d0][0] * rs * gq[0], qv[d0][1] * rs * gq[1]); w.y = pg8::cvt_pk_bf16(qv[d0][2] * rs * gq[2], qv[d0][3] * rs * gq[3]);
      w.z = pg8::cvt_pk_bf16(qv[d0][4] * rs * gq[4], qv[d0][5] * rs * gq[5]); w.w = pg8::cvt_pk_bf16(qv[d0][6] * rs * gq[6], qv[d0][7] * rs * gq[7]); qr[d0] = __builtin_bit_cast(bf16x8, w); } }
  const float g0 = B.NG[tok * 24 + h * 3 + 0], g1 = B.NG[tok * 24 + h * 3 + 1], g2 = B.NG[tok * 24 + h * 3 + 2];
  const u16* kc = B.KCMP + (size_t)(b * 2 + g) * 256 * 64; const u16* vc = B.VCMP + (size_t)(b * 2 + g) * 256 * 64;
  const u16* ksb = B.QKV + (size_t)b * S * QKVW + nv::O_KS + g * 64; const u16* vsb = B.QKV + (size_t)b * S * QKVW + nv::O_VS + g * 64;
  const u16* kwb = B.QKV + (size_t)b * S * QKVW + nv::O_KW + g * 64; const u16* vwb = B.QKV + (size_t)b * S * QKVW + nv::O_VW + g * 64;
  int nvis = t >= 31 ? (t - 31) / 16 + 1 : 0; nvis = nvis > 255 ? 255 : nvis;
  const int ntA = (4 * i + 3 + 63) / 64, nC = (i < 8 ? i : 8) + 1, jC0 = i - (nC - 1);
  const int sI = ntA, sB = 2 * ntA, sC = sB + i + 1, NS = sC + nC;
  { LAS float* IM = (LAS float*)(lds + L_IMP); for (int k = tid; k < 4 * IMP_HEAD; k += 512) IM[k] = 0.f; }
  f32x16 outacc[2];
  LAS float* slab = (LAS float*)(lds + L_IMP) + wid * 2048;
  SmState st; sm_reset(st);
  float mA = 0.f, invlA = 0.f; unsigned long long mybits = 0ull;
  FA_PROF_DECL
#ifdef PROBE_STAMPS
  const unsigned long long ck0 = __builtin_amdgcn_s_memtime(), rt0 = __builtin_amdgcn_s_memrealtime();
#endif
#define FA_ISSUE1(s_) do { const int s__ = (s_); const int sl = s__ & 3; \
    if (s__ < sI) stage_kv(lds, sl, kc + (size_t)s__ * 4096, vc + (size_t)s__ * 4096, 64, wid, lane, true); \
    else if (s__ < sB) stage_kv(lds, sl, kc + (size_t)(s__ - sI) * 4096, vc + (size_t)(s__ - sI) * 4096, 64, wid, lane, true); \
    else if (s__ < sC) stage_kv(lds, sl, ksb + (size_t)(s__ - sB) * 64 * QKVW, vsb + (size_t)(s__ - sB) * 64 * QKVW, QKVW, wid, lane, true); \
    else stage_kv(lds, sl, kwb + (size_t)(jC0 + s__ - sC) * 64 * QKVW, vwb + (size_t)(jC0 + s__ - sC) * 64 * QKVW, QKVW, wid, lane, true); } while (0)
  FA_ISSUE1(0);
  int s = 0;
#define FA_TOP(n_) do { asm volatile("s_waitcnt vmcnt(0)" ::: "memory"); __syncthreads(); if (s + 1 < NS) FA_ISSUE1(s + 1); } while (0)
#pragma unroll 1
  for (; s < sI; ++s) { FA_TOP(1); tile_step(st, lds, s & 3, qr, wsf, r32, hi, vb0, 0, nvis - 64 * s - 1, 0.f FA_PROF_PASS); }
  finalize<0>(st, g0, outacc, slab, wsf, r32, hi, lane, mA, invlA);
#pragma unroll 1
  for (; s < sB; ++s) { FA_TOP(1); imp_step(lds, s & 3, qr, r32, hi, nvis - 64 * (s - sI) - 1, mA, invlA, imph, tq, s - sI); }
  asm volatile("s_waitcnt lgkmcnt(0)\n\ts_barrier" ::: "memory");
  topk_select(lds, wsf, wid, lane, i);
  asm volatile("s_waitcnt lgkmcnt(0)\n\ts_barrier" ::: "memory"); mybits = ((const LAS unsigned long long*)(lds + L_MASK))[tq];
#pragma unroll
  for (int r = 0; r < 16; ++r) { slab[r * 64 + lane] = outacc[0][r]; slab[(16 + r) * 64 + lane] = outacc[1][r]; }
  sm_reset(st);
#pragma unroll 1
  for (; s < sC; ++s) { FA_TOP(1); const int j = s - sB; const bool selj = (mybits >> j) & 1ull;
    tile_step(st, lds, s & 3, qr, wsf, r32, hi, vb0, 0, j == i ? tq : 63, selj ? 0.f : -INFINITY FA_PROF_PASS); }
  { float d0_, d1_; finalize<1>(st, g1, outacc, slab, wsf, r32, hi, lane, d0_, d1_); sm_reset(st); }
#pragma unroll 1
  for (; s < NS; ++s) { FA_TOP(1); const int j = jC0 + (s - sC);
    tile_step(st, lds, s & 3, qr, wsf, r32, hi, vb0, (i >= 8 && j == i - 8) ? tq + 1 : 0, j == i ? tq : 63, 0.f FA_PROF_PASS); }
  { float d0_, d1_; finalize<2>(st, g2, outacc, slab, wsf, r32, hi, lane, d0_, d1_); }
#undef FA_ISSUE1
#undef FA_TOP
  { u16* Ow = B.YA + ((size_t)b * S + 64 * i + 32 * (wid & 1)) * 512 + h * 64; LAS u16* stg = (LAS u16*)(lds + L_OST) + wid * 4096;
#pragma unroll
    for (int r = 0; r < 16; ++r) { const int orow = crow(r, hi); stg[orow * 64 + r32] = nv::f2bf(outacc[0][r]); stg[orow * 64 + 32 + r32] = nv::f2bf(outacc[1][r]); }
    asm volatile("s_waitcnt lgkmcnt(0)" ::: "memory");
#pragma unroll
    for (int q = 0; q < 4; ++q) { const int row = q * 8 + (lane >> 3), ch = lane & 7; const u32x4 v = *(const LAS u32x4*)(stg + row * 64 + ch * 8); *(u32x4*)(Ow + (size_t)row * 512 + ch * 8) = v; } }
#ifdef PROBE_STAMPS
  if (blockIdx.x == 0 && threadIdx.x == PROBE_TID) { volatile LAS unsigned long long* ts = (volatile LAS unsigned long long*)(lds + 147120); for (int k = 0; k < 4; ++k) ts[20 + k] += prof.a[k]; ts[24] += (__builtin_amdgcn_s_memtime() - ck0) / 10; ts[25] += __builtin_amdgcn_s_memrealtime() - rt0; }
#endif
  __syncthreads();
}
__device__ __forceinline__ void phase_attention(LAS unsigned char* lds, const nv::Inputs& I, const Bufs& B) {
  const int G = gridDim.x, bx = blockIdx.x; const int vcu = (G % 8 == 0) ? (bx % 8) * (G / 8) + bx / 8 : bx;
  for (int u = vcu; u < 256; u += G) { const int bg = u >> 4, s = u & 15;
#pragma unroll 1
    for (int k = 0; k < 4; ++k) { const int i = (k == 0) ? s : (k == 1) ? 31 - s : (k == 2) ? 32 + s : 63 - s; attn_unit(lds, I, B, bg >> 1, bg & 1, i); } }
}
}
namespace fs {
#ifdef PROBE_STAMPS
#define FS_STAMP(k) do { if (blockIdx.x == 0 && threadIdx.x == 0) *(volatile LAS unsigned long long*)(lds + 147120 + 8 * (k)) = __builtin_amdgcn_s_memrealtime(); } while (0)
#else
#define FS_STAMP(k) do {} while (0)
#endif
using nv::u16; using nv::Bufs; using nv::Inputs;
using fa::bf16x8; using fa::f32x16; using fa::u32x4; using fa::crow; using fa::ex2;
typedef float f32x4 __attribute__((ext_vector_type(4)));
constexpr int S = nv::S, NTOK = nv::NTOK, SCD = 1536;
constexpr float LOG2E = 1.4426950408889634f;
struct SsdBufs { u16* XC; u16* STATE; float* ACS; float* DEC; };
__host__ __device__ inline size_t carve_ssd(SsdBufs& X, const Bufs& B, unsigned char* ws, size_t off) {
  auto take = [&](size_t bytes) { unsigned char* r = ws + off; off += (bytes + 255) / 256 * 256; return r; };
  X.XC = B.HB;
  X.STATE = B.HB + (size_t)NTOK * SCD;
  X.ACS = (float*)take((size_t)NTOK * 16 * 4); X.DEC = (float*)take((size_t)8 * 16 * 16 * 4);
  return off;
}
constexpr int L_ARR = 101376;
constexpr int L_BT = 0, BT_LD = 264, L_XWT = 67584;
constexpr int L_KIMG = 0, L_XV = 0, L_OST = 65536;
static_assert(L_XWT + 64 * BT_LD * 2 <= L_ARR && L_OST + 32768 <= L_ARR && L_ARR + 16384 <= 147456, "SSD LDS map");

__device__ __forceinline__ void phase_conv(const Inputs& I, const Bufs& B, const SsdBufs& X) {
  const int id = blockIdx.x * 512 + fx::otid(); if (id >= 192 * 512) return;
  const int c8 = (id % 192) * 8, run = id / 192; const int tok0 = run * 64; const int t0 = tok0 & (S - 1);
  float w[4][8], bias[8], h0[8], h1[8], h2[8];
#pragma unroll
  for (int j = 0; j < 8; ++j) { bias[j] = I.conv_b[c8 + j];
#pragma unroll
    for (int k = 0; k < 4; ++k) w[k][j] = I.conv_w[k * SCD + c8 + j]; }
  if (t0 >= 3) { fx::load8(B.XBC + (size_t)(tok0 - 3) * SCD + c8, h0); fx::load8(B.XBC + (size_t)(tok0 - 2) * SCD + c8, h1); fx::load8(B.XBC + (size_t)(tok0 - 1) * SCD + c8, h2); }
  else {
#pragma unroll
    for (int j = 0; j < 8; ++j) { h0[j] = 0.f; h1[j] = 0.f; h2[j] = 0.f; } }
#pragma unroll 8
  for (int t = 0; t < 64; ++t) { float x[8], y[8]; fx::load8(B.XBC + (size_t)(tok0 + t) * SCD + c8, x);
#pragma unroll
    for (int j = 0; j < 8; ++j) { const float a = bias[j] + w[0][j] * h0[j] + w[1][j] * h1[j] + w[2][j] * h2[j] + w[3][j] * x[j]; y[j] = a * fx::fsig(a); h0[j] = h1[j]; h1[j] = h2[j]; h2[j] = x[j]; }
    fx::store8(X.XC + (size_t)(tok0 + t) * SCD + c8, y); }
}

__device__ __forceinline__ void ssd_x_unit(LAS unsigned char* lds, const Inputs& I, const Bufs& B, const SsdBufs& X, int b, int c, int g) {
  const int tid = fx::otid(), lane = tid & 63, wid = __builtin_amdgcn_readfirstlane(tid >> 6), r32 = lane & 31, hi = lane >> 5, fr = lane & 15, fq = lane >> 4;
  const size_t tok0 = (size_t)b * S + (size_t)c * 256;
  LAS float* acs2 = (LAS float*)(lds + L_ARR); LAS float* dtl = acs2 + 8 * 256;
  { const int hh = g * 8 + wid; const float a = -expf(I.a_log[hh]) * LOG2E; float d[4], sc[4];
#pragma unroll
    for (int k = 0; k < 4; ++k) d[k] = B.DT[(tok0 + 4 * lane + k) * 16 + hh];
    sc[0] = d[0] * a; sc[1] = sc[0] + d[1] * a; sc[2] = sc[1] + d[2] * a; sc[3] = sc[2] + d[3] * a;
    float tot = sc[3];
#pragma unroll
    for (int o = 1; o < 64; o <<= 1) { const float up = __shfl_up(tot, o); if (lane >= o) tot += up; }
    const float excl = tot - sc[3];
#pragma unroll
    for (int k = 0; k < 4; ++k) { const float v = excl + sc[k]; acs2[wid * 256 + 4 * lane + k] = v; dtl[wid * 256 + 4 * lane + k] = d[k]; X.ACS[(tok0 + 4 * lane + k) * 16 + hh] = v; }
    if (lane == 63) X.DEC[((size_t)b * 16 + c) * 16 + hh] = ex2(tot); }
  { LAS u16* BT = (LAS u16*)(lds + L_BT);
#pragma unroll 1
    for (int q = tid; q < 256 * 16; q += 512) { const int l = q >> 4, n8 = (q & 15) * 8; const u32x4 w = *(const u32x4*)(X.XC + (tok0 + l) * SCD + 1024 + g * 128 + n8);
      BT[(n8 + 0) * BT_LD + l] = (u16)(w.x & 0xffff); BT[(n8 + 1) * BT_LD + l] = (u16)(w.x >> 16); BT[(n8 + 2) * BT_LD + l] = (u16)(w.y & 0xffff); BT[(n8 + 3) * BT_LD + l] = (u16)(w.y >> 16);
      BT[(n8 + 4) * BT_LD + l] = (u16)(w.z & 0xffff); BT[(n8 + 5) * BT_LD + l] = (u16)(w.z >> 16); BT[(n8 + 6) * BT_LD + l] = (u16)(w.w & 0xffff); BT[(n8 + 7) * BT_LD + l] = (u16)(w.w >> 16); } }
  __syncthreads();
  FS_STAMP(30);
  u32x4 nx[4];
#define FSX_LOAD_X(h_) do { _Pragma("unroll") for (int u = 0; u < 4; ++u) { const int q = tid + u * 512; nx[u] = *(const u32x4*)(X.XC + (tok0 + (q >> 3)) * SCD + (g * 8 + (h_)) * 64 + (q & 7) * 8); } } while (0)
  FSX_LOAD_X(0);
#pragma unroll 1
  for (int h = 0; h < 8; ++h) { const int hh = g * 8 + h; LAS u16* XwT = (LAS u16*)(lds + L_XWT); const LAS u16* BT = (const LAS u16*)(lds + L_BT);
    const float aend = acs2[h * 256 + 255];
#pragma unroll
    for (int u = 0; u < 4; ++u) { const int q = tid + u * 512, l = q >> 3, p8 = (q & 7) * 8; const float w = ex2(aend - acs2[h * 256 + l]) * dtl[h * 256 + l]; const u32x4 xv = nx[u];
      XwT[(p8 + 0) * BT_LD + l] = nv::f2bf(__uint_as_float(xv.x << 16) * w); XwT[(p8 + 1) * BT_LD + l] = nv::f2bf(__uint_as_float(xv.x & 0xffff0000u) * w);
      XwT[(p8 + 2) * BT_LD + l] = nv::f2bf(__uint_as_float(xv.y << 16) * w); XwT[(p8 + 3) * BT_LD + l] = nv::f2bf(__uint_as_float(xv.y & 0xffff0000u) * w);
      XwT[(p8 + 4) * BT_LD + l] = nv::f2bf(__uint_as_float(xv.z << 16) * w); XwT[(p8 + 5) * BT_LD + l] = nv::f2bf(__uint_as_float(xv.z & 0xffff0000u) * w);
      XwT[(p8 + 6) * BT_LD + l] = nv::f2bf(__uint_as_float(xv.w << 16) * w); XwT[(p8 + 7) * BT_LD + l] = nv::f2bf(__uint_as_float(xv.w & 0xffff0000u) * w); }
    if (h + 1 < 8) FSX_LOAD_X(h + 1);
    asm volatile("s_waitcnt lgkmcnt(0)\n\ts_barrier" ::: "memory");
    { const int pt = wid & 3, nt0 = (wid >> 2) * 4; pg8::f32x4 acc[4];
#pragma unroll
      for (int n = 0; n < 4; ++n) acc[n] = (pg8::f32x4){0.f, 0.f, 0.f, 0.f};
#pragma unroll
      for (int ks = 0; ks < 8; ++ks) { const bf16x8 a = *(const LAS bf16x8*)(XwT + (pt * 16 + fr) * BT_LD + ks * 32 + fq * 8);
#pragma unroll
        for (int n = 0; n < 4; ++n) { const bf16x8 bb = *(const LAS bf16x8*)(BT + ((nt0 + n) * 16 + fr) * BT_LD + ks * 32 + fq * 8); acc[n] = __builtin_amdgcn_mfma_f32_16x16x32_bf16(a, bb, acc[n], 0, 0, 0); } }
      u16* st = X.STATE + (((size_t)b * 16 + c) * 16 + hh) * 8192;
#pragma unroll
      for (int n = 0; n < 4; ++n)
#pragma unroll
        for (int j = 0; j < 4; ++j) st[(pt * 16 + 4 * fq + j) * 128 + (nt0 + n) * 16 + fr] = nv::f2bf(acc[n][j]); }
    asm volatile("s_waitcnt lgkmcnt(0)\n\ts_barrier" ::: "memory"); }
#undef FSX_LOAD_X
  FS_STAMP(31);
  const int lt = wid < 4 ? wid : 11 - wid;
  const int l = 32 * lt + r32;
  for (int k = tid; k < 8 * 256; k += 512) { const int h_ = k >> 8, s_ = k & 255; dtl[k] = ex2(acs2[h_ * 256 + (s_ & ~15)] - acs2[k]) * dtl[k]; }
  bf16x8 qr[8];
#pragma unroll
  for (int d0 = 0; d0 < 8; ++d0) qr[d0] = *(const bf16x8*)(X.XC + (tok0 + l) * SCD + 1280 + g * 128 + d0 * 16 + hi * 8);
  unsigned Sp[4][16];
#define FS_STAGE_K(j_) do { const int j__ = (j_); _Pragma("unroll") for (int q = 0; q < 2; ++q) { const int ch = wid + 8 * q; \
    __builtin_amdgcn_global_load_lds((const unsigned*)(X.XC + (tok0 + 64 * j__ + lane) * SCD + 1024 + g * 128 + ch * 8), (LAS unsigned*)(lds + L_KIMG + (j__ & 1) * 16384 + ch * 1024), 16, 0, 0); } } while (0)
  FS_STAGE_K(0);
#pragma unroll
  for (int j = 0; j < 4; ++j) {
    asm volatile("s_waitcnt vmcnt(0)" ::: "memory"); __syncthreads();
    if (j + 1 < 4) FS_STAGE_K(j + 1);
    f32x16 p0, p1;
#pragma unroll
    for (int r = 0; r < 16; ++r) { p0[r] = 0.f; p1[r] = 0.f; }
    if (64 * j <= 32 * lt + 31) { const LAS unsigned char* kb = lds + L_KIMG + (j & 1) * 16384 + hi * 1024 + r32 * 16;
#pragma unroll
      for (int d0 = 0; d0 < 8; ++d0) { const bf16x8 b0 = *(const LAS bf16x8*)(kb + d0 * 2048), b1 = *(const LAS bf16x8*)(kb + d0 * 2048 + 512);
        p0 = __builtin_amdgcn_mfma_f32_32x32x16_bf16(b0, qr[d0], p0, 0, 0, 0); p1 = __builtin_amdgcn_mfma_f32_32x32x16_bf16(b1, qr[d0], p1, 0, 0, 0); } }
#pragma unroll
    for (int r = 0; r < 8; ++r) { Sp[j][r] = pg8::cvt_pk_bf16(p0[2 * r], p0[2 * r + 1]); Sp[j][8 + r] = pg8::cvt_pk_bf16(p1[2 * r], p1[2 * r + 1]); } }
#undef FS_STAGE_K
  FS_STAMP(32);
  __syncthreads();
#define FS_STAGE_X(h_) do { const int h__ = (h_); _Pragma("unroll") for (int j = 0; j < 4; ++j) \
    __builtin_amdgcn_global_load_lds((const unsigned*)(X.XC + (tok0 + 64 * j + 16 * (wid & 3) + (lane >> 2)) * SCD + (g * 8 + h__) * 64 + (wid >> 2) * 32 + (lane & 3) * 8), \
                                     (LAS unsigned*)(lds + L_XV + (h__ & 1) * 32768 + j * 8192 + wid * 1024), 16, 0, 0); } while (0)
  const int vb0 = (int)(unsigned)(size_t)lds + ((lane >> 4) & 1) * 32 + (lane & 3) * 8 + (4 * hi + ((lane & 15) >> 2)) * 64;
  FS_STAGE_X(0);
#pragma unroll 1
  for (int h = 0; h < 8; ++h) { const int hh = g * 8 + h;
    if (h == 0) asm volatile("s_waitcnt vmcnt(0) lgkmcnt(0)\n\ts_barrier" ::: "memory"); else asm volatile("s_waitcnt vmcnt(4) lgkmcnt(0)\n\ts_barrier" ::: "memory");
    if (h + 1 < 8) FS_STAGE_X(h + 1);
    const float al = acs2[h * 256 + l]; f32x16 o[2];
#pragma unroll
    for (int r = 0; r < 16; ++r) { o[0][r] = 0.f; o[1][r] = 0.f; }
#pragma unroll
    for (int j = 0; j < 4; ++j) { if (64 * j <= 32 * lt + 31) { f32x16 p0, p1;
#pragma unroll
        for (int r = 0; r < 16; ++r) asm volatile("" : "+v"(Sp[j][r]));
#pragma unroll
        for (int r = 0; r < 8; ++r) { p0[2 * r] = __uint_as_float(Sp[j][r] << 16); p0[2 * r + 1] = __uint_as_float(Sp[j][r] & 0xffff0000u); p1[2 * r] = __uint_as_float(Sp[j][8 + r] << 16); p1[2 * r + 1] = __uint_as_float(Sp[j][8 + r] & 0xffff0000u); }
        float e1[4];
#pragma unroll
        for (int q = 0; q < 4; ++q) e1[q] = ex2(al - acs2[h * 256 + 64 * j + 16 * q]);
#pragma unroll
        for (int gq = 0; gq < 4; ++gq) { const int s0 = 64 * j + 8 * gq + 4 * hi; const f32x4 d0v = *(const LAS f32x4*)(dtl + h * 256 + s0), d1v = *(const LAS f32x4*)(dtl + h * 256 + s0 + 32);
#pragma unroll
          for (int k = 0; k < 4; ++k) { const int r = 4 * gq + k, s = s0 + k; p0[r] = (s <= l) ? p0[r] * (e1[gq >> 1] * d0v[k]) : 0.f; p1[r] = (s + 32 <= l) ? p1[r] * (e1[2 + (gq >> 1)] * d1v[k]) : 0.f; } }
        u32x4 w0, w1, w2, w3;
        w0.x = pg8::cvt_pk_bf16(p0[0], p0[1]); w0.y = pg8::cvt_pk_bf16(p0[2], p0[3]); w0.z = pg8::cvt_pk_bf16(p0[4], p0[5]); w0.w = pg8::cvt_pk_bf16(p0[6], p0[7]);
        w1.x = pg8::cvt_pk_bf16(p0[8], p0[9]); w1.y = pg8::cvt_pk_bf16(p0[10], p0[11]); w1.z = pg8::cvt_pk_bf16(p0[12], p0[13]); w1.w = pg8::cvt_pk_bf16(p0[14], p0[15]);
        w2.x = pg8::cvt_pk_bf16(p1[0], p1[1]); w2.y = pg8::cvt_pk_bf16(p1[2], p1[3]); w2.z = pg8::cvt_pk_bf16(p1[4], p1[5]); w2.w = pg8::cvt_pk_bf16(p1[6], p1[7]);
        w3.x = pg8::cvt_pk_bf16(p1[8], p1[9]); w3.y = pg8::cvt_pk_bf16(p1[10], p1[11]); w3.z = pg8::cvt_pk_bf16(p1[12], p1[13]); w3.w = pg8::cvt_pk_bf16(p1[14], p1[15]);
        fa::pv(o, vb0 + L_XV + (h & 1) * 32768 + j * 8192, __builtin_bit_cast(bf16x8, w0), __builtin_bit_cast(bf16x8, w1), __builtin_bit_cast(bf16x8, w2), __builtin_bit_cast(bf16x8, w3)); } }
    { const float dsk = I.d_skip[hh]; const LAS u16* xi = (const LAS u16*)(lds + L_XV + (h & 1) * 32768 + (lt >> 1) * 8192); LAS u16* stg = (LAS u16*)(lds + L_OST) + wid * 2048;
#pragma unroll
      for (int r = 0; r < 16; ++r) { const int key = 32 * (lt & 1) + crow(r, hi);
#pragma unroll
        for (int d0 = 0; d0 < 2; ++d0) { const float xv = nv::bf2f(xi[d0 * 2048 + (key >> 4) * 512 + (key & 15) * 32 + r32]); stg[crow(r, hi) * 64 + d0 * 32 + r32] = nv::f2bf(o[d0][r] + dsk * xv); } }
      asm volatile("s_waitcnt lgkmcnt(0)" ::: "memory");
      u16* Ow = X.XC + (tok0 + 32 * lt) * SCD + hh * 64;
#pragma unroll
      for (int q = 0; q < 4; ++q) { const int row = q * 8 + (lane >> 3), ch = lane & 7; const u32x4 v = *(const LAS u32x4*)(stg + row * 64 + ch * 8); *(u32x4*)(Ow + (size_t)row * SCD + ch * 8) = v; } } }
#undef FS_STAMP_DUMMY
#undef FS_STAGE_X
  __syncthreads(); FS_STAMP(33);
}
__device__ __forceinline__ void phase_ssd_x(LAS unsigned char* lds, const Inputs& I, const Bufs& B, const SsdBufs& X) {
  for (int u = blockIdx.x; u < 256; u += gridDim.x) ssd_x_unit(lds, I, B, X, u >> 5, (u >> 1) & 15, u & 1);
}
__device__ __forceinline__ void phase_ssd_scan(const SsdBufs& X) {
  for (int it = blockIdx.x * 512 + fx::otid(); it < 8 * 16 * 64 * 32; it += gridDim.x * 512) { const int n4 = (it & 31) * 4, p = (it >> 5) & 63, hh = (it >> 11) & 15, b = it >> 15;
    pg8::u32x2 v[16]; float dec[16];
#pragma unroll
    for (int c = 0; c < 16; ++c) { v[c] = *(const pg8::u32x2*)(X.STATE + (((size_t)b * 16 + c) * 16 + hh) * 8192 + p * 128 + n4); dec[c] = X.DEC[((size_t)b * 16 + c) * 16 + hh]; }
    float h0 = 0.f, h1 = 0.f, h2 = 0.f, h3 = 0.f;
#pragma unroll
    for (int c = 0; c < 16; ++c) { pg8::u32x2 o; o.x = fx::pk2(h0, h1); o.y = fx::pk2(h2, h3); *(pg8::u32x2*)(X.STATE + (((size_t)b * 16 + c) * 16 + hh) * 8192 + p * 128 + n4) = o;
      h0 = h0 * dec[c] + __uint_as_float(v[c].x << 16); h1 = h1 * dec[c] + __uint_as_float(v[c].x & 0xffff0000u); h2 = h2 * dec[c] + __uint_as_float(v[c].y << 16); h3 = h3 * dec[c] + __uint_as_float(v[c].y & 0xffff0000u); } }
}
__device__ __forceinline__ void ssd_y_unit(LAS unsigned char* lds, const Inputs& I, const Bufs& B, const SsdBufs& X, int b, int c, int g) {
  const int tid = fx::otid(), lane = tid & 63, wid = __builtin_amdgcn_readfirstlane(tid >> 6), r32 = lane & 31, hi = lane >> 5;
  const size_t tok0 = (size_t)b * S + (size_t)c * 256; const int l = 32 * wid + r32;
  LAS float* acsw = (LAS float*)(lds + 0) + wid * 32 * 8;
  LAS u16* stg1 = (LAS u16*)(lds + 16384) + wid * 2048; LAS u16* stg2 = (LAS u16*)(lds + 49152) + wid * 2048; LAS float* rstdL = (LAS float*)(lds + 81920);
  { const int row = lane >> 1, h4 = (lane & 1) * 4; const f32x4 a = *(const f32x4*)(X.ACS + (tok0 + 32 * wid + row) * 16 + g * 8 + h4); acsw[row * 8 + h4 + 0] = ex2(a.x); acsw[row * 8 + h4 + 1] = ex2(a.y); acsw[row * 8 + h4 + 2] = ex2(a.z); acsw[row * 8 + h4 + 3] = ex2(a.w); }
  bf16x8 qr[8];
#pragma unroll
  for (int d0 = 0; d0 < 8; ++d0) qr[d0] = *(const bf16x8*)(X.XC + (tok0 + l) * SCD + 1280 + g * 128 + d0 * 16 + hi * 8);
  float ssq[16];
#pragma unroll
  for (int r = 0; r < 16; ++r) ssq[r] = 0.f;
#define FSY_STAGE_P(h_) do { const int h__ = (h_); const u16* pp_ = X.STATE + (((size_t)b * 16 + c) * 16 + g * 8 + h__) * 8192; _Pragma("unroll") for (int q = 0; q < 2; ++q) { const int ch = wid + 8 * q; \
    __builtin_amdgcn_global_load_lds((const unsigned*)(pp_ + (size_t)lane * 128 + ch * 8), (LAS unsigned*)(lds + 90112 + (h__ & 1) * 16384 + ch * 1024), 16, 0, 0); } } while (0)
#define FSY_LOAD_YZ(h_) do { const int hh__ = g * 8 + (h_); _Pragma("unroll") for (int q = 0; q < 4; ++q) { const int row = q * 8 + (lane >> 3), ch = lane & 7; \
    ny1[q] = *(const u32x4*)(X.XC + (tok0 + 32 * wid + row) * SCD + hh__ * 64 + ch * 8); nz[q] = *(const u32x4*)(B.Z + (tok0 + 32 * wid + row) * 1024 + hh__ * 64 + ch * 8); } } while (0)
  u32x4 ny1[4], nz[4];
  FS_STAMP(34);
  FSY_STAGE_P(0); FSY_LOAD_YZ(0);
#pragma unroll 1
  for (int h = 0; h < 8; ++h) { const int hh = g * 8 + h;
    if (h == 0) asm volatile("s_waitcnt vmcnt(0) lgkmcnt(0)\n\ts_barrier" ::: "memory"); else asm volatile("s_waitcnt vmcnt(4) lgkmcnt(0)\n\ts_barrier" ::: "memory");
#pragma unroll
    for (int q = 0; q < 4; ++q) { const int row = q * 8 + (lane >> 3), ch = lane & 7; *(LAS u32x4*)(stg1 + row * 64 + ch * 8) = ny1[q]; *(LAS u32x4*)(stg2 + row * 64 + ch * 8) = nz[q]; }
    if (h + 1 < 8) { FSY_STAGE_P(h + 1); FSY_LOAD_YZ(h + 1); }
    f32x16 y[2];
#pragma unroll
    for (int r = 0; r < 16; ++r) { y[0][r] = 0.f; y[1][r] = 0.f; }
    { const LAS unsigned char* pb = lds + 90112 + (h & 1) * 16384 + hi * 1024 + r32 * 16;
#pragma unroll
      for (int d0 = 0; d0 < 8; ++d0) { const bf16x8 b0 = *(const LAS bf16x8*)(pb + d0 * 2048), b1 = *(const LAS bf16x8*)(pb + d0 * 2048 + 512);
        y[0] = __builtin_amdgcn_mfma_f32_32x32x16_bf16(qr[d0], b0, y[0], 0, 0, 0); y[1] = __builtin_amdgcn_mfma_f32_32x32x16_bf16(qr[d0], b1, y[1], 0, 0, 0); } }
    asm volatile("s_waitcnt lgkmcnt(0)" ::: "memory");
#pragma unroll
    for (int r = 0; r < 16; ++r) { const int row = crow(r, hi); const float ea = acsw[row * 8 + h];
#pragma unroll
      for (int d0 = 0; d0 < 2; ++d0) { const int idx = row * 64 + d0 * 32 + r32; const float yy = nv::bf2f(stg1[idx]) + ea * y[d0][r]; const float zz = nv::bf2f(stg2[idx]); const float yg = yy * zz * fx::fsig(zz); ssq[r] += yg * yg; stg1[idx] = nv::f2bf(yg); } }
    asm volatile("s_waitcnt lgkmcnt(0)" ::: "memory");
#pragma unroll
    for (int q = 0; q < 4; ++q) { const int row = q * 8 + (lane >> 3), ch = lane & 7; *(u32x4*)(B.YB + (tok0 + 32 * wid + row) * 1024 + hh * 64 + ch * 8) = *(const LAS u32x4*)(stg1 + row * 64 + ch * 8); }
    asm volatile("s_waitcnt lgkmcnt(0)" ::: "memory"); }
  FS_STAMP(35);
#pragma unroll
  for (int r = 0; r < 16; ++r) { float v = ssq[r];
#pragma unroll
    for (int o = 1; o < 32; o <<= 1) v += __shfl_xor(v, o);
    if (r32 == 0) rstdL[32 * wid + crow(r, hi)] = 1.0f / sqrtf(v * (1.f / 512.f) + nv::EPS); }
#undef FSY_STAGE_P
#undef FSY_LOAD_YZ
  asm volatile("s_waitcnt vmcnt(0) lgkmcnt(0)\n\ts_barrier" ::: "memory"); FS_STAMP(36);
#pragma unroll 1
  for (int q0 = tid; q0 < 256 * 64; q0 += 512 * 8) { float v[8][8];
#pragma unroll
    for (int u = 0; u < 8; ++u) { const int q = q0 + u * 512, row = q >> 6, c8 = (q & 63) * 8; fx::load8(B.YB + (tok0 + row) * 1024 + g * 512 + c8, v[u]); }
#pragma unroll
    for (int u = 0; u < 8; ++u) { const int q = q0 + u * 512, row = q >> 6, c8 = (q & 63) * 8; const float rs = rstdL[row];
#pragma unroll
      for (int j = 0; j < 8; ++j) v[u][j] = v[u][j] * rs * I.ssm_norm[g * 512 + c8 + j];
      fx::store8(B.YB + (tok0 + row) * 1024 + g * 512 + c8, v[u]); } }
  __syncthreads();
}
__device__ __forceinline__ void phase_ssd_y(LAS unsigned char* lds, const Inputs& I, const Bufs& B, const SsdBufs& X) {
  for (int u = blockIdx.x; u < 256; u += gridDim.x) ssd_y_unit(lds, I, B, X, u >> 5, (u >> 1) & 15, u & 1);
}
}
namespace fc {
using nv::u16; using nv::Bufs; using nv::Inputs; using pg8::Unit;
constexpr int S = nv::S;
struct CmpBufs { u16* WcT; float* BIAS1; float* PAB; };
__host__ __device__ inline size_t carve_cmp(CmpBufs& C, unsigned char* ws, size_t off) {
  auto take = [&](size_t bytes) { unsigned char* r = ws + off; off += (bytes + 255) / 256 * 256; return r; };
  C.WcT = (u16*)take((size_t)2 * 256 * 1024 * 2); C.BIAS1 = (float*)take(2 * 128 * 4); C.PAB = (float*)take((size_t)2 * 2 * 16 * 256 * 256 * 4);
  return off;
}
struct CpCmp { const float* src; int ld; __device__ const float* operator()(int n) const { return n < 128 ? src + n : src + (size_t)1024 * 128 + (n - 128); } };
__device__ __forceinline__ void prologue_cmp(LAS unsigned char* lds, const Inputs& I, const CmpBufs& C) {
  { const int tid = fx::otid(), lane = tid & 63, wv = tid >> 6, gw = fx::obid() * 8 + wv, ngw = gridDim.x * 8; LAS float* scr = (LAS float*)lds + wv * (64 * 33);
    for (int t = gw; t < 2 * 8 * 16; t += ngw) { const int kv = t >> 7, q = t & 127; CpCmp cp{kv ? I.w1_v : I.w1_k, 128}; fx::transpose_item(scr, cp, C.WcT + (size_t)kv * 256 * 1024, 1024, (q >> 4) * 32, (q & 15) * 64, lane); } }
  { const int tid = fx::otid(), lane = tid & 63, gw = fx::obid() * 8 + (tid >> 6);
    if (gw < 256) { const int kv = gw >> 7, n = gw & 127; const float* w1 = kv ? I.w1_v : I.w1_k; const float* pos = kv ? I.pos_v : I.pos_k; float s = 0.f;
      for (int k = lane; k < 2048; k += 64) s += pos[k] * w1[(size_t)k * 128 + n];
      s = fx::wave_sum(s); if (lane == 0) C.BIAS1[kv * 128 + n] = s; } }
}
struct SchedCmp { int kv, bg, kh;
  __device__ bool next(int i, Unit& u) const { if (i > 0) return false; u.pm = (kh * 2 + kv) * 16 + bg; u.pn = 0; u.aux0 = 0; u.aux1 = 0; return true; }
  __device__ __forceinline__ const char* a_base(const pg8::Gemm& g, const Unit&) const { return (const char*)g.A + (size_t)kh * 8 * 1280 * 2; }
  __device__ __forceinline__ const char* b_base(const pg8::Gemm& g, const Unit&) const { return (const char*)g.Bt + ((size_t)kv * 256 * 1024 + (size_t)kh * 512) * 2; }
  __device__ __forceinline__ int a_row(const Unit&, int r) const { return ((bg >> 1) * S + 16 * r) * 1280 + (kv ? nv::O_VC : nv::O_KC) + (bg & 1) * 64; } };
struct FPab { float* o; __device__ __forceinline__ void operator()(const Unit&, int row, int c, const float (&v)[8]) const { float* p = o + (size_t)row * 256 + c; *(pg8::f32x4*)p = (pg8::f32x4){v[0], v[1], v[2], v[3]}; *(pg8::f32x4*)(p + 4) = (pg8::f32x4){v[4], v[5], v[6], v[7]}; } };
__device__ __forceinline__ void phase_cmp_gemm(LAS unsigned char* lds, const Bufs& B, const CmpBufs& C) {
  for (int u = (int)blockIdx.x - ((int)gridDim.x - 64); u >= 0 && u < 64; u += gridDim.x) { pg8::Gemm g{B.QKV, C.WcT, 256, 256, 512, 1, 1024, 1280 * 2}; SchedCmp S{(u >> 4) & 1, u & 15, u >> 5}; fx::Epi8<FPab> E{FPab{C.PAB}};
    pg8::gemm_phase<fx::Epi8<FPab>, SchedCmp, true, true>(lds, g, S, E); }
}
__device__ __forceinline__ void phase_cmp_finish(LAS unsigned char* lds, const Inputs& I, const Bufs& B, const CmpBufs& C) {
  const int tid = fx::otid(), lane = tid & 63, wv = tid >> 6, gw = fx::obid() * 8 + wv, ngw = gridDim.x * 8;
  LAS float* w2s = (LAS float*)lds; LAS float* hs = (LAS float*)(lds + 65536) + wv * 128;
  for (int k = tid; k < 2 * 128 * 64 / 4; k += 512) { const int kv = k >> 11, q = k & 2047; *(LAS pg8::f32x4*)(w2s + kv * 8192 + q * 4) = *(const pg8::f32x4*)((kv ? I.w2_v : I.w2_k) + q * 4); }
  __syncthreads();
  for (int it = gw; it < 2 * 16 * 256; it += ngw) { const int kv = it >> 12, bg = (it >> 8) & 15, c = it & 255; u16* dst = (kv ? B.VCMP : B.KCMP) + ((size_t)bg * 256 + c) * 64;
    if (c == 255) { dst[lane] = 0; continue; }
    const float* pa = C.PAB + ((size_t)(kv * 16 + bg) * 256 + c) * 256; const float* pb = pa + 256 + 128; const float* b1 = C.BIAS1 + kv * 128;
    const float* pa2 = pa + (size_t)2 * 16 * 256 * 256; const float* pb2 = pb + (size_t)2 * 16 * 256 * 256;
    { const float ha = (pa[lane] + pa2[lane]) + (pb[lane] + pb2[lane]) + b1[lane], hb = (pa[64 + lane] + pa2[64 + lane]) + (pb[64 + lane] + pb2[64 + lane]) + b1[64 + lane]; hs[lane] = ha * fx::fsig(ha); hs[64 + lane] = hb * fx::fsig(hb); }
    const LAS float* w2 = w2s + kv * 8192; float acc = 0.f;
#pragma unroll 8
    for (int n = 0; n < 128; ++n) acc += hs[n] * w2[n * 64 + lane];
    if (kv == 0) { const float ss = fx::wave_sum(acc * acc); acc = acc * (1.0f / sqrtf(ss * (1.f / 64.f) + nv::EPS)) * I.kc_gain[lane]; }
    dst[lane] = nv::f2bf(acc); }
  __syncthreads();
}
}
struct Params { nv::Inputs I; float* out; unsigned char* ws; };
constexpr int LDS_BYTES = 147456;
template <class F> __device__ __forceinline__ void run_phase(const F& f, long n) {
  for (long i = blockIdx.x * 512L + fx::otid(); i < n; i += (long)gridDim.x * 512L) f(i);
}
__global__ void __launch_bounds__(512) mega_fwd(Params P) {
  extern __shared__ __attribute__((aligned(16))) unsigned char lds_raw[];
  LAS unsigned char* lds = (LAS unsigned char*)lds_raw;
  cg::grid_group grid = cg::this_grid();
#define PH(...) { unsigned char* ws_ = P.ws; float* out = P.out; asm volatile("" : "+s"(ws_), "+s"(out)); nv::Bufs B; const size_t woff = nv::carve(B, ws_, out); fx::WBufs W; const size_t moff = fx::carve_w(W, ws_, woff); \
    fx::MoeBufs M; const size_t soff = fx::carve_moe(M, B, ws_, moff); fs::SsdBufs X; const size_t coff = fs::carve_ssd(X, B, ws_, soff); fc::CmpBufs C; const size_t boff = fc::carve_cmp(C, ws_, coff); unsigned* barw = (unsigned*)(ws_ + boff); (void)barw; (void)W; (void)M; (void)X; (void)C; __VA_ARGS__ }
  if (threadIdx.x < 4) ((LAS unsigned*)(lds + LDS_BYTES - 16))[threadIdx.x] = 0u;
  __syncthreads();
  xb::XcdBarrier bar; PH( bar = xb::xcd_barrier_post(barw, (volatile LAS unsigned*)(lds + LDS_BYTES - 16)); )
#define GSYNC() xb::xcd_barrier(bar)
  PH( fx::phase_prologue(lds, P.I, B, W); fx::phase_rms_rows(P.I.x, P.I.mix_norm, B.HB); fx::prologue_pb(P.I, W); fx::prologue_moe(P.I, M); fc::prologue_cmp(lds, P.I, C); ) grid.sync();
  PH( fx::dense_gemm(lds, B.HB, 1024, W.WinT, 1024, nv::NTOK, fx::INW_PAD, 1024, fx::FInProj{B.QKV, B.Z, B.XBC, B.BG, B.NG, B.DT, P.I.dt_bias}); ) GSYNC();
  PH( fc::phase_cmp_gemm(lds, B, C); fs::phase_conv(P.I, B, X); fa::phase_qknorm(P.I, B); ) GSYNC();
  PH( fs::phase_ssd_x(lds, P.I, B, X); ) GSYNC();
  PH( fs::phase_ssd_scan(X); fc::phase_cmp_finish(lds, P.I, B, C); ) GSYNC();
  PH( fs::phase_ssd_y(lds, P.I, B, X); ) GSYNC();
  PH( fa::phase_attention(lds, P.I, B); ) GSYNC();
  PH( fx::dense_gemm(lds, B.YA, 512, W.WaT, 512, nv::NTOK, 1024, 512, fx::FStoreBf{B.T1, 1024}); )
  PH( fx::dense_gemm(lds, B.YB, 1024, W.WbT, 1024, nv::NTOK, 1024, 1024, fx::FMerge{B.T1, B.BG, B.MERGED}); ) GSYNC();
  PH( fx::dense_gemm(lds, B.MERGED, 1024, W.WoutT, 1024, nv::NTOK, 1024, 1024, fx::FResid{P.I.x, (nv::u16*)out}); ) GSYNC();
  PH( fx::phase_rms_rows_bf((const nv::u16*)out, P.I.moe_norm, B.H2); ) GSYNC();
  PH( fx::dense_gemm(lds, B.H2, 1024, M.WrT, 1024, nv::NTOK, 256, 1024, fx::FLogits{M.LOGITS}); ) GSYNC();
  PH( fx::phase_route(lds, P.I, B, M); ) GSYNC();
  PH( fx::build_tile_table(lds, M); )
  PH( fx::phase_moe_gu(lds, B, W, M); ) GSYNC();
  PH( fx::phase_moe_down(lds, B, W, M); ) GSYNC();
  PH( fx::phase_moe_combine(lds, (const nv::u16*)out, B.ACT, M, B.EW, P.I.ple_norm, B.H2); ) GSYNC();
  PH( fx::dense_gemm(lds, W.PB, 256, W.PlePT, 256, nv::NTOK, 1024, 256, fx::FStoreBf{B.PP, 1024}); )
  PH( fx::dense_gemm(lds, B.H2, 1024, W.PleGT, 1024, nv::NTOK, 1024, 1024, fx::FPle{B.ACT, out, B.PP}); )
#undef GSYNC
}
extern "C" void kernel_launch(void* const* d_in, const int* in_sizes, int n_in, void* d_out, int out_size, void* d_ws, size_t ws_size, hipStream_t stream) {
  static int grid_blocks = 0;
  if (!grid_blocks) {
    int dev = 0, cus = 0, per_cu = 0;
    (void)hipGetDevice(&dev);
    (void)hipDeviceGetAttribute(&cus, hipDeviceAttributeMultiprocessorCount, dev);
    if (hipFuncSetAttribute((const void*)mega_fwd, hipFuncAttributeMaxDynamicSharedMemorySize, LDS_BYTES) != hipSuccess) fprintf(stderr, "kernel_launch: hipFuncSetAttribute failed\n");
    if (hipOccupancyMaxActiveBlocksPerMultiprocessor(&per_cu, mega_fwd, 512, LDS_BYTES) != hipSuccess || per_cu < 1) { fprintf(stderr, "kernel_launch: occupancy query says %d blocks per CU\n", per_cu); }
    grid_blocks = cus;
    { nv::Bufs B; fx::WBufs W; fx::MoeBufs M; fs::SsdBufs X; fc::CmpBufs C; size_t need = 16384 + fc::carve_cmp(C, nullptr, fs::carve_ssd(X, B, nullptr, fx::carve_moe(M, B, nullptr, fx::carve_w(W, nullptr, nv::carve(B, nullptr, nullptr))))); if (need > ws_size) fprintf(stderr, "kernel_launch: workspace too small: need %zu have %zu\n", need, ws_size); }
  }
  static size_t bar_off = 0;
  if (!bar_off) { nv::Bufs B; fx::WBufs W; fx::MoeBufs M; fs::SsdBufs X; fc::CmpBufs C; bar_off = fc::carve_cmp(C, nullptr, fs::carve_ssd(X, B, nullptr, fx::carve_moe(M, B, nullptr, fx::carve_w(W, nullptr, nv::carve(B, nullptr, nullptr))))); }
  (void)hipMemsetAsync((char*)d_ws + bar_off, 0, 16384, stream);
  Params p; memset(&p, 0, sizeof(p));
  const float** ip = (const float**)&p.I; for (int i = 0; i < 34; ++i) ip[i] = (const float*)d_in[i];
  p.out = (float*)d_out; p.ws = (unsigned char*)d_ws;
  void* args[] = {&p};
  hipError_t e = hipLaunchCooperativeKernel((void*)mega_fwd, dim3(grid_blocks), dim3(512), args, LDS_BYTES, stream);
  if (e != hipSuccess) fprintf(stderr, "cooperative launch failed: %s (grid %d)\n", hipGetErrorString(e), grid_blocks);
}
```

```cpp
#include <hip/hip_runtime.h>
#include <hip/hip_cooperative_groups.h>
#include <cstdio>
#include <cstring>
namespace cg = cooperative_groups;
#define HD __host__ __device__ inline
#if defined(__HIP_DEVICE_COMPILE__)
#define NV_FENCE() asm volatile("" ::: "memory")
#else
#define NV_FENCE()
#endif
#ifndef CFG_DM
#define CFG_DM 1024
#endif
#ifndef CFG_BATCH
#define CFG_BATCH 8
#endif
#ifndef CFG_SEQ
#define CFG_SEQ 4096
#endif
#ifndef CFG_MH
#define CFG_MH 256
#endif
#ifndef CFG_PLE
#define CFG_PLE 256
#endif

#ifndef NV_FENCE
#define NV_FENCE()
#endif
namespace nv {
typedef unsigned short u16;
typedef unsigned long long u64;
constexpr int DM = CFG_DM, NB = CFG_BATCH, S = CFG_SEQ, MH = CFG_MH, PLE = CFG_PLE;
constexpr int NTOK = NB * S;
constexpr int H = 8, G = 2, E = 4;
constexpr int QW = 512, GW = 24, QKVW = 1280;
constexpr int SH = 16, SP = 64, SI = 1024, SG = 2, SN = 128, SCD = 1536;
constexpr int INW = QW + 6 * 128 + GW + SI + SCD + SH + 2 * DM;
constexpr int O_Q = 0, O_KC = 512, O_VC = 640, O_KS = 768, O_VS = 896, O_KW = 1024, O_VW = 1152, O_NG = 1280, O_Z = 1304, O_XBC = 2328, O_DT = 3864, O_BG = 3880;
static_assert(O_BG + 2 * DM == INW, "in-proj width");
constexpr int NCMP = S / 16 - 1, NCP = S / 16, NSEL = S / 64, NTOP = NSEL < 16 ? NSEL : 16;
constexpr int NEXP = 32;
constexpr float EPS = 1e-6f;

HD float sigmoidf_(float x) { return 1.0f / (1.0f + expf(-x)); }
HD float siluf_(float x) { return x / (1.0f + expf(-x)); }
HD float softplusf_(float x) { return x > 20.f ? x : log1pf(expf(x)); }
HD u16 f2bf(float f) { unsigned u = __builtin_bit_cast(unsigned, f); u += 0x7fffu + ((u >> 16) & 1u); return (u16)(u >> 16); }
HD float bf2f(u16 h) { return __builtin_bit_cast(float, (unsigned)h << 16); }

struct Bufs {
  u16* HB;
  u16* QKV;
  float* NG;
  u16* Z;
  u16* XBC;
  float* DT;
  u16* BG;
  u16* KCMP;
  u16* VCMP;
  u16* YA;
  u16* YB;
  u16* T1;
  u16* MERGED;
  u16* H2;
  u16* ACT;
  u16* PP;
  int* EI;
  float* EW;
  float* HID;
  float* KTMP;
  float* ML;
  float* IMP;
  u64* MASK;
};
struct Inputs { const float *x, *p, *mix_norm, *w_in, *q_gain, *kc_gain, *ks_gain, *kw_gain, *pos_k, *w1_k, *w2_k, *pos_v, *w1_v, *w2_v, *conv_w, *conv_b, *dt_bias, *a_log, *d_skip, *ssm_norm,
  *w_a, *w_b, *w_out, *moe_norm, *w_group, *b_group, *w_expert, *b_expert, *w_gate, *w_up, *w_down, *ple_norm, *ple_wg, *ple_wp; };

HD size_t carve(Bufs& B, unsigned char* ws, float* out) {
  size_t off = 0; auto take = [&](size_t bytes) { unsigned char* r = ws + off; off += (bytes + 255) / 256 * 256; return r; };
  const size_t N = NTOK;
  B.BG = (u16*)out;
  unsigned char* R0 = take(N * DM * 2);
  unsigned char* R5 = take(N * 2 * MH * 2 + (size_t)NEXP * 256 * MH * 2);
  B.YA = (u16*)take(N * QW * 2);
  unsigned char* R1 = take(N * QKVW * 2);
  unsigned char* R2 = take(N * SI * 2);
  unsigned char* R3 = take(N * SCD * 2);
  B.HB = (u16*)R0; B.H2 = (u16*)R0; B.QKV = (u16*)R1; B.T1 = (u16*)R1; B.Z = (u16*)R2; B.XBC = (u16*)R3; B.MERGED = (u16*)R3; B.PP = (u16*)R3;
  B.ACT = (u16*)R5; B.YB = B.Z;
  B.NG = (float*)take(N * GW * 4); B.DT = (float*)take(N * SH * 4);
  B.KCMP = (u16*)take((size_t)NB * G * NCP * 64 * 2); B.VCMP = (u16*)take((size_t)NB * G * NCP * 64 * 2);
  B.EI = (int*)take(N * 2 * 4); B.EW = (float*)take(N * 2 * 4);
#ifdef NV2_NAIVE_SCRATCH
  B.HID = (float*)take((size_t)NB * G * NCMP * 128 * 4); B.KTMP = (float*)take((size_t)NB * G * NCMP * 64 * 4);
  B.ML = (float*)take(N * H * 2 * 4); B.IMP = (float*)take((size_t)NB * G * S * 64 * 4); B.MASK = (u64*)take((size_t)NB * G * S * 8);
#else
  B.HID = nullptr; B.KTMP = nullptr; B.ML = nullptr; B.IMP = nullptr; B.MASK = nullptr;
#endif
  return off;
}
}
namespace xb {
#define LAS __attribute__((address_space(3)))
#define XB_TMO      128
#define XB_XCNT(j)  (256  + 64 * (j))
#define XB_XSUB(j)  (1280 + 64 * (j))
#define XB_XGEN(j)  (2304 + 64 * (j))
#define XB_TOP      3328
#define XB_TOPGEN   3392
#define XCD_BAR_WORDS 3456
#define XB_SPIN_CAP (1u << 22)

__device__ __forceinline__ unsigned xb_ld(unsigned* p)              { return __hip_atomic_load(p, __ATOMIC_RELAXED, __HIP_MEMORY_SCOPE_AGENT); }
__device__ __forceinline__ unsigned xb_add(unsigned* p, unsigned v) { return __hip_atomic_fetch_add(p, v, __ATOMIC_RELAXED, __HIP_MEMORY_SCOPE_AGENT); }
__device__ __forceinline__ unsigned xb_xcc_id() { return (unsigned)__builtin_amdgcn_s_getreg((3 << 11) | 20) & 0xFu; }
#define XB_SPIN(cond, bar) do { unsigned _sp = 0; while (cond) { __builtin_amdgcn_s_sleep(1); \
    if ((++_sp & 255u) == 0u) { if (xb_ld(&(bar)[XB_TMO])) break; if (_sp > XB_SPIN_CAP) { atomicAdd(&(bar)[XB_TMO], 1u); break; } } } } while (0)

struct XcdBarrier {
    unsigned* bar; unsigned x;
    volatile LAS unsigned* st;
};

__device__ __forceinline__ XcdBarrier xcd_barrier_post(unsigned* bar, volatile LAS unsigned* st) {
    XcdBarrier b; b.bar = bar; b.x = xb_xcc_id(); b.st = st;
    if (threadIdx.x == 0) (void)xb_add(&bar[XB_XCNT(b.x)], 1u);
    return b;
}
__device__ __forceinline__ void xcd_barrier_complete(unsigned* bar, unsigned x, unsigned& nloc, unsigned& nx) {
    const unsigned G = gridDim.x * gridDim.y * gridDim.z;
    unsigned sum, cnt, mine, sp = 0u;
    for (;;) {
        sum = 0u; cnt = 0u; mine = 0u;
#pragma unroll
        for (unsigned j = 0; j < 16; ++j) { const unsigned c = xb_ld(&bar[XB_XCNT(j)]); sum += c; cnt += (c > 0u) ? 1u : 0u; mine = (j == x) ? c : mine; }
        if (sum == G) break;
        __builtin_amdgcn_s_sleep(1);
        if ((++sp & 255u) == 0u) { if (xb_ld(&bar[XB_TMO])) break; if (sp > XB_SPIN_CAP) { atomicAdd(&bar[XB_TMO], 1u); break; } }
    }
    nloc = mine > 0u ? mine : 1u; nx = cnt > 0u ? cnt : 1u;
}

__device__ __forceinline__ void xcd_barrier(const XcdBarrier& b) {
    asm volatile("s_waitcnt vmcnt(0)" ::: "memory");
    __syncthreads();
    if (threadIdx.x == 0) {
        unsigned* bar = b.bar;
        __builtin_amdgcn_s_waitcnt(0);
        unsigned nloc = b.st[0], nx = b.st[1];
        if (nloc == 0u) { xcd_barrier_complete(bar, b.x, nloc, nx); b.st[0] = nloc; b.st[1] = nx; }
        const unsigned old = xb_add(&bar[XB_XSUB(b.x)], 1u);
        const unsigned gen = old / nloc;
        if (old + 1u == (gen + 1u) * nloc) {
            __builtin_amdgcn_fence(__ATOMIC_RELEASE, "agent");
            asm volatile("s_waitcnt vmcnt(0)" ::: "memory");
            const unsigned og = xb_add(&bar[XB_TOP], 1u);
            const unsigned tg = og / nx;
            if (og + 1u == (tg + 1u) * nx) xb_add(&bar[XB_TOPGEN], 1u);
            else XB_SPIN(xb_ld(&bar[XB_TOPGEN]) == tg, bar);
            __builtin_amdgcn_fence(__ATOMIC_ACQUIRE, "agent");
            xb_add(&bar[XB_XGEN(b.x)], 1u);
            asm volatile("s_waitcnt vmcnt(0)" ::: "memory");
        } else {
            XB_SPIN(xb_ld(&bar[XB_XGEN(b.x)]) == gen, bar);
            __builtin_amdgcn_fence(__ATOMIC_ACQUIRE, "agent");
            asm volatile("s_waitcnt vmcnt(0)" ::: "memory");
        }
    }
    __syncthreads();
}
}
namespace pg8 {
#define PG8_LAS __attribute__((address_space(3)))
typedef unsigned short bf16_t;
typedef short bf16x8 __attribute__((ext_vector_type(8)));
typedef float f32x4 __attribute__((ext_vector_type(4)));
typedef unsigned u32x4 __attribute__((ext_vector_type(4)));
typedef unsigned u32x2 __attribute__((ext_vector_type(2)));
constexpr int BM = 256, BK = 64, HALF = 128, HTB = HALF * BK * 2  , STAGE_BYTES = 8 * HTB, NXCD = 8, WGM = 8;

__host__ __device__ __forceinline__ int lds_byte(int r, int c) { const int st = (r >> 4) * 2 + (c >> 5), rr = r & 15, cc = c & 31, ob = rr * 64 + cc * 2; return st * 1024 + (ob ^ (((ob >> 9) & 1) << 5)); }
__host__ __device__ __forceinline__ void stage_rc(int b, int& R, int& C) { const int st = b / 1024, sb = b % 1024, swz = sb ^ (((sb >> 9) & 1) << 5); R = (st >> 1) * 16 + swz / 64; C = (st & 1) * 32 + (swz % 64) / 2; }
__host__ __device__ __forceinline__ int perm32(int rho) { const int n = rho >> 4, i = rho & 15; return 8 * (i >> 2) + 4 * n + (i & 3); }

struct Unit { int pm, pn, aux0, aux1; };
struct Gemm { const bf16_t* A; const bf16_t* Bt; int M, N, K, lda, ldb, kstepA; };

struct StaticOrder {
    int nM, nN, nwg, G, c;
    __device__ void init(int M, int N, int G_, int c_) { nM = M / BM; nN = N / BM; nwg = nM * nN; G = G_; c = c_; }
    __device__ bool next(int i, Unit& u) const {
        const long L = (long)i * G + c; if (L >= nwg) return false;
        int wgid = (int)L; { const int q = nwg / NXCD, r = nwg % NXCD, xcd = wgid % NXCD, off = wgid / NXCD; wgid = (xcd < r ? xcd * (q + 1) : r * (q + 1) + (xcd - r) * q) + off; }
        const int nig = WGM * nN, gid = wgid / nig, fm = gid * WGM, gsz = (nM - fm) < WGM ? (nM - fm) : WGM;
        u.pm = fm + ((wgid % nig) % gsz); u.pn = (wgid % nig) / gsz; u.aux0 = 0; u.aux1 = 0; return true;
    }
    __device__ __forceinline__ const char* a_base(const Gemm& g, const Unit& u) const { return (const char*)g.A + (size_t)u.pm * BM * g.lda * 2; }
    __device__ __forceinline__ const char* b_base(const Gemm& g, const Unit& u) const { return (const char*)g.Bt + (size_t)u.pn * BM * g.ldb * 2; }
    __device__ __forceinline__ int a_row(const Unit&, int) const { return 0; }
};

typedef float f32x2_t __attribute__((ext_vector_type(2))); typedef __bf16 bf16x2_t __attribute__((ext_vector_type(2)));
__device__ __forceinline__ unsigned cvt_pk_bf16(float lo, float hi) { f32x2_t v = {lo, hi}; bf16x2_t b = __builtin_convertvector(v, bf16x2_t); return __builtin_bit_cast(unsigned, b); }


template <class Epi, class Sched, bool ALIGN_EPI = true, bool GATHER = false>
__device__ __forceinline__ void gemm_phase(PG8_LAS unsigned char* lds, const Gemm g, const Sched& S, const Epi& E) {
    int tid_ = threadIdx.x; asm volatile("" : "+v"(tid_));
    const int tid = tid_, wid = __builtin_amdgcn_readfirstlane(tid >> 6), lane = tid & 63, wr = wid >> 2, wc = wid & 3, fr = lane & 15, fq = lane >> 4;
    const int K = g.K, nt = K / BK;
    unsigned voffA[2], voffA1[2], voffB[2];
    int RA[2], CA[2];
#pragma unroll
    for (int i = 0; i < 2; ++i) { int R, C; stage_rc(tid * 16 + i * 8192, R, C); const int Rb = Epi::PERM ? ((R & ~31) + perm32(R & 31)) : R;
        RA[i] = R; CA[i] = C; voffA[i] = (unsigned)(R * g.lda + C) * 2u; voffA1[i] = voffA[i]; voffB[i] = (unsigned)(Rb * g.ldb + C) * 2u; }
    const size_t kstep = (size_t)(BK * 2);
    const size_t kstepA = (size_t)g.kstepA;
    const size_t hstepA = GATHER ? (size_t)0 : (size_t)HALF * g.lda * 2;
    const size_t hstepB = (size_t)HALF * g.ldb * 2;
    const unsigned ldsw = (unsigned)wid * 1024u;
    const int aoff = lds_byte(wr * 64 + fr, fq * 8), boff = lds_byte(wc * 32 + fr, fq * 8);
#define PG8_SA(b, h) (((b) * 2 + (h)) * HTB)
#define PG8_SB(b, h) ((4 + (b) * 2 + (h)) * HTB)
#define PG8_STAGE(bufoff, gbase, voff) do { _Pragma("unroll") for (int _i = 0; _i < 2; ++_i) \
        __builtin_amdgcn_global_load_lds((const unsigned*)((const char*)(gbase) + (voff)[_i]), (PG8_LAS unsigned*)(lds + (bufoff) + ldsw + _i * 8192), 16, 0, 0); } while (0)
#define PG8_STAGE_A0(bufoff, gbase) PG8_STAGE(bufoff, gbase, voffA)
#define PG8_STAGE_A1(bufoff, gbase) do { if constexpr (GATHER) { PG8_STAGE(bufoff, gbase, voffA1); } else { PG8_STAGE(bufoff, (gbase) + hstepA, voffA); } } while (0)
#define PG8_LDA(dst, b, h) do { _Pragma("unroll") for (int m = 0; m < 4; ++m) _Pragma("unroll") for (int k = 0; k < 2; ++k) dst[m][k] = *(const PG8_LAS bf16x8*)(lds + PG8_SA(b, h) + aoff + m * 2048 + k * 1024); } while (0)
#define PG8_LDB(dst, b, h) do { _Pragma("unroll") for (int n = 0; n < 2; ++n) _Pragma("unroll") for (int k = 0; k < 2; ++k) dst[n][k] = *(const PG8_LAS bf16x8*)(lds + PG8_SB(b, h) + boff + n * 2048 + k * 1024); } while (0)
#define PG8_MMA(ai, bj, At, Bt) do { __builtin_amdgcn_s_setprio(1); _Pragma("unroll") for (int m = 0; m < 4; ++m) _Pragma("unroll") for (int n = 0; n < 2; ++n) _Pragma("unroll") for (int k = 0; k < 2; ++k) \
        acc[ai][bj][m][n] = __builtin_amdgcn_mfma_f32_16x16x32_bf16(Bt[n][k], At[m][k], acc[ai][bj][m][n], 0, 0, 0); __builtin_amdgcn_s_setprio(0); } while (0)
#define PG8_WAIT_V(n) asm volatile("s_waitcnt vmcnt(" #n ")" ::: "memory")
#define PG8_WAIT_L(n) asm volatile("s_waitcnt lgkmcnt(" #n ")" ::: "memory")
#define PG8_BAR __builtin_amdgcn_s_barrier()
#define PG8_SCHED __builtin_amdgcn_sched_barrier(0)
    Unit cur, nxt; int ui = 0;
    if (!S.next(0, cur)) return;
    if constexpr (GATHER) {
#pragma unroll
        for (int i = 0; i < 2; ++i) { voffA[i] = (unsigned)(S.a_row(cur, RA[i]) * g.lda + CA[i]) * 2u; voffA1[i] = (unsigned)(S.a_row(cur, HALF + RA[i]) * g.lda + CA[i]) * 2u; }
    }
    f32x4 acc[2][2][4][2];
#pragma unroll
    for (int a = 0; a < 2; ++a)
#pragma unroll
        for (int b = 0; b < 2; ++b)
#pragma unroll
            for (int m = 0; m < 4; ++m)
#pragma unroll
                for (int n = 0; n < 2; ++n) acc[a][b][m][n] = (f32x4){0.f, 0.f, 0.f, 0.f};
    bf16x8 At[4][2], B0[2][2], B1[2][2];
    const char* cA = S.a_base(g, cur); const char* cB = S.b_base(g, cur);
    PG8_STAGE(PG8_SB(0, 0), cB, voffB); PG8_STAGE(PG8_SB(0, 1), cB + hstepB, voffB); PG8_STAGE_A0(PG8_SA(0, 0), cA); PG8_STAGE_A1(PG8_SA(0, 1), cA);
    if (wr == 1) PG8_BAR;
    PG8_WAIT_V(2); PG8_BAR;
    PG8_STAGE(PG8_SB(1, 0), cB + kstep, voffB); PG8_STAGE_A0(PG8_SA(1, 0), cA + kstepA); PG8_STAGE(PG8_SB(1, 1), cB + hstepB + kstep, voffB);
    PG8_WAIT_V(6); PG8_BAR;
    for (;;) {
        const bool has_next = GATHER ? false : S.next(ui + 1, nxt);
        const char* nA = has_next ? S.a_base(g, nxt) : cA; const char* nB = has_next ? S.b_base(g, nxt) : cB;
#pragma unroll 1
        for (int t = 0; t < nt; t += 2) {
            const bool last = (t == nt - 2);
            const char* a1 = cA + (size_t)(t + 1) * kstepA;
            const char* a2 = last ? nA : cA + (size_t)(t + 2) * kstepA; const char* b2 = last ? nB : cB + (size_t)(t + 2) * kstep;
            const char* a3 = a2 + kstepA; const char* b3 = b2 + kstep;
            PG8_LDB(B0, 0, 0); PG8_LDB(B1, 0, 1); PG8_SCHED; PG8_LDA(At, 0, 0); PG8_STAGE_A1(PG8_SA(1, 1), a1);
            PG8_WAIT_V(8); PG8_WAIT_L(0); PG8_BAR; PG8_MMA(0, 0, At, B0); PG8_MMA(0, 1, At, B1); PG8_BAR; PG8_SCHED;
            PG8_LDA(At, 0, 1); PG8_STAGE(PG8_SB(0, 0), b2, voffB); PG8_STAGE(PG8_SB(0, 1), b2 + hstepB, voffB); PG8_STAGE_A0(PG8_SA(0, 0), a2);
            PG8_WAIT_V(8); PG8_WAIT_L(0); PG8_BAR; PG8_MMA(1, 0, At, B0); PG8_MMA(1, 1, At, B1); PG8_BAR; PG8_SCHED;
            PG8_LDB(B0, 1, 0); PG8_LDB(B1, 1, 1); PG8_SCHED; PG8_LDA(At, 1, 0); PG8_STAGE_A1(PG8_SA(0, 1), a2);
            PG8_WAIT_V(8); PG8_WAIT_L(0); PG8_BAR; PG8_MMA(0, 0, At, B0); PG8_MMA(0, 1, At, B1); PG8_BAR; PG8_SCHED;
            PG8_LDA(At, 1, 1); PG8_STAGE(PG8_SB(1, 0), b3, voffB); PG8_STAGE(PG8_SB(1, 1), b3 + hstepB, voffB); PG8_STAGE_A0(PG8_SA(1, 0), a3);
            PG8_WAIT_V(8); PG8_WAIT_L(0); PG8_BAR; PG8_MMA(1, 0, At, B0); PG8_MMA(1, 1, At, B1); PG8_BAR; PG8_SCHED;
        }
        if constexpr (ALIGN_EPI) { if (wr == 0) PG8_BAR; }
        E(acc, cur, wr, wc, fr, fq);
        if (!has_next) break;
#pragma unroll
        for (int a = 0; a < 2; ++a)
#pragma unroll
            for (int b = 0; b < 2; ++b)
#pragma unroll
                for (int m = 0; m < 4; ++m)
#pragma unroll
                    for (int n = 0; n < 2; ++n) acc[a][b][m][n] = (f32x4){0.f, 0.f, 0.f, 0.f};
        cur = nxt; cA = nA; cB = nB; ++ui;
        if constexpr (ALIGN_EPI) { if (wr == 1) PG8_BAR; }
    }
    PG8_WAIT_V(0);
    if constexpr (!ALIGN_EPI) { if (wr == 0) PG8_BAR; }
    PG8_BAR;
#undef PG8_SA
#undef PG8_SB
#undef PG8_STAGE
#undef PG8_STAGE_A0
#undef PG8_STAGE_A1
#undef PG8_LDA
#undef PG8_LDB
#undef PG8_MMA
#undef PG8_WAIT_V
#undef PG8_WAIT_L
#undef PG8_BAR
#undef PG8_SCHED
}
}
namespace fx {
using nv::u16; using nv::Bufs; using nv::Inputs;
using pg8::f32x4; using pg8::u32x4; using pg8::Unit;
#define LAS __attribute__((address_space(3)))
static_assert(nv::DM == 1024 && nv::NB == 8 && nv::S == 4096 && nv::MH == 256 && nv::PLE == 256, "fast phases are written for the full-size problem");
constexpr int NTOK = nv::NTOK, DM = 1024;
constexpr int INW_PAD = 6144;
constexpr int C_Z = 1280, C_XBC = 2304, C_BG = 3840, C_NG = 5888, C_DT = 5912, C_END = 5928;

struct WBufs { u16 *WinT, *WaT, *WbT, *WoutT, *PleGT, *PlePT, *WguT, *WdT, *PB; };
__host__ __device__ inline size_t carve_w(WBufs& W, unsigned char* ws, size_t off) {
  auto take = [&](size_t bytes) { unsigned char* r = ws + off; off += (bytes + 255) / 256 * 256; return r; };
  W.WinT = (u16*)take((size_t)INW_PAD * 1024 * 2); W.WaT = (u16*)take((size_t)1024 * 512 * 2); W.WbT = (u16*)take((size_t)1024 * 1024 * 2); W.WoutT = (u16*)take((size_t)1024 * 1024 * 2);
  W.PleGT = (u16*)take((size_t)1024 * 1024 * 2); W.PlePT = (u16*)take((size_t)1024 * 256 * 2); W.WguT = (u16*)take((size_t)32 * 512 * 1024 * 2); W.WdT = (u16*)take((size_t)32 * 1024 * 256 * 2);
  W.PB = (u16*)take((size_t)NTOK * 256 * 2);
  return off;
}

__device__ __forceinline__ int otid() { int t = threadIdx.x; asm volatile("" : "+v"(t)); return t; }
__device__ __forceinline__ int obid() { int b = blockIdx.x; asm volatile("" : "+s"(b)); return b; }
__device__ __forceinline__ float fsig(float x) { return __builtin_amdgcn_rcpf(1.0f + __expf(-x)); }
__device__ __forceinline__ float fsoftplus(float x) { const float e = __expf(x); return x > 20.f ? x : (e < 0.0625f ? e * (1.f - e * (0.5f - e * (0.33333333f - 0.25f * e))) : __logf(1.0f + e)); }
__device__ __forceinline__ unsigned pk2(float lo, float hi) { return pg8::cvt_pk_bf16(lo, hi); }
__device__ __forceinline__ void store8(u16* p, const float (&v)[8]) { u32x4 w; w.x = pk2(v[0], v[1]); w.y = pk2(v[2], v[3]); w.z = pk2(v[4], v[5]); w.w = pk2(v[6], v[7]); *(u32x4*)p = w; }
__device__ __forceinline__ void load8(const u16* p, float (&v)[8]) { const u32x4 w = *(const u32x4*)p;
  v[0] = __uint_as_float(w.x << 16); v[1] = __uint_as_float(w.x & 0xffff0000u); v[2] = __uint_as_float(w.y << 16); v[3] = __uint_as_float(w.y & 0xffff0000u);
  v[4] = __uint_as_float(w.z << 16); v[5] = __uint_as_float(w.z & 0xffff0000u); v[6] = __uint_as_float(w.w << 16); v[7] = __uint_as_float(w.w & 0xffff0000u); }

__device__ __forceinline__ float wave_sum(float v) {
#pragma unroll
  for (int o = 1; o < 64; o <<= 1) v += __shfl_xor(v, o);
  return v; }
__device__ __forceinline__ void rms_row_to_bf16(const float* xrow, const float* gain, u16* orow, int lane) {
  const f32x4* xr = (const f32x4*)xrow + lane; const f32x4* gr = (const f32x4*)gain + lane;
  f32x4 v[4]; float s = 0.f;
#pragma unroll
  for (int j = 0; j < 4; ++j) { v[j] = xr[64 * j]; s += (v[j].x * v[j].x + v[j].y * v[j].y) + (v[j].z * v[j].z + v[j].w * v[j].w); }
  const float rs = 1.0f / sqrtf(wave_sum(s) * (1.f / 1024.f) + nv::EPS);
  unsigned long long* o8 = (unsigned long long*)orow + lane;
#pragma unroll
  for (int j = 0; j < 4; ++j) { const f32x4 g = gr[64 * j]; o8[64 * j] = (unsigned long long)pk2(v[j].x * rs * g.x, v[j].y * rs * g.y) | ((unsigned long long)pk2(v[j].z * rs * g.z, v[j].w * rs * g.w) << 32); }
}
__device__ __forceinline__ void phase_rms_rows(const float* x, const float* gain, u16* out) {
  const int tid = otid(), lane = tid & 63, gw = obid() * 8 + (tid >> 6), ngw = gridDim.x * 8;
  for (int r = gw; r < NTOK; r += 4 * ngw) { f32x4 v[4][4]; float s[4];
#pragma unroll
    for (int q = 0; q < 4; ++q) { const int rq = (r + q * ngw < NTOK) ? r + q * ngw : r; const f32x4* xr = (const f32x4*)(x + (size_t)rq * 1024) + lane;
#pragma unroll
      for (int j = 0; j < 4; ++j) v[q][j] = xr[64 * j]; }
#pragma unroll
    for (int q = 0; q < 4; ++q) { s[q] = 0.f;
#pragma unroll
      for (int j = 0; j < 4; ++j) s[q] += (v[q][j].x * v[q][j].x + v[q][j].y * v[q][j].y) + (v[q][j].z * v[q][j].z + v[q][j].w * v[q][j].w);
      s[q] = 1.0f / sqrtf(wave_sum(s[q]) * (1.f / 1024.f) + nv::EPS); }
#pragma unroll
    for (int q = 0; q < 4; ++q) { if (r + q * ngw >= NTOK) break; unsigned long long* o8 = (unsigned long long*)(out + (size_t)(r + q * ngw) * 1024) + lane; const f32x4* gr = (const f32x4*)gain + lane;
#pragma unroll
      for (int j = 0; j < 4; ++j) { const f32x4 g = gr[64 * j]; o8[64 * j] = (unsigned long long)pk2(v[q][j].x * s[q] * g.x, v[q][j].y * s[q] * g.y) | ((unsigned long long)pk2(v[q][j].z * s[q] * g.z, v[q][j].w * s[q] * g.w) << 32); } } }
}
__device__ __forceinline__ void phase_rms_rows_bf(const u16* x, const float* gain, u16* out) {
  const int tid = otid(), lane = tid & 63, gw = obid() * 8 + (tid >> 6), ngw = gridDim.x * 8;
  for (int r = gw; r < NTOK; r += 4 * ngw) { u32x4 w[4][2]; float s[4];
#pragma unroll
    for (int q = 0; q < 4; ++q) { const int rq = (r + q * ngw < NTOK) ? r + q * ngw : r; const u32x4* xr = (const u32x4*)(x + (size_t)rq * 1024) + lane; w[q][0] = xr[0]; w[q][1] = xr[64]; }
#pragma unroll
    for (int q = 0; q < 4; ++q) { s[q] = 0.f;
#pragma unroll
      for (int j = 0; j < 2; ++j) { const unsigned e[4] = {w[q][j].x, w[q][j].y, w[q][j].z, w[q][j].w};
#pragma unroll
        for (int i = 0; i < 4; ++i) { const float lo = __uint_as_float(e[i] << 16), hi = __uint_as_float(e[i] & 0xffff0000u); s[q] += lo * lo + hi * hi; } }
      s[q] = 1.0f / sqrtf(wave_sum(s[q]) * (1.f / 1024.f) + nv::EPS); }
#pragma unroll
    for (int q = 0; q < 4; ++q) { if (r + q * ngw >= NTOK) break; u32x4* o = (u32x4*)(out + (size_t)(r + q * ngw) * 1024) + lane;
#pragma unroll
      for (int j = 0; j < 2; ++j) { const f32x4 g0 = *(const f32x4*)(gain + 512 * j + 8 * lane), g1 = *(const f32x4*)(gain + 512 * j + 8 * lane + 4); const u32x4 e = w[q][j]; const float rs = s[q]; u32x4 ov;
        ov.x = pk2(__uint_as_float(e.x << 16) * rs * g0.x, __uint_as_float(e.x & 0xffff0000u) * rs * g0.y); ov.y = pk2(__uint_as_float(e.y << 16) * rs * g0.z, __uint_as_float(e.y & 0xffff0000u) * rs * g0.w);
        ov.z = pk2(__uint_as_float(e.z << 16) * rs * g1.x, __uint_as_float(e.z & 0xffff0000u) * rs * g1.y); ov.w = pk2(__uint_as_float(e.w << 16) * rs * g1.z, __uint_as_float(e.w & 0xffff0000u) * rs * g1.w);
        o[64 * j] = ov; } } }
}
template <class CP> __device__ __forceinline__ void transpose_item(LAS float* scr, const CP cp, u16* dst, int K, int n0, int k0, int lane) {
  { const float* p = cp(n0 + (lane & 31));
#pragma unroll 8
    for (int i = 0; i < 32; ++i) { const int kk = 2 * i + (lane >> 5); scr[kk * 33 + (lane & 31)] = p ? p[(size_t)(k0 + kk) * cp.ld] : 0.f; } }
  asm volatile("s_waitcnt lgkmcnt(0)" ::: "memory");
  const int c = lane & 7;
#pragma unroll
  for (int j = 0; j < 4; ++j) { const int n = (lane >> 3) + 8 * j; const LAS float* s = scr + (8 * c) * 33 + n;
    u32x4 o; o.x = pk2(s[0 * 33], s[1 * 33]); o.y = pk2(s[2 * 33], s[3 * 33]); o.z = pk2(s[4 * 33], s[5 * 33]); o.w = pk2(s[6 * 33], s[7 * 33]);
    *(u32x4*)(dst + (size_t)(n0 + n) * K + k0 + 8 * c) = o; }
  asm volatile("s_waitcnt lgkmcnt(0)" ::: "memory");
}
struct CpIdent { const float* src; int ld; __device__ const float* operator()(int n) const { return src + n; } };
struct CpInProj { const float* src; int ld; __device__ const float* operator()(int n) const {
  int c; if (n < C_Z) c = n; else if (n < C_XBC) c = nv::O_Z + (n - C_Z); else if (n < C_BG) c = nv::O_XBC + (n - C_XBC); else if (n < C_NG) c = nv::O_BG + (n - C_BG); else if (n < C_DT) c = nv::O_NG + (n - C_NG); else if (n < C_END) c = nv::O_DT + (n - C_DT); else return nullptr;
  return src + c; } };
struct CpGU { const float* gate; long updelta; int ld; __device__ const float* operator()(int n) const { const int tile = n >> 8, r = n & 255; return gate + (r < 128 ? 0L : updelta) + tile * 128 + (r & 127); } };

struct WJob { const float* src; int ld; u16* dst; int K, n0, k0; };
__device__ __forceinline__ WJob wjob_decode(int t, const Inputs& I, const WBufs& W, int lane) {
  constexpr int T_IN = (INW_PAD / 32) * 16, T_A = 32 * 8, T_B = 32 * 16, T_O = 32 * 16, T_PG = 32 * 16, T_PP = 32 * 4, T_GU = 32 * 16 * 16;
  WJob j; int r = t; const int c = lane & 31;
  if (r < T_IN) { CpInProj cp{I.w_in, nv::INW}; j.n0 = (r / 16) * 32; j.k0 = (r % 16) * 64; j.src = cp(j.n0 + c); j.ld = nv::INW; j.dst = W.WinT; j.K = 1024; return j; } r -= T_IN;
  if (r < T_A) { j.n0 = (r / 8) * 32; j.k0 = (r % 8) * 64; j.src = I.w_a + j.n0 + c; j.ld = 1024; j.dst = W.WaT; j.K = 512; return j; } r -= T_A;
  if (r < T_B) { j.n0 = (r / 16) * 32; j.k0 = (r % 16) * 64; j.src = I.w_b + j.n0 + c; j.ld = 1024; j.dst = W.WbT; j.K = 1024; return j; } r -= T_B;
  if (r < T_O) { j.n0 = (r / 16) * 32; j.k0 = (r % 16) * 64; j.src = I.w_out + j.n0 + c; j.ld = 1024; j.dst = W.WoutT; j.K = 1024; return j; } r -= T_O;
  if (r < T_PG) { j.n0 = (r / 16) * 32; j.k0 = (r % 16) * 64; j.src = I.ple_wg + j.n0 + c; j.ld = 1024; j.dst = W.PleGT; j.K = 1024; return j; } r -= T_PG;
  if (r < T_PP) { j.n0 = (r / 4) * 32; j.k0 = (r % 4) * 64; j.src = I.ple_wp + j.n0 + c; j.ld = 1024; j.dst = W.PlePT; j.K = 256; return j; } r -= T_PP;
  if (r < T_GU) { const int e = r / 256, q = r % 256; CpGU cp{I.w_gate + (size_t)e * 1024 * 256, (long)(I.w_up - I.w_gate), 256}; j.n0 = (q / 16) * 32; j.k0 = (q % 16) * 64; j.src = cp(j.n0 + c); j.ld = 256; j.dst = W.WguT + (size_t)e * 512 * 1024; j.K = 1024; return j; } r -= T_GU;
  { const int e = r / 128, q = r % 128; j.n0 = (q / 4) * 32; j.k0 = (q % 4) * 64; j.src = I.w_down + (size_t)e * 256 * 1024 + j.n0 + c; j.ld = 1024; j.dst = W.WdT + (size_t)e * 1024 * 256; j.K = 256; return j; }
}
__device__ __forceinline__ void phase_prologue(LAS unsigned char* lds, const Inputs& I, const Bufs& B, const WBufs& W) {
  const int tid = otid(), lane = tid & 63, wv = tid >> 6, gw = obid() * 8 + wv, ngw = gridDim.x * 8;
  LAS float* scr = (LAS float*)lds + wv * (64 * 33);
  constexpr int TOT = (INW_PAD / 32) * 16 + 32 * 8 + 32 * 16 * 3 + 32 * 4 + 32 * 16 * 16 + 32 * 32 * 4;
  float cur[32];
  int t = gw; WJob jb;
  if (t < TOT) { jb = wjob_decode(t, I, W, lane);
#pragma unroll
    for (int i = 0; i < 32; ++i) cur[i] = jb.src ? jb.src[(size_t)(jb.k0 + 2 * i + (lane >> 5)) * jb.ld] : 0.f; }
  while (t < TOT) { const int tn = t + ngw; WJob jn = jb; float nxt[32];
    if (tn < TOT) { jn = wjob_decode(tn, I, W, lane);
#pragma unroll
      for (int i = 0; i < 32; ++i) nxt[i] = jn.src ? jn.src[(size_t)(jn.k0 + 2 * i + (lane >> 5)) * jn.ld] : 0.f; }
#pragma unroll
    for (int i = 0; i < 32; ++i) scr[(2 * i + (lane >> 5)) * 33 + (lane & 31)] = cur[i];
    asm volatile("s_waitcnt lgkmcnt(0)" ::: "memory");
    { const int c = lane & 7;
#pragma unroll
      for (int j = 0; j < 4; ++j) { const int n = (lane >> 3) + 8 * j; const LAS float* s = scr + (8 * c) * 33 + n;
        u32x4 o; o.x = pk2(s[0 * 33], s[1 * 33]); o.y = pk2(s[2 * 33], s[3 * 33]); o.z = pk2(s[4 * 33], s[5 * 33]); o.w = pk2(s[6 * 33], s[7 * 33]);
        *(u32x4*)(jb.dst + (size_t)(jb.n0 + n) * jb.K + jb.k0 + 8 * c) = o; } }
    asm volatile("s_waitcnt lgkmcnt(0)" ::: "memory");
    if (tn < TOT) {
#pragma unroll
      for (int i = 0; i < 32; ++i) cur[i] = nxt[i]; }
    jb = jn; t = tn; }
}
__device__ __forceinline__ void prologue_pb(const Inputs& I, const WBufs& W) {
  for (long i = blockIdx.x * 512L + otid(); i < (long)NTOK * 256 / 8; i += (long)gridDim.x * 512L) { const f32x4 a = ((const f32x4*)I.p)[2 * i], b = ((const f32x4*)I.p)[2 * i + 1];
    u32x4 o; o.x = pk2(a.x, a.y); o.y = pk2(a.z, a.w); o.z = pk2(b.x, b.y); o.w = pk2(b.z, b.w); ((u32x4*)W.PB)[i] = o; }
}

template <class F> struct Epi8 { static constexpr bool PERM = true; F f;
  __device__ __forceinline__ void operator()(const f32x4 (&acc)[2][2][4][2], const Unit& u, int wr, int wc, int fr, int fq) const {
#pragma unroll
    for (int ai = 0; ai < 2; ++ai)
#pragma unroll
      for (int m = 0; m < 4; ++m) { const int row = u.pm * 256 + ai * 128 + wr * 64 + m * 16 + fr;
#pragma unroll
        for (int bj = 0; bj < 2; ++bj) { const int col = u.pn * 256 + bj * 128 + wc * 32 + 8 * fq; const f32x4 a = acc[ai][bj][m][0], b = acc[ai][bj][m][1];
          const float v[8] = {a.x, a.y, a.z, a.w, b.x, b.y, b.z, b.w}; f(u, row, col, v); }
        if (m & 1) asm volatile("" ::: "memory"); } } };

struct FInProj { u16* QKV; u16* Z; u16* XBC; u16* BG; float* NG; float* DT; const float* dt_bias;
  __device__ __forceinline__ void operator()(const Unit&, int r, int c, const float (&v)[8]) const {
    if (c < C_Z) store8(QKV + (size_t)r * 1280 + c, v);
    else if (c < C_XBC) store8(Z + (size_t)r * 1024 + (c - C_Z), v);
    else if (c < C_BG) store8(XBC + (size_t)r * 1536 + (c - C_XBC), v);
    else if (c < C_NG) { float s[8];
#pragma unroll
      for (int i = 0; i < 8; ++i) s[i] = fsig(v[i]);
      store8(BG + (size_t)r * 2048 + (c - C_BG), s); }
    else if (c < C_DT) { float* o = NG + (size_t)r * 24 + (c - C_NG);
#pragma unroll
      for (int i = 0; i < 8; ++i) o[i] = fsig(v[i]); }
    else if (c < C_END) { float* o = DT + (size_t)r * 16 + (c - C_DT); const float* bi = dt_bias + (c - C_DT);
#pragma unroll
      for (int i = 0; i < 8; ++i) o[i] = fsoftplus(v[i] + bi[i]); } } };
struct FStoreBf { u16* o; int ld; __device__ __forceinline__ void operator()(const Unit&, int r, int c, const float (&v)[8]) const { store8(o + (size_t)r * ld + c, v); } };
struct FMerge { const u16* t1; const u16* bg; u16* o;
  __device__ __forceinline__ void operator()(const Unit&, int r, int c, const float (&v)[8]) const { float t[8], ga[8], gb[8], m[8]; load8(t1 + (size_t)r * 1024 + c, t); load8(bg + (size_t)r * 2048 + c, ga); load8(bg + (size_t)r * 2048 + 1024 + c, gb);
#pragma unroll
    for (int i = 0; i < 8; ++i) m[i] = ga[i] * t[i] + gb[i] * v[i];
    store8(o + (size_t)r * 1024 + c, m); } };
struct FResid { const float* x; u16* o;
  __device__ __forceinline__ void operator()(const Unit&, int r, int c, const float (&v)[8]) const { const f32x4 a = *(const f32x4*)(x + (size_t)r * 1024 + c), b = *(const f32x4*)(x + (size_t)r * 1024 + c + 4);
    const float t[8] = {a.x + v[0], a.y + v[1], a.z + v[2], a.w + v[3], b.x + v[4], b.y + v[5], b.z + v[6], b.w + v[7]}; store8(o + (size_t)r * 1024 + c, t); } };
struct FPle { const u16* x2; float* o; const u16* pp;
  __device__ __forceinline__ void operator()(const Unit&, int r, int c, const float (&v)[8]) const { float p[8], x[8]; load8(pp + (size_t)r * 1024 + c, p); load8(x2 + (size_t)r * 1024 + c, x); float* xp = o + (size_t)r * 1024 + c;
    *(f32x4*)xp = (f32x4){x[0] + fsig(v[0]) * p[0], x[1] + fsig(v[1]) * p[1], x[2] + fsig(v[2]) * p[2], x[3] + fsig(v[3]) * p[3]};
    *(f32x4*)(xp + 4) = (f32x4){x[4] + fsig(v[4]) * p[4], x[5] + fsig(v[5]) * p[5], x[6] + fsig(v[6]) * p[6], x[7] + fsig(v[7]) * p[7]}; } };

template <class F, bool ALIGN = true> __device__ __forceinline__ void dense_gemm(LAS unsigned char* lds, const u16* A, int lda, const u16* Bt, int ldb, int M, int N, int K, const F& f) {
  pg8::Gemm g{A, Bt, M, N, K, lda, ldb, 128}; pg8::StaticOrder S; S.init(M, N, (int)gridDim.x, (int)blockIdx.x); Epi8<F> E{f};
  pg8::gemm_phase<Epi8<F>, pg8::StaticOrder, ALIGN, false>(lds, g, S, E);
}
}
namespace fx {
constexpr int LIST_CAP = 32768;
constexpr int LDS_TAB = 131072;
struct MoeBufs { float* LOGITS; int* CNT; int* LIST; int* ASG; u16* MOEOUT; u16* WrT; float* SSQ; };
__host__ __device__ inline size_t carve_moe(MoeBufs& M, const Bufs& B, unsigned char* ws, size_t off) {
  auto take = [&](size_t bytes) { unsigned char* r = ws + off; off += (bytes + 255) / 256 * 256; return r; };
  M.LOGITS = (float*)take((size_t)NTOK * 64 * 4); M.CNT = (int*)take(32 * 256); M.LIST = (int*)take((size_t)32 * LIST_CAP * 4); M.WrT = (u16*)take((size_t)256 * 1024 * 2); M.ASG = (int*)take((size_t)NTOK * 2 * 4); M.SSQ = (float*)take((size_t)NTOK * 4);
  M.MOEOUT = B.QKV;
  return off;
}
__device__ __forceinline__ void prologue_moe(const Inputs& I, const MoeBufs& M) {
  for (long i = blockIdx.x * 512L + otid(); i < 256L * 1024; i += (long)gridDim.x * 512L) { const int n = (int)(i >> 10), k = (int)(i & 1023);
    float v = 0.f; if (n < 4) v = I.w_group[k * 4 + n]; else if (n < 36) v = I.w_expert[k * 32 + (n - 4)];
    M.WrT[i] = nv::f2bf(v); }
  if (blockIdx.x == 0 && threadIdx.x < 32) M.CNT[threadIdx.x * 64] = 0;
  for (int i = blockIdx.x * 512 + otid(); i < NTOK; i += gridDim.x * 512) M.SSQ[i] = 0.f;
}
struct FLogits { float* o; __device__ __forceinline__ void operator()(const Unit&, int r, int c, const float (&v)[8]) const { if (c < 40) { *(f32x4*)(o + (size_t)r * 64 + c) = (f32x4){v[0], v[1], v[2], v[3]}; *(f32x4*)(o + (size_t)r * 64 + c + 4) = (f32x4){v[4], v[5], v[6], v[7]}; } } };
__device__ __forceinline__ void phase_route(LAS unsigned char* lds, const Inputs& I, const Bufs& B, const MoeBufs& M) {
  LAS int* lcnt = (LAS int*)lds; LAS int* lbase = lcnt + 32; const int tid = otid();
  for (int blk = blockIdx.x; blk < NTOK / 128; blk += gridDim.x) {
    if (tid < 32) lcnt[tid] = 0;
    __syncthreads();
    int e0 = 0, e1 = 0, r0 = 0, r1 = 0; float w0 = 0.f, w1 = 0.f; const int tok = blk * 128 + tid;
    if (tid < 128) { const float* lg = M.LOGITS + (size_t)tok * 64;
      const float rsd = 1.0f;
      const f32x4 g4 = *(const f32x4*)lg; const float g0 = rsd * g4.x + I.b_group[0], g1 = rsd * g4.y + I.b_group[1], g2 = rsd * g4.z + I.b_group[2], g3 = rsd * g4.w + I.b_group[3];
      int gi = 0; float gm = g0; if (g1 > gm) { gm = g1; gi = 1; } if (g2 > gm) { gm = g2; gi = 2; } if (g3 > gm) { gm = g3; gi = 3; }
      const float grp_w = 1.0f / (expf(g0 - gm) + expf(g1 - gm) + expf(g2 - gm) + expf(g3 - gm));
      const f32x4 ea = *(const f32x4*)(lg + 4 + gi * 8), eb = *(const f32x4*)(lg + 8 + gi * 8); const f32x4 ba = *(const f32x4*)(I.b_expert + gi * 8), bb = *(const f32x4*)(I.b_expert + gi * 8 + 4);
      const float el[8] = {rsd * ea.x + ba.x, rsd * ea.y + ba.y, rsd * ea.z + ba.z, rsd * ea.w + ba.w, rsd * eb.x + bb.x, rsd * eb.y + bb.y, rsd * eb.z + bb.z, rsd * eb.w + bb.w};
      int i0 = 0; float m0 = el[0];
#pragma unroll
      for (int j = 1; j < 8; ++j) if (el[j] > m0) { m0 = el[j]; i0 = j; }
      int i1 = -1; float m1 = -3.0e38f;
#pragma unroll
      for (int j = 0; j < 8; ++j) if (j != i0 && el[j] > m1) { m1 = el[j]; i1 = j; }
      const float r = expf(m1 - m0); w0 = grp_w / (1.0f + r); w1 = grp_w * r / (1.0f + r);
      e0 = gi * 8 + i0; e1 = gi * 8 + i1;
      r0 = __hip_atomic_fetch_add(lcnt + e0, 1, __ATOMIC_RELAXED, __HIP_MEMORY_SCOPE_WORKGROUP); r1 = __hip_atomic_fetch_add(lcnt + e1, 1, __ATOMIC_RELAXED, __HIP_MEMORY_SCOPE_WORKGROUP); }
    __syncthreads();
    if (tid < 32) { const int n = lcnt[tid]; lbase[tid] = n > 0 ? atomicAdd(&M.CNT[tid * 64], n) : 0; }
    __syncthreads();
    if (tid < 128) { const int p0 = lbase[e0] + r0, p1 = lbase[e1] + r1;
      M.LIST[e0 * LIST_CAP + p0] = tok * 2; M.LIST[e1 * LIST_CAP + p1] = tok * 2 + 1; M.ASG[tok * 2] = (e0 << 16) | p0; M.ASG[tok * 2 + 1] = (e1 << 16) | p1; B.EW[tok * 2] = w0; B.EW[tok * 2 + 1] = w1; }
    __syncthreads(); }
}
__device__ __forceinline__ void build_tile_table(LAS unsigned char* lds, const MoeBufs& M) {
  LAS int* tab = (LAS int*)(lds + LDS_TAB);
  if (threadIdx.x == 0) { int acc = 0; for (int e = 0; e < 32; ++e) { tab[e] = acc; acc += (M.CNT[e * 64] + 255) >> 8; } tab[32] = acc; }
  __syncthreads();
}
__device__ __forceinline__ int tile_expert(const LAS int* tab, int tile) { int e = 0;
#pragma unroll 1
  for (int j = 1; j < 32; ++j) if (tab[j] <= tile) e = j;
  return e; }

struct SchedGU { const int* list; int tile, ct, lbase, nvalid, e;
  __device__ bool next(int i, Unit& u) const { if (i > 0) return false; u.pm = tile; u.pn = ct; u.aux0 = lbase; u.aux1 = nvalid; return true; }
  __device__ __forceinline__ const char* a_base(const pg8::Gemm& g, const Unit&) const { return (const char*)g.A; }
  __device__ __forceinline__ const char* b_base(const pg8::Gemm& g, const Unit&) const { return (const char*)g.Bt + ((size_t)e * 512 + (size_t)ct * 256) * 1024 * 2; }
  __device__ __forceinline__ int a_row(const Unit&, int r) const { return r < nvalid ? (list[lbase + r] >> 1) : 0; } };
struct EpiGU { static constexpr bool PERM = true; u16* act; const int* list; const float* ssq;
  __device__ __forceinline__ void operator()(const f32x4 (&acc)[2][2][4][2], const Unit& u, int wr, int wc, int fr, int fq) const {
#pragma unroll
    for (int ai = 0; ai < 2; ++ai)
#pragma unroll
      for (int m = 0; m < 4; ++m) { const int r = ai * 128 + wr * 64 + m * 16 + fr; const float rs = 1.0f;
        const f32x4 g0 = acc[ai][0][m][0] * rs, g1 = acc[ai][0][m][1] * rs, u0 = acc[ai][1][m][0] * rs, u1 = acc[ai][1][m][1] * rs;
        const float a[8] = {g0.x * fsig(g0.x) * u0.x, g0.y * fsig(g0.y) * u0.y, g0.z * fsig(g0.z) * u0.z, g0.w * fsig(g0.w) * u0.w, g1.x * fsig(g1.x) * u1.x, g1.y * fsig(g1.y) * u1.y, g1.z * fsig(g1.z) * u1.z, g1.w * fsig(g1.w) * u1.w};
        store8(act + ((size_t)u.pm * 256 + r) * 256 + u.pn * 128 + wc * 32 + 8 * fq, a);
        if (m & 1) asm volatile("" ::: "memory"); } } };
__device__ __forceinline__ void phase_moe_gu(LAS unsigned char* lds, const Bufs& B, const WBufs& W, const MoeBufs& M) {
  const LAS int* tab = (const LAS int*)(lds + LDS_TAB); const int T = tab[32];
  for (int L = blockIdx.x; L < T * 2; L += gridDim.x) { const int tile = L >> 1, ct = L & 1, e = __builtin_amdgcn_readfirstlane(tile_expert(tab, tile)), rt = tile - __builtin_amdgcn_readfirstlane(tab[e]); int nvalid = __builtin_amdgcn_readfirstlane(M.CNT[e * 64]) - rt * 256; nvalid = nvalid > 256 ? 256 : nvalid;
    pg8::Gemm g{B.H2, W.WguT, 256, 256, 1024, 1024, 1024, 128}; SchedGU S{M.LIST, tile, ct, e * LIST_CAP + rt * 256, nvalid, e}; EpiGU E{B.ACT, M.LIST, M.SSQ};
    pg8::gemm_phase<EpiGU, SchedGU, true, true>(lds, g, S, E); }
  { const int G = (int)gridDim.x, r = (T * 2) % G;
    if ((int)blockIdx.x >= r) { pg8::Gemm g{W.PB, W.PlePT, NTOK, 1024, 256, 256, 256, 128}; pg8::StaticOrder S; S.init(NTOK, 1024, G - r, (int)blockIdx.x - r); Epi8<FStoreBf> E{FStoreBf{B.PP, 1024}};
      pg8::gemm_phase<Epi8<FStoreBf>, pg8::StaticOrder, true, false>(lds, g, S, E); } }
}
struct SchedD { const LAS int* tab; int T4, G, c;
  __device__ bool next(int i, Unit& u) const { const int L = i * G + c; if (L >= T4) return false; const int tile = L >> 2; u.pm = tile; u.pn = L & 3; u.aux0 = __builtin_amdgcn_readfirstlane(tile_expert(tab, tile)); u.aux1 = 0; return true; }
  __device__ __forceinline__ const char* a_base(const pg8::Gemm& g, const Unit& u) const { return (const char*)g.A + (size_t)u.pm * 256 * 256 * 2; }
  __device__ __forceinline__ const char* b_base(const pg8::Gemm& g, const Unit& u) const { return (const char*)g.Bt + ((size_t)u.aux0 * 1024 + (size_t)u.pn * 256) * 256 * 2; }
  __device__ __forceinline__ int a_row(const Unit&, int) const { return 0; } };
__device__ __forceinline__ void phase_moe_down(LAS unsigned char* lds, const Bufs& B, const WBufs& W, const MoeBufs& M) {
  const LAS int* tab = (const LAS int*)(lds + LDS_TAB);
  pg8::Gemm g{B.ACT, W.WdT, 256, 1024, 256, 256, 256, 128}; SchedD S{tab, tab[32] * 4, (int)gridDim.x, (int)blockIdx.x}; Epi8<FStoreBf> E{FStoreBf{M.MOEOUT, 1024}};
  pg8::gemm_phase<Epi8<FStoreBf>, SchedD, true, false>(lds, g, S, E);
}
__device__ __forceinline__ void phase_moe_combine(LAS unsigned char* lds, const u16* x1, u16* x2, const MoeBufs& M, const float* ew, const float* gain, u16* hout) {
  const LAS int* tab = (const LAS int*)(lds + LDS_TAB);
  const int tid = otid(), lane = tid & 63, gw = obid() * 8 + (tid >> 6), ngw = gridDim.x * 8;
  for (int tk = gw; tk < NTOK; tk += 2 * ngw) { float v[2][2][8]; float rs[2];
    u32x4 xw[2][2], a[2][2], b[2][2]; float w0[2], w1[2];
#pragma unroll
    for (int q = 0; q < 2; ++q) { const int tok = (tk + q * ngw < NTOK) ? tk + q * ngw : tk; const int a0 = M.ASG[tok * 2], a1 = M.ASG[tok * 2 + 1]; w0[q] = ew[tok * 2]; w1[q] = ew[tok * 2 + 1];
      const int s0 = (tab[a0 >> 16] + ((a0 & 0xffff) >> 8)) * 256 + (a0 & 255), s1 = (tab[a1 >> 16] + ((a1 & 0xffff) >> 8)) * 256 + (a1 & 255);
      const u32x4* xr = (const u32x4*)(x1 + (size_t)tok * 1024) + lane; const u32x4* o0 = (const u32x4*)(M.MOEOUT + (size_t)s0 * 1024) + lane; const u32x4* o1 = (const u32x4*)(M.MOEOUT + (size_t)s1 * 1024) + lane;
#pragma unroll
      for (int j = 0; j < 2; ++j) { xw[q][j] = xr[64 * j]; a[q][j] = o0[64 * j]; b[q][j] = o1[64 * j]; } }
#pragma unroll
    for (int q = 0; q < 2; ++q) { float s = 0.f;
#pragma unroll
      for (int j = 0; j < 2; ++j) { const unsigned xe[4] = {xw[q][j].x, xw[q][j].y, xw[q][j].z, xw[q][j].w}, ae[4] = {a[q][j].x, a[q][j].y, a[q][j].z, a[q][j].w}, be[4] = {b[q][j].x, b[q][j].y, b[q][j].z, b[q][j].w};
#pragma unroll
        for (int i = 0; i < 4; ++i) { const float lo = __uint_as_float(xe[i] << 16) + (w0[q] * __uint_as_float(ae[i] << 16) + w1[q] * __uint_as_float(be[i] << 16));
          const float hi = __uint_as_float(xe[i] & 0xffff0000u) + (w0[q] * __uint_as_float(ae[i] & 0xffff0000u) + w1[q] * __uint_as_float(be[i] & 0xffff0000u));
          v[q][j][2 * i] = lo; v[q][j][2 * i + 1] = hi; s += lo * lo + hi * hi; } }
      rs[q] = 1.0f / sqrtf(wave_sum(s) * (1.f / 1024.f) + nv::EPS); }
#pragma unroll
    for (int q = 0; q < 2; ++q) { if (tk + q * ngw >= NTOK) break; const int tok = tk + q * ngw; u32x4* xo = (u32x4*)(x2 + (size_t)tok * 1024) + lane; u32x4* ho = (u32x4*)(hout + (size_t)tok * 1024) + lane;
#pragma unroll
      for (int j = 0; j < 2; ++j) { const f32x4 g0 = *(const f32x4*)(gain + 512 * j + 8 * lane), g1 = *(const f32x4*)(gain + 512 * j + 8 * lane + 4); const float (&x)[8] = v[q][j]; const float r = rs[q]; u32x4 ox, oh;
        ox.x = pk2(x[0], x[1]); ox.y = pk2(x[2], x[3]); ox.z = pk2(x[4], x[5]); ox.w = pk2(x[6], x[7]);
        oh.x = pk2(x[0] * r * g0.x, x[1] * r * g0.y); oh.y = pk2(x[2] * r * g0.z, x[3] * r * g0.w); oh.z = pk2(x[4] * r * g1.x, x[5] * r * g1.y); oh.w = pk2(x[6] * r * g1.z, x[7] * r * g1.w);
        xo[64 * j] = ox; ho[64 * j] = oh; } } }
}
}
namespace fa {
using nv::u16; using nv::Bufs;
typedef short bf16x8 __attribute__((ext_vector_type(8)));
typedef short s16x4 __attribute__((ext_vector_type(4)));
typedef float f32x16 __attribute__((ext_vector_type(16)));
typedef unsigned u32x4 __attribute__((ext_vector_type(4)));
constexpr float C2 = 0.125f * 1.4426950408889634f;
constexpr int S = nv::S, QKVW = 1280;
constexpr int IMP_LD = 65, IMP_HEAD = 64 * IMP_LD;
constexpr int L_K = 0, L_V = 32768, L_WSF = 65536, L_IMP = 67584, L_MASK = L_IMP + 4 * IMP_HEAD * 4 + 64  , L_OST = L_IMP  , L_END = L_MASK + 512;
static_assert(L_END <= 147456, "attention LDS map");

__device__ __forceinline__ int crow(int r, int hi) { return (r & 3) + 8 * (r >> 2) + 4 * hi; }
__device__ __forceinline__ float ex2(float x) { return __builtin_amdgcn_exp2f(x); }
__device__ __forceinline__ float max3f(float a, float b, float c) { float r; asm("v_max3_f32 %0, %1, %2, %3" : "=v"(r) : "v"(a), "v"(b), "v"(c)); return r; }
__device__ __forceinline__ float max2f(float a, float b) { float r; asm("v_max_f32_e32 %0, %1, %2" : "=v"(r) : "v"(a), "v"(b)); return r; }
__device__ __forceinline__ float swap_add(float v) { auto rr = __builtin_amdgcn_permlane32_swap(__float_as_uint(v), __float_as_uint(v), false, false); return __uint_as_float(rr[0]) + __uint_as_float(rr[1]); }
__device__ __forceinline__ float swap_max(float v) { auto rr = __builtin_amdgcn_permlane32_swap(__float_as_uint(v), __float_as_uint(v), false, false); return __builtin_fmaxf(__uint_as_float(rr[0]), __uint_as_float(rr[1])); }

__device__ __forceinline__ void phase_qknorm(const nv::Inputs& I, const Bufs& B) {
  const int nwg = (int)gridDim.x > 64 ? (int)gridDim.x - 64 : (int)gridDim.x;
  if ((int)blockIdx.x >= nwg) return;
  for (int it = blockIdx.x * 512 + fx::otid(); it < nv::NTOK * 4; it += nwg * 512) { const int tok = it >> 2, w = it & 3; u16* v; const float* gain;
    if (w < 2) { v = B.QKV + (size_t)tok * QKVW + nv::O_KS + w * 64; gain = I.ks_gain; } else { v = B.QKV + (size_t)tok * QKVW + nv::O_KW + (w - 2) * 64; gain = I.kw_gain; }
    float x[8][8]; float s = 0.f;
#pragma unroll
    for (int c = 0; c < 8; ++c) { fx::load8(v + c * 8, x[c]);
#pragma unroll
      for (int j = 0; j < 8; ++j) s += x[c][j] * x[c][j]; }
    const float rs = 1.0f / sqrtf(s * (1.f / 64.f) + nv::EPS);
#pragma unroll
    for (int c = 0; c < 8; ++c) { float y[8];
#pragma unroll
      for (int j = 0; j < 8; ++j) y[j] = x[c][j] * rs * gain[c * 8 + j];
      fx::store8(v + c * 8, y); } }
}

__device__ __forceinline__ void stage_kv(LAS unsigned char* lds, int slot, const u16* kbase, const u16* vbase, int stride, int wid, int lane, bool withV) {
  { const int row = 8 * wid + (lane >> 3), ch = lane & 7; const u16* ksrc = kbase + (size_t)row * stride + ((ch ^ (row & 7)) * 8);
    __builtin_amdgcn_global_load_lds((const unsigned*)ksrc, (LAS unsigned*)(lds + L_K + slot * 8192 + wid * 1024), 16, 0, 0); }
  if (withV) { const u16* vsrc = vbase + (size_t)(16 * (wid & 3) + (lane >> 2)) * stride + (wid >> 2) * 32 + (lane & 3) * 8;
    __builtin_amdgcn_global_load_lds((const unsigned*)vsrc, (LAS unsigned*)(lds + L_V + slot * 8192 + wid * 1024), 16, 0, 0); }
}
__device__ __forceinline__ void qkt(f32x16& p0, f32x16& p1, const LAS unsigned char* Kslot, const bf16x8 (&qr)[4], int r32, int hi, float bias = 0.f) {
  const LAS unsigned char* kb = Kslot + r32 * 128; const int sw = r32 & 7;
  bf16x8 kf[8];
#pragma unroll
  for (int d0 = 0; d0 < 4; ++d0) { const int o = ((2 * d0 + hi) ^ sw) << 4; kf[2 * d0] = *(const LAS bf16x8*)(kb + o); kf[2 * d0 + 1] = *(const LAS bf16x8*)(kb + 4096 + o); }
  f32x16 z;
#pragma unroll
  for (int r = 0; r < 16; ++r) z[r] = bias;
  asm volatile("s_waitcnt lgkmcnt(0)" ::: "memory"); __builtin_amdgcn_sched_barrier(0);
  p0 = __builtin_amdgcn_mfma_f32_32x32x16_bf16(kf[0], qr[0], z, 0, 0, 0); p1 = __builtin_amdgcn_mfma_f32_32x32x16_bf16(kf[1], qr[0], z, 0, 0, 0);
#pragma unroll
  for (int d0 = 1; d0 < 4; ++d0) { p0 = __builtin_amdgcn_mfma_f32_32x32x16_bf16(kf[2 * d0], qr[d0], p0, 0, 0, 0); p1 = __builtin_amdgcn_mfma_f32_32x32x16_bf16(kf[2 * d0 + 1], qr[d0], p1, 0, 0, 0); }
}
__device__ __forceinline__ void pv(f32x16 (&o)[2], int vb, bf16x8 pa0, bf16x8 pa1, bf16x8 pa2, bf16x8 pa3) {
#define FA_PK(k) (bf16x8){lo[k][0], lo[k][1], lo[k][2], lo[k][3], hi[k][0], hi[k][1], hi[k][2], hi[k][3]}
  s16x4 lo[8], hi[8];
#pragma unroll
  for (int d0 = 0; d0 < 2; ++d0)
#pragma unroll
    for (int ks = 0; ks < 4; ++ks) {
      asm volatile("ds_read_b64_tr_b16 %0,%1 offset:%c2" : "=&v"(lo[d0 * 4 + ks]) : "v"(vb), "i"(d0 * 4096 + ks * 1024) : "memory");
      asm volatile("ds_read_b64_tr_b16 %0,%1 offset:%c2" : "=&v"(hi[d0 * 4 + ks]) : "v"(vb), "i"(d0 * 4096 + ks * 1024 + 512) : "memory"); }
  asm volatile("s_waitcnt lgkmcnt(0)" ::: "memory"); __builtin_amdgcn_sched_barrier(0);
  o[0] = __builtin_amdgcn_mfma_f32_32x32x16_bf16(pa0, FA_PK(0), o[0], 0, 0, 0); o[1] = __builtin_amdgcn_mfma_f32_32x32x16_bf16(pa0, FA_PK(4), o[1], 0, 0, 0);
  o[0] = __builtin_amdgcn_mfma_f32_32x32x16_bf16(pa1, FA_PK(1), o[0], 0, 0, 0); o[1] = __builtin_amdgcn_mfma_f32_32x32x16_bf16(pa1, FA_PK(5), o[1], 0, 0, 0);
  o[0] = __builtin_amdgcn_mfma_f32_32x32x16_bf16(pa2, FA_PK(2), o[0], 0, 0, 0); o[1] = __builtin_amdgcn_mfma_f32_32x32x16_bf16(pa2, FA_PK(6), o[1], 0, 0, 0);
  o[0] = __builtin_amdgcn_mfma_f32_32x32x16_bf16(pa3, FA_PK(3), o[0], 0, 0, 0); o[1] = __builtin_amdgcn_mfma_f32_32x32x16_bf16(pa3, FA_PK(7), o[1], 0, 0, 0);
#undef FA_PK
}
struct SmState { float m, l; f32x16 o[2]; };
#ifdef PROBE_STAMPS
struct Prof { unsigned long long t, a[4]; };
#define FA_PROF_DECL Prof prof; prof.t = __builtin_amdgcn_s_memrealtime(); prof.a[0] = prof.a[1] = prof.a[2] = prof.a[3] = 0;
#define FA_PROF(k) do { __builtin_amdgcn_sched_barrier(0); const unsigned long long n_ = __builtin_amdgcn_s_memrealtime(); prof.a[k] += n_ - prof.t; prof.t = n_; __builtin_amdgcn_sched_barrier(0); } while (0)
#define FA_PROF_ARG , Prof& prof
#define FA_PROF_PASS , prof
#else
#define FA_PROF_DECL
#define FA_PROF(k) do {} while (0)
#define FA_PROF_ARG
#define FA_PROF_PASS
#endif
__device__ __forceinline__ void sm_reset(SmState& st) { st.m = 0.f; st.l = 0.f;
#pragma unroll
  for (int r = 0; r < 16; ++r) { st.o[0][r] = 0.f; st.o[1][r] = 0.f; } }
__device__ __forceinline__ void mask_range(f32x16& p0, f32x16& p1, int klo, int khi, int hi) {
  if (__all(klo <= 0 && khi >= 63)) return;
#pragma unroll
  for (int r = 0; r < 16; ++r) { const int k0 = crow(r, hi), k1 = k0 + 32; if (k0 < klo || k0 > khi) p0[r] = -INFINITY; if (k1 < klo || k1 > khi) p1[r] = -INFINITY; }
}
__device__ __forceinline__ void tile_step(SmState& st, LAS unsigned char* lds, int slot, const bf16x8 (&qr)[4], LAS float* wsf, int r32, int hi, int vb0, int klo, int khi, float bias FA_PROF_ARG) {
  FA_PROF(0);
  f32x16 p0, p1; qkt(p0, p1, lds + L_K + slot * 8192, qr, r32, hi, bias);
  asm volatile("" : "+v"(p0), "+v"(p1)); FA_PROF(1);
  mask_range(p0, p1, klo, khi, hi);
  float rs = 0.f;
#pragma unroll
  for (int r = 0; r < 16; ++r) { p0[r] = ex2(p0[r] - st.m); p1[r] = ex2(p1[r] - st.m); rs += p0[r] + p1[r]; }
  if (__builtin_expect(__any(!(rs < 1.0e30f)), 0)) {
    qkt(p0, p1, lds + L_K + slot * 8192, qr, r32, hi, bias); mask_range(p0, p1, klo, khi, hi);
    float rm = max2f(p0[0], p1[0]);
#pragma unroll
    for (int r = 1; r < 16; ++r) rm = max3f(rm, p0[r], p1[r]);
    rm = swap_max(rm) - st.m; const float d = rm > 24.f ? rm : 0.f; const float f = ex2(-d); st.m += d; st.l *= f;
    if (hi == 0) wsf[r32] = f;
    rs = 0.f;
#pragma unroll
    for (int r = 0; r < 16; ++r) { p0[r] = ex2(p0[r] - st.m); p1[r] = ex2(p1[r] - st.m); rs += p0[r] + p1[r]; const float fr = wsf[crow(r, hi)]; st.o[0][r] *= fr; st.o[1][r] *= fr; } }
  st.l += rs;
  u32x4 w0, w1, w2, w3;
  w0.x = pg8::cvt_pk_bf16(p0[0], p0[1]); w0.y = pg8::cvt_pk_bf16(p0[2], p0[3]); w0.z = pg8::cvt_pk_bf16(p0[4], p0[5]); w0.w = pg8::cvt_pk_bf16(p0[6], p0[7]);
  w1.x = pg8::cvt_pk_bf16(p0[8], p0[9]); w1.y = pg8::cvt_pk_bf16(p0[10], p0[11]); w1.z = pg8::cvt_pk_bf16(p0[12], p0[13]); w1.w = pg8::cvt_pk_bf16(p0[14], p0[15]);
  w2.x = pg8::cvt_pk_bf16(p1[0], p1[1]); w2.y = pg8::cvt_pk_bf16(p1[2], p1[3]); w2.z = pg8::cvt_pk_bf16(p1[4], p1[5]); w2.w = pg8::cvt_pk_bf16(p1[6], p1[7]);
  w3.x = pg8::cvt_pk_bf16(p1[8], p1[9]); w3.y = pg8::cvt_pk_bf16(p1[10], p1[11]); w3.z = pg8::cvt_pk_bf16(p1[12], p1[13]); w3.w = pg8::cvt_pk_bf16(p1[14], p1[15]);
  asm volatile("" : "+v"(w0), "+v"(w1), "+v"(w2), "+v"(w3)); FA_PROF(2);
  pv(st.o, vb0 + L_V + slot * 8192, __builtin_bit_cast(bf16x8, w0), __builtin_bit_cast(bf16x8, w1), __builtin_bit_cast(bf16x8, w2), __builtin_bit_cast(bf16x8, w3));
  asm volatile("" : "+v"(st.o[0]), "+v"(st.o[1])); FA_PROF(3);
}
template <int MODE> __device__ __forceinline__ void finalize(SmState& st, float gate, f32x16 (&outacc)[2], LAS float* slab, LAS float* wsf, int r32, int hi, int lane, float& msafe, float& invl) {
  const float lt = swap_add(st.l); invl = lt > 0.f ? 1.0f / lt : 0.f; msafe = st.m;
  if (hi == 0) wsf[r32] = gate * invl;
#pragma unroll
  for (int r = 0; r < 16; ++r) { const float fr = wsf[crow(r, hi)];
    if (MODE == 0) { outacc[0][r] = st.o[0][r] * fr; outacc[1][r] = st.o[1][r] * fr; }
    else if (MODE == 1) { slab[r * 64 + lane] += st.o[0][r] * fr; slab[(16 + r) * 64 + lane] += st.o[1][r] * fr; }
    else { outacc[0][r] = slab[r * 64 + lane] + st.o[0][r] * fr; outacc[1][r] = slab[(16 + r) * 64 + lane] + st.o[1][r] * fr; } }
}
__device__ __forceinline__ void imp_step(LAS unsigned char* lds, int slot, const bf16x8 (&qr)[4], int r32, int hi, int khi, float msafe, float invl, LAS float* imph  , int tq, int T) {
  f32x16 p0, p1; qkt(p0, p1, lds + L_K + slot * 8192, qr, r32, hi);
  mask_range(p0, p1, 0, khi, hi);
#pragma unroll
  for (int r = 0; r < 16; ++r) { p0[r] = ex2(p0[r] - msafe) * invl; p1[r] = ex2(p1[r] - msafe) * invl; }
  LAS float* row = imph + tq * IMP_LD + 16 * T + hi;
#pragma unroll
  for (int gq = 0; gq < 4; ++gq) { row[2 * gq] += (p0[4 * gq] + p0[4 * gq + 1]) + (p0[4 * gq + 2] + p0[4 * gq + 3]); row[2 * gq + 8] += (p1[4 * gq] + p1[4 * gq + 1]) + (p1[4 * gq + 2] + p1[4 * gq + 3]); }
  asm volatile("s_waitcnt lgkmcnt(0)" ::: "memory");
#pragma unroll
  for (int gq = 0; gq < 4; ++gq) { row[2 * gq + 1] += p0[4 * gq + 3]; if (16 * T + hi + 2 * gq + 9 < 64) row[2 * gq + 9] += p1[4 * gq + 3]; }
  asm volatile("s_waitcnt lgkmcnt(0)" ::: "memory");
}
__device__ __forceinline__ void topk_select(LAS unsigned char* lds, LAS float* wsf, int wid, int lane, int i) {
  LAS float* IM = (LAS float*)(lds + L_IMP); LAS unsigned long long* MK = (LAS unsigned long long*)(lds + L_MASK);
  const int j = lane; const int nforced = i == 0 ? 1 : (i == 1 ? 2 : 3);
  const bool forced = (j <= i) && (j == 0 || j == i || j == i - 1); const bool cand = (j >= 1) && (j <= i - 2);
  for (int tq = wid; tq < 64; tq += 8) {
    const float v = (IM[tq * IMP_LD + j] + IM[IMP_HEAD + tq * IMP_LD + j]) + (IM[2 * IMP_HEAD + tq * IMP_LD + j] + IM[3 * IMP_HEAD + tq * IMP_LD + j]);
    int cnt = 0;
#pragma unroll 4
    for (int jj = 1; jj <= i - 2; ++jj) { const float vv = __uint_as_float(__builtin_amdgcn_readlane(__float_as_uint(v), jj)); cnt += (vv > v || (vv == v && jj < j)) ? 1 : 0; }
    const bool sel = forced || (cand && cnt < 16 - nforced);
    const unsigned long long mk = __ballot(sel);
    if (lane == 0) MK[tq] = mk;
  }
}
__device__ __forceinline__ void attn_unit(LAS unsigned char* lds, const nv::Inputs& I, const Bufs& B, int b, int g, int i) {
  const int tid = fx::otid(), lane = tid & 63, wid = __builtin_amdgcn_readfirstlane(tid >> 6), r32 = lane & 31, hi = lane >> 5;
  const int e = wid >> 1, h = g * 4 + e, tq = 32 * (wid & 1) + r32; const size_t tok = (size_t)b * S + 64 * i + tq; const int t = 64 * i + tq;
  LAS float* wsf = (LAS float*)(lds + L_WSF) + wid * 64;
  LAS float* imph = (LAS float*)(lds + L_IMP) + e * IMP_HEAD;
  const int vb0 = (int)(unsigned)(size_t)lds + ((lane >> 4) & 1) * 32 + (lane & 3) * 8 + (4 * hi + ((lane & 15) >> 2)) * 64;
  bf16x8 qr[4];
  {
    float qv[4][8]; float ss = 0.f;
#pragma unroll
    for (int d0 = 0; d0 < 4; ++d0) { fx::load8(B.QKV + tok * QKVW + h * 64 + d0 * 16 + hi * 8, qv[d0]);
#pragma unroll
      for (int j = 0; j < 8; ++j) ss += qv[d0][j] * qv[d0][j]; }
    ss = swap_add(ss); const float rs = C2 / sqrtf(ss * (1.f / 64.f) + nv::EPS);
#pragma unroll
    for (int d0 = 0; d0 < 4; ++d0) { u32x4 w; const float* gq = I.q_gain + d0 * 16 + hi * 8;
      w.x = pg8::cvt_pk_bf16(qv[d0][0] * rs * gq[0], qv[d0][1] * rs * gq[1]); w.y = pg8::cvt_pk_bf16(qv[d0][2] * rs * gq[2], qv[d0][3] * rs * gq[3]);
      w.z = pg8::cvt_pk_bf16(qv[d0][4] * rs * gq[4], qv[d0][5] * rs * gq[5]); w.w = pg8::cvt_pk_bf16(qv[d0][6] * rs * gq[6], qv[d0][7] * rs * gq[7]); qr[d0] = __builtin_bit_cast(bf16x8, w); } }
  const float g0 = B.NG[tok * 24 + h * 3 + 0], g1 = B.NG[tok * 24 + h * 3 + 1], g2 = B.NG[tok * 24 + h * 3 + 2];
  const u16* kc = B.KCMP + (size_t)(b * 2 + g) * 256 * 64; const u16* vc = B.VCMP + (size_t)(b * 2 + g) * 256 * 64;
  const u16* ksb = B.QKV + (size_t)b * S * QKVW + nv::O_KS + g * 64; const u16* vsb = B.QKV + (size_t)b * S * QKVW + nv::O_VS + g * 64;
  const u16* kwb = B.QKV + (size_t)b * S * QKVW + nv::O_KW + g * 64; const u16* vwb = B.QKV + (size_t)b * S * QKVW + nv::O_VW + g * 64;
  int nvis = t >= 31 ? (t - 31) / 16 + 1 : 0; nvis = nvis > 255 ? 255 : nvis;
  const int ntA = (4 * i + 3 + 63) / 64, nC = (i < 8 ? i : 8) + 1, jC0 = i - (nC - 1);
  const int sI = ntA, sB = 2 * ntA, sC = sB + i + 1, NS = sC + nC;
  { LAS float* IM = (LAS float*)(lds + L_IMP); for (int k = tid; k < 4 * IMP_HEAD; k += 512) IM[k] = 0.f; }
  f32x16 outacc[2];
  LAS float* slab = (LAS float*)(lds + L_IMP) + wid * 2048;
  SmState st; sm_reset(st);
  float mA = 0.f, invlA = 0.f; unsigned long long mybits = 0ull;
  FA_PROF_DECL
#ifdef PROBE_STAMPS
  const unsigned long long ck0 = __builtin_amdgcn_s_memtime(), rt0 = __builtin_amdgcn_s_memrealtime();
#endif
#define FA_ISSUE1(s_) do { const int s__ = (s_); const int sl = s__ & 3; \
    if (s__ < sI) stage_kv(lds, sl, kc + (size_t)s__ * 4096, vc + (size_t)s__ * 4096, 64, wid, lane, true); \
    else if (s__ < sB) stage_kv(lds, sl, kc + (size_t)(s__ - sI) * 4096, vc + (size_t)(s__ - sI) * 4096, 64, wid, lane, true); \
    else if (s__ < sC) stage_kv(lds, sl, ksb + (size_t)(s__ - sB) * 64 * QKVW, vsb + (size_t)(s__ - sB) * 64 * QKVW, QKVW, wid, lane, true); \
    else stage_kv(lds, sl, kwb + (size_t)(jC0 + s__ - sC) * 64 * QKVW, vwb + (size_t)(jC0 + s__ - sC) * 64 * QKVW, QKVW, wid, lane, true); } while (0)
  FA_ISSUE1(0);
  int s = 0;
#define FA_TOP(n_) do { asm volatile("s_waitcnt vmcnt(0)" ::: "memory"); __syncthreads(); if (s + 1 < NS) FA_ISSUE1(s + 1); } while (0)
#pragma unroll 1
  for (; s < sI; ++s) { FA_TOP(1); tile_step(st, lds, s & 3, qr, wsf, r32, hi, vb0, 0, nvis - 64 * s - 1, 0.f FA_PROF_PASS); }
  finalize<0>(st, g0, outacc, slab, wsf, r32, hi, lane, mA, invlA);
#pragma unroll 1
  for (; s < sB; ++s) { FA_TOP(1); imp_step(lds, s & 3, qr, r32, hi, nvis - 64 * (s - sI) - 1, mA, invlA, imph, tq, s - sI); }
  asm volatile("s_waitcnt lgkmcnt(0)\n\ts_barrier" ::: "memory");
  topk_select(lds, wsf, wid, lane, i);
  asm volatile("s_waitcnt lgkmcnt(0)\n\ts_barrier" ::: "memory"); mybits = ((const LAS unsigned long long*)(lds + L_MASK))[tq];
#pragma unroll
  for (int r = 0; r < 16; ++r) { slab[r * 64 + lane] = outacc[0][r]; slab[(16 + r) * 64 + lane] = outacc[1][r]; }
  sm_reset(st);
#pragma unroll 1
  for (; s < sC; ++s) { FA_TOP(1); const int j = s - sB; const bool selj = (mybits >> j) & 1ull;
    tile_step(st, lds, s & 3, qr, wsf, r32, hi, vb0, 0, j == i ? tq : 63, selj ? 0.f : -INFINITY FA_PROF_PASS); }
  { float d0_, d1_; finalize<1>(st, g1, outacc, slab, wsf, r32, hi, lane, d0_, d1_); sm_reset(st); }
#pragma unroll 1
  for (; s < NS; ++s) { FA_TOP(1); const int j = jC0 + (s - sC);
    tile_step(st, lds, s & 3, qr, wsf, r32, hi, vb0, (i >= 8 && j == i - 8) ? tq + 1 : 0, j == i ? tq : 63, 0.f FA_PROF_PASS); }
  { float d0_, d1_; finalize<2>(st, g2, outacc, slab, wsf, r32, hi, lane, d0_, d1_); }
#undef FA_ISSUE1
#undef FA_TOP
  { u16* Ow = B.YA + ((size_t)b * S + 64 * i + 32 * (wid & 1)) * 512 + h * 64; LAS u16* stg = (LAS u16*)(lds + L_OST) + wid * 4096;
#pragma unroll
    for (int r = 0; r < 16; ++r) { const int orow = crow(r, hi); stg[orow * 64 + r32] = nv::f2bf(outacc[0][r]); stg[orow * 64 + 32 + r32] = nv::f2bf(outacc[1][r]); }
    asm volatile("s_waitcnt lgkmcnt(0)" ::: "memory");
#pragma unroll
    for (int q = 0; q < 4; ++q) { const int row = q * 8 + (lane >> 3), ch = lane & 7; const u32x4 v = *(const LAS u32x4*)(stg + row * 64 + ch * 8); *(u32x4*)(Ow + (size_t)row * 512 + ch * 8) = v; } }
#ifdef PROBE_STAMPS
  if (blockIdx.x == 0 && threadIdx.x == PROBE_TID) { volatile LAS unsigned long long* ts = (volatile LAS unsigned long long*)(lds + 147120); for (int k = 0; k < 4; ++k) ts[20 + k] += prof.a[k]; ts[24] += (__builtin_amdgcn_s_memtime() - ck0) / 10; ts[25] += __builtin_amdgcn_s_memrealtime() - rt0; }
#endif
  __syncthreads();
}
__device__ __forceinline__ void phase_attention(LAS unsigned char* lds, const nv::Inputs& I, const Bufs& B) {
  const int G = gridDim.x, bx = blockIdx.x; const int vcu = (G % 8 == 0) ? (bx % 8) * (G / 8) + bx / 8 : bx;
  for (int u = vcu; u < 256; u += G) { const int bg = u >> 4, s = u & 15;
#pragma unroll 1
    for (int k = 0; k < 4; ++k) { const int i = (k == 0) ? s : (k == 1) ? 31 - s : (k == 2) ? 32 + s : 63 - s; attn_unit(lds, I, B, bg >> 1, bg & 1, i); } }
}
}
namespace fs {
#ifdef PROBE_STAMPS
#define FS_STAMP(k) do { if (blockIdx.x == 0 && threadIdx.x == 0) *(volatile LAS unsigned long long*)(lds + 147120 + 8 * (k)) = __builtin_amdgcn_s_memrealtime(); } while (0)
#else
#define FS_STAMP(k) do {} while (0)
#endif
using nv::u16; using nv::Bufs; using nv::Inputs;
using fa::bf16x8; using fa::f32x16; using fa::u32x4; using fa::crow; using fa::ex2;
typedef float f32x4 __attribute__((ext_vector_type(4)));
constexpr int S = nv::S, NTOK = nv::NTOK, SCD = 1536;
constexpr float LOG2E = 1.4426950408889634f;
struct SsdBufs { u16* XC; u16* STATE; float* ACS; float* DEC; };
__host__ __device__ inline size_t carve_ssd(SsdBufs& X, const Bufs& B, unsigned char* ws, size_t off) {
  auto take = [&](size_t bytes) { unsigned char* r = ws + off; off += (bytes + 255) / 256 * 256; return r; };
  X.XC = B.HB;
  X.STATE = B.HB + (size_t)NTOK * SCD;
  X.ACS = (float*)take((size_t)NTOK * 16 * 4); X.DEC = (float*)take((size_t)8 * 16 * 16 * 4);
  return off;
}
constexpr int L_ARR = 101376;
constexpr int L_BT = 0, BT_LD = 264, L_XWT = 67584;
constexpr int L_KIMG = 0, L_XV = 0, L_OST = 65536;
static_assert(L_XWT + 64 * BT_LD * 2 <= L_ARR && L_OST + 32768 <= L_ARR && L_ARR + 16384 <= 147456, "SSD LDS map");

__device__ __forceinline__ void phase_conv(const Inputs& I, const Bufs& B, const SsdBufs& X) {
  const int id = blockIdx.x * 512 + fx::otid(); if (id >= 192 * 512) return;
  const int c8 = (id % 192) * 8, run = id / 192; const int tok0 = run * 64; const int t0 = tok0 & (S - 1);
  float w[4][8], bias[8], h0[8], h1[8], h2[8];
#pragma unroll
  for (int j = 0; j < 8; ++j) { bias[j] = I.conv_b[c8 + j];
#pragma unroll
    for (int k = 0; k < 4; ++k) w[k][j] = I.conv_w[k * SCD + c8 + j]; }
  if (t0 >= 3) { fx::load8(B.XBC + (size_t)(tok0 - 3) * SCD + c8, h0); fx::load8(B.XBC + (size_t)(tok0 - 2) * SCD + c8, h1); fx::load8(B.XBC + (size_t)(tok0 - 1) * SCD + c8, h2); }
  else {
#pragma unroll
    for (int j = 0; j < 8; ++j) { h0[j] = 0.f; h1[j] = 0.f; h2[j] = 0.f; } }
#pragma unroll 8
  for (int t = 0; t < 64; ++t) { float x[8], y[8]; fx::load8(B.XBC + (size_t)(tok0 + t) * SCD + c8, x);
#pragma unroll
    for (int j = 0; j < 8; ++j) { const float a = bias[j] + w[0][j] * h0[j] + w[1][j] * h1[j] + w[2][j] * h2[j] + w[3][j] * x[j]; y[j] = a * fx::fsig(a); h0[j] = h1[j]; h1[j] = h2[j]; h2[j] = x[j]; }
    fx::store8(X.XC + (size_t)(tok0 + t) * SCD + c8, y); }
}

__device__ __forceinline__ void ssd_x_unit(LAS unsigned char* lds, const Inputs& I, const Bufs& B, const SsdBufs& X, int b, int c, int g) {
  const int tid = fx::otid(), lane = tid & 63, wid = __builtin_amdgcn_readfirstlane(tid >> 6), r32 = lane & 31, hi = lane >> 5, fr = lane & 15, fq = lane >> 4;
  const size_t tok0 = (size_t)b * S + (size_t)c * 256;
  LAS float* acs2 = (LAS float*)(lds + L_ARR); LAS float* dtl = acs2 + 8 * 256;
  { const int hh = g * 8 + wid; const float a = -expf(I.a_log[hh]) * LOG2E; float d[4], sc[4];
#pragma unroll
    for (int k = 0; k < 4; ++k) d[k] = B.DT[(tok0 + 4 * lane + k) * 16 + hh];
    sc[0] = d[0] * a; sc[1] = sc[0] + d[1] * a; sc[2] = sc[1] + d[2] * a; sc[3] = sc[2] + d[3] * a;
    float tot = sc[3];
#pragma unroll
    for (int o = 1; o < 64; o <<= 1) { const float up = __shfl_up(tot, o); if (lane >= o) tot += up; }
    const float excl = tot - sc[3];
#pragma unroll
    for (int k = 0; k < 4; ++k) { const float v = excl + sc[k]; acs2[wid * 256 + 4 * lane + k] = v; dtl[wid * 256 + 4 * lane + k] = d[k]; X.ACS[(tok0 + 4 * lane + k) * 16 + hh] = v; }
    if (lane == 63) X.DEC[((size_t)b * 16 + c) * 16 + hh] = ex2(tot); }
  { LAS u16* BT = (LAS u16*)(lds + L_BT);
#pragma unroll 1
    for (int q = tid; q < 256 * 16; q += 512) { const int l = q >> 4, n8 = (q & 15) * 8; const u32x4 w = *(const u32x4*)(X.XC + (tok0 + l) * SCD + 1024 + g * 128 + n8);
      BT[(n8 + 0) * BT_LD + l] = (u16)(w.x & 0xffff); BT[(n8 + 1) * BT_LD + l] = (u16)(w.x >> 16); BT[(n8 + 2) * BT_LD + l] = (u16)(w.y & 0xffff); BT[(n8 + 3) * BT_LD + l] = (u16)(w.y >> 16);
      BT[(n8 + 4) * BT_LD + l] = (u16)(w.z & 0xffff); BT[(n8 + 5) * BT_LD + l] = (u16)(w.z >> 16); BT[(n8 + 6) * BT_LD + l] = (u16)(w.w & 0xffff); BT[(n8 + 7) * BT_LD + l] = (u16)(w.w >> 16); } }
  __syncthreads();
  FS_STAMP(30);
  u32x4 nx[4];
#define FSX_LOAD_X(h_) do { _Pragma("unroll") for (int u = 0; u < 4; ++u) { const int q = tid + u * 512; nx[u] = *(const u32x4*)(X.XC + (tok0 + (q >> 3)) * SCD + (g * 8 + (h_)) * 64 + (q & 7) * 8); } } while (0)
  FSX_LOAD_X(0);
#pragma unroll 1
  for (int h = 0; h < 8; ++h) { const int hh = g * 8 + h; LAS u16* XwT = (LAS u16*)(lds + L_XWT); const LAS u16* BT = (const LAS u16*)(lds + L_BT);
    const float aend = acs2[h * 256 + 255];
#pragma unroll
    for (int u = 0; u < 4; ++u) { const int q = tid + u * 512, l = q >> 3, p8 = (q & 7) * 8; const float w = ex2(aend - acs2[h * 256 + l]) * dtl[h * 256 + l]; const u32x4 xv = nx[u];
      XwT[(p8 + 0) * BT_LD + l] = nv::f2bf(__uint_as_float(xv.x << 16) * w); XwT[(p8 + 1) * BT_LD + l] = nv::f2bf(__uint_as_float(xv.x & 0xffff0000u) * w);
      XwT[(p8 + 2) * BT_LD + l] = nv::f2bf(__uint_as_float(xv.y << 16) * w); XwT[(p8 + 3) * BT_LD + l] = nv::f2bf(__uint_as_float(xv.y & 0xffff0000u) * w);
      XwT[(p8 + 4) * BT_LD + l] = nv::f2bf(__uint_as_float(xv.z << 16) * w); XwT[(p8 + 5) * BT_LD + l] = nv::f2bf(__uint_as_float(xv.z & 0xffff0000u) * w);
      XwT[(p8 + 6) * BT_LD + l] = nv::f2bf(__uint_as_float(xv.w << 16) * w); XwT[(p8 + 7) * BT_LD + l] = nv::f2bf(__uint_as_float(xv.w & 0xffff0000u) * w); }
    if (h + 1 < 8) FSX_LOAD_X(h + 1);
    asm volatile("s_waitcnt lgkmcnt(0)\n\ts_barrier" ::: "memory");
    { const int pt = wid & 3, nt0 = (wid >> 2) * 4; pg8::f32x4 acc[4];
#pragma unroll
      for (int n = 0; n < 4; ++n) acc[n] = (pg8::f32x4){0.f, 0.f, 0.f, 0.f};
#pragma unroll
      for (int ks = 0; ks < 8; ++ks) { const bf16x8 a = *(const LAS bf16x8*)(XwT + (pt * 16 + fr) * BT_LD + ks * 32 + fq * 8);
#pragma unroll
        for (int n = 0; n < 4; ++n) { const bf16x8 bb = *(const LAS bf16x8*)(BT + ((nt0 + n) * 16 + fr) * BT_LD + ks * 32 + fq * 8); acc[n] = __builtin_amdgcn_mfma_f32_16x16x32_bf16(a, bb, acc[n], 0, 0, 0); } }
      u16* st = X.STATE + (((size_t)b * 16 + c) * 16 + hh) * 8192;
#pragma unroll
      for (int n = 0; n < 4; ++n)
#pragma unroll
        for (int j = 0; j < 4; ++j) st[(pt * 16 + 4 * fq + j) * 128 + (nt0 + n) * 16 + fr] = nv::f2bf(acc[n][j]); }
    asm volatile("s_waitcnt lgkmcnt(0)\n\ts_barrier" ::: "memory"); }
#undef FSX_LOAD_X
  FS_STAMP(31);
  const int lt = wid < 4 ? wid : 11 - wid;
  const int l = 32 * lt + r32;
  for (int k = tid; k < 8 * 256; k += 512) { const int h_ = k >> 8, s_ = k & 255; dtl[k] = ex2(acs2[h_ * 256 + (s_ & ~15)] - acs2[k]) * dtl[k]; }
  bf16x8 qr[8];
#pragma unroll
  for (int d0 = 0; d0 < 8; ++d0) qr[d0] = *(const bf16x8*)(X.XC + (tok0 + l) * SCD + 1280 + g * 128 + d0 * 16 + hi * 8);
  unsigned Sp[4][16];
#define FS_STAGE_K(j_) do { const int j__ = (j_); _Pragma("unroll") for (int q = 0; q < 2; ++q) { const int ch = wid + 8 * q; \
    __builtin_amdgcn_global_load_lds((const unsigned*)(X.XC + (tok0 + 64 * j__ + lane) * SCD + 1024 + g * 128 + ch * 8), (LAS unsigned*)(lds + L_KIMG + (j__ & 1) * 16384 + ch * 1024), 16, 0, 0); } } while (0)
  FS_STAGE_K(0);
#pragma unroll
  for (int j = 0; j < 4; ++j) {
    asm volatile("s_waitcnt vmcnt(0)" ::: "memory"); __syncthreads();
    if (j + 1 < 4) FS_STAGE_K(j + 1);
    f32x16 p0, p1;
#pragma unroll
    for (int r = 0; r < 16; ++r) { p0[r] = 0.f; p1[r] = 0.f; }
    if (64 * j <= 32 * lt + 31) { const LAS unsigned char* kb = lds + L_KIMG + (j & 1) * 16384 + hi * 1024 + r32 * 16;
#pragma unroll
      for (int d0 = 0; d0 < 8; ++d0) { const bf16x8 b0 = *(const LAS bf16x8*)(kb + d0 * 2048), b1 = *(const LAS bf16x8*)(kb + d0 * 2048 + 512);
        p0 = __builtin_amdgcn_mfma_f32_32x32x16_bf16(b0, qr[d0], p0, 0, 0, 0); p1 = __builtin_amdgcn_mfma_f32_32x32x16_bf16(b1, qr[d0], p1, 0, 0, 0); } }
#pragma unroll
    for (int r = 0; r < 8; ++r) { Sp[j][r] = pg8::cvt_pk_bf16(p0[2 * r], p0[2 * r + 1]); Sp[j][8 + r] = pg8::cvt_pk_bf16(p1[2 * r], p1[2 * r + 1]); } }
#undef FS_STAGE_K
  FS_STAMP(32);
  __syncthreads();
#define FS_STAGE_X(h_) do { const int h__ = (h_); _Pragma("unroll") for (int j = 0; j < 4; ++j) \
    __builtin_amdgcn_global_load_lds((const unsigned*)(X.XC + (tok0 + 64 * j + 16 * (wid & 3) + (lane >> 2)) * SCD + (g * 8 + h__) * 64 + (wid >> 2) * 32 + (lane & 3) * 8), \
                                     (LAS unsigned*)(lds + L_XV + (h__ & 1) * 32768 + j * 8192 + wid * 1024), 16, 0, 0); } while (0)
  const int vb0 = (int)(unsigned)(size_t)lds + ((lane >> 4) & 1) * 32 + (lane & 3) * 8 + (4 * hi + ((lane & 15) >> 2)) * 64;
  FS_STAGE_X(0);
#pragma unroll 1
  for (int h = 0; h < 8; ++h) { const int hh = g * 8 + h;
    if (h == 0) asm volatile("s_waitcnt vmcnt(0) lgkmcnt(0)\n\ts_barrier" ::: "memory"); else asm volatile("s_waitcnt vmcnt(4) lgkmcnt(0)\n\ts_barrier" ::: "memory");
    if (h + 1 < 8) FS_STAGE_X(h + 1);
    const float al = acs2[h * 256 + l]; f32x16 o[2];
#pragma unroll
    for (int r = 0; r < 16; ++r) { o[0][r] = 0.f; o[1][r] = 0.f; }
#pragma unroll
    for (int j = 0; j < 4; ++j) { if (64 * j <= 32 * lt + 31) { f32x16 p0, p1;
#pragma unroll
        for (int r = 0; r < 16; ++r) asm volatile("" : "+v"(Sp[j][r]));
#pragma unroll
        for (int r = 0; r < 8; ++r) { p0[2 * r] = __uint_as_float(Sp[j][r] << 16); p0[2 * r + 1] = __uint_as_float(Sp[j][r] & 0xffff0000u); p1[2 * r] = __uint_as_float(Sp[j][8 + r] << 16); p1[2 * r + 1] = __uint_as_float(Sp[j][8 + r] & 0xffff0000u); }
        float e1[4];
#pragma unroll
        for (int q = 0; q < 4; ++q) e1[q] = ex2(al - acs2[h * 256 + 64 * j + 16 * q]);
#pragma unroll
        for (int gq = 0; gq < 4; ++gq) { const int s0 = 64 * j + 8 * gq + 4 * hi; const f32x4 d0v = *(const LAS f32x4*)(dtl + h * 256 + s0), d1v = *(const LAS f32x4*)(dtl + h * 256 + s0 + 32);
#pragma unroll
          for (int k = 0; k < 4; ++k) { const int r = 4 * gq + k, s = s0 + k; p0[r] = (s <= l) ? p0[r] * (e1[gq >> 1] * d0v[k]) : 0.f; p1[r] = (s + 32 <= l) ? p1[r] * (e1[2 + (gq >> 1)] * d1v[k]) : 0.f; } }
        u32x4 w0, w1, w2, w3;
        w0.x = pg8::cvt_pk_bf16(p0[0], p0[1]); w0.y = pg8::cvt_pk_bf16(p0[2], p0[3]); w0.z = pg8::cvt_pk_bf16(p0[4], p0[5]); w0.w = pg8::cvt_pk_bf16(p0[6], p0[7]);
        w1.x = pg8::cvt_pk_bf16(p0[8], p0[9]); w1.y = pg8::cvt_pk_bf16(p0[10], p0[11]); w1.z = pg8::cvt_pk_bf16(p0[12], p0[13]); w1.w = pg8::cvt_pk_bf16(p0[14], p0[15]);
        w2.x = pg8::cvt_pk_bf16(p1[0], p1[1]); w2.y = pg8::cvt_pk_bf16(p1[2], p1[3]); w2.z = pg8::cvt_pk_bf16(p1[4], p1[5]); w2.w = pg8::cvt_pk_bf16(p1[6], p1[7]);
        w3.x = pg8::cvt_pk_bf16(p1[8], p1[9]); w3.y = pg8::cvt_pk_bf16(p1[10], p1[11]); w3.z = pg8::cvt_pk_bf16(p1[12], p1[13]); w3.w = pg8::cvt_pk_bf16(p1[14], p1[15]);
        fa::pv(o, vb0 + L_XV + (h & 1) * 32768 + j * 8192, __builtin_bit_cast(bf16x8, w0), __builtin_bit_cast(bf16x8, w1), __builtin_bit_cast(bf16x8, w2), __builtin_bit_cast(bf16x8, w3)); } }
    { const float dsk = I.d_skip[hh]; const LAS u16* xi = (const LAS u16*)(lds + L_XV + (h & 1) * 32768 + (lt >> 1) * 8192); LAS u16* stg = (LAS u16*)(lds + L_OST) + wid * 2048;
#pragma unroll
      for (int r = 0; r < 16; ++r) { const int key = 32 * (lt & 1) + crow(r, hi);
#pragma unroll
        for (int d0 = 0; d0 < 2; ++d0) { const float xv = nv::bf2f(xi[d0 * 2048 + (key >> 4) * 512 + (key & 15) * 32 + r32]); stg[crow(r, hi) * 64 + d0 * 32 + r32] = nv::f2bf(o[d0][r] + dsk * xv); } }
      asm volatile("s_waitcnt lgkmcnt(0)" ::: "memory");
      u16* Ow = X.XC + (tok0 + 32 * lt) * SCD + hh * 64;
#pragma unroll
      for (int q = 0; q < 4; ++q) { const int row = q * 8 + (lane >> 3), ch = lane & 7; const u32x4 v = *(const LAS u32x4*)(stg + row * 64 + ch * 8); *(u32x4*)(Ow + (size_t)row * SCD + ch * 8) = v; } } }
#undef FS_STAMP_DUMMY
#undef FS_STAGE_X
  __syncthreads(); FS_STAMP(33);
}
__device__ __forceinline__ void phase_ssd_x(LAS unsigned char* lds, const Inputs& I, const Bufs& B, const SsdBufs& X) {
  for (int u = blockIdx.x; u < 256; u += gridDim.x) ssd_x_unit(lds, I, B, X, u >> 5, (u >> 1) & 15, u & 1);
}
__device__ __forceinline__ void phase_ssd_scan(const SsdBufs& X) {
  for (int it = blockIdx.x * 512 + fx::otid(); it < 8 * 16 * 64 * 32; it += gridDim.x * 512) { const int n4 = (it & 31) * 4, p = (it >> 5) & 63, hh = (it >> 11) & 15, b = it >> 15;
    pg8::u32x2 v[16]; float dec[16];
#pragma unroll
    for (int c = 0; c < 16; ++c) { v[c] = *(const pg8::u32x2*)(X.STATE + (((size_t)b * 16 + c) * 16 + hh) * 8192 + p * 128 + n4); dec[c] = X.DEC[((size_t)b * 16 + c) * 16 + hh]; }
    float h0 = 0.f, h1 = 0.f, h2 = 0.f, h3 = 0.f;
#pragma unroll
    for (int c = 0; c < 16; ++c) { pg8::u32x2 o; o.x = fx::pk2(h0, h1); o.y = fx::pk2(h2, h3); *(pg8::u32x2*)(X.STATE + (((size_t)b * 16 + c) * 16 + hh) * 8192 + p * 128 + n4) = o;
      h0 = h0 * dec[c] + __uint_as_float(v[c].x << 16); h1 = h1 * dec[c] + __uint_as_float(v[c].x & 0xffff0000u); h2 = h2 * dec[c] + __uint_as_float(v[c].y << 16); h3 = h3 * dec[c] + __uint_as_float(v[c].y & 0xffff0000u); } }
}
__device__ __forceinline__ void ssd_y_unit(LAS unsigned char* lds, const Inputs& I, const Bufs& B, const SsdBufs& X, int b, int c, int g) {
  const int tid = fx::otid(), lane = tid & 63, wid = __builtin_amdgcn_readfirstlane(tid >> 6), r32 = lane & 31, hi = lane >> 5;
  const size_t tok0 = (size_t)b * S + (size_t)c * 256; const int l = 32 * wid + r32;
  LAS float* acsw = (LAS float*)(lds + 0) + wid * 32 * 8;
  LAS u16* stg1 = (LAS u16*)(lds + 16384) + wid * 2048; LAS u16* stg2 = (LAS u16*)(lds + 49152) + wid * 2048; LAS float* rstdL = (LAS float*)(lds + 81920);
  { const int row = lane >> 1, h4 = (lane & 1) * 4; const f32x4 a = *(const f32x4*)(X.ACS + (tok0 + 32 * wid + row) * 16 + g * 8 + h4); acsw[row * 8 + h4 + 0] = ex2(a.x); acsw[row * 8 + h4 + 1] = ex2(a.y); acsw[row * 8 + h4 + 2] = ex2(a.z); acsw[row * 8 + h4 + 3] = ex2(a.w); }
  bf16x8 qr[8];
#pragma unroll
  for (int d0 = 0; d0 < 8; ++d0) qr[d0] = *(const bf16x8*)(X.XC + (tok0 + l) * SCD + 1280 + g * 128 + d0 * 16 + hi * 8);
  float ssq[16];
#pragma unroll
  for (int r = 0; r < 16; ++r) ssq[r] = 0.f;
#define FSY_STAGE_P(h_) do { const int h__ = (h_); const u16* pp_ = X.STATE + (((size_t)b * 16 + c) * 16 + g * 8 + h__) * 8192; _Pragma("unroll") for (int q = 0; q < 2; ++q) { const int ch = wid + 8 * q; \
    __builtin_amdgcn_global_load_lds((const unsigned*)(pp_ + (size_t)lane * 128 + ch * 8), (LAS unsigned*)(lds + 90112 + (h__ & 1) * 16384 + ch * 1024), 16, 0, 0); } } while (0)
#define FSY_LOAD_YZ(h_) do { const int hh__ = g * 8 + (h_); _Pragma("unroll") for (int q = 0; q < 4; ++q) { const int row = q * 8 + (lane >> 3), ch = lane & 7; \
    ny1[q] = *(const u32x4*)(X.XC + (tok0 + 32 * wid + row) * SCD + hh__ * 64 + ch * 8); nz[q] = *(const u32x4*)(B.Z + (tok0 + 32 * wid + row) * 1024 + hh__ * 64 + ch * 8); } } while (0)
  u32x4 ny1[4], nz[4];
  FS_STAMP(34);
  FSY_STAGE_P(0); FSY_LOAD_YZ(0);
#pragma unroll 1
  for (int h = 0; h < 8; ++h) { const int hh = g * 8 + h;
    if (h == 0) asm volatile("s_waitcnt vmcnt(0) lgkmcnt(0)\n\ts_barrier" ::: "memory"); else asm volatile("s_waitcnt vmcnt(4) lgkmcnt(0)\n\ts_barrier" ::: "memory");
#pragma unroll
    for (int q = 0; q < 4; ++q) { const int row = q * 8 + (lane >> 3), ch = lane & 7; *(LAS u32x4*)(stg1 + row * 64 + ch * 8) = ny1[q]; *(LAS u32x4*)(stg2 + row * 64 + ch * 8) = nz[q]; }
    if (h + 1 < 8) { FSY_STAGE_P(h + 1); FSY_LOAD_YZ(h + 1); }
    f32x16 y[2];
#pragma unroll
    for (int r = 0; r < 16; ++r) { y[0][r] = 0.f; y[1][r] = 0.f; }
    { const LAS unsigned char* pb = lds + 90112 + (h & 1) * 16384 + hi * 1024 + r32 * 16;
#pragma unroll
      for (int d0 = 0; d0 < 8; ++d0) { const bf16x8 b0 = *(const LAS bf16x8*)(pb + d0 * 2048), b1 = *(const LAS bf16x8*)(pb + d0 * 2048 + 512);
        y[0] = __builtin_amdgcn_mfma_f32_32x32x16_bf16(qr[d0], b0, y[0], 0, 0, 0); y[1] = __builtin_amdgcn_mfma_f32_32x32x16_bf16(qr[d0], b1, y[1], 0, 0, 0); } }
    asm volatile("s_waitcnt lgkmcnt(0)" ::: "memory");
#pragma unroll
    for (int r = 0; r < 16; ++r) { const int row = crow(r, hi); const float ea = acsw[row * 8 + h];
#pragma unroll
      for (int d0 = 0; d0 < 2; ++d0) { const int idx = row * 64 + d0 * 32 + r32; const float yy = nv::bf2f(stg1[idx]) + ea * y[d0][r]; const float zz = nv::bf2f(stg2[idx]); const float yg = yy * zz * fx::fsig(zz); ssq[r] += yg * yg; stg1[idx] = nv::f2bf(yg); } }
    asm volatile("s_waitcnt lgkmcnt(0)" ::: "memory");
#pragma unroll
    for (int q = 0; q < 4; ++q) { const int row = q * 8 + (lane >> 3), ch = lane & 7; *(u32x4*)(B.YB + (tok0 + 32 * wid + row) * 1024 + hh * 64 + ch * 8) = *(const LAS u32x4*)(stg1 + row * 64 + ch * 8); }
    asm volatile("s_waitcnt lgkmcnt(0)" ::: "memory"); }
  FS_STAMP(35);
#pragma unroll
  for (int r = 0; r < 16; ++r) { float v = ssq[r];
#pragma unroll
    for (int o = 1; o < 32; o <<= 1) v += __shfl_xor(v, o);
    if (r32 == 0) rstdL[32 * wid + crow(r, hi)] = 1.0f / sqrtf(v * (1.f / 512.f) + nv::EPS); }
#undef FSY_STAGE_P
#undef FSY_LOAD_YZ
  asm volatile("s_waitcnt vmcnt(0) lgkmcnt(0)\n\ts_barrier" ::: "memory"); FS_STAMP(36);
#pragma unroll 1
  for (int q0 = tid; q0 < 256 * 64; q0 += 512 * 8) { float v[8][8];
#pragma unroll
    for (int u = 0; u < 8; ++u) { const int q = q0 + u * 512, row = q >> 6, c8 = (q & 63) * 8; fx::load8(B.YB + (tok0 + row) * 1024 + g * 512 + c8, v[u]); }
#pragma unroll
    for (int u = 0; u < 8; ++u) { const int q = q0 + u * 512, row = q >> 6, c8 = (q & 63) * 8; const float rs = rstdL[row];
#pragma unroll
      for (int j = 0; j < 8; ++j) v[u][j] = v[u][j] * rs * I.ssm_norm[g * 512 + c8 + j];
      fx::store8(B.YB + (tok0 + row) * 1024 + g * 512 + c8, v[u]); } }
  __syncthreads();
}
__device__ __forceinline__ void phase_ssd_y(LAS unsigned char* lds, const Inputs& I, const Bufs& B, const SsdBufs& X) {
  for (int u = blockIdx.x; u < 256; u += gridDim.x) ssd_y_unit(lds, I, B, X, u >> 5, (u >> 1) & 15, u & 1);
}
}
namespace fc {
using nv::u16; using nv::Bufs; using nv::Inputs; using pg8::Unit;
constexpr int S = nv::S;
struct CmpBufs { u16* WcT; float* BIAS1; float* PAB; };
__host__ __device__ inline size_t carve_cmp(CmpBufs& C, unsigned char* ws, size_t off) {
  auto take = [&](size_t bytes) { unsigned char* r = ws + off; off += (bytes + 255) / 256 * 256; return r; };
  C.WcT = (u16*)take((size_t)2 * 256 * 1024 * 2); C.BIAS1 = (float*)take(2 * 128 * 4); C.PAB = (float*)take((size_t)2 * 2 * 16 * 256 * 256 * 4);
  return off;
}
struct CpCmp { const float* src; int ld; __device__ const float* operator()(int n) const { return n < 128 ? src + n : src + (size_t)1024 * 128 + (n - 128); } };
__device__ __forceinline__ void prologue_cmp(LAS unsigned char* lds, const Inputs& I, const CmpBufs& C) {
  { const int tid = fx::otid(), lane = tid & 63, wv = tid >> 6, gw = fx::obid() * 8 + wv, ngw = gridDim.x * 8; LAS float* scr = (LAS float*)lds + wv * (64 * 33);
    for (int t = gw; t < 2 * 8 * 16; t += ngw) { const int kv = t >> 7, q = t & 127; CpCmp cp{kv ? I.w1_v : I.w1_k, 128}; fx::transpose_item(scr, cp, C.WcT + (size_t)kv * 256 * 1024, 1024, (q >> 4) * 32, (q & 15) * 64, lane); } }
  { const int tid = fx::otid(), lane = tid & 63, gw = fx::obid() * 8 + (tid >> 6);
    if (gw < 256) { const int kv = gw >> 7, n = gw & 127; const float* w1 = kv ? I.w1_v : I.w1_k; const float* pos = kv ? I.pos_v : I.pos_k; float s = 0.f;
      for (int k = lane; k < 2048; k += 64) s += pos[k] * w1[(size_t)k * 128 + n];
      s = fx::wave_sum(s); if (lane == 0) C.BIAS1[kv * 128 + n] = s; } }
}
struct SchedCmp { int kv, bg, kh;
  __device__ bool next(int i, Unit& u) const { if (i > 0) return false; u.pm = (kh * 2 + kv) * 16 + bg; u.pn = 0; u.aux0 = 0; u.aux1 = 0; return true; }
  __device__ __forceinline__ const char* a_base(const pg8::Gemm& g, const Unit&) const { return (const char*)g.A + (size_t)kh * 8 * 1280 * 2; }
  __device__ __forceinline__ const char* b_base(const pg8::Gemm& g, const Unit&) const { return (const char*)g.Bt + ((size_t)kv * 256 * 1024 + (size_t)kh * 512) * 2; }
  __device__ __forceinline__ int a_row(const Unit&, int r) const { return ((bg >> 1) * S + 16 * r) * 1280 + (kv ? nv::O_VC : nv::O_KC) + (bg & 1) * 64; } };
struct FPab { float* o; __device__ __forceinline__ void operator()(const Unit&, int row, int c, const float (&v)[8]) const { float* p = o + (size_t)row * 256 + c; *(pg8::f32x4*)p = (pg8::f32x4){v[0], v[1], v[2], v[3]}; *(pg8::f32x4*)(p + 4) = (pg8::f32x4){v[4], v[5], v[6], v[7]}; } };
__device__ __forceinline__ void phase_cmp_gemm(LAS unsigned char* lds, const Bufs& B, const CmpBufs& C) {
  for (int u = (int)blockIdx.x - ((int)gridDim.x - 64); u >= 0 && u < 64; u += gridDim.x) { pg8::Gemm g{B.QKV, C.WcT, 256, 256, 512, 1, 1024, 1280 * 2}; SchedCmp S{(u >> 4) & 1, u & 15, u >> 5}; fx::Epi8<FPab> E{FPab{C.PAB}};
    pg8::gemm_phase<fx::Epi8<FPab>, SchedCmp, true, true>(lds, g, S, E); }
}
__device__ __forceinline__ void phase_cmp_finish(LAS unsigned char* lds, const Inputs& I, const Bufs& B, const CmpBufs& C) {
  const int tid = fx::otid(), lane = tid & 63, wv = tid >> 6, gw = fx::obid() * 8 + wv, ngw = gridDim.x * 8;
  LAS float* w2s = (LAS float*)lds; LAS float* hs = (LAS float*)(lds + 65536) + wv * 128;
  for (int k = tid; k < 2 * 128 * 64 / 4; k += 512) { const int kv = k >> 11, q = k & 2047; *(LAS pg8::f32x4*)(w2s + kv * 8192 + q * 4) = *(const pg8::f32x4*)((kv ? I.w2_v : I.w2_k) + q * 4); }
  __syncthreads();
  for (int it = gw; it < 2 * 16 * 256; it += ngw) { const int kv = it >> 12, bg = (it >> 8) & 15, c = it & 255; u16* dst = (kv ? B.VCMP : B.KCMP) + ((size_t)bg * 256 + c) * 64;
    if (c == 255) { dst[lane] = 0; continue; }
    const float* pa = C.PAB + ((size_t)(kv * 16 + bg) * 256 + c) * 256; const float* pb = pa + 256 + 128; const float* b1 = C.BIAS1 + kv * 128;
    const float* pa2 = pa + (size_t)2 * 16 * 256 * 256; const float* pb2 = pb + (size_t)2 * 16 * 256 * 256;
    { const float ha = (pa[lane] + pa2[lane]) + (pb[lane] + pb2[lane]) + b1[lane], hb = (pa[64 + lane] + pa2[64 + lane]) + (pb[64 + lane] + pb2[64 + lane]) + b1[64 + lane]; hs[lane] = ha * fx::fsig(ha); hs[64 + lane] = hb * fx::fsig(hb); }
    const LAS float* w2 = w2s + kv * 8192; float acc = 0.f;
#pragma unroll 8
    for (int n = 0; n < 128; ++n) acc += hs[n] * w2[n * 64 + lane];
    if (kv == 0) { const float ss = fx::wave_sum(acc * acc); acc = acc * (1.0f / sqrtf(ss * (1.f / 64.f) + nv::EPS)) * I.kc_gain[lane]; }
    dst[lane] = nv::f2bf(acc); }
  __syncthreads();
}
}
struct Params { nv::Inputs I; float* out; unsigned char* ws; };
constexpr int LDS_BYTES = 147456;
template <class F> __device__ __forceinline__ void run_phase(const F& f, long n) {
  for (long i = blockIdx.x * 512L + fx::otid(); i < n; i += (long)gridDim.x * 512L) f(i);
}
__global__ void __launch_bounds__(512) mega_fwd(Params P) {
  extern __shared__ __attribute__((aligned(16))) unsigned char lds_raw[];
  LAS unsigned char* lds = (LAS unsigned char*)lds_raw;
  cg::grid_group grid = cg::this_grid();
#define PH(...) { unsigned char* ws_ = P.ws; float* out = P.out; asm volatile("" : "+s"(ws_), "+s"(out)); nv::Bufs B; const size_t woff = nv::carve(B, ws_, out); fx::WBufs W; const size_t moff = fx::carve_w(W, ws_, woff); \
    fx::MoeBufs M; const size_t soff = fx::carve_moe(M, B, ws_, moff); fs::SsdBufs X; const size_t coff = fs::carve_ssd(X, B, ws_, soff); fc::CmpBufs C; const size_t boff = fc::carve_cmp(C, ws_, coff); unsigned* barw = (unsigned*)(ws_ + boff); (void)barw; (void)W; (void)M; (void)X; (void)C; __VA_ARGS__ }
  if (threadIdx.x < 4) ((LAS unsigned*)(lds + LDS_BYTES - 16))[threadIdx.x] = 0u;
  __syncthreads();
  xb::XcdBarrier bar; PH( bar = xb::xcd_barrier_post(barw, (volatile LAS unsigned*)(lds + LDS_BYTES - 16)); )
#define GSYNC() xb::xcd_barrier(bar)
  PH( fx::phase_prologue(lds, P.I, B, W); fx::phase_rms_rows(P.I.x, P.I.mix_norm, B.HB); fx::prologue_pb(P.I, W); fx::prologue_moe(P.I, M); fc::prologue_cmp(lds, P.I, C); ) grid.sync();
  PH( fx::dense_gemm(lds, B.HB, 1024, W.WinT, 1024, nv::NTOK, fx::INW_PAD, 1024, fx::FInProj{B.QKV, B.Z, B.XBC, B.BG, B.NG, B.DT, P.I.dt_bias}); ) GSYNC();
  PH( fc::phase_cmp_gemm(lds, B, C); fs::phase_conv(P.I, B, X); fa::phase_qknorm(P.I, B); ) GSYNC();
  PH( fs::phase_ssd_x(lds, P.I, B, X); ) GSYNC();
  PH( fs::phase_ssd_scan(X); fc::phase_cmp_finish(lds, P.I, B, C); ) GSYNC();
  PH( fs::phase_ssd_y(lds, P.I, B, X); ) GSYNC();
  PH( fa::phase_attention(lds, P.I, B); ) GSYNC();
  PH( fx::dense_gemm(lds, B.YA, 512, W.WaT, 512, nv::NTOK, 1024, 512, fx::FStoreBf{B.T1, 1024}); )
  PH( fx::dense_gemm(lds, B.YB, 1024, W.WbT, 1024, nv::NTOK, 1024, 1024, fx::FMerge{B.T1, B.BG, B.MERGED}); ) GSYNC();
  PH( fx::dense_gemm(lds, B.MERGED, 1024, W.WoutT, 1024, nv::NTOK, 1024, 1024, fx::FResid{P.I.x, (nv::u16*)out}); ) GSYNC();
  PH( fx::phase_rms_rows_bf((const nv::u16*)out, P.I.moe_norm, B.H2); ) GSYNC();
  PH( fx::dense_gemm(lds, B.H2, 1024, M.WrT, 1024, nv::NTOK, 256, 1024, fx::FLogits{M.LOGITS}); ) GSYNC();
  PH( fx::phase_route(lds, P.I, B, M); ) GSYNC();
  PH( fx::build_tile_table(lds, M); )
  PH( fx::phase_moe_gu(lds, B, W, M); ) GSYNC();
  PH( fx::phase_moe_down(lds, B, W, M); ) GSYNC();
  PH( fx::phase_moe_combine(lds, (const nv::u16*)out, B.ACT, M, B.EW, P.I.ple_norm, B.H2); ) GSYNC();
  PH( fx::dense_gemm(lds, B.H2, 1024, W.PleGT, 1024, nv::NTOK, 1024, 1024, fx::FPle{B.ACT, out, B.PP}); )
#undef GSYNC
}
extern "C" void kernel_launch(void* const* d_in, const int* in_sizes, int n_in, void* d_out, int out_size, void* d_ws, size_t ws_size, hipStream_t stream) {
  static int grid_blocks = 0;
  if (!grid_blocks) {
    int dev = 0, cus = 0, per_cu = 0;
    (void)hipGetDevice(&dev);
    (void)hipDeviceGetAttribute(&cus, hipDeviceAttributeMultiprocessorCount, dev);
    if (hipFuncSetAttribute((const void*)mega_fwd, hipFuncAttributeMaxDynamicSharedMemorySize, LDS_BYTES) != hipSuccess) fprintf(stderr, "kernel_launch: hipFuncSetAttribute failed\n");
    if (hipOccupancyMaxActiveBlocksPerMultiprocessor(&per_cu, mega_fwd, 512, LDS_BYTES) != hipSuccess || per_cu < 1) { fprintf(stderr, "kernel_launch: occupancy query says %d blocks per CU\n", per_cu); }
    grid_blocks = cus;
    { nv::Bufs B; fx::WBufs W; fx::MoeBufs M; fs::SsdBufs X; fc::CmpBufs C; size_t need = 16384 + fc::carve_cmp(C, nullptr, fs::carve_ssd(X, B, nullptr, fx::carve_moe(M, B, nullptr, fx::carve_w(W, nullptr, nv::carve(B, nullptr, nullptr))))); if (need > ws_size) fprintf(stderr, "kernel_launch: workspace too small: need %zu have %zu\n", need, ws_size); }
  }
  static size_t bar_off = 0;
  if (!bar_off) { nv::Bufs B; fx::WBufs W; fx::MoeBufs M; fs::SsdBufs X; fc::CmpBufs C; bar_off = fc::carve_cmp(C, nullptr, fs::carve_ssd(X, B, nullptr, fx::carve_moe(M, B, nullptr, fx::carve_w(W, nullptr, nv::carve(B, nullptr, nullptr))))); }
  (void)hipMemsetAsync((char*)d_ws + bar_off, 0, 16384, stream);
  Params p; memset(&p, 0, sizeof(p));
  const float** ip = (const float**)&p.I; for (int i = 0; i < 34; ++i) ip[i] = (const float*)d_in[i];
  p.out = (float*)d_out; p.ws = (unsigned char*)d_ws;
  void* args[] = {&p};
  hipError_t e = hipLaunchCooperativeKernel((void*)mega_fwd, dim3(grid_blocks), dim3(512), args, LDS_BYTES, stream);
  if (e != hipSuccess) fprintf(stderr, "cooperative launch failed: %s (grid %d)\n", hipGetErrorString(e), grid_blocks);
}
```

```cpp
#include <hip/hip_runtime.h>
#include <hip/hip_cooperative_groups.h>
#include <cstdio>
#include <cstring>
namespace cg = cooperative_groups;
#define HD __host__ __device__ inline
#if defined(__HIP_DEVICE_COMPILE__)
#define NV_FENCE() asm volatile("" ::: "memory")
#else
#define NV_FENCE()
#endif
#ifndef CFG_DM
#define CFG_DM 1024
#endif
#ifndef CFG_BATCH
#define CFG_BATCH 8
#endif
#ifndef CFG_SEQ
#define CFG_SEQ 4096
#endif
#ifndef CFG_MH
#define CFG_MH 256
#endif
#ifndef CFG_PLE
#define CFG_PLE 256
#endif

#ifndef NV_FENCE
#define NV_FENCE()
#endif
namespace nv {
typedef unsigned short u16;
typedef unsigned long long u64;
constexpr int DM = CFG_DM, NB = CFG_BATCH, S = CFG_SEQ, MH = CFG_MH, PLE = CFG_PLE;
constexpr int NTOK = NB * S;
constexpr int H = 8, G = 2, E = 4;
constexpr int QW = 512, GW = 24, QKVW = 1280;
constexpr int SH = 16, SP = 64, SI = 1024, SG = 2, SN = 128, SCD = 1536;
constexpr int INW = QW + 6 * 128 + GW + SI + SCD + SH + 2 * DM;
constexpr int O_Q = 0, O_KC = 512, O_VC = 640, O_KS = 768, O_VS = 896, O_KW = 1024, O_VW = 1152, O_NG = 1280, O_Z = 1304, O_XBC = 2328, O_DT = 3864, O_BG = 3880;
static_assert(O_BG + 2 * DM == INW, "in-proj width");
constexpr int NCMP = S / 16 - 1, NCP = S / 16, NSEL = S / 64, NTOP = NSEL < 16 ? NSEL : 16;
constexpr int NEXP = 32;
constexpr float EPS = 1e-6f;

HD float sigmoidf_(float x) { return 1.0f / (1.0f + expf(-x)); }
HD float siluf_(float x) { return x / (1.0f + expf(-x)); }
HD float softplusf_(float x) { return x > 20.f ? x : log1pf(expf(x)); }
HD u16 f2bf(float f) { unsigned u = __builtin_bit_cast(unsigned, f); u += 0x7fffu + ((u >> 16) & 1u); return (u16)(u >> 16); }
HD float bf2f(u16 h) { return __builtin_bit_cast(float, (unsigned)h << 16); }

struct Bufs {
  u16* HB;
  u16* QKV;
  float* NG;
  u16* Z;
  u16* XBC;
  float* DT;
  u16* BG;
  u16* KCMP;
  u16* VCMP;
  u16* YA;
  u16* YB;
  u16* T1;
  u16* MERGED;
  u16* H2;
  u16* ACT;
  u16* PP;
  int* EI;
  float* EW;
  float* HID;
  float* KTMP;
  float* ML;
  float* IMP;
  u64* MASK;
};
struct Inputs { const float *x, *p, *mix_norm, *w_in, *q_gain, *kc_gain, *ks_gain, *kw_gain, *pos_k, *w1_k, *w2_k, *pos_v, *w1_v, *w2_v, *conv_w, *conv_b, *dt_bias, *a_log, *d_skip, *ssm_norm,
  *w_a, *w_b, *w_out, *moe_norm, *w_group, *b_group, *w_expert, *b_expert, *w_gate, *w_up, *w_down, *ple_norm, *ple_wg, *ple_wp; };

HD size_t carve(Bufs& B, unsigned char* ws, float* out) {
  size_t off = 0; auto take = [&](size_t bytes) { unsigned char* r = ws + off; off += (bytes + 255) / 256 * 256; return r; };
  const size_t N = NTOK;
  B.BG = (u16*)out;
  unsigned char* R0 = take(N * DM * 2);
  unsigned char* R5 = take(N * 2 * MH * 2 + (size_t)NEXP * 256 * MH * 2);
  B.YA = (u16*)take(N * QW * 2);
  unsigned char* R1 = take(N * QKVW * 2);
  unsigned char* R2 = take(N * SI * 2);
  unsigned char* R3 = take(N * SCD * 2);
  B.HB = (u16*)R0; B.H2 = (u16*)R0; B.QKV = (u16*)R1; B.T1 = (u16*)R1; B.Z = (u16*)R2; B.XBC = (u16*)R3; B.MERGED = (u16*)R3; B.PP = (u16*)R3;
  B.ACT = (u16*)R5; B.YB = B.Z;
  B.NG = (float*)take(N * GW * 4); B.DT = (float*)take(N * SH * 4);
  B.KCMP = (u16*)take((size_t)NB * G * NCP * 64 * 2); B.VCMP = (u16*)take((size_t)NB * G * NCP * 64 * 2);
  B.EI = (int*)take(N * 2 * 4); B.EW = (float*)take(N * 2 * 4);
#ifdef NV2_NAIVE_SCRATCH
  B.HID = (float*)take((size_t)NB * G * NCMP * 128 * 4); B.KTMP = (float*)take((size_t)NB * G * NCMP * 64 * 4);
  B.ML = (float*)take(N * H * 2 * 4); B.IMP = (float*)take((size_t)NB * G * S * 64 * 4); B.MASK = (u64*)take((size_t)NB * G * S * 8);
#else
  B.HID = nullptr; B.KTMP = nullptr; B.ML = nullptr; B.IMP = nullptr; B.MASK = nullptr;
#endif
  return off;
}
}
namespace xb {
#define LAS __attribute__((address_space(3)))
#define XB_TMO      128
#define XB_XCNT(j)  (256  + 64 * (j))
#define XB_XSUB(j)  (1280 + 64 * (j))
#define XB_XGEN(j)  (2304 + 64 * (j))
#define XB_TOP      3328
#define XB_TOPGEN   3392
#define XCD_BAR_WORDS 3456
#define XB_SPIN_CAP (1u << 22)

__device__ __forceinline__ unsigned xb_ld(unsigned* p)              { return __hip_atomic_load(p, __ATOMIC_RELAXED, __HIP_MEMORY_SCOPE_AGENT); }
__device__ __forceinline__ unsigned xb_add(unsigned* p, unsigned v) { return __hip_atomic_fetch_add(p, v, __ATOMIC_RELAXED, __HIP_MEMORY_SCOPE_AGENT); }
__device__ __forceinline__ unsigned xb_xcc_id() { return (unsigned)__builtin_amdgcn_s_getreg((3 << 11) | 20) & 0xFu; }
#define XB_SPIN(cond, bar) do { unsigned _sp = 0; while (cond) { __builtin_amdgcn_s_sleep(1); \
    if ((++_sp & 255u) == 0u) { if (xb_ld(&(bar)[XB_TMO])) break; if (_sp > XB_SPIN_CAP) { atomicAdd(&(bar)[XB_TMO], 1u); break; } } } } while (0)

struct XcdBarrier {
    unsigned* bar; unsigned x;
    volatile LAS unsigned* st;
};

__device__ __forceinline__ XcdBarrier xcd_barrier_post(unsigned* bar, volatile LAS unsigned* st) {
    XcdBarrier b; b.bar = bar; b.x = xb_xcc_id(); b.st = st;
    if (threadIdx.x == 0) (void)xb_add(&bar[XB_XCNT(b.x)], 1u);
    return b;
}
__device__ __forceinline__ void xcd_barrier_complete(unsigned* bar, unsigned x, unsigned& nloc, unsigned& nx) {
    const unsigned G = gridDim.x * gridDim.y * gridDim.z;
    unsigned sum, cnt, mine, sp = 0u;
    for (;;) {
        sum = 0u; cnt = 0u; mine = 0u;
#pragma unroll
        for (unsigned j = 0; j < 16; ++j) { const unsigned c = xb_ld(&bar[XB_XCNT(j)]); sum += c; cnt += (c > 0u) ? 1u : 0u; mine = (j == x) ? c : mine; }
        if (sum == G) break;
        __builtin_amdgcn_s_sleep(1);
        if ((++sp & 255u) == 0u) { if (xb_ld(&bar[XB_TMO])) break; if (sp > XB_SPIN_CAP) { atomicAdd(&bar[XB_TMO], 1u); break; } }
    }
    nloc = mine > 0u ? mine : 1u; nx = cnt > 0u ? cnt : 1u;
}

__device__ __forceinline__ void xcd_barrier(const XcdBarrier& b) {
    asm volatile("s_waitcnt vmcnt(0)" ::: "memory");
    __syncthreads();
    if (threadIdx.x == 0) {
        unsigned* bar = b.bar;
        __builtin_amdgcn_s_waitcnt(0);
        unsigned nloc = b.st[0], nx = b.st[1];
        if (nloc == 0u) { xcd_barrier_complete(bar, b.x, nloc, nx); b.st[0] = nloc; b.st[1] = nx; }
        const unsigned old = xb_add(&bar[XB_XSUB(b.x)], 1u);
        const unsigned gen = old / nloc;
        if (old + 1u == (gen + 1u) * nloc) {
            __builtin_amdgcn_fence(__ATOMIC_RELEASE, "agent");
            asm volatile("s_waitcnt vmcnt(0)" ::: "memory");
            const unsigned og = xb_add(&bar[XB_TOP], 1u);
            const unsigned tg = og / nx;
            if (og + 1u == (tg + 1u) * nx) xb_add(&bar[XB_TOPGEN], 1u);
            else XB_SPIN(xb_ld(&bar[XB_TOPGEN]) == tg, bar);
            __builtin_amdgcn_fence(__ATOMIC_ACQUIRE, "agent");
            xb_add(&bar[XB_XGEN(b.x)], 1u);
            asm volatile("s_waitcnt vmcnt(0)" ::: "memory");
        } else {
            XB_SPIN(xb_ld(&bar[XB_XGEN(b.x)]) == gen, bar);
            __builtin_amdgcn_fence(__ATOMIC_ACQUIRE, "agent");
            asm volatile("s_waitcnt vmcnt(0)" ::: "memory");
        }
    }
    __syncthreads();
}
}
namespace pg8 {
#define PG8_LAS __attribute__((address_space(3)))
typedef unsigned short bf16_t;
typedef short bf16x8 __attribute__((ext_vector_type(8)));
typedef float f32x4 __attribute__((ext_vector_type(4)));
typedef unsigned u32x4 __attribute__((ext_vector_type(4)));
typedef unsigned u32x2 __attribute__((ext_vector_type(2)));
constexpr int BM = 256, BK = 64, HALF = 128, HTB = HALF * BK * 2  , STAGE_BYTES = 8 * HTB, NXCD = 8, WGM = 8;

__host__ __device__ __forceinline__ int lds_byte(int r, int c) { const int st = (r >> 4) * 2 + (c >> 5), rr = r & 15, cc = c & 31, ob = rr * 64 + cc * 2; return st * 1024 + (ob ^ (((ob >> 9) & 1) << 5)); }
__host__ __device__ __forceinline__ void stage_rc(int b, int& R, int& C) { const int st = b / 1024, sb = b % 1024, swz = sb ^ (((sb >> 9) & 1) << 5); R = (st >> 1) * 16 + swz / 64; C = (st & 1) * 32 + (swz % 64) / 2; }
__host__ __device__ __forceinline__ int perm32(int rho) { const int n = rho >> 4, i = rho & 15; return 8 * (i >> 2) + 4 * n + (i & 3); }

struct Unit { int pm, pn, aux0, aux1; };
struct Gemm { const bf16_t* A; const bf16_t* Bt; int M, N, K, lda, ldb, kstepA; };

struct StaticOrder {
    int nM, nN, nwg, G, c;
    __device__ void init(int M, int N, int G_, int c_) { nM = M / BM; nN = N / BM; nwg = nM * nN; G = G_; c = c_; }
    __device__ bool next(int i, Unit& u) const {
        const long L = (long)i * G + c; if (L >= nwg) return false;
        int wgid = (int)L; { const int q = nwg / NXCD, r = nwg % NXCD, xcd = wgid % NXCD, off = wgid / NXCD; wgid = (xcd < r ? xcd * (q + 1) : r * (q + 1) + (xcd - r) * q) + off; }
        const int nig = WGM * nN, gid = wgid / nig, fm = gid * WGM, gsz = (nM - fm) < WGM ? (nM - fm) : WGM;
        u.pm = fm + ((wgid % nig) % gsz); u.pn = (wgid % nig) / gsz; u.aux0 = 0; u.aux1 = 0; return true;
    }
    __device__ __forceinline__ const char* a_base(const Gemm& g, const Unit& u) const { return (const char*)g.A + (size_t)u.pm * BM * g.lda * 2; }
    __device__ __forceinline__ const char* b_base(const Gemm& g, const Unit& u) const { return (const char*)g.Bt + (size_t)u.pn * BM * g.ldb * 2; }
    __device__ __forceinline__ int a_row(const Unit&, int) const { return 0; }
};

typedef float f32x2_t __attribute__((ext_vector_type(2))); typedef __bf16 bf16x2_t __attribute__((ext_vector_type(2)));
__device__ __forceinline__ unsigned cvt_pk_bf16(float lo, float hi) { f32x2_t v = {lo, hi}; bf16x2_t b = __builtin_convertvector(v, bf16x2_t); return __builtin_bit_cast(unsigned, b); }


template <class Epi, class Sched, bool ALIGN_EPI = true, bool GATHER = false>
__device__ __forceinline__ void gemm_phase(PG8_LAS unsigned char* lds, const Gemm g, const Sched& S, const Epi& E) {
    int tid_ = threadIdx.x; asm volatile("" : "+v"(tid_));
    const int tid = tid_, wid = __builtin_amdgcn_readfirstlane(tid >> 6), lane = tid & 63, wr = wid >> 2, wc = wid & 3, fr = lane & 15, fq = lane >> 4;
    const int K = g.K, nt = K / BK;
    unsigned voffA[2], voffA1[2], voffB[2];
    int RA[2], CA[2];
#pragma unroll
    for (int i = 0; i < 2; ++i) { int R, C; stage_rc(tid * 16 + i * 8192, R, C); const int Rb = Epi::PERM ? ((R & ~31) + perm32(R & 31)) : R;
        RA[i] = R; CA[i] = C; voffA[i] = (unsigned)(R * g.lda + C) * 2u; voffA1[i] = voffA[i]; voffB[i] = (unsigned)(Rb * g.ldb + C) * 2u; }
    const size_t kstep = (size_t)(BK * 2);
    const size_t kstepA = (size_t)g.kstepA;
    const size_t hstepA = GATHER ? (size_t)0 : (size_t)HALF * g.lda * 2;
    const size_t hstepB = (size_t)HALF * g.ldb * 2;
    const unsigned ldsw = (unsigned)wid * 1024u;
    const int aoff = lds_byte(wr * 64 + fr, fq * 8), boff = lds_byte(wc * 32 + fr, fq * 8);
#define PG8_SA(b, h) (((b) * 2 + (h)) * HTB)
#define PG8_SB(b, h) ((4 + (b) * 2 + (h)) * HTB)
#define PG8_STAGE(bufoff, gbase, voff) do { _Pragma("unroll") for (int _i = 0; _i < 2; ++_i) \
        __builtin_amdgcn_global_load_lds((const unsigned*)((const char*)(gbase) + (voff)[_i]), (PG8_LAS unsigned*)(lds + (bufoff) + ldsw + _i * 8192), 16, 0, 0); } while (0)
#define PG8_STAGE_A0(bufoff, gbase) PG8_STAGE(bufoff, gbase, voffA)
#define PG8_STAGE_A1(bufoff, gbase) do { if constexpr (GATHER) { PG8_STAGE(bufoff, gbase, voffA1); } else { PG8_STAGE(bufoff, (gbase) + hstepA, voffA); } } while (0)
#define PG8_LDA(dst, b, h) do { _Pragma("unroll") for (int m = 0; m < 4; ++m) _Pragma("unroll") for (int k = 0; k < 2; ++k) dst[m][k] = *(const PG8_LAS bf16x8*)(lds + PG8_SA(b, h) + aoff + m * 2048 + k * 1024); } while (0)
#define PG8_LDB(dst, b, h) do { _Pragma("unroll") for (int n = 0; n < 2; ++n) _Pragma("unroll") for (int k = 0; k < 2; ++k) dst[n][k] = *(const PG8_LAS bf16x8*)(lds + PG8_SB(b, h) + boff + n * 2048 + k * 1024); } while (0)
#define PG8_MMA(ai, bj, At, Bt) do { __builtin_amdgcn_s_setprio(1); _Pragma("unroll") for (int m = 0; m < 4; ++m) _Pragma("unroll") for (int n = 0; n < 2; ++n) _Pragma("unroll") for (int k = 0; k < 2; ++k) \
        acc[ai][bj][m][n] = __builtin_amdgcn_mfma_f32_16x16x32_bf16(Bt[n][k], At[m][k], acc[ai][bj][m][n], 0, 0, 0); __builtin_amdgcn_s_setprio(0); } while (0)
#define PG8_WAIT_V(n) asm volatile("s_waitcnt vmcnt(" #n ")" ::: "memory")
#define PG8_WAIT_L(n) asm volatile("s_waitcnt lgkmcnt(" #n ")" ::: "memory")
#define PG8_BAR __builtin_amdgcn_s_barrier()
#define PG8_SCHED __builtin_amdgcn_sched_barrier(0)
    Unit cur, nxt; int ui = 0;
    if (!S.next(0, cur)) return;
    if constexpr (GATHER) {
#pragma unroll
        for (int i = 0; i < 2; ++i) { voffA[i] = (unsigned)(S.a_row(cur, RA[i]) * g.lda + CA[i]) * 2u; voffA1[i] = (unsigned)(S.a_row(cur, HALF + RA[i]) * g.lda + CA[i]) * 2u; }
    }
    f32x4 acc[2][2][4][2];
#pragma unroll
    for (int a = 0; a < 2; ++a)
#pragma unroll
        for (int b = 0; b < 2; ++b)
#pragma unroll
            for (int m = 0; m < 4; ++m)
#pragma unroll
                for (int n = 0; n < 2; ++n) acc[a][b][m][n] = (f32x4){0.f, 0.f, 0.f, 0.f};
    bf16x8 At[4][2], B0[2][2], B1[2][2];
    const char* cA = S.a_base(g, cur); const char* cB = S.b_base(g, cur);
    PG8_STAGE(PG8_SB(0, 0), cB, voffB); PG8_STAGE(PG8_SB(0, 1), cB + hstepB, voffB); PG8_STAGE_A0(PG8_SA(0, 0), cA); PG8_STAGE_A1(PG8_SA(0, 1), cA);
    if (wr == 1) PG8_BAR;
    PG8_WAIT_V(2); PG8_BAR;
    PG8_STAGE(PG8_SB(1, 0), cB + kstep, voffB); PG8_STAGE_A0(PG8_SA(1, 0), cA + kstepA); PG8_STAGE(PG8_SB(1, 1), cB + hstepB + kstep, voffB);
    PG8_WAIT_V(6); PG8_BAR;
    for (;;) {
        const bool has_next = GATHER ? false : S.next(ui + 1, nxt);
        const char* nA = has_next ? S.a_base(g, nxt) : cA; const char* nB = has_next ? S.b_base(g, nxt) : cB;
#pragma unroll 1
        for (int t = 0; t < nt; t += 2) {
            const bool last = (t == nt - 2);
            const char* a1 = cA + (size_t)(t + 1) * kstepA;
            const char* a2 = last ? nA : cA + (size_t)(t + 2) * kstepA; const char* b2 = last ? nB : cB + (size_t)(t + 2) * kstep;
            const char* a3 = a2 + kstepA; const char* b3 = b2 + kstep;
            PG8_LDB(B0, 0, 0); PG8_LDB(B1, 0, 1); PG8_SCHED; PG8_LDA(At, 0, 0); PG8_STAGE_A1(PG8_SA(1, 1), a1);
            PG8_WAIT_V(8); PG8_WAIT_L(0); PG8_BAR; PG8_MMA(0, 0, At, B0); PG8_MMA(0, 1, At, B1); PG8_BAR; PG8_SCHED;
            PG8_LDA(At, 0, 1); PG8_STAGE(PG8_SB(0, 0), b2, voffB); PG8_STAGE(PG8_SB(0, 1), b2 + hstepB, voffB); PG8_STAGE_A0(PG8_SA(0, 0), a2);
            PG8_WAIT_V(8); PG8_WAIT_L(0); PG8_BAR; PG8_MMA(1, 0, At, B0); PG8_MMA(1, 1, At, B1); PG8_BAR; PG8_SCHED;
            PG8_LDB(B0, 1, 0); PG8_LDB(B1, 1, 1); PG8_SCHED; PG8_LDA(At, 1, 0); PG8_STAGE_A1(PG8_SA(0, 1), a2);
            PG8_WAIT_V(8); PG8_WAIT_L(0); PG8_BAR; PG8_MMA(0, 0, At, B0); PG8_MMA(0, 1, At, B1); PG8_BAR; PG8_SCHED;
            PG8_LDA(At, 1, 1); PG8_STAGE(PG8_SB(1, 0), b3, voffB); PG8_STAGE(PG8_SB(1, 1), b3 + hstepB, voffB); PG8_STAGE_A0(PG8_SA(1, 0), a3);
            PG8_WAIT_V(8); PG8_WAIT_L(0); PG8_BAR; PG8_MMA(1, 0, At, B0); PG8_MMA(1, 1, At, B1); PG8_BAR; PG8_SCHED;
        }
        if constexpr (ALIGN_EPI) { if (wr == 0) PG8_BAR; }
        E(acc, cur, wr, wc, fr, fq);
        if (!has_next) break;
#pragma unroll
        for (int a = 0; a < 2; ++a)
#pragma unroll
            for (int b = 0; b < 2; ++b)
#pragma unroll
                for (int m = 0; m < 4; ++m)
#pragma unroll
                    for (int n = 0; n < 2; ++n) acc[a][b][m][n] = (f32x4){0.f, 0.f, 0.f, 0.f};
        cur = nxt; cA = nA; cB = nB; ++ui;
        if constexpr (ALIGN_EPI) { if (wr == 1) PG8_BAR; }
    }
    PG8_WAIT_V(0);
    if constexpr (!ALIGN_EPI) { if (wr == 0) PG8_BAR; }
    PG8_BAR;
#undef PG8_SA
#undef PG8_SB
#undef PG8_STAGE
#undef PG8_STAGE_A0
#undef PG8_STAGE_A1
#undef PG8_LDA
#undef PG8_LDB
#undef PG8_MMA
#undef PG8_WAIT_V
#undef PG8_WAIT_L
#undef PG8_BAR
#undef PG8_SCHED
}
}
namespace fx {
using nv::u16; using nv::Bufs; using nv::Inputs;
using pg8::f32x4; using pg8::u32x4; using pg8::Unit;
#define LAS __attribute__((address_space(3)))
static_assert(nv::DM == 1024 && nv::NB == 8 && nv::S == 4096 && nv::MH == 256 && nv::PLE == 256, "fast phases are written for the full-size problem");
constexpr int NTOK = nv::NTOK, DM = 1024;
constexpr int INW_PAD = 6144;
constexpr int C_Z = 1280, C_XBC = 2304, C_BG = 3840, C_NG = 5888, C_DT = 5912, C_END = 5928;

struct WBufs { u16 *WinT, *WaT, *WbT, *WoutT, *PleGT, *PlePT, *WguT, *WdT, *PB; };
__host__ __device__ inline size_t carve_w(WBufs& W, unsigned char* ws, size_t off) {
  auto take = [&](size_t bytes) { unsigned char* r = ws + off; off += (bytes + 255) / 256 * 256; return r; };
  W.WinT = (u16*)take((size_t)INW_PAD * 1024 * 2); W.WaT = (u16*)take((size_t)1024 * 512 * 2); W.WbT = (u16*)take((size_t)1024 * 1024 * 2); W.WoutT = (u16*)take((size_t)1024 * 1024 * 2);
  W.PleGT = (u16*)take((size_t)1024 * 1024 * 2); W.PlePT = (u16*)take((size_t)1024 * 256 * 2); W.WguT = (u16*)take((size_t)32 * 512 * 1024 * 2); W.WdT = (u16*)take((size_t)32 * 1024 * 256 * 2);
  W.PB = (u16*)take((size_t)NTOK * 256 * 2);
  return off;
}

__device__ __forceinline__ int otid() { int t = threadIdx.x; asm volatile("" : "+v"(t)); return t; }
__device__ __forceinline__ int obid() { int b = blockIdx.x; asm volatile("" : "+s"(b)); return b; }
__device__ __forceinline__ float fsig(float x) { return __builtin_amdgcn_rcpf(1.0f + __expf(-x)); }
__device__ __forceinline__ float fsoftplus(float x) { const float e = __expf(x); return x > 20.f ? x : (e < 0.0625f ? e * (1.f - e * (0.5f - e * (0.33333333f - 0.25f * e))) : __logf(1.0f + e)); }
__device__ __forceinline__ unsigned pk2(float lo, float hi) { return pg8::cvt_pk_bf16(lo, hi); }
__device__ __forceinline__ void store8(u16* p, const float (&v)[8]) { u32x4 w; w.x = pk2(v[0], v[1]); w.y = pk2(v[2], v[3]); w.z = pk2(v[4], v[5]); w.w = pk2(v[6], v[7]); *(u32x4*)p = w; }
__device__ __forceinline__ void load8(const u16* p, float (&v)[8]) { const u32x4 w = *(const u32x4*)p;
  v[0] = __uint_as_float(w.x << 16); v[1] = __uint_as_float(w.x & 0xffff0000u); v[2] = __uint_as_float(w.y << 16); v[3] = __uint_as_float(w.y & 0xffff0000u);
  v[4] = __uint_as_float(w.z << 16); v[5] = __uint_as_float(w.z & 0xffff0000u); v[6] = __uint_as_float(w.w << 16); v[7] = __uint_as_float(w.w & 0xffff0000u); }

__device__ __forceinline__ float wave_sum(float v) {
#pragma unroll
  for (int o = 1; o < 64; o <<= 1) v += __shfl_xor(v, o);
  return v; }
__device__ __forceinline__ void rms_row_to_bf16(const float* xrow, const float* gain, u16* orow, int lane) {
  const f32x4* xr = (const f32x4*)xrow + lane; const f32x4* gr = (const f32x4*)gain + lane;
  f32x4 v[4]; float s = 0.f;
#pragma unroll
  for (int j = 0; j < 4; ++j) { v[j] = xr[64 * j]; s += (v[j].x * v[j].x + v[j].y * v[j].y) + (v[j].z * v[j].z + v[j].w * v[j].w); }
  const float rs = 1.0f / sqrtf(wave_sum(s) * (1.f / 1024.f) + nv::EPS);
  unsigned long long* o8 = (unsigned long long*)orow + lane;
#pragma unroll
  for (int j = 0; j < 4; ++j) { const f32x4 g = gr[64 * j]; o8[64 * j] = (unsigned long long)pk2(v[j].x * rs * g.x, v[j].y * rs * g.y) | ((unsigned long long)pk2(v[j].z * rs * g.z, v[j].w * rs * g.w) << 32); }
}
__device__ __forceinline__ void phase_rms_rows(const float* x, const float* gain, u16* out) {
  const int tid = otid(), lane = tid & 63, gw = obid() * 8 + (tid >> 6), ngw = gridDim.x * 8;
  for (int r = gw; r < NTOK; r += 4 * ngw) { f32x4 v[4][4]; float s[4];
#pragma unroll
    for (int q = 0; q < 4; ++q) { const int rq = (r + q * ngw < NTOK) ? r + q * ngw : r; const f32x4* xr = (const f32x4*)(x + (size_t)rq * 1024) + lane;
#pragma unroll
      for (int j = 0; j < 4; ++j) v[q][j] = xr[64 * j]; }
#pragma unroll
    for (int q = 0; q < 4; ++q) { s[q] = 0.f;
#pragma unroll
      for (int j = 0; j < 4; ++j) s[q] += (v[q][j].x * v[q][j].x + v[q][j].y * v[q][j].y) + (v[q][j].z * v[q][j].z + v[q][j].w * v[q][j].w);
      s[q] = 1.0f / sqrtf(wave_sum(s[q]) * (1.f / 1024.f) + nv::EPS); }
#pragma unroll
    for (int q = 0; q < 4; ++q) { if (r + q * ngw >= NTOK) break; unsigned long long* o8 = (unsigned long long*)(out + (size_t)(r + q * ngw) * 1024) + lane; const f32x4* gr = (const f32x4*)gain + lane;
#pragma unroll
      for (int j = 0; j < 4; ++j) { const f32x4 g = gr[64 * j]; o8[64 * j] = (unsigned long long)pk2(v[q][j].x * s[q] * g.x, v[q][j].y * s[q] * g.y) | ((unsigned long long)pk2(v[q][j].z * s[q] * g.z, v[q][j].w * s[q] * g.w) << 32); } } }
}
template <class CP> __device__ __forceinline__ void transpose_item(LAS float* scr, const CP cp, u16* dst, int K, int n0, int k0, int lane) {
  { const float* p = cp(n0 + (lane & 31));
#pragma unroll 8
    for (int i = 0; i < 32; ++i) { const int kk = 2 * i + (lane >> 5); scr[kk * 33 + (lane & 31)] = p ? p[(size_t)(k0 + kk) * cp.ld] : 0.f; } }
  asm volatile("s_waitcnt lgkmcnt(0)" ::: "memory");
  const int c = lane & 7;
#pragma unroll
  for (int j = 0; j < 4; ++j) { const int n = (lane >> 3) + 8 * j; const LAS float* s = scr + (8 * c) * 33 + n;
    u32x4 o; o.x = pk2(s[0 * 33], s[1 * 33]); o.y = pk2(s[2 * 33], s[3 * 33]); o.z = pk2(s[4 * 33], s[5 * 33]); o.w = pk2(s[6 * 33], s[7 * 33]);
    *(u32x4*)(dst + (size_t)(n0 + n) * K + k0 + 8 * c) = o; }
  asm volatile("s_waitcnt lgkmcnt(0)" ::: "memory");
}
struct CpIdent { const float* src; int ld; __device__ const float* operator()(int n) const { return src + n; } };
struct CpInProj { const float* src; int ld; __device__ const float* operator()(int n) const {
  int c; if (n < C_Z) c = n; else if (n < C_XBC) c = nv::O_Z + (n - C_Z); else if (n < C_BG) c = nv::O_XBC + (n - C_XBC); else if (n < C_NG) c = nv::O_BG + (n - C_BG); else if (n < C_DT) c = nv::O_NG + (n - C_NG); else if (n < C_END) c = nv::O_DT + (n - C_DT); else return nullptr;
  return src + c; } };
struct CpGU { const float* gate; long updelta; int ld; __device__ const float* operator()(int n) const { const int tile = n >> 8, r = n & 255; return gate + (r < 128 ? 0L : updelta) + tile * 128 + (r & 127); } };

struct WJob { const float* src; int ld; u16* dst; int K, n0, k0; const float* gk; };
__device__ __forceinline__ WJob wjob_decode(int t, const Inputs& I, const WBufs& W, int lane) {
  constexpr int T_IN = (INW_PAD / 32) * 16, T_A = 32 * 8, T_B = 32 * 16, T_O = 32 * 16, T_PG = 32 * 16, T_PP = 32 * 4, T_GU = 32 * 16 * 16;
  WJob j; j.gk = nullptr; int r = t; const int c = lane & 31;
  if (r < T_IN) { CpInProj cp{I.w_in, nv::INW}; j.n0 = (r / 16) * 32; j.k0 = (r % 16) * 64; j.src = cp(j.n0 + c); j.ld = nv::INW; j.dst = W.WinT; j.K = 1024; return j; } r -= T_IN;
  if (r < T_A) { j.n0 = (r / 8) * 32; j.k0 = (r % 8) * 64; j.src = I.w_a + j.n0 + c; j.ld = 1024; j.dst = W.WaT; j.K = 512; return j; } r -= T_A;
  if (r < T_B) { j.n0 = (r / 16) * 32; j.k0 = (r % 16) * 64; j.src = I.w_b + j.n0 + c; j.ld = 1024; j.dst = W.WbT; j.K = 1024; return j; } r -= T_B;
  if (r < T_O) { j.n0 = (r / 16) * 32; j.k0 = (r % 16) * 64; j.src = I.w_out + j.n0 + c; j.ld = 1024; j.dst = W.WoutT; j.K = 1024; return j; } r -= T_O;
  if (r < T_PG) { j.n0 = (r / 16) * 32; j.k0 = (r % 16) * 64; j.src = I.ple_wg + j.n0 + c; j.ld = 1024; j.dst = W.PleGT; j.K = 1024; j.gk = I.ple_norm; return j; } r -= T_PG;
  if (r < T_PP) { j.n0 = (r / 4) * 32; j.k0 = (r % 4) * 64; j.src = I.ple_wp + j.n0 + c; j.ld = 1024; j.dst = W.PlePT; j.K = 256; return j; } r -= T_PP;
  if (r < T_GU) { const int e = r / 256, q = r % 256; CpGU cp{I.w_gate + (size_t)e * 1024 * 256, (long)(I.w_up - I.w_gate), 256}; j.n0 = (q / 16) * 32; j.k0 = (q % 16) * 64; j.src = cp(j.n0 + c); j.ld = 256; j.dst = W.WguT + (size_t)e * 512 * 1024; j.K = 1024; j.gk = I.moe_norm; return j; } r -= T_GU;
  { const int e = r / 128, q = r % 128; j.n0 = (q / 4) * 32; j.k0 = (q % 4) * 64; j.src = I.w_down + (size_t)e * 256 * 1024 + j.n0 + c; j.ld = 1024; j.dst = W.WdT + (size_t)e * 1024 * 256; j.K = 256; return j; }
}
__device__ __forceinline__ void phase_prologue(LAS unsigned char* lds, const Inputs& I, const Bufs& B, const WBufs& W) {
  const int tid = otid(), lane = tid & 63, wv = tid >> 6, gw = obid() * 8 + wv, ngw = gridDim.x * 8;
  LAS float* scr = (LAS float*)lds + wv * (64 * 33);
  constexpr int TOT = (INW_PAD / 32) * 16 + 32 * 8 + 32 * 16 * 3 + 32 * 4 + 32 * 16 * 16 + 32 * 32 * 4;
  float cur[32];
  int t = gw; WJob jb;
  if (t < TOT) { jb = wjob_decode(t, I, W, lane);
#pragma unroll
    for (int i = 0; i < 32; ++i) cur[i] = jb.src ? jb.src[(size_t)(jb.k0 + 2 * i + (lane >> 5)) * jb.ld] : 0.f;
    if (jb.gk) {
#pragma unroll
      for (int i = 0; i < 32; ++i) cur[i] *= jb.gk[jb.k0 + 2 * i + (lane >> 5)]; } }
  while (t < TOT) { const int tn = t + ngw; WJob jn = jb; float nxt[32];
    if (tn < TOT) { jn = wjob_decode(tn, I, W, lane);
#pragma unroll
      for (int i = 0; i < 32; ++i) nxt[i] = jn.src ? jn.src[(size_t)(jn.k0 + 2 * i + (lane >> 5)) * jn.ld] : 0.f;
      if (jn.gk) {
#pragma unroll
        for (int i = 0; i < 32; ++i) nxt[i] *= jn.gk[jn.k0 + 2 * i + (lane >> 5)]; } }
#pragma unroll
    for (int i = 0; i < 32; ++i) scr[(2 * i + (lane >> 5)) * 33 + (lane & 31)] = cur[i];
    asm volatile("s_waitcnt lgkmcnt(0)" ::: "memory");
    { const int c = lane & 7;
#pragma unroll
      for (int j = 0; j < 4; ++j) { const int n = (lane >> 3) + 8 * j; const LAS float* s = scr + (8 * c) * 33 + n;
        u32x4 o; o.x = pk2(s[0 * 33], s[1 * 33]); o.y = pk2(s[2 * 33], s[3 * 33]); o.z = pk2(s[4 * 33], s[5 * 33]); o.w = pk2(s[6 * 33], s[7 * 33]);
        *(u32x4*)(jb.dst + (size_t)(jb.n0 + n) * jb.K + jb.k0 + 8 * c) = o; } }
    asm volatile("s_waitcnt lgkmcnt(0)" ::: "memory");
    if (tn < TOT) {
#pragma unroll
      for (int i = 0; i < 32; ++i) cur[i] = nxt[i]; }
    jb = jn; t = tn; }
}
__device__ __forceinline__ void prologue_pb(const Inputs& I, const WBufs& W) {
  for (long i = blockIdx.x * 512L + otid(); i < (long)NTOK * 256 / 8; i += (long)gridDim.x * 512L) { const f32x4 a = ((const f32x4*)I.p)[2 * i], b = ((const f32x4*)I.p)[2 * i + 1];
    u32x4 o; o.x = pk2(a.x, a.y); o.y = pk2(a.z, a.w); o.z = pk2(b.x, b.y); o.w = pk2(b.z, b.w); ((u32x4*)W.PB)[i] = o; }
}

template <class F> struct Epi8 { static constexpr bool PERM = true; F f;
  __device__ __forceinline__ void operator()(const f32x4 (&acc)[2][2][4][2], const Unit& u, int wr, int wc, int fr, int fq) const {
#pragma unroll
    for (int ai = 0; ai < 2; ++ai)
#pragma unroll
      for (int m = 0; m < 4; ++m) { const int row = u.pm * 256 + ai * 128 + wr * 64 + m * 16 + fr;
#pragma unroll
        for (int bj = 0; bj < 2; ++bj) { const int col = u.pn * 256 + bj * 128 + wc * 32 + 8 * fq; const f32x4 a = acc[ai][bj][m][0], b = acc[ai][bj][m][1];
          const float v[8] = {a.x, a.y, a.z, a.w, b.x, b.y, b.z, b.w}; f(u, row, col, v); }
        if (m & 1) asm volatile("" ::: "memory"); } } };

struct FInProj { u16* QKV; u16* Z; u16* XBC; u16* BG; float* NG; float* DT; const float* dt_bias;
  __device__ __forceinline__ void operator()(const Unit&, int r, int c, const float (&v)[8]) const {
    if (c < C_Z) store8(QKV + (size_t)r * 1280 + c, v);
    else if (c < C_XBC) store8(Z + (size_t)r * 1024 + (c - C_Z), v);
    else if (c < C_BG) store8(XBC + (size_t)r * 1536 + (c - C_XBC), v);
    else if (c < C_NG) { float s[8];
#pragma unroll
      for (int i = 0; i < 8; ++i) s[i] = fsig(v[i]);
      store8(BG + (size_t)r * 2048 + (c - C_BG), s); }
    else if (c < C_DT) { float* o = NG + (size_t)r * 24 + (c - C_NG);
#pragma unroll
      for (int i = 0; i < 8; ++i) o[i] = fsig(v[i]); }
    else if (c < C_END) { float* o = DT + (size_t)r * 16 + (c - C_DT); const float* bi = dt_bias + (c - C_DT);
#pragma unroll
      for (int i = 0; i < 8; ++i) o[i] = fsoftplus(v[i] + bi[i]); } } };
struct FStoreBf { u16* o; int ld; __device__ __forceinline__ void operator()(const Unit&, int r, int c, const float (&v)[8]) const { store8(o + (size_t)r * ld + c, v); } };
struct FMerge { const u16* t1; const u16* bg; u16* o;
  __device__ __forceinline__ void operator()(const Unit&, int r, int c, const float (&v)[8]) const { float t[8], ga[8], gb[8], m[8]; load8(t1 + (size_t)r * 1024 + c, t); load8(bg + (size_t)r * 2048 + c, ga); load8(bg + (size_t)r * 2048 + 1024 + c, gb);
#pragma unroll
    for (int i = 0; i < 8; ++i) m[i] = ga[i] * t[i] + gb[i] * v[i];
    store8(o + (size_t)r * 1024 + c, m); } };
struct FResid { const float* x; u16* o;
  __device__ __forceinline__ void operator()(const Unit&, int r, int c, const float (&v)[8]) const { const f32x4 a = *(const f32x4*)(x + (size_t)r * 1024 + c), b = *(const f32x4*)(x + (size_t)r * 1024 + c + 4);
    const float t[8] = {a.x + v[0], a.y + v[1], a.z + v[2], a.w + v[3], b.x + v[4], b.y + v[5], b.z + v[6], b.w + v[7]}; store8(o + (size_t)r * 1024 + c, t); } };
struct FPle { const u16* x2; float* o; const u16* pp; const float* rs;
  __device__ __forceinline__ void operator()(const Unit&, int r, int c, const float (&v)[8]) const { float p[8], x[8]; load8(pp + (size_t)r * 1024 + c, p); load8(x2 + (size_t)r * 1024 + c, x); float* xp = o + (size_t)r * 1024 + c; const float s = rs[r];
    *(f32x4*)xp = (f32x4){x[0] + fsig(s * v[0]) * p[0], x[1] + fsig(s * v[1]) * p[1], x[2] + fsig(s * v[2]) * p[2], x[3] + fsig(s * v[3]) * p[3]};
    *(f32x4*)(xp + 4) = (f32x4){x[4] + fsig(s * v[4]) * p[4], x[5] + fsig(s * v[5]) * p[5], x[6] + fsig(s * v[6]) * p[6], x[7] + fsig(s * v[7]) * p[7]}; } };

template <class F, bool ALIGN = true> __device__ __forceinline__ void dense_gemm(LAS unsigned char* lds, const u16* A, int lda, const u16* Bt, int ldb, int M, int N, int K, const F& f) {
  pg8::Gemm g{A, Bt, M, N, K, lda, ldb, 128}; pg8::StaticOrder S; S.init(M, N, (int)gridDim.x, (int)blockIdx.x); Epi8<F> E{f};
  pg8::gemm_phase<Epi8<F>, pg8::StaticOrder, ALIGN, false>(lds, g, S, E);
}
}
namespace fx {
constexpr int LIST_CAP = 32768;
constexpr int LDS_TAB = 131072;
struct MoeBufs { float* LOGITS; int* CNT; int* LIST; int* ASG; u16* MOEOUT; u16* WrT; float* SSQ; };
__host__ __device__ inline size_t carve_moe(MoeBufs& M, const Bufs& B, unsigned char* ws, size_t off) {
  auto take = [&](size_t bytes) { unsigned char* r = ws + off; off += (bytes + 255) / 256 * 256; return r; };
  M.LOGITS = (float*)take((size_t)NTOK * 64 * 4); M.CNT = (int*)take(32 * 256); M.LIST = (int*)take((size_t)32 * LIST_CAP * 4); M.WrT = (u16*)take((size_t)256 * 1024 * 2); M.ASG = (int*)take((size_t)NTOK * 2 * 4); M.SSQ = (float*)take((size_t)NTOK * 4);
  M.MOEOUT = B.QKV;
  return off;
}
__device__ __forceinline__ void prologue_moe(const Inputs& I, const MoeBufs& M) {
  for (long i = blockIdx.x * 512L + otid(); i < 256L * 1024; i += (long)gridDim.x * 512L) { const int n = (int)(i >> 10), k = (int)(i & 1023);
    float v = 0.f; if (n < 4) v = I.w_group[k * 4 + n]; else if (n < 36) v = I.w_expert[k * 32 + (n - 4)];
    M.WrT[i] = nv::f2bf(v * I.moe_norm[k]); }
  if (blockIdx.x == 0 && threadIdx.x < 32) M.CNT[threadIdx.x * 64] = 0;
}
struct FLogits { float* o; __device__ __forceinline__ void operator()(const Unit&, int r, int c, const float (&v)[8]) const { if (c < 40) { *(f32x4*)(o + (size_t)r * 64 + c) = (f32x4){v[0], v[1], v[2], v[3]}; *(f32x4*)(o + (size_t)r * 64 + c + 4) = (f32x4){v[4], v[5], v[6], v[7]}; } } };
__device__ __forceinline__ void phase_row_rstd(const u16* x1, float* rsout, int wg0) {
  const int nw = ((int)gridDim.x - wg0) * 8; if ((int)blockIdx.x < wg0 || nw <= 0) return;
  const int tid = otid(), lane = tid & 63, gw = ((int)blockIdx.x - wg0) * 8 + (tid >> 6);
#pragma unroll 1
  for (int r = gw; r < NTOK; r += 4 * nw) { u32x4 w[4][2];
#pragma unroll
    for (int q = 0; q < 4; ++q) { const int rq = (r + q * nw < NTOK) ? r + q * nw : r; const u32x4* xr = (const u32x4*)(x1 + (size_t)rq * 1024) + lane; w[q][0] = xr[0]; w[q][1] = xr[64]; }
#pragma unroll
    for (int q = 0; q < 4; ++q) { float ss = 0.f;
#pragma unroll
      for (int j = 0; j < 2; ++j) { const unsigned e[4] = {w[q][j].x, w[q][j].y, w[q][j].z, w[q][j].w};
#pragma unroll
        for (int i2 = 0; i2 < 4; ++i2) { const float lo = __uint_as_float(e[i2] << 16), hi = __uint_as_float(e[i2] & 0xffff0000u); ss += lo * lo + hi * hi; } }
      ss = wave_sum(ss); if (lane == 0 && r + q * nw < NTOK) rsout[r + q * nw] = 1.0f / sqrtf(ss * (1.f / 1024.f) + nv::EPS); } }
}
__device__ __forceinline__ void phase_route(LAS unsigned char* lds, const Inputs& I, const Bufs& B, const MoeBufs& M) {
  LAS int* lcnt = (LAS int*)lds; LAS int* lbase = lcnt + 32; const int tid = otid();
  for (int blk = blockIdx.x; blk < NTOK / 128; blk += gridDim.x) {
    if (tid < 32) lcnt[tid] = 0;
    __syncthreads();
    int e0 = 0, e1 = 0, r0 = 0, r1 = 0; float w0 = 0.f, w1 = 0.f; const int tok = blk * 128 + tid;
    if (tid < 128) { const float* lg = M.LOGITS + (size_t)tok * 64;
      const float rsd = M.SSQ[tok];
      const f32x4 g4 = *(const f32x4*)lg; const float g0 = rsd * g4.x + I.b_group[0], g1 = rsd * g4.y + I.b_group[1], g2 = rsd * g4.z + I.b_group[2], g3 = rsd * g4.w + I.b_group[3];
      int gi = 0; float gm = g0; if (g1 > gm) { gm = g1; gi = 1; } if (g2 > gm) { gm = g2; gi = 2; } if (g3 > gm) { gm = g3; gi = 3; }
      const float grp_w = 1.0f / (expf(g0 - gm) + expf(g1 - gm) + expf(g2 - gm) + expf(g3 - gm));
      const f32x4 ea = *(const f32x4*)(lg + 4 + gi * 8), eb = *(const f32x4*)(lg + 8 + gi * 8); const f32x4 ba = *(const f32x4*)(I.b_expert + gi * 8), bb = *(const f32x4*)(I.b_expert + gi * 8 + 4);
      const float el[8] = {rsd * ea.x + ba.x, rsd * ea.y + ba.y, rsd * ea.z + ba.z, rsd * ea.w + ba.w, rsd * eb.x + bb.x, rsd * eb.y + bb.y, rsd * eb.z + bb.z, rsd * eb.w + bb.w};
      int i0 = 0; float m0 = el[0];
#pragma unroll
      for (int j = 1; j < 8; ++j) if (el[j] > m0) { m0 = el[j]; i0 = j; }
      int i1 = -1; float m1 = -3.0e38f;
#pragma unroll
      for (int j = 0; j < 8; ++j) if (j != i0 && el[j] > m1) { m1 = el[j]; i1 = j; }
      const float r = expf(m1 - m0); w0 = grp_w / (1.0f + r); w1 = grp_w * r / (1.0f + r);
      e0 = gi * 8 + i0; e1 = gi * 8 + i1;
      r0 = __hip_atomic_fetch_add(lcnt + e0, 1, __ATOMIC_RELAXED, __HIP_MEMORY_SCOPE_WORKGROUP); r1 = __hip_atomic_fetch_add(lcnt + e1, 1, __ATOMIC_RELAXED, __HIP_MEMORY_SCOPE_WORKGROUP); }
    __syncthreads();
    if (tid < 32) { const int n = lcnt[tid]; lbase[tid] = n > 0 ? atomicAdd(&M.CNT[tid * 64], n) : 0; }
    __syncthreads();
    if (tid < 128) { const int p0 = lbase[e0] + r0, p1 = lbase[e1] + r1;
      M.LIST[e0 * LIST_CAP + p0] = tok * 2; M.LIST[e1 * LIST_CAP + p1] = tok * 2 + 1; M.ASG[tok * 2] = (e0 << 16) | p0; M.ASG[tok * 2 + 1] = (e1 << 16) | p1; B.EW[tok * 2] = w0; B.EW[tok * 2 + 1] = w1; }
    __syncthreads(); }
}
__device__ __forceinline__ void build_tile_table(LAS unsigned char* lds, const MoeBufs& M) {
  LAS int* tab = (LAS int*)(lds + LDS_TAB);
  if (threadIdx.x == 0) { int acc = 0; for (int e = 0; e < 32; ++e) { tab[e] = acc; acc += (M.CNT[e * 64] + 255) >> 8; } tab[32] = acc; }
  __syncthreads();
}
__device__ __forceinline__ int tile_expert(const LAS int* tab, int tile) { int e = 0;
#pragma unroll 1
  for (int j = 1; j < 32; ++j) if (tab[j] <= tile) e = j;
  return e; }

struct SchedGU { const int* list; int tile, ct, lbase, nvalid, e;
  __device__ bool next(int i, Unit& u) const { if (i > 0) return false; u.pm = tile; u.pn = ct; u.aux0 = lbase; u.aux1 = nvalid; return true; }
  __device__ __forceinline__ const char* a_base(const pg8::Gemm& g, const Unit&) const { return (const char*)g.A; }
  __device__ __forceinline__ const char* b_base(const pg8::Gemm& g, const Unit&) const { return (const char*)g.Bt + ((size_t)e * 512 + (size_t)ct * 256) * 1024 * 2; }
  __device__ __forceinline__ int a_row(const Unit&, int r) const { return r < nvalid ? (list[lbase + r] >> 1) : 0; } };
struct EpiGU { static constexpr bool PERM = true; u16* act; const int* list; const float* ssq;
  __device__ __forceinline__ void operator()(const f32x4 (&acc)[2][2][4][2], const Unit& u, int wr, int wc, int fr, int fq) const {
#pragma unroll
    for (int ai = 0; ai < 2; ++ai)
#pragma unroll
      for (int m = 0; m < 4; ++m) { const int r = ai * 128 + wr * 64 + m * 16 + fr; const float rs = r < u.aux1 ? ssq[list[u.aux0 + r] >> 1] : 0.f;
        const f32x4 g0 = acc[ai][0][m][0] * rs, g1 = acc[ai][0][m][1] * rs, u0 = acc[ai][1][m][0] * rs, u1 = acc[ai][1][m][1] * rs;
        const float a[8] = {g0.x * fsig(g0.x) * u0.x, g0.y * fsig(g0.y) * u0.y, g0.z * fsig(g0.z) * u0.z, g0.w * fsig(g0.w) * u0.w, g1.x * fsig(g1.x) * u1.x, g1.y * fsig(g1.y) * u1.y, g1.z * fsig(g1.z) * u1.z, g1.w * fsig(g1.w) * u1.w};
        store8(act + ((size_t)u.pm * 256 + r) * 256 + u.pn * 128 + wc * 32 + 8 * fq, a);
        if (m & 1) asm volatile("" ::: "memory"); } } };
__device__ __forceinline__ void phase_moe_gu(LAS unsigned char* lds, const Bufs& B, const WBufs& W, const MoeBufs& M, const u16* x1) {
  const LAS int* tab = (const LAS int*)(lds + LDS_TAB); const int T = tab[32];
  for (int L = blockIdx.x; L < T * 2; L += gridDim.x) { const int tile = L >> 1, ct = L & 1, e = __builtin_amdgcn_readfirstlane(tile_expert(tab, tile)), rt = tile - __builtin_amdgcn_readfirstlane(tab[e]); int nvalid = __builtin_amdgcn_readfirstlane(M.CNT[e * 64]) - rt * 256; nvalid = nvalid > 256 ? 256 : nvalid;
    pg8::Gemm g{x1, W.WguT, 256, 256, 1024, 1024, 1024, 128}; SchedGU S{M.LIST, tile, ct, e * LIST_CAP + rt * 256, nvalid, e}; EpiGU E{B.ACT, M.LIST, M.SSQ};
    pg8::gemm_phase<EpiGU, SchedGU, true, true>(lds, g, S, E); }
  { const int G = (int)gridDim.x, r = (T * 2) % G;
    if ((int)blockIdx.x >= r) { pg8::Gemm g{W.PB, W.PlePT, NTOK, 1024, 256, 256, 256, 128}; pg8::StaticOrder S; S.init(NTOK, 1024, G - r, (int)blockIdx.x - r); Epi8<FStoreBf> E{FStoreBf{B.PP, 1024}};
      pg8::gemm_phase<Epi8<FStoreBf>, pg8::StaticOrder, true, false>(lds, g, S, E); } }
}
struct SchedD { const LAS int* tab; int T4, G, c;
  __device__ bool next(int i, Unit& u) const { const int L = i * G + c; if (L >= T4) return false; const int tile = L >> 2; u.pm = tile; u.pn = L & 3; u.aux0 = __builtin_amdgcn_readfirstlane(tile_expert(tab, tile)); u.aux1 = 0; return true; }
  __device__ __forceinline__ const char* a_base(const pg8::Gemm& g, const Unit& u) const { return (const char*)g.A + (size_t)u.pm * 256 * 256 * 2; }
  __device__ __forceinline__ const char* b_base(const pg8::Gemm& g, const Unit& u) const { return (const char*)g.Bt + ((size_t)u.aux0 * 1024 + (size_t)u.pn * 256) * 256 * 2; }
  __device__ __forceinline__ int a_row(const Unit&, int) const { return 0; } };
__device__ __forceinline__ void phase_moe_down(LAS unsigned char* lds, const Bufs& B, const WBufs& W, const MoeBufs& M) {
  const LAS int* tab = (const LAS int*)(lds + LDS_TAB);
  pg8::Gemm g{B.ACT, W.WdT, 256, 1024, 256, 256, 256, 128}; SchedD S{tab, tab[32] * 4, (int)gridDim.x, (int)blockIdx.x}; Epi8<FStoreBf> E{FStoreBf{M.MOEOUT, 1024}};
  pg8::gemm_phase<Epi8<FStoreBf>, SchedD, true, false>(lds, g, S, E);
}
__device__ __forceinline__ void phase_moe_combine(LAS unsigned char* lds, const u16* x1, u16* x2, const MoeBufs& M, const float* ew, float* rsout) {
  const LAS int* tab = (const LAS int*)(lds + LDS_TAB);
  const int tid = otid(), lane = tid & 63, gw = obid() * 8 + (tid >> 6), ngw = gridDim.x * 8;
  for (int tk = gw; tk < NTOK; tk += 2 * ngw) { float v[2][2][8]; float rs[2];
    u32x4 xw[2][2], a[2][2], b[2][2]; float w0[2], w1[2];
#pragma unroll
    for (int q = 0; q < 2; ++q) { const int tok = (tk + q * ngw < NTOK) ? tk + q * ngw : tk; const int a0 = M.ASG[tok * 2], a1 = M.ASG[tok * 2 + 1]; w0[q] = ew[tok * 2]; w1[q] = ew[tok * 2 + 1];
      const int s0 = (tab[a0 >> 16] + ((a0 & 0xffff) >> 8)) * 256 + (a0 & 255), s1 = (tab[a1 >> 16] + ((a1 & 0xffff) >> 8)) * 256 + (a1 & 255);
      const u32x4* xr = (const u32x4*)(x1 + (size_t)tok * 1024) + lane; const u32x4* o0 = (const u32x4*)(M.MOEOUT + (size_t)s0 * 1024) + lane; const u32x4* o1 = (const u32x4*)(M.MOEOUT + (size_t)s1 * 1024) + lane;
#pragma unroll
      for (int j = 0; j < 2; ++j) { xw[q][j] = xr[64 * j]; a[q][j] = o0[64 * j]; b[q][j] = o1[64 * j]; } }
#pragma unroll
    for (int q = 0; q < 2; ++q) { float s = 0.f;
#pragma unroll
      for (int j = 0; j < 2; ++j) { const unsigned xe[4] = {xw[q][j].x, xw[q][j].y, xw[q][j].z, xw[q][j].w}, ae[4] = {a[q][j].x, a[q][j].y, a[q][j].z, a[q][j].w}, be[4] = {b[q][j].x, b[q][j].y, b[q][j].z, b[q][j].w};
#pragma unroll
        for (int i = 0; i < 4; ++i) { const float lo = __uint_as_float(xe[i] << 16) + (w0[q] * __uint_as_float(ae[i] << 16) + w1[q] * __uint_as_float(be[i] << 16));
          const float hi = __uint_as_float(xe[i] & 0xffff0000u) + (w0[q] * __uint_as_float(ae[i] & 0xffff0000u) + w1[q] * __uint_as_float(be[i] & 0xffff0000u));
          v[q][j][2 * i] = lo; v[q][j][2 * i + 1] = hi; s += lo * lo + hi * hi; } }
      rs[q] = 1.0f / sqrtf(wave_sum(s) * (1.f / 1024.f) + nv::EPS); }
#pragma unroll
    for (int q = 0; q < 2; ++q) { if (tk + q * ngw >= NTOK) break; const int tok = tk + q * ngw; u32x4* xo = (u32x4*)(x2 + (size_t)tok * 1024) + lane;
      if (lane == 0) rsout[tok] = rs[q];
#pragma unroll
      for (int j = 0; j < 2; ++j) { const float (&x)[8] = v[q][j]; u32x4 ox; ox.x = pk2(x[0], x[1]); ox.y = pk2(x[2], x[3]); ox.z = pk2(x[4], x[5]); ox.w = pk2(x[6], x[7]); xo[64 * j] = ox; } } }
}
}
namespace fa {
using nv::u16; using nv::Bufs;
typedef short bf16x8 __attribute__((ext_vector_type(8)));
typedef short s16x4 __attribute__((ext_vector_type(4)));
typedef float f32x16 __attribute__((ext_vector_type(16)));
typedef unsigned u32x4 __attribute__((ext_vector_type(4)));
constexpr float C2 = 0.125f * 1.4426950408889634f;
constexpr int S = nv::S, QKVW = 1280;
constexpr int IMP_LD = 65, IMP_HEAD = 64 * IMP_LD;
constexpr int L_K = 0, L_V = 32768, L_WSF = 65536, L_IMP = 67584, L_MASK = L_IMP + 4 * IMP_HEAD * 4 + 64  , L_OST = L_IMP  , L_END = L_MASK + 512;
static_assert(L_END <= 147456, "attention LDS map");

__device__ __forceinline__ int crow(int r, int hi) { return (r & 3) + 8 * (r >> 2) + 4 * hi; }
__device__ __forceinline__ float ex2(float x) { return __builtin_amdgcn_exp2f(x); }
__device__ __forceinline__ float max3f(float a, float b, float c) { float r; asm("v_max3_f32 %0, %1, %2, %3" : "=v"(r) : "v"(a), "v"(b), "v"(c)); return r; }
__device__ __forceinline__ float max2f(float a, float b) { float r; asm("v_max_f32_e32 %0, %1, %2" : "=v"(r) : "v"(a), "v"(b)); return r; }
__device__ __forceinline__ float swap_add(float v) { auto rr = __builtin_amdgcn_permlane32_swap(__float_as_uint(v), __float_as_uint(v), false, false); return __uint_as_float(rr[0]) + __uint_as_float(rr[1]); }
__device__ __forceinline__ float swap_max(float v) { auto rr = __builtin_amdgcn_permlane32_swap(__float_as_uint(v), __float_as_uint(v), false, false); return __builtin_fmaxf(__uint_as_float(rr[0]), __uint_as_float(rr[1])); }

__device__ __forceinline__ void phase_qknorm(const nv::Inputs& I, const Bufs& B) {
  const int nwg = (int)gridDim.x > 64 ? (int)gridDim.x - 64 : (int)gridDim.x;
  if ((int)blockIdx.x >= nwg) return;
  for (int it = blockIdx.x * 512 + fx::otid(); it < nv::NTOK * 4; it += nwg * 512) { const int tok = it >> 2, w = it & 3; u16* v; const float* gain;
    if (w < 2) { v = B.QKV + (size_t)tok * QKVW + nv::O_KS + w * 64; gain = I.ks_gain; } else { v = B.QKV + (size_t)tok * QKVW + nv::O_KW + (w - 2) * 64; gain = I.kw_gain; }
    float x[8][8]; float s = 0.f;
#pragma unroll
    for (int c = 0; c < 8; ++c) { fx::load8(v + c * 8, x[c]);
#pragma unroll
      for (int j = 0; j < 8; ++j) s += x[c][j] * x[c][j]; }
    const float rs = 1.0f / sqrtf(s * (1.f / 64.f) + nv::EPS);
#pragma unroll
    for (int c = 0; c < 8; ++c) { float y[8];
#pragma unroll
      for (int j = 0; j < 8; ++j) y[j] = x[c][j] * rs * gain[c * 8 + j];
      fx::store8(v + c * 8, y); } }
}

__device__ __forceinline__ void stage_kv(LAS unsigned char* lds, int slot, const u16* kbase, const u16* vbase, int stride, int wid, int lane, bool withV) {
  { const int row = 8 * wid + (lane >> 3), ch = lane & 7; const u16* ksrc = kbase + (size_t)row * stride + ((ch ^ (row & 7)) * 8);
    __builtin_amdgcn_global_load_lds((const unsigned*)ksrc, (LAS unsigned*)(lds + L_K + slot * 8192 + wid * 1024), 16, 0, 0); }
  if (withV) { const u16* vsrc = vbase + (size_t)(16 * (wid & 3) + (lane >> 2)) * stride + (wid >> 2) * 32 + (lane & 3) * 8;
    __builtin_amdgcn_global_load_lds((const unsigned*)vsrc, (LAS unsigned*)(lds + L_V + slot * 8192 + wid * 1024), 16, 0, 0); }
}
__device__ __forceinline__ void qkt(f32x16& p0, f32x16& p1, const LAS unsigned char* Kslot, const bf16x8 (&qr)[4], int r32, int hi, float bias = 0.f) {
  const LAS unsigned char* kb = Kslot + r32 * 128; const int sw = r32 & 7;
  bf16x8 kf[8];
#pragma unroll
  for (int d0 = 0; d0 < 4; ++d0) { const int o = ((2 * d0 + hi) ^ sw) << 4; kf[2 * d0] = *(const LAS bf16x8*)(kb + o); kf[2 * d0 + 1] = *(const LAS bf16x8*)(kb + 4096 + o); }
  f32x16 z;
#pragma unroll
  for (int r = 0; r < 16; ++r) z[r] = bias;
  asm volatile("s_waitcnt lgkmcnt(0)" ::: "memory"); __builtin_amdgcn_sched_barrier(0);
  p0 = __builtin_amdgcn_mfma_f32_32x32x16_bf16(kf[0], qr[0], z, 0, 0, 0); p1 = __builtin_amdgcn_mfma_f32_32x32x16_bf16(kf[1], qr[0], z, 0, 0, 0);
#pragma unroll
  for (int d0 = 1; d0 < 4; ++d0) { p0 = __builtin_amdgcn_mfma_f32_32x32x16_bf16(kf[2 * d0], qr[d0], p0, 0, 0, 0); p1 = __builtin_amdgcn_mfma_f32_32x32x16_bf16(kf[2 * d0 + 1], qr[d0], p1, 0, 0, 0); }
}
__device__ __forceinline__ void pv(f32x16 (&o)[2], int vb, bf16x8 pa0, bf16x8 pa1, bf16x8 pa2, bf16x8 pa3) {
#define FA_PK(k) (bf16x8){lo[k][0], lo[k][1], lo[k][2], lo[k][3], hi[k][0], hi[k][1], hi[k][2], hi[k][3]}
  s16x4 lo[8], hi[8];
#pragma unroll
  for (int d0 = 0; d0 < 2; ++d0)
#pragma unroll
    for (int ks = 0; ks < 4; ++ks) {
      asm volatile("ds_read_b64_tr_b16 %0,%1 offset:%c2" : "=&v"(lo[d0 * 4 + ks]) : "v"(vb), "i"(d0 * 4096 + ks * 1024) : "memory");
      asm volatile("ds_read_b64_tr_b16 %0,%1 offset:%c2" : "=&v"(hi[d0 * 4 + ks]) : "v"(vb), "i"(d0 * 4096 + ks * 1024 + 512) : "memory"); }
  asm volatile("s_waitcnt lgkmcnt(0)" ::: "memory"); __builtin_amdgcn_sched_barrier(0);
  o[0] = __builtin_amdgcn_mfma_f32_32x32x16_bf16(pa0, FA_PK(0), o[0], 0, 0, 0); o[1] = __builtin_amdgcn_mfma_f32_32x32x16_bf16(pa0, FA_PK(4), o[1], 0, 0, 0);
  o[0] = __builtin_amdgcn_mfma_f32_32x32x16_bf16(pa1, FA_PK(1), o[0], 0, 0, 0); o[1] = __builtin_amdgcn_mfma_f32_32x32x16_bf16(pa1, FA_PK(5), o[1], 0, 0, 0);
  o[0] = __builtin_amdgcn_mfma_f32_32x32x16_bf16(pa2, FA_PK(2), o[0], 0, 0, 0); o[1] = __builtin_amdgcn_mfma_f32_32x32x16_bf16(pa2, FA_PK(6), o[1], 0, 0, 0);
  o[0] = __builtin_amdgcn_mfma_f32_32x32x16_bf16(pa3, FA_PK(3), o[0], 0, 0, 0); o[1] = __builtin_amdgcn_mfma_f32_32x32x16_bf16(pa3, FA_PK(7), o[1], 0, 0, 0);
#undef FA_PK
}
struct SmState { float m, l; f32x16 o[2]; };
#ifdef PROBE_STAMPS
struct Prof { unsigned long long t, a[8]; };
#define FA_PROF_DECL Prof prof; prof.t = __builtin_amdgcn_s_memrealtime(); for (int k_ = 0; k_ < 8; ++k_) prof.a[k_] = 0;
#define FA_PROF(k) do { __builtin_amdgcn_sched_barrier(0); const unsigned long long n_ = __builtin_amdgcn_s_memrealtime(); prof.a[k] += n_ - prof.t; prof.t = n_; __builtin_amdgcn_sched_barrier(0); } while (0)
#define FA_PROF_ARG , Prof& prof
#define FA_PROF_PASS , prof
#else
#define FA_PROF_DECL
#define FA_PROF(k) do {} while (0)
#define FA_PROF_ARG
#define FA_PROF_PASS
#endif
__device__ __forceinline__ void sm_reset(SmState& st) { st.m = 0.f; st.l = 0.f;
#pragma unroll
  for (int r = 0; r < 16; ++r) { st.o[0][r] = 0.f; st.o[1][r] = 0.f; } }
__device__ __forceinline__ void mask_range(f32x16& p0, f32x16& p1, int klo, int khi, int hi) {
  if (__all(klo <= 0 && khi >= 63)) return;
#pragma unroll
  for (int r = 0; r < 16; ++r) { const int k0 = crow(r, hi), k1 = k0 + 32; if (k0 < klo || k0 > khi) p0[r] = -INFINITY; if (k1 < klo || k1 > khi) p1[r] = -INFINITY; }
}
__device__ __forceinline__ void sm_pv(SmState& st, f32x16& p0, f32x16& p1, LAS unsigned char* lds, int slot, const bf16x8 (&qr)[4], LAS float* wsf, int r32, int hi, int vb0, int klo, int khi, float bias FA_PROF_ARG) {
  mask_range(p0, p1, klo, khi, hi);
  float rs = 0.f;
#pragma unroll
  for (int r = 0; r < 16; ++r) { p0[r] = ex2(p0[r]); p1[r] = ex2(p1[r]); rs += p0[r] + p1[r]; }
  if (__builtin_expect(__any(!(rs < 1.0e30f)), 0)) {
    qkt(p0, p1, lds + L_K + slot * 8192, qr, r32, hi, bias - st.m); mask_range(p0, p1, klo, khi, hi);
    float rm = max2f(p0[0], p1[0]);
#pragma unroll
    for (int r = 1; r < 16; ++r) rm = max3f(rm, p0[r], p1[r]);
    rm = swap_max(rm); const float d = rm > 24.f ? rm : 0.f; const float f = ex2(-d); st.m += d; st.l *= f;
    if (hi == 0) wsf[r32] = f;
    rs = 0.f;
#pragma unroll
    for (int r = 0; r < 16; ++r) { p0[r] = ex2(p0[r] - d); p1[r] = ex2(p1[r] - d); rs += p0[r] + p1[r]; const float fr = wsf[crow(r, hi)]; st.o[0][r] *= fr; st.o[1][r] *= fr; } }
  st.l += rs;
  u32x4 w0, w1, w2, w3;
  w0.x = pg8::cvt_pk_bf16(p0[0], p0[1]); w0.y = pg8::cvt_pk_bf16(p0[2], p0[3]); w0.z = pg8::cvt_pk_bf16(p0[4], p0[5]); w0.w = pg8::cvt_pk_bf16(p0[6], p0[7]);
  w1.x = pg8::cvt_pk_bf16(p0[8], p0[9]); w1.y = pg8::cvt_pk_bf16(p0[10], p0[11]); w1.z = pg8::cvt_pk_bf16(p0[12], p0[13]); w1.w = pg8::cvt_pk_bf16(p0[14], p0[15]);
  w2.x = pg8::cvt_pk_bf16(p1[0], p1[1]); w2.y = pg8::cvt_pk_bf16(p1[2], p1[3]); w2.z = pg8::cvt_pk_bf16(p1[4], p1[5]); w2.w = pg8::cvt_pk_bf16(p1[6], p1[7]);
  w3.x = pg8::cvt_pk_bf16(p1[8], p1[9]); w3.y = pg8::cvt_pk_bf16(p1[10], p1[11]); w3.z = pg8::cvt_pk_bf16(p1[12], p1[13]); w3.w = pg8::cvt_pk_bf16(p1[14], p1[15]);
  asm volatile("" : "+v"(w0), "+v"(w1), "+v"(w2), "+v"(w3)); FA_PROF(2);
  pv(st.o, vb0 + L_V + slot * 8192, __builtin_bit_cast(bf16x8, w0), __builtin_bit_cast(bf16x8, w1), __builtin_bit_cast(bf16x8, w2), __builtin_bit_cast(bf16x8, w3));
  asm volatile("" : "+v"(st.o[0]), "+v"(st.o[1])); FA_PROF(3);
}
__device__ __forceinline__ void tile_step(SmState& st, LAS unsigned char* lds, int slot, const bf16x8 (&qr)[4], LAS float* wsf, int r32, int hi, int vb0, int klo, int khi, float bias FA_PROF_ARG) {
  FA_PROF(0);
  f32x16 p0, p1; qkt(p0, p1, lds + L_K + slot * 8192, qr, r32, hi, bias - st.m);
  asm volatile("" : "+v"(p0), "+v"(p1)); FA_PROF(1);
  sm_pv(st, p0, p1, lds, slot, qr, wsf, r32, hi, vb0, klo, khi, bias FA_PROF_PASS);
}
#define FA_SGB4 _Pragma("unroll") for (int k_ = 0; k_ < 4; ++k_) { __builtin_amdgcn_sched_group_barrier(0x8, 1, 0); __builtin_amdgcn_sched_group_barrier(0x400, 4, 0); __builtin_amdgcn_sched_group_barrier(0x2, 7, 0); }
template <bool SEL> __device__ __forceinline__ void fast_step(SmState& st, LAS unsigned char* lds, int slot, const bf16x8 (&qr)[4], int r32, int hi, int vb0, unsigned selm) {
  const LAS unsigned char* kb = lds + L_K + slot * 8192 + r32 * 128; const int sw = r32 & 7;
  bf16x8 kf[8];
#pragma unroll
  for (int d0 = 0; d0 < 4; ++d0) { const int o = ((2 * d0 + hi) ^ sw) << 4; kf[2 * d0] = *(const LAS bf16x8*)(kb + o); kf[2 * d0 + 1] = *(const LAS bf16x8*)(kb + 4096 + o); }
  const int vb = vb0 + L_V + slot * 8192;
  s16x4 vl[4], vh[4];
#pragma unroll
  for (int d0 = 0; d0 < 2; ++d0)
#pragma unroll
    for (int ks = 0; ks < 2; ++ks) {
      asm volatile("ds_read_b64_tr_b16 %0,%1 offset:%c2" : "=&v"(vl[d0 * 2 + ks]) : "v"(vb), "i"(d0 * 4096 + ks * 1024) : "memory");
      asm volatile("ds_read_b64_tr_b16 %0,%1 offset:%c2" : "=&v"(vh[d0 * 2 + ks]) : "v"(vb), "i"(d0 * 4096 + ks * 1024 + 512) : "memory"); }
  const f32x16 z = {0.f, 0.f, 0.f, 0.f, 0.f, 0.f, 0.f, 0.f, 0.f, 0.f, 0.f, 0.f, 0.f, 0.f, 0.f, 0.f};
  asm volatile("s_waitcnt lgkmcnt(0)" ::: "memory"); __builtin_amdgcn_sched_barrier(0);
  f32x16 p0 = __builtin_amdgcn_mfma_f32_32x32x16_bf16(kf[0], qr[0], z, 0, 0, 0);
#pragma unroll
  for (int d0 = 1; d0 < 4; ++d0) p0 = __builtin_amdgcn_mfma_f32_32x32x16_bf16(kf[2 * d0], qr[d0], p0, 0, 0, 0);
  __builtin_amdgcn_sched_barrier(0);
  f32x16 p1 = __builtin_amdgcn_mfma_f32_32x32x16_bf16(kf[1], qr[0], z, 0, 0, 0);
#pragma unroll
  for (int d0 = 1; d0 < 4; ++d0) p1 = __builtin_amdgcn_mfma_f32_32x32x16_bf16(kf[2 * d0 + 1], qr[d0], p1, 0, 0, 0);
  float rs = 0.f;
#pragma unroll
  for (int r = 0; r < 16; ++r) { p0[r] = ex2(p0[r]); rs += p0[r]; }
  u32x4 w0, w1, w2, w3;
  w0.x = pg8::cvt_pk_bf16(p0[0], p0[1]); w0.y = pg8::cvt_pk_bf16(p0[2], p0[3]); w0.z = pg8::cvt_pk_bf16(p0[4], p0[5]); w0.w = pg8::cvt_pk_bf16(p0[6], p0[7]);
  w1.x = pg8::cvt_pk_bf16(p0[8], p0[9]); w1.y = pg8::cvt_pk_bf16(p0[10], p0[11]); w1.z = pg8::cvt_pk_bf16(p0[12], p0[13]); w1.w = pg8::cvt_pk_bf16(p0[14], p0[15]);
  if (SEL) { w0.x &= selm; w0.y &= selm; w0.z &= selm; w0.w &= selm; w1.x &= selm; w1.y &= selm; w1.z &= selm; w1.w &= selm; }
  FA_SGB4
  __builtin_amdgcn_sched_barrier(0);
  s16x4 ul[4], uh[4];
#pragma unroll
  for (int d0 = 0; d0 < 2; ++d0)
#pragma unroll
    for (int ks = 0; ks < 2; ++ks) {
      asm volatile("ds_read_b64_tr_b16 %0,%1 offset:%c2" : "=&v"(ul[d0 * 2 + ks]) : "v"(vb), "i"(d0 * 4096 + (2 + ks) * 1024) : "memory");
      asm volatile("ds_read_b64_tr_b16 %0,%1 offset:%c2" : "=&v"(uh[d0 * 2 + ks]) : "v"(vb), "i"(d0 * 4096 + (2 + ks) * 1024 + 512) : "memory"); }
#define FA_PKV(l_, h_, k) (bf16x8){l_[k][0], l_[k][1], l_[k][2], l_[k][3], h_[k][0], h_[k][1], h_[k][2], h_[k][3]}
  { const bf16x8 pa0 = __builtin_bit_cast(bf16x8, w0), pa1 = __builtin_bit_cast(bf16x8, w1);
    st.o[0] = __builtin_amdgcn_mfma_f32_32x32x16_bf16(pa0, FA_PKV(vl, vh, 0), st.o[0], 0, 0, 0); st.o[1] = __builtin_amdgcn_mfma_f32_32x32x16_bf16(pa0, FA_PKV(vl, vh, 2), st.o[1], 0, 0, 0);
    st.o[0] = __builtin_amdgcn_mfma_f32_32x32x16_bf16(pa1, FA_PKV(vl, vh, 1), st.o[0], 0, 0, 0); st.o[1] = __builtin_amdgcn_mfma_f32_32x32x16_bf16(pa1, FA_PKV(vl, vh, 3), st.o[1], 0, 0, 0); }
#pragma unroll
  for (int r = 0; r < 16; ++r) { p1[r] = ex2(p1[r]); rs += p1[r]; }
  w2.x = pg8::cvt_pk_bf16(p1[0], p1[1]); w2.y = pg8::cvt_pk_bf16(p1[2], p1[3]); w2.z = pg8::cvt_pk_bf16(p1[4], p1[5]); w2.w = pg8::cvt_pk_bf16(p1[6], p1[7]);
  w3.x = pg8::cvt_pk_bf16(p1[8], p1[9]); w3.y = pg8::cvt_pk_bf16(p1[10], p1[11]); w3.z = pg8::cvt_pk_bf16(p1[12], p1[13]); w3.w = pg8::cvt_pk_bf16(p1[14], p1[15]);
  if (SEL) { w2.x &= selm; w2.y &= selm; w2.z &= selm; w2.w &= selm; w3.x &= selm; w3.y &= selm; w3.z &= selm; w3.w &= selm; rs = __uint_as_float(__float_as_uint(rs) & selm); }
  FA_SGB4
  __builtin_amdgcn_sched_barrier(0);
  asm volatile("s_waitcnt lgkmcnt(0)" ::: "memory"); __builtin_amdgcn_sched_barrier(0);
  { const bf16x8 pa2 = __builtin_bit_cast(bf16x8, w2), pa3 = __builtin_bit_cast(bf16x8, w3);
    st.o[0] = __builtin_amdgcn_mfma_f32_32x32x16_bf16(pa2, FA_PKV(ul, uh, 0), st.o[0], 0, 0, 0); st.o[1] = __builtin_amdgcn_mfma_f32_32x32x16_bf16(pa2, FA_PKV(ul, uh, 2), st.o[1], 0, 0, 0);
    st.o[0] = __builtin_amdgcn_mfma_f32_32x32x16_bf16(pa3, FA_PKV(ul, uh, 1), st.o[0], 0, 0, 0); st.o[1] = __builtin_amdgcn_mfma_f32_32x32x16_bf16(pa3, FA_PKV(ul, uh, 3), st.o[1], 0, 0, 0); }
#undef FA_PKV
  st.l += rs;
  asm volatile("" : "+v"(st.o[0]), "+v"(st.o[1]));
}
template <int MODE> __device__ __forceinline__ void finalize(SmState& st, float gate, f32x16 (&outacc)[2], LAS float* slab, LAS float* wsf, int r32, int hi, int lane, float& msafe, float& invl) {
  const float lt = swap_add(st.l); invl = lt > 0.f ? 1.0f / lt : 0.f; msafe = st.m;
  if (hi == 0) wsf[r32] = gate * invl;
#pragma unroll
  for (int r = 0; r < 16; ++r) { const float fr = wsf[crow(r, hi)];
    if (MODE == 0) { outacc[0][r] = st.o[0][r] * fr; outacc[1][r] = st.o[1][r] * fr; }
    else if (MODE == 1) { slab[r * 64 + lane] += st.o[0][r] * fr; slab[(16 + r) * 64 + lane] += st.o[1][r] * fr; }
    else { outacc[0][r] = slab[r * 64 + lane] + st.o[0][r] * fr; outacc[1][r] = slab[(16 + r) * 64 + lane] + st.o[1][r] * fr; } }
}
__device__ __forceinline__ void imp_step(LAS unsigned char* lds, int slot, const bf16x8 (&qr)[4], int r32, int hi, int khi, float msafe, float invl, LAS float* imph  , int tq, int T) {
  f32x16 p0, p1; qkt(p0, p1, lds + L_K + slot * 8192, qr, r32, hi);
  mask_range(p0, p1, 0, khi, hi);
#pragma unroll
  for (int r = 0; r < 16; ++r) { p0[r] = ex2(p0[r] - msafe) * invl; p1[r] = ex2(p1[r] - msafe) * invl; }
  LAS float* row = imph + tq * IMP_LD + 16 * T + hi;
#pragma unroll
  for (int gq = 0; gq < 4; ++gq) { row[2 * gq] += (p0[4 * gq] + p0[4 * gq + 1]) + (p0[4 * gq + 2] + p0[4 * gq + 3]); row[2 * gq + 8] += (p1[4 * gq] + p1[4 * gq + 1]) + (p1[4 * gq + 2] + p1[4 * gq + 3]); }
  asm volatile("s_waitcnt lgkmcnt(0)" ::: "memory");
#pragma unroll
  for (int gq = 0; gq < 4; ++gq) { row[2 * gq + 1] += p0[4 * gq + 3]; if (16 * T + hi + 2 * gq + 9 < 64) row[2 * gq + 9] += p1[4 * gq + 3]; }
  asm volatile("s_waitcnt lgkmcnt(0)" ::: "memory");
}
__device__ __forceinline__ void topk_select(LAS unsigned char* lds, LAS float* rows, int wid, int lane, int i) {
  LAS float* IM = (LAS float*)(lds + L_IMP); LAS unsigned long long* MK = (LAS unsigned long long*)(lds + L_MASK);
  const int j = lane; const int nforced = i == 0 ? 1 : (i == 1 ? 2 : 3);
  const bool forced = (j <= i) && (j == 0 || j == i || j == i - 1); const bool cand = (j >= 1) && (j <= i - 2);
  float v8[8]; int cnt[8];
#pragma unroll
  for (int q = 0; q < 8; ++q) { const int tq = wid + 8 * q;
    v8[q] = (IM[tq * IMP_LD + j] + IM[IMP_HEAD + tq * IMP_LD + j]) + (IM[2 * IMP_HEAD + tq * IMP_LD + j] + IM[3 * IMP_HEAD + tq * IMP_LD + j]);
    rows[q * 64 + lane] = cand ? v8[q] : -INFINITY; cnt[q] = 0; }
#pragma unroll 1
  for (int jj = 0; jj <= i - 2; jj += 4) {
#pragma unroll
    for (int q = 0; q < 8; ++q) { const pg8::f32x4 c = *(const LAS pg8::f32x4*)(rows + q * 64 + jj); cnt[q] += ((c.x > v8[q] ? 1 : 0) + (c.y > v8[q] ? 1 : 0)) + ((c.z > v8[q] ? 1 : 0) + (c.w > v8[q] ? 1 : 0)); } }
  const int ncand = i >= 3 ? i - 2 : 0, want = nforced + (ncand < 16 - nforced ? ncand : 16 - nforced);
#pragma unroll
  for (int q = 0; q < 8; ++q) { const float v = v8[q];
    bool sel = forced || (cand && cnt[q] < 16 - nforced);
    unsigned long long mk = __ballot(sel);
    if (__builtin_expect(__builtin_popcountll(mk) != want, 0)) { int c2 = 0;
#pragma unroll 1
      for (int jj = 1; jj <= i - 2; ++jj) { const float vv = __uint_as_float(__builtin_amdgcn_readlane(__float_as_uint(v), jj)); c2 += (vv > v || (vv == v && jj < j)) ? 1 : 0; }
      sel = forced || (cand && c2 < 16 - nforced); mk = __ballot(sel); }
    if (lane == 0) MK[wid + 8 * q] = mk; }
}
__device__ __forceinline__ void attn_unit(LAS unsigned char* lds, const nv::Inputs& I, const Bufs& B, int b, int g, int i) {
  const int tid = fx::otid(), lane = tid & 63, wid = __builtin_amdgcn_readfirstlane(tid >> 6), r32 = lane & 31, hi = lane >> 5;
  const int e = wid >> 1, h = g * 4 + e, tq = 32 * (wid & 1) + r32; const size_t tok = (size_t)b * S + 64 * i + tq; const int t = 64 * i + tq;
  LAS float* wsf = (LAS float*)(lds + L_WSF) + wid * 64;
  LAS float* imph = (LAS float*)(lds + L_IMP) + e * IMP_HEAD;
  const int vb0 = (int)(unsigned)(size_t)lds + ((lane >> 4) & 1) * 32 + (lane & 3) * 8 + (4 * hi + ((lane & 15) >> 2)) * 64;
  bf16x8 qr[4]; float qn2;
  {
    float qv[4][8]; float ss = 0.f; qn2 = 0.f;
#pragma unroll
    for (int d0 = 0; d0 < 4; ++d0) { fx::load8(B.QKV + tok * QKVW + h * 64 + d0 * 16 + hi * 8, qv[d0]);
#pragma unroll
      for (int j = 0; j < 8; ++j) ss += qv[d0][j] * qv[d0][j]; }
    ss = swap_add(ss); const float rs = C2 / sqrtf(ss * (1.f / 64.f) + nv::EPS);
#pragma unroll
    for (int d0 = 0; d0 < 4; ++d0) { u32x4 w; const float* gq = I.q_gain + d0 * 16 + hi * 8;
      w.x = pg8::cvt_pk_bf16(qv[d0][0] * rs * gq[0], qv[d0][1] * rs * gq[1]); w.y = pg8::cvt_pk_bf16(qv[d0][2] * rs * gq[2], qv[d0][3] * rs * gq[3]);
      w.z = pg8::cvt_pk_bf16(qv[d0][4] * rs * gq[4], qv[d0][5] * rs * gq[5]); w.w = pg8::cvt_pk_bf16(qv[d0][6] * rs * gq[6], qv[d0][7] * rs * gq[7]); qr[d0] = __builtin_bit_cast(bf16x8, w);
#pragma unroll
      for (int j = 0; j < 8; ++j) { const float qn = qv[d0][j] * rs * gq[j]; qn2 += qn * qn; } }
    qn2 = swap_add(qn2); }
  bool safe;
  { wsf[lane] = fmaxf(fmaxf(fabsf(I.ks_gain[lane]), fabsf(I.kw_gain[lane])), fabsf(I.kc_gain[lane])); float gm = 0.f;
#pragma unroll
    for (int k = 0; k < 16; ++k) { const pg8::f32x4 c = *(const LAS pg8::f32x4*)(wsf + 4 * k); gm = fmaxf(fmaxf(gm, fmaxf(c.x, c.y)), fmaxf(c.z, c.w)); }
    safe = __all(sqrtf(qn2) * gm * (8.0f * 1.02f) < 80.0f) != 0; }
  const float g0 = B.NG[tok * 24 + h * 3 + 0], g1 = B.NG[tok * 24 + h * 3 + 1], g2 = B.NG[tok * 24 + h * 3 + 2];
  const u16* kc = B.KCMP + (size_t)(b * 2 + g) * 256 * 64; const u16* vc = B.VCMP + (size_t)(b * 2 + g) * 256 * 64;
  const u16* ksb = B.QKV + (size_t)b * S * QKVW + nv::O_KS + g * 64; const u16* vsb = B.QKV + (size_t)b * S * QKVW + nv::O_VS + g * 64;
  const u16* kwb = B.QKV + (size_t)b * S * QKVW + nv::O_KW + g * 64; const u16* vwb = B.QKV + (size_t)b * S * QKVW + nv::O_VW + g * 64;
  int nvis = t >= 31 ? (t - 31) / 16 + 1 : 0; nvis = nvis > 255 ? 255 : nvis;
  const int ntA = (4 * i + 3 + 63) / 64, nC = (i < 8 ? i : 8) + 1, jC0 = i - (nC - 1);
  const int sI = ntA, sB = 2 * ntA, sC = sB + i + 1, NS = sC + nC;
  { LAS float* IM = (LAS float*)(lds + L_IMP); for (int k = tid; k < 4 * IMP_HEAD; k += 512) IM[k] = 0.f; }
  f32x16 outacc[2];
  LAS float* slab = (LAS float*)(lds + L_IMP) + wid * 2048;
  SmState st; sm_reset(st);
  float mA = 0.f, invlA = 0.f; unsigned long long mybits = 0ull;
  FA_PROF_DECL
#ifdef PROBE_STAMPS
  const unsigned long long ck0 = __builtin_amdgcn_s_memtime(), rt0 = __builtin_amdgcn_s_memrealtime();
#endif
#define FA_ISSUE1(s_) do { const int s__ = (s_); const int sl = s__ & 3; \
    if (s__ < sI) stage_kv(lds, sl, kc + (size_t)s__ * 4096, vc + (size_t)s__ * 4096, 64, wid, lane, true); \
    else if (s__ < sB) stage_kv(lds, sl, kc + (size_t)(s__ - sI) * 4096, vc + (size_t)(s__ - sI) * 4096, 64, wid, lane, true); \
    else if (s__ < sC) stage_kv(lds, sl, ksb + (size_t)(s__ - sB) * 64 * QKVW, vsb + (size_t)(s__ - sB) * 64 * QKVW, QKVW, wid, lane, true); \
    else stage_kv(lds, sl, kwb + (size_t)(jC0 + s__ - sC) * 64 * QKVW, vwb + (size_t)(jC0 + s__ - sC) * 64 * QKVW, QKVW, wid, lane, true); } while (0)
  FA_ISSUE1(0);
  int s = 0;
#define FA_TOP(n_) do { FA_PROF(4); asm volatile("s_waitcnt vmcnt(0)" ::: "memory"); FA_PROF(5); __syncthreads(); FA_PROF(6); if (s + 1 < NS) FA_ISSUE1(s + 1); } while (0)
#define FA_PAR_A(sx, klo, khi, bias) { klo = 0; khi = nvis - 64 * (sx) - 1; bias = 0.f; }
#define FA_PAR_B(sx, klo, khi, bias) { const int j_ = (sx) - sB; klo = 0; khi = (j_ == i) ? tq : 63; bias = ((mybits >> j_) & 1ull) ? 0.f : -INFINITY; }
#define FA_PAR_C(sx, klo, khi, bias) { const int j_ = jC0 + ((sx) - sC); klo = (i >= 8 && j_ == i - 8) ? tq + 1 : 0; khi = (j_ == i) ? tq : 63; bias = 0.f; }
#define FA_LOOP(S_END, PAR, SEL) \
  _Pragma("unroll 1") for (; s < (S_END); ++s) { FA_TOP(1); int klo_, khi_; float bias_; PAR(s, klo_, khi_, bias_); \
    if (safe && __all(klo_ <= 0 && khi_ >= 63)) fast_step<SEL>(st, lds, s & 3, qr, r32, hi, vb0, bias_ == 0.f ? 0xffffffffu : 0u); \
    else tile_step(st, lds, s & 3, qr, wsf, r32, hi, vb0, klo_, khi_, bias_ FA_PROF_PASS); }
  FA_LOOP(sI, FA_PAR_A, false)
  finalize<0>(st, g0, outacc, slab, wsf, r32, hi, lane, mA, invlA);
#pragma unroll 1
  for (; s < sB; ++s) { FA_TOP(1); FA_PROF(0); imp_step(lds, s & 3, qr, r32, hi, nvis - 64 * (s - sI) - 1, mA, invlA, imph, tq, s - sI); FA_PROF(7); }
  asm volatile("s_waitcnt lgkmcnt(0)\n\ts_barrier" ::: "memory");
  FA_PROF(6); topk_select(lds, (LAS float*)(lds + (wid < 4 ? L_K : L_V) + ((s + 1) & 3) * 8192 + (wid & 3) * 2048), wid, lane, i);     FA_PROF(5);
  asm volatile("s_waitcnt lgkmcnt(0)\n\ts_barrier" ::: "memory"); mybits = ((const LAS unsigned long long*)(lds + L_MASK))[tq];
#pragma unroll
  for (int r = 0; r < 16; ++r) { slab[r * 64 + lane] = outacc[0][r]; slab[(16 + r) * 64 + lane] = outacc[1][r]; }
  sm_reset(st);
  FA_LOOP(sC, FA_PAR_B, true)
  { float d0_, d1_; finalize<1>(st, g1, outacc, slab, wsf, r32, hi, lane, d0_, d1_); sm_reset(st); }
  FA_LOOP(NS, FA_PAR_C, false)
  { float d0_, d1_; finalize<2>(st, g2, outacc, slab, wsf, r32, hi, lane, d0_, d1_); }
#undef FA_ISSUE1
#undef FA_TOP
#undef FA_LOOP
#undef FA_PAR_A
#undef FA_PAR_B
#undef FA_PAR_C
  { u16* Ow = B.YA + ((size_t)b * S + 64 * i + 32 * (wid & 1)) * 512 + h * 64; LAS u16* stg = (LAS u16*)(lds + L_OST) + wid * 4096;
#pragma unroll
    for (int r = 0; r < 16; ++r) { const int orow = crow(r, hi); stg[orow * 64 + r32] = nv::f2bf(outacc[0][r]); stg[orow * 64 + 32 + r32] = nv::f2bf(outacc[1][r]); }
    asm volatile("s_waitcnt lgkmcnt(0)" ::: "memory");
#pragma unroll
    for (int q = 0; q < 4; ++q) { const int row = q * 8 + (lane >> 3), ch = lane & 7; const u32x4 v = *(const LAS u32x4*)(stg + row * 64 + ch * 8); *(u32x4*)(Ow + (size_t)row * 512 + ch * 8) = v; } }
#ifdef PROBE_STAMPS
  if (blockIdx.x == 0 && threadIdx.x == PROBE_TID) { volatile LAS unsigned long long* ts = (volatile LAS unsigned long long*)(lds + 147120); for (int k = 0; k < 8; ++k) ts[20 + k] += prof.a[k]; ts[28] += (__builtin_amdgcn_s_memtime() - ck0) / 10; ts[34] += __builtin_amdgcn_s_memrealtime() - rt0; }
#endif
  __syncthreads();
}
__device__ __forceinline__ void phase_attention(LAS unsigned char* lds, const nv::Inputs& I, const Bufs& B) {
  const int G = gridDim.x, bx = blockIdx.x; const int vcu = (G % 8 == 0) ? (bx % 8) * (G / 8) + bx / 8 : bx;
  for (int u = vcu; u < 256; u += G) { const int bg = u >> 4, s = u & 15;
#pragma unroll 1
    for (int k = 0; k < 4; ++k) { const int i = (k == 0) ? s : (k == 1) ? 31 - s : (k == 2) ? 32 + s : 63 - s; attn_unit(lds, I, B, bg >> 1, bg & 1, i); } }
}
}
namespace fs {
#ifdef PROBE_STAMPS
#define FS_STAMP(k) do { if (blockIdx.x == 0 && threadIdx.x == 0) *(volatile LAS unsigned long long*)(lds + 147120 + 8 * (k)) = __builtin_amdgcn_s_memrealtime(); } while (0)
#else
#define FS_STAMP(k) do {} while (0)
#endif
using nv::u16; using nv::Bufs; using nv::Inputs;
using fa::bf16x8; using fa::f32x16; using fa::u32x4; using fa::crow; using fa::ex2;
typedef float f32x4 __attribute__((ext_vector_type(4)));
constexpr int S = nv::S, NTOK = nv::NTOK, SCD = 1536;
constexpr float LOG2E = 1.4426950408889634f;
struct SsdBufs { u16* XC; u16* STATE; float* ACS; float* DEC; };
__host__ __device__ inline size_t carve_ssd(SsdBufs& X, const Bufs& B, unsigned char* ws, size_t off) {
  auto take = [&](size_t bytes) { unsigned char* r = ws + off; off += (bytes + 255) / 256 * 256; return r; };
  X.XC = B.HB;
  X.STATE = B.HB + (size_t)NTOK * SCD;
  X.ACS = (float*)take((size_t)NTOK * 16 * 4); X.DEC = (float*)take((size_t)8 * 16 * 16 * 4);
  return off;
}
constexpr int L_ARR = 101376;
constexpr int L_BT = 0, BT_LD = 264, L_XWT = 67584;
constexpr int L_KIMG = 0, L_XV = 0, L_OST = 65536;
static_assert(L_XWT + 64 * BT_LD * 2 <= L_ARR && L_OST + 32768 <= L_ARR && L_ARR + 16384 <= 147456, "SSD LDS map");

__device__ __forceinline__ void phase_conv(const Inputs& I, const Bufs& B, const SsdBufs& X) {
  const int id = blockIdx.x * 512 + fx::otid(); if (id >= 192 * 512) return;
  const int c8 = (id % 192) * 8, run = id / 192; const int tok0 = run * 64; const int t0 = tok0 & (S - 1);
  float w[4][8], bias[8], h0[8], h1[8], h2[8];
#pragma unroll
  for (int j = 0; j < 8; ++j) { bias[j] = I.conv_b[c8 + j];
#pragma unroll
    for (int k = 0; k < 4; ++k) w[k][j] = I.conv_w[k * SCD + c8 + j]; }
  if (t0 >= 3) { fx::load8(B.XBC + (size_t)(tok0 - 3) * SCD + c8, h0); fx::load8(B.XBC + (size_t)(tok0 - 2) * SCD + c8, h1); fx::load8(B.XBC + (size_t)(tok0 - 1) * SCD + c8, h2); }
  else {
#pragma unroll
    for (int j = 0; j < 8; ++j) { h0[j] = 0.f; h1[j] = 0.f; h2[j] = 0.f; } }
#pragma unroll 8
  for (int t = 0; t < 64; ++t) { float x[8], y[8]; fx::load8(B.XBC + (size_t)(tok0 + t) * SCD + c8, x);
#pragma unroll
    for (int j = 0; j < 8; ++j) { const float a = bias[j] + w[0][j] * h0[j] + w[1][j] * h1[j] + w[2][j] * h2[j] + w[3][j] * x[j]; y[j] = a * fx::fsig(a); h0[j] = h1[j]; h1[j] = h2[j]; h2[j] = x[j]; }
    fx::store8(X.XC + (size_t)(tok0 + t) * SCD + c8, y); }
}

__device__ __forceinline__ void ssd_x_unit(LAS unsigned char* lds, const Inputs& I, const Bufs& B, const SsdBufs& X, int b, int c, int g) {
  const int tid = fx::otid(), lane = tid & 63, wid = __builtin_amdgcn_readfirstlane(tid >> 6), r32 = lane & 31, hi = lane >> 5, fr = lane & 15, fq = lane >> 4;
  const size_t tok0 = (size_t)b * S + (size_t)c * 256;
  LAS float* acs2 = (LAS float*)(lds + L_ARR); LAS float* dtl = acs2 + 8 * 256;
  { const int hh = g * 8 + wid; const float a = -expf(I.a_log[hh]) * LOG2E; float d[4], sc[4];
#pragma unroll
    for (int k = 0; k < 4; ++k) d[k] = B.DT[(tok0 + 4 * lane + k) * 16 + hh];
    sc[0] = d[0] * a; sc[1] = sc[0] + d[1] * a; sc[2] = sc[1] + d[2] * a; sc[3] = sc[2] + d[3] * a;
    float tot = sc[3];
#pragma unroll
    for (int o = 1; o < 64; o <<= 1) { const float up = __shfl_up(tot, o); if (lane >= o) tot += up; }
    const float excl = tot - sc[3];
#pragma unroll
    for (int k = 0; k < 4; ++k) { const float v = excl + sc[k]; acs2[wid * 256 + 4 * lane + k] = v; dtl[wid * 256 + 4 * lane + k] = d[k]; X.ACS[(tok0 + 4 * lane + k) * 16 + hh] = v; }
    if (lane == 63) X.DEC[((size_t)b * 16 + c) * 16 + hh] = ex2(tot); }
  { LAS u16* BT = (LAS u16*)(lds + L_BT);
#pragma unroll 1
    for (int q = tid; q < 256 * 16; q += 512) { const int l = q >> 4, n8 = (q & 15) * 8; const u32x4 w = *(const u32x4*)(X.XC + (tok0 + l) * SCD + 1024 + g * 128 + n8);
      BT[(n8 + 0) * BT_LD + l] = (u16)(w.x & 0xffff); BT[(n8 + 1) * BT_LD + l] = (u16)(w.x >> 16); BT[(n8 + 2) * BT_LD + l] = (u16)(w.y & 0xffff); BT[(n8 + 3) * BT_LD + l] = (u16)(w.y >> 16);
      BT[(n8 + 4) * BT_LD + l] = (u16)(w.z & 0xffff); BT[(n8 + 5) * BT_LD + l] = (u16)(w.z >> 16); BT[(n8 + 6) * BT_LD + l] = (u16)(w.w & 0xffff); BT[(n8 + 7) * BT_LD + l] = (u16)(w.w >> 16); } }
  __syncthreads();
  FS_STAMP(30);
  u32x4 nx[4];
#define FSX_LOAD_X(h_) do { _Pragma("unroll") for (int u = 0; u < 4; ++u) { const int q = tid + u * 512; nx[u] = *(const u32x4*)(X.XC + (tok0 + (q >> 3)) * SCD + (g * 8 + (h_)) * 64 + (q & 7) * 8); } } while (0)
  FSX_LOAD_X(0);
#pragma unroll 1
  for (int h = 0; h < 8; ++h) { const int hh = g * 8 + h; LAS u16* XwT = (LAS u16*)(lds + L_XWT); const LAS u16* BT = (const LAS u16*)(lds + L_BT);
    const float aend = acs2[h * 256 + 255];
#pragma unroll
    for (int u = 0; u < 4; ++u) { const int q = tid + u * 512, l = q >> 3, p8 = (q & 7) * 8; const float w = ex2(aend - acs2[h * 256 + l]) * dtl[h * 256 + l]; const u32x4 xv = nx[u];
      XwT[(p8 + 0) * BT_LD + l] = nv::f2bf(__uint_as_float(xv.x << 16) * w); XwT[(p8 + 1) * BT_LD + l] = nv::f2bf(__uint_as_float(xv.x & 0xffff0000u) * w);
      XwT[(p8 + 2) * BT_LD + l] = nv::f2bf(__uint_as_float(xv.y << 16) * w); XwT[(p8 + 3) * BT_LD + l] = nv::f2bf(__uint_as_float(xv.y & 0xffff0000u) * w);
      XwT[(p8 + 4) * BT_LD + l] = nv::f2bf(__uint_as_float(xv.z << 16) * w); XwT[(p8 + 5) * BT_LD + l] = nv::f2bf(__uint_as_float(xv.z & 0xffff0000u) * w);
      XwT[(p8 + 6) * BT_LD + l] = nv::f2bf(__uint_as_float(xv.w << 16) * w); XwT[(p8 + 7) * BT_LD + l] = nv::f2bf(__uint_as_float(xv.w & 0xffff0000u) * w); }
    if (h + 1 < 8) FSX_LOAD_X(h + 1);
    asm volatile("s_waitcnt lgkmcnt(0)\n\ts_barrier" ::: "memory");
    { const int pt = wid & 3, nt0 = (wid >> 2) * 4; pg8::f32x4 acc[4];
#pragma unroll
      for (int n = 0; n < 4; ++n) acc[n] = (pg8::f32x4){0.f, 0.f, 0.f, 0.f};
#pragma unroll
      for (int ks = 0; ks < 8; ++ks) { const bf16x8 a = *(const LAS bf16x8*)(XwT + (pt * 16 + fr) * BT_LD + ks * 32 + fq * 8);
#pragma unroll
        for (int n = 0; n < 4; ++n) { const bf16x8 bb = *(const LAS bf16x8*)(BT + ((nt0 + n) * 16 + fr) * BT_LD + ks * 32 + fq * 8); acc[n] = __builtin_amdgcn_mfma_f32_16x16x32_bf16(a, bb, acc[n], 0, 0, 0); } }
      u16* st = X.STATE + (((size_t)b * 16 + c) * 16 + hh) * 8192;
#pragma unroll
      for (int n = 0; n < 4; ++n)
#pragma unroll
        for (int j = 0; j < 4; ++j) st[(pt * 16 + 4 * fq + j) * 128 + (nt0 + n) * 16 + fr] = nv::f2bf(acc[n][j]); }
    asm volatile("s_waitcnt lgkmcnt(0)\n\ts_barrier" ::: "memory"); }
#undef FSX_LOAD_X
  FS_STAMP(31);
  const int lt = wid < 4 ? wid : 11 - wid;
  const int l = 32 * lt + r32;
  for (int k = tid; k < 8 * 256; k += 512) { const int h_ = k >> 8, s_ = k & 255; dtl[k] = ex2(acs2[h_ * 256 + (s_ & ~15)] - acs2[k]) * dtl[k]; }
  bf16x8 qr[8];
#pragma unroll
  for (int d0 = 0; d0 < 8; ++d0) qr[d0] = *(const bf16x8*)(X.XC + (tok0 + l) * SCD + 1280 + g * 128 + d0 * 16 + hi * 8);
  unsigned Sp[4][16];
#define FS_STAGE_K(j_) do { const int j__ = (j_); _Pragma("unroll") for (int q = 0; q < 2; ++q) { const int ch = wid + 8 * q; \
    __builtin_amdgcn_global_load_lds((const unsigned*)(X.XC + (tok0 + 64 * j__ + lane) * SCD + 1024 + g * 128 + ch * 8), (LAS unsigned*)(lds + L_KIMG + (j__ & 1) * 16384 + ch * 1024), 16, 0, 0); } } while (0)
  FS_STAGE_K(0);
#pragma unroll
  for (int j = 0; j < 4; ++j) {
    asm volatile("s_waitcnt vmcnt(0)" ::: "memory"); __syncthreads();
    if (j + 1 < 4) FS_STAGE_K(j + 1);
    f32x16 p0, p1;
#pragma unroll
    for (int r = 0; r < 16; ++r) { p0[r] = 0.f; p1[r] = 0.f; }
    if (64 * j <= 32 * lt + 31) { const LAS unsigned char* kb = lds + L_KIMG + (j & 1) * 16384 + hi * 1024 + r32 * 16;
#pragma unroll
      for (int d0 = 0; d0 < 8; ++d0) { const bf16x8 b0 = *(const LAS bf16x8*)(kb + d0 * 2048), b1 = *(const LAS bf16x8*)(kb + d0 * 2048 + 512);
        p0 = __builtin_amdgcn_mfma_f32_32x32x16_bf16(b0, qr[d0], p0, 0, 0, 0); p1 = __builtin_amdgcn_mfma_f32_32x32x16_bf16(b1, qr[d0], p1, 0, 0, 0); } }
#pragma unroll
    for (int r = 0; r < 8; ++r) { Sp[j][r] = pg8::cvt_pk_bf16(p0[2 * r], p0[2 * r + 1]); Sp[j][8 + r] = pg8::cvt_pk_bf16(p1[2 * r], p1[2 * r + 1]); } }
#undef FS_STAGE_K
  FS_STAMP(32);
  __syncthreads();
#define FS_STAGE_X(h_) do { const int h__ = (h_); _Pragma("unroll") for (int j = 0; j < 4; ++j) \
    __builtin_amdgcn_global_load_lds((const unsigned*)(X.XC + (tok0 + 64 * j + 16 * (wid & 3) + (lane >> 2)) * SCD + (g * 8 + h__) * 64 + (wid >> 2) * 32 + (lane & 3) * 8), \
                                     (LAS unsigned*)(lds + L_XV + (h__ & 1) * 32768 + j * 8192 + wid * 1024), 16, 0, 0); } while (0)
  const int vb0 = (int)(unsigned)(size_t)lds + ((lane >> 4) & 1) * 32 + (lane & 3) * 8 + (4 * hi + ((lane & 15) >> 2)) * 64;
  FS_STAGE_X(0);
#pragma unroll 1
  for (int h = 0; h < 8; ++h) { const int hh = g * 8 + h;
    if (h == 0) asm volatile("s_waitcnt vmcnt(0) lgkmcnt(0)\n\ts_barrier" ::: "memory"); else asm volatile("s_waitcnt vmcnt(4) lgkmcnt(0)\n\ts_barrier" ::: "memory");
    if (h + 1 < 8) FS_STAGE_X(h + 1);
    const float al = acs2[h * 256 + l]; f32x16 o[2];
#pragma unroll
    for (int r = 0; r < 16; ++r) { o[0][r] = 0.f; o[1][r] = 0.f; }
#pragma unroll
    for (int j = 0; j < 4; ++j) { if (64 * j <= 32 * lt + 31) { f32x16 p0, p1;
#pragma unroll
        for (int r = 0; r < 16; ++r) asm volatile("" : "+v"(Sp[j][r]));
#pragma unroll
        for (int r = 0; r < 8; ++r) { p0[2 * r] = __uint_as_float(Sp[j][r] << 16); p0[2 * r + 1] = __uint_as_float(Sp[j][r] & 0xffff0000u); p1[2 * r] = __uint_as_float(Sp[j][8 + r] << 16); p1[2 * r + 1] = __uint_as_float(Sp[j][8 + r] & 0xffff0000u); }
        float e1[4];
#pragma unroll
        for (int q = 0; q < 4; ++q) e1[q] = ex2(al - acs2[h * 256 + 64 * j + 16 * q]);
#pragma unroll
        for (int gq = 0; gq < 4; ++gq) { const int s0 = 64 * j + 8 * gq + 4 * hi; const f32x4 d0v = *(const LAS f32x4*)(dtl + h * 256 + s0), d1v = *(const LAS f32x4*)(dtl + h * 256 + s0 + 32);
#pragma unroll
          for (int k = 0; k < 4; ++k) { const int r = 4 * gq + k, s = s0 + k; p0[r] = (s <= l) ? p0[r] * (e1[gq >> 1] * d0v[k]) : 0.f; p1[r] = (s + 32 <= l) ? p1[r] * (e1[2 + (gq >> 1)] * d1v[k]) : 0.f; } }
        u32x4 w0, w1, w2, w3;
        w0.x = pg8::cvt_pk_bf16(p0[0], p0[1]); w0.y = pg8::cvt_pk_bf16(p0[2], p0[3]); w0.z = pg8::cvt_pk_bf16(p0[4], p0[5]); w0.w = pg8::cvt_pk_bf16(p0[6], p0[7]);
        w1.x = pg8::cvt_pk_bf16(p0[8], p0[9]); w1.y = pg8::cvt_pk_bf16(p0[10], p0[11]); w1.z = pg8::cvt_pk_bf16(p0[12], p0[13]); w1.w = pg8::cvt_pk_bf16(p0[14], p0[15]);
        w2.x = pg8::cvt_pk_bf16(p1[0], p1[1]); w2.y = pg8::cvt_pk_bf16(p1[2], p1[3]); w2.z = pg8::cvt_pk_bf16(p1[4], p1[5]); w2.w = pg8::cvt_pk_bf16(p1[6], p1[7]);
        w3.x = pg8::cvt_pk_bf16(p1[8], p1[9]); w3.y = pg8::cvt_pk_bf16(p1[10], p1[11]); w3.z = pg8::cvt_pk_bf16(p1[12], p1[13]); w3.w = pg8::cvt_pk_bf16(p1[14], p1[15]);
        fa::pv(o, vb0 + L_XV + (h & 1) * 32768 + j * 8192, __builtin_bit_cast(bf16x8, w0), __builtin_bit_cast(bf16x8, w1), __builtin_bit_cast(bf16x8, w2), __builtin_bit_cast(bf16x8, w3)); } }
    { const float dsk = I.d_skip[hh]; const LAS u16* xi = (const LAS u16*)(lds + L_XV + (h & 1) * 32768 + (lt >> 1) * 8192); LAS u16* stg = (LAS u16*)(lds + L_OST) + wid * 2048;
#pragma unroll
      for (int r = 0; r < 16; ++r) { const int key = 32 * (lt & 1) + crow(r, hi);
#pragma unroll
        for (int d0 = 0; d0 < 2; ++d0) { const float xv = nv::bf2f(xi[d0 * 2048 + (key >> 4) * 512 + (key & 15) * 32 + r32]); stg[crow(r, hi) * 64 + d0 * 32 + r32] = nv::f2bf(o[d0][r] + dsk * xv); } }
      asm volatile("s_waitcnt lgkmcnt(0)" ::: "memory");
      u16* Ow = X.XC + (tok0 + 32 * lt) * SCD + hh * 64;
#pragma unroll
      for (int q = 0; q < 4; ++q) { const int row = q * 8 + (lane >> 3), ch = lane & 7; const u32x4 v = *(const LAS u32x4*)(stg + row * 64 + ch * 8); *(u32x4*)(Ow + (size_t)row * SCD + ch * 8) = v; } } }
#undef FS_STAMP_DUMMY
#undef FS_STAGE_X
  __syncthreads(); FS_STAMP(33);
}
__device__ __forceinline__ void phase_ssd_x(LAS unsigned char* lds, const Inputs& I, const Bufs& B, const SsdBufs& X) {
  for (int u = blockIdx.x; u < 256; u += gridDim.x) ssd_x_unit(lds, I, B, X, u >> 5, (u >> 1) & 15, u & 1);
}
__device__ __forceinline__ void phase_ssd_scan(const SsdBufs& X) {
  for (int it = blockIdx.x * 512 + fx::otid(); it < 8 * 16 * 64 * 32; it += gridDim.x * 512) { const int n4 = (it & 31) * 4, p = (it >> 5) & 63, hh = (it >> 11) & 15, b = it >> 15;
    pg8::u32x2 v[16]; float dec[16];
#pragma unroll
    for (int c = 0; c < 16; ++c) { v[c] = *(const pg8::u32x2*)(X.STATE + (((size_t)b * 16 + c) * 16 + hh) * 8192 + p * 128 + n4); dec[c] = X.DEC[((size_t)b * 16 + c) * 16 + hh]; }
    float h0 = 0.f, h1 = 0.f, h2 = 0.f, h3 = 0.f;
#pragma unroll
    for (int c = 0; c < 16; ++c) { pg8::u32x2 o; o.x = fx::pk2(h0, h1); o.y = fx::pk2(h2, h3); *(pg8::u32x2*)(X.STATE + (((size_t)b * 16 + c) * 16 + hh) * 8192 + p * 128 + n4) = o;
      h0 = h0 * dec[c] + __uint_as_float(v[c].x << 16); h1 = h1 * dec[c] + __uint_as_float(v[c].x & 0xffff0000u); h2 = h2 * dec[c] + __uint_as_float(v[c].y << 16); h3 = h3 * dec[c] + __uint_as_float(v[c].y & 0xffff0000u); } }
}
__device__ __forceinline__ void ssd_y_unit(LAS unsigned char* lds, const Inputs& I, const Bufs& B, const SsdBufs& X, int b, int c, int g) {
  const int tid = fx::otid(), lane = tid & 63, wid = __builtin_amdgcn_readfirstlane(tid >> 6), r32 = lane & 31, hi = lane >> 5;
  const size_t tok0 = (size_t)b * S + (size_t)c * 256; const int l = 32 * wid + r32;
  LAS float* acsw = (LAS float*)(lds + 0) + wid * 32 * 8;
  LAS u16* stg1 = (LAS u16*)(lds + 16384) + wid * 2048; LAS u16* stg2 = (LAS u16*)(lds + 49152) + wid * 2048; LAS float* rstdL = (LAS float*)(lds + 81920);
  { const int row = lane >> 1, h4 = (lane & 1) * 4; const f32x4 a = *(const f32x4*)(X.ACS + (tok0 + 32 * wid + row) * 16 + g * 8 + h4); acsw[row * 8 + h4 + 0] = ex2(a.x); acsw[row * 8 + h4 + 1] = ex2(a.y); acsw[row * 8 + h4 + 2] = ex2(a.z); acsw[row * 8 + h4 + 3] = ex2(a.w); }
  bf16x8 qr[8];
#pragma unroll
  for (int d0 = 0; d0 < 8; ++d0) qr[d0] = *(const bf16x8*)(X.XC + (tok0 + l) * SCD + 1280 + g * 128 + d0 * 16 + hi * 8);
  float ssq[16];
#pragma unroll
  for (int r = 0; r < 16; ++r) ssq[r] = 0.f;
#define FSY_STAGE_P(h_) do { const int h__ = (h_); const u16* pp_ = X.STATE + (((size_t)b * 16 + c) * 16 + g * 8 + h__) * 8192; _Pragma("unroll") for (int q = 0; q < 2; ++q) { const int ch = wid + 8 * q; \
    __builtin_amdgcn_global_load_lds((const unsigned*)(pp_ + (size_t)lane * 128 + ch * 8), (LAS unsigned*)(lds + 90112 + (h__ & 1) * 16384 + ch * 1024), 16, 0, 0); } } while (0)
#define FSY_LOAD_YZ(h_) do { const int hh__ = g * 8 + (h_); _Pragma("unroll") for (int q = 0; q < 4; ++q) { const int row = q * 8 + (lane >> 3), ch = lane & 7; \
    ny1[q] = *(const u32x4*)(X.XC + (tok0 + 32 * wid + row) * SCD + hh__ * 64 + ch * 8); nz[q] = *(const u32x4*)(B.Z + (tok0 + 32 * wid + row) * 1024 + hh__ * 64 + ch * 8); } } while (0)
  u32x4 ny1[4], nz[4];
  FS_STAMP(34);
  FSY_STAGE_P(0); FSY_LOAD_YZ(0);
#pragma unroll 1
  for (int h = 0; h < 8; ++h) { const int hh = g * 8 + h;
    if (h == 0) asm volatile("s_waitcnt vmcnt(0) lgkmcnt(0)\n\ts_barrier" ::: "memory"); else asm volatile("s_waitcnt vmcnt(4) lgkmcnt(0)\n\ts_barrier" ::: "memory");
#pragma unroll
    for (int q = 0; q < 4; ++q) { const int row = q * 8 + (lane >> 3), ch = lane & 7; *(LAS u32x4*)(stg1 + row * 64 + ch * 8) = ny1[q]; *(LAS u32x4*)(stg2 + row * 64 + ch * 8) = nz[q]; }
    if (h + 1 < 8) { FSY_STAGE_P(h + 1); FSY_LOAD_YZ(h + 1); }
    f32x16 y[2];
#pragma unroll
    for (int r = 0; r < 16; ++r) { y[0][r] = 0.f; y[1][r] = 0.f; }
    { const LAS unsigned char* pb = lds + 90112 + (h & 1) * 16384 + hi * 1024 + r32 * 16;
#pragma unroll
      for (int d0 = 0; d0 < 8; ++d0) { const bf16x8 b0 = *(const LAS bf16x8*)(pb + d0 * 2048), b1 = *(const LAS bf16x8*)(pb + d0 * 2048 + 512);
        y[0] = __builtin_amdgcn_mfma_f32_32x32x16_bf16(qr[d0], b0, y[0], 0, 0, 0); y[1] = __builtin_amdgcn_mfma_f32_32x32x16_bf16(qr[d0], b1, y[1], 0, 0, 0); } }
    asm volatile("s_waitcnt lgkmcnt(0)" ::: "memory");
#pragma unroll
    for (int r = 0; r < 16; ++r) { const int row = crow(r, hi); const float ea = acsw[row * 8 + h];
#pragma unroll
      for (int d0 = 0; d0 < 2; ++d0) { const int idx = row * 64 + d0 * 32 + r32; const float yy = nv::bf2f(stg1[idx]) + ea * y[d0][r]; const float zz = nv::bf2f(stg2[idx]); const float yg = yy * zz * fx::fsig(zz); ssq[r] += yg * yg; stg1[idx] = nv::f2bf(yg); } }
    asm volatile("s_waitcnt lgkmcnt(0)" ::: "memory");
#pragma unroll
    for (int q = 0; q < 4; ++q) { const int row = q * 8 + (lane >> 3), ch = lane & 7; *(u32x4*)(B.YB + (tok0 + 32 * wid + row) * 1024 + hh * 64 + ch * 8) = *(const LAS u32x4*)(stg1 + row * 64 + ch * 8); }
    asm volatile("s_waitcnt lgkmcnt(0)" ::: "memory"); }
  FS_STAMP(35);
#pragma unroll
  for (int r = 0; r < 16; ++r) { float v = ssq[r];
#pragma unroll
    for (int o = 1; o < 32; o <<= 1) v += __shfl_xor(v, o);
    if (r32 == 0) rstdL[32 * wid + crow(r, hi)] = 1.0f / sqrtf(v * (1.f / 512.f) + nv::EPS); }
#undef FSY_STAGE_P
#undef FSY_LOAD_YZ
  asm volatile("s_waitcnt vmcnt(0) lgkmcnt(0)\n\ts_barrier" ::: "memory"); FS_STAMP(36);
#pragma unroll 1
  for (int q0 = tid; q0 < 256 * 64; q0 += 512 * 8) { float v[8][8];
#pragma unroll
    for (int u = 0; u < 8; ++u) { const int q = q0 + u * 512, row = q >> 6, c8 = (q & 63) * 8; fx::load8(B.YB + (tok0 + row) * 1024 + g * 512 + c8, v[u]); }
#pragma unroll
    for (int u = 0; u < 8; ++u) { const int q = q0 + u * 512, row = q >> 6, c8 = (q & 63) * 8; const float rs = rstdL[row];
#pragma unroll
      for (int j = 0; j < 8; ++j) v[u][j] = v[u][j] * rs * I.ssm_norm[g * 512 + c8 + j];
      fx::store8(B.YB + (tok0 + row) * 1024 + g * 512 + c8, v[u]); } }
  __syncthreads();
}
__device__ __forceinline__ void phase_ssd_y(LAS unsigned char* lds, const Inputs& I, const Bufs& B, const SsdBufs& X) {
  for (int u = blockIdx.x; u < 256; u += gridDim.x) ssd_y_unit(lds, I, B, X, u >> 5, (u >> 1) & 15, u & 1);
}
}
namespace fc {
using nv::u16; using nv::Bufs; using nv::Inputs; using pg8::Unit;
constexpr int S = nv::S;
struct CmpBufs { u16* WcT; float* BIAS1; float* PAB; };
__host__ __device__ inline size_t carve_cmp(CmpBufs& C, unsigned char* ws, size_t off) {
  auto take = [&](size_t bytes) { unsigned char* r = ws + off; off += (bytes + 255) / 256 * 256; return r; };
  C.WcT = (u16*)take((size_t)2 * 256 * 1024 * 2); C.BIAS1 = (float*)take(2 * 128 * 4); C.PAB = (float*)take((size_t)2 * 2 * 16 * 256 * 256 * 4);
  return off;
}
struct CpCmp { const float* src; int ld; __device__ const float* operator()(int n) const { return n < 128 ? src + n : src + (size_t)1024 * 128 + (n - 128); } };
__device__ __forceinline__ void prologue_cmp(LAS unsigned char* lds, const Inputs& I, const CmpBufs& C) {
  { const int tid = fx::otid(), lane = tid & 63, wv = tid >> 6, gw = fx::obid() * 8 + wv, ngw = gridDim.x * 8; LAS float* scr = (LAS float*)lds + wv * (64 * 33);
    for (int t = gw; t < 2 * 8 * 16; t += ngw) { const int kv = t >> 7, q = t & 127; CpCmp cp{kv ? I.w1_v : I.w1_k, 128}; fx::transpose_item(scr, cp, C.WcT + (size_t)kv * 256 * 1024, 1024, (q >> 4) * 32, (q & 15) * 64, lane); } }
  { const int tid = fx::otid(), lane = tid & 63, gw = fx::obid() * 8 + (tid >> 6);
    if (gw < 256) { const int kv = gw >> 7, n = gw & 127; const float* w1 = kv ? I.w1_v : I.w1_k; const float* pos = kv ? I.pos_v : I.pos_k; float s = 0.f;
      for (int k = lane; k < 2048; k += 64) s += pos[k] * w1[(size_t)k * 128 + n];
      s = fx::wave_sum(s); if (lane == 0) C.BIAS1[kv * 128 + n] = s; } }
}
struct SchedCmp { int kv, bg, kh;
  __device__ bool next(int i, Unit& u) const { if (i > 0) return false; u.pm = (kh * 2 + kv) * 16 + bg; u.pn = 0; u.aux0 = 0; u.aux1 = 0; return true; }
  __device__ __forceinline__ const char* a_base(const pg8::Gemm& g, const Unit&) const { return (const char*)g.A + (size_t)kh * 8 * 1280 * 2; }
  __device__ __forceinline__ const char* b_base(const pg8::Gemm& g, const Unit&) const { return (const char*)g.Bt + ((size_t)kv * 256 * 1024 + (size_t)kh * 512) * 2; }
  __device__ __forceinline__ int a_row(const Unit&, int r) const { return ((bg >> 1) * S + 16 * r) * 1280 + (kv ? nv::O_VC : nv::O_KC) + (bg & 1) * 64; } };
struct FPab { float* o; __device__ __forceinline__ void operator()(const Unit&, int row, int c, const float (&v)[8]) const { float* p = o + (size_t)row * 256 + c; *(pg8::f32x4*)p = (pg8::f32x4){v[0], v[1], v[2], v[3]}; *(pg8::f32x4*)(p + 4) = (pg8::f32x4){v[4], v[5], v[6], v[7]}; } };
__device__ __forceinline__ void phase_cmp_gemm(LAS unsigned char* lds, const Bufs& B, const CmpBufs& C) {
  for (int u = (int)blockIdx.x - ((int)gridDim.x - 64); u >= 0 && u < 64; u += gridDim.x) { pg8::Gemm g{B.QKV, C.WcT, 256, 256, 512, 1, 1024, 1280 * 2}; SchedCmp S{(u >> 4) & 1, u & 15, u >> 5}; fx::Epi8<FPab> E{FPab{C.PAB}};
    pg8::gemm_phase<fx::Epi8<FPab>, SchedCmp, true, true>(lds, g, S, E); }
}
__device__ __forceinline__ void phase_cmp_finish(LAS unsigned char* lds, const Inputs& I, const Bufs& B, const CmpBufs& C) {
  const int tid = fx::otid(), lane = tid & 63, wv = tid >> 6, gw = fx::obid() * 8 + wv, ngw = gridDim.x * 8;
  LAS float* w2s = (LAS float*)lds; LAS float* hs = (LAS float*)(lds + 65536) + wv * 128;
  for (int k = tid; k < 2 * 128 * 64 / 4; k += 512) { const int kv = k >> 11, q = k & 2047; *(LAS pg8::f32x4*)(w2s + kv * 8192 + q * 4) = *(const pg8::f32x4*)((kv ? I.w2_v : I.w2_k) + q * 4); }
  __syncthreads();
  for (int it = gw; it < 2 * 16 * 256; it += ngw) { const int kv = it >> 12, bg = (it >> 8) & 15, c = it & 255; u16* dst = (kv ? B.VCMP : B.KCMP) + ((size_t)bg * 256 + c) * 64;
    if (c == 255) { dst[lane] = 0; continue; }
    const float* pa = C.PAB + ((size_t)(kv * 16 + bg) * 256 + c) * 256; const float* pb = pa + 256 + 128; const float* b1 = C.BIAS1 + kv * 128;
    const float* pa2 = pa + (size_t)2 * 16 * 256 * 256; const float* pb2 = pb + (size_t)2 * 16 * 256 * 256;
    { const float ha = (pa[lane] + pa2[lane]) + (pb[lane] + pb2[lane]) + b1[lane], hb = (pa[64 + lane] + pa2[64 + lane]) + (pb[64 + lane] + pb2[64 + lane]) + b1[64 + lane]; hs[lane] = ha * fx::fsig(ha); hs[64 + lane] = hb * fx::fsig(hb); }
    const LAS float* w2 = w2s + kv * 8192; float acc = 0.f;
#pragma unroll 8
    for (int n = 0; n < 128; ++n) acc += hs[n] * w2[n * 64 + lane];
    if (kv == 0) { const float ss = fx::wave_sum(acc * acc); acc = acc * (1.0f / sqrtf(ss * (1.f / 64.f) + nv::EPS)) * I.kc_gain[lane]; }
    dst[lane] = nv::f2bf(acc); }
  __syncthreads();
}
}
struct Params { nv::Inputs I; float* out; unsigned char* ws; };
constexpr int LDS_BYTES = 147456;
template <class F> __device__ __forceinline__ void run_phase(const F& f, long n) {
  for (long i = blockIdx.x * 512L + fx::otid(); i < n; i += (long)gridDim.x * 512L) f(i);
}
__global__ void __launch_bounds__(512) mega_fwd(Params P) {
  extern __shared__ __attribute__((aligned(16))) unsigned char lds_raw[];
  LAS unsigned char* lds = (LAS unsigned char*)lds_raw;
  cg::grid_group grid = cg::this_grid();
#define PH(...) { unsigned char* ws_ = P.ws; float* out = P.out; asm volatile("" : "+s"(ws_), "+s"(out)); nv::Bufs B; const size_t woff = nv::carve(B, ws_, out); fx::WBufs W; const size_t moff = fx::carve_w(W, ws_, woff); \
    fx::MoeBufs M; const size_t soff = fx::carve_moe(M, B, ws_, moff); fs::SsdBufs X; const size_t coff = fs::carve_ssd(X, B, ws_, soff); fc::CmpBufs C; const size_t boff = fc::carve_cmp(C, ws_, coff); unsigned* barw = (unsigned*)(ws_ + boff); (void)barw; (void)W; (void)M; (void)X; (void)C; __VA_ARGS__ }
  if (threadIdx.x < 4) ((LAS unsigned*)(lds + LDS_BYTES - 16))[threadIdx.x] = 0u;
  __syncthreads();
  xb::XcdBarrier bar; PH( bar = xb::xcd_barrier_post(barw, (volatile LAS unsigned*)(lds + LDS_BYTES - 16)); )
#define GSYNC() xb::xcd_barrier(bar)
  PH( fx::phase_prologue(lds, P.I, B, W); fx::phase_rms_rows(P.I.x, P.I.mix_norm, B.HB); fx::prologue_pb(P.I, W); fx::prologue_moe(P.I, M); fc::prologue_cmp(lds, P.I, C); ) grid.sync();
  PH( fx::dense_gemm(lds, B.HB, 1024, W.WinT, 1024, nv::NTOK, fx::INW_PAD, 1024, fx::FInProj{B.QKV, B.Z, B.XBC, B.BG, B.NG, B.DT, P.I.dt_bias}); ) GSYNC();
  PH( fc::phase_cmp_gemm(lds, B, C); fs::phase_conv(P.I, B, X); fa::phase_qknorm(P.I, B); ) GSYNC();
  PH( fs::phase_ssd_x(lds, P.I, B, X); ) GSYNC();
  PH( fs::phase_ssd_scan(X); fc::phase_cmp_finish(lds, P.I, B, C); ) GSYNC();
  PH( fs::phase_ssd_y(lds, P.I, B, X); ) GSYNC();
  PH( fa::phase_attention(lds, P.I, B); ) GSYNC();
  PH( fx::dense_gemm(lds, B.YA, 512, W.WaT, 512, nv::NTOK, 1024, 512, fx::FStoreBf{B.T1, 1024}); )
  PH( fx::dense_gemm(lds, B.YB, 1024, W.WbT, 1024, nv::NTOK, 1024, 1024, fx::FMerge{B.T1, B.BG, B.MERGED}); ) GSYNC();
  PH( fx::dense_gemm(lds, B.MERGED, 1024, W.WoutT, 1024, nv::NTOK, 1024, 1024, fx::FResid{P.I.x, (nv::u16*)out}); ) GSYNC();
  PH( fx::dense_gemm(lds, (const nv::u16*)out, 1024, M.WrT, 1024, nv::NTOK, 256, 1024, fx::FLogits{M.LOGITS}); fx::phase_row_rstd((const nv::u16*)out, M.SSQ, (int)gridDim.x > 128 ? 128 : 0); ) GSYNC();
  PH( fx::phase_route(lds, P.I, B, M); ) GSYNC();
  PH( fx::build_tile_table(lds, M); )
  PH( fx::phase_moe_gu(lds, B, W, M, (const nv::u16*)out); ) GSYNC();
  PH( fx::phase_moe_down(lds, B, W, M); ) GSYNC();
  PH( fx::phase_moe_combine(lds, (const nv::u16*)out, B.ACT, M, B.EW, M.SSQ); ) GSYNC();
  PH( fx::dense_gemm(lds, B.ACT, 1024, W.PleGT, 1024, nv::NTOK, 1024, 1024, fx::FPle{B.ACT, out, B.PP, M.SSQ}); )
#undef GSYNC
}
extern "C" void kernel_launch(void* const* d_in, const int* in_sizes, int n_in, void* d_out, int out_size, void* d_ws, size_t ws_size, hipStream_t stream) {
  static int grid_blocks = 0;
  if (!grid_blocks) {
    int dev = 0, cus = 0, per_cu = 0;
    (void)hipGetDevice(&dev);
    (void)hipDeviceGetAttribute(&cus, hipDeviceAttributeMultiprocessorCount, dev);
    if (hipFuncSetAttribute((const void*)mega_fwd, hipFuncAttributeMaxDynamicSharedMemorySize, LDS_BYTES) != hipSuccess) fprintf(stderr, "kernel_launch: hipFuncSetAttribute failed\n");
    if (hipOccupancyMaxActiveBlocksPerMultiprocessor(&per_cu, mega_fwd, 512, LDS_BYTES) != hipSuccess || per_cu < 1) { fprintf(stderr, "kernel_launch: occupancy query says %d blocks per CU\n", per_cu); }
    grid_blocks = cus;
    { nv::Bufs B; fx::WBufs W; fx::MoeBufs M; fs::SsdBufs X; fc::CmpBufs C; size_t need = 16384 + fc::carve_cmp(C, nullptr, fs::carve_ssd(X, B, nullptr, fx::carve_moe(M, B, nullptr, fx::carve_w(W, nullptr, nv::carve(B, nullptr, nullptr))))); if (need > ws_size) fprintf(stderr, "kernel_launch: workspace too small: need %zu have %zu\n", need, ws_size); }
  }
  static size_t bar_off = 0;
  if (!bar_off) { nv::Bufs B; fx::WBufs W; fx::MoeBufs M; fs::SsdBufs X; fc::CmpBufs C; bar_off = fc::carve_cmp(C, nullptr, fs::carve_ssd(X, B, nullptr, fx::carve_moe(M, B, nullptr, fx::carve_w(W, nullptr, nv::carve(B, nullptr, nullptr))))); }
  (void)hipMemsetAsync((char*)d_ws + bar_off, 0, 16384, stream);
  Params p; memset(&p, 0, sizeof(p));
  const float** ip = (const float**)&p.I; for (int i = 0; i < 34; ++i) ip[i] = (const float*)d_in[i];
  p.out = (float*)d_out; p.ws = (unsigned char*)d_ws;
  void* args[] = {&p};
  hipError_t e = hipLaunchCooperativeKernel((void*)mega_fwd, dim3(grid_blocks), dim3(512), args, LDS_BYTES, stream);
  if (e != hipSuccess) fprintf(stderr, "cooperative launch failed: %s (grid %d)\n", hipGetErrorString(e), grid_blocks);
}
```

```cpp
#include <hip/hip_runtime.h>
#include <hip/hip_cooperative_groups.h>
#include <cstdio>
#include <cstring>
namespace cg = cooperative_groups;
#define HD __host__ __device__ inline
#if defined(__HIP_DEVICE_COMPILE__)
#define NV_FENCE() asm volatile("" ::: "memory")
#else
#define NV_FENCE()
#endif
#ifndef CFG_DM
#define CFG_DM 1024
#endif
#ifndef CFG_BATCH
#define CFG_BATCH 8
#endif
#ifndef CFG_SEQ
#define CFG_SEQ 4096
#endif
#ifndef CFG_MH
#define CFG_MH 256
#endif
#ifndef CFG_PLE
#define CFG_PLE 256
#endif

#ifndef NV_FENCE
#define NV_FENCE()
#endif
namespace nv {
typedef unsigned short u16;
typedef unsigned long long u64;
constexpr int DM = CFG_DM, NB = CFG_BATCH, S = CFG_SEQ, MH = CFG_MH, PLE = CFG_PLE;
constexpr int NTOK = NB * S;
constexpr int H = 8, G = 2, E = 4;
constexpr int QW = 512, GW = 24, QKVW = 1280;
constexpr int SH = 16, SP = 64, SI = 1024, SG = 2, SN = 128, SCD = 1536;
constexpr int INW = QW + 6 * 128 + GW + SI + SCD + SH + 2 * DM;
constexpr int O_Q = 0, O_KC = 512, O_VC = 640, O_KS = 768, O_VS = 896, O_KW = 1024, O_VW = 1152, O_NG = 1280, O_Z = 1304, O_XBC = 2328, O_DT = 3864, O_BG = 3880;
static_assert(O_BG + 2 * DM == INW, "in-proj width");
constexpr int NCMP = S / 16 - 1, NCP = S / 16, NSEL = S / 64, NTOP = NSEL < 16 ? NSEL : 16;
constexpr int NEXP = 32;
constexpr float EPS = 1e-6f;

HD float sigmoidf_(float x) { return 1.0f / (1.0f + expf(-x)); }
HD float siluf_(float x) { return x / (1.0f + expf(-x)); }
HD float softplusf_(float x) { return x > 20.f ? x : log1pf(expf(x)); }
HD u16 f2bf(float f) { unsigned u = __builtin_bit_cast(unsigned, f); u += 0x7fffu + ((u >> 16) & 1u); return (u16)(u >> 16); }
HD float bf2f(u16 h) { return __builtin_bit_cast(float, (unsigned)h << 16); }

struct Bufs {
  u16* HB;
  u16* QKV;
  float* NG;
  u16* Z;
  u16* XBC;
  float* DT;
  u16* BG;
  u16* KCMP;
  u16* VCMP;
  u16* YA;
  u16* YB;
  u16* T1;
  u16* MERGED;
  u16* H2;
  u16* ACT;
  u16* PP;
  int* EI;
  float* EW;
  float* HID;
  float* KTMP;
  float* ML;
  float* IMP;
  u64* MASK;
};
struct Inputs { const float *x, *p, *mix_norm, *w_in, *q_gain, *kc_gain, *ks_gain, *kw_gain, *pos_k, *w1_k, *w2_k, *pos_v, *w1_v, *w2_v, *conv_w, *conv_b, *dt_bias, *a_log, *d_skip, *ssm_norm,
  *w_a, *w_b, *w_out, *moe_norm, *w_group, *b_group, *w_expert, *b_expert, *w_gate, *w_up, *w_down, *ple_norm, *ple_wg, *ple_wp; };

HD size_t carve(Bufs& B, unsigned char* ws, float* out) {
  size_t off = 0; auto take = [&](size_t bytes) { unsigned char* r = ws + off; off += (bytes + 255) / 256 * 256; return r; };
  const size_t N = NTOK;
  B.BG = (u16*)out;
  unsigned char* R0 = take(N * DM * 2);
  unsigned char* R5 = take(N * 2 * MH * 2 + (size_t)NEXP * 256 * MH * 2);
  B.YA = (u16*)take(N * QW * 2);
  unsigned char* R1 = take(N * QKVW * 2);
  unsigned char* R2 = take(N * SI * 2);
  unsigned char* R3 = take(N * SCD * 2);
  B.HB = (u16*)R0; B.H2 = (u16*)R0; B.QKV = (u16*)R1; B.T1 = (u16*)R1; B.Z = (u16*)R2; B.XBC = (u16*)R3; B.MERGED = (u16*)R3; B.PP = (u16*)R3;
  B.ACT = (u16*)R5; B.YB = B.Z;
  B.NG = (float*)take(N * GW * 4); B.DT = (float*)take(N * SH * 4);
  B.KCMP = (u16*)take((size_t)NB * G * NCP * 64 * 2); B.VCMP = (u16*)take((size_t)NB * G * NCP * 64 * 2);
  B.EI = (int*)take(N * 2 * 4); B.EW = (float*)take(N * 2 * 4);
#ifdef NV2_NAIVE_SCRATCH
  B.HID = (float*)take((size_t)NB * G * NCMP * 128 * 4); B.KTMP = (float*)take((size_t)NB * G * NCMP * 64 * 4);
  B.ML = (float*)take(N * H * 2 * 4); B.IMP = (float*)take((size_t)NB * G * S * 64 * 4); B.MASK = (u64*)take((size_t)NB * G * S * 8);
#else
  B.HID = nullptr; B.KTMP = nullptr; B.ML = nullptr; B.IMP = nullptr; B.MASK = nullptr;
#endif
  return off;
}
}
namespace xb {
#define LAS __attribute__((address_space(3)))
#define XB_TMO      128
#define XB_XCNT(j)  (256  + 64 * (j))
#define XB_XSUB(j)  (1280 + 64 * (j))
#define XB_XGEN(j)  (2304 + 64 * (j))
#define XB_TOP      3328
#define XB_TOPGEN   3392
#define XCD_BAR_WORDS 3456
#define XB_SPIN_CAP (1u << 22)

__device__ __forceinline__ unsigned xb_ld(unsigned* p)              { return __hip_atomic_load(p, __ATOMIC_RELAXED, __HIP_MEMORY_SCOPE_AGENT); }
__device__ __forceinline__ unsigned xb_add(unsigned* p, unsigned v) { return __hip_atomic_fetch_add(p, v, __ATOMIC_RELAXED, __HIP_MEMORY_SCOPE_AGENT); }
__device__ __forceinline__ unsigned xb_xcc_id() { return (unsigned)__builtin_amdgcn_s_getreg((3 << 11) | 20) & 0xFu; }
#define XB_SPIN(cond, bar) do { unsigned _sp = 0; while (cond) { __builtin_amdgcn_s_sleep(1); \
    if ((++_sp & 255u) == 0u) { if (xb_ld(&(bar)[XB_TMO])) break; if (_sp > XB_SPIN_CAP) { atomicAdd(&(bar)[XB_TMO], 1u); break; } } } } while (0)

struct XcdBarrier {
    unsigned* bar; unsigned x;
    volatile LAS unsigned* st;
};

__device__ __forceinline__ XcdBarrier xcd_barrier_post(unsigned* bar, volatile LAS unsigned* st) {
    XcdBarrier b; b.bar = bar; b.x = xb_xcc_id(); b.st = st;
    if (threadIdx.x == 0) (void)xb_add(&bar[XB_XCNT(b.x)], 1u);
    return b;
}
__device__ __forceinline__ void xcd_barrier_complete(unsigned* bar, unsigned x, unsigned& nloc, unsigned& nx) {
    const unsigned G = gridDim.x * gridDim.y * gridDim.z;
    unsigned sum, cnt, mine, sp = 0u;
    for (;;) {
        sum = 0u; cnt = 0u; mine = 0u;
#pragma unroll
        for (unsigned j = 0; j < 16; ++j) { const unsigned c = xb_ld(&bar[XB_XCNT(j)]); sum += c; cnt += (c > 0u) ? 1u : 0u; mine = (j == x) ? c : mine; }
        if (sum == G) break;
        __builtin_amdgcn_s_sleep(1);
        if ((++sp & 255u) == 0u) { if (xb_ld(&bar[XB_TMO])) break; if (sp > XB_SPIN_CAP) { atomicAdd(&bar[XB_TMO], 1u); break; } }
    }
    nloc = mine > 0u ? mine : 1u; nx = cnt > 0u ? cnt : 1u;
}

__device__ __forceinline__ void xcd_barrier(const XcdBarrier& b) {
    asm volatile("s_waitcnt vmcnt(0)" ::: "memory");
    __syncthreads();
    if (threadIdx.x == 0) {
        unsigned* bar = b.bar;
        __builtin_amdgcn_s_waitcnt(0);
        unsigned nloc = b.st[0], nx = b.st[1];
        if (nloc == 0u) { xcd_barrier_complete(bar, b.x, nloc, nx); b.st[0] = nloc; b.st[1] = nx; }
        const unsigned old = xb_add(&bar[XB_XSUB(b.x)], 1u);
        const unsigned gen = old / nloc;
        if (old + 1u == (gen + 1u) * nloc) {
            __builtin_amdgcn_fence(__ATOMIC_RELEASE, "agent");
            asm volatile("s_waitcnt vmcnt(0)" ::: "memory");
            const unsigned og = xb_add(&bar[XB_TOP], 1u);
            const unsigned tg = og / nx;
            if (og + 1u == (tg + 1u) * nx) xb_add(&bar[XB_TOPGEN], 1u);
            else XB_SPIN(xb_ld(&bar[XB_TOPGEN]) == tg, bar);
            __builtin_amdgcn_fence(__ATOMIC_ACQUIRE, "agent");
            xb_add(&bar[XB_XGEN(b.x)], 1u);
            asm volatile("s_waitcnt vmcnt(0)" ::: "memory");
        } else {
            XB_SPIN(xb_ld(&bar[XB_XGEN(b.x)]) == gen, bar);
            __builtin_amdgcn_fence(__ATOMIC_ACQUIRE, "agent");
            asm volatile("s_waitcnt vmcnt(0)" ::: "memory");
        }
    }
    __syncthreads();
}
}
namespace pg8 {
#define PG8_LAS __attribute__((address_space(3)))
typedef unsigned short bf16_t;
typedef short bf16x8 __attribute__((ext_vector_type(8)));
typedef float f32x4 __attribute__((ext_vector_type(4)));
typedef unsigned u32x4 __attribute__((ext_vector_type(4)));
typedef unsigned u32x2 __attribute__((ext_vector_type(2)));
constexpr int BM = 256, BK = 64, HALF = 128, HTB = HALF * BK * 2  , STAGE_BYTES = 8 * HTB, NXCD = 8, WGM = 8;

__host__ __device__ __forceinline__ int lds_byte(int r, int c) { const int st = (r >> 4) * 2 + (c >> 5), rr = r & 15, cc = c & 31, ob = rr * 64 + cc * 2; return st * 1024 + (ob ^ (((ob >> 9) & 1) << 5)); }
__host__ __device__ __forceinline__ void stage_rc(int b, int& R, int& C) { const int st = b / 1024, sb = b % 1024, swz = sb ^ (((sb >> 9) & 1) << 5); R = (st >> 1) * 16 + swz / 64; C = (st & 1) * 32 + (swz % 64) / 2; }
__host__ __device__ __forceinline__ int perm32(int rho) { const int n = rho >> 4, i = rho & 15; return 8 * (i >> 2) + 4 * n + (i & 3); }

struct Unit { int pm, pn, aux0, aux1; };
struct Gemm { const bf16_t* A; const bf16_t* Bt; int M, N, K, lda, ldb, kstepA; };

struct StaticOrder {
    int nM, nN, nwg, G, c;
    __device__ void init(int M, int N, int G_, int c_) { nM = M / BM; nN = N / BM; nwg = nM * nN; G = G_; c = c_; }
    __device__ bool next(int i, Unit& u) const {
        const long L = (long)i * G + c; if (L >= nwg) return false;
        int wgid = (int)L; { const int q = nwg / NXCD, r = nwg % NXCD, xcd = wgid % NXCD, off = wgid / NXCD; wgid = (xcd < r ? xcd * (q + 1) : r * (q + 1) + (xcd - r) * q) + off; }
        const int nig = WGM * nN, gid = wgid / nig, fm = gid * WGM, gsz = (nM - fm) < WGM ? (nM - fm) : WGM;
        u.pm = fm + ((wgid % nig) % gsz); u.pn = (wgid % nig) / gsz; u.aux0 = 0; u.aux1 = 0;
        if (nN == 24 && gsz == WGM) u.pn = (u.pn & ~3) + ((u.pn + i) & 3);
        return true;
    }
    __device__ __forceinline__ const char* a_base(const Gemm& g, const Unit& u) const { return (const char*)g.A + (size_t)u.pm * BM * g.lda * 2; }
    __device__ __forceinline__ const char* b_base(const Gemm& g, const Unit& u) const { return (const char*)g.Bt + (size_t)u.pn * BM * g.ldb * 2; }
    __device__ __forceinline__ int a_row(const Unit&, int) const { return 0; }
};

typedef float f32x2_t __attribute__((ext_vector_type(2))); typedef __bf16 bf16x2_t __attribute__((ext_vector_type(2)));
__device__ __forceinline__ unsigned cvt_pk_bf16(float lo, float hi) { f32x2_t v = {lo, hi}; bf16x2_t b = __builtin_convertvector(v, bf16x2_t); return __builtin_bit_cast(unsigned, b); }


template <class Epi, class Sched, bool ALIGN_EPI = true, bool GATHER = false, bool MIDK = false>
__device__ __forceinline__ void gemm_phase(PG8_LAS unsigned char* lds, const Gemm g, const Sched& S, const Epi& E, const float* rsc = nullptr) {
    int tid_ = threadIdx.x; asm volatile("" : "+v"(tid_));
    const int tid = tid_, wid = __builtin_amdgcn_readfirstlane(tid >> 6), lane = tid & 63, wr = wid >> 2, wc = wid & 3, fr = lane & 15, fq = lane >> 4;
    const int K = g.K, nt = K / BK;
    unsigned voffA[2], voffA1[2], voffB[2];
    int RA[2], CA[2];
#pragma unroll
    for (int i = 0; i < 2; ++i) { int R, C; stage_rc(tid * 16 + i * 8192, R, C); const int Rb = Epi::PERM ? ((R & ~31) + perm32(R & 31)) : R;
        RA[i] = R; CA[i] = C; voffA[i] = (unsigned)(R * g.lda + C) * 2u; voffA1[i] = voffA[i]; voffB[i] = (unsigned)(Rb * g.ldb + C) * 2u; }
    const size_t kstep = (size_t)(BK * 2);
    const size_t kstepA = (size_t)g.kstepA;
    const size_t hstepA = GATHER ? (size_t)0 : (size_t)HALF * g.lda * 2;
    const size_t hstepB = (size_t)HALF * g.ldb * 2;
    const unsigned ldsw = (unsigned)wid * 1024u;
    const int aoff = lds_byte(wr * 64 + fr, fq * 8), boff = lds_byte(wc * 32 + fr, fq * 8);
#define PG8_SA(b, h) (((b) * 2 + (h)) * HTB)
#define PG8_SB(b, h) ((4 + (b) * 2 + (h)) * HTB)
#define PG8_STAGE(bufoff, gbase, voff) do { _Pragma("unroll") for (int _i = 0; _i < 2; ++_i) \
        __builtin_amdgcn_global_load_lds((const unsigned*)((const char*)(gbase) + (voff)[_i]), (PG8_LAS unsigned*)(lds + (bufoff) + ldsw + _i * 8192), 16, 0, 0); } while (0)
#define PG8_STAGE_A0(bufoff, gbase) PG8_STAGE(bufoff, gbase, voffA)
#define PG8_STAGE_A1(bufoff, gbase) do { if constexpr (GATHER) { PG8_STAGE(bufoff, gbase, voffA1); } else { PG8_STAGE(bufoff, (gbase) + hstepA, voffA); } } while (0)
#define PG8_LDA(dst, b, h) do { _Pragma("unroll") for (int m = 0; m < 4; ++m) _Pragma("unroll") for (int k = 0; k < 2; ++k) dst[m][k] = *(const PG8_LAS bf16x8*)(lds + PG8_SA(b, h) + aoff + m * 2048 + k * 1024); } while (0)
#define PG8_LDB(dst, b, h) do { _Pragma("unroll") for (int n = 0; n < 2; ++n) _Pragma("unroll") for (int k = 0; k < 2; ++k) dst[n][k] = *(const PG8_LAS bf16x8*)(lds + PG8_SB(b, h) + boff + n * 2048 + k * 1024); } while (0)
#define PG8_MMA(ai, bj, At, Bt) do { __builtin_amdgcn_s_setprio(1); _Pragma("unroll") for (int m = 0; m < 4; ++m) _Pragma("unroll") for (int n = 0; n < 2; ++n) _Pragma("unroll") for (int k = 0; k < 2; ++k) \
        acc[ai][bj][m][n] = __builtin_amdgcn_mfma_f32_16x16x32_bf16(Bt[n][k], At[m][k], acc[ai][bj][m][n], 0, 0, 0); __builtin_amdgcn_s_setprio(0); } while (0)
#define PG8_WAIT_V(n) asm volatile("s_waitcnt vmcnt(" #n ")" ::: "memory")
#define PG8_WAIT_L(n) asm volatile("s_waitcnt lgkmcnt(" #n ")" ::: "memory")
#define PG8_BAR __builtin_amdgcn_s_barrier()
#define PG8_SCHED __builtin_amdgcn_sched_barrier(0)
    Unit cur, nxt; int ui = 0;
    if (!S.next(0, cur)) return;
    if constexpr (GATHER) {
#pragma unroll
        for (int i = 0; i < 2; ++i) { voffA[i] = (unsigned)(S.a_row(cur, RA[i]) * g.lda + CA[i]) * 2u; voffA1[i] = (unsigned)(S.a_row(cur, HALF + RA[i]) * g.lda + CA[i]) * 2u; }
    }
    f32x4 acc[2][2][4][2];
#pragma unroll
    for (int a = 0; a < 2; ++a)
#pragma unroll
        for (int b = 0; b < 2; ++b)
#pragma unroll
            for (int m = 0; m < 4; ++m)
#pragma unroll
                for (int n = 0; n < 2; ++n) acc[a][b][m][n] = (f32x4){0.f, 0.f, 0.f, 0.f};
    bf16x8 At[4][2], B0[2][2], B1[2][2];
    const char* cA = S.a_base(g, cur); const char* cB = S.b_base(g, cur);
    PG8_STAGE(PG8_SB(0, 0), cB, voffB); PG8_STAGE(PG8_SB(0, 1), cB + hstepB, voffB); PG8_STAGE_A0(PG8_SA(0, 0), cA); PG8_STAGE_A1(PG8_SA(0, 1), cA);
    if (wr == 1) PG8_BAR;
    PG8_WAIT_V(2); PG8_BAR;
    PG8_STAGE(PG8_SB(1, 0), cB + kstep, voffB); PG8_STAGE_A0(PG8_SA(1, 0), cA + kstepA); PG8_STAGE(PG8_SB(1, 1), cB + hstepB + kstep, voffB);
    PG8_WAIT_V(6); PG8_BAR;
    for (;;) {
        const bool has_next = GATHER ? false : S.next(ui + 1, nxt);
        const char* nA = has_next ? S.a_base(g, nxt) : cA; const char* nB = has_next ? S.b_base(g, nxt) : cB;
#pragma unroll 1
        for (int t = 0; t < nt; t += 2) {
            if constexpr (MIDK) { if (t == (nt >> 1)) { int fr_ = fr; asm volatile("" : "+v"(fr_));
#pragma unroll
                for (int ai = 0; ai < 2; ++ai)
#pragma unroll
                    for (int m = 0; m < 4; ++m) { const float* rp = rsc + (size_t)(cur.pm * BM + ai * HALF + wr * 64 + m * 16 + fr_) * 16; const __attribute__((address_space(1))) float* rg = (const __attribute__((address_space(1))) float*)rp; const float ratio = rg[0] * __builtin_amdgcn_rcpf(rg[8]);
#pragma unroll
                        for (int bj = 0; bj < 2; ++bj)
#pragma unroll
                            for (int n = 0; n < 2; ++n) acc[ai][bj][m][n] = acc[ai][bj][m][n] * ratio;
                        asm volatile("" ::: "memory"); } } }
            const bool last = (t == nt - 2);
            const char* a1 = cA + (size_t)(t + 1) * kstepA;
            const char* a2 = last ? nA : cA + (size_t)(t + 2) * kstepA; const char* b2 = last ? nB : cB + (size_t)(t + 2) * kstep;
            const char* a3 = a2 + kstepA; const char* b3 = b2 + kstep;
            PG8_LDB(B0, 0, 0); PG8_LDB(B1, 0, 1); PG8_SCHED; PG8_LDA(At, 0, 0); PG8_STAGE_A1(PG8_SA(1, 1), a1);
            PG8_WAIT_V(8); PG8_WAIT_L(0); PG8_BAR; PG8_MMA(0, 0, At, B0); PG8_MMA(0, 1, At, B1); PG8_BAR; PG8_SCHED;
            PG8_LDA(At, 0, 1); PG8_STAGE(PG8_SB(0, 0), b2, voffB); PG8_STAGE(PG8_SB(0, 1), b2 + hstepB, voffB); PG8_STAGE_A0(PG8_SA(0, 0), a2);
            PG8_WAIT_V(8); PG8_WAIT_L(0); PG8_BAR; PG8_MMA(1, 0, At, B0); PG8_MMA(1, 1, At, B1); PG8_BAR; PG8_SCHED;
            PG8_LDB(B0, 1, 0); PG8_LDB(B1, 1, 1); PG8_SCHED; PG8_LDA(At, 1, 0); PG8_STAGE_A1(PG8_SA(0, 1), a2);
            PG8_WAIT_V(8); PG8_WAIT_L(0); PG8_BAR; PG8_MMA(0, 0, At, B0); PG8_MMA(0, 1, At, B1); PG8_BAR; PG8_SCHED;
            PG8_LDA(At, 1, 1); PG8_STAGE(PG8_SB(1, 0), b3, voffB); PG8_STAGE(PG8_SB(1, 1), b3 + hstepB, voffB); PG8_STAGE_A0(PG8_SA(1, 0), a3);
            PG8_WAIT_V(8); PG8_WAIT_L(0); PG8_BAR; PG8_MMA(1, 0, At, B0); PG8_MMA(1, 1, At, B1); PG8_BAR; PG8_SCHED;
        }
        if constexpr (ALIGN_EPI) { if (wr == 0) PG8_BAR; }
        E(acc, cur, wr, wc, fr, fq);
        if (!has_next) break;
#pragma unroll
        for (int a = 0; a < 2; ++a)
#pragma unroll
            for (int b = 0; b < 2; ++b)
#pragma unroll
                for (int m = 0; m < 4; ++m)
#pragma unroll
                    for (int n = 0; n < 2; ++n) acc[a][b][m][n] = (f32x4){0.f, 0.f, 0.f, 0.f};
        cur = nxt; cA = nA; cB = nB; ++ui;
        if constexpr (ALIGN_EPI) { if (wr == 1) PG8_BAR; }
    }
    PG8_WAIT_V(0);
    if constexpr (!ALIGN_EPI) { if (wr == 0) PG8_BAR; }
    PG8_BAR;
#undef PG8_SA
#undef PG8_SB
#undef PG8_STAGE
#undef PG8_STAGE_A0
#undef PG8_STAGE_A1
#undef PG8_LDA
#undef PG8_LDB
#undef PG8_MMA
#undef PG8_WAIT_V
#undef PG8_WAIT_L
#undef PG8_BAR
#undef PG8_SCHED
}
}
namespace fx {
using nv::u16; using nv::Bufs; using nv::Inputs;
using pg8::f32x4; using pg8::u32x4; using pg8::Unit;
#define LAS __attribute__((address_space(3)))
static_assert(nv::DM == 1024 && nv::NB == 8 && nv::S == 4096 && nv::MH == 256 && nv::PLE == 256, "fast phases are written for the full-size problem");
constexpr int NTOK = nv::NTOK, DM = 1024;
constexpr int INW_PAD = 6144;
constexpr int C_Z = 1280, C_XBC = 2304, C_BG = 3840, C_NG = 5888, C_NGE = 5912, C_DT = 5920, C_END = 5936;

struct WBufs { u16 *WinT, *WaT, *WbT, *WoutT, *PleGT, *PlePT, *WguT, *WdT, *PB; };
__host__ __device__ inline size_t carve_w(WBufs& W, unsigned char* ws, size_t off) {
  auto take = [&](size_t bytes) { unsigned char* r = ws + off; off += (bytes + 255) / 256 * 256; return r; };
  W.WinT = (u16*)take((size_t)INW_PAD * 1024 * 2); W.WaT = (u16*)take((size_t)1024 * 512 * 2); W.WbT = (u16*)take((size_t)1024 * 1024 * 2); W.WoutT = (u16*)take((size_t)1024 * 1024 * 2);
  W.PleGT = (u16*)take((size_t)1024 * 1024 * 2); W.PlePT = (u16*)take((size_t)1024 * 256 * 2); W.WguT = (u16*)take((size_t)32 * 512 * 1024 * 2); W.WdT = (u16*)take((size_t)32 * 1024 * 256 * 2);
  W.PB = (u16*)take((size_t)NTOK * 256 * 2);
  return off;
}

__device__ __forceinline__ int otid() { int t = threadIdx.x; asm volatile("" : "+v"(t)); return t; }
__device__ __forceinline__ int obid() { int b = blockIdx.x; asm volatile("" : "+s"(b)); return b; }
__device__ __forceinline__ float fsig(float x) { return __builtin_amdgcn_rcpf(1.0f + __expf(-x)); }
__device__ __forceinline__ float fsoftplus(float x) { const float e = __expf(x); return x > 20.f ? x : (e < 0.0625f ? e * (1.f - e * (0.5f - e * (0.33333333f - 0.25f * e))) : __logf(1.0f + e)); }
__device__ __forceinline__ unsigned pk2(float lo, float hi) { return pg8::cvt_pk_bf16(lo, hi); }
#define GAS __attribute__((address_space(1)))
template <class T> __device__ __forceinline__ T gld(const void* p) { return *(const GAS T*)p; }
template <class T> __device__ __forceinline__ void gst(void* p, const T v) { *(GAS T*)p = v; }
__device__ __forceinline__ void store8(u16* p, const float (&v)[8]) { u32x4 w; w.x = pk2(v[0], v[1]); w.y = pk2(v[2], v[3]); w.z = pk2(v[4], v[5]); w.w = pk2(v[6], v[7]); gst<u32x4>(p, w); }
__device__ __forceinline__ void load8(const u16* p, float (&v)[8]) { const u32x4 w = *(const u32x4*)p;
  v[0] = __uint_as_float(w.x << 16); v[1] = __uint_as_float(w.x & 0xffff0000u); v[2] = __uint_as_float(w.y << 16); v[3] = __uint_as_float(w.y & 0xffff0000u);
  v[4] = __uint_as_float(w.z << 16); v[5] = __uint_as_float(w.z & 0xffff0000u); v[6] = __uint_as_float(w.w << 16); v[7] = __uint_as_float(w.w & 0xffff0000u); }

__device__ __forceinline__ float wave_sum(float v) {
#pragma unroll
  for (int o = 1; o < 64; o <<= 1) v += __shfl_xor(v, o);
  return v; }
__device__ __forceinline__ void rms_row_to_bf16(const float* xrow, const float* gain, u16* orow, int lane) {
  const f32x4* xr = (const f32x4*)xrow + lane; const f32x4* gr = (const f32x4*)gain + lane;
  f32x4 v[4]; float s = 0.f;
#pragma unroll
  for (int j = 0; j < 4; ++j) { v[j] = xr[64 * j]; s += (v[j].x * v[j].x + v[j].y * v[j].y) + (v[j].z * v[j].z + v[j].w * v[j].w); }
  const float rs = 1.0f / sqrtf(wave_sum(s) * (1.f / 1024.f) + nv::EPS);
  unsigned long long* o8 = (unsigned long long*)orow + lane;
#pragma unroll
  for (int j = 0; j < 4; ++j) { const f32x4 g = gr[64 * j]; o8[64 * j] = (unsigned long long)pk2(v[j].x * rs * g.x, v[j].y * rs * g.y) | ((unsigned long long)pk2(v[j].z * rs * g.z, v[j].w * rs * g.w) << 32); }
}
__device__ __forceinline__ void phase_rms_rows(const float* x, const float* gain, u16* out) {
  const int tid = otid(), lane = tid & 63, gw = obid() * 8 + (tid >> 6), ngw = gridDim.x * 8;
  for (int r = gw; r < NTOK; r += 4 * ngw) { f32x4 v[4][4]; float s[4];
#pragma unroll
    for (int q = 0; q < 4; ++q) { const int rq = (r + q * ngw < NTOK) ? r + q * ngw : r; const f32x4* xr = (const f32x4*)(x + (size_t)rq * 1024) + lane;
#pragma unroll
      for (int j = 0; j < 4; ++j) v[q][j] = xr[64 * j]; }
#pragma unroll
    for (int q = 0; q < 4; ++q) { s[q] = 0.f;
#pragma unroll
      for (int j = 0; j < 4; ++j) s[q] += (v[q][j].x * v[q][j].x + v[q][j].y * v[q][j].y) + (v[q][j].z * v[q][j].z + v[q][j].w * v[q][j].w);
      s[q] = 1.0f / sqrtf(wave_sum(s[q]) * (1.f / 1024.f) + nv::EPS); }
#pragma unroll
    for (int q = 0; q < 4; ++q) { if (r + q * ngw >= NTOK) break; unsigned long long* o8 = (unsigned long long*)(out + (size_t)(r + q * ngw) * 1024) + lane; const f32x4* gr = (const f32x4*)gain + lane;
#pragma unroll
      for (int j = 0; j < 4; ++j) { const f32x4 g = gr[64 * j]; o8[64 * j] = (unsigned long long)pk2(v[q][j].x * s[q] * g.x, v[q][j].y * s[q] * g.y) | ((unsigned long long)pk2(v[q][j].z * s[q] * g.z, v[q][j].w * s[q] * g.w) << 32); } } }
}
template <class CP> __device__ __forceinline__ void transpose_item(LAS float* scr, const CP cp, u16* dst, int K, int n0, int k0, int lane) {
  { const float* p = cp(n0 + (lane & 31));
#pragma unroll 8
    for (int i = 0; i < 32; ++i) { const int kk = 2 * i + (lane >> 5); scr[kk * 33 + (lane & 31)] = p ? p[(size_t)(k0 + kk) * cp.ld] : 0.f; } }
  asm volatile("s_waitcnt lgkmcnt(0)" ::: "memory");
  const int c = lane & 7;
#pragma unroll
  for (int j = 0; j < 4; ++j) { const int n = (lane >> 3) + 8 * j; const LAS float* s = scr + (8 * c) * 33 + n;
    u32x4 o; o.x = pk2(s[0 * 33], s[1 * 33]); o.y = pk2(s[2 * 33], s[3 * 33]); o.z = pk2(s[4 * 33], s[5 * 33]); o.w = pk2(s[6 * 33], s[7 * 33]);
    *(u32x4*)(dst + (size_t)(n0 + n) * K + k0 + 8 * c) = o; }
  asm volatile("s_waitcnt lgkmcnt(0)" ::: "memory");
}
struct CpIdent { const float* src; int ld; __device__ const float* operator()(int n) const { return src + n; } };
struct CpInProj { const float* src; int ld; __device__ const float* operator()(int n) const {
  int c; if (n < C_Z) c = n; else if (n < C_XBC) c = nv::O_Z + (n - C_Z); else if (n < C_BG) c = nv::O_XBC + (n - C_XBC); else if (n < C_NG) c = nv::O_BG + (n - C_BG); else if (n < C_NGE) c = nv::O_NG + (n - C_NG); else if (n < C_DT) return nullptr; else if (n < C_END) c = nv::O_DT + (n - C_DT); else return nullptr;
  return src + c; } };
struct CpGU { const float* gate; long updelta; int ld; __device__ const float* operator()(int n) const { const int tile = n >> 8, r = n & 255; return gate + (r < 128 ? 0L : updelta) + tile * 128 + (r & 127); } };

struct WJob { const float* src; int ld; u16* dst; int K, n0, k0; const float* gk; };
__device__ __forceinline__ WJob wjob_decode(int t, const Inputs& I, const WBufs& W, u16* wct, int lane) {
  constexpr int T_IN = (INW_PAD / 32) * 16, T_A = 32 * 8, T_B = 32 * 16, T_O = 32 * 16, T_PG = 32 * 16, T_PP = 32 * 4, T_GU = 32 * 16 * 16;
  WJob j; j.gk = nullptr; int r = t; const int c = lane & 31;
  if (r < T_IN) { CpInProj cp{I.w_in, nv::INW}; j.n0 = (r / 16) * 32; j.k0 = (r % 16) * 64; j.src = cp(j.n0 + c); j.ld = nv::INW; j.dst = W.WinT; j.K = 1024; return j; } r -= T_IN;
  if (r < T_A) { j.n0 = (r / 8) * 32; j.k0 = (r % 8) * 64; j.src = I.w_a + j.n0 + c; j.ld = 1024; j.dst = W.WaT; j.K = 512; return j; } r -= T_A;
  if (r < T_B) { j.n0 = (r / 16) * 32; j.k0 = (r % 16) * 64; j.src = I.w_b + j.n0 + c; j.ld = 1024; j.dst = W.WbT; j.K = 1024; j.gk = I.ssm_norm; return j; } r -= T_B;
  if (r < T_O) { j.n0 = (r / 16) * 32; j.k0 = (r % 16) * 64; j.src = I.w_out + j.n0 + c; j.ld = 1024; j.dst = W.WoutT; j.K = 1024; return j; } r -= T_O;
  if (r < T_PG) { j.n0 = (r / 16) * 32; j.k0 = (r % 16) * 64; j.src = I.ple_wg + j.n0 + c; j.ld = 1024; j.dst = W.PleGT; j.K = 1024; j.gk = I.ple_norm; return j; } r -= T_PG;
  if (r < T_PP) { j.n0 = (r / 4) * 32; j.k0 = (r % 4) * 64; j.src = I.ple_wp + j.n0 + c; j.ld = 1024; j.dst = W.PlePT; j.K = 256; return j; } r -= T_PP;
  if (r < T_GU) { const int e = r / 256, q = r % 256; CpGU cp{I.w_gate + (size_t)e * 1024 * 256, (long)(I.w_up - I.w_gate), 256}; j.n0 = (q / 16) * 32; j.k0 = (q % 16) * 64; j.src = cp(j.n0 + c); j.ld = 256; j.dst = W.WguT + (size_t)e * 512 * 1024; j.K = 1024; j.gk = I.moe_norm; return j; } r -= T_GU;
  if (r < 32 * 32 * 4) { const int e = r / 128, q = r % 128; j.n0 = (q / 4) * 32; j.k0 = (q % 4) * 64; j.src = I.w_down + (size_t)e * 256 * 1024 + j.n0 + c; j.ld = 1024; j.dst = W.WdT + (size_t)e * 1024 * 256; j.K = 256; return j; } r -= 32 * 32 * 4;
  { const int kv = r >> 7, q = r & 127; j.n0 = (q >> 4) * 32; j.k0 = (q & 15) * 64; const int n = j.n0 + c; j.src = (kv ? I.w1_v : I.w1_k) + (n < 128 ? n : 1024 * 128 + (n - 128)); j.ld = 128; j.dst = wct + (size_t)kv * 256 * 1024; j.K = 1024; return j; }
}
__device__ __forceinline__ void phase_prologue(LAS unsigned char* lds, const Inputs& I, const Bufs& B, const WBufs& W, u16* wct) {
  const int tid = otid(), lane = tid & 63, wv = tid >> 6, gw = obid() * 8 + wv, ngw = gridDim.x * 8;
  LAS float* scr = (LAS float*)lds + wv * (64 * 33);
  constexpr int TOT = (INW_PAD / 32) * 16 + 32 * 8 + 32 * 16 * 3 + 32 * 4 + 32 * 16 * 16 + 32 * 32 * 4 + 2 * 8 * 16;
  float cur[32]; float gc[8];
  int t = gw; WJob jb;
#define FX_GLOAD(job, g_) do { if ((job).gk) { const f32x4 a_ = *(const f32x4*)((job).gk + (job).k0 + 8 * (lane & 7)), b_ = *(const f32x4*)((job).gk + (job).k0 + 8 * (lane & 7) + 4); \
      g_[0] = a_.x; g_[1] = a_.y; g_[2] = a_.z; g_[3] = a_.w; g_[4] = b_.x; g_[5] = b_.y; g_[6] = b_.z; g_[7] = b_.w; } else { _Pragma("unroll") for (int i_ = 0; i_ < 8; ++i_) g_[i_] = 1.0f; } } while (0)
  if (t < TOT) { jb = wjob_decode(t, I, W, wct, lane); FX_GLOAD(jb, gc);
#pragma unroll
    for (int i = 0; i < 32; ++i) cur[i] = jb.src ? jb.src[(size_t)(jb.k0 + 2 * i + (lane >> 5)) * jb.ld] : 0.f; }
  while (t < TOT) { const int tn = t + ngw; WJob jn = jb; float nxt[32]; float gn[8];
#pragma unroll
    for (int i = 0; i < 8; ++i) gn[i] = 1.0f;
    if (tn < TOT) { jn = wjob_decode(tn, I, W, wct, lane); FX_GLOAD(jn, gn);
#pragma unroll
      for (int i = 0; i < 32; ++i) nxt[i] = jn.src ? jn.src[(size_t)(jn.k0 + 2 * i + (lane >> 5)) * jn.ld] : 0.f; }
#pragma unroll
    for (int i = 0; i < 32; ++i) scr[(2 * i + (lane >> 5)) * 33 + (lane & 31)] = cur[i];
    asm volatile("s_waitcnt lgkmcnt(0)" ::: "memory");
    { const int c = lane & 7;
#pragma unroll
      for (int j = 0; j < 4; ++j) { const int n = (lane >> 3) + 8 * j; const LAS float* s = scr + (8 * c) * 33 + n;
        u32x4 o; o.x = pk2(s[0 * 33] * gc[0], s[1 * 33] * gc[1]); o.y = pk2(s[2 * 33] * gc[2], s[3 * 33] * gc[3]); o.z = pk2(s[4 * 33] * gc[4], s[5 * 33] * gc[5]); o.w = pk2(s[6 * 33] * gc[6], s[7 * 33] * gc[7]);
        *(u32x4*)(jb.dst + (size_t)(jb.n0 + n) * jb.K + jb.k0 + 8 * c) = o; } }
    asm volatile("s_waitcnt lgkmcnt(0)" ::: "memory");
    if (tn < TOT) {
#pragma unroll
      for (int i = 0; i < 32; ++i) cur[i] = nxt[i];
#pragma unroll
      for (int i = 0; i < 8; ++i) gc[i] = gn[i]; }
    jb = jn; t = tn; }
#undef FX_GLOAD
}
__device__ __forceinline__ void prologue_pb(const Inputs& I, const WBufs& W) {
  for (long i = blockIdx.x * 512L + otid(); i < (long)NTOK * 256 / 8; i += (long)gridDim.x * 512L) { const f32x4 a = ((const f32x4*)I.p)[2 * i], b = ((const f32x4*)I.p)[2 * i + 1];
    u32x4 o; o.x = pk2(a.x, a.y); o.y = pk2(a.z, a.w); o.z = pk2(b.x, b.y); o.w = pk2(b.z, b.w); ((u32x4*)W.PB)[i] = o; }
}

template <class F> struct Epi8 { static constexpr bool PERM = true; F f;
  __device__ __forceinline__ void operator()(const f32x4 (&acc)[2][2][4][2], const Unit& u, int wr, int wc, int fr, int fq) const {
    if constexpr (F::HAS_PRE) {
      typename F::Pre P[9][2];
#pragma unroll
      for (int bj = 0; bj < 2; ++bj) P[0][bj] = f.pre(u, u.pm * 256 + wr * 64 + fr, u.pn * 256 + bj * 128 + wc * 32 + 8 * fq);
#pragma unroll
      for (int b = 0; b < 8; ++b) { const int ai = b >> 2, m = b & 3, row = u.pm * 256 + ai * 128 + wr * 64 + m * 16 + fr;
        if (b + 1 < 8) { const int rown = u.pm * 256 + ((b + 1) >> 2) * 128 + wr * 64 + ((b + 1) & 3) * 16 + fr;
#pragma unroll
          for (int bj = 0; bj < 2; ++bj) P[b + 1][bj] = f.pre(u, rown, u.pn * 256 + bj * 128 + wc * 32 + 8 * fq); }
#pragma unroll
        for (int bj = 0; bj < 2; ++bj) { const int col = u.pn * 256 + bj * 128 + wc * 32 + 8 * fq; const f32x4 a = acc[ai][bj][m][0], bb = acc[ai][bj][m][1];
          const float v[8] = {a.x, a.y, a.z, a.w, bb.x, bb.y, bb.z, bb.w}; f(u, row, col, v, P[b][bj]); } }
    } else {
#pragma unroll
      for (int ai = 0; ai < 2; ++ai)
#pragma unroll
        for (int m = 0; m < 4; ++m) { const int row = u.pm * 256 + ai * 128 + wr * 64 + m * 16 + fr;
#pragma unroll
          for (int bj = 0; bj < 2; ++bj) { const int col = u.pn * 256 + bj * 128 + wc * 32 + 8 * fq; const f32x4 a = acc[ai][bj][m][0], b = acc[ai][bj][m][1];
            const float v[8] = {a.x, a.y, a.z, a.w, b.x, b.y, b.z, b.w}; f(u, row, col, v); }
          if (m & 1) asm volatile("" ::: "memory"); } } } };

struct FInProj { static constexpr bool HAS_PRE = false; u16* QKV; u16* Z; u16* XBC; u16* BG; float* NG; float* DT; const float* dt_bias;
  __device__ __forceinline__ void operator()(const Unit&, int r, int c, const float (&v)[8]) const {
    if (c < C_Z) store8(QKV + (size_t)r * 1280 + c, v);
    else if (c < C_XBC) store8(Z + (size_t)r * 1024 + (c - C_Z), v);
    else if (c < C_BG) store8(XBC + (size_t)r * 1536 + (c - C_XBC), v);
    else if (c < C_NG) { float s[8];
#pragma unroll
      for (int i = 0; i < 8; ++i) s[i] = fsig(v[i]);
      store8(BG + (size_t)r * 2048 + (c - C_BG), s); }
    else if (c < C_NGE) { float* o = NG + (size_t)r * 24 + (c - C_NG); float s[8];
#pragma unroll
      for (int i = 0; i < 8; ++i) s[i] = fsig(v[i]);
      gst<f32x4>(o, (f32x4){s[0], s[1], s[2], s[3]}); gst<f32x4>(o + 4, (f32x4){s[4], s[5], s[6], s[7]}); }
    else if (c >= C_DT && c < C_END) { float* o = DT + (size_t)r * 16 + (c - C_DT); const __attribute__((address_space(4))) float* bq = (const __attribute__((address_space(4))) float*)dt_bias; const bool hi8 = (c - C_DT) >= 8; float s[8];
#pragma unroll
      for (int i = 0; i < 8; ++i) { const float blo = bq[i], bhi = bq[8 + i]; s[i] = fsoftplus(v[i] + (hi8 ? bhi : blo)); }
      gst<f32x4>(o, (f32x4){s[0], s[1], s[2], s[3]}); gst<f32x4>(o + 4, (f32x4){s[4], s[5], s[6], s[7]}); } } };
struct FStoreBf { static constexpr bool HAS_PRE = false; u16* o; int ld; __device__ __forceinline__ void operator()(const Unit&, int r, int c, const float (&v)[8]) const { store8(o + (size_t)r * ld + c, v); } };
__device__ __forceinline__ void unpack8(const u32x4 w, float (&v)[8]) {
  v[0] = __uint_as_float(w.x << 16); v[1] = __uint_as_float(w.x & 0xffff0000u); v[2] = __uint_as_float(w.y << 16); v[3] = __uint_as_float(w.y & 0xffff0000u);
  v[4] = __uint_as_float(w.z << 16); v[5] = __uint_as_float(w.z & 0xffff0000u); v[6] = __uint_as_float(w.w << 16); v[7] = __uint_as_float(w.w & 0xffff0000u); }
struct FMerge { static constexpr bool HAS_PRE = true; const u16* t1; const u16* bg; u16* o; const float* rsc;
  struct Pre { u32x4 t, ga, gb; float r1; };
  __device__ __forceinline__ Pre pre(const Unit&, int r, int c) const { Pre p; p.t = gld<u32x4>(t1 + (size_t)r * 1024 + c); p.ga = gld<u32x4>(bg + (size_t)r * 2048 + c); p.gb = gld<u32x4>(bg + (size_t)r * 2048 + 1024 + c); p.r1 = gld<float>(rsc + (size_t)r * 16 + 8); return p; }
  __device__ __forceinline__ void operator()(const Unit&, int r, int c, const float (&v)[8], const Pre& p) const { float t[8], ga[8], gb[8], m[8]; unpack8(p.t, t); unpack8(p.ga, ga); unpack8(p.gb, gb);
#pragma unroll
    for (int i = 0; i < 8; ++i) m[i] = ga[i] * t[i] + gb[i] * (v[i] * p.r1);
    store8(o + (size_t)r * 1024 + c, m); } };
struct FResid { static constexpr bool HAS_PRE = true; const float* x; u16* o;
  struct Pre { f32x4 a, b; };
  __device__ __forceinline__ Pre pre(const Unit&, int r, int c) const { Pre p; p.a = gld<f32x4>(x + (size_t)r * 1024 + c); p.b = gld<f32x4>(x + (size_t)r * 1024 + c + 4); return p; }
  __device__ __forceinline__ void operator()(const Unit&, int r, int c, const float (&v)[8], const Pre& p) const {
    const float t[8] = {p.a.x + v[0], p.a.y + v[1], p.a.z + v[2], p.a.w + v[3], p.b.x + v[4], p.b.y + v[5], p.b.z + v[6], p.b.w + v[7]}; store8(o + (size_t)r * 1024 + c, t); } };
struct FPle { static constexpr bool HAS_PRE = true; const u16* x2; float* o; const u16* pp; const float* rs;
  struct Pre { u32x4 p, x; float s; };
  __device__ __forceinline__ Pre pre(const Unit&, int r, int c) const { Pre q; q.p = gld<u32x4>(pp + (size_t)r * 1024 + c); q.x = gld<u32x4>(x2 + (size_t)r * 1024 + c); q.s = gld<float>(rs + r); return q; }
  __device__ __forceinline__ void operator()(const Unit&, int r, int c, const float (&v)[8], const Pre& q) const { float p[8], x[8]; unpack8(q.p, p); unpack8(q.x, x); float* xp = o + (size_t)r * 1024 + c; const float s = q.s;
    gst<f32x4>(xp, (f32x4){x[0] + fsig(s * v[0]) * p[0], x[1] + fsig(s * v[1]) * p[1], x[2] + fsig(s * v[2]) * p[2], x[3] + fsig(s * v[3]) * p[3]});
    gst<f32x4>(xp + 4, (f32x4){x[4] + fsig(s * v[4]) * p[4], x[5] + fsig(s * v[5]) * p[5], x[6] + fsig(s * v[6]) * p[6], x[7] + fsig(s * v[7]) * p[7]}); } };

template <class F, bool ALIGN = true, bool MIDK = false> __device__ __forceinline__ void dense_gemm(LAS unsigned char* lds, const u16* A, int lda, const u16* Bt, int ldb, int M, int N, int K, const F& f, const float* rsc = nullptr) {
  pg8::Gemm g{A, Bt, M, N, K, lda, ldb, 128}; pg8::StaticOrder S; S.init(M, N, (int)gridDim.x, (int)blockIdx.x); Epi8<F> E{f};
  pg8::gemm_phase<Epi8<F>, pg8::StaticOrder, ALIGN, false, MIDK>(lds, g, S, E, rsc);
}
}
namespace fx {
constexpr int LIST_CAP = 32768;
constexpr int LDS_TAB = 131072;
struct MoeBufs { float* LOGITS; int* CNT; int* LIST; int* ASG; u16* MOEOUT; u16* WrT; float* SSQ; };
__host__ __device__ inline size_t carve_moe(MoeBufs& M, const Bufs& B, unsigned char* ws, size_t off) {
  auto take = [&](size_t bytes) { unsigned char* r = ws + off; off += (bytes + 255) / 256 * 256; return r; };
  M.LOGITS = (float*)take((size_t)NTOK * 64 * 4); M.CNT = (int*)take(32 * 256); M.LIST = (int*)take((size_t)32 * LIST_CAP * 4); M.WrT = (u16*)take((size_t)256 * 1024 * 2); M.ASG = (int*)take((size_t)NTOK * 2 * 4); M.SSQ = (float*)take((size_t)NTOK * 4);
  M.MOEOUT = B.QKV;
  return off;
}
__device__ __forceinline__ void prologue_moe(const Inputs& I, const MoeBufs& M) {
  for (long i = blockIdx.x * 512L + otid(); i < 256L * 1024; i += (long)gridDim.x * 512L) { const int n = (int)(i >> 10), k = (int)(i & 1023);
    float v = 0.f; if (n < 4) v = I.w_group[k * 4 + n]; else if (n < 36) v = I.w_expert[k * 32 + (n - 4)];
    M.WrT[i] = nv::f2bf(v * I.moe_norm[k]); }
  if (blockIdx.x == 0 && threadIdx.x < 32) M.CNT[threadIdx.x * 64] = 0;
}
struct FLogits { static constexpr bool HAS_PRE = false; float* o; __device__ __forceinline__ void operator()(const Unit&, int r, int c, const float (&v)[8]) const { if (c < 40) { *(f32x4*)(o + (size_t)r * 64 + c) = (f32x4){v[0], v[1], v[2], v[3]}; *(f32x4*)(o + (size_t)r * 64 + c + 4) = (f32x4){v[4], v[5], v[6], v[7]}; } } };
__device__ __forceinline__ void phase_row_rstd(const u16* x1, float* rsout, int wg0) {
  const int nw = ((int)gridDim.x - wg0) * 8; if ((int)blockIdx.x < wg0 || nw <= 0) return;
  const int tid = otid(), lane = tid & 63, gw = ((int)blockIdx.x - wg0) * 8 + (tid >> 6);
#pragma unroll 1
  for (int r = gw; r < NTOK; r += 4 * nw) { u32x4 w[4][2];
#pragma unroll
    for (int q = 0; q < 4; ++q) { const int rq = (r + q * nw < NTOK) ? r + q * nw : r; const u32x4* xr = (const u32x4*)(x1 + (size_t)rq * 1024) + lane; w[q][0] = xr[0]; w[q][1] = xr[64]; }
#pragma unroll
    for (int q = 0; q < 4; ++q) { float ss = 0.f;
#pragma unroll
      for (int j = 0; j < 2; ++j) { const unsigned e[4] = {w[q][j].x, w[q][j].y, w[q][j].z, w[q][j].w};
#pragma unroll
        for (int i2 = 0; i2 < 4; ++i2) { const float lo = __uint_as_float(e[i2] << 16), hi = __uint_as_float(e[i2] & 0xffff0000u); ss += lo * lo + hi * hi; } }
      ss = wave_sum(ss); if (lane == 0 && r + q * nw < NTOK) rsout[r + q * nw] = 1.0f / sqrtf(ss * (1.f / 1024.f) + nv::EPS); } }
}
__device__ __forceinline__ void phase_route(LAS unsigned char* lds, const Inputs& I, const Bufs& B, const MoeBufs& M) {
  LAS int* lcnt = (LAS int*)lds; LAS int* lbase = lcnt + 32; const int tid = otid();
  for (int blk = blockIdx.x; blk < NTOK / 128; blk += gridDim.x) {
    if (tid < 32) lcnt[tid] = 0;
    __syncthreads();
    int e0 = 0, e1 = 0, r0 = 0, r1 = 0; float w0 = 0.f, w1 = 0.f; const int tok = blk * 128 + tid;
    if (tid < 128) { const float* lg = M.LOGITS + (size_t)tok * 64;
      const float rsd = M.SSQ[tok];
      const f32x4 g4 = *(const f32x4*)lg; const float g0 = rsd * g4.x + I.b_group[0], g1 = rsd * g4.y + I.b_group[1], g2 = rsd * g4.z + I.b_group[2], g3 = rsd * g4.w + I.b_group[3];
      int gi = 0; float gm = g0; if (g1 > gm) { gm = g1; gi = 1; } if (g2 > gm) { gm = g2; gi = 2; } if (g3 > gm) { gm = g3; gi = 3; }
      const float grp_w = 1.0f / (expf(g0 - gm) + expf(g1 - gm) + expf(g2 - gm) + expf(g3 - gm));
      const f32x4 ea = *(const f32x4*)(lg + 4 + gi * 8), eb = *(const f32x4*)(lg + 8 + gi * 8); const f32x4 ba = *(const f32x4*)(I.b_expert + gi * 8), bb = *(const f32x4*)(I.b_expert + gi * 8 + 4);
      const float el[8] = {rsd * ea.x + ba.x, rsd * ea.y + ba.y, rsd * ea.z + ba.z, rsd * ea.w + ba.w, rsd * eb.x + bb.x, rsd * eb.y + bb.y, rsd * eb.z + bb.z, rsd * eb.w + bb.w};
      int i0 = 0; float m0 = el[0];
#pragma unroll
      for (int j = 1; j < 8; ++j) if (el[j] > m0) { m0 = el[j]; i0 = j; }
      int i1 = -1; float m1 = -3.0e38f;
#pragma unroll
      for (int j = 0; j < 8; ++j) if (j != i0 && el[j] > m1) { m1 = el[j]; i1 = j; }
      const float r = expf(m1 - m0); w0 = grp_w / (1.0f + r); w1 = grp_w * r / (1.0f + r);
      e0 = gi * 8 + i0; e1 = gi * 8 + i1;
      r0 = __hip_atomic_fetch_add(lcnt + e0, 1, __ATOMIC_RELAXED, __HIP_MEMORY_SCOPE_WORKGROUP); r1 = __hip_atomic_fetch_add(lcnt + e1, 1, __ATOMIC_RELAXED, __HIP_MEMORY_SCOPE_WORKGROUP); }
    __syncthreads();
    if (tid < 32) { const int n = lcnt[tid]; lbase[tid] = n > 0 ? atomicAdd(&M.CNT[tid * 64], n) : 0; }
    __syncthreads();
    if (tid < 128) { const int p0 = lbase[e0] + r0, p1 = lbase[e1] + r1;
      M.LIST[e0 * LIST_CAP + p0] = tok * 2; M.LIST[e1 * LIST_CAP + p1] = tok * 2 + 1; M.ASG[tok * 2] = (e0 << 16) | p0; M.ASG[tok * 2 + 1] = (e1 << 16) | p1; B.EW[tok * 2] = w0; B.EW[tok * 2 + 1] = w1; }
    __syncthreads(); }
}
__device__ __forceinline__ void build_tile_table(LAS unsigned char* lds, const MoeBufs& M) {
  LAS int* tab = (LAS int*)(lds + LDS_TAB);
  if (threadIdx.x == 0) { int acc = 0; for (int e = 0; e < 32; ++e) { tab[e] = acc; acc += (M.CNT[e * 64] + 255) >> 8; } tab[32] = acc; }
  __syncthreads();
}
__device__ __forceinline__ int tile_expert(const LAS int* tab, int tile) { int e = 0;
#pragma unroll 1
  for (int j = 1; j < 32; ++j) if (tab[j] <= tile) e = j;
  return e; }

struct SchedGU { const int* list; int tile, ct, lbase, nvalid, e;
  __device__ bool next(int i, Unit& u) const { if (i > 0) return false; u.pm = tile; u.pn = ct; u.aux0 = lbase; u.aux1 = nvalid; return true; }
  __device__ __forceinline__ const char* a_base(const pg8::Gemm& g, const Unit&) const { return (const char*)g.A; }
  __device__ __forceinline__ const char* b_base(const pg8::Gemm& g, const Unit&) const { return (const char*)g.Bt + ((size_t)e * 512 + (size_t)ct * 256) * 1024 * 2; }
  __device__ __forceinline__ int a_row(const Unit&, int r) const { return r < nvalid ? (list[lbase + r] >> 1) : 0; } };
struct EpiGU { static constexpr bool PERM = true; u16* act; const int* list; const float* ssq;
  __device__ __forceinline__ void operator()(const f32x4 (&acc)[2][2][4][2], const Unit& u, int wr, int wc, int fr, int fq) const {
    float rs8[8];
#pragma unroll
    for (int k = 0; k < 8; ++k) { const int r = (k >> 2) * 128 + wr * 64 + (k & 3) * 16 + fr; rs8[k] = r < u.aux1 ? gld<float>(ssq + (gld<int>(list + u.aux0 + r) >> 1)) : 0.f; }
#pragma unroll
    for (int ai = 0; ai < 2; ++ai)
#pragma unroll
      for (int m = 0; m < 4; ++m) { const int r = ai * 128 + wr * 64 + m * 16 + fr; const float rs = rs8[ai * 4 + m];
        const f32x4 g0 = acc[ai][0][m][0] * rs, g1 = acc[ai][0][m][1] * rs, u0 = acc[ai][1][m][0] * rs, u1 = acc[ai][1][m][1] * rs;
        const float a[8] = {g0.x * fsig(g0.x) * u0.x, g0.y * fsig(g0.y) * u0.y, g0.z * fsig(g0.z) * u0.z, g0.w * fsig(g0.w) * u0.w, g1.x * fsig(g1.x) * u1.x, g1.y * fsig(g1.y) * u1.y, g1.z * fsig(g1.z) * u1.z, g1.w * fsig(g1.w) * u1.w};
        store8(act + ((size_t)u.pm * 256 + r) * 256 + u.pn * 128 + wc * 32 + 8 * fq, a);
        if (m & 1) asm volatile("" ::: "memory"); } } };
__device__ __forceinline__ void phase_moe_gu(LAS unsigned char* lds, const Bufs& B, const WBufs& W, const MoeBufs& M, const u16* x1) {
  const LAS int* tab = (const LAS int*)(lds + LDS_TAB); const int T = tab[32];
  for (int L = blockIdx.x; L < T * 2; L += gridDim.x) { const int tile = L >> 1, ct = L & 1, e = __builtin_amdgcn_readfirstlane(tile_expert(tab, tile)), rt = tile - __builtin_amdgcn_readfirstlane(tab[e]); int nvalid = __builtin_amdgcn_readfirstlane(M.CNT[e * 64]) - rt * 256; nvalid = nvalid > 256 ? 256 : nvalid;
    pg8::Gemm g{x1, W.WguT, 256, 256, 1024, 1024, 1024, 128}; SchedGU S{M.LIST, tile, ct, e * LIST_CAP + rt * 256, nvalid, e}; EpiGU E{B.ACT, M.LIST, M.SSQ};
    pg8::gemm_phase<EpiGU, SchedGU, true, true>(lds, g, S, E); }
  { const int G = (int)gridDim.x, r = (T * 2) % G;
    if ((int)blockIdx.x >= r) { pg8::Gemm g{W.PB, W.PlePT, NTOK, 1024, 256, 256, 256, 128}; pg8::StaticOrder S; S.init(NTOK, 1024, G - r, (int)blockIdx.x - r); Epi8<FStoreBf> E{FStoreBf{B.PP, 1024}};
      pg8::gemm_phase<Epi8<FStoreBf>, pg8::StaticOrder, true, false>(lds, g, S, E); } }
}
struct SchedD { const LAS int* tab; int T4, G, c;
  __device__ bool next(int i, Unit& u) const { const int L = i * G + c; if (L >= T4) return false; const int tile = L >> 2; u.pm = tile; u.pn = L & 3; u.aux0 = __builtin_amdgcn_readfirstlane(tile_expert(tab, tile)); u.aux1 = 0; return true; }
  __device__ __forceinline__ const char* a_base(const pg8::Gemm& g, const Unit& u) const { return (const char*)g.A + (size_t)u.pm * 256 * 256 * 2; }
  __device__ __forceinline__ const char* b_base(const pg8::Gemm& g, const Unit& u) const { return (const char*)g.Bt + ((size_t)u.aux0 * 1024 + (size_t)u.pn * 256) * 256 * 2; }
  __device__ __forceinline__ int a_row(const Unit&, int) const { return 0; } };
__device__ __forceinline__ void phase_moe_down(LAS unsigned char* lds, const Bufs& B, const WBufs& W, const MoeBufs& M) {
  const LAS int* tab = (const LAS int*)(lds + LDS_TAB);
  pg8::Gemm g{B.ACT, W.WdT, 256, 1024, 256, 256, 256, 128}; SchedD S{tab, tab[32] * 4, (int)gridDim.x, (int)blockIdx.x}; Epi8<FStoreBf> E{FStoreBf{M.MOEOUT, 1024}};
  pg8::gemm_phase<Epi8<FStoreBf>, SchedD, true, false>(lds, g, S, E);
}
__device__ __forceinline__ void phase_moe_combine(LAS unsigned char* lds, const u16* x1, u16* x2, const MoeBufs& M, const float* ew, float* rsout) {
  const LAS int* tab = (const LAS int*)(lds + LDS_TAB);
  const int tid = otid(), lane = tid & 63, gw = obid() * 8 + (tid >> 6), ngw = gridDim.x * 8;
  for (int tk = gw; tk < NTOK; tk += 2 * ngw) { float v[2][2][8]; float rs[2];
    u32x4 xw[2][2], a[2][2], b[2][2]; float w0[2], w1[2];
#pragma unroll
    for (int q = 0; q < 2; ++q) { const int tok = (tk + q * ngw < NTOK) ? tk + q * ngw : tk; const int a0 = M.ASG[tok * 2], a1 = M.ASG[tok * 2 + 1]; w0[q] = ew[tok * 2]; w1[q] = ew[tok * 2 + 1];
      const int s0 = (tab[a0 >> 16] + ((a0 & 0xffff) >> 8)) * 256 + (a0 & 255), s1 = (tab[a1 >> 16] + ((a1 & 0xffff) >> 8)) * 256 + (a1 & 255);
      const u32x4* xr = (const u32x4*)(x1 + (size_t)tok * 1024) + lane; const u32x4* o0 = (const u32x4*)(M.MOEOUT + (size_t)s0 * 1024) + lane; const u32x4* o1 = (const u32x4*)(M.MOEOUT + (size_t)s1 * 1024) + lane;
#pragma unroll
      for (int j = 0; j < 2; ++j) { xw[q][j] = xr[64 * j]; a[q][j] = o0[64 * j]; b[q][j] = o1[64 * j]; } }
#pragma unroll
    for (int q = 0; q < 2; ++q) { float s = 0.f;
#pragma unroll
      for (int j = 0; j < 2; ++j) { const unsigned xe[4] = {xw[q][j].x, xw[q][j].y, xw[q][j].z, xw[q][j].w}, ae[4] = {a[q][j].x, a[q][j].y, a[q][j].z, a[q][j].w}, be[4] = {b[q][j].x, b[q][j].y, b[q][j].z, b[q][j].w};
#pragma unroll
        for (int i = 0; i < 4; ++i) { const float lo = __uint_as_float(xe[i] << 16) + (w0[q] * __uint_as_float(ae[i] << 16) + w1[q] * __uint_as_float(be[i] << 16));
          const float hi = __uint_as_float(xe[i] & 0xffff0000u) + (w0[q] * __uint_as_float(ae[i] & 0xffff0000u) + w1[q] * __uint_as_float(be[i] & 0xffff0000u));
          v[q][j][2 * i] = lo; v[q][j][2 * i + 1] = hi; s += lo * lo + hi * hi; } }
      rs[q] = 1.0f / sqrtf(wave_sum(s) * (1.f / 1024.f) + nv::EPS); }
#pragma unroll
    for (int q = 0; q < 2; ++q) { if (tk + q * ngw >= NTOK) break; const int tok = tk + q * ngw; u32x4* xo = (u32x4*)(x2 + (size_t)tok * 1024) + lane;
      if (lane == 0) rsout[tok] = rs[q];
#pragma unroll
      for (int j = 0; j < 2; ++j) { const float (&x)[8] = v[q][j]; u32x4 ox; ox.x = pk2(x[0], x[1]); ox.y = pk2(x[2], x[3]); ox.z = pk2(x[4], x[5]); ox.w = pk2(x[6], x[7]); xo[64 * j] = ox; } } }
}
}
namespace fa {
using nv::u16; using nv::Bufs;
typedef short bf16x8 __attribute__((ext_vector_type(8)));
typedef short s16x4 __attribute__((ext_vector_type(4)));
typedef float f32x16 __attribute__((ext_vector_type(16)));
typedef unsigned u32x4 __attribute__((ext_vector_type(4)));
constexpr float C2 = 0.125f * 1.4426950408889634f;
constexpr int S = nv::S, QKVW = 1280;
constexpr int IMP_LD = 65, IMP_HEAD = 64 * IMP_LD;
constexpr int L_K = 0, L_V = 32768, L_WSF = 65536, L_IMP = 67584, L_MASK = L_IMP + 4 * IMP_HEAD * 4 + 64  , L_OST = L_IMP  , L_END = L_MASK + 512;
static_assert(L_END <= 147456, "attention LDS map");

__device__ __forceinline__ int crow(int r, int hi) { return (r & 3) + 8 * (r >> 2) + 4 * hi; }
__device__ __forceinline__ float ex2(float x) { return __builtin_amdgcn_exp2f(x); }
__device__ __forceinline__ float max3f(float a, float b, float c) { float r; asm("v_max3_f32 %0, %1, %2, %3" : "=v"(r) : "v"(a), "v"(b), "v"(c)); return r; }
__device__ __forceinline__ float max2f(float a, float b) { float r; asm("v_max_f32_e32 %0, %1, %2" : "=v"(r) : "v"(a), "v"(b)); return r; }
__device__ __forceinline__ float swap_add(float v) { auto rr = __builtin_amdgcn_permlane32_swap(__float_as_uint(v), __float_as_uint(v), false, false); return __uint_as_float(rr[0]) + __uint_as_float(rr[1]); }
__device__ __forceinline__ float swap_max(float v) { auto rr = __builtin_amdgcn_permlane32_swap(__float_as_uint(v), __float_as_uint(v), false, false); return __builtin_fmaxf(__uint_as_float(rr[0]), __uint_as_float(rr[1])); }

__device__ __forceinline__ void phase_qknorm(const nv::Inputs& I, const Bufs& B) {
  for (int it = (int)blockIdx.x * 512 + fx::otid(); it < nv::NTOK * 4; it += (int)gridDim.x * 512) { const int tok = it >> 2, w = it & 3; u16* v; const float* gain;
    if (w < 2) { v = B.QKV + (size_t)tok * QKVW + nv::O_KS + w * 64; gain = I.ks_gain; } else { v = B.QKV + (size_t)tok * QKVW + nv::O_KW + (w - 2) * 64; gain = I.kw_gain; }
    float x[8][8]; float s = 0.f;
#pragma unroll
    for (int c = 0; c < 8; ++c) { fx::load8(v + c * 8, x[c]);
#pragma unroll
      for (int j = 0; j < 8; ++j) s += x[c][j] * x[c][j]; }
    const float rs = 1.0f / sqrtf(s * (1.f / 64.f) + nv::EPS);
#pragma unroll
    for (int c = 0; c < 8; ++c) { float y[8];
#pragma unroll
      for (int j = 0; j < 8; ++j) y[j] = x[c][j] * rs * gain[c * 8 + j];
      fx::store8(v + c * 8, y); } }
}

__device__ __forceinline__ void stage_kv(LAS unsigned char* lds, int slot, const u16* kbase, const u16* vbase, int stride, int wid, int lane, bool withV) {
  { const int row = 8 * wid + (lane >> 3), ch = lane & 7; const u16* ksrc = kbase + (size_t)row * stride + ((ch ^ (row & 7)) * 8);
    __builtin_amdgcn_global_load_lds((const unsigned*)ksrc, (LAS unsigned*)(lds + L_K + slot * 8192 + wid * 1024), 16, 0, 0); }
  if (withV) { const u16* vsrc = vbase + (size_t)(16 * (wid & 3) + (lane >> 2)) * stride + (wid >> 2) * 32 + (lane & 3) * 8;
    __builtin_amdgcn_global_load_lds((const unsigned*)vsrc, (LAS unsigned*)(lds + L_V + slot * 8192 + wid * 1024), 16, 0, 0); }
}
__device__ __forceinline__ void stage_kv2(LAS unsigned char* lds, int slot, const u16* kbase, const u16* vbase, unsigned kofs, unsigned vofs, int wid) {
  __builtin_amdgcn_global_load_lds((const unsigned*)(kbase + kofs), (LAS unsigned*)(lds + L_K + slot * 8192 + wid * 1024), 16, 0, 0);
  __builtin_amdgcn_global_load_lds((const unsigned*)(vbase + vofs), (LAS unsigned*)(lds + L_V + slot * 8192 + wid * 1024), 16, 0, 0);
}
__device__ __forceinline__ void qkt(f32x16& p0, f32x16& p1, const LAS unsigned char* Kslot, const bf16x8 (&qr)[4], int r32, int hi, float bias = 0.f) {
  const LAS unsigned char* kb = Kslot + r32 * 128; const int sw = r32 & 7;
  bf16x8 kf[8];
#pragma unroll
  for (int d0 = 0; d0 < 4; ++d0) { const int o = ((2 * d0 + hi) ^ sw) << 4; kf[2 * d0] = *(const LAS bf16x8*)(kb + o); kf[2 * d0 + 1] = *(const LAS bf16x8*)(kb + 4096 + o); }
  f32x16 z;
#pragma unroll
  for (int r = 0; r < 16; ++r) z[r] = bias;
  asm volatile("s_waitcnt lgkmcnt(0)" ::: "memory"); __builtin_amdgcn_sched_barrier(0);
  p0 = __builtin_amdgcn_mfma_f32_32x32x16_bf16(kf[0], qr[0], z, 0, 0, 0); p1 = __builtin_amdgcn_mfma_f32_32x32x16_bf16(kf[1], qr[0], z, 0, 0, 0);
#pragma unroll
  for (int d0 = 1; d0 < 4; ++d0) { p0 = __builtin_amdgcn_mfma_f32_32x32x16_bf16(kf[2 * d0], qr[d0], p0, 0, 0, 0); p1 = __builtin_amdgcn_mfma_f32_32x32x16_bf16(kf[2 * d0 + 1], qr[d0], p1, 0, 0, 0); }
}
__device__ __forceinline__ void pv(f32x16 (&o)[2], int vb, bf16x8 pa0, bf16x8 pa1, bf16x8 pa2, bf16x8 pa3) {
#define FA_PK(k) (bf16x8){lo[k][0], lo[k][1], lo[k][2], lo[k][3], hi[k][0], hi[k][1], hi[k][2], hi[k][3]}
  s16x4 lo[8], hi[8];
#pragma unroll
  for (int d0 = 0; d0 < 2; ++d0)
#pragma unroll
    for (int ks = 0; ks < 4; ++ks) {
      asm volatile("ds_read_b64_tr_b16 %0,%1 offset:%c2" : "=&v"(lo[d0 * 4 + ks]) : "v"(vb), "i"(d0 * 4096 + ks * 1024) : "memory");
      asm volatile("ds_read_b64_tr_b16 %0,%1 offset:%c2" : "=&v"(hi[d0 * 4 + ks]) : "v"(vb), "i"(d0 * 4096 + ks * 1024 + 512) : "memory"); }
  asm volatile("s_waitcnt lgkmcnt(0)" ::: "memory"); __builtin_amdgcn_sched_barrier(0);
  o[0] = __builtin_amdgcn_mfma_f32_32x32x16_bf16(pa0, FA_PK(0), o[0], 0, 0, 0); o[1] = __builtin_amdgcn_mfma_f32_32x32x16_bf16(pa0, FA_PK(4), o[1], 0, 0, 0);
  o[0] = __builtin_amdgcn_mfma_f32_32x32x16_bf16(pa1, FA_PK(1), o[0], 0, 0, 0); o[1] = __builtin_amdgcn_mfma_f32_32x32x16_bf16(pa1, FA_PK(5), o[1], 0, 0, 0);
  o[0] = __builtin_amdgcn_mfma_f32_32x32x16_bf16(pa2, FA_PK(2), o[0], 0, 0, 0); o[1] = __builtin_amdgcn_mfma_f32_32x32x16_bf16(pa2, FA_PK(6), o[1], 0, 0, 0);
  o[0] = __builtin_amdgcn_mfma_f32_32x32x16_bf16(pa3, FA_PK(3), o[0], 0, 0, 0); o[1] = __builtin_amdgcn_mfma_f32_32x32x16_bf16(pa3, FA_PK(7), o[1], 0, 0, 0);
#undef FA_PK
}
struct SmState { float m, l; f32x16 o[2]; };
#ifdef PROBE_STAMPS
struct Prof { unsigned long long t, a[8]; };
#define FA_PROF_DECL Prof prof; prof.t = __builtin_amdgcn_s_memrealtime(); for (int k_ = 0; k_ < 8; ++k_) prof.a[k_] = 0;
#define FA_PROF(k) do { __builtin_amdgcn_sched_barrier(0); const unsigned long long n_ = __builtin_amdgcn_s_memrealtime(); prof.a[k] += n_ - prof.t; prof.t = n_; __builtin_amdgcn_sched_barrier(0); } while (0)
#define FA_PROF_ARG , Prof& prof
#define FA_PROF_PASS , prof
#else
#define FA_PROF_DECL
#define FA_PROF(k) do {} while (0)
#define FA_PROF_ARG
#define FA_PROF_PASS
#endif
__device__ __forceinline__ void sm_reset(SmState& st) { st.m = 0.f; st.l = 0.f;
#pragma unroll
  for (int r = 0; r < 16; ++r) { st.o[0][r] = 0.f; st.o[1][r] = 0.f; } }
__device__ __forceinline__ void mask_range(f32x16& p0, f32x16& p1, int klo, int khi, int hi) {
  if (__all(klo <= 0 && khi >= 63)) return;
#pragma unroll
  for (int r = 0; r < 16; ++r) { const int k0 = crow(r, hi), k1 = k0 + 32; if (k0 < klo || k0 > khi) p0[r] = -INFINITY; if (k1 < klo || k1 > khi) p1[r] = -INFINITY; }
}
__device__ __forceinline__ void sm_pv(SmState& st, f32x16& p0, f32x16& p1, LAS unsigned char* lds, int slot, const bf16x8 (&qr)[4], LAS float* wsf, int r32, int hi, int vb0, int klo, int khi, float bias FA_PROF_ARG) {
  mask_range(p0, p1, klo, khi, hi);
  float rs = 0.f;
#pragma unroll
  for (int r = 0; r < 16; ++r) { p0[r] = ex2(p0[r]); p1[r] = ex2(p1[r]); rs += p0[r] + p1[r]; }
  if (__builtin_expect(__any(!(rs < 1.0e30f)), 0)) {
    qkt(p0, p1, lds + L_K + slot * 8192, qr, r32, hi, bias - st.m); mask_range(p0, p1, klo, khi, hi);
    float rm = max2f(p0[0], p1[0]);
#pragma unroll
    for (int r = 1; r < 16; ++r) rm = max3f(rm, p0[r], p1[r]);
    rm = swap_max(rm); const float d = rm > 24.f ? rm : 0.f; const float f = ex2(-d); st.m += d; st.l *= f;
    if (hi == 0) wsf[r32] = f;
    rs = 0.f;
#pragma unroll
    for (int r = 0; r < 16; ++r) { p0[r] = ex2(p0[r] - d); p1[r] = ex2(p1[r] - d); rs += p0[r] + p1[r]; const float fr = wsf[crow(r, hi)]; st.o[0][r] *= fr; st.o[1][r] *= fr; } }
  st.l += rs;
  u32x4 w0, w1, w2, w3;
  w0.x = pg8::cvt_pk_bf16(p0[0], p0[1]); w0.y = pg8::cvt_pk_bf16(p0[2], p0[3]); w0.z = pg8::cvt_pk_bf16(p0[4], p0[5]); w0.w = pg8::cvt_pk_bf16(p0[6], p0[7]);
  w1.x = pg8::cvt_pk_bf16(p0[8], p0[9]); w1.y = pg8::cvt_pk_bf16(p0[10], p0[11]); w1.z = pg8::cvt_pk_bf16(p0[12], p0[13]); w1.w = pg8::cvt_pk_bf16(p0[14], p0[15]);
  w2.x = pg8::cvt_pk_bf16(p1[0], p1[1]); w2.y = pg8::cvt_pk_bf16(p1[2], p1[3]); w2.z = pg8::cvt_pk_bf16(p1[4], p1[5]); w2.w = pg8::cvt_pk_bf16(p1[6], p1[7]);
  w3.x = pg8::cvt_pk_bf16(p1[8], p1[9]); w3.y = pg8::cvt_pk_bf16(p1[10], p1[11]); w3.z = pg8::cvt_pk_bf16(p1[12], p1[13]); w3.w = pg8::cvt_pk_bf16(p1[14], p1[15]);
  asm volatile("" : "+v"(w0), "+v"(w1), "+v"(w2), "+v"(w3)); FA_PROF(2);
  pv(st.o, vb0 + L_V + slot * 8192, __builtin_bit_cast(bf16x8, w0), __builtin_bit_cast(bf16x8, w1), __builtin_bit_cast(bf16x8, w2), __builtin_bit_cast(bf16x8, w3));
  asm volatile("" : "+v"(st.o[0]), "+v"(st.o[1])); FA_PROF(3);
}
__device__ __forceinline__ void tile_step(SmState& st, LAS unsigned char* lds, int slot, const bf16x8 (&qr)[4], LAS float* wsf, int r32, int hi, int vb0, int klo, int khi, float bias FA_PROF_ARG) {
  FA_PROF(0);
  f32x16 p0, p1; qkt(p0, p1, lds + L_K + slot * 8192, qr, r32, hi, bias - st.m);
  asm volatile("" : "+v"(p0), "+v"(p1)); FA_PROF(1);
  sm_pv(st, p0, p1, lds, slot, qr, wsf, r32, hi, vb0, klo, khi, bias FA_PROF_PASS);
}
template <int MODE> __device__ __forceinline__ void finalize(SmState& st, float gate, f32x16 (&outacc)[2], LAS float* slab, LAS float* wsf, int r32, int hi, int lane, float& msafe, float& invl) {
  const float lt = swap_add(st.l); invl = lt > 0.f ? 1.0f / lt : 0.f; msafe = st.m;
  if (hi == 0) wsf[r32] = gate * invl;
#pragma unroll
  for (int r = 0; r < 16; ++r) { const float fr = wsf[crow(r, hi)];
    if (MODE == 0) { outacc[0][r] = st.o[0][r] * fr; outacc[1][r] = st.o[1][r] * fr; }
    else if (MODE == 1) { slab[r * 64 + lane] += st.o[0][r] * fr; slab[(16 + r) * 64 + lane] += st.o[1][r] * fr; }
    else { outacc[0][r] = slab[r * 64 + lane] + st.o[0][r] * fr; outacc[1][r] = slab[(16 + r) * 64 + lane] + st.o[1][r] * fr; } }
}
__device__ __forceinline__ void imp_step(LAS unsigned char* lds, int slot, const bf16x8 (&qr)[4], int r32, int hi, int khi, float msafe, float invl, LAS float* imph  , int tq, int T) {
  f32x16 p0, p1; qkt(p0, p1, lds + L_K + slot * 8192, qr, r32, hi);
  mask_range(p0, p1, 0, khi, hi);
#pragma unroll
  for (int r = 0; r < 16; ++r) { p0[r] = ex2(p0[r] - msafe) * invl; p1[r] = ex2(p1[r] - msafe) * invl; }
  LAS float* row = imph + tq * IMP_LD + 16 * T + hi;
#pragma unroll
  for (int gq = 0; gq < 4; ++gq) { row[2 * gq] += (p0[4 * gq] + p0[4 * gq + 1]) + (p0[4 * gq + 2] + p0[4 * gq + 3]); row[2 * gq + 8] += (p1[4 * gq] + p1[4 * gq + 1]) + (p1[4 * gq + 2] + p1[4 * gq + 3]); }
  asm volatile("s_waitcnt lgkmcnt(0)" ::: "memory");
#pragma unroll
  for (int gq = 0; gq < 4; ++gq) { row[2 * gq + 1] += p0[4 * gq + 3]; if (16 * T + hi + 2 * gq + 9 < 64) row[2 * gq + 9] += p1[4 * gq + 3]; }
  asm volatile("s_waitcnt lgkmcnt(0)" ::: "memory");
}
__device__ __forceinline__ void topk_select(LAS unsigned char* lds, LAS float* rows, int wid, int lane, int i) {
  LAS float* IM = (LAS float*)(lds + L_IMP); LAS unsigned long long* MK = (LAS unsigned long long*)(lds + L_MASK);
  const int j = lane; const int nforced = i == 0 ? 1 : (i == 1 ? 2 : 3);
  const bool forced = (j <= i) && (j == 0 || j == i || j == i - 1); const bool cand = (j >= 1) && (j <= i - 2);
  float v8[8]; int cnt[8];
#pragma unroll
  for (int q = 0; q < 8; ++q) { const int tq = wid + 8 * q;
    v8[q] = (IM[tq * IMP_LD + j] + IM[IMP_HEAD + tq * IMP_LD + j]) + (IM[2 * IMP_HEAD + tq * IMP_LD + j] + IM[3 * IMP_HEAD + tq * IMP_LD + j]);
    rows[q * 64 + lane] = cand ? v8[q] : -INFINITY; cnt[q] = 0; }
#pragma unroll 1
  for (int jj = 0; jj <= i - 2; jj += 4) {
#pragma unroll
    for (int q = 0; q < 8; ++q) { const pg8::f32x4 c = *(const LAS pg8::f32x4*)(rows + q * 64 + jj); cnt[q] += ((c.x > v8[q] ? 1 : 0) + (c.y > v8[q] ? 1 : 0)) + ((c.z > v8[q] ? 1 : 0) + (c.w > v8[q] ? 1 : 0)); } }
  const int ncand = i >= 3 ? i - 2 : 0, want = nforced + (ncand < 16 - nforced ? ncand : 16 - nforced);
#pragma unroll
  for (int q = 0; q < 8; ++q) { const float v = v8[q];
    bool sel = forced || (cand && cnt[q] < 16 - nforced);
    unsigned long long mk = __ballot(sel);
    if (__builtin_expect(__builtin_popcountll(mk) != want, 0)) { int c2 = 0;
#pragma unroll 1
      for (int jj = 1; jj <= i - 2; ++jj) { const float vv = __uint_as_float(__builtin_amdgcn_readlane(__float_as_uint(v), jj)); c2 += (vv > v || (vv == v && jj < j)) ? 1 : 0; }
      sel = forced || (cand && c2 < 16 - nforced); mk = __ballot(sel); }
    if (lane == 0) MK[wid + 8 * q] = mk; }
}
__device__ __forceinline__ void attn_unit(LAS unsigned char* lds, const nv::Inputs& I, const Bufs& B, int b, int g, int i) {
  const int tid = fx::otid(), lane = tid & 63, wid = __builtin_amdgcn_readfirstlane(tid >> 6), r32 = lane & 31, hi = lane >> 5;
  const int e = wid >> 1, h = g * 4 + e, tq = 32 * (wid & 1) + r32; const size_t tok = (size_t)b * S + 64 * i + tq; const int t = 64 * i + tq;
  LAS float* wsf = (LAS float*)(lds + L_WSF) + wid * 64;
  LAS float* imph = (LAS float*)(lds + L_IMP) + e * IMP_HEAD;
  const int vb0 = (int)(unsigned)(size_t)lds + ((lane >> 4) & 1) * 32 + (lane & 3) * 8 + (4 * hi + ((lane & 15) >> 2)) * 64;
  const u16* kc = B.KCMP + (size_t)(b * 2 + g) * 256 * 64; const u16* vc = B.VCMP + (size_t)(b * 2 + g) * 256 * 64;
  stage_kv(lds, 0, kc, vc, 64, wid, lane, true);
  bf16x8 qr[4];
  {
    float qv[4][8]; float ss = 0.f; u32x4 qraw[4];
#pragma unroll
    for (int d0 = 0; d0 < 4; ++d0) qraw[d0] = *(const GAS u32x4*)(B.QKV + tok * QKVW + h * 64 + d0 * 16 + hi * 8);
    { LAS float* IM = (LAS float*)(lds + L_IMP); for (int k = tid; k < 4 * IMP_HEAD; k += 512) IM[k] = 0.f; }
#pragma unroll
    for (int d0 = 0; d0 < 4; ++d0) { const unsigned e_[4] = {qraw[d0].x, qraw[d0].y, qraw[d0].z, qraw[d0].w};
#pragma unroll
      for (int j = 0; j < 4; ++j) { qv[d0][2 * j] = __uint_as_float(e_[j] << 16); qv[d0][2 * j + 1] = __uint_as_float(e_[j] & 0xffff0000u); }
#pragma unroll
      for (int j = 0; j < 8; ++j) ss += qv[d0][j] * qv[d0][j]; }
    ss = swap_add(ss); const float rs = C2 / sqrtf(ss * (1.f / 64.f) + nv::EPS);
#pragma unroll
    for (int d0 = 0; d0 < 4; ++d0) { u32x4 w; const float* gq = I.q_gain + d0 * 16 + hi * 8;
      w.x = pg8::cvt_pk_bf16(qv[d0][0] * rs * gq[0], qv[d0][1] * rs * gq[1]); w.y = pg8::cvt_pk_bf16(qv[d0][2] * rs * gq[2], qv[d0][3] * rs * gq[3]);
      w.z = pg8::cvt_pk_bf16(qv[d0][4] * rs * gq[4], qv[d0][5] * rs * gq[5]); w.w = pg8::cvt_pk_bf16(qv[d0][6] * rs * gq[6], qv[d0][7] * rs * gq[7]); qr[d0] = __builtin_bit_cast(bf16x8, w); } }
  const float g0 = B.NG[tok * 24 + h * 3 + 0], g1 = B.NG[tok * 24 + h * 3 + 1], g2 = B.NG[tok * 24 + h * 3 + 2];
  const u16* ksb = B.QKV + (size_t)b * S * QKVW + nv::O_KS + g * 64; const u16* vsb = B.QKV + (size_t)b * S * QKVW + nv::O_VS + g * 64;
  const u16* kwb = B.QKV + (size_t)b * S * QKVW + nv::O_KW + g * 64; const u16* vwb = B.QKV + (size_t)b * S * QKVW + nv::O_VW + g * 64;
  int nvis = t >= 31 ? (t - 31) / 16 + 1 : 0; nvis = nvis > 255 ? 255 : nvis;
  const int ntA = (4 * i + 3 + 63) / 64, nC = (i < 8 ? i : 8) + 1, jC0 = i - (nC - 1);
  const int sI = ntA, sB = 2 * ntA, sC = sB + i + 1, NS = sC + nC;
  f32x16 outacc[2];
  LAS float* slab = (LAS float*)(lds + L_IMP) + wid * 2048;
  SmState st; sm_reset(st);
  float mA = 0.f, invlA = 0.f; unsigned long long mybits = 0ull; const bool late = false;
  FA_PROF_DECL
#ifdef PROBE_STAMPS
  const unsigned long long ck0 = __builtin_amdgcn_s_memtime(), rt0 = __builtin_amdgcn_s_memrealtime();
#endif
  const unsigned kofs64 = (unsigned)((8 * wid + (lane >> 3)) * 64 + (((lane & 7) ^ ((8 * wid + (lane >> 3)) & 7)) * 8)), kofsQ = (unsigned)((8 * wid + (lane >> 3)) * QKVW + (((lane & 7) ^ ((8 * wid + (lane >> 3)) & 7)) * 8));
  const unsigned vofs64 = (unsigned)((16 * (wid & 3) + (lane >> 2)) * 64 + (wid >> 2) * 32 + (lane & 3) * 8), vofsQ = (unsigned)((16 * (wid & 3) + (lane >> 2)) * QKVW + (wid >> 2) * 32 + (lane & 3) * 8);
#define FA_ISSUE1(s_) do { const int s__ = (s_); const int sl = s__ & 3; \
    if (s__ < sI) stage_kv2(lds, sl, kc + (size_t)s__ * 4096, vc + (size_t)s__ * 4096, kofs64, vofs64, wid); \
    else if (s__ < sB) stage_kv2(lds, sl, kc + (size_t)(s__ - sI) * 4096, vc + (size_t)(s__ - sI) * 4096, kofs64, vofs64, wid); \
    else if (s__ < sC) stage_kv2(lds, sl, ksb + (size_t)(s__ - sB) * 64 * QKVW, vsb + (size_t)(s__ - sB) * 64 * QKVW, kofsQ, vofsQ, wid); \
    else stage_kv2(lds, sl, kwb + (size_t)(jC0 + s__ - sC) * 64 * QKVW, vwb + (size_t)(jC0 + s__ - sC) * 64 * QKVW, kofsQ, vofsQ, wid); } while (0)
  int s = 0;
#define FA_TOP(n_) do { FA_PROF(4); asm volatile("s_waitcnt vmcnt(0)" ::: "memory"); FA_PROF(5); __syncthreads(); FA_PROF(6); if (s + 1 < NS) FA_ISSUE1(s + 1); } while (0)
#define FA_PAR_A(sx, klo, khi, bias) { klo = 0; khi = nvis - 64 * (sx) - 1; bias = 0.f; }
#define FA_PAR_B(sx, klo, khi, bias) { const int j_ = (sx) - sB; klo = 0; khi = (j_ == i) ? tq : 63; bias = ((mybits >> j_) & 1ull) ? 0.f : -INFINITY; }
#define FA_PAR_C(sx, klo, khi, bias) { const int j_ = jC0 + ((sx) - sC); klo = (i >= 8 && j_ == i - 8) ? tq + 1 : 0; khi = (j_ == i) ? tq : 63; bias = 0.f; }
#define FA_LOOP(S_END, PAR) \
  if (!late) { _Pragma("unroll 1") for (; s < (S_END); ++s) { FA_TOP(1); int klo_, khi_; float bias_; PAR(s, klo_, khi_, bias_); tile_step(st, lds, s & 3, qr, wsf, r32, hi, vb0, klo_, khi_, bias_ FA_PROF_PASS); } } \
  else if (s < (S_END)) { f32x16 p0, p1; int klo_, khi_; float bias_; FA_TOP(1); PAR(s, klo_, khi_, bias_); qkt(p0, p1, lds + L_K + (s & 3) * 8192, qr, r32, hi, bias_ - st.m); asm volatile("" : "+v"(p0), "+v"(p1)); ++s; \
    _Pragma("unroll 1") for (; s < (S_END); ++s) { FA_TOP(1); sm_pv(st, p0, p1, lds, (s - 1) & 3, qr, wsf, r32, hi, vb0, klo_, khi_, bias_ FA_PROF_PASS); PAR(s, klo_, khi_, bias_); \
      qkt(p0, p1, lds + L_K + (s & 3) * 8192, qr, r32, hi, bias_ - st.m); asm volatile("" : "+v"(p0), "+v"(p1)); } \
    sm_pv(st, p0, p1, lds, (s - 1) & 3, qr, wsf, r32, hi, vb0, klo_, khi_, bias_ FA_PROF_PASS); }
  FA_LOOP(sI, FA_PAR_A)
  finalize<0>(st, g0, outacc, slab, wsf, r32, hi, lane, mA, invlA);
#pragma unroll 1
  for (; s < sB; ++s) { FA_TOP(1); FA_PROF(0); imp_step(lds, s & 3, qr, r32, hi, nvis - 64 * (s - sI) - 1, mA, invlA, imph, tq, s - sI); FA_PROF(7); }
  asm volatile("s_waitcnt lgkmcnt(0)\n\ts_barrier" ::: "memory");
  FA_PROF(6); topk_select(lds, (LAS float*)(lds + (wid < 4 ? L_K : L_V) + ((s + 1) & 3) * 8192 + (wid & 3) * 2048), wid, lane, i);     FA_PROF(5);
  asm volatile("s_waitcnt lgkmcnt(0)\n\ts_barrier" ::: "memory"); mybits = ((const LAS unsigned long long*)(lds + L_MASK))[tq];
#pragma unroll
  for (int r = 0; r < 16; ++r) { slab[r * 64 + lane] = outacc[0][r]; slab[(16 + r) * 64 + lane] = outacc[1][r]; }
  sm_reset(st);
  FA_LOOP(sC, FA_PAR_B)
  { float d0_, d1_; finalize<1>(st, g1, outacc, slab, wsf, r32, hi, lane, d0_, d1_); sm_reset(st); }
  FA_LOOP(NS, FA_PAR_C)
  { float d0_, d1_; finalize<2>(st, g2, outacc, slab, wsf, r32, hi, lane, d0_, d1_); }
#undef FA_ISSUE1
#undef FA_TOP
#undef FA_LOOP
#undef FA_PAR_A
#undef FA_PAR_B
#undef FA_PAR_C
  { u16* Ow = B.YA + ((size_t)b * S + 64 * i + 32 * (wid & 1)) * 512 + h * 64; LAS u16* stg = (LAS u16*)(lds + L_OST) + wid * 4096;
#pragma unroll
    for (int r = 0; r < 16; ++r) { const int orow = crow(r, hi); stg[orow * 64 + r32] = nv::f2bf(outacc[0][r]); stg[orow * 64 + 32 + r32] = nv::f2bf(outacc[1][r]); }
    asm volatile("s_waitcnt lgkmcnt(0)" ::: "memory");
#pragma unroll
    for (int q = 0; q < 4; ++q) { const int row = q * 8 + (lane >> 3), ch = lane & 7; const u32x4 v = *(const LAS u32x4*)(stg + row * 64 + ch * 8); *(GAS u32x4*)(Ow + (size_t)row * 512 + ch * 8) = v; } }
#ifdef PROBE_STAMPS
  if (blockIdx.x == 0 && threadIdx.x == PROBE_TID) { volatile LAS unsigned long long* ts = (volatile LAS unsigned long long*)(lds + 147120); for (int k = 0; k < 8; ++k) ts[20 + k] += prof.a[k]; ts[28] += (__builtin_amdgcn_s_memtime() - ck0) / 10; ts[34] += __builtin_amdgcn_s_memrealtime() - rt0; }
#endif
  __syncthreads();
}
__device__ __forceinline__ void phase_attention(LAS unsigned char* lds, const nv::Inputs& I, const Bufs& B) {
  const int G = gridDim.x, bx = blockIdx.x; const int vcu = (G % 8 == 0) ? (bx % 8) * (G / 8) + bx / 8 : bx;
  for (int u = vcu; u < 256; u += G) { const int bg = u >> 4, s = u & 15;
#pragma unroll 1
    for (int k = 0; k < 4; ++k) { const int i = (k == 0) ? s : (k == 1) ? 31 - s : (k == 2) ? 32 + s : 63 - s; attn_unit(lds, I, B, bg >> 1, bg & 1, i); } }
}
}
namespace fs {
#ifdef PROBE_STAMPS
#define FS_STAMP(k) do { if (blockIdx.x == 0 && threadIdx.x == 0) *(volatile LAS unsigned long long*)(lds + 147120 + 8 * (k)) = __builtin_amdgcn_s_memrealtime(); } while (0)
#else
#define FS_STAMP(k) do {} while (0)
#endif
using nv::u16; using nv::Bufs; using nv::Inputs;
using fa::bf16x8; using fa::f32x16; using fa::u32x4; using fa::crow; using fa::ex2;
typedef float f32x4 __attribute__((ext_vector_type(4)));
constexpr int S = nv::S, NTOK = nv::NTOK, SCD = 1536;
constexpr float LOG2E = 1.4426950408889634f;
struct SsdBufs { u16* XC; u16* STATE; float* ACS; float* DEC; };
__host__ __device__ inline size_t carve_ssd(SsdBufs& X, const Bufs& B, unsigned char* ws, size_t off) {
  auto take = [&](size_t bytes) { unsigned char* r = ws + off; off += (bytes + 255) / 256 * 256; return r; };
  X.XC = B.HB;
  X.STATE = B.HB + (size_t)NTOK * SCD;
  X.ACS = (float*)take((size_t)NTOK * 16 * 4); X.DEC = (float*)take((size_t)8 * 16 * 16 * 4);
  return off;
}
constexpr int L_ARR = 102400;
constexpr int STG_LD = 72;
constexpr int L_BT = 0, BT_LD = 264, L_XWT = 67584;
constexpr int L_KIMG = 0, L_XV = 0, L_OST = 65536;
static_assert(L_XWT + 64 * BT_LD * 2 <= L_ARR && L_OST + 8 * 32 * STG_LD * 2 <= L_ARR && L_ARR + 16384 <= 147456, "SSD LDS map");

__device__ __forceinline__ void phase_conv(const Inputs& I, const Bufs& B, const SsdBufs& X) {
  const int id = blockIdx.x * 512 + fx::otid(); if (id >= 192 * 512) return;
  const int c8 = (id % 192) * 8, run = id / 192; const int tok0 = run * 64; const int t0 = tok0 & (S - 1);
  float w[4][8], bias[8], h0[8], h1[8], h2[8];
#pragma unroll
  for (int j = 0; j < 8; ++j) { bias[j] = I.conv_b[c8 + j];
#pragma unroll
    for (int k = 0; k < 4; ++k) w[k][j] = I.conv_w[k * SCD + c8 + j]; }
  if (t0 >= 3) { fx::load8(B.XBC + (size_t)(tok0 - 3) * SCD + c8, h0); fx::load8(B.XBC + (size_t)(tok0 - 2) * SCD + c8, h1); fx::load8(B.XBC + (size_t)(tok0 - 1) * SCD + c8, h2); }
  else {
#pragma unroll
    for (int j = 0; j < 8; ++j) { h0[j] = 0.f; h1[j] = 0.f; h2[j] = 0.f; } }
#pragma unroll 8
  for (int t = 0; t < 64; ++t) { float x[8], y[8]; fx::load8(B.XBC + (size_t)(tok0 + t) * SCD + c8, x);
#pragma unroll
    for (int j = 0; j < 8; ++j) { const float a = bias[j] + w[0][j] * h0[j] + w[1][j] * h1[j] + w[2][j] * h2[j] + w[3][j] * x[j]; y[j] = a * fx::fsig(a); h0[j] = h1[j]; h1[j] = h2[j]; h2[j] = x[j]; }
    fx::store8(X.XC + (size_t)(tok0 + t) * SCD + c8, y); }
}

__device__ __forceinline__ void ssd_x_unit(LAS unsigned char* lds, const Inputs& I, const Bufs& B, const SsdBufs& X, int b, int c, int g) {
  const int tid = fx::otid(), lane = tid & 63, wid = __builtin_amdgcn_readfirstlane(tid >> 6), r32 = lane & 31, hi = lane >> 5, fr = lane & 15, fq = lane >> 4;
  const size_t tok0 = (size_t)b * S + (size_t)c * 256;
  LAS float* acs2 = (LAS float*)(lds + L_ARR); LAS float* dtl = acs2 + 8 * 256;
  { const int hh = g * 8 + wid; const float a = -expf(I.a_log[hh]) * LOG2E; float d[4], sc[4];
#pragma unroll
    for (int k = 0; k < 4; ++k) d[k] = B.DT[(tok0 + 4 * lane + k) * 16 + hh];
    sc[0] = d[0] * a; sc[1] = sc[0] + d[1] * a; sc[2] = sc[1] + d[2] * a; sc[3] = sc[2] + d[3] * a;
    float tot = sc[3];
#pragma unroll
    for (int o = 1; o < 64; o <<= 1) { const float up = __shfl_up(tot, o); if (lane >= o) tot += up; }
    const float excl = tot - sc[3];
#pragma unroll
    for (int k = 0; k < 4; ++k) { const float v = excl + sc[k]; acs2[wid * 256 + 4 * lane + k] = v; dtl[wid * 256 + 4 * lane + k] = d[k]; X.ACS[(tok0 + 4 * lane + k) * 16 + hh] = v; }
    if (lane == 63) X.DEC[((size_t)b * 16 + c) * 16 + hh] = ex2(tot); }
  { LAS u16* BT = (LAS u16*)(lds + L_BT);
#pragma unroll 1
    for (int q = tid; q < 256 * 16; q += 512) { const int l = 32 * ((q >> 6) & 7) + (q & 31), n8 = (2 * (q >> 9) + ((q >> 5) & 1)) * 8;
      const u32x4 w = *(const GAS u32x4*)(X.XC + (tok0 + l) * SCD + 1024 + g * 128 + n8);
      BT[(n8 + 0) * BT_LD + l] = (u16)(w.x & 0xffff); BT[(n8 + 1) * BT_LD + l] = (u16)(w.x >> 16); BT[(n8 + 2) * BT_LD + l] = (u16)(w.y & 0xffff); BT[(n8 + 3) * BT_LD + l] = (u16)(w.y >> 16);
      BT[(n8 + 4) * BT_LD + l] = (u16)(w.z & 0xffff); BT[(n8 + 5) * BT_LD + l] = (u16)(w.z >> 16); BT[(n8 + 6) * BT_LD + l] = (u16)(w.w & 0xffff); BT[(n8 + 7) * BT_LD + l] = (u16)(w.w >> 16); } }
  __syncthreads();
  FS_STAMP(30);
  u32x4 nx[4];
#define FSX_L(q_) (32 * (((q_) >> 6) & 7) + ((q_) & 31))
#define FSX_P8(q_) ((2 * ((q_) >> 9) + (((q_) >> 5) & 1)) * 8)
#define FSX_LOAD_X(h_) do { _Pragma("unroll") for (int u = 0; u < 4; ++u) { const int q = tid + u * 512; nx[u] = *(const GAS u32x4*)(X.XC + (tok0 + FSX_L(q)) * SCD + (g * 8 + (h_)) * 64 + FSX_P8(q)); } } while (0)
  FSX_LOAD_X(0);
#pragma unroll 1
  for (int h = 0; h < 8; ++h) { const int hh = g * 8 + h; LAS u16* XwT = (LAS u16*)(lds + L_XWT); const LAS u16* BT = (const LAS u16*)(lds + L_BT);
    const float aend = acs2[h * 256 + 255];
#pragma unroll
    for (int u = 0; u < 4; ++u) { const int q = tid + u * 512, l = FSX_L(q), p8 = FSX_P8(q); const float w = ex2(aend - acs2[h * 256 + l]) * dtl[h * 256 + l]; const u32x4 xv = nx[u];
      const unsigned k0 = fx::pk2(__uint_as_float(xv.x << 16) * w, __uint_as_float(xv.x & 0xffff0000u) * w), k1 = fx::pk2(__uint_as_float(xv.y << 16) * w, __uint_as_float(xv.y & 0xffff0000u) * w);
      const unsigned k2 = fx::pk2(__uint_as_float(xv.z << 16) * w, __uint_as_float(xv.z & 0xffff0000u) * w), k3 = fx::pk2(__uint_as_float(xv.w << 16) * w, __uint_as_float(xv.w & 0xffff0000u) * w);
      XwT[(p8 + 0) * BT_LD + l] = (u16)(k0 & 0xffff); XwT[(p8 + 1) * BT_LD + l] = (u16)(k0 >> 16); XwT[(p8 + 2) * BT_LD + l] = (u16)(k1 & 0xffff); XwT[(p8 + 3) * BT_LD + l] = (u16)(k1 >> 16);
      XwT[(p8 + 4) * BT_LD + l] = (u16)(k2 & 0xffff); XwT[(p8 + 5) * BT_LD + l] = (u16)(k2 >> 16); XwT[(p8 + 6) * BT_LD + l] = (u16)(k3 & 0xffff); XwT[(p8 + 7) * BT_LD + l] = (u16)(k3 >> 16); }
    if (h + 1 < 8) FSX_LOAD_X(h + 1);
    asm volatile("s_waitcnt lgkmcnt(0)\n\ts_barrier" ::: "memory");
    { const int pt = wid & 3, nt0 = (wid >> 2) * 4; pg8::f32x4 acc[4];
#pragma unroll
      for (int n = 0; n < 4; ++n) acc[n] = (pg8::f32x4){0.f, 0.f, 0.f, 0.f};
#pragma unroll
      for (int ks = 0; ks < 8; ++ks) { const bf16x8 a = *(const LAS bf16x8*)(XwT + (pt * 16 + fr) * BT_LD + ks * 32 + fq * 8);
#pragma unroll
        for (int n = 0; n < 4; ++n) { const bf16x8 bb = *(const LAS bf16x8*)(BT + ((nt0 + n) * 16 + fr) * BT_LD + ks * 32 + fq * 8); acc[n] = __builtin_amdgcn_mfma_f32_16x16x32_bf16(bb, a, acc[n], 0, 0, 0); } }
      u16* st = X.STATE + (((size_t)b * 16 + c) * 16 + hh) * 8192;
#pragma unroll
      for (int n = 0; n < 4; ++n) { pg8::u32x2 w; w.x = fx::pk2(acc[n][0], acc[n][1]); w.y = fx::pk2(acc[n][2], acc[n][3]); *(GAS pg8::u32x2*)(st + (pt * 16 + fr) * 128 + (nt0 + n) * 16 + 4 * fq) = w; } }
    asm volatile("s_waitcnt lgkmcnt(0)\n\ts_barrier" ::: "memory"); }
#undef FSX_LOAD_X
#undef FSX_L
#undef FSX_P8
  FS_STAMP(31);
  const int lt = wid < 4 ? wid : 11 - wid;
  const int l = 32 * lt + r32;
  for (int k = tid; k < 8 * 256; k += 512) { const int h_ = k >> 8, s_ = k & 255; dtl[k] = ex2(acs2[h_ * 256 + (s_ & ~15)] - acs2[k]) * dtl[k]; }
  bf16x8 qr[8];
#pragma unroll
  for (int d0 = 0; d0 < 8; ++d0) qr[d0] = *(const GAS bf16x8*)(X.XC + (tok0 + l) * SCD + 1280 + g * 128 + d0 * 16 + hi * 8);
  unsigned Sp[4][16];
#define FS_STAGE_K(j_) do { const int j__ = (j_); _Pragma("unroll") for (int q = 0; q < 2; ++q) { const int ch = wid + 8 * q; \
    __builtin_amdgcn_global_load_lds((const unsigned*)(X.XC + (tok0 + 64 * j__ + lane) * SCD + 1024 + g * 128 + ch * 8), (LAS unsigned*)(lds + L_KIMG + (j__ & 1) * 16384 + ch * 1024), 16, 0, 0); } } while (0)
  FS_STAGE_K(0);
#pragma unroll
  for (int j = 0; j < 4; ++j) {
    asm volatile("s_waitcnt vmcnt(0)" ::: "memory"); __syncthreads();
    if (j + 1 < 4) FS_STAGE_K(j + 1);
    f32x16 p0, p1;
#pragma unroll
    for (int r = 0; r < 16; ++r) { p0[r] = 0.f; p1[r] = 0.f; }
    if (64 * j <= 32 * lt + 31) { const LAS unsigned char* kb = lds + L_KIMG + (j & 1) * 16384 + hi * 1024 + r32 * 16;
#pragma unroll
      for (int d0 = 0; d0 < 8; ++d0) { const bf16x8 b0 = *(const LAS bf16x8*)(kb + d0 * 2048), b1 = *(const LAS bf16x8*)(kb + d0 * 2048 + 512);
        p0 = __builtin_amdgcn_mfma_f32_32x32x16_bf16(b0, qr[d0], p0, 0, 0, 0); p1 = __builtin_amdgcn_mfma_f32_32x32x16_bf16(b1, qr[d0], p1, 0, 0, 0); } }
#pragma unroll
    for (int r = 0; r < 8; ++r) { Sp[j][r] = pg8::cvt_pk_bf16(p0[2 * r], p0[2 * r + 1]); Sp[j][8 + r] = pg8::cvt_pk_bf16(p1[2 * r], p1[2 * r + 1]); } }
#undef FS_STAGE_K
  FS_STAMP(32);
  __syncthreads();
#define FS_STAGE_X(h_) do { const int h__ = (h_); _Pragma("unroll") for (int j = 0; j < 4; ++j) \
    __builtin_amdgcn_global_load_lds((const unsigned*)(X.XC + (tok0 + 64 * j + 16 * (wid & 3) + (lane >> 2)) * SCD + (g * 8 + h__) * 64 + (wid >> 2) * 32 + (lane & 3) * 8), \
                                     (LAS unsigned*)(lds + L_XV + (h__ & 1) * 32768 + j * 8192 + wid * 1024), 16, 0, 0); } while (0)
  const int vb0 = (int)(unsigned)(size_t)lds + ((lane >> 4) & 1) * 32 + (lane & 3) * 8 + (4 * hi + ((lane & 15) >> 2)) * 64;
  FS_STAGE_X(0);
#pragma unroll 1
  for (int h = 0; h < 8; ++h) { const int hh = g * 8 + h;
    if (h == 0) asm volatile("s_waitcnt vmcnt(0) lgkmcnt(0)\n\ts_barrier" ::: "memory"); else asm volatile("s_waitcnt vmcnt(4) lgkmcnt(0)\n\ts_barrier" ::: "memory");
    if (h + 1 < 8) FS_STAGE_X(h + 1);
    const float al = acs2[h * 256 + l]; f32x16 o[2];
#pragma unroll
    for (int r = 0; r < 16; ++r) { o[0][r] = 0.f; o[1][r] = 0.f; }
#pragma unroll
    for (int j = 0; j < 4; ++j) { if (64 * j <= 32 * lt + 31) { f32x16 p0, p1;
#pragma unroll
        for (int r = 0; r < 16; ++r) asm volatile("" : "+v"(Sp[j][r]));
#pragma unroll
        for (int r = 0; r < 8; ++r) { p0[2 * r] = __uint_as_float(Sp[j][r] << 16); p0[2 * r + 1] = __uint_as_float(Sp[j][r] & 0xffff0000u); p1[2 * r] = __uint_as_float(Sp[j][8 + r] << 16); p1[2 * r + 1] = __uint_as_float(Sp[j][8 + r] & 0xffff0000u); }
        float e1[4];
#pragma unroll
        for (int q = 0; q < 4; ++q) e1[q] = ex2(al - acs2[h * 256 + 64 * j + 16 * q]);
#pragma unroll
        for (int gq = 0; gq < 4; ++gq) { const int s0 = 64 * j + 8 * gq + 4 * hi; const f32x4 d0v = *(const LAS f32x4*)(dtl + h * 256 + s0), d1v = *(const LAS f32x4*)(dtl + h * 256 + s0 + 32);
          if (64 * j + 63 <= 32 * lt) {
#pragma unroll
            for (int k = 0; k < 4; ++k) { const int r = 4 * gq + k; p0[r] = p0[r] * (e1[gq >> 1] * d0v[k]); p1[r] = p1[r] * (e1[2 + (gq >> 1)] * d1v[k]); } }
          else {
#pragma unroll
            for (int k = 0; k < 4; ++k) { const int r = 4 * gq + k, s = s0 + k; p0[r] = (s <= l) ? p0[r] * (e1[gq >> 1] * d0v[k]) : 0.f; p1[r] = (s + 32 <= l) ? p1[r] * (e1[2 + (gq >> 1)] * d1v[k]) : 0.f; } } }
        u32x4 w0, w1, w2, w3;
        w0.x = pg8::cvt_pk_bf16(p0[0], p0[1]); w0.y = pg8::cvt_pk_bf16(p0[2], p0[3]); w0.z = pg8::cvt_pk_bf16(p0[4], p0[5]); w0.w = pg8::cvt_pk_bf16(p0[6], p0[7]);
        w1.x = pg8::cvt_pk_bf16(p0[8], p0[9]); w1.y = pg8::cvt_pk_bf16(p0[10], p0[11]); w1.z = pg8::cvt_pk_bf16(p0[12], p0[13]); w1.w = pg8::cvt_pk_bf16(p0[14], p0[15]);
        w2.x = pg8::cvt_pk_bf16(p1[0], p1[1]); w2.y = pg8::cvt_pk_bf16(p1[2], p1[3]); w2.z = pg8::cvt_pk_bf16(p1[4], p1[5]); w2.w = pg8::cvt_pk_bf16(p1[6], p1[7]);
        w3.x = pg8::cvt_pk_bf16(p1[8], p1[9]); w3.y = pg8::cvt_pk_bf16(p1[10], p1[11]); w3.z = pg8::cvt_pk_bf16(p1[12], p1[13]); w3.w = pg8::cvt_pk_bf16(p1[14], p1[15]);
        fa::pv(o, vb0 + L_XV + (h & 1) * 32768 + j * 8192, __builtin_bit_cast(bf16x8, w0), __builtin_bit_cast(bf16x8, w1), __builtin_bit_cast(bf16x8, w2), __builtin_bit_cast(bf16x8, w3)); } }
    { const float dsk = I.d_skip[hh]; const LAS u16* xi = (const LAS u16*)(lds + L_XV + (h & 1) * 32768 + (lt >> 1) * 8192); LAS u16* stg = (LAS u16*)(lds + L_OST) + wid * (32 * STG_LD);
#pragma unroll
      for (int r = 0; r < 16; ++r) { const int key = 32 * (lt & 1) + crow(r, hi);
#pragma unroll
        for (int d0 = 0; d0 < 2; ++d0) { const float xv = nv::bf2f(xi[d0 * 2048 + (key >> 4) * 512 + (key & 15) * 32 + r32]); stg[crow(r, hi) * STG_LD + d0 * 32 + r32] = (u16)(fx::pk2(o[d0][r] + dsk * xv, 0.f) & 0xffffu); } }
      asm volatile("s_waitcnt lgkmcnt(0)" ::: "memory");
      u16* Ow = X.XC + (tok0 + 32 * lt) * SCD + hh * 64;
#pragma unroll
      for (int q = 0; q < 4; ++q) { const int row = q * 8 + (lane >> 3), ch = lane & 7; const u32x4 v = *(const LAS u32x4*)(stg + row * STG_LD + ch * 8); *(GAS u32x4*)(Ow + (size_t)row * SCD + ch * 8) = v; } } }
#undef FS_STAMP_DUMMY
#undef FS_STAGE_X
  __syncthreads(); FS_STAMP(33);
}
__device__ __forceinline__ void phase_ssd_x(LAS unsigned char* lds, const Inputs& I, const Bufs& B, const SsdBufs& X) {
  for (int u = blockIdx.x; u < 256; u += gridDim.x) ssd_x_unit(lds, I, B, X, u >> 5, (u >> 1) & 15, u & 1);
}
__device__ __forceinline__ void phase_ssd_scan(const SsdBufs& X) {
  for (int it = blockIdx.x * 512 + fx::otid(); it < 8 * 16 * 64 * 32; it += gridDim.x * 512) { const int n4 = (it & 31) * 4, p = (it >> 5) & 63, hh = (it >> 11) & 15, b = it >> 15;
    pg8::u32x2 v[16]; float dec[16];
#pragma unroll
    for (int c = 0; c < 16; ++c) { v[c] = *(const pg8::u32x2*)(X.STATE + (((size_t)b * 16 + c) * 16 + hh) * 8192 + p * 128 + n4); dec[c] = X.DEC[((size_t)b * 16 + c) * 16 + hh]; }
    float h0 = 0.f, h1 = 0.f, h2 = 0.f, h3 = 0.f;
#pragma unroll
    for (int c = 0; c < 16; ++c) { pg8::u32x2 o; o.x = fx::pk2(h0, h1); o.y = fx::pk2(h2, h3); *(pg8::u32x2*)(X.STATE + (((size_t)b * 16 + c) * 16 + hh) * 8192 + p * 128 + n4) = o;
      h0 = h0 * dec[c] + __uint_as_float(v[c].x << 16); h1 = h1 * dec[c] + __uint_as_float(v[c].x & 0xffff0000u); h2 = h2 * dec[c] + __uint_as_float(v[c].y << 16); h3 = h3 * dec[c] + __uint_as_float(v[c].y & 0xffff0000u); } }
}
__device__ __forceinline__ void ssd_y_unit(LAS unsigned char* lds, const Inputs& I, const Bufs& B, const SsdBufs& X, int b, int c, int g) {
  const int tid = fx::otid(), lane = tid & 63, wid = __builtin_amdgcn_readfirstlane(tid >> 6), r32 = lane & 31, hi = lane >> 5;
  const size_t tok0 = (size_t)b * S + (size_t)c * 256; const int l = 32 * wid + r32;
  LAS float* acsw = (LAS float*)(lds + 0) + wid * 32 * 8;
  LAS u16* stg1 = (LAS u16*)(lds + 16384) + wid * (32 * STG_LD); LAS u16* stg2 = (LAS u16*)(lds + 53248) + wid * (32 * STG_LD); LAS float* rstdL = (LAS float*)(lds + 122880);
  { const int row = lane >> 1, h4 = (lane & 1) * 4; const f32x4 a = *(const GAS f32x4*)(X.ACS + (tok0 + 32 * wid + row) * 16 + g * 8 + h4); acsw[row * 8 + h4 + 0] = ex2(a.x); acsw[row * 8 + h4 + 1] = ex2(a.y); acsw[row * 8 + h4 + 2] = ex2(a.z); acsw[row * 8 + h4 + 3] = ex2(a.w); }
  bf16x8 qr[8];
#pragma unroll
  for (int d0 = 0; d0 < 8; ++d0) qr[d0] = *(const GAS bf16x8*)(X.XC + (tok0 + l) * SCD + 1280 + g * 128 + d0 * 16 + hi * 8);
  float ssq[16];
#pragma unroll
  for (int r = 0; r < 16; ++r) ssq[r] = 0.f;
#define FSY_STAGE_P(h_) do { const int h__ = (h_); const u16* pp_ = X.STATE + (((size_t)b * 16 + c) * 16 + g * 8 + h__) * 8192; _Pragma("unroll") for (int q = 0; q < 2; ++q) { const int ch = wid + 8 * q; \
    __builtin_amdgcn_global_load_lds((const unsigned*)(pp_ + (size_t)lane * 128 + ch * 8), (LAS unsigned*)(lds + 90112 + (h__ & 1) * 16384 + ch * 1024), 16, 0, 0); } } while (0)
#define FSY_LOAD_YZ(h_) do { const int hh__ = g * 8 + (h_); _Pragma("unroll") for (int q = 0; q < 4; ++q) { const int row = q * 8 + (lane >> 3), ch = lane & 7; \
    ny1[q] = *(const GAS u32x4*)(X.XC + (tok0 + 32 * wid + row) * SCD + hh__ * 64 + ch * 8); nz[q] = *(const GAS u32x4*)(B.Z + (tok0 + 32 * wid + row) * 1024 + hh__ * 64 + ch * 8); } } while (0)
  u32x4 ny1[4], nz[4];
  FS_STAMP(34);
  FSY_STAGE_P(0); FSY_LOAD_YZ(0);
#pragma unroll 1
  for (int h = 0; h < 8; ++h) { const int hh = g * 8 + h;
    if (h == 0) asm volatile("s_waitcnt vmcnt(0) lgkmcnt(0)\n\ts_barrier" ::: "memory"); else asm volatile("s_waitcnt vmcnt(4) lgkmcnt(0)\n\ts_barrier" ::: "memory");
#pragma unroll
    for (int q = 0; q < 4; ++q) { const int row = q * 8 + (lane >> 3), ch = lane & 7; *(LAS u32x4*)(stg1 + row * STG_LD + ch * 8) = ny1[q]; *(LAS u32x4*)(stg2 + row * STG_LD + ch * 8) = nz[q]; }
    if (h + 1 < 8) { FSY_STAGE_P(h + 1); FSY_LOAD_YZ(h + 1); }
    f32x16 y[2];
#pragma unroll
    for (int r = 0; r < 16; ++r) { y[0][r] = 0.f; y[1][r] = 0.f; }
    { const LAS unsigned char* pb = lds + 90112 + (h & 1) * 16384 + hi * 1024 + r32 * 16;
#pragma unroll
      for (int d0 = 0; d0 < 8; ++d0) { const bf16x8 b0 = *(const LAS bf16x8*)(pb + d0 * 2048), b1 = *(const LAS bf16x8*)(pb + d0 * 2048 + 512);
        y[0] = __builtin_amdgcn_mfma_f32_32x32x16_bf16(qr[d0], b0, y[0], 0, 0, 0); y[1] = __builtin_amdgcn_mfma_f32_32x32x16_bf16(qr[d0], b1, y[1], 0, 0, 0); } }
    asm volatile("s_waitcnt lgkmcnt(0)" ::: "memory");
#pragma unroll
    for (int r = 0; r < 16; ++r) { const int row = crow(r, hi); const float ea = acsw[row * 8 + h];
#pragma unroll
      for (int d0 = 0; d0 < 2; ++d0) { const int idx = row * STG_LD + d0 * 32 + r32; const float yy = nv::bf2f(stg1[idx]) + ea * y[d0][r]; const float zz = nv::bf2f(stg2[idx]); const float yg = yy * zz * fx::fsig(zz); ssq[r] += yg * yg; stg1[idx] = (u16)(fx::pk2(yg, 0.f) & 0xffffu); } }
    asm volatile("s_waitcnt lgkmcnt(0)" ::: "memory");
#pragma unroll
    for (int q = 0; q < 4; ++q) { const int row = q * 8 + (lane >> 3), ch = lane & 7; *(GAS u32x4*)(B.YB + (tok0 + 32 * wid + row) * 1024 + hh * 64 + ch * 8) = *(const LAS u32x4*)(stg1 + row * STG_LD + ch * 8); }
    asm volatile("s_waitcnt lgkmcnt(0)" ::: "memory"); }
  FS_STAMP(35);
#pragma unroll
  for (int r = 0; r < 16; ++r) { float v = ssq[r];
#pragma unroll
    for (int o = 1; o < 32; o <<= 1) v += __shfl_xor(v, o);
    if (r32 == 0) X.ACS[(tok0 + 32 * wid + crow(r, hi)) * 16 + g * 8] = 1.0f / sqrtf(v * (1.f / 512.f) + nv::EPS); }
#undef FSY_STAGE_P
#undef FSY_LOAD_YZ
  asm volatile("s_waitcnt vmcnt(0) lgkmcnt(0)\n\ts_barrier" ::: "memory"); FS_STAMP(36);
}
__device__ __forceinline__ void phase_ssd_y(LAS unsigned char* lds, const Inputs& I, const Bufs& B, const SsdBufs& X) {
  for (int u = blockIdx.x; u < 256; u += gridDim.x) ssd_y_unit(lds, I, B, X, u >> 5, (u >> 1) & 15, u & 1);
}
}
namespace fc {
using nv::u16; using nv::Bufs; using nv::Inputs; using pg8::Unit;
constexpr int S = nv::S;
struct CmpBufs { u16* WcT; float* BIAS1; float* PAB; };
__host__ __device__ inline size_t carve_cmp(CmpBufs& C, unsigned char* ws, size_t off) {
  auto take = [&](size_t bytes) { unsigned char* r = ws + off; off += (bytes + 255) / 256 * 256; return r; };
  C.WcT = (u16*)take((size_t)2 * 256 * 1024 * 2); C.BIAS1 = (float*)take(2 * 16 * 128 * 4);        C.PAB = (float*)take((size_t)2 * 2 * 16 * 256 * 256 * 4);
  return off;
}
struct CpCmp { const float* src; int ld; __device__ const float* operator()(int n) const { return n < 128 ? src + n : src + (size_t)1024 * 128 + (n - 128); } };
__device__ __forceinline__ void prologue_cmp(LAS unsigned char* lds, const Inputs& I, const CmpBufs& C) {
  { const int tid = fx::otid(), lane = tid & 63, wv = tid >> 6, bid = fx::obid();
    const int G_ = (int)gridDim.x;
    if (wv == 7) for (int idx = (bid + G_ - (128 % G_)) % G_; idx < 32; idx += G_) { const int kv = idx >> 4, sl = idx & 15;        const float* w1 = kv ? I.w1_v : I.w1_k; const float* pos = kv ? I.pos_v : I.pos_k; float s0 = 0.f, s1 = 0.f;
#pragma unroll 8
      for (int kk = 0; kk < 128; ++kk) { const int k = sl * 128 + kk; const float p = pos[k]; s0 += p * w1[(size_t)k * 128 + lane]; s1 += p * w1[(size_t)k * 128 + 64 + lane]; }
      C.BIAS1[(kv * 16 + sl) * 128 + lane] = s0; C.BIAS1[(kv * 16 + sl) * 128 + 64 + lane] = s1; } }
}
struct SchedCmp { int kv, bg, kh;
  __device__ bool next(int i, Unit& u) const { if (i > 0) return false; u.pm = (kh * 2 + kv) * 16 + bg; u.pn = 0; u.aux0 = 0; u.aux1 = 0; return true; }
  __device__ __forceinline__ const char* a_base(const pg8::Gemm& g, const Unit&) const { return (const char*)g.A + (size_t)kh * 8 * 1280 * 2; }
  __device__ __forceinline__ const char* b_base(const pg8::Gemm& g, const Unit&) const { return (const char*)g.Bt + ((size_t)kv * 256 * 1024 + (size_t)kh * 512) * 2; }
  __device__ __forceinline__ int a_row(const Unit&, int r) const { return ((bg >> 1) * S + 16 * r) * 1280 + (kv ? nv::O_VC : nv::O_KC) + (bg & 1) * 64; } };
struct FPab { static constexpr bool HAS_PRE = false; float* o; __device__ __forceinline__ void operator()(const Unit&, int row, int c, const float (&v)[8]) const { float* p = o + (size_t)row * 256 + c; *(pg8::f32x4*)p = (pg8::f32x4){v[0], v[1], v[2], v[3]}; *(pg8::f32x4*)(p + 4) = (pg8::f32x4){v[4], v[5], v[6], v[7]}; } };
__device__ __forceinline__ void phase_cmp_gemm(LAS unsigned char* lds, const Bufs& B, const CmpBufs& C) {
  for (int u = (int)blockIdx.x - ((int)gridDim.x - 64); u >= 0 && u < 64; u += gridDim.x) { pg8::Gemm g{B.QKV, C.WcT, 256, 256, 512, 1, 1024, 1280 * 2}; SchedCmp S{(u >> 4) & 1, u & 15, u >> 5}; fx::Epi8<FPab> E{FPab{C.PAB}};
    pg8::gemm_phase<fx::Epi8<FPab>, SchedCmp, true, true>(lds, g, S, E); }
}
__device__ __forceinline__ void phase_cmp_finish(LAS unsigned char* lds, const Inputs& I, const Bufs& B, const CmpBufs& C) {
  const int tid = fx::otid(), lane = tid & 63, wv = tid >> 6, gw = fx::obid() * 8 + wv, ngw = gridDim.x * 8;
  LAS float* w2s = (LAS float*)lds; LAS float* hs = (LAS float*)(lds + 65536) + wv * 128; LAS float* b1s = (LAS float*)(lds + 69632);
  if (tid < 256) { const float* pp = C.BIAS1 + (size_t)(tid >> 7) * 16 * 128 + (tid & 127); float a = 0.f;
#pragma unroll
    for (int sl = 0; sl < 16; ++sl) a += pp[sl * 128];
    b1s[tid] = a; }
  for (int k = tid; k < 2 * 128 * 64 / 4; k += 512) { const int kv = k >> 11, q = k & 2047; *(LAS pg8::f32x4*)(w2s + kv * 8192 + q * 4) = *(const pg8::f32x4*)((kv ? I.w2_v : I.w2_k) + q * 4); }
  __syncthreads();
  for (int it = gw; it < 2 * 16 * 256; it += ngw) { const int kv = it >> 12, bg = (it >> 8) & 15, c = it & 255; u16* dst = (kv ? B.VCMP : B.KCMP) + ((size_t)bg * 256 + c) * 64;
    if (c == 255) { dst[lane] = 0; continue; }
    const float* pa = C.PAB + ((size_t)(kv * 16 + bg) * 256 + c) * 256; const float* pb = pa + 256 + 128; const LAS float* b1 = b1s + kv * 128;
    const float* pa2 = pa + (size_t)2 * 16 * 256 * 256; const float* pb2 = pb + (size_t)2 * 16 * 256 * 256;
    { const float ha = (pa[lane] + pa2[lane]) + (pb[lane] + pb2[lane]) + b1[lane], hb = (pa[64 + lane] + pa2[64 + lane]) + (pb[64 + lane] + pb2[64 + lane]) + b1[64 + lane]; hs[lane] = ha * fx::fsig(ha); hs[64 + lane] = hb * fx::fsig(hb); }
    const LAS float* w2 = w2s + kv * 8192; float acc = 0.f;
#pragma unroll 8
    for (int n = 0; n < 128; ++n) acc += hs[n] * w2[n * 64 + lane];
    if (kv == 0) { const float ss = fx::wave_sum(acc * acc); acc = acc * (1.0f / sqrtf(ss * (1.f / 64.f) + nv::EPS)) * I.kc_gain[lane]; }
    dst[lane] = nv::f2bf(acc); }
  __syncthreads();
}
}
struct Params { nv::Inputs I; float* out; unsigned char* ws; };
constexpr int LDS_BYTES = 147456;
template <class F> __device__ __forceinline__ void run_phase(const F& f, long n) {
  for (long i = blockIdx.x * 512L + fx::otid(); i < n; i += (long)gridDim.x * 512L) f(i);
}
__global__ void __launch_bounds__(512) mega_fwd(Params P) {
  extern __shared__ __attribute__((aligned(16))) unsigned char lds_raw[];
  LAS unsigned char* lds = (LAS unsigned char*)lds_raw;
  cg::grid_group grid = cg::this_grid();
#define PH(...) { unsigned char* ws_ = P.ws; float* out = P.out; asm volatile("" : "+s"(ws_), "+s"(out)); nv::Bufs B; const size_t woff = nv::carve(B, ws_, out); fx::WBufs W; const size_t moff = fx::carve_w(W, ws_, woff); \
    fx::MoeBufs M; const size_t soff = fx::carve_moe(M, B, ws_, moff); fs::SsdBufs X; const size_t coff = fs::carve_ssd(X, B, ws_, soff); fc::CmpBufs C; const size_t boff = fc::carve_cmp(C, ws_, coff); unsigned* barw = (unsigned*)(ws_ + boff); (void)barw; (void)W; (void)M; (void)X; (void)C; __VA_ARGS__ }
  if (threadIdx.x < 4) ((LAS unsigned*)(lds + LDS_BYTES - 16))[threadIdx.x] = 0u;
  __syncthreads();
  xb::XcdBarrier bar; PH( bar = xb::xcd_barrier_post(barw, (volatile LAS unsigned*)(lds + LDS_BYTES - 16)); )
#define GSYNC() xb::xcd_barrier(bar)
  PH( fx::phase_prologue(lds, P.I, B, W, C.WcT); fx::phase_rms_rows(P.I.x, P.I.mix_norm, B.HB); fx::prologue_pb(P.I, W); fx::prologue_moe(P.I, M); fc::prologue_cmp(lds, P.I, C); ) grid.sync();
  PH( fx::dense_gemm(lds, B.HB, 1024, W.WinT, 1024, nv::NTOK, fx::INW_PAD, 1024, fx::FInProj{B.QKV, B.Z, B.XBC, B.BG, B.NG, B.DT, P.I.dt_bias}); ) GSYNC();
  PH( fc::phase_cmp_gemm(lds, B, C); fs::phase_conv(P.I, B, X); fa::phase_qknorm(P.I, B); ) GSYNC();
  PH( fs::phase_ssd_x(lds, P.I, B, X); ) GSYNC();
  PH( fs::phase_ssd_scan(X); fc::phase_cmp_finish(lds, P.I, B, C); ) GSYNC();
  PH( fs::phase_ssd_y(lds, P.I, B, X); ) GSYNC();
  PH( fa::phase_attention(lds, P.I, B); ) GSYNC();
  PH( fx::dense_gemm(lds, B.YA, 512, W.WaT, 512, nv::NTOK, 1024, 512, fx::FStoreBf{B.T1, 1024}); )
  PH( fx::dense_gemm<fx::FMerge, true, true>(lds, B.YB, 1024, W.WbT, 1024, nv::NTOK, 1024, 1024, fx::FMerge{B.T1, B.BG, B.MERGED, X.ACS}, X.ACS); ) GSYNC();
  PH( fx::dense_gemm(lds, B.MERGED, 1024, W.WoutT, 1024, nv::NTOK, 1024, 1024, fx::FResid{P.I.x, (nv::u16*)out}); ) GSYNC();
  PH( fx::dense_gemm(lds, (const nv::u16*)out, 1024, M.WrT, 1024, nv::NTOK, 256, 1024, fx::FLogits{M.LOGITS}); fx::phase_row_rstd((const nv::u16*)out, M.SSQ, (int)gridDim.x > 128 ? 128 : 0); ) GSYNC();
  PH( fx::phase_route(lds, P.I, B, M); ) GSYNC();
  PH( fx::build_tile_table(lds, M); )
  PH( fx::phase_moe_gu(lds, B, W, M, (const nv::u16*)out); ) GSYNC();
  PH( fx::phase_moe_down(lds, B, W, M); ) GSYNC();
  PH( fx::phase_moe_combine(lds, (const nv::u16*)out, B.ACT, M, B.EW, M.SSQ); ) GSYNC();
  PH( fx::dense_gemm(lds, B.ACT, 1024, W.PleGT, 1024, nv::NTOK, 1024, 1024, fx::FPle{B.ACT, out, B.PP, M.SSQ}); )
#undef GSYNC
}
extern "C" void kernel_launch(void* const* d_in, const int* in_sizes, int n_in, void* d_out, int out_size, void* d_ws, size_t ws_size, hipStream_t stream) {
  static int grid_blocks = 0;
  if (!grid_blocks) {
    int dev = 0, cus = 0, per_cu = 0;
    (void)hipGetDevice(&dev);
    (void)hipDeviceGetAttribute(&cus, hipDeviceAttributeMultiprocessorCount, dev);
    if (hipFuncSetAttribute((const void*)mega_fwd, hipFuncAttributeMaxDynamicSharedMemorySize, LDS_BYTES) != hipSuccess) fprintf(stderr, "kernel_launch: hipFuncSetAttribute failed\n");
    if (hipOccupancyMaxActiveBlocksPerMultiprocessor(&per_cu, mega_fwd, 512, LDS_BYTES) != hipSuccess || per_cu < 1) { fprintf(stderr, "kernel_launch: occupancy query says %d blocks per CU\n", per_cu); }
    grid_blocks = cus;
    { nv::Bufs B; fx::WBufs W; fx::MoeBufs M; fs::SsdBufs X; fc::CmpBufs C; size_t need = 16384 + fc::carve_cmp(C, nullptr, fs::carve_ssd(X, B, nullptr, fx::carve_moe(M, B, nullptr, fx::carve_w(W, nullptr, nv::carve(B, nullptr, nullptr))))); if (need > ws_size) fprintf(stderr, "kernel_launch: workspace too small: need %zu have %zu\n", need, ws_size); }
  }
  static size_t bar_off = 0;
  if (!bar_off) { nv::Bufs B; fx::WBufs W; fx::MoeBufs M; fs::SsdBufs X; fc::CmpBufs C; bar_off = fc::carve_cmp(C, nullptr, fs::carve_ssd(X, B, nullptr, fx::carve_moe(M, B, nullptr, fx::carve_w(W, nullptr, nv::carve(B, nullptr, nullptr))))); }
  (void)hipMemsetAsync((char*)d_ws + bar_off, 0, 16384, stream);
  Params p; memset(&p, 0, sizeof(p));
  const float** ip = (const float**)&p.I; for (int i = 0; i < 34; ++i) ip[i] = (const float*)d_in[i];
  p.out = (float*)d_out; p.ws = (unsigned char*)d_ws;
  void* args[] = {&p};
  hipError_t e = hipLaunchCooperativeKernel((void*)mega_fwd, dim3(grid_blocks), dim3(512), args, LDS_BYTES, stream);
  if (e != hipSuccess) fprintf(stderr, "cooperative launch failed: %s (grid %d)\n", hipGetErrorString(e), grid_blocks);
}
```
